# Optimizing an MI355X kernel written in HIP

```python
import jax, jax.numpy as jnp
from jax import lax
import numpy as np

D_MODEL = 1024
BATCH = 8
SEQ = 2048
DEPTH = 2

GRID_W = 64
CTX_LEN = 256
HEAD_DIM = 64
N_HEADS_TOTAL = D_MODEL // HEAD_DIM
RET_HEADS = N_HEADS_TOTAL // 4
MLSTM_HEADS = N_HEADS_TOTAL // 4
NA_HEADS = N_HEADS_TOTAL - RET_HEADS - MLSTM_HEADS
RET_W = RET_HEADS * HEAD_DIM
MLSTM_W = MLSTM_HEADS * HEAD_DIM
NA_W = NA_HEADS * HEAD_DIM
D_MIX = RET_W + MLSTM_W + NA_W
CHUNK = 128
MLSTM_CONV = 3
NA_WIN_R = 8
NA_WIN_C = 16
ROPE_BASE = 10000.0
D_FF = 2816
N_EXPERTS = 8
TOP_K = 2
N_DENSE = (DEPTH + 1) // 2
N_MOE = DEPTH // 2
EPS = 1e-6
IN_SIZES = (RET_W,) * 4 + (MLSTM_W,) * 4 + (4 * MLSTM_HEADS,) + (NA_W,) * 3
IN_SPLITS = tuple(int(s) for s in np.cumsum(IN_SIZES)[:-1])
D_IN = int(sum(IN_SIZES))

kernel_name = "hybrid_ret_mlstm_natten_moe_dit"

F32 = jnp.float32


def _identity(a):
    return a


def _flip(a):
    return a[:, ::-1]


def rmsnorm(x, g):
    x32 = x.astype(F32)
    y = x32 * lax.rsqrt(jnp.mean(x32 * x32, axis=-1, keepdims=True) + EPS)
    return (y * g.astype(F32)).astype(x.dtype)


def head_rms(y):
    y32 = y.astype(F32)
    return y32 * lax.rsqrt(jnp.mean(y32 * y32, axis=-1, keepdims=True) + EPS)


def qk_norm(y, g):
    return (head_rms(y) * g.astype(F32)).astype(y.dtype)


def _rotate(x, ang):
    x1, x2 = jnp.split(x, 2, axis=-1)
    cos = jnp.cos(ang)[None, :, None, :].astype(x.dtype)
    sin = jnp.sin(ang)[None, :, None, :].astype(x.dtype)
    return jnp.concatenate([x1 * cos - x2 * sin, x1 * sin + x2 * cos], axis=-1)


def rope_2d(x):
    T = x.shape[1]
    t = jnp.arange(T)
    row = (t // GRID_W).astype(F32)
    col = (t % GRID_W).astype(F32)
    half = HEAD_DIM // 2
    inv = ROPE_BASE ** (-jnp.arange(0, half, 2, dtype=F32) / half)
    xr = _rotate(x[..., :half], row[:, None] * inv[None, :])
    xc = _rotate(x[..., half:], col[:, None] * inv[None, :])
    return jnp.concatenate([xr, xc], axis=-1)


def dwconv_centered(x, w, b):
    K = w.shape[0]
    y = lax.conv_general_dilated(x, w[:, None, :].astype(x.dtype), window_strides=(1,),
                                 padding=[((K - 1) // 2, K // 2)],
                                 dimension_numbers=('NWC', 'WIO', 'NWC'),
                                 feature_group_count=x.shape[-1])
    return y + b.astype(x.dtype)


def _chunks(a):
    B, T, H, d = a.shape
    return a.reshape(B, T // CHUNK, CHUNK, H, d).transpose(1, 0, 3, 2, 4).astype(F32)


def _unchunks(a):
    n, B, H, C, d = a.shape
    return a.transpose(1, 0, 3, 2, 4).reshape(B, n * C, H, d)


def _gate_chunks(a):
    B, T, H = a.shape
    return a.reshape(B, T // CHUNK, CHUNK, H).transpose(1, 0, 3, 2).astype(F32)


def retention_scan(q, k, v, log_gamma, s0, with_output):
    d = q.shape[-1]
    qc, kc, vc = _chunks(q), _chunks(k * (d ** -0.5)), _chunks(v)
    lg = log_gamma.astype(F32)
    idx = jnp.arange(CHUNK, dtype=F32)
    diff = idx[:, None] - idx[None, :]
    intra = jnp.where(diff >= 0, jnp.exp(lg[:, None, None] * jnp.maximum(diff, 0.0)), 0.0)
    q_dec = jnp.exp(lg[:, None] * (idx[None, :] + 1.0))
    k_dec = jnp.exp(lg[:, None] * (CHUNK - 1.0 - idx[None, :]))
    c_dec = jnp.exp(lg * CHUNK)

    def step(s, inp):
        qj, kj, vj = inp
        s_new = c_dec[None, :, None, None] * s + jnp.einsum(
            'bhcd,bhce->bhde', kj * k_dec[None, :, :, None], vj)
        if not with_output:
            return s_new, None
        att = jnp.einsum('bhid,bhjd->bhij', qj, kj) * intra[None]
        o = jnp.einsum('bhij,bhje->bhie', att, vj) + jnp.einsum(
            'bhid,bhde->bhie', qj * q_dec[None, :, :, None], s)
        return s_new, o

    s_final, o = lax.scan(step, s0.astype(F32), (qc, kc, vc))
    return (_unchunks(o) if with_output else None), s_final


def mlstm_scan(q, k, v, i_pre, logf, state, with_output):
    d = q.shape[-1]
    qc, kc, vc = _chunks(q), _chunks(k * (d ** -0.5)), _chunks(v)
    ic, fc = _gate_chunks(i_pre), _gate_chunks(logf)
    causal = jnp.tril(jnp.ones((CHUNK, CHUNK), dtype=bool))

    def step(carry, inp):
        C_, n_, m_ = carry
        qj, kj, vj, ij, fj = inp
        b = jnp.cumsum(fj, axis=-1)
        b_last = b[..., -1]
        w_state = b_last[..., None] - b + ij
        m_new = jnp.maximum(b_last + m_, jnp.max(w_state, axis=-1))
        decay_prev = jnp.exp(b_last + m_ - m_new)
        wk = jnp.exp(w_state - m_new[..., None])
        C_new = decay_prev[..., None, None] * C_ + jnp.einsum('bhc,bhcd,bhce->bhde', wk, kj, vj)
        n_new = decay_prev[..., None] * n_ + jnp.einsum('bhc,bhcd->bhd', wk, kj)
        if not with_output:
            return (C_new, n_new, m_new), None
        Dm = jnp.where(causal, b[..., :, None] - b[..., None, :] + ij[..., None, :], -jnp.inf)
        inter = b + m_[..., None]
        m_row = jnp.maximum(jnp.max(Dm, axis=-1), inter)
        s = jnp.einsum('bhid,bhjd->bhij', qj, kj) * jnp.exp(Dm - m_row[..., None])
        g = jnp.exp(inter - m_row)
        num = jnp.einsum('bhij,bhje->bhie', s, vj) + g[..., None] * jnp.einsum('bhid,bhde->bhie', qj, C_)
        den = jnp.sum(s, axis=-1) + g * jnp.einsum('bhid,bhd->bhi', qj, n_)
        h = num / jnp.maximum(jnp.abs(den), jnp.exp(-m_row))[..., None]
        return (C_new, n_new, m_new), h

    st, h = lax.scan(step, state, (qc, kc, vc, ic, fc))
    return (_unchunks(h) if with_output else None), st


def bidir_retention(q, k, v, q_c, k_c, v_c, log_gamma, with_ctx_out):
    B, _, H, d = q.shape
    s0 = jnp.zeros((B, H, d, d), F32)
    y, y_c = 0.0, 0.0
    for dn in range(2):
        f = _identity if dn == 0 else _flip
        oc, sc = retention_scan(f(q_c), f(k_c), f(v_c), log_gamma[dn], s0, with_ctx_out)
        ox, _ = retention_scan(f(q), f(k), f(v), log_gamma[dn], sc, True)
        y = y + f(ox)
        if with_ctx_out:
            y_c = y_c + f(oc)
    return y, (y_c if with_ctx_out else None)


def bidir_mlstm(q, k, v, g, q_c, k_c, v_c, g_c, with_ctx_out):
    B, _, H, d = q.shape
    init = (jnp.zeros((B, H, d, d), F32), jnp.zeros((B, H, d), F32), jnp.zeros((B, H), F32))
    y, y_c = 0.0, 0.0
    for dn in range(2):
        f = _identity if dn == 0 else _flip
        oc, st = mlstm_scan(f(q_c), f(k_c), f(v_c), f(g_c[:, :, dn]),
                            f(jax.nn.log_sigmoid(g_c[:, :, 2 + dn])), init, with_ctx_out)
        ox, _ = mlstm_scan(f(q), f(k), f(v), f(g[:, :, dn]),
                           f(jax.nn.log_sigmoid(g[:, :, 2 + dn])), st, True)
        y = y + f(ox)
        if with_ctx_out:
            y_c = y_c + f(oc)
    return y, (y_c if with_ctx_out else None)


def neighbourhood_attention(q, k, v, k_ctx, v_ctx, rpb):
    B, T, H, d = q.shape
    rows = T // GRID_W
    kr = min(NA_WIN_R, rows)
    r = jnp.arange(rows)
    key_rows = jnp.clip(r - kr // 2, 0, rows - kr)[:, None] + jnp.arange(kr)[None, :]
    cq = jnp.arange(GRID_W)
    start_c = jnp.clip(cq - NA_WIN_C // 2, 0, GRID_W - NA_WIN_C)
    col_ok = (cq[None, :] >= start_c[:, None]) & (cq[None, :] < start_c[:, None] + NA_WIN_C)
    dr = (key_rows - r[:, None] + NA_WIN_R - 1)[:, None, :, None]
    dc = jnp.clip(cq[None, :] - cq[:, None] + NA_WIN_C - 1, 0, 2 * NA_WIN_C - 2)[None, :, None, :]
    bias = rpb.astype(F32)[:, dr, dc]
    scale = HEAD_DIM ** -0.5
    qg = q.reshape(B, rows, GRID_W, H, d)
    kg = k.reshape(B, rows, GRID_W, H, d)[:, key_rows]
    vg = v.reshape(B, rows, GRID_W, H, d)[:, key_rows]
    s_loc = jnp.einsum('brqhd,brkwhd->bhrqkw', qg, kg).astype(F32) * scale + bias[None]
    s_loc = jnp.where(col_ok[None, None, None, :, None, :], s_loc, -jnp.inf)
    s_ctx = jnp.einsum('brqhd,bchd->bhrqc', qg, k_ctx).astype(F32) * scale
    n_loc = kr * GRID_W
    p = jax.nn.softmax(jnp.concatenate([s_loc.reshape(B, H, rows, GRID_W, n_loc), s_ctx], axis=-1), axis=-1)
    p_loc = p[..., :n_loc].reshape(B, H, rows, GRID_W, kr, GRID_W)
    o = jnp.einsum('bhrqkw,brkwhd->brqhd', p_loc, vg) + jnp.einsum('bhrqc,bchd->brqhd', p[..., n_loc:], v_ctx)
    return o.reshape(B, T, H, d).astype(q.dtype)


def context_attention(q, k, v):
    s = jnp.einsum('bqhd,bkhd->bhqk', q, k).astype(F32) * (HEAD_DIM ** -0.5)
    p = jax.nn.softmax(s, axis=-1)
    return jnp.einsum('bhqk,bkhd->bqhd', p, v).astype(q.dtype)


def _prep(h, w_in, conv_w, conv_b, gate_b, latent):
    B, T, _ = h.shape
    rq, rk, rv, rg, mq, mk, mv, mo, mg, nq, nk, nv = jnp.split(h @ w_in, IN_SPLITS, axis=-1)
    rq = rq.reshape(B, T, RET_HEADS, HEAD_DIM)
    rk = rk.reshape(B, T, RET_HEADS, HEAD_DIM)
    if latent:
        rq, rk = rope_2d(rq), rope_2d(rk)
    rv = rv.reshape(B, T, RET_HEADS, HEAD_DIM)
    mqk = jax.nn.silu(dwconv_centered(jnp.concatenate([mq, mk], axis=-1), conv_w, conv_b))
    mq, mk = jnp.split(mqk, 2, axis=-1)
    mq = mq.reshape(B, T, MLSTM_HEADS, HEAD_DIM)
    mk = mk.reshape(B, T, MLSTM_HEADS, HEAD_DIM)
    mv = mv.reshape(B, T, MLSTM_HEADS, HEAD_DIM)
    mg = mg.reshape(B, T, 4, MLSTM_HEADS).astype(F32) + gate_b.astype(F32)
    nq = nq.reshape(B, T, NA_HEADS, HEAD_DIM)
    nk = nk.reshape(B, T, NA_HEADS, HEAD_DIM)
    nv = nv.reshape(B, T, NA_HEADS, HEAD_DIM)
    return rq, rk, rv, rg, mq, mk, mv, mo, mg, nq, nk, nv


def _merge(rg, ret, mo, ml, na, w_out):
    B, T = rg.shape[:2]
    ret = (jax.nn.silu(rg.astype(F32)) * head_rms(ret).reshape(B, T, RET_W)).astype(rg.dtype)
    ml = (jax.nn.sigmoid(mo.astype(F32)) * head_rms(ml).reshape(B, T, MLSTM_W)).astype(rg.dtype)
    return jnp.concatenate([ret, ml, na.reshape(B, T, NA_W)], axis=-1) @ w_out


def mixer(hx, hc, w_in, ret_decay, conv_w, conv_b, gate_b, q_gain, k_gain, rpb, w_out, with_ctx_out):
    X = _prep(hx, w_in, conv_w, conv_b, gate_b, True)
    C = _prep(hc, w_in, conv_w, conv_b, gate_b, False)
    log_gamma = jax.nn.log_sigmoid(ret_decay.astype(F32))
    ret_x, ret_c = bidir_retention(X[0], X[1], X[2], C[0], C[1], C[2], log_gamma, with_ctx_out)
    ml_x, ml_c = bidir_mlstm(X[4], X[5], X[6], X[8], C[4], C[5], C[6], C[8], with_ctx_out)
    nk_c = qk_norm(C[10], k_gain)
    na_x = neighbourhood_attention(qk_norm(X[9], q_gain), qk_norm(X[10], k_gain), X[11], nk_c, C[11], rpb)
    out_x = _merge(X[3], ret_x, X[7], ml_x, na_x, w_out)
    if not with_ctx_out:
        return out_x, None
    na_c = context_attention(qk_norm(C[9], q_gain), nk_c, C[11])
    return out_x, _merge(C[3], ret_c, C[7], ml_c, na_c, w_out)


def swiglu(h, wg, wu, wd):
    return (jax.nn.silu(h @ wg) * (h @ wu)) @ wd


def moe_swiglu(h, w_router, w_gate, w_up, w_down):
    B, T, D = h.shape
    t = h.reshape(B * T, D)
    logits = (t @ w_router).astype(F32)
    top_v, top_i = lax.top_k(logits, TOP_K)
    wts = jax.nn.softmax(top_v, axis=-1)
    combine = jnp.sum(jax.nn.one_hot(top_i, N_EXPERTS, dtype=F32) * wts[..., None], axis=1)
    out = jnp.zeros_like(t)
    for e in range(N_EXPERTS):
        out = out + combine[:, e:e + 1].astype(t.dtype) * swiglu(t, w_gate[e], w_up[e], w_down[e])
    return out.reshape(B, T, D)


def setup_inputs(seed: int = 0) -> dict:
    key = jax.random.key(seed)
    ks = jax.random.split(key, 26)
    D = D_MODEL

    def nrm(k, shape, s):
        return jax.random.normal(k, shape, F32) * s

    gam = 1.0 - 2.0 ** (-5.0 - jnp.arange(RET_HEADS, dtype=F32))
    i_b = nrm(ks[12], (DEPTH, 2, MLSTM_HEADS), 0.1)
    f_b = jnp.linspace(3.0, 6.0, MLSTM_HEADS, dtype=F32) + nrm(ks[13], (DEPTH, 2, MLSTM_HEADS), 0.1)
    return {
        "x": nrm(ks[0], (BATCH, SEQ, D), 1.0),
        "c": nrm(ks[1], (BATCH, D), 1.0),
        "ctx": nrm(ks[2], (BATCH, CTX_LEN, D), 1.0),
        "c_ctx": nrm(ks[3], (D,), 1.0),
        "norm_mix": 1.0 + nrm(ks[4], (DEPTH, D), 0.02),
        "norm_ffn": 1.0 + nrm(ks[5], (DEPTH, D), 0.02),
        "w_mod": nrm(ks[6], (DEPTH, D, 6 * D), 0.5 * D ** -0.5),
        "b_mod": nrm(ks[7], (DEPTH, 6 * D), 0.02),
        "w_in": nrm(ks[8], (DEPTH, D, D_IN), D ** -0.5),
        "ret_decay": (jnp.log(gam) - jnp.log1p(-gam)) + nrm(ks[9], (DEPTH, 2, RET_HEADS), 0.05),
        "mlstm_conv_w": nrm(ks[10], (DEPTH, MLSTM_CONV, 2 * MLSTM_W), MLSTM_CONV ** -0.5),
        "mlstm_conv_b": nrm(ks[11], (DEPTH, 2 * MLSTM_W), 0.02),
        "mlstm_gate_b": jnp.concatenate([i_b, f_b], axis=1),
        "na_q_gain": 1.0 + nrm(ks[14], (DEPTH, HEAD_DIM), 0.02),
        "na_k_gain": 1.0 + nrm(ks[15], (DEPTH, HEAD_DIM), 0.02),
        "na_rpb": nrm(ks[16], (DEPTH, NA_HEADS, 2 * NA_WIN_R - 1, 2 * NA_WIN_C - 1), 0.1),
        "w_out": nrm(ks[17], (DEPTH, D_MIX, D), D_MIX ** -0.5),
        "ffn_w_gate": nrm(ks[18], (N_DENSE, D, D_FF), D ** -0.5),
        "ffn_w_up": nrm(ks[19], (N_DENSE, D, D_FF), D ** -0.5),
        "ffn_w_down": nrm(ks[20], (N_DENSE, D_FF, D), D_FF ** -0.5),
        "moe_router": nrm(ks[21], (N_MOE, D, N_EXPERTS), D ** -0.5),
        "moe_w_gate": nrm(ks[22], (N_MOE, N_EXPERTS, D, D_FF), D ** -0.5),
        "moe_w_up": nrm(ks[23], (N_MOE, N_EXPERTS, D, D_FF), D ** -0.5),
        "moe_w_down": nrm(ks[24], (N_MOE, N_EXPERTS, D_FF, D), D_FF ** -0.5),
    }


def reference(x, c, ctx, c_ctx, norm_mix, norm_ffn, w_mod, b_mod, w_in, ret_decay, mlstm_conv_w,
              mlstm_conv_b, mlstm_gate_b, na_q_gain, na_k_gain, na_rpb, w_out, ffn_w_gate, ffn_w_up,
              ffn_w_down, moe_router, moe_w_gate, moe_w_up, moe_w_down):
    sc_x = jax.nn.silu(c)[:, None, :]
    sc_c = jax.nn.silu(c_ctx)[None, None, :]
    for l in range(DEPTH):
        need_ctx = l < DEPTH - 1
        sh1, s1, g1, sh2, s2, g2 = jnp.split(sc_x @ w_mod[l] + b_mod[l], 6, axis=-1)
        csh1, cs1, cg1, csh2, cs2, cg2 = jnp.split(sc_c @ w_mod[l] + b_mod[l], 6, axis=-1)
        hx = rmsnorm(x, norm_mix[l]) * (1.0 + s1) + sh1
        hc = rmsnorm(ctx, norm_mix[l]) * (1.0 + cs1) + csh1
        mx, mc = mixer(hx, hc, w_in[l], ret_decay[l], mlstm_conv_w[l], mlstm_conv_b[l], mlstm_gate_b[l],
                       na_q_gain[l], na_k_gain[l], na_rpb[l], w_out[l], need_ctx)
        x = x + g1 * mx
        if need_ctx:
            ctx = ctx + cg1 * mc
        h2 = rmsnorm(x, norm_ffn[l]) * (1.0 + s2) + sh2
        if l % 2 == 0:
            j = l // 2
            x = x + g2 * swiglu(h2, ffn_w_gate[j], ffn_w_up[j], ffn_w_down[j])
            if need_ctx:
                h2c = rmsnorm(ctx, norm_ffn[l]) * (1.0 + cs2) + csh2
                ctx = ctx + cg2 * swiglu(h2c, ffn_w_gate[j], ffn_w_up[j], ffn_w_down[j])
        else:
            j = l // 2
            x = x + g2 * moe_swiglu(h2, moe_router[j], moe_w_gate[j], moe_w_up[j], moe_w_down[j])
            if need_ctx:
                h2c = rmsnorm(ctx, norm_ffn[l]) * (1.0 + cs2) + csh2
                ctx = ctx + cg2 * moe_swiglu(h2c, moe_router[j], moe_w_gate[j], moe_w_up[j], moe_w_down[j])
    return x
```

```cpp
#include <hip/hip_runtime.h>
#include <stdio.h>
#include <stdint.h>

#ifndef N_LAUNCH_MODE
#define N_LAUNCH_MODE 1
#endif

constexpr int NB = 8, SEQ = 2048, DM = 1024, CTXL = 256, HD = 64;
constexpr int NLAT = NB * SEQ, NCTX = NB * CTXL, MALL = NLAT + NCTX;
constexpr int DIN = 3600, NPW = 3584;
constexpr int DFF = 2816, NUP = 2 * DFF, NEXP = 8;
constexpr int GRIDW = 64, NROWS = 32;
constexpr float EPS = 1e-6f;
constexpr int PC_RQ = 0, PC_RK = 256, PC_RV = 512, PC_RG = 768, PC_MQ = 1024, PC_MK = 1280, PC_MV = 1536, PC_MO = 1792, PC_NQ = 2048, PC_NK = 2560, PC_NV = 3072;

constexpr size_t al256(size_t x) { return (x + 255) & ~(size_t)255; }
constexpr size_t WS_CTL = 0, CTL_BYTES = 1u << 20;
constexpr size_t WS_MOD = WS_CTL + CTL_BYTES;
constexpr size_t WS_ROPE = WS_MOD + al256((size_t)2 * 9 * 6144 * 4);
constexpr size_t WS_WTIN = WS_ROPE + al256(64 * 16 * 2 * 4);
constexpr size_t WS_WTOUT = WS_WTIN + (size_t)2 * NPW * DM * 2;
constexpr size_t WS_WTUP = WS_WTOUT + (size_t)2 * DM * DM * 2;
constexpr size_t WS_WTDN = WS_WTUP + (size_t)NUP * DM * 2;
constexpr size_t WS_WTMUP = WS_WTDN + (size_t)DM * DFF * 2;
constexpr size_t WS_WTMDN = WS_WTMUP + (size_t)NEXP * NUP * DM * 2;
constexpr size_t WS_H = WS_WTMDN + (size_t)NEXP * DM * DFF * 2;
constexpr size_t WS_XC = WS_H + (size_t)MALL * DM * 2;
constexpr size_t WS_GATES = WS_XC + (size_t)NCTX * DM * 4;
constexpr size_t WS_COMB = WS_GATES + (size_t)MALL * 16 * 4;
constexpr size_t WS_FCUM = WS_COMB + (size_t)NLAT * 8 * 4;
constexpr size_t WS_BIG = WS_FCUM + al256((size_t)NB * 4 * 2 * 2304 * 4);
constexpr size_t WS_MQK = WS_BIG + (size_t)MALL * NPW * 2;
constexpr size_t WS_RETY = WS_MQK + (size_t)MALL * 512 * 2;
constexpr size_t WS_MLY = WS_RETY + (size_t)MALL * 256 * 4;
constexpr size_t WS_NAY = WS_MLY + (size_t)MALL * 256 * 4;
constexpr size_t WS_END = WS_NAY + (size_t)MALL * 512 * 2;

typedef unsigned short bf16_t;
typedef float f32x4 __attribute__((ext_vector_type(4)));
typedef float f32x2 __attribute__((ext_vector_type(2)));
typedef unsigned u32x4 __attribute__((ext_vector_type(4)));
typedef unsigned u32x2 __attribute__((ext_vector_type(2)));
#define LAS __attribute__((address_space(3)))
#define GAS __attribute__((address_space(1)))

__device__ __forceinline__ float bf2f(bf16_t b) { return __uint_as_float(((unsigned)b) << 16); }
__device__ __forceinline__ unsigned f2bf(float f) { unsigned u = __float_as_uint(f); return (u + 0x7fffu + ((u >> 16) & 1u)) >> 16; }
__device__ __forceinline__ unsigned pk2(float lo, float hi) { return f2bf(lo) | (f2bf(hi) << 16); }
__device__ __forceinline__ float bflo(unsigned w) { return __uint_as_float(w << 16); }
__device__ __forceinline__ float bfhi(unsigned w) { return __uint_as_float(w & 0xffff0000u); }
__device__ __forceinline__ float sigmoidf_(float x) { return 1.0f / (1.0f + __expf(-x)); }
__device__ __forceinline__ float siluf_(float x) { return x / (1.0f + __expf(-x)); }
__device__ __forceinline__ float logsigmoidf_(float x) { return fminf(x, 0.f) - log1pf(__expf(-fabsf(x))); }
__device__ __forceinline__ float wave_sum(float v) {
#pragma unroll
    for (int o = 1; o < 64; o <<= 1) v += __shfl_xor(v, o);
    return v;
}
__device__ __forceinline__ float wave_max(float v) {
#pragma unroll
    for (int o = 1; o < 64; o <<= 1) v = fmaxf(v, __shfl_xor(v, o));
    return v;
}

struct Args {
    const float* in[24];
    float* out;
    unsigned char* ws;
    int ph_lo, ph_hi;
};
namespace pg8 {
#define PG8_LAS __attribute__((address_space(3)))
typedef unsigned short bf16_t;
typedef short bf16x8 __attribute__((ext_vector_type(8)));
typedef float f32x4 __attribute__((ext_vector_type(4)));
typedef unsigned u32x4 __attribute__((ext_vector_type(4)));
constexpr int BM = 256, BK = 64, HALF = 128, HTB = HALF * BK * 2  , STAGE_BYTES = 8 * HTB, NXCD = 8, WGM = 8;

__host__ __device__ __forceinline__ int lds_byte(int r, int c) { const int st = (r >> 4) * 2 + (c >> 5), rr = r & 15, cc = c & 31, ob = rr * 64 + cc * 2; return st * 1024 + (ob ^ (((ob >> 9) & 1) << 5)); }
__host__ __device__ __forceinline__ void stage_rc(int b, int& R, int& C) { const int st = b / 1024, sb = b % 1024, swz = sb ^ (((sb >> 9) & 1) << 5); R = (st >> 1) * 16 + swz / 64; C = (st & 1) * 32 + (swz % 64) / 2; }
__host__ __device__ __forceinline__ int perm32(int rho) { const int n = rho >> 4, i = rho & 15; return 8 * (i >> 2) + 4 * n + (i & 3); }

struct Unit { int pm, pn; };
struct Gemm { const bf16_t* A; const bf16_t* Bt; int M, N, K; };

struct StaticOrder {
    int nM, nN, nwg, G, c;
    __host__ __device__ void init(int M, int N, int G_, int c_) { nM = M / BM; nN = N / BM; nwg = nM * nN; G = G_; c = c_; }
    __host__ __device__ bool next(int i, Unit& u) const {
        const long L = (long)i * G + c; if (L >= nwg) return false;
        int wgid = (int)L; { const int q = nwg / NXCD, r = nwg % NXCD, xcd = wgid % NXCD, off = wgid / NXCD; wgid = (xcd < r ? xcd * (q + 1) : r * (q + 1) + (xcd - r) * q) + off; }
        const int nig = WGM * nN, gid = wgid / nig, fm = gid * WGM, gsz = (nM - fm) < WGM ? (nM - fm) : WGM;
        u.pm = fm + ((wgid % nig) % gsz); u.pn = (wgid % nig) / gsz; return true;
    }
    __device__ __forceinline__ void a_ready(const Unit&) const {}
    __device__ __forceinline__ void done(const Unit&) const {}
};
__device__ __forceinline__ unsigned cvt_pk_bf16(float lo, float hi) { unsigned r; asm volatile("v_cvt_pk_bf16_f32 %0, %1, %2" : "=v"(r) : "v"(lo), "v"(hi)); return r; }
typedef float f32x2 __attribute__((ext_vector_type(2)));
struct EpiBf16 {
    static constexpr bool PERM = true, AFTER_DRAIN = false;
    bf16_t* O; int ldc;
    __device__ __forceinline__ void operator()(const f32x4 (&acc)[2][2][4][2], const Unit& u, int wr, int wc, int fr, int fq) const {
        const int row0 = u.pm * BM + wr * 64 + fr, col0 = u.pn * BM + wc * 32 + 8 * fq;
#pragma unroll
        for (int ai = 0; ai < 2; ++ai)
#pragma unroll
            for (int m = 0; m < 4; ++m) { bf16_t* rowp = O + (size_t)(row0 + ai * HALF + m * 16) * ldc + col0;
#pragma unroll
                for (int bj = 0; bj < 2; ++bj) { const f32x4 v0 = acc[ai][bj][m][0], v1 = acc[ai][bj][m][1];
                    u32x4 w; w.x = cvt_pk_bf16(v0[0], v0[1]); w.y = cvt_pk_bf16(v0[2], v0[3]); w.z = cvt_pk_bf16(v1[0], v1[1]); w.w = cvt_pk_bf16(v1[2], v1[3]);
                    *(u32x4*)(rowp + bj * HALF) = w; } }
    }
};
struct EpiSwiGLU {
    static constexpr bool PERM = true, AFTER_DRAIN = false;
    bf16_t* O; int ldc;
    __device__ __forceinline__ void operator()(const f32x4 (&acc)[2][2][4][2], const Unit& u, int wr, int wc, int fr, int fq) const {
        const int row0 = u.pm * BM + wr * 64 + fr, col0 = u.pn * HALF + wc * 32 + 8 * fq;
#pragma unroll
        for (int ai = 0; ai < 2; ++ai)
#pragma unroll
            for (int m = 0; m < 4; ++m) { bf16_t* rowp = O + (size_t)(row0 + ai * HALF + m * 16) * ldc + col0;
                float r[8];
#pragma unroll
                for (int n = 0; n < 2; ++n)
#pragma unroll
                    for (int j = 0; j < 4; ++j) { const float g = acc[ai][0][m][n][j], uu = acc[ai][1][m][n][j]; r[n * 4 + j] = g / (1.0f + __expf(-g)) * uu; }
                u32x4 w; w.x = cvt_pk_bf16(r[0], r[1]); w.y = cvt_pk_bf16(r[2], r[3]); w.z = cvt_pk_bf16(r[4], r[5]); w.w = cvt_pk_bf16(r[6], r[7]);
                *(u32x4*)rowp = w; }
    }
};
struct EpiResid {
    static constexpr bool PERM = false, AFTER_DRAIN = false;
    const float* base_lat; const float* base_ctx; float* out_lat; float* out_ctx; const float* gate; const float* comb; int comb_ld; int nlat_tiles;
    __device__ __forceinline__ void operator()(const f32x4 (&acc)[2][2][4][2], const Unit& u, int wr, int wc, int fr, int fq) const {
        const bool isctx = u.pm >= nlat_tiles;
        const int rloc0 = (isctx ? (u.pm - nlat_tiles) : u.pm) * BM + wr * 64 + fr, col0 = u.pn * BM + wc * 32 + 4 * fq;
        const float* bp = isctx ? base_ctx : base_lat; float* op = isctx ? out_ctx : out_lat;
        const float* gp = gate + (size_t)(isctx ? 8 : (u.pm >> 3)) * 6144 + col0;
        f32x4 gv[2][2];
#pragma unroll
        for (int bj = 0; bj < 2; ++bj)
#pragma unroll
            for (int n = 0; n < 2; ++n) gv[bj][n] = *(const f32x4*)(gp + bj * HALF + n * 16);
#pragma unroll
        for (int ai = 0; ai < 2; ++ai)
#pragma unroll
            for (int m = 0; m < 4; ++m) { const int rl = rloc0 + ai * HALF + m * 16; const size_t off = (size_t)rl * 1024 + col0;
                const float cs = comb ? comb[(size_t)rl * comb_ld] : 1.0f;
#pragma unroll
                for (int bj = 0; bj < 2; ++bj)
#pragma unroll
                    for (int n = 0; n < 2; ++n) { const f32x4 bs = *(const f32x4*)(bp + off + bj * HALF + n * 16);
                        *(f32x4*)(op + off + bj * HALF + n * 16) = bs + gv[bj][n] * acc[ai][bj][m][n] * cs; } }
    }
};
template <class Epi, class Sched, bool STAMP = false>
__device__ __forceinline__ void gemm_phase(PG8_LAS unsigned char* lds, const Gemm g, const Sched& S, const Epi& E, unsigned long long* stamps) {
    int tid_ = threadIdx.x; asm volatile("" : "+v"(tid_)); const int tid = tid_, wid = __builtin_amdgcn_readfirstlane(tid >> 6), lane = tid & 63, wr = wid >> 2, wc = wid & 3, fr = lane & 15, fq = lane >> 4;
    const int K = g.K, nt = K / BK;
    int ts_lo = 0, ts_hi = 0, nts = 0; const unsigned long long rt_entry = STAMP ? (unsigned long long)wall_clock64() : 0ull;
#define PG8_STAMP() do { if (STAMP && wid == 0 && nts < 64) { const unsigned long long _c = (unsigned long long)clock64(); \
        ts_lo = (lane == nts) ? (int)(unsigned)_c : ts_lo; ts_hi = (lane == nts) ? (int)(unsigned)(_c >> 32) : ts_hi; ++nts; } } while (0)
    PG8_STAMP();
    unsigned voffA[2], voffB[2];
#pragma unroll
    for (int i = 0; i < 2; ++i) { int R, C; stage_rc(tid * 16 + i * 8192, R, C); const int Rb = Epi::PERM ? ((R & ~31) + perm32(R & 31)) : R;
        voffA[i] = (unsigned)(R * K + C) * 2u; voffB[i] = (unsigned)(Rb * K + C) * 2u; }
    const size_t kstep = (size_t)(BK * 2);
    const size_t hstep = (size_t)HALF * K * 2;
    const size_t tstep = 2 * hstep;
    const unsigned ldsw = (unsigned)wid * 1024u;
    const int aoff = lds_byte(wr * 64 + fr, fq * 8), boff = lds_byte(wc * 32 + fr, fq * 8);
#define PG8_SA(b, h) (((b) * 2 + (h)) * HTB)
#define PG8_SB(b, h) ((4 + (b) * 2 + (h)) * HTB)
#define PG8_STAGE(bufoff, gbase, voff) do { _Pragma("unroll") for (int _i = 0; _i < 2; ++_i) \
        __builtin_amdgcn_global_load_lds((const unsigned*)((const char*)(gbase) + (voff)[_i]), (PG8_LAS unsigned*)(lds + (bufoff) + ldsw + _i * 8192), 16, 0, 0); } while (0)
#define PG8_LDA(dst, b, h) do { _Pragma("unroll") for (int m = 0; m < 4; ++m) _Pragma("unroll") for (int k = 0; k < 2; ++k) dst[m][k] = *(const PG8_LAS bf16x8*)(lds + PG8_SA(b, h) + aoff + m * 2048 + k * 1024); } while (0)
#define PG8_LDB(dst, b, h) do { _Pragma("unroll") for (int n = 0; n < 2; ++n) _Pragma("unroll") for (int k = 0; k < 2; ++k) dst[n][k] = *(const PG8_LAS bf16x8*)(lds + PG8_SB(b, h) + boff + n * 2048 + k * 1024); } while (0)
#define PG8_MMA(ai, bj, At, Bt) do { __builtin_amdgcn_s_setprio(1); _Pragma("unroll") for (int m = 0; m < 4; ++m) _Pragma("unroll") for (int n = 0; n < 2; ++n) _Pragma("unroll") for (int k = 0; k < 2; ++k) \
        acc[ai][bj][m][n] = __builtin_amdgcn_mfma_f32_16x16x32_bf16(Bt[n][k], At[m][k], acc[ai][bj][m][n], 0, 0, 0); __builtin_amdgcn_s_setprio(0); } while (0)
#define PG8_WAIT_V(n) asm volatile("s_waitcnt vmcnt(" #n ")" ::: "memory")
#define PG8_WAIT_L(n) asm volatile("s_waitcnt lgkmcnt(" #n ")" ::: "memory")
#define PG8_BAR __builtin_amdgcn_s_barrier()
#define PG8_SCHED __builtin_amdgcn_sched_barrier(0)
    Unit cur, nxt; int ui = 0;
    if (!S.next(0, cur)) return;
    f32x4 acc[2][2][4][2];
#pragma unroll
    for (int a = 0; a < 2; ++a)
#pragma unroll
        for (int b = 0; b < 2; ++b)
#pragma unroll
            for (int m = 0; m < 4; ++m)
#pragma unroll
                for (int n = 0; n < 2; ++n) acc[a][b][m][n] = (f32x4){0.f, 0.f, 0.f, 0.f};
    bf16x8 At[4][2], B0[2][2], B1[2][2];
    const char* cA = (const char*)g.A + (size_t)cur.pm * tstep; const char* cB = (const char*)g.Bt + (size_t)cur.pn * tstep;
    S.a_ready(cur);
    PG8_STAGE(PG8_SB(0, 0), cB, voffB); PG8_STAGE(PG8_SA(0, 0), cA, voffA); PG8_STAGE(PG8_SB(0, 1), cB + hstep, voffB); PG8_STAGE(PG8_SA(0, 1), cA + hstep, voffA);
    if (wr == 1) PG8_BAR;
    PG8_WAIT_V(4); PG8_BAR;
    PG8_STAGE(PG8_SB(1, 0), cB + kstep, voffB); PG8_STAGE(PG8_SA(1, 0), cA + kstep, voffA); PG8_STAGE(PG8_SB(1, 1), cB + hstep + kstep, voffB);
    PG8_WAIT_V(6); PG8_BAR;
    PG8_STAMP();
    for (;;) {
        const bool has_next = S.next(ui + 1, nxt);
        const char* nA = has_next ? (const char*)g.A + (size_t)nxt.pm * tstep : cA; const char* nB = has_next ? (const char*)g.Bt + (size_t)nxt.pn * tstep : cB;
        for (int t = 0; t < nt; t += 2) {
            const bool last = (t == nt - 2);
            const char* a1 = cA + (size_t)(t + 1) * kstep;
            const char* a2 = last ? nA : cA + (size_t)(t + 2) * kstep; const char* b2 = last ? nB : cB + (size_t)(t + 2) * kstep;
            const char* a3 = a2 + kstep; const char* b3 = b2 + kstep;
            if (last && has_next) S.a_ready(nxt);
            PG8_LDB(B0, 0, 0); PG8_SCHED; PG8_LDA(At, 0, 0); PG8_STAGE(PG8_SA(1, 1), a1 + hstep, voffA);
            PG8_WAIT_L(8); PG8_BAR; PG8_WAIT_L(0); PG8_MMA(0, 0, At, B0); PG8_BAR; PG8_SCHED;
            PG8_LDB(B1, 0, 1); PG8_STAGE(PG8_SB(0, 0), b2, voffB);
            PG8_BAR; PG8_WAIT_L(0); PG8_MMA(0, 1, At, B1); PG8_BAR;
            PG8_LDA(At, 0, 1); PG8_STAGE(PG8_SA(0, 0), a2, voffA);
            PG8_BAR; PG8_WAIT_L(0); PG8_MMA(1, 0, At, B0); PG8_BAR; PG8_SCHED;
            PG8_STAGE(PG8_SB(0, 1), b2 + hstep, voffB);
            PG8_WAIT_V(6); PG8_BAR; PG8_MMA(1, 1, At, B1); PG8_BAR;
            PG8_LDB(B0, 1, 0); PG8_SCHED; PG8_LDA(At, 1, 0); PG8_STAGE(PG8_SA(0, 1), a2 + hstep, voffA);
            PG8_WAIT_L(8); PG8_BAR; PG8_WAIT_L(0); PG8_MMA(0, 0, At, B0); PG8_BAR; PG8_SCHED;
            PG8_LDB(B1, 1, 1); PG8_STAGE(PG8_SB(1, 0), b3, voffB);
            PG8_BAR; PG8_WAIT_L(0); PG8_MMA(0, 1, At, B1); PG8_BAR;
            PG8_LDA(At, 1, 1); PG8_STAGE(PG8_SA(1, 0), a3, voffA);
            PG8_BAR; PG8_WAIT_L(0); PG8_MMA(1, 0, At, B0); PG8_BAR; PG8_SCHED;
            PG8_STAGE(PG8_SB(1, 1), b3 + hstep, voffB);
            PG8_WAIT_V(6); PG8_BAR; PG8_MMA(1, 1, At, B1); PG8_BAR;
        }
        PG8_STAMP();
        if constexpr (!Epi::AFTER_DRAIN) { E(acc, cur, wr, wc, fr, fq); S.done(cur); }
        PG8_STAMP();
        if (!has_next) break;
#pragma unroll
        for (int a = 0; a < 2; ++a)
#pragma unroll
            for (int b = 0; b < 2; ++b)
#pragma unroll
                for (int m = 0; m < 4; ++m)
#pragma unroll
                    for (int n = 0; n < 2; ++n) acc[a][b][m][n] = (f32x4){0.f, 0.f, 0.f, 0.f};
        cur = nxt; cA = nA; cB = nB; ++ui;
    }
    PG8_WAIT_V(0);
    if (wr == 0) PG8_BAR;
    PG8_BAR;
    if constexpr (Epi::AFTER_DRAIN) { E.fused(acc, cur, wr, wc, fr, fq, lds, wid, lane); S.done(cur); }
    PG8_STAMP();
    if (STAMP && wid == 0) { stamps[lane] = lane < nts ? (((unsigned long long)(unsigned)ts_hi << 32) | (unsigned)ts_lo) : 0ull;
        if (lane == 62) stamps[62] = rt_entry; if (lane == 63) stamps[63] = (unsigned long long)wall_clock64(); }
#undef PG8_STAMP
#undef PG8_SA
#undef PG8_SB
#undef PG8_STAGE
#undef PG8_LDA
#undef PG8_LDB
#undef PG8_MMA
#undef PG8_WAIT_V
#undef PG8_WAIT_L
#undef PG8_BAR
#undef PG8_SCHED
}
}
#define XB_TMO      128
#define XB_XCNT(j)  (256  + 64 * (j))
#define XB_XSUB(j)  (1280 + 64 * (j))
#define XB_XGEN(j)  (2304 + 64 * (j))
#define XB_TOP      3328
#define XB_TOPGEN   3392
#define XCD_BAR_WORDS 3456
#define XB_SPIN_CAP (1u << 24)

__device__ __forceinline__ unsigned xb_ld(unsigned* p)              { return __hip_atomic_load(p, __ATOMIC_RELAXED, __HIP_MEMORY_SCOPE_AGENT); }
__device__ __forceinline__ unsigned xb_add(unsigned* p, unsigned v) { return __hip_atomic_fetch_add(p, v, __ATOMIC_RELAXED, __HIP_MEMORY_SCOPE_AGENT); }
__device__ __forceinline__ unsigned xb_xcc_id() { return (unsigned)__builtin_amdgcn_s_getreg((3 << 11) | 20) & 0xFu; }
#define XB_SPIN(cond, bar) do { unsigned _sp = 0; while (cond) { __builtin_amdgcn_s_sleep(1); \
    if ((++_sp & 255u) == 0u) { if (xb_ld(&(bar)[XB_TMO])) break; if (_sp > XB_SPIN_CAP) { atomicAdd(&(bar)[XB_TMO], 1u); break; } } } } while (0)

struct XcdBarrier {
    unsigned* bar; unsigned x;
    volatile LAS unsigned* st;
};

__device__ __forceinline__ XcdBarrier xcd_barrier_post(unsigned* bar, volatile LAS unsigned* st) {
    XcdBarrier b; b.bar = bar; b.x = xb_xcc_id(); b.st = st;
    if (threadIdx.x == 0) (void)xb_add(&bar[XB_XCNT(b.x)], 1u);
    return b;
}
__device__ __forceinline__ void xcd_barrier_complete(unsigned* bar, unsigned x, unsigned& nloc, unsigned& nx) {
    const unsigned G = gridDim.x * gridDim.y * gridDim.z;
    unsigned sum, cnt, mine, sp = 0u;
    for (;;) {
        sum = 0u; cnt = 0u; mine = 0u;
#pragma unroll
        for (unsigned j = 0; j < 16; ++j) { const unsigned c = xb_ld(&bar[XB_XCNT(j)]); sum += c; cnt += (c > 0u) ? 1u : 0u; mine = (j == x) ? c : mine; }
        if (sum == G) break;
        __builtin_amdgcn_s_sleep(1);
        if ((++sp & 255u) == 0u) { if (xb_ld(&bar[XB_TMO])) break; if (sp > XB_SPIN_CAP) { atomicAdd(&bar[XB_TMO], 1u); break; } }
    }
    nloc = mine > 0u ? mine : 1u; nx = cnt > 0u ? cnt : 1u;
}

__device__ __forceinline__ void xcd_barrier(const XcdBarrier& b) {
    asm volatile("s_waitcnt vmcnt(0)" ::: "memory");
    __syncthreads();
    if (threadIdx.x == 0) {
        unsigned* bar = b.bar;
        __builtin_amdgcn_s_waitcnt(0);
        unsigned nloc = b.st[0], nx = b.st[1];
        if (nloc == 0u) { xcd_barrier_complete(bar, b.x, nloc, nx); b.st[0] = nloc; b.st[1] = nx; }
        const unsigned old = xb_add(&bar[XB_XSUB(b.x)], 1u);
        const unsigned gen = old / nloc;
        if (old + 1u == (gen + 1u) * nloc) {
            __builtin_amdgcn_fence(__ATOMIC_RELEASE, "agent");
            asm volatile("s_waitcnt vmcnt(0)" ::: "memory");
            const unsigned og = xb_add(&bar[XB_TOP], 1u);
            const unsigned tg = og / nx;
            if (og + 1u == (tg + 1u) * nx) xb_add(&bar[XB_TOPGEN], 1u);
            else XB_SPIN(xb_ld(&bar[XB_TOPGEN]) == tg, bar);
            __builtin_amdgcn_fence(__ATOMIC_ACQUIRE, "agent");
            xb_add(&bar[XB_XGEN(b.x)], 1u);
            asm volatile("s_waitcnt vmcnt(0)" ::: "memory");
        } else {
            XB_SPIN(xb_ld(&bar[XB_XGEN(b.x)]) == gen, bar);
            __builtin_amdgcn_fence(__ATOMIC_ACQUIRE, "agent");
            asm volatile("s_waitcnt vmcnt(0)" ::: "memory");
        }
    }
    __syncthreads();
}

constexpr int SCR_BYTES = 139264;
constexpr int MISC_OFF = SCR_BYTES;
constexpr int LDS_BYTES = 147456;
constexpr int CW_BAR = 4096;
constexpr int NTHR = 512, NWAVES = 8;

__device__ __forceinline__ void transpose_item(const float* W, int ldw, int col0, int K, bf16_t* WT, int drow0, int kb, LAS float* scr, int lane) {
    const int k0 = 64 * kb;
#pragma unroll 8
    for (int i = 0; i < 32; ++i) { const int kk = 2 * i + (lane >> 5); scr[kk * 33 + (lane & 31)] = W[(size_t)(k0 + kk) * ldw + col0 + (lane & 31)]; }
    asm volatile("s_waitcnt lgkmcnt(0)" ::: "memory");
    const int c = lane & 7;
#pragma unroll
    for (int j = 0; j < 4; ++j) { const int n = (lane >> 3) + 8 * j; const LAS float* s = scr + (8 * c) * 33 + n;
        u32x4 o; o.x = pk2(s[0 * 33], s[1 * 33]); o.y = pk2(s[2 * 33], s[3 * 33]); o.z = pk2(s[4 * 33], s[5 * 33]); o.w = pk2(s[6 * 33], s[7 * 33]);
        *(u32x4*)(WT + (size_t)(drow0 + n) * K + k0 + 8 * c) = o; }
    asm volatile("s_waitcnt lgkmcnt(0)" ::: "memory");
}
__device__ __forceinline__ void up_item(const float* wg, const float* wu, bf16_t* WT, int it, LAS float* scr, int lane) {
    const int nb = it >> 4, kb = it & 15, r0 = 32 * nb, pn = r0 >> 8, p = r0 & 255;
    transpose_item(p < 128 ? wg : wu, DFF, 128 * pn + (p & 127), DM, WT, r0, kb, scr, lane);
}
__device__ __forceinline__ void dn_item(const float* wd, bf16_t* WT, int it, LAS float* scr, int lane) {
    const int nb = it / 44, kb = it % 44;
    transpose_item(wd, DM, 32 * nb, DFF, WT, 32 * nb, kb, scr, lane);
}
constexpr int IT_IN = 112 * 16, IT_OUT = 32 * 16, IT_UP = 176 * 16, IT_DN = 32 * 44;
constexpr int IT_TOTAL = 2 * IT_IN + 2 * IT_OUT + IT_UP + IT_DN + NEXP * (IT_UP + IT_DN);

__device__ __forceinline__ void phase_prologue(const Args& a, LAS unsigned char* lds, int tid, int lane, int wave, int bid, int G) {
    unsigned char* ws = a.ws;
    {
        LAS float* scr = (LAS float*)(lds + wave * 8704);
        const int gw = bid * NWAVES + wave, NGW = G * NWAVES;
        for (int it0 = gw; it0 < IT_TOTAL; it0 += NGW) {
            int it = it0;
            if (it < 2 * IT_IN) { const int l = it / IT_IN; it -= l * IT_IN; const int nb = it >> 4, kb = it & 15, r0 = 32 * nb;
                transpose_item(a.in[8] + (size_t)l * DM * DIN, DIN, r0 < 2048 ? r0 : r0 + 16, DM, (bf16_t*)(ws + WS_WTIN) + (size_t)l * NPW * DM, r0, kb, scr, lane); continue; }
            it -= 2 * IT_IN;
            if (it < 2 * IT_OUT) { const int l = it / IT_OUT; it -= l * IT_OUT; const int nb = it >> 4, kb = it & 15;
                transpose_item(a.in[16] + (size_t)l * DM * DM, DM, 32 * nb, DM, (bf16_t*)(ws + WS_WTOUT) + (size_t)l * DM * DM, 32 * nb, kb, scr, lane); continue; }
            it -= 2 * IT_OUT;
            if (it < IT_UP) { up_item(a.in[17], a.in[18], (bf16_t*)(ws + WS_WTUP), it, scr, lane); continue; }
            it -= IT_UP;
            if (it < IT_DN) { dn_item(a.in[19], (bf16_t*)(ws + WS_WTDN), it, scr, lane); continue; }
            it -= IT_DN;
            if (it < NEXP * IT_UP) { const int e = it / IT_UP; it -= e * IT_UP;
                up_item(a.in[21] + (size_t)e * DM * DFF, a.in[22] + (size_t)e * DM * DFF, (bf16_t*)(ws + WS_WTMUP) + (size_t)e * NUP * DM, it, scr, lane); continue; }
            it -= NEXP * IT_UP;
            { const int e = it / IT_DN; it -= e * IT_DN; dn_item(a.in[23] + (size_t)e * DFF * DM, (bf16_t*)(ws + WS_WTMDN) + (size_t)e * DM * DFF, it, scr, lane); }
        }
    }
    __syncthreads();
    {
        const int gt = bid * NTHR + tid;
        if (gt < 1024) { const int pos = gt >> 4, i = gt & 15;
            double inv = 1.0; for (int q = 0; q < i; ++q) inv *= 0.56234132519034908;
            const float angf = (float)pos * (float)inv; const double ang = (double)angf;
            const double kq = rint(ang * 0.63661977236758134); const double r = ang - kq * 1.5707963267948966 - kq * 6.123233995736766e-17; const double r2 = r * r;
            double sn = r * (1.0 + r2 * (-1.0 / 6 + r2 * (1.0 / 120 + r2 * (-1.0 / 5040 + r2 * (1.0 / 362880 + r2 * (-1.0 / 39916800 + r2 * (1.0 / 6227020800.0)))))));
            double cs = 1.0 + r2 * (-0.5 + r2 * (1.0 / 24 + r2 * (-1.0 / 720 + r2 * (1.0 / 40320 + r2 * (-1.0 / 3628800 + r2 * (1.0 / 479001600.0 + r2 * (-1.0 / 87178291200.0)))))));
            const int kk = ((int)kq) & 3; double c2, s2;
            if (kk == 0) { c2 = cs; s2 = sn; } else if (kk == 1) { c2 = -sn; s2 = cs; } else if (kk == 2) { c2 = -cs; s2 = -sn; } else { c2 = sn; s2 = -cs; }
            float* R = (float*)(ws + WS_ROPE); R[gt * 2] = (float)c2; R[gt * 2 + 1] = (float)s2; }
    }
    {
        LAS float* sc = (LAS float*)(lds + 73728);
        LAS float* red = (LAS float*)(lds + 73728 + 36864);
        for (int i = tid; i < 9 * 1024; i += NTHR) { const float v = i < 8192 ? a.in[1][i] : a.in[3][i - 8192]; sc[i] = v / (1.0f + __expf(-v)); }
        __syncthreads();
        for (int item = bid; item < 192; item += G) {
            const int l = item / 96, n0 = (item % 96) * 64;
            const float* wm = a.in[6] + (size_t)l * DM * 6144 + n0 + lane;
            float acc[9];
#pragma unroll
            for (int b = 0; b < 9; ++b) acc[b] = 0.f;
#pragma unroll 4
            for (int kk = 0; kk < 128; ++kk) { const int k = wave * 128 + kk; const float w = wm[(size_t)k * 6144];
#pragma unroll
                for (int b = 0; b < 9; ++b) acc[b] += sc[b * 1024 + k] * w; }
#pragma unroll
            for (int b = 0; b < 9; ++b) red[(wave * 9 + b) * 64 + lane] = acc[b];
            __syncthreads();
            for (int o = tid; o < 576; o += NTHR) { const int b = o >> 6, ln = o & 63; float s = a.in[7][(size_t)l * 6144 + n0 + ln];
#pragma unroll
                for (int w = 0; w < 8; ++w) s += red[(w * 9 + b) * 64 + ln];
                ((float*)(ws + WS_MOD))[((size_t)l * 9 + b) * 6144 + n0 + ln] = s; }
            __syncthreads();
        }
    }
}

template <int MODE>
__device__ __forceinline__ void phase_norm(const Args& a, int l, LAS unsigned char* lds, int tid, int lane, int wave, int bid, int G) {
    unsigned char* ws = a.ws;
    LAS float* WT = (LAS float*)lds;
    if (MODE == 0) { const float* w = a.in[8] + (size_t)l * DM * DIN + 2048; for (int i = tid; i < 16384; i += NTHR) { const int k = i >> 4, j = i & 15; WT[j * 1024 + k] = w[(size_t)k * DIN + j]; } __syncthreads(); }
    if (MODE == 2) { const float* w = a.in[20]; for (int i = tid; i < 8192; i += NTHR) { const int k = i >> 3, j = i & 7; WT[j * 1024 + k] = w[(size_t)k * 8 + j]; } __syncthreads(); }
    const float* gam = (MODE == 0 ? a.in[4] : a.in[5]) + (size_t)l * DM;
    const float* mod = (const float*)(ws + WS_MOD) + (size_t)l * 9 * 6144;
    const int shoff = MODE == 0 ? 0 : 3072, soff = MODE == 0 ? 1024 : 4096;
    const int nrows = (MODE == 2) ? NLAT : MALL;
    bf16_t* H = (bf16_t*)(ws + WS_H);
    for (int r = bid * NWAVES + wave; r < nrows; r += G * NWAVES) {
        const bool lat = r < NLAT; const int bi = lat ? (r >> 11) : 8;
        const float* src = (MODE == 0 && l == 0) ? (lat ? a.in[0] + (size_t)r * DM : a.in[2] + (size_t)(r - NLAT) * DM)
                                    : (lat ? a.out + (size_t)r * DM : (const float*)(ws + WS_XC) + (size_t)(r - NLAT) * DM);
        f32x4 v[4]; float ss = 0.f;
#pragma unroll
        for (int j = 0; j < 4; ++j) { v[j] = *(const f32x4*)(src + 4 * lane + 256 * j); ss += (v[j].x * v[j].x + v[j].y * v[j].y) + (v[j].z * v[j].z + v[j].w * v[j].w); }
        const float rstd = rsqrtf(wave_sum(ss) * (1.0f / DM) + EPS);
        const float* mrow = mod + (size_t)bi * 6144;
#pragma unroll
        for (int j = 0; j < 4; ++j) { const int k = 4 * lane + 256 * j;
            const f32x4 g = *(const f32x4*)(gam + k), s = *(const f32x4*)(mrow + soff + k), sh = *(const f32x4*)(mrow + shoff + k);
            v[j] = v[j] * rstd * g * (1.0f + s) + sh;
            u32x2 w; w.x = pk2(v[j].x, v[j].y); w.y = pk2(v[j].z, v[j].w);
            *(u32x2*)(H + (size_t)r * DM + k) = w; }
        if (MODE == 0) {
            float mine = 0.f;
#pragma nounroll
            for (int jg = 0; jg < 16; ++jg) { float s = 0.f;
#pragma unroll
                for (int j = 0; j < 4; ++j) { const f32x4 w = *(const LAS f32x4*)(WT + jg * 1024 + 4 * lane + 256 * j); s += (v[j].x * w.x + v[j].y * w.y) + (v[j].z * w.z + v[j].w * w.w); }
                s = wave_sum(s); mine = (lane == jg) ? s : mine; }
            if (lane < 16) ((float*)(ws + WS_GATES))[(size_t)r * 16 + lane] = mine + a.in[12][l * 16 + lane];
        }
        if (MODE == 2) {
            int i1 = 0, i2 = 0; float v1 = -3.0e38f, v2 = -3.0e38f;
#pragma nounroll
            for (int e = 0; e < 8; ++e) { float s = 0.f;
#pragma unroll
                for (int j = 0; j < 4; ++j) { const f32x4 w = *(const LAS f32x4*)(WT + e * 1024 + 4 * lane + 256 * j); s += (v[j].x * w.x + v[j].y * w.y) + (v[j].z * w.z + v[j].w * w.w); }
                s = wave_sum(s);
                if (s > v1) { v2 = v1; i2 = i1; v1 = s; i1 = e; } else if (s > v2) { v2 = s; i2 = e; } }
            const float w2 = 1.0f / (1.0f + __expf(v1 - v2)), w1 = 1.0f - w2;
            if (lane < 8) ((float*)(ws + WS_COMB))[(size_t)r * 8 + lane] = (lane == i1) ? w1 : ((lane == i2) ? w2 : 0.f);
        }
    }
}

__device__ __forceinline__ void phase_post(const Args& a, int l, int lane, int wave, int bid, int G) {
    unsigned char* ws = a.ws;
    bf16_t* P = (bf16_t*)(ws + WS_BIG); bf16_t* MQK = (bf16_t*)(ws + WS_MQK);
    const float* ROPE = (const float*)(ws + WS_ROPE);
    const float* cw = a.in[10] + (size_t)l * 3 * 512; const float* cb = a.in[11] + (size_t)l * 512;
    const float qg = a.in[13][l * 64 + lane], kg = a.in[14][l * 64 + lane];
    for (int r = bid * NWAVES + wave; r < MALL; r += G * NWAVES) {
        const bool lat = r < NLAT; bf16_t* row = P + (size_t)r * NPW;
        int t, tlen; if (lat) { t = r & (SEQ - 1); tlen = SEQ; } else { t = (r - NLAT) & (CTXL - 1); tlen = CTXL; }
        if (lat) { const int gr = t >> 6, gc = t & 63;
#pragma unroll
            for (int blk = 0; blk < 2; ++blk)
#pragma unroll
                for (int ii = 0; ii < 2; ++ii) { const int pid = lane + 64 * ii, head = pid >> 5, half = (pid >> 4) & 1, i = pid & 15, c1 = (blk ? PC_RK : PC_RQ) + head * 64 + half * 32 + i;
                    const int pos = half ? gc : gr; const float cs = ROPE[(pos * 16 + i) * 2], sn = ROPE[(pos * 16 + i) * 2 + 1];
                    const float x1 = bf2f(row[c1]), x2 = bf2f(row[c1 + 16]); const float sc = blk ? 0.125f : 1.0f;
                    row[c1] = (bf16_t)f2bf((x1 * cs - x2 * sn) * sc); row[c1 + 16] = (bf16_t)f2bf((x1 * sn + x2 * cs) * sc); }
        } else {
#pragma unroll
            for (int ii = 0; ii < 4; ++ii) { const int c = PC_RK + lane + 64 * ii; row[c] = (bf16_t)f2bf(bf2f(row[c]) * 0.125f); }
        }
#pragma unroll
        for (int ii = 0; ii < 8; ++ii) { const int c = lane + 64 * ii;
            const float x0 = bf2f(row[PC_MQ + c]);
            const float xm = t > 0 ? bf2f(row[PC_MQ + c - NPW]) : 0.f, xp = t < tlen - 1 ? bf2f(row[PC_MQ + c + NPW]) : 0.f;
            float y = cb[c] + cw[c] * xm + cw[512 + c] * x0 + cw[1024 + c] * xp;
            y = y / (1.0f + __expf(-y)); if (c >= 256) y *= 0.125f;
            MQK[(size_t)r * 512 + c] = (bf16_t)f2bf(y); }
#pragma unroll
        for (int hh = 0; hh < 16; ++hh) { const int c = PC_NQ + hh * 64 + lane; const float v = bf2f(row[c]);
            const float rs = rsqrtf(wave_sum(v * v) * (1.0f / 64.0f) + EPS);
            row[c] = (bf16_t)f2bf(v * rs * (hh < 8 ? qg : kg)); }
    }
}

__device__ __forceinline__ int tokrow(int b, int p, int dir) {
    if (dir == 0) return p < CTXL ? NLAT + b * CTXL + p : b * SEQ + (p - CTXL);
    return p < CTXL ? NLAT + b * CTXL + (CTXL - 1 - p) : b * SEQ + (SEQ - 1 - (p - CTXL));
}
__device__ __forceinline__ void phase_fcum(const Args& a, int lane, int wave, int bid, int G) {
    unsigned char* ws = a.ws; const float* GT = (const float*)(ws + WS_GATES); float* F = (float*)(ws + WS_FCUM);
    for (int it = bid * NWAVES + wave; it < NB * 4 * 2; it += G * NWAVES) {
        const int dir = it & 1, h = (it >> 1) & 3, b = it >> 3; float carry = 0.f;
        for (int p0 = 0; p0 < CTXL + SEQ; p0 += 64) { const int p = p0 + lane; const int row = tokrow(b, p, dir);
            float v = logsigmoidf_(GT[(size_t)row * 16 + 8 + 4 * dir + h]);
#pragma unroll
            for (int o = 1; o < 64; o <<= 1) { const float u = __shfl_up(v, o); if (lane >= o) v += u; }
            F[(size_t)((b * 4 + h) * 2 + dir) * 2304 + p] = carry + v;
            carry += __shfl(v, 63); }
    }
}

__device__ __forceinline__ void phase_quad(const Args& a, int l, bool need_ctx, LAS unsigned char* lds, int lane, int wave, int bid, int G) {
    unsigned char* ws = a.ws;
    const bf16_t* P = (const bf16_t*)(ws + WS_BIG); const bf16_t* MQK = (const bf16_t*)(ws + WS_MQK);
    const float* GT = (const float*)(ws + WS_GATES); const float* FC = (const float*)(ws + WS_FCUM);
    LAS float* scr = (LAS float*)(lds + wave * 16640);
    const int nrows = need_ctx ? MALL : NLAT, nitems = nrows * 8;
    for (int it = bid * NWAVES + wave; it < nitems; it += G * NWAVES) {
        const int kind = it & 1, h = (it >> 1) & 3, r = it >> 3;
        const bool lat = r < NLAT; const int b = lat ? (r >> 11) : ((r - NLAT) >> 8), tt = lat ? (r & (SEQ - 1)) : ((r - NLAT) & (CTXL - 1));
        const bf16_t* qsrc = kind == 0 ? P + (size_t)r * NPW + PC_RQ + h * 64 : MQK + (size_t)r * 512 + h * 64;
        unsigned qp[32];
#pragma unroll
        for (int i = 0; i < 8; ++i) { const u32x4 w = *(const u32x4*)(qsrc + 8 * i); qp[4 * i] = w.x; qp[4 * i + 1] = w.y; qp[4 * i + 2] = w.z; qp[4 * i + 3] = w.w; }
        float y = 0.f;
        for (int dir = 0; dir < 2; ++dir) {
            const int p = lat ? (dir == 0 ? CTXL + tt : CTXL + (SEQ - 1 - tt)) : (dir == 0 ? tt : CTXL - 1 - tt);
            const float lg = logsigmoidf_(a.in[9][(l * 2 + dir) * 4 + h]);
            const float* fc = FC + (size_t)((b * 4 + h) * 2 + dir) * 2304; const float fp = fc[p];
            float num[64]; float den = 0.f;
#pragma unroll
            for (int e = 0; e < 64; ++e) num[e] = 0.f;
            for (int p0 = 0; p0 <= p; p0 += 64) {
                const int pk = p0 + lane; const bool valid = pk <= p; const int pkc = valid ? pk : p; const int rk = tokrow(b, pkc, dir);
                const bf16_t* ksrc = kind == 0 ? P + (size_t)rk * NPW + PC_RK + h * 64 : MQK + (size_t)rk * 512 + 256 + h * 64;
                const bf16_t* vsrc = P + (size_t)rk * NPW + (kind == 0 ? PC_RV : PC_MV) + h * 64;
                float dot = 0.f;
#pragma unroll
                for (int i = 0; i < 8; ++i) { const u32x4 w = *(const u32x4*)(ksrc + 8 * i);
                    dot += bflo(qp[4 * i]) * bflo(w.x) + bfhi(qp[4 * i]) * bfhi(w.x) + bflo(qp[4 * i + 1]) * bflo(w.y) + bfhi(qp[4 * i + 1]) * bfhi(w.y)
                         + bflo(qp[4 * i + 2]) * bflo(w.z) + bfhi(qp[4 * i + 2]) * bfhi(w.z) + bflo(qp[4 * i + 3]) * bflo(w.w) + bfhi(qp[4 * i + 3]) * bfhi(w.w); }
                float wgt;
                if (kind == 0) wgt = __expf(lg * (float)(p - pkc));
                else wgt = __expf(fp - fc[pkc] + GT[(size_t)rk * 16 + 4 * dir + h]);
                const float wd = valid ? wgt * dot : 0.f;
                den += wd;
#pragma unroll
                for (int i = 0; i < 8; ++i) { const u32x4 w = *(const u32x4*)(vsrc + 8 * i);
                    num[8 * i] += wd * bflo(w.x); num[8 * i + 1] += wd * bfhi(w.x); num[8 * i + 2] += wd * bflo(w.y); num[8 * i + 3] += wd * bfhi(w.y);
                    num[8 * i + 4] += wd * bflo(w.z); num[8 * i + 5] += wd * bfhi(w.z); num[8 * i + 6] += wd * bflo(w.w); num[8 * i + 7] += wd * bfhi(w.w); }
            }
#pragma unroll
            for (int e = 0; e < 64; ++e) scr[lane * 65 + e] = num[e];
            den = wave_sum(den);
            asm volatile("s_waitcnt lgkmcnt(0)" ::: "memory");
            float s = 0.f;
#pragma unroll 8
            for (int i = 0; i < 64; ++i) s += scr[i * 65 + lane];
            asm volatile("s_waitcnt lgkmcnt(0)" ::: "memory");
            y += kind == 0 ? s : s / fmaxf(fabsf(den), 1.0f);
        }
        ((float*)(ws + (kind == 0 ? WS_RETY : WS_MLY)))[(size_t)r * 256 + h * 64 + lane] = y;
    }
}

__device__ __forceinline__ void phase_natt(const Args& a, int l, bool need_ctx, LAS unsigned char* lds, int lane, int wave, int bid, int G) {
    unsigned char* ws = a.ws;
    const bf16_t* P = (const bf16_t*)(ws + WS_BIG); bf16_t* NAY = (bf16_t*)(ws + WS_NAY);
    LAS float* prob = (LAS float*)(lds + wave * 16640);
    LAS int* krow = (LAS int*)(lds + wave * 16640 + 1536);
    const int nrows = need_ctx ? MALL : NLAT, nitems = nrows * 8;
    for (int it = bid * NWAVES + wave; it < nitems; it += G * NWAVES) {
        const int h = it & 7, r = it >> 3; const bool lat = r < NLAT;
        const int b = lat ? (r >> 11) : ((r - NLAT) >> 8);
        const bf16_t* qsrc = P + (size_t)r * NPW + PC_NQ + h * 64;
        unsigned qp[32];
#pragma unroll
        for (int i = 0; i < 8; ++i) { const u32x4 w = *(const u32x4*)(qsrc + 8 * i); qp[4 * i] = w.x; qp[4 * i + 1] = w.y; qp[4 * i + 2] = w.z; qp[4 * i + 3] = w.w; }
        int gr = 0, gc = 0, sr = 0, scc = 0;
        if (lat) { const int t = r & (SEQ - 1); gr = t >> 6; gc = t & 63; sr = min(max(gr - 4, 0), NROWS - 8); scc = min(max(gc - 8, 0), GRIDW - 16); }
        const float* rpb = a.in[15] + (size_t)(l * 8 + h) * 15 * 31;
        float s[6]; float mx = -3.0e38f;
#pragma unroll
        for (int jj = 0; jj < 6; ++jj) {
            const bool loc = jj < 2; int rk; float bias = 0.f; bool valid = true;
            if (loc) { const int j = lane + 64 * jj, kk = j >> 4, kc = j & 15, kr_ = sr + kk, kcol = scc + kc; rk = b * SEQ + kr_ * 64 + kcol;
                bias = rpb[(kr_ - gr + 7) * 31 + min(max(kcol - gc + 15, 0), 30)]; valid = lat; if (lat) krow[j] = rk; }
            else rk = NLAT + b * CTXL + lane + 64 * (jj - 2);
            const bf16_t* ksrc = P + (size_t)rk * NPW + PC_NK + h * 64;
            float dot = 0.f;
#pragma unroll
            for (int i = 0; i < 8; ++i) { const u32x4 w = *(const u32x4*)(ksrc + 8 * i);
                dot += bflo(qp[4 * i]) * bflo(w.x) + bfhi(qp[4 * i]) * bfhi(w.x) + bflo(qp[4 * i + 1]) * bflo(w.y) + bfhi(qp[4 * i + 1]) * bfhi(w.y)
                     + bflo(qp[4 * i + 2]) * bflo(w.z) + bfhi(qp[4 * i + 2]) * bfhi(w.z) + bflo(qp[4 * i + 3]) * bflo(w.w) + bfhi(qp[4 * i + 3]) * bfhi(w.w); }
            s[jj] = valid ? dot * 0.125f + bias : -3.0e38f; mx = fmaxf(mx, s[jj]);
        }
        mx = wave_max(mx); float sum = 0.f;
#pragma unroll
        for (int jj = 0; jj < 6; ++jj) { s[jj] = (s[jj] > -1.0e38f) ? __expf(s[jj] - mx) : 0.f; sum += s[jj]; }
        sum = wave_sum(sum); const float inv = 1.0f / sum;
#pragma unroll
        for (int jj = 0; jj < 6; ++jj) prob[lane + 64 * jj] = s[jj] * inv;
        asm volatile("s_waitcnt lgkmcnt(0)" ::: "memory");
        float o = 0.f;
        if (lat) for (int j = 0; j < 128; ++j) o += prob[j] * bf2f(P[(size_t)krow[j] * NPW + PC_NV + h * 64 + lane]);
        for (int j = 0; j < CTXL; ++j) o += prob[128 + j] * bf2f(P[(size_t)(NLAT + b * CTXL + j) * NPW + PC_NV + h * 64 + lane]);
        asm volatile("s_waitcnt lgkmcnt(0)" ::: "memory");
        NAY[(size_t)r * 512 + h * 64 + lane] = (bf16_t)f2bf(o);
    }
}

__device__ __forceinline__ void phase_merge(const Args& a, bool need_ctx, int lane, int wave, int bid, int G) {
    unsigned char* ws = a.ws;
    const bf16_t* P = (const bf16_t*)(ws + WS_BIG); const bf16_t* NAY = (const bf16_t*)(ws + WS_NAY); bf16_t* MG = (bf16_t*)(ws + WS_H);
    const float* RY = (const float*)(ws + WS_RETY); const float* MY = (const float*)(ws + WS_MLY);
    const int nrows = need_ctx ? MALL : NLAT;
    for (int r = bid * NWAVES + wave; r < nrows; r += G * NWAVES) {
#pragma unroll
        for (int h = 0; h < 4; ++h) {
            { const float v = RY[(size_t)r * 256 + h * 64 + lane]; const float rs = rsqrtf(wave_sum(v * v) * (1.0f / 64.0f) + EPS);
              const float g = bf2f(P[(size_t)r * NPW + PC_RG + h * 64 + lane]); MG[(size_t)r * DM + h * 64 + lane] = (bf16_t)f2bf(siluf_(g) * v * rs); }
            { const float v = MY[(size_t)r * 256 + h * 64 + lane]; const float rs = rsqrtf(wave_sum(v * v) * (1.0f / 64.0f) + EPS);
              const float g = bf2f(P[(size_t)r * NPW + PC_MO + h * 64 + lane]); MG[(size_t)r * DM + 256 + h * 64 + lane] = (bf16_t)f2bf(sigmoidf_(g) * v * rs); }
        }
#pragma unroll
        for (int i = 0; i < 8; ++i) MG[(size_t)r * DM + 512 + lane + 64 * i] = NAY[(size_t)r * 512 + lane + 64 * i];
    }
}
#ifndef EN_PRO
#define EN_PRO 1
#endif
#ifndef EN_NORM
#define EN_NORM 1
#endif
#ifndef EN_GIN
#define EN_GIN 1
#endif
#ifndef EN_POST
#define EN_POST 1
#endif
#ifndef EN_FCUM
#define EN_FCUM 1
#endif
#ifndef EN_QUAD
#define EN_QUAD 1
#endif
#ifndef EN_NATT
#define EN_NATT 1
#endif
#ifndef EN_MERGE
#define EN_MERGE 1
#endif
#ifndef EN_GOUT
#define EN_GOUT 1
#endif
#ifndef EN_NORM2
#define EN_NORM2 1
#endif
#ifndef EN_GUP
#define EN_GUP 1
#endif
#ifndef EN_GDN
#define EN_GDN 1
#endif

__global__ void __launch_bounds__(NTHR, 2) fwd_kernel(Args a) {
    extern __shared__ __attribute__((aligned(16))) unsigned char lds_raw[];
    LAS unsigned char* lds = (LAS unsigned char*)lds_raw;
    const int tid0 = threadIdx.x, G = gridDim.x, bid = blockIdx.x;
    unsigned char* ws = a.ws;
    volatile LAS unsigned* MISC = (volatile LAS unsigned*)(lds + MISC_OFF);
    if (tid0 < 32) MISC[tid0] = 0u;
    __syncthreads();
    const int lo = a.ph_lo, hi = a.ph_hi;
    XcdBarrier bar; bar.bar = (unsigned*)(ws + WS_CTL) + CW_BAR; bar.x = 0; bar.st = MISC + 8;
    if (hi - lo > 1) bar = xcd_barrier_post((unsigned*)(ws + WS_CTL) + CW_BAR, MISC + 8);
    int ph = 0;
#define PH_BEGIN if (ph >= lo && ph < hi) { asm volatile("; PHMARK_BEGIN %0" :: "i"(__LINE__)); int tid = tid0; asm volatile("" : "+v"(tid)); const int lane = tid & 63, wave = __builtin_amdgcn_readfirstlane(tid >> 6); (void)lane; (void)wave;
#define PH_END   asm volatile("; PHMARK_END %0" :: "i"(__LINE__)); if (ph + 1 < hi) xcd_barrier(bar); else __syncthreads(); } ++ph;

    PH_BEGIN
#if EN_PRO
 phase_prologue(a, lds, tid, lane, wave, bid, G);
#endif
 PH_END

    for (int l = 0; l < 2; ++l) {
        const bool need_ctx = (l == 0);
        const float* mod = (const float*)(ws + WS_MOD) + (size_t)l * 9 * 6144;
        PH_BEGIN
#if EN_NORM
 phase_norm<0>(a, l, lds, tid, lane, wave, bid, G);
#endif
 PH_END
        PH_BEGIN
#if EN_GIN
 { pg8::Gemm g{(const bf16_t*)(ws + WS_H), (const bf16_t*)(ws + WS_WTIN) + (size_t)l * NPW * DM, MALL, NPW, DM};
                   pg8::StaticOrder S; S.init(MALL, NPW, G, bid); pg8::EpiBf16 E{(bf16_t*)(ws + WS_BIG), NPW};
                   pg8::gemm_phase<pg8::EpiBf16, pg8::StaticOrder, false>(lds, g, S, E, nullptr); }
#endif
 PH_END
        PH_BEGIN
#if EN_POST
 phase_post(a, l, lane, wave, bid, G);
#endif
 PH_END
        PH_BEGIN
#if EN_FCUM
 phase_fcum(a, lane, wave, bid, G);
#endif
 PH_END
        PH_BEGIN
#if EN_QUAD
 phase_quad(a, l, need_ctx, lds, lane, wave, bid, G);
#endif
#if EN_NATT
 phase_natt(a, l, need_ctx, lds, lane, wave, bid, G);
#endif
 PH_END
        PH_BEGIN
#if EN_MERGE
 phase_merge(a, need_ctx, lane, wave, bid, G);
#endif
 PH_END
        PH_BEGIN
#if EN_GOUT
 { const int M = need_ctx ? MALL : NLAT;
                   pg8::Gemm g{(const bf16_t*)(ws + WS_H), (const bf16_t*)(ws + WS_WTOUT) + (size_t)l * DM * DM, M, DM, DM};
                   pg8::StaticOrder S; S.init(M, DM, G, bid);
                   pg8::EpiResid E{l == 0 ? a.in[0] : a.out, l == 0 ? a.in[2] : (const float*)(ws + WS_XC), a.out, (float*)(ws + WS_XC), mod + 2048, nullptr, 0, NLAT / 256};
                   pg8::gemm_phase<pg8::EpiResid, pg8::StaticOrder, false>(lds, g, S, E, nullptr); }
#endif
 PH_END
        if (l == 0) { PH_BEGIN
#if EN_NORM2
 phase_norm<1>(a, l, lds, tid, lane, wave, bid, G);
#endif
 PH_END }
        else        { PH_BEGIN
#if EN_NORM2
 phase_norm<2>(a, l, lds, tid, lane, wave, bid, G);
#endif
 PH_END }
        const int ne = (l == 0) ? 1 : NEXP;
        for (int e = 0; e < ne; ++e) {
            const int M = need_ctx ? MALL : NLAT;
            PH_BEGIN
#if EN_GUP
 { const bf16_t* Bt = (l == 0) ? (const bf16_t*)(ws + WS_WTUP) : (const bf16_t*)(ws + WS_WTMUP) + (size_t)e * NUP * DM;
                       pg8::Gemm g{(const bf16_t*)(ws + WS_H), Bt, M, NUP, DM};
                       pg8::StaticOrder S; S.init(M, NUP, G, bid); pg8::EpiSwiGLU E{(bf16_t*)(ws + WS_BIG), DFF};
                       pg8::gemm_phase<pg8::EpiSwiGLU, pg8::StaticOrder, false>(lds, g, S, E, nullptr); }
#endif
 PH_END
            PH_BEGIN
#if EN_GDN
 { const bf16_t* Bt = (l == 0) ? (const bf16_t*)(ws + WS_WTDN) : (const bf16_t*)(ws + WS_WTMDN) + (size_t)e * DM * DFF;
                       pg8::Gemm g{(const bf16_t*)(ws + WS_BIG), Bt, M, DM, DFF};
                       pg8::StaticOrder S; S.init(M, DM, G, bid);
                       pg8::EpiResid E{a.out, (const float*)(ws + WS_XC), a.out, (float*)(ws + WS_XC), mod + 5120, (l == 0) ? nullptr : (const float*)(ws + WS_COMB) + e, 8, NLAT / 256};
                       pg8::gemm_phase<pg8::EpiResid, pg8::StaticOrder, false>(lds, g, S, E, nullptr); }
#endif
 PH_END
        }
    }
#undef PH_BEGIN
#undef PH_END
}
constexpr int N_PHASES = 1 + 10 + 8 + 16;
#ifndef DBG_MAXPH
#define DBG_MAXPH 1000
#endif

extern "C" void kernel_launch(void* const* d_in, const int* in_sizes, int n_in, void* d_out, int out_size, void* d_ws, size_t ws_size, hipStream_t stream) {
    static int grid = 0;
    if (grid == 0) {
        if (n_in != 24 || out_size != NLAT * DM || ws_size < WS_END) { fprintf(stderr, "kernel_launch: unexpected sizes (n_in %d, out %d, ws %zu < %zu); nothing launched\n", n_in, out_size, ws_size, (size_t)WS_END); grid = -1; return; }
        int dev = 0, cus = 0;
        if (hipGetDevice(&dev) != hipSuccess || hipDeviceGetAttribute(&cus, hipDeviceAttributeMultiprocessorCount, dev) != hipSuccess) { grid = -1; return; }
        if (hipFuncSetAttribute((const void*)fwd_kernel, hipFuncAttributeMaxDynamicSharedMemorySize, LDS_BYTES) != hipSuccess) { fprintf(stderr, "kernel_launch: hipFuncSetAttribute failed\n"); grid = -1; return; }
        int per_cu = 0;
        if (hipOccupancyMaxActiveBlocksPerMultiprocessor(&per_cu, (const void*)fwd_kernel, NTHR, LDS_BYTES) != hipSuccess || per_cu < 1) { fprintf(stderr, "kernel_launch: occupancy query says %d\n", per_cu); }
        (void)hipGetLastError();
        grid = cus;
    }
    if (grid < 0) return;
    (void)hipMemsetAsync((char*)d_ws + WS_CTL, 0, CTL_BYTES, stream);
    Args a{};
    for (int i = 0; i < 24; ++i) a.in[i] = (const float*)d_in[i];
    a.out = (float*)d_out; a.ws = (unsigned char*)d_ws;
#if N_LAUNCH_MODE == 0
    a.ph_lo = 0; a.ph_hi = N_PHASES;
    hipLaunchKernelGGL(fwd_kernel, dim3(grid), dim3(NTHR), LDS_BYTES, stream, a);
#else
    for (int p = 0; p < N_PHASES && p < DBG_MAXPH; ++p) { a.ph_lo = p; a.ph_hi = p + 1; hipLaunchKernelGGL(fwd_kernel, dim3(grid), dim3(NTHR), LDS_BYTES, stream, a); }
#endif
}
```

```cpp
#include <hip/hip_runtime.h>
#include <stdio.h>
#include <stdint.h>

#ifndef N_LAUNCH_MODE
#define N_LAUNCH_MODE 0
#endif

constexpr int NB = 8, SEQ = 2048, DM = 1024, CTXL = 256, HD = 64;
constexpr int NLAT = NB * SEQ, NCTX = NB * CTXL, MALL = NLAT + NCTX;
constexpr int DIN = 3600, NPW = 3584;
constexpr int DFF = 2816, NUP = 2 * DFF, NEXP = 8;
constexpr int GRIDW = 64, NROWS = 32;
constexpr float EPS = 1e-6f;
constexpr int PC_RQ = 0, PC_RK = 256, PC_RV = 512, PC_RG = 768, PC_MQ = 1024, PC_MK = 1280, PC_MV = 1536, PC_MO = 1792, PC_NQ = 2048, PC_NK = 2560, PC_NV = 3072;

constexpr size_t al256(size_t x) { return (x + 255) & ~(size_t)255; }
constexpr size_t WS_CTL = 0, CTL_BYTES = 1u << 20;
constexpr size_t WS_MOD = WS_CTL + CTL_BYTES;
constexpr size_t WS_ROPE = WS_MOD + al256((size_t)2 * 9 * 6144 * 4);
constexpr size_t WS_WTIN = WS_ROPE + al256(64 * 16 * 2 * 4);
constexpr size_t WS_WTOUT = WS_WTIN + (size_t)2 * NPW * DM * 2;
constexpr size_t WS_WTUP = WS_WTOUT + (size_t)2 * DM * DM * 2;
constexpr size_t WS_WTDN = WS_WTUP + (size_t)NUP * DM * 2;
constexpr size_t WS_WTMUP = WS_WTDN + (size_t)DM * DFF * 2;
constexpr size_t WS_WTMDN = WS_WTMUP + (size_t)NEXP * NUP * DM * 2;
constexpr size_t WS_H = WS_WTMDN + (size_t)NEXP * DM * DFF * 2;
constexpr size_t WS_XC = WS_H + (size_t)MALL * DM * 2;
constexpr size_t WS_GATES = WS_XC + (size_t)NCTX * DM * 4;
constexpr size_t WS_COMB = WS_GATES + (size_t)MALL * 16 * 4;
constexpr size_t WS_FCUM = WS_COMB + (size_t)NLAT * 8 * 4;
constexpr size_t WS_BIG = WS_FCUM + al256((size_t)NB * 4 * 2 * 2304 * 4);
constexpr size_t WS_MQK = WS_BIG + (size_t)MALL * NPW * 2;
constexpr size_t WS_RETY = WS_MQK + (size_t)MALL * 512 * 2;
constexpr size_t WS_MLY = WS_RETY + (size_t)MALL * 256 * 4;
constexpr size_t WS_NAY = WS_MLY + (size_t)MALL * 256 * 4;
constexpr size_t WS_END = WS_NAY + (size_t)MALL * 512 * 2;

typedef unsigned short bf16_t;
typedef float f32x4 __attribute__((ext_vector_type(4)));
typedef float f32x2 __attribute__((ext_vector_type(2)));
typedef unsigned u32x4 __attribute__((ext_vector_type(4)));
typedef unsigned u32x2 __attribute__((ext_vector_type(2)));
#define LAS __attribute__((address_space(3)))
#define GAS __attribute__((address_space(1)))

__device__ __forceinline__ float bf2f(bf16_t b) { return __uint_as_float(((unsigned)b) << 16); }
__device__ __forceinline__ unsigned f2bf(float f) { unsigned u = __float_as_uint(f); return (u + 0x7fffu + ((u >> 16) & 1u)) >> 16; }
__device__ __forceinline__ unsigned pk2(float lo, float hi) { return f2bf(lo) | (f2bf(hi) << 16); }
__device__ __forceinline__ float bflo(unsigned w) { return __uint_as_float(w << 16); }
__device__ __forceinline__ float bfhi(unsigned w) { return __uint_as_float(w & 0xffff0000u); }
__device__ __forceinline__ float sigmoidf_(float x) { return 1.0f / (1.0f + __expf(-x)); }
__device__ __forceinline__ float siluf_(float x) { return x / (1.0f + __expf(-x)); }
__device__ __forceinline__ float logsigmoidf_(float x) { return fminf(x, 0.f) - log1pf(__expf(-fabsf(x))); }
__device__ __forceinline__ float wave_sum(float v) {
#pragma unroll
    for (int o = 1; o < 64; o <<= 1) v += __shfl_xor(v, o);
    return v;
}
__device__ __forceinline__ float wave_max(float v) {
#pragma unroll
    for (int o = 1; o < 64; o <<= 1) v = fmaxf(v, __shfl_xor(v, o));
    return v;
}

struct Args {
    const float* in[24];
    float* out;
    unsigned char* ws;
    int ph_lo, ph_hi;
};
namespace pg8 {
#define PG8_LAS __attribute__((address_space(3)))
typedef unsigned short bf16_t;
typedef short bf16x8 __attribute__((ext_vector_type(8)));
typedef float f32x4 __attribute__((ext_vector_type(4)));
typedef unsigned u32x4 __attribute__((ext_vector_type(4)));
constexpr int BM = 256, BK = 64, HALF = 128, HTB = HALF * BK * 2  , STAGE_BYTES = 8 * HTB, NXCD = 8, WGM = 8;

__host__ __device__ __forceinline__ int lds_byte(int r, int c) { const int st = (r >> 4) * 2 + (c >> 5), rr = r & 15, cc = c & 31, ob = rr * 64 + cc * 2; return st * 1024 + (ob ^ (((ob >> 9) & 1) << 5)); }
__host__ __device__ __forceinline__ void stage_rc(int b, int& R, int& C) { const int st = b / 1024, sb = b % 1024, swz = sb ^ (((sb >> 9) & 1) << 5); R = (st >> 1) * 16 + swz / 64; C = (st & 1) * 32 + (swz % 64) / 2; }
__host__ __device__ __forceinline__ int perm32(int rho) { const int n = rho >> 4, i = rho & 15; return 8 * (i >> 2) + 4 * n + (i & 3); }

struct Unit { int pm, pn; };
struct Gemm { const bf16_t* A; const bf16_t* Bt; int M, N, K; };

struct StaticOrder {
    int nM, nN, nwg, G, c;
    __host__ __device__ void init(int M, int N, int G_, int c_) { nM = M / BM; nN = N / BM; nwg = nM * nN; G = G_; c = c_; }
    __host__ __device__ bool next(int i, Unit& u) const {
        const long L = (long)i * G + c; if (L >= nwg) return false;
        int wgid = (int)L; { const int q = nwg / NXCD, r = nwg % NXCD, xcd = wgid % NXCD, off = wgid / NXCD; wgid = (xcd < r ? xcd * (q + 1) : r * (q + 1) + (xcd - r) * q) + off; }
        const int nig = WGM * nN, gid = wgid / nig, fm = gid * WGM, gsz = (nM - fm) < WGM ? (nM - fm) : WGM;
        u.pm = fm + ((wgid % nig) % gsz); u.pn = (wgid % nig) / gsz; return true;
    }
    __device__ __forceinline__ void a_ready(const Unit&) const {}
    __device__ __forceinline__ void done(const Unit&) const {}
};
__device__ __forceinline__ unsigned cvt_pk_bf16(float lo, float hi) { unsigned r; asm volatile("v_cvt_pk_bf16_f32 %0, %1, %2" : "=v"(r) : "v"(lo), "v"(hi)); return r; }
typedef float f32x2 __attribute__((ext_vector_type(2)));
struct EpiBf16 {
    static constexpr bool PERM = true, AFTER_DRAIN = false;
    bf16_t* O; int ldc;
    __device__ __forceinline__ void operator()(const f32x4 (&acc)[2][2][4][2], const Unit& u, int wr, int wc, int fr, int fq) const {
        const int row0 = u.pm * BM + wr * 64 + fr, col0 = u.pn * BM + wc * 32 + 8 * fq;
#pragma unroll
        for (int ai = 0; ai < 2; ++ai)
#pragma unroll
            for (int m = 0; m < 4; ++m) { bf16_t* rowp = O + (size_t)(row0 + ai * HALF + m * 16) * ldc + col0;
#pragma unroll
                for (int bj = 0; bj < 2; ++bj) { const f32x4 v0 = acc[ai][bj][m][0], v1 = acc[ai][bj][m][1];
                    u32x4 w; w.x = cvt_pk_bf16(v0[0], v0[1]); w.y = cvt_pk_bf16(v0[2], v0[3]); w.z = cvt_pk_bf16(v1[0], v1[1]); w.w = cvt_pk_bf16(v1[2], v1[3]);
                    *(u32x4*)(rowp + bj * HALF) = w; } }
    }
};
struct EpiSwiGLU {
    static constexpr bool PERM = true, AFTER_DRAIN = false;
    bf16_t* O; int ldc;
    __device__ __forceinline__ void operator()(const f32x4 (&acc)[2][2][4][2], const Unit& u, int wr, int wc, int fr, int fq) const {
        const int row0 = u.pm * BM + wr * 64 + fr, col0 = u.pn * HALF + wc * 32 + 8 * fq;
#pragma unroll
        for (int ai = 0; ai < 2; ++ai)
#pragma unroll
            for (int m = 0; m < 4; ++m) { bf16_t* rowp = O + (size_t)(row0 + ai * HALF + m * 16) * ldc + col0;
                float r[8];
#pragma unroll
                for (int n = 0; n < 2; ++n)
#pragma unroll
                    for (int j = 0; j < 4; ++j) { const float g = acc[ai][0][m][n][j], uu = acc[ai][1][m][n][j]; r[n * 4 + j] = g / (1.0f + __expf(-g)) * uu; }
                u32x4 w; w.x = cvt_pk_bf16(r[0], r[1]); w.y = cvt_pk_bf16(r[2], r[3]); w.z = cvt_pk_bf16(r[4], r[5]); w.w = cvt_pk_bf16(r[6], r[7]);
                *(u32x4*)rowp = w; }
    }
};
struct EpiResid {
    static constexpr bool PERM = false, AFTER_DRAIN = false;
    const float* base_lat; const float* base_ctx; float* out_lat; float* out_ctx; const float* gate; const float* comb; int comb_ld; int nlat_tiles;
    __device__ __forceinline__ void operator()(const f32x4 (&acc)[2][2][4][2], const Unit& u, int wr, int wc, int fr, int fq) const {
        const bool isctx = u.pm >= nlat_tiles;
        const int rloc0 = (isctx ? (u.pm - nlat_tiles) : u.pm) * BM + wr * 64 + fr, col0 = u.pn * BM + wc * 32 + 4 * fq;
        const float* bp = isctx ? base_ctx : base_lat; float* op = isctx ? out_ctx : out_lat;
        const float* gp = gate + (size_t)(isctx ? 8 : (u.pm >> 3)) * 6144 + col0;
        f32x4 gv[2][2];
#pragma unroll
        for (int bj = 0; bj < 2; ++bj)
#pragma unroll
            for (int n = 0; n < 2; ++n) gv[bj][n] = *(const f32x4*)(gp + bj * HALF + n * 16);
#pragma unroll
        for (int ai = 0; ai < 2; ++ai)
#pragma unroll
            for (int m = 0; m < 4; ++m) { const int rl = rloc0 + ai * HALF + m * 16; const size_t off = (size_t)rl * 1024 + col0;
                const float cs = comb ? comb[(size_t)rl * comb_ld] : 1.0f;
#pragma unroll
                for (int bj = 0; bj < 2; ++bj)
#pragma unroll
                    for (int n = 0; n < 2; ++n) { const f32x4 bs = *(const f32x4*)(bp + off + bj * HALF + n * 16);
                        *(f32x4*)(op + off + bj * HALF + n * 16) = bs + gv[bj][n] * acc[ai][bj][m][n] * cs; } }
    }
};
template <class Epi, class Sched, bool STAMP = false>
__device__ __forceinline__ void gemm_phase(PG8_LAS unsigned char* lds, const Gemm g, const Sched& S, const Epi& E, unsigned long long* stamps) {
    int tid_ = threadIdx.x; asm volatile("" : "+v"(tid_)); const int tid = tid_, wid = __builtin_amdgcn_readfirstlane(tid >> 6), lane = tid & 63, wr = wid >> 2, wc = wid & 3, fr = lane & 15, fq = lane >> 4;
    const int K = g.K, nt = K / BK;
    int ts_lo = 0, ts_hi = 0, nts = 0; const unsigned long long rt_entry = STAMP ? (unsigned long long)wall_clock64() : 0ull;
#define PG8_STAMP() do { if (STAMP && wid == 0 && nts < 64) { const unsigned long long _c = (unsigned long long)clock64(); \
        ts_lo = (lane == nts) ? (int)(unsigned)_c : ts_lo; ts_hi = (lane == nts) ? (int)(unsigned)(_c >> 32) : ts_hi; ++nts; } } while (0)
    PG8_STAMP();
    unsigned voffA[2], voffB[2];
#pragma unroll
    for (int i = 0; i < 2; ++i) { int R, C; stage_rc(tid * 16 + i * 8192, R, C); const int Rb = Epi::PERM ? ((R & ~31) + perm32(R & 31)) : R;
        voffA[i] = (unsigned)(R * K + C) * 2u; voffB[i] = (unsigned)(Rb * K + C) * 2u; }
    const size_t kstep = (size_t)(BK * 2);
    const size_t hstep = (size_t)HALF * K * 2;
    const size_t tstep = 2 * hstep;
    const unsigned ldsw = (unsigned)wid * 1024u;
    const int aoff = lds_byte(wr * 64 + fr, fq * 8), boff = lds_byte(wc * 32 + fr, fq * 8);
#define PG8_SA(b, h) (((b) * 2 + (h)) * HTB)
#define PG8_SB(b, h) ((4 + (b) * 2 + (h)) * HTB)
#define PG8_STAGE(bufoff, gbase, voff) do { _Pragma("unroll") for (int _i = 0; _i < 2; ++_i) \
        __builtin_amdgcn_global_load_lds((const unsigned*)((const char*)(gbase) + (voff)[_i]), (PG8_LAS unsigned*)(lds + (bufoff) + ldsw + _i * 8192), 16, 0, 0); } while (0)
#define PG8_LDA(dst, b, h) do { _Pragma("unroll") for (int m = 0; m < 4; ++m) _Pragma("unroll") for (int k = 0; k < 2; ++k) dst[m][k] = *(const PG8_LAS bf16x8*)(lds + PG8_SA(b, h) + aoff + m * 2048 + k * 1024); } while (0)
#define PG8_LDB(dst, b, h) do { _Pragma("unroll") for (int n = 0; n < 2; ++n) _Pragma("unroll") for (int k = 0; k < 2; ++k) dst[n][k] = *(const PG8_LAS bf16x8*)(lds + PG8_SB(b, h) + boff + n * 2048 + k * 1024); } while (0)
#define PG8_MMA(ai, bj, At, Bt) do { __builtin_amdgcn_s_setprio(1); _Pragma("unroll") for (int m = 0; m < 4; ++m) _Pragma("unroll") for (int n = 0; n < 2; ++n) _Pragma("unroll") for (int k = 0; k < 2; ++k) \
        acc[ai][bj][m][n] = __builtin_amdgcn_mfma_f32_16x16x32_bf16(Bt[n][k], At[m][k], acc[ai][bj][m][n], 0, 0, 0); __builtin_amdgcn_s_setprio(0); } while (0)
#define PG8_WAIT_V(n) asm volatile("s_waitcnt vmcnt(" #n ")" ::: "memory")
#define PG8_WAIT_L(n) asm volatile("s_waitcnt lgkmcnt(" #n ")" ::: "memory")
#define PG8_BAR __builtin_amdgcn_s_barrier()
#define PG8_SCHED __builtin_amdgcn_sched_barrier(0)
    Unit cur, nxt; int ui = 0;
    if (!S.next(0, cur)) return;
    f32x4 acc[2][2][4][2];
#pragma unroll
    for (int a = 0; a < 2; ++a)
#pragma unroll
        for (int b = 0; b < 2; ++b)
#pragma unroll
            for (int m = 0; m < 4; ++m)
#pragma unroll
                for (int n = 0; n < 2; ++n) acc[a][b][m][n] = (f32x4){0.f, 0.f, 0.f, 0.f};
    bf16x8 At[4][2], B0[2][2], B1[2][2];
    const char* cA = (const char*)g.A + (size_t)cur.pm * tstep; const char* cB = (const char*)g.Bt + (size_t)cur.pn * tstep;
    S.a_ready(cur);
    PG8_STAGE(PG8_SB(0, 0), cB, voffB); PG8_STAGE(PG8_SA(0, 0), cA, voffA); PG8_STAGE(PG8_SB(0, 1), cB + hstep, voffB); PG8_STAGE(PG8_SA(0, 1), cA + hstep, voffA);
    if (wr == 1) PG8_BAR;
    PG8_WAIT_V(4); PG8_BAR;
    PG8_STAGE(PG8_SB(1, 0), cB + kstep, voffB); PG8_STAGE(PG8_SA(1, 0), cA + kstep, voffA); PG8_STAGE(PG8_SB(1, 1), cB + hstep + kstep, voffB);
    PG8_WAIT_V(6); PG8_BAR;
    PG8_STAMP();
    for (;;) {
        const bool has_next = S.next(ui + 1, nxt);
        const char* nA = has_next ? (const char*)g.A + (size_t)nxt.pm * tstep : cA; const char* nB = has_next ? (const char*)g.Bt + (size_t)nxt.pn * tstep : cB;
        for (int t = 0; t < nt; t += 2) {
            const bool last = (t == nt - 2);
            const char* a1 = cA + (size_t)(t + 1) * kstep;
            const char* a2 = last ? nA : cA + (size_t)(t + 2) * kstep; const char* b2 = last ? nB : cB + (size_t)(t + 2) * kstep;
            const char* a3 = a2 + kstep; const char* b3 = b2 + kstep;
            if (last && has_next) S.a_ready(nxt);
            PG8_LDB(B0, 0, 0); PG8_SCHED; PG8_LDA(At, 0, 0); PG8_STAGE(PG8_SA(1, 1), a1 + hstep, voffA);
            PG8_WAIT_L(8); PG8_BAR; PG8_WAIT_L(0); PG8_MMA(0, 0, At, B0); PG8_BAR; PG8_SCHED;
            PG8_LDB(B1, 0, 1); PG8_STAGE(PG8_SB(0, 0), b2, voffB);
            PG8_BAR; PG8_WAIT_L(0); PG8_MMA(0, 1, At, B1); PG8_BAR;
            PG8_LDA(At, 0, 1); PG8_STAGE(PG8_SA(0, 0), a2, voffA);
            PG8_BAR; PG8_WAIT_L(0); PG8_MMA(1, 0, At, B0); PG8_BAR; PG8_SCHED;
            PG8_STAGE(PG8_SB(0, 1), b2 + hstep, voffB);
            PG8_WAIT_V(6); PG8_BAR; PG8_MMA(1, 1, At, B1); PG8_BAR;
            PG8_LDB(B0, 1, 0); PG8_SCHED; PG8_LDA(At, 1, 0); PG8_STAGE(PG8_SA(0, 1), a2 + hstep, voffA);
            PG8_WAIT_L(8); PG8_BAR; PG8_WAIT_L(0); PG8_MMA(0, 0, At, B0); PG8_BAR; PG8_SCHED;
            PG8_LDB(B1, 1, 1); PG8_STAGE(PG8_SB(1, 0), b3, voffB);
            PG8_BAR; PG8_WAIT_L(0); PG8_MMA(0, 1, At, B1); PG8_BAR;
            PG8_LDA(At, 1, 1); PG8_STAGE(PG8_SA(1, 0), a3, voffA);
            PG8_BAR; PG8_WAIT_L(0); PG8_MMA(1, 0, At, B0); PG8_BAR; PG8_SCHED;
            PG8_STAGE(PG8_SB(1, 1), b3 + hstep, voffB);
            PG8_WAIT_V(6); PG8_BAR; PG8_MMA(1, 1, At, B1); PG8_BAR;
        }
        PG8_STAMP();
        if constexpr (!Epi::AFTER_DRAIN) { E(acc, cur, wr, wc, fr, fq); S.done(cur); }
        PG8_STAMP();
        if (!has_next) break;
#pragma unroll
        for (int a = 0; a < 2; ++a)
#pragma unroll
            for (int b = 0; b < 2; ++b)
#pragma unroll
                for (int m = 0; m < 4; ++m)
#pragma unroll
                    for (int n = 0; n < 2; ++n) acc[a][b][m][n] = (f32x4){0.f, 0.f, 0.f, 0.f};
        cur = nxt; cA = nA; cB = nB; ++ui;
    }
    PG8_WAIT_V(0);
    if (wr == 0) PG8_BAR;
    PG8_BAR;
    if constexpr (Epi::AFTER_DRAIN) { E.fused(acc, cur, wr, wc, fr, fq, lds, wid, lane); S.done(cur); }
    PG8_STAMP();
    if (STAMP && wid == 0) { stamps[lane] = lane < nts ? (((unsigned long long)(unsigned)ts_hi << 32) | (unsigned)ts_lo) : 0ull;
        if (lane == 62) stamps[62] = rt_entry; if (lane == 63) stamps[63] = (unsigned long long)wall_clock64(); }
#undef PG8_STAMP
#undef PG8_SA
#undef PG8_SB
#undef PG8_STAGE
#undef PG8_LDA
#undef PG8_LDB
#undef PG8_MMA
#undef PG8_WAIT_V
#undef PG8_WAIT_L
#undef PG8_BAR
#undef PG8_SCHED
}
}
#define XB_TMO      128
#define XB_XCNT(j)  (256  + 64 * (j))
#define XB_XSUB(j)  (1280 + 64 * (j))
#define XB_XGEN(j)  (2304 + 64 * (j))
#define XB_TOP      3328
#define XB_TOPGEN   3392
#define XCD_BAR_WORDS 3456
#define XB_SPIN_CAP (1u << 24)

__device__ __forceinline__ unsigned xb_ld(unsigned* p)              { return __hip_atomic_load(p, __ATOMIC_RELAXED, __HIP_MEMORY_SCOPE_AGENT); }
__device__ __forceinline__ unsigned xb_add(unsigned* p, unsigned v) { return __hip_atomic_fetch_add(p, v, __ATOMIC_RELAXED, __HIP_MEMORY_SCOPE_AGENT); }
__device__ __forceinline__ unsigned xb_xcc_id() { return (unsigned)__builtin_amdgcn_s_getreg((3 << 11) | 20) & 0xFu; }
#define XB_SPIN(cond, bar) do { unsigned _sp = 0; while (cond) { __builtin_amdgcn_s_sleep(1); \
    if ((++_sp & 255u) == 0u) { if (xb_ld(&(bar)[XB_TMO])) break; if (_sp > XB_SPIN_CAP) { atomicAdd(&(bar)[XB_TMO], 1u); break; } } } } while (0)

struct XcdBarrier {
    unsigned* bar; unsigned x;
    volatile LAS unsigned* st;
};

__device__ __forceinline__ XcdBarrier xcd_barrier_post(unsigned* bar, volatile LAS unsigned* st) {
    XcdBarrier b; b.bar = bar; b.x = xb_xcc_id(); b.st = st;
    if (threadIdx.x == 0) (void)xb_add(&bar[XB_XCNT(b.x)], 1u);
    return b;
}
__device__ __forceinline__ void xcd_barrier_complete(unsigned* bar, unsigned x, unsigned& nloc, unsigned& nx) {
    const unsigned G = gridDim.x * gridDim.y * gridDim.z;
    unsigned sum, cnt, mine, sp = 0u;
    for (;;) {
        sum = 0u; cnt = 0u; mine = 0u;
#pragma unroll
        for (unsigned j = 0; j < 16; ++j) { const unsigned c = xb_ld(&bar[XB_XCNT(j)]); sum += c; cnt += (c > 0u) ? 1u : 0u; mine = (j == x) ? c : mine; }
        if (sum == G) break;
        __builtin_amdgcn_s_sleep(1);
        if ((++sp & 255u) == 0u) { if (xb_ld(&bar[XB_TMO])) break; if (sp > XB_SPIN_CAP) { atomicAdd(&bar[XB_TMO], 1u); break; } }
    }
    nloc = mine > 0u ? mine : 1u; nx = cnt > 0u ? cnt : 1u;
}

__device__ __forceinline__ void xcd_barrier(const XcdBarrier& b) {
    asm volatile("s_waitcnt vmcnt(0)" ::: "memory");
    __syncthreads();
    if (threadIdx.x == 0) {
        unsigned* bar = b.bar;
        __builtin_amdgcn_s_waitcnt(0);
        unsigned nloc = b.st[0], nx = b.st[1];
        if (nloc == 0u) { xcd_barrier_complete(bar, b.x, nloc, nx); b.st[0] = nloc; b.st[1] = nx; }
        const unsigned old = xb_add(&bar[XB_XSUB(b.x)], 1u);
        const unsigned gen = old / nloc;
        if (old + 1u == (gen + 1u) * nloc) {
            __builtin_amdgcn_fence(__ATOMIC_RELEASE, "agent");
            asm volatile("s_waitcnt vmcnt(0)" ::: "memory");
            const unsigned og = xb_add(&bar[XB_TOP], 1u);
            const unsigned tg = og / nx;
            if (og + 1u == (tg + 1u) * nx) xb_add(&bar[XB_TOPGEN], 1u);
            else XB_SPIN(xb_ld(&bar[XB_TOPGEN]) == tg, bar);
            __builtin_amdgcn_fence(__ATOMIC_ACQUIRE, "agent");
            xb_add(&bar[XB_XGEN(b.x)], 1u);
            asm volatile("s_waitcnt vmcnt(0)" ::: "memory");
        } else {
            XB_SPIN(xb_ld(&bar[XB_XGEN(b.x)]) == gen, bar);
            __builtin_amdgcn_fence(__ATOMIC_ACQUIRE, "agent");
            asm volatile("s_waitcnt vmcnt(0)" ::: "memory");
        }
    }
    __syncthreads();
}

constexpr int SCR_BYTES = 139264;
constexpr int MISC_OFF = SCR_BYTES;
constexpr int LDS_BYTES = 147456;
constexpr int CW_BAR = 4096;
constexpr int NTHR = 512, NWAVES = 8;

__device__ __forceinline__ void transpose_item(const float* W, int ldw, int col0, int K, bf16_t* WT, int drow0, int kb, LAS float* scr, int lane) {
    const int k0 = 64 * kb;
#pragma unroll 8
    for (int i = 0; i < 32; ++i) { const int kk = 2 * i + (lane >> 5); scr[kk * 33 + (lane & 31)] = W[(size_t)(k0 + kk) * ldw + col0 + (lane & 31)]; }
    asm volatile("s_waitcnt lgkmcnt(0)" ::: "memory");
    const int c = lane & 7;
#pragma unroll
    for (int j = 0; j < 4; ++j) { const int n = (lane >> 3) + 8 * j; const LAS float* s = scr + (8 * c) * 33 + n;
        u32x4 o; o.x = pk2(s[0 * 33], s[1 * 33]); o.y = pk2(s[2 * 33], s[3 * 33]); o.z = pk2(s[4 * 33], s[5 * 33]); o.w = pk2(s[6 * 33], s[7 * 33]);
        *(u32x4*)(WT + (size_t)(drow0 + n) * K + k0 + 8 * c) = o; }
    asm volatile("s_waitcnt lgkmcnt(0)" ::: "memory");
}
__device__ __forceinline__ void up_item(const float* wg, const float* wu, bf16_t* WT, int it, LAS float* scr, int lane) {
    const int nb = it >> 4, kb = it & 15, r0 = 32 * nb, pn = r0 >> 8, p = r0 & 255;
    transpose_item(p < 128 ? wg : wu, DFF, 128 * pn + (p & 127), DM, WT, r0, kb, scr, lane);
}
__device__ __forceinline__ void dn_item(const float* wd, bf16_t* WT, int it, LAS float* scr, int lane) {
    const int nb = it / 44, kb = it % 44;
    transpose_item(wd, DM, 32 * nb, DFF, WT, 32 * nb, kb, scr, lane);
}
constexpr int IT_IN = 112 * 16, IT_OUT = 32 * 16, IT_UP = 176 * 16, IT_DN = 32 * 44;
constexpr int IT_TOTAL = 2 * IT_IN + 2 * IT_OUT + IT_UP + IT_DN + NEXP * (IT_UP + IT_DN);

__device__ __forceinline__ void phase_prologue(const Args& a, LAS unsigned char* lds, int tid, int lane, int wave, int bid, int G) {
    unsigned char* ws = a.ws;
    {
        LAS float* scr = (LAS float*)(lds + wave * 8704);
        const int gw = bid * NWAVES + wave, NGW = G * NWAVES;
        for (int it0 = gw; it0 < IT_TOTAL; it0 += NGW) {
            int it = it0;
            if (it < 2 * IT_IN) { const int l = it / IT_IN; it -= l * IT_IN; const int nb = it >> 4, kb = it & 15, r0 = 32 * nb;
                transpose_item(a.in[8] + (size_t)l * DM * DIN, DIN, r0 < 2048 ? r0 : r0 + 16, DM, (bf16_t*)(ws + WS_WTIN) + (size_t)l * NPW * DM, r0, kb, scr, lane); continue; }
            it -= 2 * IT_IN;
            if (it < 2 * IT_OUT) { const int l = it / IT_OUT; it -= l * IT_OUT; const int nb = it >> 4, kb = it & 15;
                transpose_item(a.in[16] + (size_t)l * DM * DM, DM, 32 * nb, DM, (bf16_t*)(ws + WS_WTOUT) + (size_t)l * DM * DM, 32 * nb, kb, scr, lane); continue; }
            it -= 2 * IT_OUT;
            if (it < IT_UP) { up_item(a.in[17], a.in[18], (bf16_t*)(ws + WS_WTUP), it, scr, lane); continue; }
            it -= IT_UP;
            if (it < IT_DN) { dn_item(a.in[19], (bf16_t*)(ws + WS_WTDN), it, scr, lane); continue; }
            it -= IT_DN;
            if (it < NEXP * IT_UP) { const int e = it / IT_UP; it -= e * IT_UP;
                up_item(a.in[21] + (size_t)e * DM * DFF, a.in[22] + (size_t)e * DM * DFF, (bf16_t*)(ws + WS_WTMUP) + (size_t)e * NUP * DM, it, scr, lane); continue; }
            it -= NEXP * IT_UP;
            { const int e = it / IT_DN; it -= e * IT_DN; dn_item(a.in[23] + (size_t)e * DFF * DM, (bf16_t*)(ws + WS_WTMDN) + (size_t)e * DM * DFF, it, scr, lane); }
        }
    }
    __syncthreads();
    {
        const int gt = bid * NTHR + tid;
        if (gt < 1024) { const int pos = gt >> 4, i = gt & 15;
            double inv = 1.0; for (int q = 0; q < i; ++q) inv *= 0.56234132519034908;
            const float angf = (float)pos * (float)inv; const double ang = (double)angf;
            const double kq = rint(ang * 0.63661977236758134); const double r = ang - kq * 1.5707963267948966 - kq * 6.123233995736766e-17; const double r2 = r * r;
            double sn = r * (1.0 + r2 * (-1.0 / 6 + r2 * (1.0 / 120 + r2 * (-1.0 / 5040 + r2 * (1.0 / 362880 + r2 * (-1.0 / 39916800 + r2 * (1.0 / 6227020800.0)))))));
            double cs = 1.0 + r2 * (-0.5 + r2 * (1.0 / 24 + r2 * (-1.0 / 720 + r2 * (1.0 / 40320 + r2 * (-1.0 / 3628800 + r2 * (1.0 / 479001600.0 + r2 * (-1.0 / 87178291200.0)))))));
            const int kk = ((int)kq) & 3; double c2, s2;
            if (kk == 0) { c2 = cs; s2 = sn; } else if (kk == 1) { c2 = -sn; s2 = cs; } else if (kk == 2) { c2 = -cs; s2 = -sn; } else { c2 = sn; s2 = -cs; }
            float* R = (float*)(ws + WS_ROPE); R[gt * 2] = (float)c2; R[gt * 2 + 1] = (float)s2; }
    }
    {
        LAS float* sc = (LAS float*)(lds + 73728);
        LAS float* red = (LAS float*)(lds + 73728 + 36864);
        for (int i = tid; i < 9 * 1024; i += NTHR) { const float v = i < 8192 ? a.in[1][i] : a.in[3][i - 8192]; sc[i] = v / (1.0f + __expf(-v)); }
        __syncthreads();
        for (int item = bid; item < 192; item += G) {
            const int l = item / 96, n0 = (item % 96) * 64;
            const float* wm = a.in[6] + (size_t)l * DM * 6144 + n0 + lane;
            float acc[9];
#pragma unroll
            for (int b = 0; b < 9; ++b) acc[b] = 0.f;
#pragma unroll 4
            for (int kk = 0; kk < 128; ++kk) { const int k = wave * 128 + kk; const float w = wm[(size_t)k * 6144];
#pragma unroll
                for (int b = 0; b < 9; ++b) acc[b] += sc[b * 1024 + k] * w; }
#pragma unroll
            for (int b = 0; b < 9; ++b) red[(wave * 9 + b) * 64 + lane] = acc[b];
            __syncthreads();
            for (int o = tid; o < 576; o += NTHR) { const int b = o >> 6, ln = o & 63; float s = a.in[7][(size_t)l * 6144 + n0 + ln];
#pragma unroll
                for (int w = 0; w < 8; ++w) s += red[(w * 9 + b) * 64 + ln];
                ((float*)(ws + WS_MOD))[((size_t)l * 9 + b) * 6144 + n0 + ln] = s; }
            __syncthreads();
        }
    }
}

template <int MODE>
__device__ __forceinline__ void phase_norm(const Args& a, int l, LAS unsigned char* lds, int tid, int lane, int wave, int bid, int G) {
    unsigned char* ws = a.ws;
    LAS float* WT = (LAS float*)lds;
    if (MODE == 0) { const float* w = a.in[8] + (size_t)l * DM * DIN + 2048; for (int i = tid; i < 16384; i += NTHR) { const int k = i >> 4, j = i & 15; WT[j * 1024 + k] = w[(size_t)k * DIN + j]; } __syncthreads(); }
    if (MODE == 2) { const float* w = a.in[20]; for (int i = tid; i < 8192; i += NTHR) { const int k = i >> 3, j = i & 7; WT[j * 1024 + k] = w[(size_t)k * 8 + j]; } __syncthreads(); }
    const float* gam = (MODE == 0 ? a.in[4] : a.in[5]) + (size_t)l * DM;
    const float* mod = (const float*)(ws + WS_MOD) + (size_t)l * 9 * 6144;
    const int shoff = MODE == 0 ? 0 : 3072, soff = MODE == 0 ? 1024 : 4096;
    const int nrows = (MODE == 2) ? NLAT : MALL;
    bf16_t* H = (bf16_t*)(ws + WS_H);
    for (int r = bid * NWAVES + wave; r < nrows; r += G * NWAVES) {
        const bool lat = r < NLAT; const int bi = lat ? (r >> 11) : 8;
        const float* src = (MODE == 0 && l == 0) ? (lat ? a.in[0] + (size_t)r * DM : a.in[2] + (size_t)(r - NLAT) * DM)
                                    : (lat ? a.out + (size_t)r * DM : (const float*)(ws + WS_XC) + (size_t)(r - NLAT) * DM);
        f32x4 v[4]; float ss = 0.f;
#pragma unroll
        for (int j = 0; j < 4; ++j) { v[j] = *(const f32x4*)(src + 4 * lane + 256 * j); ss += (v[j].x * v[j].x + v[j].y * v[j].y) + (v[j].z * v[j].z + v[j].w * v[j].w); }
        const float rstd = rsqrtf(wave_sum(ss) * (1.0f / DM) + EPS);
        const float* mrow = mod + (size_t)bi * 6144;
#pragma unroll
        for (int j = 0; j < 4; ++j) { const int k = 4 * lane + 256 * j;
            const f32x4 g = *(const f32x4*)(gam + k), s = *(const f32x4*)(mrow + soff + k), sh = *(const f32x4*)(mrow + shoff + k);
            v[j] = v[j] * rstd * g * (1.0f + s) + sh;
            u32x2 w; w.x = pk2(v[j].x, v[j].y); w.y = pk2(v[j].z, v[j].w);
            *(u32x2*)(H + (size_t)r * DM + k) = w; }
        if (MODE == 0) {
            float mine = 0.f;
#pragma nounroll
            for (int jg = 0; jg < 16; ++jg) { float s = 0.f;
#pragma unroll
                for (int j = 0; j < 4; ++j) { const f32x4 w = *(const LAS f32x4*)(WT + jg * 1024 + 4 * lane + 256 * j); s += (v[j].x * w.x + v[j].y * w.y) + (v[j].z * w.z + v[j].w * w.w); }
                s = wave_sum(s); mine = (lane == jg) ? s : mine; }
            if (lane < 16) ((float*)(ws + WS_GATES))[(size_t)r * 16 + lane] = mine + a.in[12][l * 16 + lane];
        }
        if (MODE == 2) {
            int i1 = 0, i2 = 0; float v1 = -3.0e38f, v2 = -3.0e38f;
#pragma nounroll
            for (int e = 0; e < 8; ++e) { float s = 0.f;
#pragma unroll
                for (int j = 0; j < 4; ++j) { const f32x4 w = *(const LAS f32x4*)(WT + e * 1024 + 4 * lane + 256 * j); s += (v[j].x * w.x + v[j].y * w.y) + (v[j].z * w.z + v[j].w * w.w); }
                s = wave_sum(s);
                if (s > v1) { v2 = v1; i2 = i1; v1 = s; i1 = e; } else if (s > v2) { v2 = s; i2 = e; } }
            const float w2 = 1.0f / (1.0f + __expf(v1 - v2)), w1 = 1.0f - w2;
            if (lane < 8) ((float*)(ws + WS_COMB))[(size_t)r * 8 + lane] = (lane == i1) ? w1 : ((lane == i2) ? w2 : 0.f);
        }
    }
}

__device__ __forceinline__ void phase_post(const Args& a, int l, int lane, int wave, int bid, int G) {
    unsigned char* ws = a.ws;
    bf16_t* P = (bf16_t*)(ws + WS_BIG); bf16_t* MQK = (bf16_t*)(ws + WS_MQK);
    const float* ROPE = (const float*)(ws + WS_ROPE);
    const float* cw = a.in[10] + (size_t)l * 3 * 512; const float* cb = a.in[11] + (size_t)l * 512;
    const float qg = a.in[13][l * 64 + lane], kg = a.in[14][l * 64 + lane];
    for (int r = bid * NWAVES + wave; r < MALL; r += G * NWAVES) {
        const bool lat = r < NLAT; bf16_t* row = P + (size_t)r * NPW;
        int t, tlen; if (lat) { t = r & (SEQ - 1); tlen = SEQ; } else { t = (r - NLAT) & (CTXL - 1); tlen = CTXL; }
        if (lat) { const int gr = t >> 6, gc = t & 63;
#pragma unroll
            for (int blk = 0; blk < 2; ++blk)
#pragma unroll
                for (int ii = 0; ii < 2; ++ii) { const int pid = lane + 64 * ii, head = pid >> 5, half = (pid >> 4) & 1, i = pid & 15, c1 = (blk ? PC_RK : PC_RQ) + head * 64 + half * 32 + i;
                    const int pos = half ? gc : gr; const float cs = ROPE[(pos * 16 + i) * 2], sn = ROPE[(pos * 16 + i) * 2 + 1];
                    const float x1 = bf2f(row[c1]), x2 = bf2f(row[c1 + 16]); const float sc = blk ? 0.125f : 1.0f;
                    row[c1] = (bf16_t)f2bf((x1 * cs - x2 * sn) * sc); row[c1 + 16] = (bf16_t)f2bf((x1 * sn + x2 * cs) * sc); }
        } else {
#pragma unroll
            for (int ii = 0; ii < 4; ++ii) { const int c = PC_RK + lane + 64 * ii; row[c] = (bf16_t)f2bf(bf2f(row[c]) * 0.125f); }
        }
#pragma unroll
        for (int ii = 0; ii < 8; ++ii) { const int c = lane + 64 * ii;
            const float x0 = bf2f(row[PC_MQ + c]);
            const float xm = t > 0 ? bf2f(row[PC_MQ + c - NPW]) : 0.f, xp = t < tlen - 1 ? bf2f(row[PC_MQ + c + NPW]) : 0.f;
            float y = cb[c] + cw[c] * xm + cw[512 + c] * x0 + cw[1024 + c] * xp;
            y = y / (1.0f + __expf(-y)); if (c >= 256) y *= 0.125f;
            MQK[(size_t)r * 512 + c] = (bf16_t)f2bf(y); }
#pragma unroll
        for (int hh = 0; hh < 16; ++hh) { const int c = PC_NQ + hh * 64 + lane; const float v = bf2f(row[c]);
            const float rs = rsqrtf(wave_sum(v * v) * (1.0f / 64.0f) + EPS);
            row[c] = (bf16_t)f2bf(v * rs * (hh < 8 ? qg : kg)); }
    }
}

__device__ __forceinline__ int tokrow(int b, int p, int dir) {
    if (dir == 0) return p < CTXL ? NLAT + b * CTXL + p : b * SEQ + (p - CTXL);
    return p < CTXL ? NLAT + b * CTXL + (CTXL - 1 - p) : b * SEQ + (SEQ - 1 - (p - CTXL));
}
__device__ __forceinline__ void phase_fcum(const Args& a, int lane, int wave, int bid, int G) {
    unsigned char* ws = a.ws; const float* GT = (const float*)(ws + WS_GATES); float* F = (float*)(ws + WS_FCUM);
    for (int it = bid * NWAVES + wave; it < NB * 4 * 2; it += G * NWAVES) {
        const int dir = it & 1, h = (it >> 1) & 3, b = it >> 3; float carry = 0.f;
        for (int p0 = 0; p0 < CTXL + SEQ; p0 += 64) { const int p = p0 + lane; const int row = tokrow(b, p, dir);
            float v = logsigmoidf_(GT[(size_t)row * 16 + 8 + 4 * dir + h]);
#pragma unroll
            for (int o = 1; o < 64; o <<= 1) { const float u = __shfl_up(v, o); if (lane >= o) v += u; }
            F[(size_t)((b * 4 + h) * 2 + dir) * 2304 + p] = carry + v;
            carry += __shfl(v, 63); }
    }
}

__device__ __forceinline__ void phase_quad(const Args& a, int l, bool need_ctx, LAS unsigned char* lds, int lane, int wave, int bid, int G) {
    unsigned char* ws = a.ws;
    const bf16_t* P = (const bf16_t*)(ws + WS_BIG); const bf16_t* MQK = (const bf16_t*)(ws + WS_MQK);
    const float* GT = (const float*)(ws + WS_GATES); const float* FC = (const float*)(ws + WS_FCUM);
    LAS float* scr = (LAS float*)(lds + wave * 16640);
    const int nrows = need_ctx ? MALL : NLAT, nitems = nrows * 8;
    for (int it = bid * NWAVES + wave; it < nitems; it += G * NWAVES) {
        const int kind = it & 1, h = (it >> 1) & 3, r = it >> 3;
        const bool lat = r < NLAT; const int b = lat ? (r >> 11) : ((r - NLAT) >> 8), tt = lat ? (r & (SEQ - 1)) : ((r - NLAT) & (CTXL - 1));
        const bf16_t* qsrc = kind == 0 ? P + (size_t)r * NPW + PC_RQ + h * 64 : MQK + (size_t)r * 512 + h * 64;
        unsigned qp[32];
#pragma unroll
        for (int i = 0; i < 8; ++i) { const u32x4 w = *(const u32x4*)(qsrc + 8 * i); qp[4 * i] = w.x; qp[4 * i + 1] = w.y; qp[4 * i + 2] = w.z; qp[4 * i + 3] = w.w; }
        float y = 0.f;
        for (int dir = 0; dir < 2; ++dir) {
            const int p = lat ? (dir == 0 ? CTXL + tt : CTXL + (SEQ - 1 - tt)) : (dir == 0 ? tt : CTXL - 1 - tt);
            const float lg = logsigmoidf_(a.in[9][(l * 2 + dir) * 4 + h]);
            const float* fc = FC + (size_t)((b * 4 + h) * 2 + dir) * 2304; const float fp = fc[p];
            float num[64]; float den = 0.f;
#pragma unroll
            for (int e = 0; e < 64; ++e) num[e] = 0.f;
            for (int p0 = 0; p0 <= p; p0 += 64) {
                const int pk = p0 + lane; const bool valid = pk <= p; const int pkc = valid ? pk : p; const int rk = tokrow(b, pkc, dir);
                const bf16_t* ksrc = kind == 0 ? P + (size_t)rk * NPW + PC_RK + h * 64 : MQK + (size_t)rk * 512 + 256 + h * 64;
                const bf16_t* vsrc = P + (size_t)rk * NPW + (kind == 0 ? PC_RV : PC_MV) + h * 64;
                float dot = 0.f;
#pragma unroll
                for (int i = 0; i < 8; ++i) { const u32x4 w = *(const u32x4*)(ksrc + 8 * i);
                    dot += bflo(qp[4 * i]) * bflo(w.x) + bfhi(qp[4 * i]) * bfhi(w.x) + bflo(qp[4 * i + 1]) * bflo(w.y) + bfhi(qp[4 * i + 1]) * bfhi(w.y)
                         + bflo(qp[4 * i + 2]) * bflo(w.z) + bfhi(qp[4 * i + 2]) * bfhi(w.z) + bflo(qp[4 * i + 3]) * bflo(w.w) + bfhi(qp[4 * i + 3]) * bfhi(w.w); }
                float wgt;
                if (kind == 0) wgt = __expf(lg * (float)(p - pkc));
                else wgt = __expf(fp - fc[pkc] + GT[(size_t)rk * 16 + 4 * dir + h]);
                const float wd = valid ? wgt * dot : 0.f;
                den += wd;
#pragma unroll
                for (int i = 0; i < 8; ++i) { const u32x4 w = *(const u32x4*)(vsrc + 8 * i);
                    num[8 * i] += wd * bflo(w.x); num[8 * i + 1] += wd * bfhi(w.x); num[8 * i + 2] += wd * bflo(w.y); num[8 * i + 3] += wd * bfhi(w.y);
                    num[8 * i + 4] += wd * bflo(w.z); num[8 * i + 5] += wd * bfhi(w.z); num[8 * i + 6] += wd * bflo(w.w); num[8 * i + 7] += wd * bfhi(w.w); }
            }
#pragma unroll
            for (int e = 0; e < 64; ++e) scr[lane * 65 + e] = num[e];
            den = wave_sum(den);
            asm volatile("s_waitcnt lgkmcnt(0)" ::: "memory");
            float s = 0.f;
#pragma unroll 8
            for (int i = 0; i < 64; ++i) s += scr[i * 65 + lane];
            asm volatile("s_waitcnt lgkmcnt(0)" ::: "memory");
            y += kind == 0 ? s : s / fmaxf(fabsf(den), 1.0f);
        }
        ((float*)(ws + (kind == 0 ? WS_RETY : WS_MLY)))[(size_t)r * 256 + h * 64 + lane] = y;
    }
}

__device__ __forceinline__ void phase_natt(const Args& a, int l, bool need_ctx, LAS unsigned char* lds, int lane, int wave, int bid, int G) {
    unsigned char* ws = a.ws;
    const bf16_t* P = (const bf16_t*)(ws + WS_BIG); bf16_t* NAY = (bf16_t*)(ws + WS_NAY);
    LAS float* prob = (LAS float*)(lds + wave * 16640);
    LAS int* krow = (LAS int*)(lds + wave * 16640 + 1536);
    const int nrows = need_ctx ? MALL : NLAT, nitems = nrows * 8;
    for (int it = bid * NWAVES + wave; it < nitems; it += G * NWAVES) {
        const int h = it & 7, r = it >> 3; const bool lat = r < NLAT;
        const int b = lat ? (r >> 11) : ((r - NLAT) >> 8);
        const bf16_t* qsrc = P + (size_t)r * NPW + PC_NQ + h * 64;
        unsigned qp[32];
#pragma unroll
        for (int i = 0; i < 8; ++i) { const u32x4 w = *(const u32x4*)(qsrc + 8 * i); qp[4 * i] = w.x; qp[4 * i + 1] = w.y; qp[4 * i + 2] = w.z; qp[4 * i + 3] = w.w; }
        int gr = 0, gc = 0, sr = 0, scc = 0;
        if (lat) { const int t = r & (SEQ - 1); gr = t >> 6; gc = t & 63; sr = min(max(gr - 4, 0), NROWS - 8); scc = min(max(gc - 8, 0), GRIDW - 16); }
        const float* rpb = a.in[15] + (size_t)(l * 8 + h) * 15 * 31;
        float s[6]; float mx = -3.0e38f;
#pragma unroll
        for (int jj = 0; jj < 6; ++jj) {
            const bool loc = jj < 2; int rk; float bias = 0.f; bool valid = true;
            if (loc) { const int j = lane + 64 * jj, kk = j >> 4, kc = j & 15, kr_ = sr + kk, kcol = scc + kc; rk = b * SEQ + kr_ * 64 + kcol;
                bias = rpb[(kr_ - gr + 7) * 31 + min(max(kcol - gc + 15, 0), 30)]; valid = lat; if (lat) krow[j] = rk; }
            else rk = NLAT + b * CTXL + lane + 64 * (jj - 2);
            const bf16_t* ksrc = P + (size_t)rk * NPW + PC_NK + h * 64;
            float dot = 0.f;
#pragma unroll
            for (int i = 0; i < 8; ++i) { const u32x4 w = *(const u32x4*)(ksrc + 8 * i);
                dot += bflo(qp[4 * i]) * bflo(w.x) + bfhi(qp[4 * i]) * bfhi(w.x) + bflo(qp[4 * i + 1]) * bflo(w.y) + bfhi(qp[4 * i + 1]) * bfhi(w.y)
                     + bflo(qp[4 * i + 2]) * bflo(w.z) + bfhi(qp[4 * i + 2]) * bfhi(w.z) + bflo(qp[4 * i + 3]) * bflo(w.w) + bfhi(qp[4 * i + 3]) * bfhi(w.w); }
            s[jj] = valid ? dot * 0.125f + bias : -3.0e38f; mx = fmaxf(mx, s[jj]);
        }
        mx = wave_max(mx); float sum = 0.f;
#pragma unroll
        for (int jj = 0; jj < 6; ++jj) { s[jj] = (s[jj] > -1.0e38f) ? __expf(s[jj] - mx) : 0.f; sum += s[jj]; }
        sum = wave_sum(sum); const float inv = 1.0f / sum;
#pragma unroll
        for (int jj = 0; jj < 6; ++jj) prob[lane + 64 * jj] = s[jj] * inv;
        asm volatile("s_waitcnt lgkmcnt(0)" ::: "memory");
        float o = 0.f;
        if (lat) for (int j = 0; j < 128; ++j) o += prob[j] * bf2f(P[(size_t)krow[j] * NPW + PC_NV + h * 64 + lane]);
        for (int j = 0; j < CTXL; ++j) o += prob[128 + j] * bf2f(P[(size_t)(NLAT + b * CTXL + j) * NPW + PC_NV + h * 64 + lane]);
        asm volatile("s_waitcnt lgkmcnt(0)" ::: "memory");
        NAY[(size_t)r * 512 + h * 64 + lane] = (bf16_t)f2bf(o);
    }
}

__device__ __forceinline__ void phase_merge(const Args& a, bool need_ctx, int lane, int wave, int bid, int G) {
    unsigned char* ws = a.ws;
    const bf16_t* P = (const bf16_t*)(ws + WS_BIG); const bf16_t* NAY = (const bf16_t*)(ws + WS_NAY); bf16_t* MG = (bf16_t*)(ws + WS_H);
    const float* RY = (const float*)(ws + WS_RETY); const float* MY = (const float*)(ws + WS_MLY);
    const int nrows = need_ctx ? MALL : NLAT;
    for (int r = bid * NWAVES + wave; r < nrows; r += G * NWAVES) {
#pragma unroll
        for (int h = 0; h < 4; ++h) {
            { const float v = RY[(size_t)r * 256 + h * 64 + lane]; const float rs = rsqrtf(wave_sum(v * v) * (1.0f / 64.0f) + EPS);
              const float g = bf2f(P[(size_t)r * NPW + PC_RG + h * 64 + lane]); MG[(size_t)r * DM + h * 64 + lane] = (bf16_t)f2bf(siluf_(g) * v * rs); }
            { const float v = MY[(size_t)r * 256 + h * 64 + lane]; const float rs = rsqrtf(wave_sum(v * v) * (1.0f / 64.0f) + EPS);
              const float g = bf2f(P[(size_t)r * NPW + PC_MO + h * 64 + lane]); MG[(size_t)r * DM + 256 + h * 64 + lane] = (bf16_t)f2bf(sigmoidf_(g) * v * rs); }
        }
#pragma unroll
        for (int i = 0; i < 8; ++i) MG[(size_t)r * DM + 512 + lane + 64 * i] = NAY[(size_t)r * 512 + lane + 64 * i];
    }
}
#ifndef EN_PRO
#define EN_PRO 1
#endif
#ifndef EN_NORM
#define EN_NORM 1
#endif
#ifndef EN_GIN
#define EN_GIN 1
#endif
#ifndef EN_POST
#define EN_POST 1
#endif
#ifndef EN_FCUM
#define EN_FCUM 1
#endif
#ifndef EN_QUAD
#define EN_QUAD 1
#endif
#ifndef EN_NATT
#define EN_NATT 1
#endif
#ifndef EN_MERGE
#define EN_MERGE 1
#endif
#ifndef EN_GOUT
#define EN_GOUT 1
#endif
#ifndef EN_NORM2
#define EN_NORM2 1
#endif
#ifndef EN_GUP
#define EN_GUP 1
#endif
#ifndef EN_GDN
#define EN_GDN 1
#endif

__global__ void __launch_bounds__(NTHR, 2) fwd_kernel(Args a) {
    extern __shared__ __attribute__((aligned(16))) unsigned char lds_raw[];
    LAS unsigned char* lds = (LAS unsigned char*)lds_raw;
    const int tid0 = threadIdx.x, G = gridDim.x, bid = blockIdx.x;
    unsigned char* ws = a.ws;
    volatile LAS unsigned* MISC = (volatile LAS unsigned*)(lds + MISC_OFF);
    if (tid0 < 32) MISC[tid0] = 0u;
    __syncthreads();
    const int lo = a.ph_lo, hi = a.ph_hi;
    XcdBarrier bar; bar.bar = (unsigned*)(ws + WS_CTL) + CW_BAR; bar.x = 0; bar.st = MISC + 8;
    if (hi - lo > 1) bar = xcd_barrier_post((unsigned*)(ws + WS_CTL) + CW_BAR, MISC + 8);
    int ph = 0;
#define PH_BEGIN if (ph >= lo && ph < hi) { asm volatile("; PHMARK_BEGIN %0" :: "i"(__LINE__)); int tid = tid0; asm volatile("" : "+v"(tid)); const int lane = tid & 63, wave = __builtin_amdgcn_readfirstlane(tid >> 6); (void)lane; (void)wave;
#define PH_END   asm volatile("; PHMARK_END %0" :: "i"(__LINE__)); if (ph + 1 < hi) xcd_barrier(bar); else __syncthreads(); } ++ph;

    PH_BEGIN
#if EN_PRO
 phase_prologue(a, lds, tid, lane, wave, bid, G);
#endif
 PH_END

    for (int l = 0; l < 2; ++l) {
        const bool need_ctx = (l == 0);
        const float* mod = (const float*)(ws + WS_MOD) + (size_t)l * 9 * 6144;
        PH_BEGIN
#if EN_NORM
 phase_norm<0>(a, l, lds, tid, lane, wave, bid, G);
#endif
 PH_END
        PH_BEGIN
#if EN_GIN
 { pg8::Gemm g{(const bf16_t*)(ws + WS_H), (const bf16_t*)(ws + WS_WTIN) + (size_t)l * NPW * DM, MALL, NPW, DM};
                   pg8::StaticOrder S; S.init(MALL, NPW, G, bid); pg8::EpiBf16 E{(bf16_t*)(ws + WS_BIG), NPW};
                   pg8::gemm_phase<pg8::EpiBf16, pg8::StaticOrder, false>(lds, g, S, E, nullptr); }
#endif
 PH_END
        PH_BEGIN
#if EN_POST
 phase_post(a, l, lane, wave, bid, G);
#endif
 PH_END
        PH_BEGIN
#if EN_FCUM
 phase_fcum(a, lane, wave, bid, G);
#endif
 PH_END
        PH_BEGIN
#if EN_QUAD
 phase_quad(a, l, need_ctx, lds, lane, wave, bid, G);
#endif
#if EN_NATT
 phase_natt(a, l, need_ctx, lds, lane, wave, bid, G);
#endif
 PH_END
        PH_BEGIN
#if EN_MERGE
 phase_merge(a, need_ctx, lane, wave, bid, G);
#endif
 PH_END
        PH_BEGIN
#if EN_GOUT
 { const int M = need_ctx ? MALL : NLAT;
                   pg8::Gemm g{(const bf16_t*)(ws + WS_H), (const bf16_t*)(ws + WS_WTOUT) + (size_t)l * DM * DM, M, DM, DM};
                   pg8::StaticOrder S; S.init(M, DM, G, bid);
                   pg8::EpiResid E{l == 0 ? a.in[0] : a.out, l == 0 ? a.in[2] : (const float*)(ws + WS_XC), a.out, (float*)(ws + WS_XC), mod + 2048, nullptr, 0, NLAT / 256};
                   pg8::gemm_phase<pg8::EpiResid, pg8::StaticOrder, false>(lds, g, S, E, nullptr); }
#endif
 PH_END
        if (l == 0) { PH_BEGIN
#if EN_NORM2
 phase_norm<1>(a, l, lds, tid, lane, wave, bid, G);
#endif
 PH_END }
        else        { PH_BEGIN
#if EN_NORM2
 phase_norm<2>(a, l, lds, tid, lane, wave, bid, G);
#endif
 PH_END }
        const int ne = (l == 0) ? 1 : NEXP;
        for (int e = 0; e < ne; ++e) {
            const int M = need_ctx ? MALL : NLAT;
            PH_BEGIN
#if EN_GUP
 { const bf16_t* Bt = (l == 0) ? (const bf16_t*)(ws + WS_WTUP) : (const bf16_t*)(ws + WS_WTMUP) + (size_t)e * NUP * DM;
                       pg8::Gemm g{(const bf16_t*)(ws + WS_H), Bt, M, NUP, DM};
                       pg8::StaticOrder S; S.init(M, NUP, G, bid); pg8::EpiSwiGLU E{(bf16_t*)(ws + WS_BIG), DFF};
                       pg8::gemm_phase<pg8::EpiSwiGLU, pg8::StaticOrder, false>(lds, g, S, E, nullptr); }
#endif
 PH_END
            PH_BEGIN
#if EN_GDN
 { const bf16_t* Bt = (l == 0) ? (const bf16_t*)(ws + WS_WTDN) : (const bf16_t*)(ws + WS_WTMDN) + (size_t)e * DM * DFF;
                       pg8::Gemm g{(const bf16_t*)(ws + WS_BIG), Bt, M, DM, DFF};
                       pg8::StaticOrder S; S.init(M, DM, G, bid);
                       pg8::EpiResid E{a.out, (const float*)(ws + WS_XC), a.out, (float*)(ws + WS_XC), mod + 5120, (l == 0) ? nullptr : (const float*)(ws + WS_COMB) + e, 8, NLAT / 256};
                       pg8::gemm_phase<pg8::EpiResid, pg8::StaticOrder, false>(lds, g, S, E, nullptr); }
#endif
 PH_END
        }
    }
#undef PH_BEGIN
#undef PH_END
}
constexpr int N_PHASES = 1 + 10 + 8 + 16;
#ifndef DBG_MAXPH
#define DBG_MAXPH 1000
#endif

extern "C" void kernel_launch(void* const* d_in, const int* in_sizes, int n_in, void* d_out, int out_size, void* d_ws, size_t ws_size, hipStream_t stream) {
    static int grid = 0;
    if (grid == 0) {
        if (n_in != 24 || out_size != NLAT * DM || ws_size < WS_END) { fprintf(stderr, "kernel_launch: unexpected sizes (n_in %d, out %d, ws %zu < %zu); nothing launched\n", n_in, out_size, ws_size, (size_t)WS_END); grid = -1; return; }
        int dev = 0, cus = 0;
        if (hipGetDevice(&dev) != hipSuccess || hipDeviceGetAttribute(&cus, hipDeviceAttributeMultiprocessorCount, dev) != hipSuccess) { grid = -1; return; }
        if (hipFuncSetAttribute((const void*)fwd_kernel, hipFuncAttributeMaxDynamicSharedMemorySize, LDS_BYTES) != hipSuccess) { fprintf(stderr, "kernel_launch: hipFuncSetAttribute failed\n"); grid = -1; return; }
        int per_cu = 0;
        if (hipOccupancyMaxActiveBlocksPerMultiprocessor(&per_cu, (const void*)fwd_kernel, NTHR, LDS_BYTES) != hipSuccess || per_cu < 1) { fprintf(stderr, "kernel_launch: occupancy query says %d\n", per_cu); }
        (void)hipGetLastError();
        grid = cus;
    }
    if (grid < 0) return;
    (void)hipMemsetAsync((char*)d_ws + WS_CTL, 0, CTL_BYTES, stream);
    Args a{};
    for (int i = 0; i < 24; ++i) a.in[i] = (const float*)d_in[i];
    a.out = (float*)d_out; a.ws = (unsigned char*)d_ws;
#if N_LAUNCH_MODE == 0
    a.ph_lo = 0; a.ph_hi = N_PHASES;
    hipLaunchKernelGGL(fwd_kernel, dim3(grid), dim3(NTHR), LDS_BYTES, stream, a);
#else
    for (int p = 0; p < N_PHASES && p < DBG_MAXPH; ++p) { a.ph_lo = p; a.ph_hi = p + 1; hipLaunchKernelGGL(fwd_kernel, dim3(grid), dim3(NTHR), LDS_BYTES, stream, a); }
#endif
}
```

```cpp
#include <hip/hip_runtime.h>
#include <stdio.h>
#include <stdint.h>

#ifndef N_LAUNCH_MODE
#define N_LAUNCH_MODE 0
#endif

constexpr int NB = 8, SEQ = 2048, DM = 1024, CTXL = 256, HD = 64;
constexpr int NLAT = NB * SEQ, NCTX = NB * CTXL, MALL = NLAT + NCTX;
constexpr int DIN = 3600, NPW = 3584;
constexpr int DFF = 2816, NUP = 2 * DFF, NEXP = 8;
constexpr int GRIDW = 64, NROWS = 32;
constexpr float EPS = 1e-6f;
constexpr int PC_RQ = 0, PC_RK = 256, PC_RV = 512, PC_RG = 768, PC_MQ = 1024, PC_MK = 1280, PC_MV = 1536, PC_MO = 1792, PC_NQ = 2048, PC_NK = 2560, PC_NV = 3072;

constexpr size_t al256(size_t x) { return (x + 255) & ~(size_t)255; }
constexpr size_t WS_CTL = 0, CTL_BYTES = 1u << 20;
constexpr size_t WS_MOD = WS_CTL + CTL_BYTES;
constexpr size_t WS_ROPE = WS_MOD + al256((size_t)2 * 9 * 6144 * 4);
constexpr size_t WS_WTIN = WS_ROPE + al256(64 * 16 * 2 * 4);
constexpr size_t WS_WTOUT = WS_WTIN + (size_t)2 * NPW * DM * 2;
constexpr size_t WS_WTUP = WS_WTOUT + (size_t)2 * DM * DM * 2;
constexpr size_t WS_WTDN = WS_WTUP + (size_t)NUP * DM * 2;
constexpr size_t WS_WTMUP = WS_WTDN + (size_t)DM * DFF * 2;
constexpr size_t WS_WTMDN = WS_WTMUP + (size_t)NEXP * NUP * DM * 2;
constexpr size_t WS_H = WS_WTMDN + (size_t)NEXP * DM * DFF * 2;
constexpr size_t WS_XC = WS_H + (size_t)MALL * DM * 2;
constexpr size_t WS_GATES = WS_XC + (size_t)NCTX * DM * 4;
constexpr size_t WS_COMB = WS_GATES + (size_t)MALL * 16 * 4;
constexpr size_t WS_FCUM = WS_COMB + (size_t)NLAT * 8 * 4;
constexpr size_t WS_BIG = WS_FCUM + al256((size_t)NB * 4 * 2 * 2304 * 4);
constexpr size_t WS_MQK = WS_BIG + (size_t)MALL * NPW * 2;
constexpr size_t WS_RETY = WS_MQK + (size_t)MALL * 512 * 2;
constexpr size_t WS_MLY = WS_RETY + (size_t)MALL * 256 * 4;
constexpr size_t WS_NAY = WS_MLY + (size_t)MALL * 256 * 4;
constexpr size_t WS_U = WS_NAY + (size_t)MALL * 512 * 2;
constexpr size_t WS_USC = WS_U + (size_t)2 * NB * 4 * 2 * 18 * 80 * 64 * 2;
constexpr size_t WS_END = WS_USC + al256((size_t)NB * 4 * 2 * 18 * 2 * 4);

typedef unsigned short bf16_t;
typedef float f32x4 __attribute__((ext_vector_type(4)));
typedef float f32x2 __attribute__((ext_vector_type(2)));
typedef unsigned u32x4 __attribute__((ext_vector_type(4)));
typedef unsigned u32x2 __attribute__((ext_vector_type(2)));
#define LAS __attribute__((address_space(3)))
#define GAS __attribute__((address_space(1)))

__device__ __forceinline__ float bf2f(bf16_t b) { return __uint_as_float(((unsigned)b) << 16); }
__device__ __forceinline__ unsigned f2bf(float f) { unsigned u = __float_as_uint(f); return (u + 0x7fffu + ((u >> 16) & 1u)) >> 16; }
__device__ __forceinline__ unsigned pk2(float lo, float hi) { return f2bf(lo) | (f2bf(hi) << 16); }
__device__ __forceinline__ float bflo(unsigned w) { return __uint_as_float(w << 16); }
__device__ __forceinline__ float bfhi(unsigned w) { return __uint_as_float(w & 0xffff0000u); }
__device__ __forceinline__ float sigmoidf_(float x) { return 1.0f / (1.0f + __expf(-x)); }
__device__ __forceinline__ float siluf_(float x) { return x / (1.0f + __expf(-x)); }
__device__ __forceinline__ float logsigmoidf_(float x) { return fminf(x, 0.f) - log1pf(__expf(-fabsf(x))); }
__device__ __forceinline__ float wave_sum(float v) {
#pragma unroll
    for (int o = 1; o < 64; o <<= 1) v += __shfl_xor(v, o);
    return v;
}
__device__ __forceinline__ float wave_max(float v) {
#pragma unroll
    for (int o = 1; o < 64; o <<= 1) v = fmaxf(v, __shfl_xor(v, o));
    return v;
}

struct Args {
    const float* in[24];
    float* out;
    unsigned char* ws;
    int ph_lo, ph_hi;
};
namespace pg8 {
#define PG8_LAS __attribute__((address_space(3)))
typedef unsigned short bf16_t;
typedef short bf16x8 __attribute__((ext_vector_type(8)));
typedef float f32x4 __attribute__((ext_vector_type(4)));
typedef unsigned u32x4 __attribute__((ext_vector_type(4)));
constexpr int BM = 256, BK = 64, HALF = 128, HTB = HALF * BK * 2  , STAGE_BYTES = 8 * HTB, NXCD = 8, WGM = 8;

__host__ __device__ __forceinline__ int lds_byte(int r, int c) { const int st = (r >> 4) * 2 + (c >> 5), rr = r & 15, cc = c & 31, ob = rr * 64 + cc * 2; return st * 1024 + (ob ^ (((ob >> 9) & 1) << 5)); }
__host__ __device__ __forceinline__ void stage_rc(int b, int& R, int& C) { const int st = b / 1024, sb = b % 1024, swz = sb ^ (((sb >> 9) & 1) << 5); R = (st >> 1) * 16 + swz / 64; C = (st & 1) * 32 + (swz % 64) / 2; }
__host__ __device__ __forceinline__ int perm32(int rho) { const int n = rho >> 4, i = rho & 15; return 8 * (i >> 2) + 4 * n + (i & 3); }

struct Unit { int pm, pn; };
struct Gemm { const bf16_t* A; const bf16_t* Bt; int M, N, K; };

struct StaticOrder {
    int nM, nN, nwg, G, c;
    __host__ __device__ void init(int M, int N, int G_, int c_) { nM = M / BM; nN = N / BM; nwg = nM * nN; G = G_; c = c_; }
    __host__ __device__ bool next(int i, Unit& u) const {
        const long L = (long)i * G + c; if (L >= nwg) return false;
        int wgid = (int)L; { const int q = nwg / NXCD, r = nwg % NXCD, xcd = wgid % NXCD, off = wgid / NXCD; wgid = (xcd < r ? xcd * (q + 1) : r * (q + 1) + (xcd - r) * q) + off; }
        const int nig = WGM * nN, gid = wgid / nig, fm = gid * WGM, gsz = (nM - fm) < WGM ? (nM - fm) : WGM;
        u.pm = fm + ((wgid % nig) % gsz); u.pn = (wgid % nig) / gsz; return true;
    }
    __device__ __forceinline__ void a_ready(const Unit&) const {}
    __device__ __forceinline__ void done(const Unit&) const {}
};
__device__ __forceinline__ unsigned cvt_pk_bf16(float lo, float hi) { unsigned r; asm volatile("v_cvt_pk_bf16_f32 %0, %1, %2" : "=v"(r) : "v"(lo), "v"(hi)); return r; }
typedef float f32x2 __attribute__((ext_vector_type(2)));
struct EpiBf16 {
    static constexpr bool PERM = true, AFTER_DRAIN = false;
    bf16_t* O; int ldc;
    __device__ __forceinline__ void operator()(const f32x4 (&acc)[2][2][4][2], const Unit& u, int wr, int wc, int fr, int fq) const {
        const int row0 = u.pm * BM + wr * 64 + fr, col0 = u.pn * BM + wc * 32 + 8 * fq;
#pragma unroll
        for (int ai = 0; ai < 2; ++ai)
#pragma unroll
            for (int m = 0; m < 4; ++m) { bf16_t* rowp = O + (size_t)(row0 + ai * HALF + m * 16) * ldc + col0;
#pragma unroll
                for (int bj = 0; bj < 2; ++bj) { const f32x4 v0 = acc[ai][bj][m][0], v1 = acc[ai][bj][m][1];
                    u32x4 w; w.x = cvt_pk_bf16(v0[0], v0[1]); w.y = cvt_pk_bf16(v0[2], v0[3]); w.z = cvt_pk_bf16(v1[0], v1[1]); w.w = cvt_pk_bf16(v1[2], v1[3]);
                    *(u32x4*)(rowp + bj * HALF) = w; } }
    }
};
struct EpiSwiGLU {
    static constexpr bool PERM = true, AFTER_DRAIN = false;
    bf16_t* O; int ldc;
    __device__ __forceinline__ void operator()(const f32x4 (&acc)[2][2][4][2], const Unit& u, int wr, int wc, int fr, int fq) const {
        const int row0 = u.pm * BM + wr * 64 + fr, col0 = u.pn * HALF + wc * 32 + 8 * fq;
#pragma unroll
        for (int ai = 0; ai < 2; ++ai)
#pragma unroll
            for (int m = 0; m < 4; ++m) { bf16_t* rowp = O + (size_t)(row0 + ai * HALF + m * 16) * ldc + col0;
                float r[8];
#pragma unroll
                for (int n = 0; n < 2; ++n)
#pragma unroll
                    for (int j = 0; j < 4; ++j) { const float g = acc[ai][0][m][n][j], uu = acc[ai][1][m][n][j]; r[n * 4 + j] = g / (1.0f + __expf(-g)) * uu; }
                u32x4 w; w.x = cvt_pk_bf16(r[0], r[1]); w.y = cvt_pk_bf16(r[2], r[3]); w.z = cvt_pk_bf16(r[4], r[5]); w.w = cvt_pk_bf16(r[6], r[7]);
                *(u32x4*)rowp = w; }
    }
};
struct EpiResid {
    static constexpr bool PERM = false, AFTER_DRAIN = false;
    const float* base_lat; const float* base_ctx; float* out_lat; float* out_ctx; const float* gate; const float* comb; int comb_ld; int nlat_tiles;
    __device__ __forceinline__ void operator()(const f32x4 (&acc)[2][2][4][2], const Unit& u, int wr, int wc, int fr, int fq) const {
        const bool isctx = u.pm >= nlat_tiles;
        const int rloc0 = (isctx ? (u.pm - nlat_tiles) : u.pm) * BM + wr * 64 + fr, col0 = u.pn * BM + wc * 32 + 4 * fq;
        const float* bp = isctx ? base_ctx : base_lat; float* op = isctx ? out_ctx : out_lat;
        const float* gp = gate + (size_t)(isctx ? 8 : (u.pm >> 3)) * 6144 + col0;
        f32x4 gv[2][2];
#pragma unroll
        for (int bj = 0; bj < 2; ++bj)
#pragma unroll
            for (int n = 0; n < 2; ++n) gv[bj][n] = *(const f32x4*)(gp + bj * HALF + n * 16);
#pragma unroll
        for (int ai = 0; ai < 2; ++ai)
#pragma unroll
            for (int m = 0; m < 4; ++m) { const int rl = rloc0 + ai * HALF + m * 16; const size_t off = (size_t)rl * 1024 + col0;
                const float cs = comb ? comb[(size_t)rl * comb_ld] : 1.0f;
#pragma unroll
                for (int bj = 0; bj < 2; ++bj)
#pragma unroll
                    for (int n = 0; n < 2; ++n) { const f32x4 bs = *(const f32x4*)(bp + off + bj * HALF + n * 16);
                        *(f32x4*)(op + off + bj * HALF + n * 16) = bs + gv[bj][n] * acc[ai][bj][m][n] * cs; } }
    }
};
template <class Epi, class Sched, bool STAMP = false>
__device__ __forceinline__ void gemm_phase(PG8_LAS unsigned char* lds, const Gemm g, const Sched& S, const Epi& E, unsigned long long* stamps) {
    int tid_ = threadIdx.x; asm volatile("" : "+v"(tid_)); const int tid = tid_, wid = __builtin_amdgcn_readfirstlane(tid >> 6), lane = tid & 63, wr = wid >> 2, wc = wid & 3, fr = lane & 15, fq = lane >> 4;
    const int K = g.K, nt = K / BK;
    int ts_lo = 0, ts_hi = 0, nts = 0; const unsigned long long rt_entry = STAMP ? (unsigned long long)wall_clock64() : 0ull;
#define PG8_STAMP() do { if (STAMP && wid == 0 && nts < 64) { const unsigned long long _c = (unsigned long long)clock64(); \
        ts_lo = (lane == nts) ? (int)(unsigned)_c : ts_lo; ts_hi = (lane == nts) ? (int)(unsigned)(_c >> 32) : ts_hi; ++nts; } } while (0)
    PG8_STAMP();
    unsigned voffA[2], voffB[2];
#pragma unroll
    for (int i = 0; i < 2; ++i) { int R, C; stage_rc(tid * 16 + i * 8192, R, C); const int Rb = Epi::PERM ? ((R & ~31) + perm32(R & 31)) : R;
        voffA[i] = (unsigned)(R * K + C) * 2u; voffB[i] = (unsigned)(Rb * K + C) * 2u; }
    const size_t kstep = (size_t)(BK * 2);
    const size_t hstep = (size_t)HALF * K * 2;
    const size_t tstep = 2 * hstep;
    const unsigned ldsw = (unsigned)wid * 1024u;
    const int aoff = lds_byte(wr * 64 + fr, fq * 8), boff = lds_byte(wc * 32 + fr, fq * 8);
#define PG8_SA(b, h) (((b) * 2 + (h)) * HTB)
#define PG8_SB(b, h) ((4 + (b) * 2 + (h)) * HTB)
#define PG8_STAGE(bufoff, gbase, voff) do { _Pragma("unroll") for (int _i = 0; _i < 2; ++_i) \
        __builtin_amdgcn_global_load_lds((const unsigned*)((const char*)(gbase) + (voff)[_i]), (PG8_LAS unsigned*)(lds + (bufoff) + ldsw + _i * 8192), 16, 0, 0); } while (0)
#define PG8_LDA(dst, b, h) do { _Pragma("unroll") for (int m = 0; m < 4; ++m) _Pragma("unroll") for (int k = 0; k < 2; ++k) dst[m][k] = *(const PG8_LAS bf16x8*)(lds + PG8_SA(b, h) + aoff + m * 2048 + k * 1024); } while (0)
#define PG8_LDB(dst, b, h) do { _Pragma("unroll") for (int n = 0; n < 2; ++n) _Pragma("unroll") for (int k = 0; k < 2; ++k) dst[n][k] = *(const PG8_LAS bf16x8*)(lds + PG8_SB(b, h) + boff + n * 2048 + k * 1024); } while (0)
#define PG8_MMA(ai, bj, At, Bt) do { __builtin_amdgcn_s_setprio(1); _Pragma("unroll") for (int m = 0; m < 4; ++m) _Pragma("unroll") for (int n = 0; n < 2; ++n) _Pragma("unroll") for (int k = 0; k < 2; ++k) \
        acc[ai][bj][m][n] = __builtin_amdgcn_mfma_f32_16x16x32_bf16(Bt[n][k], At[m][k], acc[ai][bj][m][n], 0, 0, 0); __builtin_amdgcn_s_setprio(0); } while (0)
#define PG8_WAIT_V(n) asm volatile("s_waitcnt vmcnt(" #n ")" ::: "memory")
#define PG8_WAIT_L(n) asm volatile("s_waitcnt lgkmcnt(" #n ")" ::: "memory")
#define PG8_BAR __builtin_amdgcn_s_barrier()
#define PG8_SCHED __builtin_amdgcn_sched_barrier(0)
    Unit cur, nxt; int ui = 0;
    if (!S.next(0, cur)) return;
    f32x4 acc[2][2][4][2];
#pragma unroll
    for (int a = 0; a < 2; ++a)
#pragma unroll
        for (int b = 0; b < 2; ++b)
#pragma unroll
            for (int m = 0; m < 4; ++m)
#pragma unroll
                for (int n = 0; n < 2; ++n) acc[a][b][m][n] = (f32x4){0.f, 0.f, 0.f, 0.f};
    bf16x8 At[4][2], B0[2][2], B1[2][2];
    const char* cA = (const char*)g.A + (size_t)cur.pm * tstep; const char* cB = (const char*)g.Bt + (size_t)cur.pn * tstep;
    S.a_ready(cur);
    PG8_STAGE(PG8_SB(0, 0), cB, voffB); PG8_STAGE(PG8_SA(0, 0), cA, voffA); PG8_STAGE(PG8_SB(0, 1), cB + hstep, voffB); PG8_STAGE(PG8_SA(0, 1), cA + hstep, voffA);
    if (wr == 1) PG8_BAR;
    PG8_WAIT_V(4); PG8_BAR;
    PG8_STAGE(PG8_SB(1, 0), cB + kstep, voffB); PG8_STAGE(PG8_SA(1, 0), cA + kstep, voffA); PG8_STAGE(PG8_SB(1, 1), cB + hstep + kstep, voffB);
    PG8_WAIT_V(6); PG8_BAR;
    PG8_STAMP();
    for (;;) {
        const bool has_next = S.next(ui + 1, nxt);
        const char* nA = has_next ? (const char*)g.A + (size_t)nxt.pm * tstep : cA; const char* nB = has_next ? (const char*)g.Bt + (size_t)nxt.pn * tstep : cB;
        for (int t = 0; t < nt; t += 2) {
            const bool last = (t == nt - 2);
            const char* a1 = cA + (size_t)(t + 1) * kstep;
            const char* a2 = last ? nA : cA + (size_t)(t + 2) * kstep; const char* b2 = last ? nB : cB + (size_t)(t + 2) * kstep;
            const char* a3 = a2 + kstep; const char* b3 = b2 + kstep;
            if (last && has_next) S.a_ready(nxt);
            PG8_LDB(B0, 0, 0); PG8_SCHED; PG8_LDA(At, 0, 0); PG8_STAGE(PG8_SA(1, 1), a1 + hstep, voffA);
            PG8_WAIT_L(8); PG8_BAR; PG8_WAIT_L(0); PG8_MMA(0, 0, At, B0); PG8_BAR; PG8_SCHED;
            PG8_LDB(B1, 0, 1); PG8_STAGE(PG8_SB(0, 0), b2, voffB);
            PG8_BAR; PG8_WAIT_L(0); PG8_MMA(0, 1, At, B1); PG8_BAR;
            PG8_LDA(At, 0, 1); PG8_STAGE(PG8_SA(0, 0), a2, voffA);
            PG8_BAR; PG8_WAIT_L(0); PG8_MMA(1, 0, At, B0); PG8_BAR; PG8_SCHED;
            PG8_STAGE(PG8_SB(0, 1), b2 + hstep, voffB);
            PG8_WAIT_V(6); PG8_BAR; PG8_MMA(1, 1, At, B1); PG8_BAR;
            PG8_LDB(B0, 1, 0); PG8_SCHED; PG8_LDA(At, 1, 0); PG8_STAGE(PG8_SA(0, 1), a2 + hstep, voffA);
            PG8_WAIT_L(8); PG8_BAR; PG8_WAIT_L(0); PG8_MMA(0, 0, At, B0); PG8_BAR; PG8_SCHED;
            PG8_LDB(B1, 1, 1); PG8_STAGE(PG8_SB(1, 0), b3, voffB);
            PG8_BAR; PG8_WAIT_L(0); PG8_MMA(0, 1, At, B1); PG8_BAR;
            PG8_LDA(At, 1, 1); PG8_STAGE(PG8_SA(1, 0), a3, voffA);
            PG8_BAR; PG8_WAIT_L(0); PG8_MMA(1, 0, At, B0); PG8_BAR; PG8_SCHED;
            PG8_STAGE(PG8_SB(1, 1), b3 + hstep, voffB);
            PG8_WAIT_V(6); PG8_BAR; PG8_MMA(1, 1, At, B1); PG8_BAR;
        }
        PG8_STAMP();
        if constexpr (!Epi::AFTER_DRAIN) { E(acc, cur, wr, wc, fr, fq); S.done(cur); }
        PG8_STAMP();
        if (!has_next) break;
#pragma unroll
        for (int a = 0; a < 2; ++a)
#pragma unroll
            for (int b = 0; b < 2; ++b)
#pragma unroll
                for (int m = 0; m < 4; ++m)
#pragma unroll
                    for (int n = 0; n < 2; ++n) acc[a][b][m][n] = (f32x4){0.f, 0.f, 0.f, 0.f};
        cur = nxt; cA = nA; cB = nB; ++ui;
    }
    PG8_WAIT_V(0);
    if (wr == 0) PG8_BAR;
    PG8_BAR;
    if constexpr (Epi::AFTER_DRAIN) { E.fused(acc, cur, wr, wc, fr, fq, lds, wid, lane); S.done(cur); }
    PG8_STAMP();
    if (STAMP && wid == 0) { stamps[lane] = lane < nts ? (((unsigned long long)(unsigned)ts_hi << 32) | (unsigned)ts_lo) : 0ull;
        if (lane == 62) stamps[62] = rt_entry; if (lane == 63) stamps[63] = (unsigned long long)wall_clock64(); }
#undef PG8_STAMP
#undef PG8_SA
#undef PG8_SB
#undef PG8_STAGE
#undef PG8_LDA
#undef PG8_LDB
#undef PG8_MMA
#undef PG8_WAIT_V
#undef PG8_WAIT_L
#undef PG8_BAR
#undef PG8_SCHED
}
}
#define XB_TMO      128
#define XB_XCNT(j)  (256  + 64 * (j))
#define XB_XSUB(j)  (1280 + 64 * (j))
#define XB_XGEN(j)  (2304 + 64 * (j))
#define XB_TOP      3328
#define XB_TOPGEN   3392
#define XCD_BAR_WORDS 3456
#define XB_SPIN_CAP (1u << 24)

__device__ __forceinline__ unsigned xb_ld(unsigned* p)              { return __hip_atomic_load(p, __ATOMIC_RELAXED, __HIP_MEMORY_SCOPE_AGENT); }
__device__ __forceinline__ unsigned xb_add(unsigned* p, unsigned v) { return __hip_atomic_fetch_add(p, v, __ATOMIC_RELAXED, __HIP_MEMORY_SCOPE_AGENT); }
__device__ __forceinline__ unsigned xb_xcc_id() { return (unsigned)__builtin_amdgcn_s_getreg((3 << 11) | 20) & 0xFu; }
#define XB_SPIN(cond, bar) do { unsigned _sp = 0; while (cond) { __builtin_amdgcn_s_sleep(1); \
    if ((++_sp & 255u) == 0u) { if (xb_ld(&(bar)[XB_TMO])) break; if (_sp > XB_SPIN_CAP) { atomicAdd(&(bar)[XB_TMO], 1u); break; } } } } while (0)

struct XcdBarrier {
    unsigned* bar; unsigned x;
    volatile LAS unsigned* st;
};

__device__ __forceinline__ XcdBarrier xcd_barrier_post(unsigned* bar, volatile LAS unsigned* st) {
    XcdBarrier b; b.bar = bar; b.x = xb_xcc_id(); b.st = st;
    if (threadIdx.x == 0) (void)xb_add(&bar[XB_XCNT(b.x)], 1u);
    return b;
}
__device__ __forceinline__ void xcd_barrier_complete(unsigned* bar, unsigned x, unsigned& nloc, unsigned& nx) {
    const unsigned G = gridDim.x * gridDim.y * gridDim.z;
    unsigned sum, cnt, mine, sp = 0u;
    for (;;) {
        sum = 0u; cnt = 0u; mine = 0u;
#pragma unroll
        for (unsigned j = 0; j < 16; ++j) { const unsigned c = xb_ld(&bar[XB_XCNT(j)]); sum += c; cnt += (c > 0u) ? 1u : 0u; mine = (j == x) ? c : mine; }
        if (sum == G) break;
        __builtin_amdgcn_s_sleep(1);
        if ((++sp & 255u) == 0u) { if (xb_ld(&bar[XB_TMO])) break; if (sp > XB_SPIN_CAP) { atomicAdd(&bar[XB_TMO], 1u); break; } }
    }
    nloc = mine > 0u ? mine : 1u; nx = cnt > 0u ? cnt : 1u;
}

__device__ __forceinline__ void xcd_barrier(const XcdBarrier& b) {
    asm volatile("s_waitcnt vmcnt(0)" ::: "memory");
    __syncthreads();
    if (threadIdx.x == 0) {
        unsigned* bar = b.bar;
        __builtin_amdgcn_s_waitcnt(0);
        unsigned nloc = b.st[0], nx = b.st[1];
        if (nloc == 0u) { xcd_barrier_complete(bar, b.x, nloc, nx); b.st[0] = nloc; b.st[1] = nx; }
        const unsigned old = xb_add(&bar[XB_XSUB(b.x)], 1u);
        const unsigned gen = old / nloc;
        if (old + 1u == (gen + 1u) * nloc) {
            __builtin_amdgcn_fence(__ATOMIC_RELEASE, "agent");
            asm volatile("s_waitcnt vmcnt(0)" ::: "memory");
            const unsigned og = xb_add(&bar[XB_TOP], 1u);
            const unsigned tg = og / nx;
            if (og + 1u == (tg + 1u) * nx) xb_add(&bar[XB_TOPGEN], 1u);
            else XB_SPIN(xb_ld(&bar[XB_TOPGEN]) == tg, bar);
            __builtin_amdgcn_fence(__ATOMIC_ACQUIRE, "agent");
            xb_add(&bar[XB_XGEN(b.x)], 1u);
            asm volatile("s_waitcnt vmcnt(0)" ::: "memory");
        } else {
            XB_SPIN(xb_ld(&bar[XB_XGEN(b.x)]) == gen, bar);
            __builtin_amdgcn_fence(__ATOMIC_ACQUIRE, "agent");
            asm volatile("s_waitcnt vmcnt(0)" ::: "memory");
        }
    }
    __syncthreads();
}

constexpr int SCR_BYTES = 139264;
constexpr int MISC_OFF = SCR_BYTES;
constexpr int LDS_BYTES = 147456;
constexpr int CW_BAR = 4096;
constexpr int NTHR = 512, NWAVES = 8;

__device__ __forceinline__ void transpose_item(const float* W, int ldw, int col0, int K, bf16_t* WT, int drow0, int kb, LAS float* scr, int lane) {
    const int k0 = 64 * kb;
#pragma unroll 8
    for (int i = 0; i < 32; ++i) { const int kk = 2 * i + (lane >> 5); scr[kk * 33 + (lane & 31)] = W[(size_t)(k0 + kk) * ldw + col0 + (lane & 31)]; }
    asm volatile("s_waitcnt lgkmcnt(0)" ::: "memory");
    const int c = lane & 7;
#pragma unroll
    for (int j = 0; j < 4; ++j) { const int n = (lane >> 3) + 8 * j; const LAS float* s = scr + (8 * c) * 33 + n;
        u32x4 o; o.x = pk2(s[0 * 33], s[1 * 33]); o.y = pk2(s[2 * 33], s[3 * 33]); o.z = pk2(s[4 * 33], s[5 * 33]); o.w = pk2(s[6 * 33], s[7 * 33]);
        *(u32x4*)(WT + (size_t)(drow0 + n) * K + k0 + 8 * c) = o; }
    asm volatile("s_waitcnt lgkmcnt(0)" ::: "memory");
}
__device__ __forceinline__ void up_item(const float* wg, const float* wu, bf16_t* WT, int it, LAS float* scr, int lane) {
    const int nb = it >> 4, kb = it & 15, r0 = 32 * nb, pn = r0 >> 8, p = r0 & 255;
    transpose_item(p < 128 ? wg : wu, DFF, 128 * pn + (p & 127), DM, WT, r0, kb, scr, lane);
}
__device__ __forceinline__ void dn_item(const float* wd, bf16_t* WT, int it, LAS float* scr, int lane) {
    const int nb = it / 44, kb = it % 44;
    transpose_item(wd, DM, 32 * nb, DFF, WT, 32 * nb, kb, scr, lane);
}
constexpr int IT_IN = 112 * 16, IT_OUT = 32 * 16, IT_UP = 176 * 16, IT_DN = 32 * 44;
constexpr int IT_TOTAL = 2 * IT_IN + 2 * IT_OUT + IT_UP + IT_DN + NEXP * (IT_UP + IT_DN);

__device__ __forceinline__ void phase_prologue(const Args& a, LAS unsigned char* lds, int tid, int lane, int wave, int bid, int G) {
    unsigned char* ws = a.ws;
    {
        LAS float* scr = (LAS float*)(lds + wave * 8704);
        const int gw = bid * NWAVES + wave, NGW = G * NWAVES;
        for (int it0 = gw; it0 < IT_TOTAL; it0 += NGW) {
            int it = it0;
            if (it < 2 * IT_IN) { const int l = it / IT_IN; it -= l * IT_IN; const int nb = it >> 4, kb = it & 15, r0 = 32 * nb;
                transpose_item(a.in[8] + (size_t)l * DM * DIN, DIN, r0 < 2048 ? r0 : r0 + 16, DM, (bf16_t*)(ws + WS_WTIN) + (size_t)l * NPW * DM, r0, kb, scr, lane); continue; }
            it -= 2 * IT_IN;
            if (it < 2 * IT_OUT) { const int l = it / IT_OUT; it -= l * IT_OUT; const int nb = it >> 4, kb = it & 15;
                transpose_item(a.in[16] + (size_t)l * DM * DM, DM, 32 * nb, DM, (bf16_t*)(ws + WS_WTOUT) + (size_t)l * DM * DM, 32 * nb, kb, scr, lane); continue; }
            it -= 2 * IT_OUT;
            if (it < IT_UP) { up_item(a.in[17], a.in[18], (bf16_t*)(ws + WS_WTUP), it, scr, lane); continue; }
            it -= IT_UP;
            if (it < IT_DN) { dn_item(a.in[19], (bf16_t*)(ws + WS_WTDN), it, scr, lane); continue; }
            it -= IT_DN;
            if (it < NEXP * IT_UP) { const int e = it / IT_UP; it -= e * IT_UP;
                up_item(a.in[21] + (size_t)e * DM * DFF, a.in[22] + (size_t)e * DM * DFF, (bf16_t*)(ws + WS_WTMUP) + (size_t)e * NUP * DM, it, scr, lane); continue; }
            it -= NEXP * IT_UP;
            { const int e = it / IT_DN; it -= e * IT_DN; dn_item(a.in[23] + (size_t)e * DFF * DM, (bf16_t*)(ws + WS_WTMDN) + (size_t)e * DM * DFF, it, scr, lane); }
        }
    }
    __syncthreads();
    {
        const int gt = bid * NTHR + tid;
        if (gt < 1024) { const int pos = gt >> 4, i = gt & 15;
            double inv = 1.0; for (int q = 0; q < i; ++q) inv *= 0.56234132519034908;
            const float angf = (float)pos * (float)inv; const double ang = (double)angf;
            const double kq = rint(ang * 0.63661977236758134); const double r = ang - kq * 1.5707963267948966 - kq * 6.123233995736766e-17; const double r2 = r * r;
            double sn = r * (1.0 + r2 * (-1.0 / 6 + r2 * (1.0 / 120 + r2 * (-1.0 / 5040 + r2 * (1.0 / 362880 + r2 * (-1.0 / 39916800 + r2 * (1.0 / 6227020800.0)))))));
            double cs = 1.0 + r2 * (-0.5 + r2 * (1.0 / 24 + r2 * (-1.0 / 720 + r2 * (1.0 / 40320 + r2 * (-1.0 / 3628800 + r2 * (1.0 / 479001600.0 + r2 * (-1.0 / 87178291200.0)))))));
            const int kk = ((int)kq) & 3; double c2, s2;
            if (kk == 0) { c2 = cs; s2 = sn; } else if (kk == 1) { c2 = -sn; s2 = cs; } else if (kk == 2) { c2 = -cs; s2 = -sn; } else { c2 = sn; s2 = -cs; }
            float* R = (float*)(ws + WS_ROPE); R[gt * 2] = (float)c2; R[gt * 2 + 1] = (float)s2; }
    }
    {
        LAS float* sc = (LAS float*)(lds + 73728);
        LAS float* red = (LAS float*)(lds + 73728 + 36864);
        for (int i = tid; i < 9 * 1024; i += NTHR) { const float v = i < 8192 ? a.in[1][i] : a.in[3][i - 8192]; sc[i] = v / (1.0f + __expf(-v)); }
        __syncthreads();
        for (int item = bid; item < 192; item += G) {
            const int l = item / 96, n0 = (item % 96) * 64;
            const float* wm = a.in[6] + (size_t)l * DM * 6144 + n0 + lane;
            float acc[9];
#pragma unroll
            for (int b = 0; b < 9; ++b) acc[b] = 0.f;
#pragma unroll 4
            for (int kk = 0; kk < 128; ++kk) { const int k = wave * 128 + kk; const float w = wm[(size_t)k * 6144];
#pragma unroll
                for (int b = 0; b < 9; ++b) acc[b] += sc[b * 1024 + k] * w; }
#pragma unroll
            for (int b = 0; b < 9; ++b) red[(wave * 9 + b) * 64 + lane] = acc[b];
            __syncthreads();
            for (int o = tid; o < 576; o += NTHR) { const int b = o >> 6, ln = o & 63; float s = a.in[7][(size_t)l * 6144 + n0 + ln];
#pragma unroll
                for (int w = 0; w < 8; ++w) s += red[(w * 9 + b) * 64 + ln];
                ((float*)(ws + WS_MOD))[((size_t)l * 9 + b) * 6144 + n0 + ln] = s; }
            __syncthreads();
        }
    }
}

template <int MODE>
__device__ __forceinline__ void phase_norm(const Args& a, int l, LAS unsigned char* lds, int tid, int lane, int wave, int bid, int G) {
    unsigned char* ws = a.ws;
    LAS float* WT = (LAS float*)lds;
    if (MODE == 0) { const float* w = a.in[8] + (size_t)l * DM * DIN + 2048; for (int i = tid; i < 16384; i += NTHR) { const int k = i >> 4, j = i & 15; WT[j * 1024 + k] = w[(size_t)k * DIN + j]; } __syncthreads(); }
    if (MODE == 2) { const float* w = a.in[20]; for (int i = tid; i < 8192; i += NTHR) { const int k = i >> 3, j = i & 7; WT[j * 1024 + k] = w[(size_t)k * 8 + j]; } __syncthreads(); }
    const float* gam = (MODE == 0 ? a.in[4] : a.in[5]) + (size_t)l * DM;
    const float* mod = (const float*)(ws + WS_MOD) + (size_t)l * 9 * 6144;
    const int shoff = MODE == 0 ? 0 : 3072, soff = MODE == 0 ? 1024 : 4096;
    const int nrows = (MODE == 2) ? NLAT : MALL;
    bf16_t* H = (bf16_t*)(ws + WS_H);
    for (int r = bid * NWAVES + wave; r < nrows; r += G * NWAVES) {
        const bool lat = r < NLAT; const int bi = lat ? (r >> 11) : 8;
        const float* src = (MODE == 0 && l == 0) ? (lat ? a.in[0] + (size_t)r * DM : a.in[2] + (size_t)(r - NLAT) * DM)
                                    : (lat ? a.out + (size_t)r * DM : (const float*)(ws + WS_XC) + (size_t)(r - NLAT) * DM);
        f32x4 v[4]; float ss = 0.f;
#pragma unroll
        for (int j = 0; j < 4; ++j) { v[j] = *(const f32x4*)(src + 4 * lane + 256 * j); ss += (v[j].x * v[j].x + v[j].y * v[j].y) + (v[j].z * v[j].z + v[j].w * v[j].w); }
        const float rstd = rsqrtf(wave_sum(ss) * (1.0f / DM) + EPS);
        const float* mrow = mod + (size_t)bi * 6144;
#pragma unroll
        for (int j = 0; j < 4; ++j) { const int k = 4 * lane + 256 * j;
            const f32x4 g = *(const f32x4*)(gam + k), s = *(const f32x4*)(mrow + soff + k), sh = *(const f32x4*)(mrow + shoff + k);
            v[j] = v[j] * rstd * g * (1.0f + s) + sh;
            u32x2 w; w.x = pk2(v[j].x, v[j].y); w.y = pk2(v[j].z, v[j].w);
            *(u32x2*)(H + (size_t)r * DM + k) = w; }
        if (MODE == 0) {
            float mine = 0.f;
#pragma nounroll
            for (int jg = 0; jg < 16; ++jg) { float s = 0.f;
#pragma unroll
                for (int j = 0; j < 4; ++j) { const f32x4 w = *(const LAS f32x4*)(WT + jg * 1024 + 4 * lane + 256 * j); s += (v[j].x * w.x + v[j].y * w.y) + (v[j].z * w.z + v[j].w * w.w); }
                s = wave_sum(s); mine = (lane == jg) ? s : mine; }
            if (lane < 16) ((float*)(ws + WS_GATES))[(size_t)r * 16 + lane] = mine + a.in[12][l * 16 + lane];
        }
        if (MODE == 2) {
            int i1 = 0, i2 = 0; float v1 = -3.0e38f, v2 = -3.0e38f;
#pragma nounroll
            for (int e = 0; e < 8; ++e) { float s = 0.f;
#pragma unroll
                for (int j = 0; j < 4; ++j) { const f32x4 w = *(const LAS f32x4*)(WT + e * 1024 + 4 * lane + 256 * j); s += (v[j].x * w.x + v[j].y * w.y) + (v[j].z * w.z + v[j].w * w.w); }
                s = wave_sum(s);
                if (s > v1) { v2 = v1; i2 = i1; v1 = s; i1 = e; } else if (s > v2) { v2 = s; i2 = e; } }
            const float w2 = 1.0f / (1.0f + __expf(v1 - v2)), w1 = 1.0f - w2;
            if (lane < 8) ((float*)(ws + WS_COMB))[(size_t)r * 8 + lane] = (lane == i1) ? w1 : ((lane == i2) ? w2 : 0.f);
        }
    }
}

__device__ __forceinline__ void phase_post(const Args& a, int l, int lane, int wave, int bid, int G) {
    unsigned char* ws = a.ws;
    bf16_t* P = (bf16_t*)(ws + WS_BIG); bf16_t* MQK = (bf16_t*)(ws + WS_MQK);
    const float* ROPE = (const float*)(ws + WS_ROPE);
    const float* cw = a.in[10] + (size_t)l * 3 * 512; const float* cb = a.in[11] + (size_t)l * 512;
    const float qg = a.in[13][l * 64 + lane], kg = a.in[14][l * 64 + lane];
    for (int r = bid * NWAVES + wave; r < MALL; r += G * NWAVES) {
        const bool lat = r < NLAT; bf16_t* row = P + (size_t)r * NPW;
        int t, tlen; if (lat) { t = r & (SEQ - 1); tlen = SEQ; } else { t = (r - NLAT) & (CTXL - 1); tlen = CTXL; }
        if (lat) { const int gr = t >> 6, gc = t & 63;
#pragma unroll
            for (int blk = 0; blk < 2; ++blk)
#pragma unroll
                for (int ii = 0; ii < 2; ++ii) { const int pid = lane + 64 * ii, head = pid >> 5, half = (pid >> 4) & 1, i = pid & 15, c1 = (blk ? PC_RK : PC_RQ) + head * 64 + half * 32 + i;
                    const int pos = half ? gc : gr; const float cs = ROPE[(pos * 16 + i) * 2], sn = ROPE[(pos * 16 + i) * 2 + 1];
                    const float x1 = bf2f(row[c1]), x2 = bf2f(row[c1 + 16]); const float sc = blk ? 0.125f : 1.0f;
                    row[c1] = (bf16_t)f2bf((x1 * cs - x2 * sn) * sc); row[c1 + 16] = (bf16_t)f2bf((x1 * sn + x2 * cs) * sc); }
        } else {
#pragma unroll
            for (int ii = 0; ii < 4; ++ii) { const int c = PC_RK + lane + 64 * ii; row[c] = (bf16_t)f2bf(bf2f(row[c]) * 0.125f); }
        }
#pragma unroll
        for (int ii = 0; ii < 8; ++ii) { const int c = lane + 64 * ii;
            const float x0 = bf2f(row[PC_MQ + c]);
            const float xm = t > 0 ? bf2f(row[PC_MQ + c - NPW]) : 0.f, xp = t < tlen - 1 ? bf2f(row[PC_MQ + c + NPW]) : 0.f;
            float y = cb[c] + cw[c] * xm + cw[512 + c] * x0 + cw[1024 + c] * xp;
            y = y / (1.0f + __expf(-y)); if (c >= 256) y *= 0.125f;
            MQK[(size_t)r * 512 + c] = (bf16_t)f2bf(y); }
#pragma unroll
        for (int hh = 0; hh < 16; ++hh) { const int c = PC_NQ + hh * 64 + lane; const float v = bf2f(row[c]);
            const float rs = rsqrtf(wave_sum(v * v) * (1.0f / 64.0f) + EPS);
            row[c] = (bf16_t)f2bf(v * rs * (hh < 8 ? qg : kg)); }
    }
}

__device__ __forceinline__ int tokrow(int b, int p, int dir) {
    if (dir == 0) return p < CTXL ? NLAT + b * CTXL + p : b * SEQ + (p - CTXL);
    return p < CTXL ? NLAT + b * CTXL + (CTXL - 1 - p) : b * SEQ + (SEQ - 1 - (p - CTXL));
}
__device__ __forceinline__ void phase_fcum(const Args& a, int lane, int wave, int bid, int G) {
    unsigned char* ws = a.ws; const float* GT = (const float*)(ws + WS_GATES); float* F = (float*)(ws + WS_FCUM);
    for (int it = bid * NWAVES + wave; it < NB * 4 * 2; it += G * NWAVES) {
        const int dir = it & 1, h = (it >> 1) & 3, b = it >> 3; float carry = 0.f;
        for (int p0 = 0; p0 < CTXL + SEQ; p0 += 64) { const int p = p0 + lane; const int row = tokrow(b, p, dir);
            float v = logsigmoidf_(GT[(size_t)row * 16 + 8 + 4 * dir + h]);
#pragma unroll
            for (int o = 1; o < 64; o <<= 1) { const float u = __shfl_up(v, o); if (lane >= o) v += u; }
            F[(size_t)((b * 4 + h) * 2 + dir) * 2304 + p] = carry + v;
            carry += __shfl(v, 63); }
    }
}

__device__ __forceinline__ void phase_quad(const Args& a, int l, bool need_ctx, LAS unsigned char* lds, int lane, int wave, int bid, int G) {
    unsigned char* ws = a.ws;
    const bf16_t* P = (const bf16_t*)(ws + WS_BIG); const bf16_t* MQK = (const bf16_t*)(ws + WS_MQK);
    const float* GT = (const float*)(ws + WS_GATES); const float* FC = (const float*)(ws + WS_FCUM);
    LAS float* scr = (LAS float*)(lds + wave * 16640);
    const int nrows = need_ctx ? MALL : NLAT, nitems = nrows * 8;
    for (int it = bid * NWAVES + wave; it < nitems; it += G * NWAVES) {
        const int kind = it & 1, h = (it >> 1) & 3, r = it >> 3;
        const bool lat = r < NLAT; const int b = lat ? (r >> 11) : ((r - NLAT) >> 8), tt = lat ? (r & (SEQ - 1)) : ((r - NLAT) & (CTXL - 1));
        const bf16_t* qsrc = kind == 0 ? P + (size_t)r * NPW + PC_RQ + h * 64 : MQK + (size_t)r * 512 + h * 64;
        unsigned qp[32];
#pragma unroll
        for (int i = 0; i < 8; ++i) { const u32x4 w = *(const u32x4*)(qsrc + 8 * i); qp[4 * i] = w.x; qp[4 * i + 1] = w.y; qp[4 * i + 2] = w.z; qp[4 * i + 3] = w.w; }
        float y = 0.f;
        for (int dir = 0; dir < 2; ++dir) {
            const int p = lat ? (dir == 0 ? CTXL + tt : CTXL + (SEQ - 1 - tt)) : (dir == 0 ? tt : CTXL - 1 - tt);
            const float lg = logsigmoidf_(a.in[9][(l * 2 + dir) * 4 + h]);
            const float* fc = FC + (size_t)((b * 4 + h) * 2 + dir) * 2304; const float fp = fc[p];
            float num[64]; float den = 0.f;
#pragma unroll
            for (int e = 0; e < 64; ++e) num[e] = 0.f;
            for (int p0 = 0; p0 <= p; p0 += 64) {
                const int pk = p0 + lane; const bool valid = pk <= p; const int pkc = valid ? pk : p; const int rk = tokrow(b, pkc, dir);
                const bf16_t* ksrc = kind == 0 ? P + (size_t)rk * NPW + PC_RK + h * 64 : MQK + (size_t)rk * 512 + 256 + h * 64;
                const bf16_t* vsrc = P + (size_t)rk * NPW + (kind == 0 ? PC_RV : PC_MV) + h * 64;
                float dot = 0.f;
#pragma unroll
                for (int i = 0; i < 8; ++i) { const u32x4 w = *(const u32x4*)(ksrc + 8 * i);
                    dot += bflo(qp[4 * i]) * bflo(w.x) + bfhi(qp[4 * i]) * bfhi(w.x) + bflo(qp[4 * i + 1]) * bflo(w.y) + bfhi(qp[4 * i + 1]) * bfhi(w.y)
                         + bflo(qp[4 * i + 2]) * bflo(w.z) + bfhi(qp[4 * i + 2]) * bfhi(w.z) + bflo(qp[4 * i + 3]) * bflo(w.w) + bfhi(qp[4 * i + 3]) * bfhi(w.w); }
                float wgt;
                if (kind == 0) wgt = __expf(lg * (float)(p - pkc));
                else wgt = __expf(fp - fc[pkc] + GT[(size_t)rk * 16 + 4 * dir + h]);
                const float wd = valid ? wgt * dot : 0.f;
                den += wd;
#pragma unroll
                for (int i = 0; i < 8; ++i) { const u32x4 w = *(const u32x4*)(vsrc + 8 * i);
                    num[8 * i] += wd * bflo(w.x); num[8 * i + 1] += wd * bfhi(w.x); num[8 * i + 2] += wd * bflo(w.y); num[8 * i + 3] += wd * bfhi(w.y);
                    num[8 * i + 4] += wd * bflo(w.z); num[8 * i + 5] += wd * bfhi(w.z); num[8 * i + 6] += wd * bflo(w.w); num[8 * i + 7] += wd * bfhi(w.w); }
            }
#pragma unroll
            for (int e = 0; e < 64; ++e) scr[lane * 65 + e] = num[e];
            den = wave_sum(den);
            asm volatile("s_waitcnt lgkmcnt(0)" ::: "memory");
            float s = 0.f;
#pragma unroll 8
            for (int i = 0; i < 64; ++i) s += scr[i * 65 + lane];
            asm volatile("s_waitcnt lgkmcnt(0)" ::: "memory");
            y += kind == 0 ? s : s / fmaxf(fabsf(den), 1.0f);
        }
        ((float*)(ws + (kind == 0 ? WS_RETY : WS_MLY)))[(size_t)r * 256 + h * 64 + lane] = y;
    }
}

__device__ __forceinline__ void phase_natt(const Args& a, int l, bool need_ctx, LAS unsigned char* lds, int lane, int wave, int bid, int G) {
    unsigned char* ws = a.ws;
    const bf16_t* P = (const bf16_t*)(ws + WS_BIG); bf16_t* NAY = (bf16_t*)(ws + WS_NAY);
    LAS float* prob = (LAS float*)(lds + wave * 16640);
    LAS int* krow = (LAS int*)(lds + wave * 16640 + 1536);
    const int nrows = need_ctx ? MALL : NLAT, nitems = nrows * 8;
    for (int it = bid * NWAVES + wave; it < nitems; it += G * NWAVES) {
        const int h = it & 7, r = it >> 3; const bool lat = r < NLAT;
        const int b = lat ? (r >> 11) : ((r - NLAT) >> 8);
        const bf16_t* qsrc = P + (size_t)r * NPW + PC_NQ + h * 64;
        unsigned qp[32];
#pragma unroll
        for (int i = 0; i < 8; ++i) { const u32x4 w = *(const u32x4*)(qsrc + 8 * i); qp[4 * i] = w.x; qp[4 * i + 1] = w.y; qp[4 * i + 2] = w.z; qp[4 * i + 3] = w.w; }
        int gr = 0, gc = 0, sr = 0, scc = 0;
        if (lat) { const int t = r & (SEQ - 1); gr = t >> 6; gc = t & 63; sr = min(max(gr - 4, 0), NROWS - 8); scc = min(max(gc - 8, 0), GRIDW - 16); }
        const float* rpb = a.in[15] + (size_t)(l * 8 + h) * 15 * 31;
        float s[6]; float mx = -3.0e38f;
#pragma unroll
        for (int jj = 0; jj < 6; ++jj) {
            const bool loc = jj < 2; int rk; float bias = 0.f; bool valid = true;
            if (loc) { const int j = lane + 64 * jj, kk = j >> 4, kc = j & 15, kr_ = sr + kk, kcol = scc + kc; rk = b * SEQ + kr_ * 64 + kcol;
                bias = rpb[(kr_ - gr + 7) * 31 + min(max(kcol - gc + 15, 0), 30)]; valid = lat; if (lat) krow[j] = rk; }
            else rk = NLAT + b * CTXL + lane + 64 * (jj - 2);
            const bf16_t* ksrc = P + (size_t)rk * NPW + PC_NK + h * 64;
            float dot = 0.f;
#pragma unroll
            for (int i = 0; i < 8; ++i) { const u32x4 w = *(const u32x4*)(ksrc + 8 * i);
                dot += bflo(qp[4 * i]) * bflo(w.x) + bfhi(qp[4 * i]) * bfhi(w.x) + bflo(qp[4 * i + 1]) * bflo(w.y) + bfhi(qp[4 * i + 1]) * bfhi(w.y)
                     + bflo(qp[4 * i + 2]) * bflo(w.z) + bfhi(qp[4 * i + 2]) * bfhi(w.z) + bflo(qp[4 * i + 3]) * bflo(w.w) + bfhi(qp[4 * i + 3]) * bfhi(w.w); }
            s[jj] = valid ? dot * 0.125f + bias : -3.0e38f; mx = fmaxf(mx, s[jj]);
        }
        mx = wave_max(mx); float sum = 0.f;
#pragma unroll
        for (int jj = 0; jj < 6; ++jj) { s[jj] = (s[jj] > -1.0e38f) ? __expf(s[jj] - mx) : 0.f; sum += s[jj]; }
        sum = wave_sum(sum); const float inv = 1.0f / sum;
#pragma unroll
        for (int jj = 0; jj < 6; ++jj) prob[lane + 64 * jj] = s[jj] * inv;
        asm volatile("s_waitcnt lgkmcnt(0)" ::: "memory");
        float o = 0.f;
        if (lat) for (int j = 0; j < 128; ++j) o += prob[j] * bf2f(P[(size_t)krow[j] * NPW + PC_NV + h * 64 + lane]);
        for (int j = 0; j < CTXL; ++j) o += prob[128 + j] * bf2f(P[(size_t)(NLAT + b * CTXL + j) * NPW + PC_NV + h * 64 + lane]);
        asm volatile("s_waitcnt lgkmcnt(0)" ::: "memory");
        NAY[(size_t)r * 512 + h * 64 + lane] = (bf16_t)f2bf(o);
    }
}

__device__ __forceinline__ void phase_merge(const Args& a, bool need_ctx, int lane, int wave, int bid, int G) {
    unsigned char* ws = a.ws;
    const bf16_t* P = (const bf16_t*)(ws + WS_BIG); const bf16_t* NAY = (const bf16_t*)(ws + WS_NAY); bf16_t* MG = (bf16_t*)(ws + WS_H);
    const float* RY = (const float*)(ws + WS_RETY); const float* MY = (const float*)(ws + WS_MLY);
    const int nrows = need_ctx ? MALL : NLAT;
    for (int r = bid * NWAVES + wave; r < nrows; r += G * NWAVES) {
#pragma unroll
        for (int h = 0; h < 4; ++h) {
            { const float v = RY[(size_t)r * 256 + h * 64 + lane]; const float rs = rsqrtf(wave_sum(v * v) * (1.0f / 64.0f) + EPS);
              const float g = bf2f(P[(size_t)r * NPW + PC_RG + h * 64 + lane]); MG[(size_t)r * DM + h * 64 + lane] = (bf16_t)f2bf(siluf_(g) * v * rs); }
            { const float v = MY[(size_t)r * 256 + h * 64 + lane]; const float rs = rsqrtf(wave_sum(v * v) * (1.0f / 64.0f) + EPS);
              const float g = bf2f(P[(size_t)r * NPW + PC_MO + h * 64 + lane]); MG[(size_t)r * DM + 256 + h * 64 + lane] = (bf16_t)f2bf(sigmoidf_(g) * v * rs); }
        }
#pragma unroll
        for (int i = 0; i < 8; ++i) MG[(size_t)r * DM + 512 + lane + 64 * i] = NAY[(size_t)r * 512 + lane + 64 * i];
    }
}

typedef short bf16x8 __attribute__((ext_vector_type(8)));
typedef short s16x4 __attribute__((ext_vector_type(4)));
constexpr int IST = 160;
__device__ __forceinline__ f32x4 mfma16(bf16x8 a, bf16x8 b, f32x4 c) { return __builtin_amdgcn_mfma_f32_16x16x32_bf16(a, b, c, 0, 0, 0); }
__device__ __forceinline__ bf16x8 frag_row(LAS const unsigned char* img, int row0, int k0, int lane) {
    return *(const LAS bf16x8*)(img + (row0 + (lane & 15)) * IST + (k0 + 8 * (lane >> 4)) * 2);
}
template <bool PERMK>
__device__ __forceinline__ bf16x8 frag_tr(LAS const unsigned char* img, int r0, int c0, int lane) {
    const int g = lane >> 4, i = lane & 15, q = i >> 2, p = i & 3;
    const unsigned addr = (unsigned)(size_t)(img + (r0 + (PERMK ? 4 : 8) * g + q) * IST + (c0 + 4 * p) * 2);
    s16x4 lo, hi;
    if (PERMK) asm volatile("ds_read_b64_tr_b16 %0, %2\n\tds_read_b64_tr_b16 %1, %2 offset:2560\n\ts_waitcnt lgkmcnt(0)" : "=&v"(lo), "=&v"(hi) : "v"(addr) : "memory");
    else       asm volatile("ds_read_b64_tr_b16 %0, %2\n\tds_read_b64_tr_b16 %1, %2 offset:640\n\ts_waitcnt lgkmcnt(0)" : "=&v"(lo), "=&v"(hi) : "v"(addr) : "memory");
    bf16x8 r; r[0] = lo[0]; r[1] = lo[1]; r[2] = lo[2]; r[3] = lo[3]; r[4] = hi[0]; r[5] = hi[1]; r[6] = hi[2]; r[7] = hi[3];
    return r;
}
__device__ __forceinline__ bf16x8 pack8(f32x4 a, f32x4 b) {
    union { u32x4 u; bf16x8 v; } x; x.u.x = pk2(a[0], a[1]); x.u.y = pk2(a[2], a[3]); x.u.z = pk2(b[0], b[1]); x.u.w = pk2(b[2], b[3]); return x.v;
}
__device__ __forceinline__ int chunk_row0(int b, int dir, int sc) {
    if (dir == 0) return sc < 2 ? NLAT + b * CTXL + 128 * sc : b * SEQ + 128 * (sc - 2);
    return sc < 2 ? NLAT + b * CTXL + 128 * (1 - sc) : b * SEQ + 128 * (17 - sc);
}
constexpr size_t U_BYTES = 80 * 64 * 2;

__device__ __forceinline__ void phase_chunk_sums(const Args& a, int l, LAS unsigned char* lds, int tid, int lane, int wave, int bid, int G) {
    unsigned char* ws = a.ws;
    const bf16_t* P = (const bf16_t*)(ws + WS_BIG); const bf16_t* MQK = (const bf16_t*)(ws + WS_MQK);
    const float* GT = (const float*)(ws + WS_GATES);
    LAS unsigned char* Kimg = lds;
    LAS unsigned char* Vimg = lds + 128 * IST;
    LAS float* wk = (LAS float*)(lds + 256 * IST);
    LAS float* red = wk + 128;
    const int nitems = 2 * NB * 4 * 2 * 18;
    for (int it = bid; it < nitems; it += G) {
        const int sc = it % 18; int r_ = it / 18; const int dir = r_ & 1; r_ >>= 1; const int h = r_ & 3; r_ >>= 2; const int b = r_ & 7; const int kind = r_ >> 3;
        const int row0 = chunk_row0(b, dir, sc);
        __syncthreads();
        if (kind == 0) { if (tid < 128) { const float lg = logsigmoidf_(a.in[9][(l * 2 + dir) * 4 + h]); wk[tid] = __expf(lg * (float)(dir == 0 ? 127 - tid : tid)); } }
        else if (wave == 0) {
            const float g0i = GT[(size_t)(row0 + lane) * 16 + 4 * dir + h], g1i = GT[(size_t)(row0 + 64 + lane) * 16 + 4 * dir + h];
            const float f0 = logsigmoidf_(GT[(size_t)(row0 + lane) * 16 + 8 + 4 * dir + h]), f1 = logsigmoidf_(GT[(size_t)(row0 + 64 + lane) * 16 + 8 + 4 * dir + h]);
            float s0 = f0, s1 = f1;
#pragma unroll
            for (int o = 1; o < 64; o <<= 1) { const float u0 = __shfl_up(s0, o), u1 = __shfl_up(s1, o); if (lane >= o) { s0 += u0; s1 += u1; } }
            const float t0 = __shfl(s0, 63), t1 = __shfl(s1, 63), tot = t0 + t1;
            float b0, b1;
            if (dir == 0) { b0 = s0; b1 = t0 + s1; } else { b0 = tot - s0 + f0; b1 = t1 - s1 + f1; }
            const float a0 = g0i - b0, a1 = g1i - b1; const float amax = wave_max(fmaxf(a0, a1));
            wk[lane] = __expf(a0 - amax); wk[lane + 64] = __expf(a1 - amax);
            if (lane == 0) { float* usc = (float*)(ws + WS_USC) + ((size_t)((b * 4 + h) * 2 + dir) * 18 + sc) * 2; usc[0] = tot; usc[1] = amax; }
        }
        __syncthreads();
        {
            const int r = tid >> 2, c8 = (tid & 3) * 16;
            const bf16_t* ksrc = kind == 0 ? P + (size_t)(row0 + r) * NPW + PC_RK + h * 64 + c8 : MQK + (size_t)(row0 + r) * 512 + 256 + h * 64 + c8;
            const bf16_t* vsrc = P + (size_t)(row0 + r) * NPW + (kind == 0 ? PC_RV : PC_MV) + h * 64 + c8;
            const u32x4 k0 = *(const u32x4*)ksrc, k1 = *(const u32x4*)(ksrc + 8), v0 = *(const u32x4*)vsrc, v1 = *(const u32x4*)(vsrc + 8);
            *(LAS u32x4*)(Kimg + r * IST + c8 * 2) = k0; *(LAS u32x4*)(Kimg + r * IST + c8 * 2 + 16) = k1;
            const float w = wk[r];
            u32x4 o0, o1;
            o0.x = pk2(bflo(v0.x) * w, bfhi(v0.x) * w); o0.y = pk2(bflo(v0.y) * w, bfhi(v0.y) * w); o0.z = pk2(bflo(v0.z) * w, bfhi(v0.z) * w); o0.w = pk2(bflo(v0.w) * w, bfhi(v0.w) * w);
            o1.x = pk2(bflo(v1.x) * w, bfhi(v1.x) * w); o1.y = pk2(bflo(v1.y) * w, bfhi(v1.y) * w); o1.z = pk2(bflo(v1.z) * w, bfhi(v1.z) * w); o1.w = pk2(bflo(v1.w) * w, bfhi(v1.w) * w);
            *(LAS u32x4*)(Vimg + r * IST + c8 * 2) = o0; *(LAS u32x4*)(Vimg + r * IST + c8 * 2 + 16) = o1;
            if ((tid & 3) == 0) { u32x4 e0; e0.x = f2bf(w); e0.y = 0u; e0.z = 0u; e0.w = 0u; const u32x4 z = {0u, 0u, 0u, 0u};
                *(LAS u32x4*)(Vimg + r * IST + 128) = e0; *(LAS u32x4*)(Vimg + r * IST + 144) = z; }
        }
        __syncthreads();
        {
            const int dt = wave & 3, et0 = 2 * (wave >> 2);
            f32x4 u0 = {0.f, 0.f, 0.f, 0.f}, u1 = u0, u2 = u0;
#pragma unroll
            for (int ks = 0; ks < 4; ++ks) {
                const bf16x8 af = frag_tr<false>(Kimg, 32 * ks, 16 * dt, lane);
                const bf16x8 b0 = frag_tr<false>(Vimg, 32 * ks, 16 * et0, lane), b1 = frag_tr<false>(Vimg, 32 * ks, 16 * et0 + 16, lane);
                u0 = mfma16(af, b0, u0); u1 = mfma16(af, b1, u1);
                if (wave < 4) { const bf16x8 b2 = frag_tr<false>(Vimg, 32 * ks, 64, lane); u2 = mfma16(af, b2, u2); }
            }
            bf16_t* U = (bf16_t*)(ws + WS_U + ((size_t)(((kind * NB + b) * 4 + h) * 2 + dir) * 18 + sc) * U_BYTES);
            const int g = lane >> 4, e = lane & 15, d0 = 16 * dt + 4 * g;
            { u32x2 w; w.x = pk2(u0[0], u0[1]); w.y = pk2(u0[2], u0[3]); *(u32x2*)(U + (size_t)(16 * et0 + e) * 64 + d0) = w; }
            { u32x2 w; w.x = pk2(u1[0], u1[1]); w.y = pk2(u1[2], u1[3]); *(u32x2*)(U + (size_t)(16 * et0 + 16 + e) * 64 + d0) = w; }
            if (wave < 4) { u32x2 w; w.x = pk2(u2[0], u2[1]); w.y = pk2(u2[2], u2[3]); *(u32x2*)(U + (size_t)(64 + e) * 64 + d0) = w; }
        }
    }
}

template <int KIND>
__device__ __forceinline__ float assemble_state(const unsigned char* ws, int l, const float* ret_decay, int b, int h, int dir, int sc, LAS unsigned char* Simg, int tid) {
    const unsigned char* Ub = ws + WS_U + (size_t)((((KIND * NB + b) * 4 + h) * 2 + dir) * 18) * U_BYTES;
    float m = -1.0e30f; float lg128 = 0.f;
    const float* usc = (const float*)(ws + WS_USC) + (size_t)((b * 4 + h) * 2 + dir) * 18 * 2;
    if (KIND == 0) lg128 = 128.0f * logsigmoidf_(ret_decay[(l * 2 + dir) * 4 + h]);
    else { float suf = 0.f; for (int s = sc - 1; s >= 0; --s) { suf += usc[2 * s]; m = fmaxf(m, usc[2 * s + 1] + suf); } }
    float acc[8];
#pragma unroll
    for (int j = 0; j < 8; ++j) acc[j] = 0.f;
    const bool extra = (KIND == 1) && tid < 8;
    float acx[8];
#pragma unroll
    for (int j = 0; j < 8; ++j) acx[j] = 0.f;
    float suf = 0.f;
    for (int s = sc - 1; s >= 0; --s) {
        float coef;
        if (KIND == 0) coef = __expf(lg128 * (float)(sc - 1 - s));
        else { suf += usc[2 * s]; coef = __expf(usc[2 * s + 1] + suf - m); }
        const u32x4 v = *(const u32x4*)(Ub + (size_t)s * U_BYTES + (size_t)tid * 16);
        acc[0] += coef * bflo(v.x); acc[1] += coef * bfhi(v.x); acc[2] += coef * bflo(v.y); acc[3] += coef * bfhi(v.y);
        acc[4] += coef * bflo(v.z); acc[5] += coef * bfhi(v.z); acc[6] += coef * bflo(v.w); acc[7] += coef * bfhi(v.w);
        if (extra) { const u32x4 x = *(const u32x4*)(Ub + (size_t)s * U_BYTES + (size_t)(512 + tid) * 16);
            acx[0] += coef * bflo(x.x); acx[1] += coef * bfhi(x.x); acx[2] += coef * bflo(x.y); acx[3] += coef * bfhi(x.y);
            acx[4] += coef * bflo(x.z); acx[5] += coef * bfhi(x.z); acx[6] += coef * bflo(x.w); acx[7] += coef * bfhi(x.w); }
    }
    { u32x4 o; o.x = pk2(acc[0], acc[1]); o.y = pk2(acc[2], acc[3]); o.z = pk2(acc[4], acc[5]); o.w = pk2(acc[6], acc[7]);
      *(LAS u32x4*)(Simg + (tid >> 3) * IST + (tid & 7) * 16) = o; }
    if (extra) { u32x4 o; o.x = pk2(acx[0], acx[1]); o.y = pk2(acx[2], acx[3]); o.z = pk2(acx[4], acx[5]); o.w = pk2(acx[6], acx[7]);
      *(LAS u32x4*)(Simg + 64 * IST + tid * 16) = o; }
    return m;
}

template <int KIND>
__device__ __forceinline__ void phase_chunk_out(const Args& a, int l, bool need_ctx, LAS unsigned char* lds, int tid, int lane, int wave, int bid, int G) {
    unsigned char* ws = a.ws;
    const bf16_t* P = (const bf16_t*)(ws + WS_BIG); const bf16_t* MQK = (const bf16_t*)(ws + WS_MQK);
    const float* GT = (const float*)(ws + WS_GATES); bf16_t* MG = (bf16_t*)(ws + WS_H);
    LAS unsigned char* Qimg = lds; LAS unsigned char* Kimg = lds + 20480; LAS unsigned char* Vimg = lds + 40960;
    LAS unsigned char* SFimg = lds + 61440; LAS unsigned char* SBimg = lds + 74240;
    LAS float* AF = (LAS float*)(lds + 87040); LAS float* CF = AF + 128; LAS float* BF = AF + 256; LAS float* AB = AF + 384; LAS float* CB = AF + 512; LAS float* BB = AF + 640;
    const int nch = need_ctx ? 18 : 16, nitems = NB * 4 * nch;
    const int g = lane >> 4, qi = 16 * wave + (lane & 15);
    for (int it = bid; it < nitems; it += G) {
        const int cc = it % nch; const int bh = it / nch; const int h = bh & 3, b = bh >> 2;
        const bool isctx = cc >= 16; const int c = isctx ? cc - 16 : cc;
        const int row0 = isctx ? NLAT + b * CTXL + 128 * c : b * SEQ + 128 * c;
        const int scf = isctx ? c : 2 + c, scb = isctx ? 1 - c : 17 - c;
        __syncthreads();
        {
            const int r = tid >> 2, c8 = (tid & 3) * 16;
            const bf16_t* qsrc = KIND == 0 ? P + (size_t)(row0 + r) * NPW + PC_RQ + h * 64 + c8 : MQK + (size_t)(row0 + r) * 512 + h * 64 + c8;
            const bf16_t* ksrc = KIND == 0 ? P + (size_t)(row0 + r) * NPW + PC_RK + h * 64 + c8 : MQK + (size_t)(row0 + r) * 512 + 256 + h * 64 + c8;
            const bf16_t* vsrc = P + (size_t)(row0 + r) * NPW + (KIND == 0 ? PC_RV : PC_MV) + h * 64 + c8;
            const u32x4 q0 = *(const u32x4*)qsrc, q1 = *(const u32x4*)(qsrc + 8), k0 = *(const u32x4*)ksrc, k1 = *(const u32x4*)(ksrc + 8), v0 = *(const u32x4*)vsrc, v1 = *(const u32x4*)(vsrc + 8);
            *(LAS u32x4*)(Qimg + r * IST + c8 * 2) = q0; *(LAS u32x4*)(Qimg + r * IST + c8 * 2 + 16) = q1;
            *(LAS u32x4*)(Kimg + r * IST + c8 * 2) = k0; *(LAS u32x4*)(Kimg + r * IST + c8 * 2 + 16) = k1;
            *(LAS u32x4*)(Vimg + r * IST + c8 * 2) = v0; *(LAS u32x4*)(Vimg + r * IST + c8 * 2 + 16) = v1;
            if ((tid & 3) == 0) { u32x4 e0; e0.x = 0x3F80u; e0.y = 0u; e0.z = 0u; e0.w = 0u; const u32x4 z = {0u, 0u, 0u, 0u};
                *(LAS u32x4*)(Vimg + r * IST + 128) = e0; *(LAS u32x4*)(Vimg + r * IST + 144) = z; }
        }
        const float mpf = assemble_state<KIND>(ws, l, a.in[9], b, h, 0, scf, SFimg, tid);
        const float mpb = assemble_state<KIND>(ws, l, a.in[9], b, h, 1, scb, SBimg, tid);
        if (KIND == 1 && wave == 0) {
            const size_t r0_ = (size_t)(row0 + lane) * 16, r1_ = (size_t)(row0 + 64 + lane) * 16;
#pragma unroll
            for (int dir = 0; dir < 2; ++dir) {
                const float i0 = GT[r0_ + 4 * dir + h], i1 = GT[r1_ + 4 * dir + h];
                const float f0 = logsigmoidf_(GT[r0_ + 8 + 4 * dir + h]), f1 = logsigmoidf_(GT[r1_ + 8 + 4 * dir + h]);
                float s0 = f0, s1 = f1;
#pragma unroll
                for (int o = 1; o < 64; o <<= 1) { const float u0 = __shfl_up(s0, o), u1 = __shfl_up(s1, o); if (lane >= o) { s0 += u0; s1 += u1; } }
                const float t0 = __shfl(s0, 63), t1 = __shfl(s1, 63);
                float b0, b1;
                if (dir == 0) { b0 = s0; b1 = t0 + s1; } else { b0 = t0 + t1 - s0 + f0; b1 = t1 - s1 + f1; }
                const float a0 = i0 - b0, a1 = i1 - b1;
                float x0 = a0, x1 = a1;
                if (dir == 0) {
#pragma unroll
                    for (int o = 1; o < 64; o <<= 1) { const float u0 = __shfl_up(x0, o), u1 = __shfl_up(x1, o); if (lane >= o) { x0 = fmaxf(x0, u0); x1 = fmaxf(x1, u1); } }
                    x1 = fmaxf(x1, __shfl(x0, 63));
                } else {
#pragma unroll
                    for (int o = 1; o < 64; o <<= 1) { const float u0 = __shfl_down(x0, o), u1 = __shfl_down(x1, o); if (lane + o < 64) { x0 = fmaxf(x0, u0); x1 = fmaxf(x1, u1); } }
                    x0 = fmaxf(x0, __shfl(x1, 0));
                }
                const float mp = dir == 0 ? mpf : mpb;
                LAS float* A_ = dir == 0 ? AF : AB; LAS float* C_ = dir == 0 ? CF : CB; LAS float* B_ = dir == 0 ? BF : BB;
                A_[lane] = a0; A_[lane + 64] = a1; C_[lane] = fmaxf(x0, mp); C_[lane + 64] = fmaxf(x1, mp); B_[lane] = b0; B_[lane + 64] = b1;
            }
        }
        __syncthreads();
        const bf16x8 bq0 = frag_row(Qimg, 16 * wave, 0, lane), bq1 = frag_row(Qimg, 16 * wave, 32, lane);
        f32x4 st[8];
#pragma unroll
        for (int kt = 0; kt < 8; ++kt) { f32x4 z = {0.f, 0.f, 0.f, 0.f}; z = mfma16(frag_row(Kimg, 16 * kt, 0, lane), bq0, z); st[kt] = mfma16(frag_row(Kimg, 16 * kt, 32, lane), bq1, z); }
        const int row = row0 + qi;
        if (KIND == 0) {
            const float lgf = logsigmoidf_(a.in[9][(l * 2 + 0) * 4 + h]), lgb = logsigmoidf_(a.in[9][(l * 2 + 1) * 4 + h]);
            f32x4 acc[4];
#pragma unroll
            for (int et = 0; et < 4; ++et) {
                f32x4 zf = {0.f, 0.f, 0.f, 0.f}, zb = zf;
                zf = mfma16(frag_row(SFimg, 16 * et, 0, lane), bq0, zf); zf = mfma16(frag_row(SFimg, 16 * et, 32, lane), bq1, zf);
                zb = mfma16(frag_row(SBimg, 16 * et, 0, lane), bq0, zb); zb = mfma16(frag_row(SBimg, 16 * et, 32, lane), bq1, zb);
                acc[et] = zf * __expf(lgf * (float)(qi + 1)) + zb * __expf(lgb * (float)(128 - qi));
            }
#pragma unroll
            for (int T = 0; T < 4; ++T) {
                f32x4 p0, p1;
#pragma unroll
                for (int j = 0; j < 4; ++j) {
                    const int k0 = 32 * T + 4 * g + j, k1 = k0 + 16;
                    const float w0 = (k0 <= qi ? __expf(lgf * (float)(qi - k0)) : 0.f) + (k0 >= qi ? __expf(lgb * (float)(k0 - qi)) : 0.f);
                    const float w1 = (k1 <= qi ? __expf(lgf * (float)(qi - k1)) : 0.f) + (k1 >= qi ? __expf(lgb * (float)(k1 - qi)) : 0.f);
                    p0[j] = st[2 * T][j] * w0; p1[j] = st[2 * T + 1][j] * w1;
                }
                const bf16x8 bp = pack8(p0, p1);
#pragma unroll
                for (int et = 0; et < 4; ++et) acc[et] = mfma16(frag_tr<true>(Vimg, 32 * T, 16 * et, lane), bp, acc[et]);
            }
            float ss = 0.f;
#pragma unroll
            for (int et = 0; et < 4; ++et) ss += (acc[et][0] * acc[et][0] + acc[et][1] * acc[et][1]) + (acc[et][2] * acc[et][2] + acc[et][3] * acc[et][3]);
            ss += __shfl_xor(ss, 16); ss += __shfl_xor(ss, 32);
            const float rs = rsqrtf(ss * (1.0f / 64.0f) + EPS);
#pragma unroll
            for (int et = 0; et < 4; ++et) { const int e0 = h * 64 + 16 * et + 4 * g;
                const u32x2 gw = *(const u32x2*)(P + (size_t)row * NPW + PC_RG + e0);
                u32x2 o; o.x = pk2(siluf_(bflo(gw.x)) * acc[et][0] * rs, siluf_(bfhi(gw.x)) * acc[et][1] * rs); o.y = pk2(siluf_(bflo(gw.y)) * acc[et][2] * rs, siluf_(bfhi(gw.y)) * acc[et][3] * rs);
                *(u32x2*)(MG + (size_t)row * DM + e0) = o; }
        } else {
            const float cf = CF[qi], cb = CB[qi];
            const float gf = __expf(mpf - cf), gb = __expf(mpb - cb);
            f32x4 af[5], ab[5];
#pragma unroll
            for (int et = 0; et < 5; ++et) {
                f32x4 zf = {0.f, 0.f, 0.f, 0.f}, zb = zf;
                zf = mfma16(frag_row(SFimg, 16 * et, 0, lane), bq0, zf); zf = mfma16(frag_row(SFimg, 16 * et, 32, lane), bq1, zf);
                zb = mfma16(frag_row(SBimg, 16 * et, 0, lane), bq0, zb); zb = mfma16(frag_row(SBimg, 16 * et, 32, lane), bq1, zb);
                af[et] = zf * gf; ab[et] = zb * gb;
            }
#pragma unroll
            for (int T = 0; T < 4; ++T) {
                const f32x4 a0f = *(const LAS f32x4*)(AF + 32 * T + 4 * g), a1f = *(const LAS f32x4*)(AF + 32 * T + 16 + 4 * g);
                const f32x4 a0b = *(const LAS f32x4*)(AB + 32 * T + 4 * g), a1b = *(const LAS f32x4*)(AB + 32 * T + 16 + 4 * g);
                f32x4 pf0, pf1, pb0, pb1;
#pragma unroll
                for (int j = 0; j < 4; ++j) {
                    const int k0 = 32 * T + 4 * g + j, k1 = k0 + 16;
                    pf0[j] = k0 <= qi ? st[2 * T][j] * __expf(a0f[j] - cf) : 0.f; pf1[j] = k1 <= qi ? st[2 * T + 1][j] * __expf(a1f[j] - cf) : 0.f;
                    pb0[j] = k0 >= qi ? st[2 * T][j] * __expf(a0b[j] - cb) : 0.f; pb1[j] = k1 >= qi ? st[2 * T + 1][j] * __expf(a1b[j] - cb) : 0.f;
                }
                const bf16x8 bpf = pack8(pf0, pf1), bpb = pack8(pb0, pb1);
#pragma unroll
                for (int et = 0; et < 5; ++et) { const bf16x8 va = frag_tr<true>(Vimg, 32 * T, 16 * et, lane); af[et] = mfma16(va, bpf, af[et]); ab[et] = mfma16(va, bpb, ab[et]); }
            }
            const float denf = __shfl(af[4][0], lane & 15), denb = __shfl(ab[4][0], lane & 15);
            const float nf = 1.0f / fmaxf(fabsf(denf), __expf(-(BF[qi] + cf))), nb = 1.0f / fmaxf(fabsf(denb), __expf(-(BB[qi] + cb)));
            f32x4 y[4]; float ss = 0.f;
#pragma unroll
            for (int et = 0; et < 4; ++et) { y[et] = af[et] * nf + ab[et] * nb; ss += (y[et][0] * y[et][0] + y[et][1] * y[et][1]) + (y[et][2] * y[et][2] + y[et][3] * y[et][3]); }
            ss += __shfl_xor(ss, 16); ss += __shfl_xor(ss, 32);
            const float rs = rsqrtf(ss * (1.0f / 64.0f) + EPS);
#pragma unroll
            for (int et = 0; et < 4; ++et) { const int e0 = h * 64 + 16 * et + 4 * g;
                const u32x2 gw = *(const u32x2*)(P + (size_t)row * NPW + PC_MO + e0);
                u32x2 o; o.x = pk2(sigmoidf_(bflo(gw.x)) * y[et][0] * rs, sigmoidf_(bfhi(gw.x)) * y[et][1] * rs); o.y = pk2(sigmoidf_(bflo(gw.y)) * y[et][2] * rs, sigmoidf_(bfhi(gw.y)) * y[et][3] * rs);
                *(u32x2*)(MG + (size_t)row * DM + 256 + e0) = o; }
        }
    }
}

__device__ __forceinline__ void phase_natt_mfma(const Args& a, int l, bool need_ctx, LAS unsigned char* lds, int tid, int lane, int wave, int bid, int G) {
    unsigned char* ws = a.ws;
    const bf16_t* P = (const bf16_t*)(ws + WS_BIG); bf16_t* MG = (bf16_t*)(ws + WS_H);
    LAS unsigned char* Qimg = lds; LAS unsigned char* Kimg = lds + 10240; LAS unsigned char* Vimg = lds + 51200;
    LAS float* RPB = (LAS float*)(lds + 92160); LAS float* XCH = (LAS float*)(lds + 94208);
    const int nlat = NB * 8 * NROWS, nitems = nlat + (need_ctx ? NB * 8 * 4 : 0);
    const int g = lane >> 4, qt = wave & 3, kh = wave >> 2, ql = 16 * qt + (lane & 15);
    for (int it = bid; it < nitems; it += G) {
        const bool lat = it < nlat; int b, h, r = 0, qrow0, sr = 0;
        if (lat) { r = it & 31; h = (it >> 5) & 7; b = it >> 8; qrow0 = b * SEQ + r * 64; sr = min(max(r - 4, 0), NROWS - 8); }
        else { const int j = it - nlat; const int qb = j & 3; h = (j >> 2) & 7; b = j >> 5; qrow0 = NLAT + b * CTXL + 64 * qb; }
        const int nblk = lat ? 3 : 1;
        __syncthreads();
        { const int rr = tid >> 3, c8 = (tid & 7) * 8; *(LAS u32x4*)(Qimg + rr * IST + c8 * 2) = *(const u32x4*)(P + (size_t)(qrow0 + rr) * NPW + PC_NQ + h * 64 + c8); }
        if (tid < 465) RPB[tid] = a.in[15][(size_t)(l * 8 + h) * 465 + tid];
        float m_run = -1.0e30f, l_run = 0.f; f32x4 acc[4];
#pragma unroll
        for (int et = 0; et < 4; ++et) acc[et] = (f32x4){0.f, 0.f, 0.f, 0.f};
        const int scq = min(max(ql - 8, 0), GRIDW - 16);
        const int tlo = min(max(16 * qt - 8, 0), 48), thi = min(max(16 * qt + 7, 0), 48) + 15;
        for (int blk = 0; blk < nblk; ++blk) {
            const bool local = lat && blk < 2;
            const int krow0 = local ? b * SEQ + sr * 64 + 256 * blk : NLAT + b * CTXL;
            if (blk > 0) __syncthreads();
            { const int rr = tid >> 1, c0 = (tid & 1) * 32; const bf16_t* ks = P + (size_t)(krow0 + rr) * NPW + PC_NK + h * 64 + c0; const bf16_t* vs = P + (size_t)(krow0 + rr) * NPW + PC_NV + h * 64 + c0;
#pragma unroll
              for (int i = 0; i < 4; ++i) { *(LAS u32x4*)(Kimg + rr * IST + (c0 + 8 * i) * 2) = *(const u32x4*)(ks + 8 * i); *(LAS u32x4*)(Vimg + rr * IST + (c0 + 8 * i) * 2) = *(const u32x4*)(vs + 8 * i); } }
            __syncthreads();
            const bf16x8 bq0 = frag_row(Qimg, 16 * qt, 0, lane), bq1 = frag_row(Qimg, 16 * qt, 32, lane);
            f32x4 s[8]; float mx = -1.0e30f;
#pragma unroll
            for (int kt = 0; kt < 8; ++kt) {
                const int tk = 8 * kh + kt, ct = tk & 3; const bool tv = !local || (16 * ct + 15 >= tlo && 16 * ct <= thi);
                if (tv) {
                    f32x4 z = {0.f, 0.f, 0.f, 0.f}; z = mfma16(frag_row(Kimg, 16 * tk, 0, lane), bq0, z); z = mfma16(frag_row(Kimg, 16 * tk, 32, lane), bq1, z);
                    if (local) { const int kk = 4 * blk + (tk >> 2); const LAS float* brow = RPB + (sr + kk - r + 7) * 31;
#pragma unroll
                        for (int j = 0; j < 4; ++j) { const int kcol = 16 * ct + 4 * g + j; const bool ok = kcol >= scq && kcol < scq + 16;
                            z[j] = ok ? z[j] * 0.125f + brow[min(max(kcol - ql + 15, 0), 30)] : -1.0e30f; }
                    } else z = z * 0.125f;
                    s[kt] = z; mx = fmaxf(mx, fmaxf(fmaxf(z[0], z[1]), fmaxf(z[2], z[3])));
                } else s[kt] = (f32x4){-1.0e30f, -1.0e30f, -1.0e30f, -1.0e30f};
            }
            mx = fmaxf(mx, __shfl_xor(mx, 16)); mx = fmaxf(mx, __shfl_xor(mx, 32));
            const float m_new = fmaxf(m_run, mx), resc = __expf(m_run - m_new);
            m_run = m_new; l_run *= resc;
#pragma unroll
            for (int et = 0; et < 4; ++et) acc[et] = acc[et] * resc;
#pragma unroll
            for (int T = 0; T < 4; ++T) {
                f32x4 p0, p1;
#pragma unroll
                for (int j = 0; j < 4; ++j) { p0[j] = s[2 * T][j] > -1.0e29f ? __expf(s[2 * T][j] - m_new) : 0.f; p1[j] = s[2 * T + 1][j] > -1.0e29f ? __expf(s[2 * T + 1][j] - m_new) : 0.f; }
                l_run += (p0[0] + p0[1]) + (p0[2] + p0[3]) + (p1[0] + p1[1]) + (p1[2] + p1[3]);
                const bf16x8 bp = pack8(p0, p1);
#pragma unroll
                for (int et = 0; et < 4; ++et) acc[et] = mfma16(frag_tr<true>(Vimg, 128 * kh + 32 * T, 16 * et, lane), bp, acc[et]);
            }
        }
        l_run += __shfl_xor(l_run, 16); l_run += __shfl_xor(l_run, 32);
        LAS float* xw = XCH + (qt * 64 + lane) * 18;
        if (kh == 1) { xw[0] = m_run; xw[1] = l_run;
#pragma unroll
            for (int et = 0; et < 4; ++et)
#pragma unroll
                for (int j = 0; j < 4; ++j) xw[2 + et * 4 + j] = acc[et][j]; }
        __syncthreads();
        if (kh == 0) {
            const float m1 = xw[0], l1 = xw[1]; const float mt = fmaxf(m_run, m1), f0 = __expf(m_run - mt), f1 = __expf(m1 - mt);
            const float inv = 1.0f / (l_run * f0 + l1 * f1);
            const int row = qrow0 + ql;
#pragma unroll
            for (int et = 0; et < 4; ++et) { float o[4];
#pragma unroll
                for (int j = 0; j < 4; ++j) o[j] = (acc[et][j] * f0 + xw[2 + et * 4 + j] * f1) * inv;
                u32x2 w; w.x = pk2(o[0], o[1]); w.y = pk2(o[2], o[3]);
                *(u32x2*)(MG + (size_t)row * DM + 512 + h * 64 + 16 * et + 4 * g) = w; }
        }
    }
}
#ifndef MIX_NAIVE
#define MIX_NAIVE 0
#endif
#ifndef MIX_RET
#define MIX_RET 1
#endif
#ifndef MIX_ML
#define MIX_ML 1
#endif
#ifndef MIX_NA
#define MIX_NA 1
#endif
#ifndef EN_PRO
#define EN_PRO 1
#endif
#ifndef EN_NORM
#define EN_NORM 1
#endif
#ifndef EN_GIN
#define EN_GIN 1
#endif
#ifndef EN_POST
#define EN_POST 1
#endif
#ifndef EN_FCUM
#define EN_FCUM 1
#endif
#ifndef EN_QUAD
#define EN_QUAD 1
#endif
#ifndef EN_NATT
#define EN_NATT 1
#endif
#ifndef EN_MERGE
#define EN_MERGE 1
#endif
#ifndef EN_GOUT
#define EN_GOUT 1
#endif
#ifndef EN_NORM2
#define EN_NORM2 1
#endif
#ifndef EN_GUP
#define EN_GUP 1
#endif
#ifndef EN_GDN
#define EN_GDN 1
#endif

__global__ void __launch_bounds__(NTHR, 2) fwd_kernel(Args a) {
    extern __shared__ __attribute__((aligned(16))) unsigned char lds_raw[];
    LAS unsigned char* lds = (LAS unsigned char*)lds_raw;
    const int tid0 = threadIdx.x, G = gridDim.x, bid = blockIdx.x;
    unsigned char* ws = a.ws;
    volatile LAS unsigned* MISC = (volatile LAS unsigned*)(lds + MISC_OFF);
    if (tid0 < 32) MISC[tid0] = 0u;
    __syncthreads();
    const int lo = a.ph_lo, hi = a.ph_hi;
    XcdBarrier bar; bar.bar = (unsigned*)(ws + WS_CTL) + CW_BAR; bar.x = 0; bar.st = MISC + 8;
    if (hi - lo > 1) bar = xcd_barrier_post((unsigned*)(ws + WS_CTL) + CW_BAR, MISC + 8);
    int ph = 0;
#define PH_BEGIN if (ph >= lo && ph < hi) { asm volatile("; PHMARK_BEGIN %0" :: "i"(__LINE__)); int tid = tid0; asm volatile("" : "+v"(tid)); const int lane = tid & 63, wave = __builtin_amdgcn_readfirstlane(tid >> 6); (void)lane; (void)wave;
#define PH_END   asm volatile("; PHMARK_END %0" :: "i"(__LINE__)); if (ph + 1 < hi) xcd_barrier(bar); else __syncthreads(); } ++ph;

    PH_BEGIN
#if EN_PRO
 phase_prologue(a, lds, tid, lane, wave, bid, G);
#endif
 PH_END

    for (int l = 0; l < 2; ++l) {
        const bool need_ctx = (l == 0);
        const float* mod = (const float*)(ws + WS_MOD) + (size_t)l * 9 * 6144;
        PH_BEGIN
#if EN_NORM
 phase_norm<0>(a, l, lds, tid, lane, wave, bid, G);
#endif
 PH_END
        PH_BEGIN
#if EN_GIN
 { pg8::Gemm g{(const bf16_t*)(ws + WS_H), (const bf16_t*)(ws + WS_WTIN) + (size_t)l * NPW * DM, MALL, NPW, DM};
                   pg8::StaticOrder S; S.init(MALL, NPW, G, bid); pg8::EpiBf16 E{(bf16_t*)(ws + WS_BIG), NPW};
                   pg8::gemm_phase<pg8::EpiBf16, pg8::StaticOrder, false>(lds, g, S, E, nullptr); }
#endif
 PH_END
        PH_BEGIN
#if EN_POST
 phase_post(a, l, lane, wave, bid, G);
#endif
 PH_END
#if MIX_NAIVE
        PH_BEGIN phase_fcum(a, lane, wave, bid, G); PH_END
        PH_BEGIN phase_quad(a, l, need_ctx, lds, lane, wave, bid, G); phase_natt(a, l, need_ctx, lds, lane, wave, bid, G); PH_END
        PH_BEGIN phase_merge(a, need_ctx, lane, wave, bid, G); PH_END
#endif
        PH_BEGIN
#if MIX_RET || MIX_ML
        phase_chunk_sums(a, l, lds, tid, lane, wave, bid, G);
#endif
        PH_END
        PH_BEGIN
#if MIX_RET
        phase_chunk_out<0>(a, l, need_ctx, lds, tid, lane, wave, bid, G);
#endif
#if MIX_ML
        phase_chunk_out<1>(a, l, need_ctx, lds, tid, lane, wave, bid, G);
#endif
#if MIX_NA
        phase_natt_mfma(a, l, need_ctx, lds, tid, lane, wave, bid, G);
#endif
        PH_END
        PH_BEGIN
#if EN_GOUT
 { const int M = need_ctx ? MALL : NLAT;
                   pg8::Gemm g{(const bf16_t*)(ws + WS_H), (const bf16_t*)(ws + WS_WTOUT) + (size_t)l * DM * DM, M, DM, DM};
                   pg8::StaticOrder S; S.init(M, DM, G, bid);
                   pg8::EpiResid E{l == 0 ? a.in[0] : a.out, l == 0 ? a.in[2] : (const float*)(ws + WS_XC), a.out, (float*)(ws + WS_XC), mod + 2048, nullptr, 0, NLAT / 256};
                   pg8::gemm_phase<pg8::EpiResid, pg8::StaticOrder, false>(lds, g, S, E, nullptr); }
#endif
 PH_END
        if (l == 0) { PH_BEGIN
#if EN_NORM2
 phase_norm<1>(a, l, lds, tid, lane, wave, bid, G);
#endif
 PH_END }
        else        { PH_BEGIN
#if EN_NORM2
 phase_norm<2>(a, l, lds, tid, lane, wave, bid, G);
#endif
 PH_END }
        const int ne = (l == 0) ? 1 : NEXP;
        for (int e = 0; e < ne; ++e) {
            const int M = need_ctx ? MALL : NLAT;
            PH_BEGIN
#if EN_GUP
 { const bf16_t* Bt = (l == 0) ? (const bf16_t*)(ws + WS_WTUP) : (const bf16_t*)(ws + WS_WTMUP) + (size_t)e * NUP * DM;
                       pg8::Gemm g{(const bf16_t*)(ws + WS_H), Bt, M, NUP, DM};
                       pg8::StaticOrder S; S.init(M, NUP, G, bid); pg8::EpiSwiGLU E{(bf16_t*)(ws + WS_BIG), DFF};
                       pg8::gemm_phase<pg8::EpiSwiGLU, pg8::StaticOrder, false>(lds, g, S, E, nullptr); }
#endif
 PH_END
            PH_BEGIN
#if EN_GDN
 { const bf16_t* Bt = (l == 0) ? (const bf16_t*)(ws + WS_WTDN) : (const bf16_t*)(ws + WS_WTMDN) + (size_t)e * DM * DFF;
                       pg8::Gemm g{(const bf16_t*)(ws + WS_BIG), Bt, M, DM, DFF};
                       pg8::StaticOrder S; S.init(M, DM, G, bid);
                       pg8::EpiResid E{a.out, (const float*)(ws + WS_XC), a.out, (float*)(ws + WS_XC), mod + 5120, (l == 0) ? nullptr : (const float*)(ws + WS_COMB) + e, 8, NLAT / 256};
                       pg8::gemm_phase<pg8::EpiResid, pg8::StaticOrder, false>(lds, g, S, E, nullptr); }
#endif
 PH_END
        }
    }
#undef PH_BEGIN
#undef PH_END
}
constexpr int N_PHASES = 1 + 2 * (7 + (MIX_NAIVE ? 3 : 0)) + 2 + 16;
#ifndef DBG_MAXPH
#define DBG_MAXPH 1000
#endif

extern "C" void kernel_launch(void* const* d_in, const int* in_sizes, int n_in, void* d_out, int out_size, void* d_ws, size_t ws_size, hipStream_t stream) {
    static int grid = 0;
    if (grid == 0) {
        if (n_in != 24 || out_size != NLAT * DM || ws_size < WS_END) { fprintf(stderr, "kernel_launch: unexpected sizes (n_in %d, out %d, ws %zu < %zu); nothing launched\n", n_in, out_size, ws_size, (size_t)WS_END); grid = -1; return; }
        int dev = 0, cus = 0;
        if (hipGetDevice(&dev) != hipSuccess || hipDeviceGetAttribute(&cus, hipDeviceAttributeMultiprocessorCount, dev) != hipSuccess) { grid = -1; return; }
        if (hipFuncSetAttribute((const void*)fwd_kernel, hipFuncAttributeMaxDynamicSharedMemorySize, LDS_BYTES) != hipSuccess) { fprintf(stderr, "kernel_launch: hipFuncSetAttribute failed\n"); grid = -1; return; }
        int per_cu = 0;
        if (hipOccupancyMaxActiveBlocksPerMultiprocessor(&per_cu, (const void*)fwd_kernel, NTHR, LDS_BYTES) != hipSuccess || per_cu < 1) { fprintf(stderr, "kernel_launch: occupancy query says %d\n", per_cu); }
        (void)hipGetLastError();
        grid = cus;
    }
    if (grid < 0) return;
    (void)hipMemsetAsync((char*)d_ws + WS_CTL, 0, CTL_BYTES, stream);
    Args a{};
    for (int i = 0; i < 24; ++i) a.in[i] = (const float*)d_in[i];
    a.out = (float*)d_out; a.ws = (unsigned char*)d_ws;
#if N_LAUNCH_MODE == 0
    a.ph_lo = 0; a.ph_hi = N_PHASES;
    hipLaunchKernelGGL(fwd_kernel, dim3(grid), dim3(NTHR), LDS_BYTES, stream, a);
#else
    for (int p = 0; p < N_PHASES && p < DBG_MAXPH; ++p) { a.ph_lo = p; a.ph_hi = p + 1; hipLaunchKernelGGL(fwd_kernel, dim3(grid), dim3(NTHR), LDS_BYTES, stream, a); }
#endif
}
```

```cpp
#include <hip/hip_runtime.h>
#include <stdio.h>
#include <stdint.h>

#ifndef N_LAUNCH_MODE
#define N_LAUNCH_MODE 0
#endif

constexpr int NB = 8, SEQ = 2048, DM = 1024, CTXL = 256, HD = 64;
constexpr int NLAT = NB * SEQ, NCTX = NB * CTXL, MALL = NLAT + NCTX;
constexpr int DIN = 3600, NPW = 3584;
constexpr int DFF = 2816, NUP = 2 * DFF, NEXP = 8;
constexpr int GRIDW = 64, NROWS = 32;
constexpr float EPS = 1e-6f;
constexpr int PC_RQ = 0, PC_RK = 256, PC_RV = 512, PC_RG = 768, PC_MQ = 1024, PC_MK = 1280, PC_MV = 1536, PC_MO = 1792, PC_NQ = 2048, PC_NK = 2560, PC_NV = 3072;

constexpr size_t al256(size_t x) { return (x + 255) & ~(size_t)255; }
constexpr size_t WS_CTL = 0, CTL_BYTES = 1u << 20;
constexpr size_t WS_MOD = WS_CTL + CTL_BYTES;
constexpr size_t WS_ROPE = WS_MOD + al256((size_t)2 * 9 * 6144 * 4);
constexpr size_t WS_WTIN = WS_ROPE + al256(64 * 16 * 2 * 4);
constexpr size_t WS_WTOUT = WS_WTIN + (size_t)2 * NPW * DM * 2;
constexpr size_t WS_WTUP = WS_WTOUT + (size_t)2 * DM * DM * 2;
constexpr size_t WS_WTDN = WS_WTUP + (size_t)NUP * DM * 2;
constexpr size_t WS_WTMUP = WS_WTDN + (size_t)DM * DFF * 2;
constexpr size_t WS_WTMDN = WS_WTMUP + (size_t)NEXP * NUP * DM * 2;
constexpr size_t WS_H = WS_WTMDN + (size_t)NEXP * DM * DFF * 2;
constexpr size_t WS_XC = WS_H + (size_t)MALL * DM * 2;
constexpr size_t WS_GATES = WS_XC + (size_t)NCTX * DM * 4;
constexpr size_t WS_COMB = WS_GATES + (size_t)MALL * 16 * 4;
constexpr size_t WS_FCUM = WS_COMB + (size_t)NLAT * 8 * 4;
constexpr size_t WS_BIG = WS_FCUM + al256((size_t)NB * 4 * 2 * 2304 * 4);
constexpr size_t WS_MQK = WS_BIG + (size_t)MALL * NPW * 2;
constexpr size_t WS_RETY = WS_MQK + (size_t)MALL * 512 * 2;
constexpr size_t WS_MLY = WS_RETY + (size_t)MALL * 256 * 4;
constexpr size_t WS_NAY = WS_MLY + (size_t)MALL * 256 * 4;
constexpr size_t WS_U = WS_NAY + (size_t)MALL * 512 * 2;
constexpr size_t WS_USC = WS_U + (size_t)2 * NB * 4 * 2 * 18 * 80 * 64 * 2;
constexpr size_t WS_LIST = WS_USC + al256((size_t)NB * 4 * 2 * 18 * 2 * 4);
constexpr size_t WS_END0 = WS_LIST + (size_t)NEXP * NLAT * 4;
constexpr size_t MOE_ROWS = 34816;
constexpr size_t WS_ACTM_END = WS_BIG + MOE_ROWS * DFF * 2;
constexpr size_t WS_END = WS_END0 > WS_ACTM_END ? WS_END0 : WS_ACTM_END;
constexpr size_t WS_UNUSED_ = WS_USC + al256((size_t)NB * 4 * 2 * 18 * 2 * 4);

typedef unsigned short bf16_t;
typedef float f32x4 __attribute__((ext_vector_type(4)));
typedef float f32x2 __attribute__((ext_vector_type(2)));
typedef unsigned u32x4 __attribute__((ext_vector_type(4)));
typedef unsigned u32x2 __attribute__((ext_vector_type(2)));
#define LAS __attribute__((address_space(3)))
#define GAS __attribute__((address_space(1)))

__device__ __forceinline__ float bf2f(bf16_t b) { return __uint_as_float(((unsigned)b) << 16); }
__device__ __forceinline__ unsigned f2bf(float f) { unsigned u = __float_as_uint(f); return (u + 0x7fffu + ((u >> 16) & 1u)) >> 16; }
__device__ __forceinline__ unsigned pk2(float lo, float hi) { return f2bf(lo) | (f2bf(hi) << 16); }
__device__ __forceinline__ float bflo(unsigned w) { return __uint_as_float(w << 16); }
__device__ __forceinline__ float bfhi(unsigned w) { return __uint_as_float(w & 0xffff0000u); }
__device__ __forceinline__ float sigmoidf_(float x) { return 1.0f / (1.0f + __expf(-x)); }
__device__ __forceinline__ float siluf_(float x) { return x / (1.0f + __expf(-x)); }
__device__ __forceinline__ float logsigmoidf_(float x) { return fminf(x, 0.f) - log1pf(__expf(-fabsf(x))); }
template <int O> __device__ __forceinline__ float swz_xor(float v) { return __int_as_float(__builtin_amdgcn_ds_swizzle(__float_as_int(v), (O << 10) | 0x1f)); }
__device__ __forceinline__ float red32_sum(float v) { const auto r = __builtin_amdgcn_permlane32_swap(__float_as_uint(v), __float_as_uint(v), false, false); return __uint_as_float(r[0]) + __uint_as_float(r[1]); }
__device__ __forceinline__ float red32_max(float v) { const auto r = __builtin_amdgcn_permlane32_swap(__float_as_uint(v), __float_as_uint(v), false, false); return fmaxf(__uint_as_float(r[0]), __uint_as_float(r[1])); }
__device__ __forceinline__ float wave_sum(float v) { v += swz_xor<1>(v); v += swz_xor<2>(v); v += swz_xor<4>(v); v += swz_xor<8>(v); v += swz_xor<16>(v); return red32_sum(v); }
__device__ __forceinline__ float wave_max(float v) { v = fmaxf(v, swz_xor<1>(v)); v = fmaxf(v, swz_xor<2>(v)); v = fmaxf(v, swz_xor<4>(v)); v = fmaxf(v, swz_xor<8>(v)); v = fmaxf(v, swz_xor<16>(v)); return red32_max(v); }
__device__ __forceinline__ float sum_g4(float v) { v += swz_xor<16>(v); return red32_sum(v); }
__device__ __forceinline__ float max_g4(float v) { v = fmaxf(v, swz_xor<16>(v)); return red32_max(v); }
__device__ __forceinline__ float lane_get(float v, int src_lane) { return __int_as_float(__builtin_amdgcn_ds_bpermute(src_lane << 2, __float_as_int(v))); }
__device__ __forceinline__ float lane_bcast(float v, int k) { return __int_as_float(__builtin_amdgcn_readlane(__float_as_int(v), k)); }

struct Args {
    const float* in[24];
    float* out;
    unsigned char* ws;
    int ph_lo, ph_hi;
};
namespace pg8 {
#define PG8_LAS __attribute__((address_space(3)))
typedef unsigned short bf16_t;
typedef short bf16x8 __attribute__((ext_vector_type(8)));
typedef float f32x4 __attribute__((ext_vector_type(4)));
typedef unsigned u32x4 __attribute__((ext_vector_type(4)));
constexpr int BM = 256, BK = 64, HALF = 128, HTB = HALF * BK * 2  , STAGE_BYTES = 8 * HTB, NXCD = 8, WGM = 8;

__host__ __device__ __forceinline__ int lds_byte(int r, int c) { const int st = (r >> 4) * 2 + (c >> 5), rr = r & 15, cc = c & 31, ob = rr * 64 + cc * 2; return st * 1024 + (ob ^ (((ob >> 9) & 1) << 5)); }
__host__ __device__ __forceinline__ void stage_rc(int b, int& R, int& C) { const int st = b / 1024, sb = b % 1024, swz = sb ^ (((sb >> 9) & 1) << 5); R = (st >> 1) * 16 + swz / 64; C = (st & 1) * 32 + (swz % 64) / 2; }
__host__ __device__ __forceinline__ int perm32(int rho) { const int n = rho >> 4, i = rho & 15; return 8 * (i >> 2) + 4 * n + (i & 3); }

struct Unit { int pm, pn; };
struct Gemm { const bf16_t* A; const bf16_t* Bt; int M, N, K; };

struct StaticOrder {
    int nM, nN, nwg, G, c;
    __host__ __device__ void init(int M, int N, int G_, int c_) { nM = M / BM; nN = N / BM; nwg = nM * nN; G = G_; c = c_; }
    __host__ __device__ bool next(int i, Unit& u) const {
        const long L = (long)i * G + c; if (L >= nwg) return false;
        int wgid = (int)L; { const int q = nwg / NXCD, r = nwg % NXCD, xcd = wgid % NXCD, off = wgid / NXCD; wgid = (xcd < r ? xcd * (q + 1) : r * (q + 1) + (xcd - r) * q) + off; }
        const int nig = WGM * nN, gid = wgid / nig, fm = gid * WGM, gsz = (nM - fm) < WGM ? (nM - fm) : WGM;
        u.pm = fm + ((wgid % nig) % gsz); u.pn = (wgid % nig) / gsz; return true;
    }
    __device__ __forceinline__ void a_ready(const Unit&) const {}
    __device__ __forceinline__ void done(const Unit&) const {}
    const char* Bt; int K2;
    __device__ __forceinline__ unsigned arow(const Unit& u, int R) const { return (unsigned)(u.pm * BM + R); }
    __device__ __forceinline__ const char* bbase(const Unit& u) const { return Bt + (size_t)u.pn * BM * K2; }
};
__device__ __forceinline__ unsigned cvt_pk_bf16(float lo, float hi) { unsigned r; asm volatile("v_cvt_pk_bf16_f32 %0, %1, %2" : "=v"(r) : "v"(lo), "v"(hi)); return r; }
typedef float f32x2 __attribute__((ext_vector_type(2)));
struct EpiBf16 {
    static constexpr bool PERM = true, AFTER_DRAIN = false;
    bf16_t* O; int ldc;
    __device__ __forceinline__ void operator()(const f32x4 (&acc)[2][2][4][2], const Unit& u, int wr, int wc, int fr, int fq) const {
        const int row0 = u.pm * BM + wr * 64 + fr, col0 = u.pn * BM + wc * 32 + 8 * fq;
#pragma unroll
        for (int ai = 0; ai < 2; ++ai)
#pragma unroll
            for (int m = 0; m < 4; ++m) { bf16_t* rowp = O + (size_t)(row0 + ai * HALF + m * 16) * ldc + col0;
#pragma unroll
                for (int bj = 0; bj < 2; ++bj) { const f32x4 v0 = acc[ai][bj][m][0], v1 = acc[ai][bj][m][1];
                    u32x4 w; w.x = cvt_pk_bf16(v0[0], v0[1]); w.y = cvt_pk_bf16(v0[2], v0[3]); w.z = cvt_pk_bf16(v1[0], v1[1]); w.w = cvt_pk_bf16(v1[2], v1[3]);
                    *(u32x4*)(rowp + bj * HALF) = w; } }
    }
};
struct EpiSwiGLU {
    static constexpr bool PERM = true, AFTER_DRAIN = false;
    bf16_t* O; int ldc;
    __device__ __forceinline__ void operator()(const f32x4 (&acc)[2][2][4][2], const Unit& u, int wr, int wc, int fr, int fq) const {
        const int row0 = u.pm * BM + wr * 64 + fr, col0 = u.pn * HALF + wc * 32 + 8 * fq;
#pragma unroll
        for (int ai = 0; ai < 2; ++ai)
#pragma unroll
            for (int m = 0; m < 4; ++m) { bf16_t* rowp = O + (size_t)(row0 + ai * HALF + m * 16) * ldc + col0;
                float r[8];
#pragma unroll
                for (int n = 0; n < 2; ++n)
#pragma unroll
                    for (int j = 0; j < 4; ++j) { const float g = acc[ai][0][m][n][j], uu = acc[ai][1][m][n][j]; r[n * 4 + j] = g / (1.0f + __expf(-g)) * uu; }
                u32x4 w; w.x = cvt_pk_bf16(r[0], r[1]); w.y = cvt_pk_bf16(r[2], r[3]); w.z = cvt_pk_bf16(r[4], r[5]); w.w = cvt_pk_bf16(r[6], r[7]);
                *(u32x4*)rowp = w; }
    }
};
struct EpiResid {
    static constexpr bool PERM = false, AFTER_DRAIN = false;
    const float* base_lat; const float* base_ctx; float* out_lat; float* out_ctx; const float* gate; const float* comb; int comb_ld; int nlat_tiles;
    __device__ __forceinline__ void operator()(const f32x4 (&acc)[2][2][4][2], const Unit& u, int wr, int wc, int fr, int fq) const {
        const bool isctx = u.pm >= nlat_tiles;
        const int rloc0 = (isctx ? (u.pm - nlat_tiles) : u.pm) * BM + wr * 64 + fr, col0 = u.pn * BM + wc * 32 + 4 * fq;
        const float* bp = isctx ? base_ctx : base_lat; float* op = isctx ? out_ctx : out_lat;
        const float* gp = gate + (size_t)(isctx ? 8 : (u.pm >> 3)) * 6144 + col0;
        f32x4 gv[2][2];
#pragma unroll
        for (int bj = 0; bj < 2; ++bj)
#pragma unroll
            for (int n = 0; n < 2; ++n) gv[bj][n] = *(const f32x4*)(gp + bj * HALF + n * 16);
#pragma unroll
        for (int ai = 0; ai < 2; ++ai)
#pragma unroll
            for (int m = 0; m < 4; ++m) { const int rl = rloc0 + ai * HALF + m * 16; const size_t off = (size_t)rl * 1024 + col0;
                const float cs = comb ? comb[(size_t)rl * comb_ld] : 1.0f;
#pragma unroll
                for (int bj = 0; bj < 2; ++bj)
#pragma unroll
                    for (int n = 0; n < 2; ++n) { const f32x4 bs = *(const f32x4*)(bp + off + bj * HALF + n * 16);
                        *(f32x4*)(op + off + bj * HALF + n * 16) = bs + gv[bj][n] * acc[ai][bj][m][n] * cs; } }
    }
};
template <class Epi, class Sched, bool STAMP = false>
__device__ __forceinline__ void gemm_phase(PG8_LAS unsigned char* lds, const Gemm g, const Sched& S, const Epi& E, unsigned long long* stamps, int tid_in) {
    int tid_ = tid_in; asm volatile("" : "+v"(tid_)); const int tid = tid_, wid = __builtin_amdgcn_readfirstlane(tid >> 6), lane = tid & 63, wr = wid >> 2, wc = wid & 3, fr = lane & 15, fq = lane >> 4;
    const int K = g.K, nt = K / BK;
    int ts_lo = 0, ts_hi = 0, nts = 0; const unsigned long long rt_entry = STAMP ? (unsigned long long)wall_clock64() : 0ull;
#define PG8_STAMP() do { if (STAMP && wid == 0 && nts < 64) { const unsigned long long _c = (unsigned long long)clock64(); \
        ts_lo = (lane == nts) ? (int)(unsigned)_c : ts_lo; ts_hi = (lane == nts) ? (int)(unsigned)(_c >> 32) : ts_hi; ++nts; } } while (0)
    PG8_STAMP();
    unsigned voffB[2]; int stR[2]; unsigned stC[2];
#pragma unroll
    for (int i = 0; i < 2; ++i) { int R, C; stage_rc(tid * 16 + i * 8192, R, C); const int Rb = Epi::PERM ? ((R & ~31) + perm32(R & 31)) : R;
        stR[i] = R; stC[i] = (unsigned)C * 2u; voffB[i] = (unsigned)(Rb * K + C) * 2u; }
    unsigned vAc0[2], vAc1[2], vAn0[2], vAn1[2];
#define PG8_AROWS(u, d0, d1) do { _Pragma("unroll") for (int _i = 0; _i < 2; ++_i) { d0[_i] = S.arow(u, stR[_i]) * (unsigned)(K * 2) + stC[_i]; d1[_i] = S.arow(u, HALF + stR[_i]) * (unsigned)(K * 2) + stC[_i]; } } while (0)
    const size_t kstep = (size_t)(BK * 2);
    const size_t hstep = (size_t)HALF * K * 2;
    const size_t tstep = 2 * hstep;
    const unsigned ldsw = (unsigned)wid * 1024u;
    const int aoff = lds_byte(wr * 64 + fr, fq * 8), boff = lds_byte(wc * 32 + fr, fq * 8);
#define PG8_SA(b, h) (((b) * 2 + (h)) * HTB)
#define PG8_SB(b, h) ((4 + (b) * 2 + (h)) * HTB)
#define PG8_STAGE(bufoff, gbase, voff) do { _Pragma("unroll") for (int _i = 0; _i < 2; ++_i) \
        __builtin_amdgcn_global_load_lds((const unsigned*)((const char*)(gbase) + (voff)[_i]), (PG8_LAS unsigned*)(lds + (bufoff) + ldsw + _i * 8192), 16, 0, 0); } while (0)
#define PG8_LDA(dst, b, h) do { _Pragma("unroll") for (int m = 0; m < 4; ++m) _Pragma("unroll") for (int k = 0; k < 2; ++k) dst[m][k] = *(const PG8_LAS bf16x8*)(lds + PG8_SA(b, h) + aoff + m * 2048 + k * 1024); } while (0)
#define PG8_LDB(dst, b, h) do { _Pragma("unroll") for (int n = 0; n < 2; ++n) _Pragma("unroll") for (int k = 0; k < 2; ++k) dst[n][k] = *(const PG8_LAS bf16x8*)(lds + PG8_SB(b, h) + boff + n * 2048 + k * 1024); } while (0)
#define PG8_MMA(ai, bj, At, Bt) do { __builtin_amdgcn_s_setprio(1); _Pragma("unroll") for (int m = 0; m < 4; ++m) _Pragma("unroll") for (int n = 0; n < 2; ++n) _Pragma("unroll") for (int k = 0; k < 2; ++k) \
        acc[ai][bj][m][n] = __builtin_amdgcn_mfma_f32_16x16x32_bf16(Bt[n][k], At[m][k], acc[ai][bj][m][n], 0, 0, 0); __builtin_amdgcn_s_setprio(0); } while (0)
#define PG8_WAIT_V(n) asm volatile("s_waitcnt vmcnt(" #n ")" ::: "memory")
#define PG8_WAIT_L(n) asm volatile("s_waitcnt lgkmcnt(" #n ")" ::: "memory")
#define PG8_BAR __builtin_amdgcn_s_barrier()
#define PG8_SCHED __builtin_amdgcn_sched_barrier(0)
    Unit cur, nxt; int ui = 0;
    if (!S.next(0, cur)) return;
    f32x4 acc[2][2][4][2];
#pragma unroll
    for (int a = 0; a < 2; ++a)
#pragma unroll
        for (int b = 0; b < 2; ++b)
#pragma unroll
            for (int m = 0; m < 4; ++m)
#pragma unroll
                for (int n = 0; n < 2; ++n) acc[a][b][m][n] = (f32x4){0.f, 0.f, 0.f, 0.f};
    bf16x8 At[4][2], B0[2][2], B1[2][2];
    const char* const cA = (const char*)g.A; const char* cB = S.bbase(cur);
    PG8_AROWS(cur, vAc0, vAc1);
    S.a_ready(cur);
    PG8_STAGE(PG8_SB(0, 0), cB, voffB); PG8_STAGE(PG8_SA(0, 0), cA, vAc0); PG8_STAGE(PG8_SB(0, 1), cB + hstep, voffB); PG8_STAGE(PG8_SA(0, 1), cA, vAc1);
    if (wr == 1) PG8_BAR;
    PG8_WAIT_V(4); PG8_BAR;
    PG8_STAGE(PG8_SB(1, 0), cB + kstep, voffB); PG8_STAGE(PG8_SA(1, 0), cA + kstep, vAc0); PG8_STAGE(PG8_SB(1, 1), cB + hstep + kstep, voffB);
    PG8_WAIT_V(6); PG8_BAR;
    PG8_STAMP();
    for (;;) {
        const bool has_next = S.next(ui + 1, nxt);
        const char* nB = has_next ? S.bbase(nxt) : cB;
        if (has_next) PG8_AROWS(nxt, vAn0, vAn1); else { _Pragma("unroll") for (int _i = 0; _i < 2; ++_i) { vAn0[_i] = vAc0[_i]; vAn1[_i] = vAc1[_i]; } }
        for (int t = 0; t < nt; t += 2) {
            const bool last = (t == nt - 2);
            const char* a1 = cA + (size_t)(t + 1) * kstep;
            const char* a2 = last ? cA : cA + (size_t)(t + 2) * kstep; const char* b2 = last ? nB : cB + (size_t)(t + 2) * kstep;
            const char* a3 = a2 + kstep; const char* b3 = b2 + kstep;
            unsigned v20[2], v21[2];
#pragma unroll
            for (int _i = 0; _i < 2; ++_i) { v20[_i] = last ? vAn0[_i] : vAc0[_i]; v21[_i] = last ? vAn1[_i] : vAc1[_i]; }
            if (last && has_next) S.a_ready(nxt);
            PG8_LDB(B0, 0, 0); PG8_SCHED; PG8_LDA(At, 0, 0); PG8_STAGE(PG8_SA(1, 1), a1, vAc1);
            PG8_WAIT_L(8); PG8_BAR; PG8_WAIT_L(0); PG8_MMA(0, 0, At, B0); PG8_BAR; PG8_SCHED;
            PG8_LDB(B1, 0, 1); PG8_STAGE(PG8_SB(0, 0), b2, voffB);
            PG8_BAR; PG8_WAIT_L(0); PG8_MMA(0, 1, At, B1); PG8_BAR;
            PG8_LDA(At, 0, 1); PG8_STAGE(PG8_SA(0, 0), a2, v20);
            PG8_BAR; PG8_WAIT_L(0); PG8_MMA(1, 0, At, B0); PG8_BAR; PG8_SCHED;
            PG8_STAGE(PG8_SB(0, 1), b2 + hstep, voffB);
            PG8_WAIT_V(6); PG8_BAR; PG8_MMA(1, 1, At, B1); PG8_BAR;
            PG8_LDB(B0, 1, 0); PG8_SCHED; PG8_LDA(At, 1, 0); PG8_STAGE(PG8_SA(0, 1), a2, v21);
            PG8_WAIT_L(8); PG8_BAR; PG8_WAIT_L(0); PG8_MMA(0, 0, At, B0); PG8_BAR; PG8_SCHED;
            PG8_LDB(B1, 1, 1); PG8_STAGE(PG8_SB(1, 0), b3, voffB);
            PG8_BAR; PG8_WAIT_L(0); PG8_MMA(0, 1, At, B1); PG8_BAR;
            PG8_LDA(At, 1, 1); PG8_STAGE(PG8_SA(1, 0), a3, v20);
            PG8_BAR; PG8_WAIT_L(0); PG8_MMA(1, 0, At, B0); PG8_BAR; PG8_SCHED;
            PG8_STAGE(PG8_SB(1, 1), b3 + hstep, voffB);
            PG8_WAIT_V(6); PG8_BAR; PG8_MMA(1, 1, At, B1); PG8_BAR;
        }
        PG8_STAMP();
        if constexpr (!Epi::AFTER_DRAIN) { E(acc, cur, wr, wc, fr, fq); S.done(cur); }
        PG8_STAMP();
        if (!has_next) break;
#pragma unroll
        for (int a = 0; a < 2; ++a)
#pragma unroll
            for (int b = 0; b < 2; ++b)
#pragma unroll
                for (int m = 0; m < 4; ++m)
#pragma unroll
                    for (int n = 0; n < 2; ++n) acc[a][b][m][n] = (f32x4){0.f, 0.f, 0.f, 0.f};
        cur = nxt; cB = nB; ++ui;
#pragma unroll
        for (int _i = 0; _i < 2; ++_i) { vAc0[_i] = vAn0[_i]; vAc1[_i] = vAn1[_i]; }
    }
    PG8_WAIT_V(0);
    if (wr == 0) PG8_BAR;
    PG8_BAR;
    if constexpr (Epi::AFTER_DRAIN) { E.fused(acc, cur, wr, wc, fr, fq, lds, wid, lane); S.done(cur); }
    PG8_STAMP();
    if (STAMP && wid == 0) { stamps[lane] = lane < nts ? (((unsigned long long)(unsigned)ts_hi << 32) | (unsigned)ts_lo) : 0ull;
        if (lane == 62) stamps[62] = rt_entry; if (lane == 63) stamps[63] = (unsigned long long)wall_clock64(); }
#undef PG8_STAMP
#undef PG8_SA
#undef PG8_AROWS
#undef PG8_SB
#undef PG8_STAGE
#undef PG8_LDA
#undef PG8_LDB
#undef PG8_MMA
#undef PG8_WAIT_V
#undef PG8_WAIT_L
#undef PG8_BAR
#undef PG8_SCHED
}
}
#define XB_TMO      128
#define XB_XCNT(j)  (256  + 64 * (j))
#define XB_XSUB(j)  (1280 + 64 * (j))
#define XB_XGEN(j)  (2304 + 64 * (j))
#define XB_TOP      3328
#define XB_TOPGEN   3392
#define XCD_BAR_WORDS 3456
#define XB_SPIN_CAP (1u << 24)

__device__ __forceinline__ unsigned xb_ld(unsigned* p)              { return __hip_atomic_load(p, __ATOMIC_RELAXED, __HIP_MEMORY_SCOPE_AGENT); }
__device__ __forceinline__ unsigned xb_add(unsigned* p, unsigned v) { return __hip_atomic_fetch_add(p, v, __ATOMIC_RELAXED, __HIP_MEMORY_SCOPE_AGENT); }
__device__ __forceinline__ unsigned xb_xcc_id() { return (unsigned)__builtin_amdgcn_s_getreg((3 << 11) | 20) & 0xFu; }
#define XB_SPIN(cond, bar) do { unsigned _sp = 0; while (cond) { __builtin_amdgcn_s_sleep(1); \
    if ((++_sp & 255u) == 0u) { if (xb_ld(&(bar)[XB_TMO])) break; if (_sp > XB_SPIN_CAP) { atomicAdd(&(bar)[XB_TMO], 1u); break; } } } } while (0)

struct XcdBarrier {
    unsigned* bar; unsigned x;
    volatile LAS unsigned* st;
};

__device__ __forceinline__ XcdBarrier xcd_barrier_post(unsigned* bar, volatile LAS unsigned* st) {
    XcdBarrier b; b.bar = bar; b.x = xb_xcc_id(); b.st = st;
    if (threadIdx.x == 0) (void)xb_add(&bar[XB_XCNT(b.x)], 1u);
    return b;
}
__device__ __forceinline__ void xcd_barrier_complete(unsigned* bar, unsigned x, unsigned& nloc, unsigned& nx) {
    const unsigned G = gridDim.x * gridDim.y * gridDim.z;
    unsigned sum, cnt, mine, sp = 0u;
    for (;;) {
        sum = 0u; cnt = 0u; mine = 0u;
#pragma unroll
        for (unsigned j = 0; j < 16; ++j) { const unsigned c = xb_ld(&bar[XB_XCNT(j)]); sum += c; cnt += (c > 0u) ? 1u : 0u; mine = (j == x) ? c : mine; }
        if (sum == G) break;
        __builtin_amdgcn_s_sleep(1);
        if ((++sp & 255u) == 0u) { if (xb_ld(&bar[XB_TMO])) break; if (sp > XB_SPIN_CAP) { atomicAdd(&bar[XB_TMO], 1u); break; } }
    }
    nloc = mine > 0u ? mine : 1u; nx = cnt > 0u ? cnt : 1u;
}

__device__ __forceinline__ void xcd_barrier(const XcdBarrier& b) {
    asm volatile("s_waitcnt vmcnt(0)" ::: "memory");
    __syncthreads();
    if (threadIdx.x == 0) {
        unsigned* bar = b.bar;
        __builtin_amdgcn_s_waitcnt(0);
        unsigned nloc = b.st[0], nx = b.st[1];
        if (nloc == 0u) { xcd_barrier_complete(bar, b.x, nloc, nx); b.st[0] = nloc; b.st[1] = nx; }
        const unsigned old = xb_add(&bar[XB_XSUB(b.x)], 1u);
        const unsigned gen = old / nloc;
        if (old + 1u == (gen + 1u) * nloc) {
            __builtin_amdgcn_fence(__ATOMIC_RELEASE, "agent");
            asm volatile("s_waitcnt vmcnt(0)" ::: "memory");
            const unsigned og = xb_add(&bar[XB_TOP], 1u);
            const unsigned tg = og / nx;
            if (og + 1u == (tg + 1u) * nx) xb_add(&bar[XB_TOPGEN], 1u);
            else XB_SPIN(xb_ld(&bar[XB_TOPGEN]) == tg, bar);
            __builtin_amdgcn_fence(__ATOMIC_ACQUIRE, "agent");
            xb_add(&bar[XB_XGEN(b.x)], 1u);
            asm volatile("s_waitcnt vmcnt(0)" ::: "memory");
        } else {
            XB_SPIN(xb_ld(&bar[XB_XGEN(b.x)]) == gen, bar);
            __builtin_amdgcn_fence(__ATOMIC_ACQUIRE, "agent");
            asm volatile("s_waitcnt vmcnt(0)" ::: "memory");
        }
    }
    __syncthreads();
}

constexpr int SCR_BYTES = 139264;
constexpr int MISC_OFF = SCR_BYTES;
constexpr int LDS_BYTES = 147456;
constexpr int CW_BAR = 4096;
constexpr int NTHR = 512, NWAVES = 8;
constexpr int CW_MOE = 8192;

__device__ __forceinline__ void transpose_item(const float* W, int ldw, int col0, int K, bf16_t* WT, int drow0, int kb, LAS float* scr, int lane) {
    const int k0 = 64 * kb;
#pragma unroll 8
    for (int i = 0; i < 32; ++i) { const int kk = 2 * i + (lane >> 5); scr[kk * 33 + (lane & 31)] = W[(size_t)(k0 + kk) * ldw + col0 + (lane & 31)]; }
    asm volatile("s_waitcnt lgkmcnt(0)" ::: "memory");
    const int c = lane & 7;
#pragma unroll
    for (int j = 0; j < 4; ++j) { const int n = (lane >> 3) + 8 * j; const LAS float* s = scr + (8 * c) * 33 + n;
        u32x4 o; o.x = pk2(s[0 * 33], s[1 * 33]); o.y = pk2(s[2 * 33], s[3 * 33]); o.z = pk2(s[4 * 33], s[5 * 33]); o.w = pk2(s[6 * 33], s[7 * 33]);
        *(u32x4*)(WT + (size_t)(drow0 + n) * K + k0 + 8 * c) = o; }
    asm volatile("s_waitcnt lgkmcnt(0)" ::: "memory");
}
__device__ __forceinline__ void up_item(const float* wg, const float* wu, bf16_t* WT, int it, LAS float* scr, int lane) {
    const int nb = it >> 4, kb = it & 15, r0 = 32 * nb, pn = r0 >> 8, p = r0 & 255;
    transpose_item(p < 128 ? wg : wu, DFF, 128 * pn + (p & 127), DM, WT, r0, kb, scr, lane);
}
__device__ __forceinline__ void dn_item(const float* wd, bf16_t* WT, int it, LAS float* scr, int lane) {
    const int nb = it / 44, kb = it % 44;
    transpose_item(wd, DM, 32 * nb, DFF, WT, 32 * nb, kb, scr, lane);
}
constexpr int IT_IN = 112 * 16, IT_OUT = 32 * 16, IT_UP = 176 * 16, IT_DN = 32 * 44;
constexpr int IT_TOTAL = 2 * IT_IN + 2 * IT_OUT + IT_UP + IT_DN + NEXP * (IT_UP + IT_DN);

__device__ __forceinline__ void phase_prologue(const Args& a, LAS unsigned char* lds, int tid, int lane, int wave, int bid, int G) {
    unsigned char* ws = a.ws;
    {
        LAS float* scr = (LAS float*)(lds + wave * 8704);
        const int gw = bid * NWAVES + wave, NGW = G * NWAVES;
        for (int it0 = gw; it0 < IT_TOTAL; it0 += NGW) {
            int it = it0;
            if (it < 2 * IT_IN) { const int l = it / IT_IN; it -= l * IT_IN; const int nb = it >> 4, kb = it & 15, r0 = 32 * nb;
                transpose_item(a.in[8] + (size_t)l * DM * DIN, DIN, r0 < 2048 ? r0 : r0 + 16, DM, (bf16_t*)(ws + WS_WTIN) + (size_t)l * NPW * DM, r0, kb, scr, lane); continue; }
            it -= 2 * IT_IN;
            if (it < 2 * IT_OUT) { const int l = it / IT_OUT; it -= l * IT_OUT; const int nb = it >> 4, kb = it & 15;
                transpose_item(a.in[16] + (size_t)l * DM * DM, DM, 32 * nb, DM, (bf16_t*)(ws + WS_WTOUT) + (size_t)l * DM * DM, 32 * nb, kb, scr, lane); continue; }
            it -= 2 * IT_OUT;
            if (it < IT_UP) { up_item(a.in[17], a.in[18], (bf16_t*)(ws + WS_WTUP), it, scr, lane); continue; }
            it -= IT_UP;
            if (it < IT_DN) { dn_item(a.in[19], (bf16_t*)(ws + WS_WTDN), it, scr, lane); continue; }
            it -= IT_DN;
            if (it < NEXP * IT_UP) { const int e = it / IT_UP; it -= e * IT_UP;
                up_item(a.in[21] + (size_t)e * DM * DFF, a.in[22] + (size_t)e * DM * DFF, (bf16_t*)(ws + WS_WTMUP) + (size_t)e * NUP * DM, it, scr, lane); continue; }
            it -= NEXP * IT_UP;
            { const int e = it / IT_DN; it -= e * IT_DN; dn_item(a.in[23] + (size_t)e * DFF * DM, (bf16_t*)(ws + WS_WTMDN) + (size_t)e * DM * DFF, it, scr, lane); }
        }
    }
    __syncthreads();
    {
        const int gt = bid * NTHR + tid;
        if (gt < 1024) { const int pos = gt >> 4, i = gt & 15;
            double inv = 1.0; for (int q = 0; q < i; ++q) inv *= 0.56234132519034908;
            const float angf = (float)pos * (float)inv; const double ang = (double)angf;
            const double kq = rint(ang * 0.63661977236758134); const double r = ang - kq * 1.5707963267948966 - kq * 6.123233995736766e-17; const double r2 = r * r;
            double sn = r * (1.0 + r2 * (-1.0 / 6 + r2 * (1.0 / 120 + r2 * (-1.0 / 5040 + r2 * (1.0 / 362880 + r2 * (-1.0 / 39916800 + r2 * (1.0 / 6227020800.0)))))));
            double cs = 1.0 + r2 * (-0.5 + r2 * (1.0 / 24 + r2 * (-1.0 / 720 + r2 * (1.0 / 40320 + r2 * (-1.0 / 3628800 + r2 * (1.0 / 479001600.0 + r2 * (-1.0 / 87178291200.0)))))));
            const int kk = ((int)kq) & 3; double c2, s2;
            if (kk == 0) { c2 = cs; s2 = sn; } else if (kk == 1) { c2 = -sn; s2 = cs; } else if (kk == 2) { c2 = -cs; s2 = -sn; } else { c2 = sn; s2 = -cs; }
            float* R = (float*)(ws + WS_ROPE); R[gt * 2] = (float)c2; R[gt * 2 + 1] = (float)s2; }
    }
    {
        LAS float* sc = (LAS float*)(lds + 73728);
        LAS float* red = (LAS float*)(lds + 73728 + 36864);
        for (int i = tid; i < 9 * 1024; i += NTHR) { const float v = i < 8192 ? a.in[1][i] : a.in[3][i - 8192]; sc[i] = v / (1.0f + __expf(-v)); }
        __syncthreads();
        for (int item = bid; item < 192; item += G) {
            const int l = item / 96, n0 = (item % 96) * 64;
            const float* wm = a.in[6] + (size_t)l * DM * 6144 + n0 + lane;
            float acc[9];
#pragma unroll
            for (int b = 0; b < 9; ++b) acc[b] = 0.f;
#pragma unroll 4
            for (int kk = 0; kk < 128; ++kk) { const int k = wave * 128 + kk; const float w = wm[(size_t)k * 6144];
#pragma unroll
                for (int b = 0; b < 9; ++b) acc[b] += sc[b * 1024 + k] * w; }
#pragma unroll
            for (int b = 0; b < 9; ++b) red[(wave * 9 + b) * 64 + lane] = acc[b];
            __syncthreads();
            for (int o = tid; o < 576; o += NTHR) { const int b = o >> 6, ln = o & 63; float s = a.in[7][(size_t)l * 6144 + n0 + ln];
#pragma unroll
                for (int w = 0; w < 8; ++w) s += red[(w * 9 + b) * 64 + ln];
                ((float*)(ws + WS_MOD))[((size_t)l * 9 + b) * 6144 + n0 + ln] = s; }
            __syncthreads();
        }
    }
}

template <int MODE>
__device__ __forceinline__ void phase_norm(const Args& a, int l, LAS unsigned char* lds, int tid, int lane, int wave, int bid, int G) {
    unsigned char* ws = a.ws;
    LAS float* WT = (LAS float*)lds;
    if (MODE == 0) { const float* w = a.in[8] + (size_t)l * DM * DIN + 2048; for (int i = tid; i < 16384; i += NTHR) { const int k = i >> 4, j = i & 15; WT[j * 1024 + k] = w[(size_t)k * DIN + j]; } __syncthreads(); }
    if (MODE == 2) { const float* w = a.in[20]; for (int i = tid; i < 8192; i += NTHR) { const int k = i >> 3, j = i & 7; WT[j * 1024 + k] = w[(size_t)k * 8 + j]; } __syncthreads(); }
    const float* gam = (MODE == 0 ? a.in[4] : a.in[5]) + (size_t)l * DM;
    const float* mod = (const float*)(ws + WS_MOD) + (size_t)l * 9 * 6144;
    const int shoff = MODE == 0 ? 0 : 3072, soff = MODE == 0 ? 1024 : 4096;
    const int nrows = (MODE == 2) ? NLAT : MALL;
    bf16_t* H = (bf16_t*)(ws + WS_H);
    int nrec = 0;
    for (int r = bid * NWAVES + wave; r < nrows; r += G * NWAVES) {
        const bool lat = r < NLAT; const int bi = lat ? (r >> 11) : 8;
        const float* src = (MODE == 0 && l == 0) ? (lat ? a.in[0] + (size_t)r * DM : a.in[2] + (size_t)(r - NLAT) * DM)
                                    : (lat ? a.out + (size_t)r * DM : (const float*)(ws + WS_XC) + (size_t)(r - NLAT) * DM);
        f32x4 v[4]; float ss = 0.f;
#pragma unroll
        for (int j = 0; j < 4; ++j) { v[j] = *(const f32x4*)(src + 4 * lane + 256 * j); ss += (v[j].x * v[j].x + v[j].y * v[j].y) + (v[j].z * v[j].z + v[j].w * v[j].w); }
        const float rstd = rsqrtf(wave_sum(ss) * (1.0f / DM) + EPS);
        const float* mrow = mod + (size_t)bi * 6144;
#pragma unroll
        for (int j = 0; j < 4; ++j) { const int k = 4 * lane + 256 * j;
            const f32x4 g = *(const f32x4*)(gam + k), s = *(const f32x4*)(mrow + soff + k), sh = *(const f32x4*)(mrow + shoff + k);
            v[j] = v[j] * rstd * g * (1.0f + s) + sh;
            u32x2 w; w.x = pk2(v[j].x, v[j].y); w.y = pk2(v[j].z, v[j].w);
            *(u32x2*)(H + (size_t)r * DM + k) = w; }
        if (MODE == 0) {
            float mine = 0.f;
#pragma nounroll
            for (int jg = 0; jg < 16; ++jg) { float s = 0.f;
#pragma unroll
                for (int j = 0; j < 4; ++j) { const f32x4 w = *(const LAS f32x4*)(WT + jg * 1024 + 4 * lane + 256 * j); s += (v[j].x * w.x + v[j].y * w.y) + (v[j].z * w.z + v[j].w * w.w); }
                s = wave_sum(s); mine = (lane == jg) ? s : mine; }
            if (lane < 16) ((float*)(ws + WS_GATES))[(size_t)r * 16 + lane] = mine + a.in[12][l * 16 + lane];
        }
        if (MODE == 2) {
            int i1 = 0, i2 = 0; float v1 = -3.0e38f, v2 = -3.0e38f;
#pragma nounroll
            for (int e = 0; e < 8; ++e) { float s = 0.f;
#pragma unroll
                for (int j = 0; j < 4; ++j) { const f32x4 w = *(const LAS f32x4*)(WT + e * 1024 + 4 * lane + 256 * j); s += (v[j].x * w.x + v[j].y * w.y) + (v[j].z * w.z + v[j].w * w.w); }
                s = wave_sum(s);
                if (s > v1) { v2 = v1; i2 = i1; v1 = s; i1 = e; } else if (s > v2) { v2 = s; i2 = e; } }
            const float w2 = 1.0f / (1.0f + __expf(v1 - v2)), w1 = 1.0f - w2;
            if (lane == 0) { LAS int* rec = (LAS int*)(lds + 32768) + nrec * 32 + wave * 4; rec[0] = i1; rec[1] = i2; rec[2] = __float_as_int(w1); rec[3] = __float_as_int(w2); }
            ++nrec;
        }
    }
    if (MODE == 2) {
        __syncthreads();
        if (tid < 8) {
            const int e = tid; const LAS int* rec = (const LAS int*)(lds + 32768); int cnt = 0;
            const int nk = (nrows - bid * NWAVES + G * NWAVES - 1) / (G * NWAVES);
            for (int k = 0; k < nk; ++k) for (int w = 0; w < NWAVES; ++w) { const int r = bid * NWAVES + w + k * G * NWAVES; if (r < nrows) { const LAS int* q = rec + k * 32 + w * 4; cnt += (q[0] == e) + (q[1] == e); } }
            int pos = (int)atomicAdd((unsigned*)(ws + WS_CTL) + CW_MOE + 64 * e, (unsigned)cnt);
            int* LIST = (int*)(ws + WS_LIST) + e * NLAT; int* TOK = (int*)(ws + WS_COMB);
            for (int k = 0; k < nk; ++k) for (int w = 0; w < NWAVES; ++w) { const int r = bid * NWAVES + w + k * G * NWAVES; if (r < nrows) { const LAS int* q = rec + k * 32 + w * 4;
                if (q[0] == e) { LIST[pos] = r; TOK[r * 8 + 0] = e; TOK[r * 8 + 2] = pos; TOK[r * 8 + 4] = q[2]; ++pos; }
                if (q[1] == e) { LIST[pos] = r; TOK[r * 8 + 1] = e; TOK[r * 8 + 3] = pos; TOK[r * 8 + 5] = q[3]; ++pos; } } }
        }
    }
}

__device__ __forceinline__ void phase_post(const Args& a, int l, int lane, int wave, int bid, int G) {
    unsigned char* ws = a.ws;
    bf16_t* P = (bf16_t*)(ws + WS_BIG); bf16_t* MQK = (bf16_t*)(ws + WS_MQK);
    const float* ROPE = (const float*)(ws + WS_ROPE);
    const float* cw = a.in[10] + (size_t)l * 3 * 512; const float* cb = a.in[11] + (size_t)l * 512;
    const float qg = a.in[13][l * 64 + lane], kg = a.in[14][l * 64 + lane];
    for (int r = bid * NWAVES + wave; r < MALL; r += G * NWAVES) {
        const bool lat = r < NLAT; bf16_t* row = P + (size_t)r * NPW;
        int t, tlen; if (lat) { t = r & (SEQ - 1); tlen = SEQ; } else { t = (r - NLAT) & (CTXL - 1); tlen = CTXL; }
        if (lat) { const int gr = t >> 6, gc = t & 63;
#pragma unroll
            for (int blk = 0; blk < 2; ++blk)
#pragma unroll
                for (int ii = 0; ii < 2; ++ii) { const int pid = lane + 64 * ii, head = pid >> 5, half = (pid >> 4) & 1, i = pid & 15, c1 = (blk ? PC_RK : PC_RQ) + head * 64 + half * 32 + i;
                    const int pos = half ? gc : gr; const float cs = ROPE[(pos * 16 + i) * 2], sn = ROPE[(pos * 16 + i) * 2 + 1];
                    const float x1 = bf2f(row[c1]), x2 = bf2f(row[c1 + 16]); const float sc = blk ? 0.125f : 1.0f;
                    row[c1] = (bf16_t)f2bf((x1 * cs - x2 * sn) * sc); row[c1 + 16] = (bf16_t)f2bf((x1 * sn + x2 * cs) * sc); }
        } else {
#pragma unroll
            for (int ii = 0; ii < 4; ++ii) { const int c = PC_RK + lane + 64 * ii; row[c] = (bf16_t)f2bf(bf2f(row[c]) * 0.125f); }
        }
#pragma unroll
        for (int ii = 0; ii < 8; ++ii) { const int c = lane + 64 * ii;
            const float x0 = bf2f(row[PC_MQ + c]);
            const float xm = t > 0 ? bf2f(row[PC_MQ + c - NPW]) : 0.f, xp = t < tlen - 1 ? bf2f(row[PC_MQ + c + NPW]) : 0.f;
            float y = cb[c] + cw[c] * xm + cw[512 + c] * x0 + cw[1024 + c] * xp;
            y = y / (1.0f + __expf(-y)); if (c >= 256) y *= 0.125f;
            MQK[(size_t)r * 512 + c] = (bf16_t)f2bf(y); }
#pragma unroll
        for (int hh = 0; hh < 16; ++hh) { const int c = PC_NQ + hh * 64 + lane; const float v = bf2f(row[c]);
            const float rs = rsqrtf(wave_sum(v * v) * (1.0f / 64.0f) + EPS);
            row[c] = (bf16_t)f2bf(v * rs * (hh < 8 ? qg : kg)); }
    }
}

__device__ __forceinline__ int tokrow(int b, int p, int dir) {
    if (dir == 0) return p < CTXL ? NLAT + b * CTXL + p : b * SEQ + (p - CTXL);
    return p < CTXL ? NLAT + b * CTXL + (CTXL - 1 - p) : b * SEQ + (SEQ - 1 - (p - CTXL));
}
__device__ __forceinline__ void phase_fcum(const Args& a, int lane, int wave, int bid, int G) {
    unsigned char* ws = a.ws; const float* GT = (const float*)(ws + WS_GATES); float* F = (float*)(ws + WS_FCUM);
    for (int it = bid * NWAVES + wave; it < NB * 4 * 2; it += G * NWAVES) {
        const int dir = it & 1, h = (it >> 1) & 3, b = it >> 3; float carry = 0.f;
        for (int p0 = 0; p0 < CTXL + SEQ; p0 += 64) { const int p = p0 + lane; const int row = tokrow(b, p, dir);
            float v = logsigmoidf_(GT[(size_t)row * 16 + 8 + 4 * dir + h]);
#pragma unroll
            for (int o = 1; o < 64; o <<= 1) { const float u = lane_get(v, lane >= o ? lane - o : lane); if (lane >= o) v += u; }
            F[(size_t)((b * 4 + h) * 2 + dir) * 2304 + p] = carry + v;
            carry += lane_bcast(v, 63); }
    }
}

__device__ __forceinline__ void phase_quad(const Args& a, int l, bool need_ctx, LAS unsigned char* lds, int lane, int wave, int bid, int G) {
    unsigned char* ws = a.ws;
    const bf16_t* P = (const bf16_t*)(ws + WS_BIG); const bf16_t* MQK = (const bf16_t*)(ws + WS_MQK);
    const float* GT = (const float*)(ws + WS_GATES); const float* FC = (const float*)(ws + WS_FCUM);
    LAS float* scr = (LAS float*)(lds + wave * 16640);
    const int nrows = need_ctx ? MALL : NLAT, nitems = nrows * 8;
    for (int it = bid * NWAVES + wave; it < nitems; it += G * NWAVES) {
        const int kind = it & 1, h = (it >> 1) & 3, r = it >> 3;
        const bool lat = r < NLAT; const int b = lat ? (r >> 11) : ((r - NLAT) >> 8), tt = lat ? (r & (SEQ - 1)) : ((r - NLAT) & (CTXL - 1));
        const bf16_t* qsrc = kind == 0 ? P + (size_t)r * NPW + PC_RQ + h * 64 : MQK + (size_t)r * 512 + h * 64;
        unsigned qp[32];
#pragma unroll
        for (int i = 0; i < 8; ++i) { const u32x4 w = *(const u32x4*)(qsrc + 8 * i); qp[4 * i] = w.x; qp[4 * i + 1] = w.y; qp[4 * i + 2] = w.z; qp[4 * i + 3] = w.w; }
        float y = 0.f;
        for (int dir = 0; dir < 2; ++dir) {
            const int p = lat ? (dir == 0 ? CTXL + tt : CTXL + (SEQ - 1 - tt)) : (dir == 0 ? tt : CTXL - 1 - tt);
            const float lg = logsigmoidf_(a.in[9][(l * 2 + dir) * 4 + h]);
            const float* fc = FC + (size_t)((b * 4 + h) * 2 + dir) * 2304; const float fp = fc[p];
            float num[64]; float den = 0.f;
#pragma unroll
            for (int e = 0; e < 64; ++e) num[e] = 0.f;
            for (int p0 = 0; p0 <= p; p0 += 64) {
                const int pk = p0 + lane; const bool valid = pk <= p; const int pkc = valid ? pk : p; const int rk = tokrow(b, pkc, dir);
                const bf16_t* ksrc = kind == 0 ? P + (size_t)rk * NPW + PC_RK + h * 64 : MQK + (size_t)rk * 512 + 256 + h * 64;
                const bf16_t* vsrc = P + (size_t)rk * NPW + (kind == 0 ? PC_RV : PC_MV) + h * 64;
                float dot = 0.f;
#pragma unroll
                for (int i = 0; i < 8; ++i) { const u32x4 w = *(const u32x4*)(ksrc + 8 * i);
                    dot += bflo(qp[4 * i]) * bflo(w.x) + bfhi(qp[4 * i]) * bfhi(w.x) + bflo(qp[4 * i + 1]) * bflo(w.y) + bfhi(qp[4 * i + 1]) * bfhi(w.y)
                         + bflo(qp[4 * i + 2]) * bflo(w.z) + bfhi(qp[4 * i + 2]) * bfhi(w.z) + bflo(qp[4 * i + 3]) * bflo(w.w) + bfhi(qp[4 * i + 3]) * bfhi(w.w); }
                float wgt;
                if (kind == 0) wgt = __expf(lg * (float)(p - pkc));
                else wgt = __expf(fp - fc[pkc] + GT[(size_t)rk * 16 + 4 * dir + h]);
                const float wd = valid ? wgt * dot : 0.f;
                den += wd;
#pragma unroll
                for (int i = 0; i < 8; ++i) { const u32x4 w = *(const u32x4*)(vsrc + 8 * i);
                    num[8 * i] += wd * bflo(w.x); num[8 * i + 1] += wd * bfhi(w.x); num[8 * i + 2] += wd * bflo(w.y); num[8 * i + 3] += wd * bfhi(w.y);
                    num[8 * i + 4] += wd * bflo(w.z); num[8 * i + 5] += wd * bfhi(w.z); num[8 * i + 6] += wd * bflo(w.w); num[8 * i + 7] += wd * bfhi(w.w); }
            }
#pragma unroll
            for (int e = 0; e < 64; ++e) scr[lane * 65 + e] = num[e];
            den = wave_sum(den);
            asm volatile("s_waitcnt lgkmcnt(0)" ::: "memory");
            float s = 0.f;
#pragma unroll 8
            for (int i = 0; i < 64; ++i) s += scr[i * 65 + lane];
            asm volatile("s_waitcnt lgkmcnt(0)" ::: "memory");
            y += kind == 0 ? s : s / fmaxf(fabsf(den), 1.0f);
        }
        ((float*)(ws + (kind == 0 ? WS_RETY : WS_MLY)))[(size_t)r * 256 + h * 64 + lane] = y;
    }
}

__device__ __forceinline__ void phase_natt(const Args& a, int l, bool need_ctx, LAS unsigned char* lds, int lane, int wave, int bid, int G) {
    unsigned char* ws = a.ws;
    const bf16_t* P = (const bf16_t*)(ws + WS_BIG); bf16_t* NAY = (bf16_t*)(ws + WS_NAY);
    LAS float* prob = (LAS float*)(lds + wave * 16640);
    LAS int* krow = (LAS int*)(lds + wave * 16640 + 1536);
    const int nrows = need_ctx ? MALL : NLAT, nitems = nrows * 8;
    for (int it = bid * NWAVES + wave; it < nitems; it += G * NWAVES) {
        const int h = it & 7, r = it >> 3; const bool lat = r < NLAT;
        const int b = lat ? (r >> 11) : ((r - NLAT) >> 8);
        const bf16_t* qsrc = P + (size_t)r * NPW + PC_NQ + h * 64;
        unsigned qp[32];
#pragma unroll
        for (int i = 0; i < 8; ++i) { const u32x4 w = *(const u32x4*)(qsrc + 8 * i); qp[4 * i] = w.x; qp[4 * i + 1] = w.y; qp[4 * i + 2] = w.z; qp[4 * i + 3] = w.w; }
        int gr = 0, gc = 0, sr = 0, scc = 0;
        if (lat) { const int t = r & (SEQ - 1); gr = t >> 6; gc = t & 63; sr = min(max(gr - 4, 0), NROWS - 8); scc = min(max(gc - 8, 0), GRIDW - 16); }
        const float* rpb = a.in[15] + (size_t)(l * 8 + h) * 15 * 31;
        float s[6]; float mx = -3.0e38f;
#pragma unroll
        for (int jj = 0; jj < 6; ++jj) {
            const bool loc = jj < 2; int rk; float bias = 0.f; bool valid = true;
            if (loc) { const int j = lane + 64 * jj, kk = j >> 4, kc = j & 15, kr_ = sr + kk, kcol = scc + kc; rk = b * SEQ + kr_ * 64 + kcol;
                bias = rpb[(kr_ - gr + 7) * 31 + min(max(kcol - gc + 15, 0), 30)]; valid = lat; if (lat) krow[j] = rk; }
            else rk = NLAT + b * CTXL + lane + 64 * (jj - 2);
            const bf16_t* ksrc = P + (size_t)rk * NPW + PC_NK + h * 64;
            float dot = 0.f;
#pragma unroll
            for (int i = 0; i < 8; ++i) { const u32x4 w = *(const u32x4*)(ksrc + 8 * i);
                dot += bflo(qp[4 * i]) * bflo(w.x) + bfhi(qp[4 * i]) * bfhi(w.x) + bflo(qp[4 * i + 1]) * bflo(w.y) + bfhi(qp[4 * i + 1]) * bfhi(w.y)
                     + bflo(qp[4 * i + 2]) * bflo(w.z) + bfhi(qp[4 * i + 2]) * bfhi(w.z) + bflo(qp[4 * i + 3]) * bflo(w.w) + bfhi(qp[4 * i + 3]) * bfhi(w.w); }
            s[jj] = valid ? dot * 0.125f + bias : -3.0e38f; mx = fmaxf(mx, s[jj]);
        }
        mx = wave_max(mx); float sum = 0.f;
#pragma unroll
        for (int jj = 0; jj < 6; ++jj) { s[jj] = (s[jj] > -1.0e38f) ? __expf(s[jj] - mx) : 0.f; sum += s[jj]; }
        sum = wave_sum(sum); const float inv = 1.0f / sum;
#pragma unroll
        for (int jj = 0; jj < 6; ++jj) prob[lane + 64 * jj] = s[jj] * inv;
        asm volatile("s_waitcnt lgkmcnt(0)" ::: "memory");
        float o = 0.f;
        if (lat) for (int j = 0; j < 128; ++j) o += prob[j] * bf2f(P[(size_t)krow[j] * NPW + PC_NV + h * 64 + lane]);
        for (int j = 0; j < CTXL; ++j) o += prob[128 + j] * bf2f(P[(size_t)(NLAT + b * CTXL + j) * NPW + PC_NV + h * 64 + lane]);
        asm volatile("s_waitcnt lgkmcnt(0)" ::: "memory");
        NAY[(size_t)r * 512 + h * 64 + lane] = (bf16_t)f2bf(o);
    }
}

__device__ __forceinline__ void phase_merge(const Args& a, bool need_ctx, int lane, int wave, int bid, int G) {
    unsigned char* ws = a.ws;
    const bf16_t* P = (const bf16_t*)(ws + WS_BIG); const bf16_t* NAY = (const bf16_t*)(ws + WS_NAY); bf16_t* MG = (bf16_t*)(ws + WS_H);
    const float* RY = (const float*)(ws + WS_RETY); const float* MY = (const float*)(ws + WS_MLY);
    const int nrows = need_ctx ? MALL : NLAT;
    for (int r = bid * NWAVES + wave; r < nrows; r += G * NWAVES) {
#pragma unroll
        for (int h = 0; h < 4; ++h) {
            { const float v = RY[(size_t)r * 256 + h * 64 + lane]; const float rs = rsqrtf(wave_sum(v * v) * (1.0f / 64.0f) + EPS);
              const float g = bf2f(P[(size_t)r * NPW + PC_RG + h * 64 + lane]); MG[(size_t)r * DM + h * 64 + lane] = (bf16_t)f2bf(siluf_(g) * v * rs); }
            { const float v = MY[(size_t)r * 256 + h * 64 + lane]; const float rs = rsqrtf(wave_sum(v * v) * (1.0f / 64.0f) + EPS);
              const float g = bf2f(P[(size_t)r * NPW + PC_MO + h * 64 + lane]); MG[(size_t)r * DM + 256 + h * 64 + lane] = (bf16_t)f2bf(sigmoidf_(g) * v * rs); }
        }
#pragma unroll
        for (int i = 0; i < 8; ++i) MG[(size_t)r * DM + 512 + lane + 64 * i] = NAY[(size_t)r * 512 + lane + 64 * i];
    }
}

typedef short bf16x8 __attribute__((ext_vector_type(8)));
typedef short s16x4 __attribute__((ext_vector_type(4)));
constexpr int IST = 160;
__device__ __forceinline__ f32x4 mfma16(bf16x8 a, bf16x8 b, f32x4 c) { return __builtin_amdgcn_mfma_f32_16x16x32_bf16(a, b, c, 0, 0, 0); }
__device__ __forceinline__ bf16x8 frag_row(LAS const unsigned char* img, int row0, int k0, int lane) {
    return *(const LAS bf16x8*)(img + (row0 + (lane & 15)) * IST + (k0 + 8 * (lane >> 4)) * 2);
}
template <bool PERMK>
__device__ __forceinline__ bf16x8 frag_tr(LAS const unsigned char* img, int r0, int c0, int lane) {
    const int g = lane >> 4, i = lane & 15, q = i >> 2, p = i & 3;
    const unsigned addr = (unsigned)(size_t)(img + (r0 + (PERMK ? 4 : 8) * g + q) * IST + (c0 + 4 * p) * 2);
    s16x4 lo, hi;
    if (PERMK) asm volatile("ds_read_b64_tr_b16 %0, %2\n\tds_read_b64_tr_b16 %1, %2 offset:2560\n\ts_waitcnt lgkmcnt(0)" : "=&v"(lo), "=&v"(hi) : "v"(addr) : "memory");
    else       asm volatile("ds_read_b64_tr_b16 %0, %2\n\tds_read_b64_tr_b16 %1, %2 offset:640\n\ts_waitcnt lgkmcnt(0)" : "=&v"(lo), "=&v"(hi) : "v"(addr) : "memory");
    bf16x8 r; r[0] = lo[0]; r[1] = lo[1]; r[2] = lo[2]; r[3] = lo[3]; r[4] = hi[0]; r[5] = hi[1]; r[6] = hi[2]; r[7] = hi[3];
    return r;
}
__device__ __forceinline__ bf16x8 pack8(f32x4 a, f32x4 b) {
    union { u32x4 u; bf16x8 v; } x; x.u.x = pk2(a[0], a[1]); x.u.y = pk2(a[2], a[3]); x.u.z = pk2(b[0], b[1]); x.u.w = pk2(b[2], b[3]); return x.v;
}
__device__ __forceinline__ int chunk_row0(int b, int dir, int sc) {
    if (dir == 0) return sc < 2 ? NLAT + b * CTXL + 128 * sc : b * SEQ + 128 * (sc - 2);
    return sc < 2 ? NLAT + b * CTXL + 128 * (1 - sc) : b * SEQ + 128 * (17 - sc);
}
constexpr size_t U_BYTES = 80 * 64 * 2;

__device__ __forceinline__ void phase_chunk_sums(const Args& a, int l, LAS unsigned char* lds, int tid, int lane, int wave, int bid, int G) {
    unsigned char* ws = a.ws;
    const bf16_t* P = (const bf16_t*)(ws + WS_BIG); const bf16_t* MQK = (const bf16_t*)(ws + WS_MQK);
    const float* GT = (const float*)(ws + WS_GATES);
    LAS unsigned char* Kimg = lds;
    LAS unsigned char* Vimg = lds + 128 * IST;
    LAS float* wk = (LAS float*)(lds + 256 * IST);
    LAS float* red = wk + 128;
    const int nitems = 2 * NB * 4 * 2 * 18;
    for (int it = bid; it < nitems; it += G) {
        const int sc = it % 18; int r_ = it / 18; const int dir = r_ & 1; r_ >>= 1; const int h = r_ & 3; r_ >>= 2; const int b = r_ & 7; const int kind = r_ >> 3;
        const int row0 = chunk_row0(b, dir, sc);
        __syncthreads();
        if (kind == 0) { if (tid < 128) { const float lg = logsigmoidf_(a.in[9][(l * 2 + dir) * 4 + h]); wk[tid] = __expf(lg * (float)(dir == 0 ? 127 - tid : tid)); } }
        else if (wave == 0) {
            const float g0i = GT[(size_t)(row0 + lane) * 16 + 4 * dir + h], g1i = GT[(size_t)(row0 + 64 + lane) * 16 + 4 * dir + h];
            const float f0 = logsigmoidf_(GT[(size_t)(row0 + lane) * 16 + 8 + 4 * dir + h]), f1 = logsigmoidf_(GT[(size_t)(row0 + 64 + lane) * 16 + 8 + 4 * dir + h]);
            float s0 = f0, s1 = f1;
#pragma unroll
            for (int o = 1; o < 64; o <<= 1) { const int sl = lane >= o ? lane - o : lane; const float u0 = lane_get(s0, sl), u1 = lane_get(s1, sl); if (lane >= o) { s0 += u0; s1 += u1; } }
            const float t0 = lane_bcast(s0, 63), t1 = lane_bcast(s1, 63), tot = t0 + t1;
            float b0, b1;
            if (dir == 0) { b0 = s0; b1 = t0 + s1; } else { b0 = tot - s0 + f0; b1 = t1 - s1 + f1; }
            const float a0 = g0i - b0, a1 = g1i - b1; const float amax = wave_max(fmaxf(a0, a1));
            wk[lane] = __expf(a0 - amax); wk[lane + 64] = __expf(a1 - amax);
            if (lane == 0) { float* usc = (float*)(ws + WS_USC) + ((size_t)((b * 4 + h) * 2 + dir) * 18 + sc) * 2; usc[0] = tot; usc[1] = amax; }
        }
        __syncthreads();
        {
            const int r = tid >> 2, c8 = (tid & 3) * 16;
            const bf16_t* ksrc = kind == 0 ? P + (size_t)(row0 + r) * NPW + PC_RK + h * 64 + c8 : MQK + (size_t)(row0 + r) * 512 + 256 + h * 64 + c8;
            const bf16_t* vsrc = P + (size_t)(row0 + r) * NPW + (kind == 0 ? PC_RV : PC_MV) + h * 64 + c8;
            const u32x4 k0 = *(const u32x4*)ksrc, k1 = *(const u32x4*)(ksrc + 8), v0 = *(const u32x4*)vsrc, v1 = *(const u32x4*)(vsrc + 8);
            *(LAS u32x4*)(Kimg + r * IST + c8 * 2) = k0; *(LAS u32x4*)(Kimg + r * IST + c8 * 2 + 16) = k1;
            const float w = wk[r];
            u32x4 o0, o1;
            o0.x = pk2(bflo(v0.x) * w, bfhi(v0.x) * w); o0.y = pk2(bflo(v0.y) * w, bfhi(v0.y) * w); o0.z = pk2(bflo(v0.z) * w, bfhi(v0.z) * w); o0.w = pk2(bflo(v0.w) * w, bfhi(v0.w) * w);
            o1.x = pk2(bflo(v1.x) * w, bfhi(v1.x) * w); o1.y = pk2(bflo(v1.y) * w, bfhi(v1.y) * w); o1.z = pk2(bflo(v1.z) * w, bfhi(v1.z) * w); o1.w = pk2(bflo(v1.w) * w, bfhi(v1.w) * w);
            *(LAS u32x4*)(Vimg + r * IST + c8 * 2) = o0; *(LAS u32x4*)(Vimg + r * IST + c8 * 2 + 16) = o1;
            if ((tid & 3) == 0) { unsigned zz; asm volatile("v_mov_b32 %0, 0" : "=v"(zz)); u32x4 e0; e0.x = f2bf(w); e0.y = zz; e0.z = zz; e0.w = zz; u32x4 z; z.x = zz; z.y = zz; z.z = zz; z.w = zz;
                *(LAS u32x4*)(Vimg + r * IST + 128) = e0; *(LAS u32x4*)(Vimg + r * IST + 144) = z; }
        }
        __syncthreads();
        {
            const int dt = wave & 3, et0 = 2 * (wave >> 2);
            f32x4 u0 = {0.f, 0.f, 0.f, 0.f}, u1 = u0, u2 = u0;
#pragma unroll
            for (int ks = 0; ks < 4; ++ks) {
                const bf16x8 af = frag_tr<false>(Kimg, 32 * ks, 16 * dt, lane);
                const bf16x8 b0 = frag_tr<false>(Vimg, 32 * ks, 16 * et0, lane), b1 = frag_tr<false>(Vimg, 32 * ks, 16 * et0 + 16, lane);
                u0 = mfma16(af, b0, u0); u1 = mfma16(af, b1, u1);
                if (wave < 4) { const bf16x8 b2 = frag_tr<false>(Vimg, 32 * ks, 64, lane); u2 = mfma16(af, b2, u2); }
            }
            bf16_t* U = (bf16_t*)(ws + WS_U + ((size_t)(((kind * NB + b) * 4 + h) * 2 + dir) * 18 + sc) * U_BYTES);
            const int g = lane >> 4, e = lane & 15, d0 = 16 * dt + 4 * g;
            { u32x2 w; w.x = pk2(u0[0], u0[1]); w.y = pk2(u0[2], u0[3]); *(u32x2*)(U + (size_t)(16 * et0 + e) * 64 + d0) = w; }
            { u32x2 w; w.x = pk2(u1[0], u1[1]); w.y = pk2(u1[2], u1[3]); *(u32x2*)(U + (size_t)(16 * et0 + 16 + e) * 64 + d0) = w; }
            if (wave < 4) { u32x2 w; w.x = pk2(u2[0], u2[1]); w.y = pk2(u2[2], u2[3]); *(u32x2*)(U + (size_t)(64 + e) * 64 + d0) = w; }
        }
    }
}

template <int KIND>
__device__ __forceinline__ float assemble_state(const unsigned char* ws, int l, const float* ret_decay, int b, int h, int dir, int sc, LAS unsigned char* Simg, int tid) {
    const unsigned char* Ub = ws + WS_U + (size_t)((((KIND * NB + b) * 4 + h) * 2 + dir) * 18) * U_BYTES;
    float m = -1.0e30f; float lg128 = 0.f;
    const float* usc = (const float*)(ws + WS_USC) + (size_t)((b * 4 + h) * 2 + dir) * 18 * 2;
    if (KIND == 0) lg128 = 128.0f * logsigmoidf_(ret_decay[(l * 2 + dir) * 4 + h]);
    else { float suf = 0.f; for (int s = sc - 1; s >= 0; --s) { suf += usc[2 * s]; m = fmaxf(m, usc[2 * s + 1] + suf); } }
    float acc[8];
#pragma unroll
    for (int j = 0; j < 8; ++j) acc[j] = 0.f;
    const bool extra = (KIND == 1) && tid < 8;
    float acx[8];
#pragma unroll
    for (int j = 0; j < 8; ++j) acx[j] = 0.f;
    float suf = 0.f;
    for (int s = sc - 1; s >= 0; --s) {
        float coef;
        if (KIND == 0) coef = __expf(lg128 * (float)(sc - 1 - s));
        else { suf += usc[2 * s]; coef = __expf(usc[2 * s + 1] + suf - m); }
        const u32x4 v = *(const u32x4*)(Ub + (size_t)s * U_BYTES + (size_t)tid * 16);
        acc[0] += coef * bflo(v.x); acc[1] += coef * bfhi(v.x); acc[2] += coef * bflo(v.y); acc[3] += coef * bfhi(v.y);
        acc[4] += coef * bflo(v.z); acc[5] += coef * bfhi(v.z); acc[6] += coef * bflo(v.w); acc[7] += coef * bfhi(v.w);
        if (extra) { const u32x4 x = *(const u32x4*)(Ub + (size_t)s * U_BYTES + (size_t)(512 + tid) * 16);
            acx[0] += coef * bflo(x.x); acx[1] += coef * bfhi(x.x); acx[2] += coef * bflo(x.y); acx[3] += coef * bfhi(x.y);
            acx[4] += coef * bflo(x.z); acx[5] += coef * bfhi(x.z); acx[6] += coef * bflo(x.w); acx[7] += coef * bfhi(x.w); }
    }
    { u32x4 o; o.x = pk2(acc[0], acc[1]); o.y = pk2(acc[2], acc[3]); o.z = pk2(acc[4], acc[5]); o.w = pk2(acc[6], acc[7]);
      *(LAS u32x4*)(Simg + (tid >> 3) * IST + (tid & 7) * 16) = o; }
    if (extra) { u32x4 o; o.x = pk2(acx[0], acx[1]); o.y = pk2(acx[2], acx[3]); o.z = pk2(acx[4], acx[5]); o.w = pk2(acx[6], acx[7]);
      *(LAS u32x4*)(Simg + 64 * IST + tid * 16) = o; }
    return m;
}

template <int KIND>
__device__ __forceinline__ void phase_chunk_out(const Args& a, int l, bool need_ctx, LAS unsigned char* lds, int tid, int lane, int wave, int bid, int G) {
    unsigned char* ws = a.ws;
    const bf16_t* P = (const bf16_t*)(ws + WS_BIG); const bf16_t* MQK = (const bf16_t*)(ws + WS_MQK);
    const float* GT = (const float*)(ws + WS_GATES); bf16_t* MG = (bf16_t*)(ws + WS_H);
    LAS unsigned char* Qimg = lds; LAS unsigned char* Kimg = lds + 20480; LAS unsigned char* Vimg = lds + 40960;
    LAS unsigned char* SFimg = lds + 61440; LAS unsigned char* SBimg = lds + 74240;
    LAS float* AF = (LAS float*)(lds + 87040); LAS float* CF = AF + 128; LAS float* BF = AF + 256; LAS float* AB = AF + 384; LAS float* CB = AF + 512; LAS float* BB = AF + 640;
    const int nch = need_ctx ? 18 : 16, nitems = NB * 4 * nch;
    const int g = lane >> 4, qi = 16 * wave + (lane & 15);
    for (int it = bid; it < nitems; it += G) {
        const int cc = it % nch; const int bh = it / nch; const int h = bh & 3, b = bh >> 2;
        const bool isctx = cc >= 16; const int c = isctx ? cc - 16 : cc;
        const int row0 = isctx ? NLAT + b * CTXL + 128 * c : b * SEQ + 128 * c;
        const int scf = isctx ? c : 2 + c, scb = isctx ? 1 - c : 17 - c;
        __syncthreads();
        {
            const int r = tid >> 2, c8 = (tid & 3) * 16;
            const bf16_t* qsrc = KIND == 0 ? P + (size_t)(row0 + r) * NPW + PC_RQ + h * 64 + c8 : MQK + (size_t)(row0 + r) * 512 + h * 64 + c8;
            const bf16_t* ksrc = KIND == 0 ? P + (size_t)(row0 + r) * NPW + PC_RK + h * 64 + c8 : MQK + (size_t)(row0 + r) * 512 + 256 + h * 64 + c8;
            const bf16_t* vsrc = P + (size_t)(row0 + r) * NPW + (KIND == 0 ? PC_RV : PC_MV) + h * 64 + c8;
            const u32x4 q0 = *(const u32x4*)qsrc, q1 = *(const u32x4*)(qsrc + 8), k0 = *(const u32x4*)ksrc, k1 = *(const u32x4*)(ksrc + 8), v0 = *(const u32x4*)vsrc, v1 = *(const u32x4*)(vsrc + 8);
            *(LAS u32x4*)(Qimg + r * IST + c8 * 2) = q0; *(LAS u32x4*)(Qimg + r * IST + c8 * 2 + 16) = q1;
            *(LAS u32x4*)(Kimg + r * IST + c8 * 2) = k0; *(LAS u32x4*)(Kimg + r * IST + c8 * 2 + 16) = k1;
            *(LAS u32x4*)(Vimg + r * IST + c8 * 2) = v0; *(LAS u32x4*)(Vimg + r * IST + c8 * 2 + 16) = v1;
            if ((tid & 3) == 0) { unsigned zz, one; asm volatile("v_mov_b32 %0, 0\n\tv_mov_b32 %1, 0x3f80" : "=v"(zz), "=v"(one)); u32x4 e0; e0.x = one; e0.y = zz; e0.z = zz; e0.w = zz; u32x4 z; z.x = zz; z.y = zz; z.z = zz; z.w = zz;
                *(LAS u32x4*)(Vimg + r * IST + 128) = e0; *(LAS u32x4*)(Vimg + r * IST + 144) = z; }
        }
        const float mpf = assemble_state<KIND>(ws, l, a.in[9], b, h, 0, scf, SFimg, tid);
        const float mpb = assemble_state<KIND>(ws, l, a.in[9], b, h, 1, scb, SBimg, tid);
        if (KIND == 1 && wave == 0) {
            const size_t r0_ = (size_t)(row0 + lane) * 16, r1_ = (size_t)(row0 + 64 + lane) * 16;
#pragma unroll
            for (int dir = 0; dir < 2; ++dir) {
                const float i0 = GT[r0_ + 4 * dir + h], i1 = GT[r1_ + 4 * dir + h];
                const float f0 = logsigmoidf_(GT[r0_ + 8 + 4 * dir + h]), f1 = logsigmoidf_(GT[r1_ + 8 + 4 * dir + h]);
                float s0 = f0, s1 = f1;
#pragma unroll
                for (int o = 1; o < 64; o <<= 1) { const int sl = lane >= o ? lane - o : lane; const float u0 = lane_get(s0, sl), u1 = lane_get(s1, sl); if (lane >= o) { s0 += u0; s1 += u1; } }
                const float t0 = lane_bcast(s0, 63), t1 = lane_bcast(s1, 63);
                float b0, b1;
                if (dir == 0) { b0 = s0; b1 = t0 + s1; } else { b0 = t0 + t1 - s0 + f0; b1 = t1 - s1 + f1; }
                const float a0 = i0 - b0, a1 = i1 - b1;
                float x0 = a0, x1 = a1;
                if (dir == 0) {
#pragma unroll
                    for (int o = 1; o < 64; o <<= 1) { const int sl = lane >= o ? lane - o : lane; const float u0 = lane_get(x0, sl), u1 = lane_get(x1, sl); if (lane >= o) { x0 = fmaxf(x0, u0); x1 = fmaxf(x1, u1); } }
                    x1 = fmaxf(x1, lane_bcast(x0, 63));
                } else {
#pragma unroll
                    for (int o = 1; o < 64; o <<= 1) { const int sl = lane + o < 64 ? lane + o : lane; const float u0 = lane_get(x0, sl), u1 = lane_get(x1, sl); if (lane + o < 64) { x0 = fmaxf(x0, u0); x1 = fmaxf(x1, u1); } }
                    x0 = fmaxf(x0, lane_bcast(x1, 0));
                }
                const float mp = dir == 0 ? mpf : mpb;
                LAS float* A_ = dir == 0 ? AF : AB; LAS float* C_ = dir == 0 ? CF : CB; LAS float* B_ = dir == 0 ? BF : BB;
                A_[lane] = a0; A_[lane + 64] = a1; C_[lane] = fmaxf(x0, mp); C_[lane + 64] = fmaxf(x1, mp); B_[lane] = b0; B_[lane + 64] = b1;
            }
        }
        __syncthreads();
        const bf16x8 bq0 = frag_row(Qimg, 16 * wave, 0, lane), bq1 = frag_row(Qimg, 16 * wave, 32, lane);
        f32x4 st[8];
#pragma unroll
        for (int kt = 0; kt < 8; ++kt) { f32x4 z = {0.f, 0.f, 0.f, 0.f}; z = mfma16(frag_row(Kimg, 16 * kt, 0, lane), bq0, z); st[kt] = mfma16(frag_row(Kimg, 16 * kt, 32, lane), bq1, z); }
        const int row = row0 + qi;
        if (KIND == 0) {
            const float lgf = logsigmoidf_(a.in[9][(l * 2 + 0) * 4 + h]), lgb = logsigmoidf_(a.in[9][(l * 2 + 1) * 4 + h]);
            f32x4 acc[4];
#pragma unroll
            for (int et = 0; et < 4; ++et) {
                f32x4 zf = {0.f, 0.f, 0.f, 0.f}, zb = zf;
                zf = mfma16(frag_row(SFimg, 16 * et, 0, lane), bq0, zf); zf = mfma16(frag_row(SFimg, 16 * et, 32, lane), bq1, zf);
                zb = mfma16(frag_row(SBimg, 16 * et, 0, lane), bq0, zb); zb = mfma16(frag_row(SBimg, 16 * et, 32, lane), bq1, zb);
                acc[et] = zf * __expf(lgf * (float)(qi + 1)) + zb * __expf(lgb * (float)(128 - qi));
            }
#pragma unroll
            for (int T = 0; T < 4; ++T) {
                f32x4 p0, p1;
#pragma unroll
                for (int j = 0; j < 4; ++j) {
                    const int k0 = 32 * T + 4 * g + j, k1 = k0 + 16;
                    const float w0 = (k0 <= qi ? __expf(lgf * (float)(qi - k0)) : 0.f) + (k0 >= qi ? __expf(lgb * (float)(k0 - qi)) : 0.f);
                    const float w1 = (k1 <= qi ? __expf(lgf * (float)(qi - k1)) : 0.f) + (k1 >= qi ? __expf(lgb * (float)(k1 - qi)) : 0.f);
                    p0[j] = st[2 * T][j] * w0; p1[j] = st[2 * T + 1][j] * w1;
                }
                const bf16x8 bp = pack8(p0, p1);
#pragma unroll
                for (int et = 0; et < 4; ++et) acc[et] = mfma16(frag_tr<true>(Vimg, 32 * T, 16 * et, lane), bp, acc[et]);
            }
            float ss = 0.f;
#pragma unroll
            for (int et = 0; et < 4; ++et) ss += (acc[et][0] * acc[et][0] + acc[et][1] * acc[et][1]) + (acc[et][2] * acc[et][2] + acc[et][3] * acc[et][3]);
            ss = sum_g4(ss);
            const float rs = rsqrtf(ss * (1.0f / 64.0f) + EPS);
#pragma unroll
            for (int et = 0; et < 4; ++et) { const int e0 = h * 64 + 16 * et + 4 * g;
                const u32x2 gw = *(const u32x2*)(P + (size_t)row * NPW + PC_RG + e0);
                u32x2 o; o.x = pk2(siluf_(bflo(gw.x)) * acc[et][0] * rs, siluf_(bfhi(gw.x)) * acc[et][1] * rs); o.y = pk2(siluf_(bflo(gw.y)) * acc[et][2] * rs, siluf_(bfhi(gw.y)) * acc[et][3] * rs);
                *(u32x2*)(MG + (size_t)row * DM + e0) = o; }
        } else {
            const float cf = CF[qi], cb = CB[qi];
            const float gf = __expf(mpf - cf), gb = __expf(mpb - cb);
            f32x4 af[5], ab[5];
#pragma unroll
            for (int et = 0; et < 5; ++et) {
                f32x4 zf = {0.f, 0.f, 0.f, 0.f}, zb = zf;
                zf = mfma16(frag_row(SFimg, 16 * et, 0, lane), bq0, zf); zf = mfma16(frag_row(SFimg, 16 * et, 32, lane), bq1, zf);
                zb = mfma16(frag_row(SBimg, 16 * et, 0, lane), bq0, zb); zb = mfma16(frag_row(SBimg, 16 * et, 32, lane), bq1, zb);
                af[et] = zf * gf; ab[et] = zb * gb;
            }
#pragma unroll
            for (int T = 0; T < 4; ++T) {
                const f32x4 a0f = *(const LAS f32x4*)(AF + 32 * T + 4 * g), a1f = *(const LAS f32x4*)(AF + 32 * T + 16 + 4 * g);
                const f32x4 a0b = *(const LAS f32x4*)(AB + 32 * T + 4 * g), a1b = *(const LAS f32x4*)(AB + 32 * T + 16 + 4 * g);
                f32x4 pf0, pf1, pb0, pb1;
#pragma unroll
                for (int j = 0; j < 4; ++j) {
                    const int k0 = 32 * T + 4 * g + j, k1 = k0 + 16;
                    pf0[j] = k0 <= qi ? st[2 * T][j] * __expf(a0f[j] - cf) : 0.f; pf1[j] = k1 <= qi ? st[2 * T + 1][j] * __expf(a1f[j] - cf) : 0.f;
                    pb0[j] = k0 >= qi ? st[2 * T][j] * __expf(a0b[j] - cb) : 0.f; pb1[j] = k1 >= qi ? st[2 * T + 1][j] * __expf(a1b[j] - cb) : 0.f;
                }
                const bf16x8 bpf = pack8(pf0, pf1), bpb = pack8(pb0, pb1);
#pragma unroll
                for (int et = 0; et < 5; ++et) { const bf16x8 va = frag_tr<true>(Vimg, 32 * T, 16 * et, lane); af[et] = mfma16(va, bpf, af[et]); ab[et] = mfma16(va, bpb, ab[et]); }
            }
            const float denf = lane_get(af[4][0], lane & 15), denb = lane_get(ab[4][0], lane & 15);
            const float nf = 1.0f / fmaxf(fabsf(denf), __expf(-(BF[qi] + cf))), nb = 1.0f / fmaxf(fabsf(denb), __expf(-(BB[qi] + cb)));
            f32x4 y[4]; float ss = 0.f;
#pragma unroll
            for (int et = 0; et < 4; ++et) { y[et] = af[et] * nf + ab[et] * nb; ss += (y[et][0] * y[et][0] + y[et][1] * y[et][1]) + (y[et][2] * y[et][2] + y[et][3] * y[et][3]); }
            ss = sum_g4(ss);
            const float rs = rsqrtf(ss * (1.0f / 64.0f) + EPS);
#pragma unroll
            for (int et = 0; et < 4; ++et) { const int e0 = h * 64 + 16 * et + 4 * g;
                const u32x2 gw = *(const u32x2*)(P + (size_t)row * NPW + PC_MO + e0);
                u32x2 o; o.x = pk2(sigmoidf_(bflo(gw.x)) * y[et][0] * rs, sigmoidf_(bfhi(gw.x)) * y[et][1] * rs); o.y = pk2(sigmoidf_(bflo(gw.y)) * y[et][2] * rs, sigmoidf_(bfhi(gw.y)) * y[et][3] * rs);
                *(u32x2*)(MG + (size_t)row * DM + 256 + e0) = o; }
        }
    }
}

__device__ __forceinline__ void phase_natt_mfma(const Args& a, int l, bool need_ctx, LAS unsigned char* lds, int tid, int lane, int wave, int bid, int G) {
    unsigned char* ws = a.ws;
    const bf16_t* P = (const bf16_t*)(ws + WS_BIG); bf16_t* MG = (bf16_t*)(ws + WS_H);
    LAS unsigned char* Qimg = lds; LAS unsigned char* Kimg = lds + 10240; LAS unsigned char* Vimg = lds + 51200;
    LAS float* RPB = (LAS float*)(lds + 92160); LAS float* XCH = (LAS float*)(lds + 94208);
    const int nlat = NB * 8 * NROWS, nitems = nlat + (need_ctx ? NB * 8 * 4 : 0);
    const int g = lane >> 4, qt = wave & 3, kh = wave >> 2, ql = 16 * qt + (lane & 15);
    for (int it = bid; it < nitems; it += G) {
        const bool lat = it < nlat; int b, h, r = 0, qrow0, sr = 0;
        if (lat) { r = it & 31; h = (it >> 5) & 7; b = it >> 8; qrow0 = b * SEQ + r * 64; sr = min(max(r - 4, 0), NROWS - 8); }
        else { const int j = it - nlat; const int qb = j & 3; h = (j >> 2) & 7; b = j >> 5; qrow0 = NLAT + b * CTXL + 64 * qb; }
        const int nblk = lat ? 3 : 1;
        __syncthreads();
        { const int rr = tid >> 3, c8 = (tid & 7) * 8; *(LAS u32x4*)(Qimg + rr * IST + c8 * 2) = *(const u32x4*)(P + (size_t)(qrow0 + rr) * NPW + PC_NQ + h * 64 + c8); }
        if (tid < 465) RPB[tid] = a.in[15][(size_t)(l * 8 + h) * 465 + tid];
        float m_run = -1.0e30f, l_run = 0.f; f32x4 acc[4];
#pragma unroll
        for (int et = 0; et < 4; ++et) acc[et] = (f32x4){0.f, 0.f, 0.f, 0.f};
        const int scq = min(max(ql - 8, 0), GRIDW - 16);
        const int tlo = min(max(16 * qt - 8, 0), 48), thi = min(max(16 * qt + 7, 0), 48) + 15;
        for (int blk = 0; blk < nblk; ++blk) {
            const bool local = lat && blk < 2;
            const int krow0 = local ? b * SEQ + sr * 64 + 256 * blk : NLAT + b * CTXL;
            if (blk > 0) __syncthreads();
            { const int rr = tid >> 1, c0 = (tid & 1) * 32; const bf16_t* ks = P + (size_t)(krow0 + rr) * NPW + PC_NK + h * 64 + c0; const bf16_t* vs = P + (size_t)(krow0 + rr) * NPW + PC_NV + h * 64 + c0;
#pragma unroll
              for (int i = 0; i < 4; ++i) { *(LAS u32x4*)(Kimg + rr * IST + (c0 + 8 * i) * 2) = *(const u32x4*)(ks + 8 * i); *(LAS u32x4*)(Vimg + rr * IST + (c0 + 8 * i) * 2) = *(const u32x4*)(vs + 8 * i); } }
            __syncthreads();
            const bf16x8 bq0 = frag_row(Qimg, 16 * qt, 0, lane), bq1 = frag_row(Qimg, 16 * qt, 32, lane);
            f32x4 s[8]; float mx = -1.0e30f;
#pragma unroll
            for (int kt = 0; kt < 8; ++kt) {
                const int tk = 8 * kh + kt, ct = tk & 3; const bool tv = !local || (16 * ct + 15 >= tlo && 16 * ct <= thi);
                if (tv) {
                    f32x4 z = {0.f, 0.f, 0.f, 0.f}; z = mfma16(frag_row(Kimg, 16 * tk, 0, lane), bq0, z); z = mfma16(frag_row(Kimg, 16 * tk, 32, lane), bq1, z);
                    if (local) { const int kk = 4 * blk + (tk >> 2); const LAS float* brow = RPB + (sr + kk - r + 7) * 31;
#pragma unroll
                        for (int j = 0; j < 4; ++j) { const int kcol = 16 * ct + 4 * g + j; const bool ok = kcol >= scq && kcol < scq + 16;
                            z[j] = ok ? z[j] * 0.125f + brow[min(max(kcol - ql + 15, 0), 30)] : -1.0e30f; }
                    } else z = z * 0.125f;
                    s[kt] = z; mx = fmaxf(mx, fmaxf(fmaxf(z[0], z[1]), fmaxf(z[2], z[3])));
                } else s[kt] = (f32x4){-1.0e30f, -1.0e30f, -1.0e30f, -1.0e30f};
            }
            mx = max_g4(mx);
            const float m_new = fmaxf(m_run, mx), resc = __expf(m_run - m_new);
            m_run = m_new; l_run *= resc;
#pragma unroll
            for (int et = 0; et < 4; ++et) acc[et] = acc[et] * resc;
#pragma unroll
            for (int T = 0; T < 4; ++T) {
                f32x4 p0, p1;
#pragma unroll
                for (int j = 0; j < 4; ++j) { p0[j] = s[2 * T][j] > -1.0e29f ? __expf(s[2 * T][j] - m_new) : 0.f; p1[j] = s[2 * T + 1][j] > -1.0e29f ? __expf(s[2 * T + 1][j] - m_new) : 0.f; }
                l_run += (p0[0] + p0[1]) + (p0[2] + p0[3]) + (p1[0] + p1[1]) + (p1[2] + p1[3]);
                const bf16x8 bp = pack8(p0, p1);
#pragma unroll
                for (int et = 0; et < 4; ++et) acc[et] = mfma16(frag_tr<true>(Vimg, 128 * kh + 32 * T, 16 * et, lane), bp, acc[et]);
            }
        }
        l_run = sum_g4(l_run);
        LAS float* xw = XCH + (qt * 64 + lane) * 18;
        if (kh == 1) { xw[0] = m_run; xw[1] = l_run;
#pragma unroll
            for (int et = 0; et < 4; ++et)
#pragma unroll
                for (int j = 0; j < 4; ++j) xw[2 + et * 4 + j] = acc[et][j]; }
        __syncthreads();
        if (kh == 0) {
            const float m1 = xw[0], l1 = xw[1]; const float mt = fmaxf(m_run, m1), f0 = __expf(m_run - mt), f1 = __expf(m1 - mt);
            const float inv = 1.0f / (l_run * f0 + l1 * f1);
            const int row = qrow0 + ql;
#pragma unroll
            for (int et = 0; et < 4; ++et) { float o[4];
#pragma unroll
                for (int j = 0; j < 4; ++j) o[j] = (acc[et][j] * f0 + xw[2 + et * 4 + j] * f1) * inv;
                u32x2 w; w.x = pk2(o[0], o[1]); w.y = pk2(o[2], o[3]);
                *(u32x2*)(MG + (size_t)row * DM + 512 + h * 64 + 16 * et + 4 * g) = w; }
        }
    }
}

constexpr int MOE_TAB_OFF = 131072;
__device__ __forceinline__ void moe_tab_setup(const unsigned char* ws, LAS unsigned char* lds, int tid) {
    if (tid == 0) { LAS int* tab = (LAS int*)(lds + MOE_TAB_OFF); int p = 0;
        for (int e = 0; e < NEXP; ++e) { const int c = (int)__hip_atomic_load((const unsigned*)(ws + WS_CTL) + CW_MOE + 64 * e, __ATOMIC_RELAXED, __HIP_MEMORY_SCOPE_AGENT); tab[e] = p; tab[16 + e] = c; p += (c + 255) >> 8; }
        tab[8] = p; }
    __syncthreads();
}
namespace pg8 {
struct MoeOrder : StaticOrder {
    const PG8_LAS int* tab; const int* list; size_t bstride;
    __device__ __forceinline__ int expert(int pm) const { int e = 0;
#pragma unroll
        for (int k = 1; k < 8; ++k) e += (pm >= tab[k]) ? 1 : 0;
        return e; }
    __device__ __forceinline__ unsigned arow(const Unit& u, int R) const {
        if (!list) return (unsigned)(u.pm * BM + R);
        const int e = expert(u.pm), idx = (u.pm - tab[e]) * BM + R;
        return idx < tab[16 + e] ? (unsigned)list[e * NLAT + idx] : 0u; }
    __device__ __forceinline__ const char* bbase(const Unit& u) const { return Bt + (size_t)expert(u.pm) * bstride + (size_t)u.pn * BM * K2; }
};
}
__device__ __forceinline__ void phase_moe_combine(const Args& a, LAS unsigned char* lds, int lane, int wave, int bid, int G) {
    unsigned char* ws = a.ws; const LAS int* tab = (const LAS int*)(lds + MOE_TAB_OFF);
    const int* TOK = (const int*)(ws + WS_COMB); const bf16_t* Y = (const bf16_t*)(ws + WS_WTMUP);
    const float* g2 = (const float*)(ws + WS_MOD) + (size_t)9 * 6144 + 5120;
    for (int r = bid * NWAVES + wave; r < NLAT; r += G * NWAVES) {
        const int e1 = TOK[r * 8], e2 = TOK[r * 8 + 1], p1 = TOK[r * 8 + 2], p2 = TOK[r * 8 + 3]; const float w1 = __int_as_float(TOK[r * 8 + 4]), w2 = __int_as_float(TOK[r * 8 + 5]);
        const bf16_t* y1 = Y + ((size_t)tab[e1] * 256 + p1) * DM; const bf16_t* y2 = Y + ((size_t)tab[e2] * 256 + p2) * DM;
        const float* gr = g2 + (size_t)(r >> 11) * 6144; float* o = a.out + (size_t)r * DM;
#pragma unroll
        for (int j = 0; j < 4; ++j) { const int k = 4 * lane + 256 * j;
            const u32x2 a1 = *(const u32x2*)(y1 + k), a2 = *(const u32x2*)(y2 + k); const f32x4 x = *(const f32x4*)(o + k), gg = *(const f32x4*)(gr + k);
            f32x4 m; m.x = w1 * bflo(a1.x) + w2 * bflo(a2.x); m.y = w1 * bfhi(a1.x) + w2 * bfhi(a2.x); m.z = w1 * bflo(a1.y) + w2 * bflo(a2.y); m.w = w1 * bfhi(a1.y) + w2 * bfhi(a2.y);
            *(f32x4*)(o + k) = x + gg * m; }
    }
}
#ifndef PH_ONLY
#define PH_ONLY 0
#endif
#ifndef MIX_NAIVE
#define MIX_NAIVE 0
#endif
#ifndef MIX_RET
#define MIX_RET 1
#endif
#ifndef MIX_ML
#define MIX_ML 1
#endif
#ifndef MIX_NA
#define MIX_NA 1
#endif
#ifndef EN_PRO
#define EN_PRO 1
#endif
#ifndef EN_NORM
#define EN_NORM 1
#endif
#ifndef EN_GIN
#define EN_GIN 1
#endif
#ifndef EN_POST
#define EN_POST 1
#endif
#ifndef EN_FCUM
#define EN_FCUM 1
#endif
#ifndef EN_QUAD
#define EN_QUAD 1
#endif
#ifndef EN_NATT
#define EN_NATT 1
#endif
#ifndef EN_MERGE
#define EN_MERGE 1
#endif
#ifndef EN_GOUT
#define EN_GOUT 1
#endif
#ifndef EN_NORM2
#define EN_NORM2 1
#endif
#ifndef EN_GUP
#define EN_GUP 1
#endif
#ifndef EN_GDN
#define EN_GDN 1
#endif

__global__ void __launch_bounds__(NTHR, 2) fwd_kernel(Args a_) {
    extern __shared__ __attribute__((aligned(16))) unsigned char lds_raw[];
    LAS unsigned char* lds = (LAS unsigned char*)lds_raw;
    const int tid0 = threadIdx.x, G = gridDim.x, bid = blockIdx.x; const int wave0 = __builtin_amdgcn_readfirstlane(tid0 >> 6);
    unsigned char* ws0 = a_.ws;
    volatile LAS unsigned* MISC = (volatile LAS unsigned*)(lds + MISC_OFF);
    if (tid0 < 32) MISC[tid0] = 0u;
    __syncthreads();
    const int lo = a_.ph_lo, hi = a_.ph_hi;
    XcdBarrier bar; bar.bar = (unsigned*)(ws0 + WS_CTL) + CW_BAR; bar.x = 0; bar.st = MISC + 8;
    if (hi - lo > 1) bar = xcd_barrier_post((unsigned*)(ws0 + WS_CTL) + CW_BAR, MISC + 8);
    int ph = 0;
#define PH_BEGIN if (ph >= lo && ph < hi) { asm volatile("; PHMARK_BEGIN %0" :: "i"(__LINE__)); int tid = wave0 * 64 + (int)__builtin_amdgcn_mbcnt_hi(~0u, __builtin_amdgcn_mbcnt_lo(~0u, 0u)); asm volatile("" : "+v"(tid)); Args a; { const __attribute__((address_space(4))) Args* ap = (const __attribute__((address_space(4))) Args*)__builtin_amdgcn_kernarg_segment_ptr(); asm volatile("" : "+s"(ap)); a = *(const Args*)ap; } unsigned char* ws = a.ws; (void)ws; if (PH_ONLY == 0 || PH_ONLY == __LINE__) { const int lane = tid & 63, wave = __builtin_amdgcn_readfirstlane(tid >> 6); (void)lane; (void)wave;
#define PH_END   } asm volatile("; PHMARK_END %0" :: "i"(__LINE__)); if (ph + 1 < hi) xcd_barrier(bar); else __syncthreads(); } ++ph;

    PH_BEGIN
#if EN_PRO
 phase_prologue(a, lds, tid, lane, wave, bid, G);
#endif
 PH_END

    for (int l = 0; l < 2; ++l) {
        const bool need_ctx = (l == 0);
#define MODP ((const float*)(ws + WS_MOD) + (size_t)l * 9 * 6144)
        PH_BEGIN
#if EN_NORM
 phase_norm<0>(a, l, lds, tid, lane, wave, bid, G);
#endif
 PH_END
        PH_BEGIN
#if EN_GIN
 { pg8::Gemm g{(const bf16_t*)(ws + WS_H), (const bf16_t*)(ws + WS_WTIN) + (size_t)l * NPW * DM, MALL, NPW, DM};
                   pg8::StaticOrder S; S.init(MALL, NPW, G, bid); S.Bt = (const char*)g.Bt; S.K2 = 2 * DM; pg8::EpiBf16 E{(bf16_t*)(ws + WS_BIG), NPW};
                   pg8::gemm_phase<pg8::EpiBf16, pg8::StaticOrder, false>(lds, g, S, E, nullptr, tid); }
#endif
 PH_END
        PH_BEGIN
#if EN_POST
 phase_post(a, l, lane, wave, bid, G);
#endif
 PH_END
#if MIX_NAIVE
        PH_BEGIN phase_fcum(a, lane, wave, bid, G); PH_END
        PH_BEGIN phase_quad(a, l, need_ctx, lds, lane, wave, bid, G); phase_natt(a, l, need_ctx, lds, lane, wave, bid, G); PH_END
        PH_BEGIN phase_merge(a, need_ctx, lane, wave, bid, G); PH_END
#endif
        PH_BEGIN
#if MIX_RET || MIX_ML
        phase_chunk_sums(a, l, lds, tid, lane, wave, bid, G);
#endif
        PH_END
        PH_BEGIN
#if MIX_RET
        phase_chunk_out<0>(a, l, need_ctx, lds, tid, lane, wave, bid, G);
#endif
#if MIX_ML
        phase_chunk_out<1>(a, l, need_ctx, lds, tid, lane, wave, bid, G);
#endif
#if MIX_NA
        phase_natt_mfma(a, l, need_ctx, lds, tid, lane, wave, bid, G);
#endif
        PH_END
        PH_BEGIN
#if EN_GOUT
 { const int M = need_ctx ? MALL : NLAT;
                   pg8::Gemm g{(const bf16_t*)(ws + WS_H), (const bf16_t*)(ws + WS_WTOUT) + (size_t)l * DM * DM, M, DM, DM};
                   pg8::StaticOrder S; S.init(M, DM, G, bid); S.Bt = (const char*)g.Bt; S.K2 = 2 * DM;
                   pg8::EpiResid E{l == 0 ? a.in[0] : a.out, l == 0 ? a.in[2] : (const float*)(ws + WS_XC), a.out, (float*)(ws + WS_XC), MODP + 2048, nullptr, 0, NLAT / 256};
                   pg8::gemm_phase<pg8::EpiResid, pg8::StaticOrder, false>(lds, g, S, E, nullptr, tid); }
#endif
 PH_END
        if (l == 0) { PH_BEGIN
#if EN_NORM2
 phase_norm<1>(a, l, lds, tid, lane, wave, bid, G);
#endif
 PH_END }
        else        { PH_BEGIN
#if EN_NORM2
 phase_norm<2>(a, l, lds, tid, lane, wave, bid, G);
#endif
 PH_END }
        if (l == 0) {
            PH_BEGIN { pg8::Gemm g{(const bf16_t*)(ws + WS_H), (const bf16_t*)(ws + WS_WTUP), MALL, NUP, DM};
                       pg8::StaticOrder S; S.init(MALL, NUP, G, bid); S.Bt = (const char*)g.Bt; S.K2 = 2 * DM; pg8::EpiSwiGLU E{(bf16_t*)(ws + WS_BIG), DFF};
                       pg8::gemm_phase<pg8::EpiSwiGLU, pg8::StaticOrder, false>(lds, g, S, E, nullptr, tid); } PH_END
            PH_BEGIN { pg8::Gemm g{(const bf16_t*)(ws + WS_BIG), (const bf16_t*)(ws + WS_WTDN), MALL, DM, DFF};
                       pg8::StaticOrder S; S.init(MALL, DM, G, bid); S.Bt = (const char*)g.Bt; S.K2 = 2 * DFF;
                       pg8::EpiResid E{a.out, (const float*)(ws + WS_XC), a.out, (float*)(ws + WS_XC), MODP + 5120, nullptr, 0, NLAT / 256};
                       pg8::gemm_phase<pg8::EpiResid, pg8::StaticOrder, false>(lds, g, S, E, nullptr, tid); } PH_END
        } else {
            PH_BEGIN { moe_tab_setup(ws, lds, tid); const LAS int* tab = (const LAS int*)(lds + MOE_TAB_OFF);
                       pg8::Gemm g{(const bf16_t*)(ws + WS_H), (const bf16_t*)(ws + WS_WTMUP), 256 * tab[8], NUP, DM};
                       pg8::MoeOrder S; S.init(256 * tab[8], NUP, G, bid); S.Bt = (const char*)g.Bt; S.K2 = 2 * DM; S.tab = tab; S.list = (const int*)(ws + WS_LIST); S.bstride = (size_t)NUP * DM * 2;
                       pg8::EpiSwiGLU E{(bf16_t*)(ws + WS_BIG), DFF};
                       pg8::gemm_phase<pg8::EpiSwiGLU, pg8::MoeOrder, false>(lds, g, S, E, nullptr, tid); } PH_END
            PH_BEGIN { moe_tab_setup(ws, lds, tid); const LAS int* tab = (const LAS int*)(lds + MOE_TAB_OFF);
                       pg8::Gemm g{(const bf16_t*)(ws + WS_BIG), (const bf16_t*)(ws + WS_WTMDN), 256 * tab[8], DM, DFF};
                       pg8::MoeOrder S; S.init(256 * tab[8], DM, G, bid); S.Bt = (const char*)g.Bt; S.K2 = 2 * DFF; S.tab = tab; S.list = nullptr; S.bstride = (size_t)DM * DFF * 2;
                       pg8::EpiBf16 E{(bf16_t*)(ws + WS_WTMUP), DM};
                       pg8::gemm_phase<pg8::EpiBf16, pg8::MoeOrder, false>(lds, g, S, E, nullptr, tid); } PH_END
            PH_BEGIN { moe_tab_setup(ws, lds, tid); phase_moe_combine(a, lds, lane, wave, bid, G); } PH_END
        }
    }
#undef PH_BEGIN
#undef PH_END
}
constexpr int N_PHASES = 1 + 2 * (7 + (MIX_NAIVE ? 3 : 0)) + 2 + 3;
#ifndef DBG_MAXPH
#define DBG_MAXPH 1000
#endif

extern "C" void kernel_launch(void* const* d_in, const int* in_sizes, int n_in, void* d_out, int out_size, void* d_ws, size_t ws_size, hipStream_t stream) {
    static int grid = 0;
    if (grid == 0) {
        if (n_in != 24 || out_size != NLAT * DM || ws_size < WS_END) { fprintf(stderr, "kernel_launch: unexpected sizes (n_in %d, out %d, ws %zu < %zu); nothing launched\n", n_in, out_size, ws_size, (size_t)WS_END); grid = -1; return; }
        int dev = 0, cus = 0;
        if (hipGetDevice(&dev) != hipSuccess || hipDeviceGetAttribute(&cus, hipDeviceAttributeMultiprocessorCount, dev) != hipSuccess) { grid = -1; return; }
        if (hipFuncSetAttribute((const void*)fwd_kernel, hipFuncAttributeMaxDynamicSharedMemorySize, LDS_BYTES) != hipSuccess) { fprintf(stderr, "kernel_launch: hipFuncSetAttribute failed\n"); grid = -1; return; }
        int per_cu = 0;
        if (hipOccupancyMaxActiveBlocksPerMultiprocessor(&per_cu, (const void*)fwd_kernel, NTHR, LDS_BYTES) != hipSuccess || per_cu < 1) { fprintf(stderr, "kernel_launch: occupancy query says %d\n", per_cu); }
        (void)hipGetLastError();
        grid = cus;
    }
    if (grid < 0) return;
    (void)hipMemsetAsync((char*)d_ws + WS_CTL, 0, CTL_BYTES, stream);
    Args a{};
    for (int i = 0; i < 24; ++i) a.in[i] = (const float*)d_in[i];
    a.out = (float*)d_out; a.ws = (unsigned char*)d_ws;
#if N_LAUNCH_MODE == 0
    a.ph_lo = 0; a.ph_hi = N_PHASES;
    hipLaunchKernelGGL(fwd_kernel, dim3(grid), dim3(NTHR), LDS_BYTES, stream, a);
#else
    for (int p = 0; p < N_PHASES && p < DBG_MAXPH; ++p) { a.ph_lo = p; a.ph_hi = p + 1; hipLaunchKernelGGL(fwd_kernel, dim3(grid), dim3(NTHR), LDS_BYTES, stream, a); }
#endif
}
```

```cpp
#include <hip/hip_runtime.h>
#include <stdio.h>
#include <stdint.h>

#ifndef N_LAUNCH_MODE
#define N_LAUNCH_MODE 0
#endif

constexpr int NB = 8, SEQ = 2048, DM = 1024, CTXL = 256, HD = 64;
constexpr int NLAT = NB * SEQ, NCTX = NB * CTXL, MALL = NLAT + NCTX;
constexpr int DIN = 3600, NPW = 3584;
constexpr int DFF = 2816, NUP = 2 * DFF, NEXP = 8;
constexpr int GRIDW = 64, NROWS = 32;
constexpr float EPS = 1e-6f;
constexpr int PC_RQ = 0, PC_RK = 256, PC_RV = 512, PC_RG = 768, PC_MQ = 1024, PC_MK = 1280, PC_MV = 1536, PC_MO = 1792, PC_NQ = 2048, PC_NK = 2560, PC_NV = 3072;

constexpr size_t al256(size_t x) { return (x + 255) & ~(size_t)255; }
constexpr size_t WS_CTL = 0, CTL_BYTES = 1u << 20;
constexpr size_t WS_MOD = WS_CTL + CTL_BYTES;
constexpr size_t WS_ROPE = WS_MOD + al256((size_t)2 * 9 * 6144 * 4);
constexpr size_t WS_WTIN = WS_ROPE + al256(64 * 16 * 2 * 4);
constexpr size_t WS_WTOUT = WS_WTIN + (size_t)2 * NPW * DM * 2;
constexpr size_t WS_WTUP = WS_WTOUT + (size_t)2 * DM * DM * 2;
constexpr size_t WS_WTDN = WS_WTUP + (size_t)NUP * DM * 2;
constexpr size_t WS_WTMUP = WS_WTDN + (size_t)DM * DFF * 2;
constexpr size_t WS_WTMDN = WS_WTMUP + (size_t)NEXP * NUP * DM * 2;
constexpr size_t WS_H = WS_WTMDN + (size_t)NEXP * DM * DFF * 2;
constexpr size_t WS_XC = WS_H + (size_t)MALL * DM * 2;
constexpr size_t WS_GATES = WS_XC + (size_t)NCTX * DM * 4;
constexpr size_t WS_COMB = WS_GATES + (size_t)MALL * 16 * 4;
constexpr size_t WS_USC = WS_COMB + (size_t)NLAT * 8 * 4;
constexpr size_t WS_SM = WS_USC + al256((size_t)NB * 4 * 2 * 18 * 2 * 4);
constexpr size_t WS_LIST = WS_SM + al256((size_t)NB * 4 * 2 * 18 * 4);
constexpr size_t WS_BIG = WS_LIST + (size_t)NEXP * NLAT * 4;
constexpr size_t WS_MQK = WS_BIG + (size_t)MALL * NPW * 2;
constexpr size_t WS_U = WS_MQK + (size_t)MALL * 512 * 2;
constexpr size_t WS_S = WS_U + (size_t)2 * NB * 4 * 2 * 18 * 80 * 64 * 2;
constexpr size_t WS_END0 = WS_S + (size_t)2 * NB * 4 * 2 * 18 * 80 * 64 * 2;
constexpr size_t MOE_ROWS = 34816;
constexpr size_t WS_ACTM_END = WS_BIG + MOE_ROWS * DFF * 2;
constexpr size_t WS_END = WS_END0 > WS_ACTM_END ? WS_END0 : WS_ACTM_END;

typedef unsigned short bf16_t;
typedef float f32x4 __attribute__((ext_vector_type(4)));
typedef float f32x2 __attribute__((ext_vector_type(2)));
typedef unsigned u32x4 __attribute__((ext_vector_type(4)));
typedef unsigned u32x2 __attribute__((ext_vector_type(2)));
#define LAS __attribute__((address_space(3)))
#define GAS __attribute__((address_space(1)))

__device__ __forceinline__ float bf2f(bf16_t b) { return __uint_as_float(((unsigned)b) << 16); }
__device__ __forceinline__ unsigned f2bf(float f) { unsigned u = __float_as_uint(f); return (u + 0x7fffu + ((u >> 16) & 1u)) >> 16; }
__device__ __forceinline__ unsigned pk2(float lo, float hi) { return f2bf(lo) | (f2bf(hi) << 16); }
__device__ __forceinline__ float bflo(unsigned w) { return __uint_as_float(w << 16); }
__device__ __forceinline__ float bfhi(unsigned w) { return __uint_as_float(w & 0xffff0000u); }
__device__ __forceinline__ float sigmoidf_(float x) { return 1.0f / (1.0f + __expf(-x)); }
__device__ __forceinline__ float siluf_(float x) { return x / (1.0f + __expf(-x)); }
__device__ __forceinline__ float logsigmoidf_(float x) { return fminf(x, 0.f) - log1pf(__expf(-fabsf(x))); }
template <int O> __device__ __forceinline__ float swz_xor(float v) { return __int_as_float(__builtin_amdgcn_ds_swizzle(__float_as_int(v), (O << 10) | 0x1f)); }
__device__ __forceinline__ float red32_sum(float v) { const auto r = __builtin_amdgcn_permlane32_swap(__float_as_uint(v), __float_as_uint(v), false, false); return __uint_as_float(r[0]) + __uint_as_float(r[1]); }
__device__ __forceinline__ float red32_max(float v) { const auto r = __builtin_amdgcn_permlane32_swap(__float_as_uint(v), __float_as_uint(v), false, false); return fmaxf(__uint_as_float(r[0]), __uint_as_float(r[1])); }
__device__ __forceinline__ float wave_sum(float v) { v += swz_xor<1>(v); v += swz_xor<2>(v); v += swz_xor<4>(v); v += swz_xor<8>(v); v += swz_xor<16>(v); return red32_sum(v); }
__device__ __forceinline__ float wave_max(float v) { v = fmaxf(v, swz_xor<1>(v)); v = fmaxf(v, swz_xor<2>(v)); v = fmaxf(v, swz_xor<4>(v)); v = fmaxf(v, swz_xor<8>(v)); v = fmaxf(v, swz_xor<16>(v)); return red32_max(v); }
__device__ __forceinline__ float sum_g4(float v) { v += swz_xor<16>(v); return red32_sum(v); }
__device__ __forceinline__ float max_g4(float v) { v = fmaxf(v, swz_xor<16>(v)); return red32_max(v); }
__device__ __forceinline__ float reduce16_lanes(const float (&p)[16], int lane) {
    float q[8], r[4], s[2];
#pragma unroll
    for (int j = 0; j < 8; ++j) { const auto x = __builtin_amdgcn_permlane32_swap(__float_as_uint(p[j]), __float_as_uint(p[j + 8]), false, false); q[j] = __uint_as_float(x[0]) + __uint_as_float(x[1]); }
    const bool b4 = (lane & 16) != 0, b3 = (lane & 8) != 0, b2 = (lane & 4) != 0;
#pragma unroll
    for (int j = 0; j < 4; ++j) { const float keep = b4 ? q[j + 4] : q[j], send = b4 ? q[j] : q[j + 4]; r[j] = keep + swz_xor<16>(send); }
#pragma unroll
    for (int j = 0; j < 2; ++j) { const float keep = b3 ? r[j + 2] : r[j], send = b3 ? r[j] : r[j + 2]; s[j] = keep + swz_xor<8>(send); }
    float v; { const float keep = b2 ? s[1] : s[0], send = b2 ? s[0] : s[1]; v = keep + swz_xor<4>(send); }
    v += swz_xor<2>(v); v += swz_xor<1>(v);
    return v;
}
__device__ __forceinline__ float reduce8_lanes(const float (&p)[8], int lane) {
    float q[4], r[2];
#pragma unroll
    for (int j = 0; j < 4; ++j) { const auto x = __builtin_amdgcn_permlane32_swap(__float_as_uint(p[j]), __float_as_uint(p[j + 4]), false, false); q[j] = __uint_as_float(x[0]) + __uint_as_float(x[1]); }
    const bool b4 = (lane & 16) != 0, b3 = (lane & 8) != 0;
#pragma unroll
    for (int j = 0; j < 2; ++j) { const float keep = b4 ? q[j + 2] : q[j], send = b4 ? q[j] : q[j + 2]; r[j] = keep + swz_xor<16>(send); }
    float v; { const float keep = b3 ? r[1] : r[0], send = b3 ? r[0] : r[1]; v = keep + swz_xor<8>(send); }
    v += swz_xor<4>(v); v += swz_xor<2>(v); v += swz_xor<1>(v);
    return v;
}
__device__ __forceinline__ float lane_get(float v, int src_lane) { return __int_as_float(__builtin_amdgcn_ds_bpermute(src_lane << 2, __float_as_int(v))); }
__device__ __forceinline__ float lane_bcast(float v, int k) { return __int_as_float(__builtin_amdgcn_readlane(__float_as_int(v), k)); }

struct Args {
    const float* in[24];
    float* out;
    unsigned char* ws;
    int ph_lo, ph_hi;
};
namespace pg8 {
#define PG8_LAS __attribute__((address_space(3)))
typedef unsigned short bf16_t;
typedef short bf16x8 __attribute__((ext_vector_type(8)));
typedef float f32x4 __attribute__((ext_vector_type(4)));
typedef unsigned u32x4 __attribute__((ext_vector_type(4)));
constexpr int BM = 256, BK = 64, HALF = 128, HTB = HALF * BK * 2  , STAGE_BYTES = 8 * HTB, NXCD = 8, WGM = 8;

__host__ __device__ __forceinline__ int lds_byte(int r, int c) { const int st = (r >> 4) * 2 + (c >> 5), rr = r & 15, cc = c & 31, ob = rr * 64 + cc * 2; return st * 1024 + (ob ^ (((ob >> 9) & 1) << 5)); }
__host__ __device__ __forceinline__ void stage_rc(int b, int& R, int& C) { const int st = b / 1024, sb = b % 1024, swz = sb ^ (((sb >> 9) & 1) << 5); R = (st >> 1) * 16 + swz / 64; C = (st & 1) * 32 + (swz % 64) / 2; }
__host__ __device__ __forceinline__ int perm32(int rho) { const int n = rho >> 4, i = rho & 15; return 8 * (i >> 2) + 4 * n + (i & 3); }

struct Unit { int pm, pn, hs; };
struct Gemm { const bf16_t* A; const bf16_t* Bt; int M, N, K; };

struct StaticOrder {
    int nM, nN, nwg, G, c;
    __host__ __device__ void init(int M, int N, int G_, int c_) { nM = M / BM; nN = N / BM; nwg = nM * nN; G = G_; c = c_; }
    __host__ __device__ bool next(int i, Unit& u) const {
        const int nfr = nwg / G, left = nwg - nfr * G; int wgid; u.hs = -1;
        if (i < nfr) wgid = i * G + c;
        else if (i == nfr && left > 0) { if (2 * left <= G) { if (c >= 2 * left) return false; wgid = nfr * G + (c >> 1); u.hs = c & 1; } else { if (c >= left) return false; wgid = nfr * G + c; } }
        else return false; { const int q = nwg / NXCD, r = nwg % NXCD, xcd = wgid % NXCD, off = wgid / NXCD; wgid = (xcd < r ? xcd * (q + 1) : r * (q + 1) + (xcd - r) * q) + off; }
        const int nig = WGM * nN, gid = wgid / nig, fm = gid * WGM, gsz = (nM - fm) < WGM ? (nM - fm) : WGM;
        u.pm = fm + ((wgid % nig) % gsz); u.pn = (wgid % nig) / gsz; return true;
    }
    __device__ __forceinline__ void a_ready(const Unit&) const {}
    __device__ __forceinline__ void done(const Unit&) const {}
    const char* Bt; int K2;
    __device__ __forceinline__ unsigned arow(const Unit& u, int R) const { return (unsigned)(u.pm * BM + (u.hs > 0 ? HALF : 0) + (u.hs >= 0 ? (R & (HALF - 1)) : R)); }
    __device__ __forceinline__ const char* bbase(const Unit& u) const { return Bt + (size_t)u.pn * BM * K2; }
};
__device__ __forceinline__ unsigned cvt_pk_bf16(float lo, float hi) { unsigned r; asm volatile("v_cvt_pk_bf16_f32 %0, %1, %2" : "=v"(r) : "v"(lo), "v"(hi)); return r; }
typedef float f32x2 __attribute__((ext_vector_type(2)));
struct EpiBf16 {
    static constexpr bool PERM = true, AFTER_DRAIN = false;
    bf16_t* O; int ldc;
    __device__ __forceinline__ void operator()(const f32x4 (&acc)[2][2][4][2], const Unit& u, int wr, int wc, int fr, int fq) const {
        const int row0 = u.pm * BM + (u.hs > 0 ? HALF : 0) + wr * 64 + fr, col0 = u.pn * BM + wc * 32 + 8 * fq; const int nai = u.hs >= 0 ? 1 : 2;
#pragma unroll
        for (int ai = 0; ai < 2; ++ai) if (ai < nai)
#pragma unroll
            for (int m = 0; m < 4; ++m) { bf16_t* rowp = O + (size_t)(row0 + ai * HALF + m * 16) * ldc + col0;
#pragma unroll
                for (int bj = 0; bj < 2; ++bj) { const f32x4 v0 = acc[ai][bj][m][0], v1 = acc[ai][bj][m][1];
                    u32x4 w; w.x = cvt_pk_bf16(v0[0], v0[1]); w.y = cvt_pk_bf16(v0[2], v0[3]); w.z = cvt_pk_bf16(v1[0], v1[1]); w.w = cvt_pk_bf16(v1[2], v1[3]);
                    *(u32x4*)(rowp + bj * HALF) = w; } }
    }
};
struct EpiSwiGLU {
    static constexpr bool PERM = true, AFTER_DRAIN = false;
    bf16_t* O; int ldc;
    __device__ __forceinline__ void operator()(const f32x4 (&acc)[2][2][4][2], const Unit& u, int wr, int wc, int fr, int fq) const {
        const int row0 = u.pm * BM + (u.hs > 0 ? HALF : 0) + wr * 64 + fr, col0 = u.pn * HALF + wc * 32 + 8 * fq; const int nai = u.hs >= 0 ? 1 : 2;
#pragma unroll
        for (int ai = 0; ai < 2; ++ai) if (ai < nai)
#pragma unroll
            for (int m = 0; m < 4; ++m) { bf16_t* rowp = O + (size_t)(row0 + ai * HALF + m * 16) * ldc + col0;
                float r[8];
#pragma unroll
                for (int n = 0; n < 2; ++n)
#pragma unroll
                    for (int j = 0; j < 4; ++j) { const float g = acc[ai][0][m][n][j], uu = acc[ai][1][m][n][j]; r[n * 4 + j] = g / (1.0f + __expf(-g)) * uu; }
                u32x4 w; w.x = cvt_pk_bf16(r[0], r[1]); w.y = cvt_pk_bf16(r[2], r[3]); w.z = cvt_pk_bf16(r[4], r[5]); w.w = cvt_pk_bf16(r[6], r[7]);
                *(u32x4*)rowp = w; }
    }
};
struct EpiResid {
    static constexpr bool PERM = false, AFTER_DRAIN = false;
    const float* base_lat; const float* base_ctx; float* out_lat; float* out_ctx; const float* gate; const float* comb; int comb_ld; int nlat_tiles;
    __device__ __forceinline__ void operator()(const f32x4 (&acc)[2][2][4][2], const Unit& u, int wr, int wc, int fr, int fq) const {
        const bool isctx = u.pm >= nlat_tiles;
        const int rloc0 = (isctx ? (u.pm - nlat_tiles) : u.pm) * BM + (u.hs > 0 ? HALF : 0) + wr * 64 + fr, col0 = u.pn * BM + wc * 32 + 4 * fq; const int nai = u.hs >= 0 ? 1 : 2;
        const float* bp = isctx ? base_ctx : base_lat; float* op = isctx ? out_ctx : out_lat;
        const float* gp = gate + (size_t)(isctx ? 8 : (u.pm >> 3)) * 6144 + col0;
        f32x4 gv[2][2];
#pragma unroll
        for (int bj = 0; bj < 2; ++bj)
#pragma unroll
            for (int n = 0; n < 2; ++n) gv[bj][n] = *(const f32x4*)(gp + bj * HALF + n * 16);
#pragma unroll
        for (int ai = 0; ai < 2; ++ai) if (ai < nai)
#pragma unroll
            for (int m = 0; m < 4; ++m) { const int rl = rloc0 + ai * HALF + m * 16; const size_t off = (size_t)rl * 1024 + col0;
                const float cs = comb ? comb[(size_t)rl * comb_ld] : 1.0f;
#pragma unroll
                for (int bj = 0; bj < 2; ++bj)
#pragma unroll
                    for (int n = 0; n < 2; ++n) { const f32x4 bs = *(const f32x4*)(bp + off + bj * HALF + n * 16);
                        *(f32x4*)(op + off + bj * HALF + n * 16) = bs + gv[bj][n] * acc[ai][bj][m][n] * cs; } }
    }
};
template <class Epi, class Sched, bool STAMP = false>
__device__ __forceinline__ void gemm_phase(PG8_LAS unsigned char* lds, const Gemm g, const Sched& S, const Epi& E, unsigned long long* stamps, int tid_in) {
    int tid_ = tid_in; asm volatile("" : "+v"(tid_)); const int tid = tid_, wid = __builtin_amdgcn_readfirstlane(tid >> 6), lane = tid & 63, wr = wid >> 2, wc = wid & 3, fr = lane & 15, fq = lane >> 4;
    const int K = g.K, nt = K / BK;
    int ts_lo = 0, ts_hi = 0, nts = 0; const unsigned long long rt_entry = STAMP ? (unsigned long long)wall_clock64() : 0ull;
#define PG8_STAMP() do { if (STAMP && wid == 0 && nts < 64) { const unsigned long long _c = (unsigned long long)clock64(); \
        ts_lo = (lane == nts) ? (int)(unsigned)_c : ts_lo; ts_hi = (lane == nts) ? (int)(unsigned)(_c >> 32) : ts_hi; ++nts; } } while (0)
    PG8_STAMP();
    unsigned voffB[2]; int stR[2]; unsigned stC[2];
#pragma unroll
    for (int i = 0; i < 2; ++i) { int R, C; stage_rc(tid * 16 + i * 8192, R, C); const int Rb = Epi::PERM ? ((R & ~31) + perm32(R & 31)) : R;
        stR[i] = R; stC[i] = (unsigned)C * 2u; voffB[i] = (unsigned)(Rb * K + C) * 2u; }
    unsigned vAc0[2], vAc1[2], vAn0[2], vAn1[2];
#define PG8_AROWS(u, d0, d1) do { _Pragma("unroll") for (int _i = 0; _i < 2; ++_i) { d0[_i] = S.arow(u, stR[_i]) * (unsigned)(K * 2) + stC[_i]; d1[_i] = S.arow(u, HALF + stR[_i]) * (unsigned)(K * 2) + stC[_i]; } } while (0)
    const size_t kstep = (size_t)(BK * 2);
    const size_t hstep = (size_t)HALF * K * 2;
    const size_t tstep = 2 * hstep;
    const unsigned ldsw = (unsigned)wid * 1024u;
    const int aoff = lds_byte(wr * 64 + fr, fq * 8), boff = lds_byte(wc * 32 + fr, fq * 8);
#define PG8_SA(b, h) (((b) * 2 + (h)) * HTB)
#define PG8_SB(b, h) ((4 + (b) * 2 + (h)) * HTB)
#define PG8_STAGE(bufoff, gbase, voff) do { _Pragma("unroll") for (int _i = 0; _i < 2; ++_i) \
        __builtin_amdgcn_global_load_lds((const unsigned*)((const char*)(gbase) + (voff)[_i]), (PG8_LAS unsigned*)(lds + (bufoff) + ldsw + _i * 8192), 16, 0, 0); } while (0)
#define PG8_LDA(dst, b, h) do { _Pragma("unroll") for (int m = 0; m < 4; ++m) _Pragma("unroll") for (int k = 0; k < 2; ++k) dst[m][k] = *(const PG8_LAS bf16x8*)(lds + PG8_SA(b, h) + aoff + m * 2048 + k * 1024); } while (0)
#define PG8_LDB(dst, b, h) do { _Pragma("unroll") for (int n = 0; n < 2; ++n) _Pragma("unroll") for (int k = 0; k < 2; ++k) dst[n][k] = *(const PG8_LAS bf16x8*)(lds + PG8_SB(b, h) + boff + n * 2048 + k * 1024); } while (0)
#define PG8_MMA(ai, bj, At, Bt) do { __builtin_amdgcn_s_setprio(1); _Pragma("unroll") for (int m = 0; m < 4; ++m) _Pragma("unroll") for (int n = 0; n < 2; ++n) _Pragma("unroll") for (int k = 0; k < 2; ++k) \
        acc[ai][bj][m][n] = __builtin_amdgcn_mfma_f32_16x16x32_bf16(Bt[n][k], At[m][k], acc[ai][bj][m][n], 0, 0, 0); __builtin_amdgcn_s_setprio(0); } while (0)
#define PG8_WAIT_V(n) asm volatile("s_waitcnt vmcnt(" #n ")" ::: "memory")
#define PG8_WAIT_L(n) asm volatile("s_waitcnt lgkmcnt(" #n ")" ::: "memory")
#define PG8_BAR __builtin_amdgcn_s_barrier()
#define PG8_SCHED __builtin_amdgcn_sched_barrier(0)
    Unit cur, nxt; int ui = 0;
    if (!S.next(0, cur)) return;
    f32x4 acc[2][2][4][2];
#pragma unroll
    for (int a = 0; a < 2; ++a)
#pragma unroll
        for (int b = 0; b < 2; ++b)
#pragma unroll
            for (int m = 0; m < 4; ++m)
#pragma unroll
                for (int n = 0; n < 2; ++n) acc[a][b][m][n] = (f32x4){0.f, 0.f, 0.f, 0.f};
    bf16x8 At[4][2], B0[2][2], B1[2][2];
    const char* const cA = (const char*)g.A; const char* cB = S.bbase(cur);
    PG8_AROWS(cur, vAc0, vAc1);
    S.a_ready(cur);
    PG8_STAGE(PG8_SB(0, 0), cB, voffB); PG8_STAGE(PG8_SA(0, 0), cA, vAc0); PG8_STAGE(PG8_SB(0, 1), cB + hstep, voffB); PG8_STAGE(PG8_SA(0, 1), cA, vAc1);
    if (wr == 1) PG8_BAR;
    PG8_WAIT_V(4); PG8_BAR;
    PG8_STAGE(PG8_SB(1, 0), cB + kstep, voffB); PG8_STAGE(PG8_SA(1, 0), cA + kstep, vAc0); PG8_STAGE(PG8_SB(1, 1), cB + hstep + kstep, voffB);
    PG8_WAIT_V(6); PG8_BAR;
    PG8_STAMP();
    for (;;) {
        const bool has_next = S.next(ui + 1, nxt);
        const char* nB = has_next ? S.bbase(nxt) : cB;
        if (has_next) PG8_AROWS(nxt, vAn0, vAn1); else { _Pragma("unroll") for (int _i = 0; _i < 2; ++_i) { vAn0[_i] = vAc0[_i]; vAn1[_i] = vAc1[_i]; } }
        const bool full = cur.hs < 0;
        for (int t = 0; t < nt; t += 2) {
            const bool last = (t == nt - 2);
            const char* a1 = cA + (size_t)(t + 1) * kstep;
            const char* a2 = last ? cA : cA + (size_t)(t + 2) * kstep; const char* b2 = last ? nB : cB + (size_t)(t + 2) * kstep;
            const char* a3 = a2 + kstep; const char* b3 = b2 + kstep;
            unsigned v20[2], v21[2];
#pragma unroll
            for (int _i = 0; _i < 2; ++_i) { v20[_i] = last ? vAn0[_i] : vAc0[_i]; v21[_i] = last ? vAn1[_i] : vAc1[_i]; }
            if (last && has_next) S.a_ready(nxt);
            PG8_LDB(B0, 0, 0); PG8_SCHED; PG8_LDA(At, 0, 0); PG8_STAGE(PG8_SA(1, 1), a1, vAc1);
            PG8_WAIT_L(8); PG8_BAR; PG8_WAIT_L(0); PG8_MMA(0, 0, At, B0); PG8_BAR; PG8_SCHED;
            PG8_LDB(B1, 0, 1); PG8_STAGE(PG8_SB(0, 0), b2, voffB);
            PG8_BAR; PG8_WAIT_L(0); PG8_MMA(0, 1, At, B1); PG8_BAR;
            if (full) PG8_LDA(At, 0, 1); PG8_STAGE(PG8_SA(0, 0), a2, v20);
            PG8_BAR; PG8_WAIT_L(0); if (full) PG8_MMA(1, 0, At, B0); PG8_BAR; PG8_SCHED;
            PG8_STAGE(PG8_SB(0, 1), b2 + hstep, voffB);
            PG8_WAIT_V(6); PG8_BAR; if (full) PG8_MMA(1, 1, At, B1); PG8_BAR;
            PG8_LDB(B0, 1, 0); PG8_SCHED; PG8_LDA(At, 1, 0); PG8_STAGE(PG8_SA(0, 1), a2, v21);
            PG8_WAIT_L(8); PG8_BAR; PG8_WAIT_L(0); PG8_MMA(0, 0, At, B0); PG8_BAR; PG8_SCHED;
            PG8_LDB(B1, 1, 1); PG8_STAGE(PG8_SB(1, 0), b3, voffB);
            PG8_BAR; PG8_WAIT_L(0); PG8_MMA(0, 1, At, B1); PG8_BAR;
            if (full) PG8_LDA(At, 1, 1); PG8_STAGE(PG8_SA(1, 0), a3, v20);
            PG8_BAR; PG8_WAIT_L(0); if (full) PG8_MMA(1, 0, At, B0); PG8_BAR; PG8_SCHED;
            PG8_STAGE(PG8_SB(1, 1), b3 + hstep, voffB);
            PG8_WAIT_V(6); PG8_BAR; if (full) PG8_MMA(1, 1, At, B1); PG8_BAR;
        }
        PG8_STAMP();
        if constexpr (!Epi::AFTER_DRAIN) { E(acc, cur, wr, wc, fr, fq); S.done(cur); }
        PG8_STAMP();
        if (!has_next) break;
#pragma unroll
        for (int a = 0; a < 2; ++a)
#pragma unroll
            for (int b = 0; b < 2; ++b)
#pragma unroll
                for (int m = 0; m < 4; ++m)
#pragma unroll
                    for (int n = 0; n < 2; ++n) acc[a][b][m][n] = (f32x4){0.f, 0.f, 0.f, 0.f};
        cur = nxt; cB = nB; ++ui;
#pragma unroll
        for (int _i = 0; _i < 2; ++_i) { vAc0[_i] = vAn0[_i]; vAc1[_i] = vAn1[_i]; }
    }
    PG8_WAIT_V(0);
    if (wr == 0) PG8_BAR;
    PG8_BAR;
    if constexpr (Epi::AFTER_DRAIN) { E.fused(acc, cur, wr, wc, fr, fq, lds, wid, lane); S.done(cur); }
    PG8_STAMP();
    if (STAMP && wid == 0) { stamps[lane] = lane < nts ? (((unsigned long long)(unsigned)ts_hi << 32) | (unsigned)ts_lo) : 0ull;
        if (lane == 62) stamps[62] = rt_entry; if (lane == 63) stamps[63] = (unsigned long long)wall_clock64(); }
#undef PG8_STAMP
#undef PG8_SA
#undef PG8_AROWS
#undef PG8_SB
#undef PG8_STAGE
#undef PG8_LDA
#undef PG8_LDB
#undef PG8_MMA
#undef PG8_WAIT_V
#undef PG8_WAIT_L
#undef PG8_BAR
#undef PG8_SCHED
}
}
#define XB_TMO      128
#define XB_XCNT(j)  (256  + 64 * (j))
#define XB_XSUB(j)  (1280 + 64 * (j))
#define XB_XGEN(j)  (2304 + 64 * (j))
#define XB_TOP      3328
#define XB_TOPGEN   3392
#define XCD_BAR_WORDS 3456
#define XB_SPIN_CAP (1u << 24)

__device__ __forceinline__ unsigned xb_ld(unsigned* p)              { return __hip_atomic_load(p, __ATOMIC_RELAXED, __HIP_MEMORY_SCOPE_AGENT); }
__device__ __forceinline__ unsigned xb_add(unsigned* p, unsigned v) { return __hip_atomic_fetch_add(p, v, __ATOMIC_RELAXED, __HIP_MEMORY_SCOPE_AGENT); }
__device__ __forceinline__ unsigned xb_xcc_id() { return (unsigned)__builtin_amdgcn_s_getreg((3 << 11) | 20) & 0xFu; }
#define XB_SPIN(cond, bar) do { unsigned _sp = 0; while (cond) { __builtin_amdgcn_s_sleep(1); \
    if ((++_sp & 255u) == 0u) { if (xb_ld(&(bar)[XB_TMO])) break; if (_sp > XB_SPIN_CAP) { atomicAdd(&(bar)[XB_TMO], 1u); break; } } } } while (0)

struct XcdBarrier {
    unsigned* bar; unsigned x;
    volatile LAS unsigned* st;
};

__device__ __forceinline__ XcdBarrier xcd_barrier_post(unsigned* bar, volatile LAS unsigned* st) {
    XcdBarrier b; b.bar = bar; b.x = xb_xcc_id(); b.st = st;
    if (threadIdx.x == 0) (void)xb_add(&bar[XB_XCNT(b.x)], 1u);
    return b;
}
__device__ __forceinline__ void xcd_barrier_complete(unsigned* bar, unsigned x, unsigned& nloc, unsigned& nx) {
    const unsigned G = gridDim.x * gridDim.y * gridDim.z;
    unsigned sum, cnt, mine, sp = 0u;
    for (;;) {
        sum = 0u; cnt = 0u; mine = 0u;
#pragma unroll
        for (unsigned j = 0; j < 16; ++j) { const unsigned c = xb_ld(&bar[XB_XCNT(j)]); sum += c; cnt += (c > 0u) ? 1u : 0u; mine = (j == x) ? c : mine; }
        if (sum == G) break;
        __builtin_amdgcn_s_sleep(1);
        if ((++sp & 255u) == 0u) { if (xb_ld(&bar[XB_TMO])) break; if (sp > XB_SPIN_CAP) { atomicAdd(&bar[XB_TMO], 1u); break; } }
    }
    nloc = mine > 0u ? mine : 1u; nx = cnt > 0u ? cnt : 1u;
}

__device__ __forceinline__ void xcd_barrier(const XcdBarrier& b) {
    asm volatile("s_waitcnt vmcnt(0)" ::: "memory");
    __syncthreads();
    if (threadIdx.x == 0) {
        unsigned* bar = b.bar;
        __builtin_amdgcn_s_waitcnt(0);
        unsigned nloc = b.st[0], nx = b.st[1];
        if (nloc == 0u) { xcd_barrier_complete(bar, b.x, nloc, nx); b.st[0] = nloc; b.st[1] = nx; }
        const unsigned old = xb_add(&bar[XB_XSUB(b.x)], 1u);
        const unsigned gen = old / nloc;
        if (old + 1u == (gen + 1u) * nloc) {
            __builtin_amdgcn_fence(__ATOMIC_RELEASE, "agent");
            asm volatile("s_waitcnt vmcnt(0)" ::: "memory");
            const unsigned og = xb_add(&bar[XB_TOP], 1u);
            const unsigned tg = og / nx;
            if (og + 1u == (tg + 1u) * nx) xb_add(&bar[XB_TOPGEN], 1u);
            else XB_SPIN(xb_ld(&bar[XB_TOPGEN]) == tg, bar);
            __builtin_amdgcn_fence(__ATOMIC_ACQUIRE, "agent");
            xb_add(&bar[XB_XGEN(b.x)], 1u);
            asm volatile("s_waitcnt vmcnt(0)" ::: "memory");
        } else {
            XB_SPIN(xb_ld(&bar[XB_XGEN(b.x)]) == gen, bar);
            __builtin_amdgcn_fence(__ATOMIC_ACQUIRE, "agent");
            asm volatile("s_waitcnt vmcnt(0)" ::: "memory");
        }
    }
    __syncthreads();
}

constexpr int SCR_BYTES = 139264;
constexpr int MISC_OFF = SCR_BYTES;
constexpr int LDS_BYTES = 147456;
constexpr int CW_BAR = 4096;
constexpr int NTHR = 512, NWAVES = 8;
constexpr int CW_MOE = 8192;

__device__ __forceinline__ void transpose_item(const float* W, int ldw, int col0, int K, bf16_t* WT, int drow0, int kb, LAS float* scr, int lane) {
    const int k0 = 64 * kb;
#pragma unroll 8
    for (int i = 0; i < 32; ++i) { const int kk = 2 * i + (lane >> 5); scr[kk * 33 + (lane & 31)] = W[(size_t)(k0 + kk) * ldw + col0 + (lane & 31)]; }
    asm volatile("s_waitcnt lgkmcnt(0)" ::: "memory");
    const int c = lane & 7;
#pragma unroll
    for (int j = 0; j < 4; ++j) { const int n = (lane >> 3) + 8 * j; const LAS float* s = scr + (8 * c) * 33 + n;
        u32x4 o; o.x = pk2(s[0 * 33], s[1 * 33]); o.y = pk2(s[2 * 33], s[3 * 33]); o.z = pk2(s[4 * 33], s[5 * 33]); o.w = pk2(s[6 * 33], s[7 * 33]);
        *(u32x4*)(WT + (size_t)(drow0 + n) * K + k0 + 8 * c) = o; }
    asm volatile("s_waitcnt lgkmcnt(0)" ::: "memory");
}
__device__ __forceinline__ void up_item(const float* wg, const float* wu, bf16_t* WT, int it, LAS float* scr, int lane) {
    const int nb = it >> 4, kb = it & 15, r0 = 32 * nb, pn = r0 >> 8, p = r0 & 255;
    transpose_item(p < 128 ? wg : wu, DFF, 128 * pn + (p & 127), DM, WT, r0, kb, scr, lane);
}
__device__ __forceinline__ void dn_item(const float* wd, bf16_t* WT, int it, LAS float* scr, int lane) {
    const int nb = it / 44, kb = it % 44;
    transpose_item(wd, DM, 32 * nb, DFF, WT, 32 * nb, kb, scr, lane);
}
constexpr int IT_IN = 112 * 16, IT_OUT = 32 * 16, IT_UP = 176 * 16, IT_DN = 32 * 44;
constexpr int IT_TOTAL = 2 * IT_IN + 2 * IT_OUT + IT_UP + IT_DN + NEXP * (IT_UP + IT_DN);

__device__ __forceinline__ void phase_prologue(const Args& a, LAS unsigned char* lds, int tid, int lane, int wave, int bid, int G) {
    unsigned char* ws = a.ws;
    {
        LAS float* scr = (LAS float*)(lds + wave * 8704);
        const int gw = bid * NWAVES + wave, NGW = G * NWAVES;
        for (int it0 = gw; it0 < IT_TOTAL; it0 += NGW) {
            int it = it0;
            if (it < 2 * IT_IN) { const int l = it / IT_IN; it -= l * IT_IN; const int nb = it >> 4, kb = it & 15, r0 = 32 * nb;
                transpose_item(a.in[8] + (size_t)l * DM * DIN, DIN, r0 < 2048 ? r0 : r0 + 16, DM, (bf16_t*)(ws + WS_WTIN) + (size_t)l * NPW * DM, r0, kb, scr, lane); continue; }
            it -= 2 * IT_IN;
            if (it < 2 * IT_OUT) { const int l = it / IT_OUT; it -= l * IT_OUT; const int nb = it >> 4, kb = it & 15;
                transpose_item(a.in[16] + (size_t)l * DM * DM, DM, 32 * nb, DM, (bf16_t*)(ws + WS_WTOUT) + (size_t)l * DM * DM, 32 * nb, kb, scr, lane); continue; }
            it -= 2 * IT_OUT;
            if (it < IT_UP) { up_item(a.in[17], a.in[18], (bf16_t*)(ws + WS_WTUP), it, scr, lane); continue; }
            it -= IT_UP;
            if (it < IT_DN) { dn_item(a.in[19], (bf16_t*)(ws + WS_WTDN), it, scr, lane); continue; }
            it -= IT_DN;
            if (it < NEXP * IT_UP) { const int e = it / IT_UP; it -= e * IT_UP;
                up_item(a.in[21] + (size_t)e * DM * DFF, a.in[22] + (size_t)e * DM * DFF, (bf16_t*)(ws + WS_WTMUP) + (size_t)e * NUP * DM, it, scr, lane); continue; }
            it -= NEXP * IT_UP;
            { const int e = it / IT_DN; it -= e * IT_DN; dn_item(a.in[23] + (size_t)e * DFF * DM, (bf16_t*)(ws + WS_WTMDN) + (size_t)e * DM * DFF, it, scr, lane); }
        }
    }
    __syncthreads();
    {
        const int gt = bid * NTHR + tid;
        if (gt < 1024) { const int pos = gt >> 4, i = gt & 15;
            double inv = 1.0; for (int q = 0; q < i; ++q) inv *= 0.56234132519034908;
            const float angf = (float)pos * (float)inv; const double ang = (double)angf;
            const double kq = rint(ang * 0.63661977236758134); const double r = ang - kq * 1.5707963267948966 - kq * 6.123233995736766e-17; const double r2 = r * r;
            double sn = r * (1.0 + r2 * (-1.0 / 6 + r2 * (1.0 / 120 + r2 * (-1.0 / 5040 + r2 * (1.0 / 362880 + r2 * (-1.0 / 39916800 + r2 * (1.0 / 6227020800.0)))))));
            double cs = 1.0 + r2 * (-0.5 + r2 * (1.0 / 24 + r2 * (-1.0 / 720 + r2 * (1.0 / 40320 + r2 * (-1.0 / 3628800 + r2 * (1.0 / 479001600.0 + r2 * (-1.0 / 87178291200.0)))))));
            const int kk = ((int)kq) & 3; double c2, s2;
            if (kk == 0) { c2 = cs; s2 = sn; } else if (kk == 1) { c2 = -sn; s2 = cs; } else if (kk == 2) { c2 = -cs; s2 = -sn; } else { c2 = sn; s2 = -cs; }
            float* R = (float*)(ws + WS_ROPE); R[gt * 2] = (float)c2; R[gt * 2 + 1] = (float)s2; }
    }
    {
        LAS float* sc = (LAS float*)(lds + 73728);
        LAS float* red = (LAS float*)(lds + 73728 + 36864);
        for (int i = tid; i < 9 * 1024; i += NTHR) { const float v = i < 8192 ? a.in[1][i] : a.in[3][i - 8192]; sc[i] = v / (1.0f + __expf(-v)); }
        __syncthreads();
        for (int item = bid; item < 192; item += G) {
            const int l = item / 96, n0 = (item % 96) * 64;
            const float* wm = a.in[6] + (size_t)l * DM * 6144 + n0 + lane;
            float acc[9];
#pragma unroll
            for (int b = 0; b < 9; ++b) acc[b] = 0.f;
#pragma unroll 4
            for (int kk = 0; kk < 128; ++kk) { const int k = wave * 128 + kk; const float w = wm[(size_t)k * 6144];
#pragma unroll
                for (int b = 0; b < 9; ++b) acc[b] += sc[b * 1024 + k] * w; }
#pragma unroll
            for (int b = 0; b < 9; ++b) red[(wave * 9 + b) * 64 + lane] = acc[b];
            __syncthreads();
            for (int o = tid; o < 576; o += NTHR) { const int b = o >> 6, ln = o & 63; float s = a.in[7][(size_t)l * 6144 + n0 + ln];
#pragma unroll
                for (int w = 0; w < 8; ++w) s += red[(w * 9 + b) * 64 + ln];
                ((float*)(ws + WS_MOD))[((size_t)l * 9 + b) * 6144 + n0 + ln] = s; }
            __syncthreads();
        }
    }
}

template <int MODE>
__device__ __forceinline__ void phase_norm(const Args& a, int l, LAS unsigned char* lds, int tid, int lane, int wave, int bid, int G) {
    unsigned char* ws = a.ws;
    LAS float* WT = (LAS float*)lds;
    if (MODE == 0) { const float* w = a.in[8] + (size_t)l * DM * DIN + 2048; for (int i = tid; i < 16384; i += NTHR) { const int k = i >> 4, j = i & 15; WT[j * 1024 + k] = w[(size_t)k * DIN + j]; } __syncthreads(); }
    if (MODE == 2) { const float* w = a.in[20]; for (int i = tid; i < 8192; i += NTHR) { const int k = i >> 3, j = i & 7; WT[j * 1024 + k] = w[(size_t)k * 8 + j]; } __syncthreads(); }
    const float* gam = (MODE == 0 ? a.in[4] : a.in[5]) + (size_t)l * DM;
    const float* mod = (const float*)(ws + WS_MOD) + (size_t)l * 9 * 6144;
    const int shoff = MODE == 0 ? 0 : 3072, soff = MODE == 0 ? 1024 : 4096;
    const int nrows = (MODE == 2) ? NLAT : MALL;
    bf16_t* H = (bf16_t*)(ws + WS_H);
    int nrec = 0;
    for (int r = bid * NWAVES + wave; r < nrows; r += G * NWAVES) {
        const bool lat = r < NLAT; const int bi = lat ? (r >> 11) : 8;
        const float* src = (MODE == 0 && l == 0) ? (lat ? a.in[0] + (size_t)r * DM : a.in[2] + (size_t)(r - NLAT) * DM)
                                    : (lat ? a.out + (size_t)r * DM : (const float*)(ws + WS_XC) + (size_t)(r - NLAT) * DM);
        f32x4 v[4]; float ss = 0.f;
#pragma unroll
        for (int j = 0; j < 4; ++j) { v[j] = *(const f32x4*)(src + 4 * lane + 256 * j); ss += (v[j].x * v[j].x + v[j].y * v[j].y) + (v[j].z * v[j].z + v[j].w * v[j].w); }
        const float rstd = rsqrtf(wave_sum(ss) * (1.0f / DM) + EPS);
        const float* mrow = mod + (size_t)bi * 6144;
#pragma unroll
        for (int j = 0; j < 4; ++j) { const int k = 4 * lane + 256 * j;
            const f32x4 g = *(const f32x4*)(gam + k), s = *(const f32x4*)(mrow + soff + k), sh = *(const f32x4*)(mrow + shoff + k);
            v[j] = v[j] * rstd * g * (1.0f + s) + sh;
            u32x2 w; w.x = pk2(v[j].x, v[j].y); w.y = pk2(v[j].z, v[j].w);
            *(u32x2*)(H + (size_t)r * DM + k) = w; }
        if (MODE == 0) {
            float p[16];
#pragma unroll
            for (int jg = 0; jg < 16; ++jg) p[jg] = 0.f;
#pragma unroll
            for (int jg = 0; jg < 16; ++jg) {
#pragma unroll
                for (int j = 0; j < 4; ++j) { const f32x4 w = *(const LAS f32x4*)(WT + jg * 1024 + 4 * lane + 256 * j); p[jg] += (v[j].x * w.x + v[j].y * w.y) + (v[j].z * w.z + v[j].w * w.w); }
                if ((jg & 3) == 3) asm volatile("" ::: "memory"); }
            const float tot = reduce16_lanes(p, lane);
            const int gid = ((lane >> 5) & 1) * 8 + ((lane >> 4) & 1) * 4 + ((lane >> 3) & 1) * 2 + ((lane >> 2) & 1);
            if ((lane & 3) == 0) ((float*)(ws + WS_GATES))[(size_t)r * 16 + gid] = tot + a.in[12][l * 16 + gid];
        }
        if (MODE == 2) {
            float p[8];
#pragma unroll
            for (int e = 0; e < 8; ++e) p[e] = 0.f;
#pragma unroll
            for (int e = 0; e < 8; ++e) {
#pragma unroll
                for (int j = 0; j < 4; ++j) { const f32x4 w = *(const LAS f32x4*)(WT + e * 1024 + 4 * lane + 256 * j); p[e] += (v[j].x * w.x + v[j].y * w.y) + (v[j].z * w.z + v[j].w * w.w); }
                if ((e & 3) == 3) asm volatile("" ::: "memory"); }
            const float tot = reduce8_lanes(p, lane);
            int i1 = 0, i2 = 0; float v1 = -3.0e38f, v2 = -3.0e38f;
#pragma unroll
            for (int e = 0; e < 8; ++e) { const float s = lane_bcast(tot, 32 * (e >> 2) + 16 * ((e >> 1) & 1) + 8 * (e & 1));
                if (s > v1) { v2 = v1; i2 = i1; v1 = s; i1 = e; } else if (s > v2) { v2 = s; i2 = e; } }
            const float w2 = 1.0f / (1.0f + __expf(v1 - v2)), w1 = 1.0f - w2;
            if (lane == 0) { LAS int* rec = (LAS int*)(lds + 32768) + nrec * 32 + wave * 4; rec[0] = i1; rec[1] = i2; rec[2] = __float_as_int(w1); rec[3] = __float_as_int(w2); }
            ++nrec;
        }
    }
    if (MODE == 2) {
        __syncthreads();
        if (tid < 8) {
            const int e = tid; const LAS int* rec = (const LAS int*)(lds + 32768); int cnt = 0;
            const int nk = (nrows - bid * NWAVES + G * NWAVES - 1) / (G * NWAVES);
            for (int k = 0; k < nk; ++k) for (int w = 0; w < NWAVES; ++w) { const int r = bid * NWAVES + w + k * G * NWAVES; if (r < nrows) { const LAS int* q = rec + k * 32 + w * 4; cnt += (q[0] == e) + (q[1] == e); } }
            int pos = (int)atomicAdd((unsigned*)(ws + WS_CTL) + CW_MOE + 64 * e, (unsigned)cnt);
            int* LIST = (int*)(ws + WS_LIST) + e * NLAT; int* TOK = (int*)(ws + WS_COMB);
            for (int k = 0; k < nk; ++k) for (int w = 0; w < NWAVES; ++w) { const int r = bid * NWAVES + w + k * G * NWAVES; if (r < nrows) { const LAS int* q = rec + k * 32 + w * 4;
                if (q[0] == e) { LIST[pos] = r; TOK[r * 8 + 0] = e; TOK[r * 8 + 2] = pos; TOK[r * 8 + 4] = q[2]; ++pos; }
                if (q[1] == e) { LIST[pos] = r; TOK[r * 8 + 1] = e; TOK[r * 8 + 3] = pos; TOK[r * 8 + 5] = q[3]; ++pos; } } }
        }
    }
}

__device__ __forceinline__ void phase_post(const Args& a, int l, int lane, int wave, int bid, int G) {
    unsigned char* ws = a.ws;
    bf16_t* P = (bf16_t*)(ws + WS_BIG); bf16_t* MQK = (bf16_t*)(ws + WS_MQK);
    const float* ROPE = (const float*)(ws + WS_ROPE);
    const float* cw = a.in[10] + (size_t)l * 3 * 512; const float* cb = a.in[11] + (size_t)l * 512;
    const float qg = a.in[13][l * 64 + lane], kg = a.in[14][l * 64 + lane];
    for (int r = bid * NWAVES + wave; r < MALL; r += G * NWAVES) {
        const bool lat = r < NLAT; bf16_t* row = P + (size_t)r * NPW;
        int t, tlen; if (lat) { t = r & (SEQ - 1); tlen = SEQ; } else { t = (r - NLAT) & (CTXL - 1); tlen = CTXL; }
        if (lat) { const int gr = t >> 6, gc = t & 63;
#pragma unroll
            for (int blk = 0; blk < 2; ++blk)
#pragma unroll
                for (int ii = 0; ii < 2; ++ii) { const int pid = lane + 64 * ii, head = pid >> 5, half = (pid >> 4) & 1, i = pid & 15, c1 = (blk ? PC_RK : PC_RQ) + head * 64 + half * 32 + i;
                    const int pos = half ? gc : gr; const float cs = ROPE[(pos * 16 + i) * 2], sn = ROPE[(pos * 16 + i) * 2 + 1];
                    const float x1 = bf2f(row[c1]), x2 = bf2f(row[c1 + 16]); const float sc = blk ? 0.125f : 1.0f;
                    row[c1] = (bf16_t)f2bf((x1 * cs - x2 * sn) * sc); row[c1 + 16] = (bf16_t)f2bf((x1 * sn + x2 * cs) * sc); }
        } else {
#pragma unroll
            for (int ii = 0; ii < 4; ++ii) { const int c = PC_RK + lane + 64 * ii; row[c] = (bf16_t)f2bf(bf2f(row[c]) * 0.125f); }
        }
#pragma unroll
        for (int ii = 0; ii < 8; ++ii) { const int c = lane + 64 * ii;
            const float x0 = bf2f(row[PC_MQ + c]);
            const float xm = t > 0 ? bf2f(row[PC_MQ + c - NPW]) : 0.f, xp = t < tlen - 1 ? bf2f(row[PC_MQ + c + NPW]) : 0.f;
            float y = cb[c] + cw[c] * xm + cw[512 + c] * x0 + cw[1024 + c] * xp;
            y = y / (1.0f + __expf(-y)); if (c >= 256) y *= 0.125f;
            MQK[(size_t)r * 512 + c] = (bf16_t)f2bf(y); }
#pragma unroll
        for (int hh = 0; hh < 16; ++hh) { const int c = PC_NQ + hh * 64 + lane; const float v = bf2f(row[c]);
            const float rs = rsqrtf(wave_sum(v * v) * (1.0f / 64.0f) + EPS);
            row[c] = (bf16_t)f2bf(v * rs * (hh < 8 ? qg : kg)); }
    }
}


typedef short bf16x8 __attribute__((ext_vector_type(8)));
typedef short s16x4 __attribute__((ext_vector_type(4)));
constexpr int IST = 160;
__device__ __forceinline__ f32x4 mfma16(bf16x8 a, bf16x8 b, f32x4 c) { return __builtin_amdgcn_mfma_f32_16x16x32_bf16(a, b, c, 0, 0, 0); }
__device__ __forceinline__ bf16x8 frag_row(LAS const unsigned char* img, int row0, int k0, int lane) {
    return *(const LAS bf16x8*)(img + (row0 + (lane & 15)) * IST + (k0 + 8 * (lane >> 4)) * 2);
}
template <bool PERMK>
__device__ __forceinline__ bf16x8 frag_tr(LAS const unsigned char* img, int r0, int c0, int lane) {
    const int g = lane >> 4, i = lane & 15, q = i >> 2, p = i & 3;
    const unsigned addr = (unsigned)(size_t)(img + (r0 + (PERMK ? 4 : 8) * g + q) * IST + (c0 + 4 * p) * 2);
    s16x4 lo, hi;
    if (PERMK) asm volatile("ds_read_b64_tr_b16 %0, %2\n\tds_read_b64_tr_b16 %1, %2 offset:2560\n\ts_waitcnt lgkmcnt(0)" : "=&v"(lo), "=&v"(hi) : "v"(addr) : "memory");
    else       asm volatile("ds_read_b64_tr_b16 %0, %2\n\tds_read_b64_tr_b16 %1, %2 offset:640\n\ts_waitcnt lgkmcnt(0)" : "=&v"(lo), "=&v"(hi) : "v"(addr) : "memory");
    bf16x8 r; r[0] = lo[0]; r[1] = lo[1]; r[2] = lo[2]; r[3] = lo[3]; r[4] = hi[0]; r[5] = hi[1]; r[6] = hi[2]; r[7] = hi[3];
    return r;
}
template <bool PERMK>
__device__ __forceinline__ void frag_tr_x4(LAS const unsigned char* img, int r0, int c0, int lane, bf16x8 (&out)[4]) {
    const int g = lane >> 4, i = lane & 15, q = i >> 2, p = i & 3;
    const unsigned addr = (unsigned)(size_t)(img + (r0 + (PERMK ? 4 : 8) * g + q) * IST + (c0 + 4 * p) * 2);
    s16x4 l0, h0, l1, h1, l2, h2, l3, h3;
    if (PERMK) asm volatile("ds_read_b64_tr_b16 %0, %8\n\tds_read_b64_tr_b16 %1, %8 offset:2560\n\tds_read_b64_tr_b16 %2, %8 offset:32\n\tds_read_b64_tr_b16 %3, %8 offset:2592\n\t"
                            "ds_read_b64_tr_b16 %4, %8 offset:64\n\tds_read_b64_tr_b16 %5, %8 offset:2624\n\tds_read_b64_tr_b16 %6, %8 offset:96\n\tds_read_b64_tr_b16 %7, %8 offset:2656\n\ts_waitcnt lgkmcnt(0)"
                            : "=&v"(l0), "=&v"(h0), "=&v"(l1), "=&v"(h1), "=&v"(l2), "=&v"(h2), "=&v"(l3), "=&v"(h3) : "v"(addr) : "memory");
    else       asm volatile("ds_read_b64_tr_b16 %0, %8\n\tds_read_b64_tr_b16 %1, %8 offset:640\n\tds_read_b64_tr_b16 %2, %8 offset:32\n\tds_read_b64_tr_b16 %3, %8 offset:672\n\t"
                            "ds_read_b64_tr_b16 %4, %8 offset:64\n\tds_read_b64_tr_b16 %5, %8 offset:704\n\tds_read_b64_tr_b16 %6, %8 offset:96\n\tds_read_b64_tr_b16 %7, %8 offset:736\n\ts_waitcnt lgkmcnt(0)"
                            : "=&v"(l0), "=&v"(h0), "=&v"(l1), "=&v"(h1), "=&v"(l2), "=&v"(h2), "=&v"(l3), "=&v"(h3) : "v"(addr) : "memory");
#define FT_PACK(o, lo, hi) o[0] = lo[0]; o[1] = lo[1]; o[2] = lo[2]; o[3] = lo[3]; o[4] = hi[0]; o[5] = hi[1]; o[6] = hi[2]; o[7] = hi[3];
    FT_PACK(out[0], l0, h0) FT_PACK(out[1], l1, h1) FT_PACK(out[2], l2, h2) FT_PACK(out[3], l3, h3)
#undef FT_PACK
}
__device__ __forceinline__ bf16x8 pack8(f32x4 a, f32x4 b) {
    union { u32x4 u; bf16x8 v; } x; x.u.x = pk2(a[0], a[1]); x.u.y = pk2(a[2], a[3]); x.u.z = pk2(b[0], b[1]); x.u.w = pk2(b[2], b[3]); return x.v;
}
__device__ __forceinline__ int chunk_row0(int b, int dir, int sc) {
    if (dir == 0) return sc < 2 ? NLAT + b * CTXL + 128 * sc : b * SEQ + 128 * (sc - 2);
    return sc < 2 ? NLAT + b * CTXL + 128 * (1 - sc) : b * SEQ + 128 * (17 - sc);
}
constexpr size_t U_BYTES = 80 * 64 * 2;

__device__ __forceinline__ void phase_chunk_sums(const Args& a, int l, LAS unsigned char* lds, int tid, int lane, int wave, int bid, int G) {
    unsigned char* ws = a.ws;
    const bf16_t* P = (const bf16_t*)(ws + WS_BIG); const bf16_t* MQK = (const bf16_t*)(ws + WS_MQK);
    const float* GT = (const float*)(ws + WS_GATES);
    LAS unsigned char* Kimg = lds;
    LAS unsigned char* Vimg = lds + 128 * IST;
    LAS float* wk = (LAS float*)(lds + 256 * IST);
    LAS float* red = wk + 128;
    const int nitems = 2 * NB * 4 * 2 * 18;
    for (int it = bid; it < nitems; it += G) {
        const int sc = it % 18; int r_ = it / 18; const int dir = r_ & 1; r_ >>= 1; const int h = r_ & 3; r_ >>= 2; const int b = r_ & 7; const int kind = r_ >> 3;
        const int row0 = chunk_row0(b, dir, sc);
        __syncthreads();
        if (kind == 0) { if (tid < 128) { const float lg = logsigmoidf_(a.in[9][(l * 2 + dir) * 4 + h]); wk[tid] = __expf(lg * (float)(dir == 0 ? 127 - tid : tid)); } }
        else if (wave == 0) {
            const float g0i = GT[(size_t)(row0 + lane) * 16 + 4 * dir + h], g1i = GT[(size_t)(row0 + 64 + lane) * 16 + 4 * dir + h];
            const float f0 = logsigmoidf_(GT[(size_t)(row0 + lane) * 16 + 8 + 4 * dir + h]), f1 = logsigmoidf_(GT[(size_t)(row0 + 64 + lane) * 16 + 8 + 4 * dir + h]);
            float s0 = f0, s1 = f1;
#pragma unroll
            for (int o = 1; o < 64; o <<= 1) { const int sl = lane >= o ? lane - o : lane; const float u0 = lane_get(s0, sl), u1 = lane_get(s1, sl); if (lane >= o) { s0 += u0; s1 += u1; } }
            const float t0 = lane_bcast(s0, 63), t1 = lane_bcast(s1, 63), tot = t0 + t1;
            float b0, b1;
            if (dir == 0) { b0 = s0; b1 = t0 + s1; } else { b0 = tot - s0 + f0; b1 = t1 - s1 + f1; }
            const float a0 = g0i - b0, a1 = g1i - b1; const float amax = wave_max(fmaxf(a0, a1));
            wk[lane] = __expf(a0 - amax); wk[lane + 64] = __expf(a1 - amax);
            if (lane == 0) { float* usc = (float*)(ws + WS_USC) + ((size_t)((b * 4 + h) * 2 + dir) * 18 + sc) * 2; usc[0] = tot; usc[1] = amax; }
        }
        __syncthreads();
        {
            const int r = tid >> 2, c8 = (tid & 3) * 16;
            const bf16_t* ksrc = kind == 0 ? P + (size_t)(row0 + r) * NPW + PC_RK + h * 64 + c8 : MQK + (size_t)(row0 + r) * 512 + 256 + h * 64 + c8;
            const bf16_t* vsrc = P + (size_t)(row0 + r) * NPW + (kind == 0 ? PC_RV : PC_MV) + h * 64 + c8;
            const u32x4 k0 = *(const u32x4*)ksrc, k1 = *(const u32x4*)(ksrc + 8), v0 = *(const u32x4*)vsrc, v1 = *(const u32x4*)(vsrc + 8);
            *(LAS u32x4*)(Kimg + r * IST + c8 * 2) = k0; *(LAS u32x4*)(Kimg + r * IST + c8 * 2 + 16) = k1;
            const float w = wk[r];
            u32x4 o0, o1;
            o0.x = pk2(bflo(v0.x) * w, bfhi(v0.x) * w); o0.y = pk2(bflo(v0.y) * w, bfhi(v0.y) * w); o0.z = pk2(bflo(v0.z) * w, bfhi(v0.z) * w); o0.w = pk2(bflo(v0.w) * w, bfhi(v0.w) * w);
            o1.x = pk2(bflo(v1.x) * w, bfhi(v1.x) * w); o1.y = pk2(bflo(v1.y) * w, bfhi(v1.y) * w); o1.z = pk2(bflo(v1.z) * w, bfhi(v1.z) * w); o1.w = pk2(bflo(v1.w) * w, bfhi(v1.w) * w);
            *(LAS u32x4*)(Vimg + r * IST + c8 * 2) = o0; *(LAS u32x4*)(Vimg + r * IST + c8 * 2 + 16) = o1;
            if ((tid & 3) == 0) { unsigned zz; asm volatile("v_mov_b32 %0, 0" : "=v"(zz)); u32x4 e0; e0.x = f2bf(w); e0.y = zz; e0.z = zz; e0.w = zz; u32x4 z; z.x = zz; z.y = zz; z.z = zz; z.w = zz;
                *(LAS u32x4*)(Vimg + r * IST + 128) = e0; *(LAS u32x4*)(Vimg + r * IST + 144) = z; }
        }
        __syncthreads();
        {
            const int dt = wave & 3, et0 = 2 * (wave >> 2);
            f32x4 u0 = {0.f, 0.f, 0.f, 0.f}, u1 = u0, u2 = u0;
#pragma unroll
            for (int ks = 0; ks < 4; ++ks) {
                const bf16x8 af = frag_tr<false>(Kimg, 32 * ks, 16 * dt, lane);
                const bf16x8 b0 = frag_tr<false>(Vimg, 32 * ks, 16 * et0, lane), b1 = frag_tr<false>(Vimg, 32 * ks, 16 * et0 + 16, lane);
                u0 = mfma16(af, b0, u0); u1 = mfma16(af, b1, u1);
                if (wave < 4) { const bf16x8 b2 = frag_tr<false>(Vimg, 32 * ks, 64, lane); u2 = mfma16(af, b2, u2); }
            }
            bf16_t* U = (bf16_t*)(ws + WS_U + ((size_t)(((kind * NB + b) * 4 + h) * 2 + dir) * 18 + sc) * U_BYTES);
            const int g = lane >> 4, e = lane & 15, d0 = 16 * dt + 4 * g;
            { u32x2 w; w.x = pk2(u0[0], u0[1]); w.y = pk2(u0[2], u0[3]); *(u32x2*)(U + (size_t)(16 * et0 + e) * 64 + d0) = w; }
            { u32x2 w; w.x = pk2(u1[0], u1[1]); w.y = pk2(u1[2], u1[3]); *(u32x2*)(U + (size_t)(16 * et0 + 16 + e) * 64 + d0) = w; }
            if (wave < 4) { u32x2 w; w.x = pk2(u2[0], u2[1]); w.y = pk2(u2[2], u2[3]); *(u32x2*)(U + (size_t)(64 + e) * 64 + d0) = w; }
        }
    }
}

__device__ __forceinline__ void phase_chunk_states(const Args& a, int l, int tid, int bid, int G) {
    unsigned char* ws = a.ws;
    for (int it = bid; it < 2 * NB * 4 * 2; it += G) {
        const int dir = it & 1, h = (it >> 1) & 3, b = (it >> 3) & 7, kind = it >> 6;
        const size_t seq = (size_t)(((kind * NB + b) * 4 + h) * 2 + dir) * 18;
        const unsigned char* Ub = ws + WS_U + seq * U_BYTES; unsigned char* Sb = ws + WS_S + seq * U_BYTES;
        const float* usc = (const float*)(ws + WS_USC) + (size_t)((b * 4 + h) * 2 + dir) * 18 * 2;
        float* sm = (float*)(ws + WS_SM) + (size_t)((b * 4 + h) * 2 + dir) * 18;
        const float dec_ret = __expf(128.0f * logsigmoidf_(a.in[9][(l * 2 + dir) * 4 + h]));
        const int nrow = kind == 0 ? 512 : 520;
        for (int ci = tid; ci < nrow; ci += NTHR) {
            u32x4 v[18];
#pragma unroll
            for (int s = 0; s < 18; ++s) v[s] = *(const u32x4*)(Ub + (size_t)s * U_BYTES + (size_t)ci * 16);
            float acc[8];
#pragma unroll
            for (int j = 0; j < 8; ++j) acc[j] = 0.f;
            float m = 0.f;
#pragma unroll
            for (int s = 0; s < 18; ++s) {
                u32x4 o; o.x = pk2(acc[0], acc[1]); o.y = pk2(acc[2], acc[3]); o.z = pk2(acc[4], acc[5]); o.w = pk2(acc[6], acc[7]);
                *(u32x4*)(Sb + (size_t)s * U_BYTES + (size_t)ci * 16) = o;
                float dk, ck;
                if (kind == 0) { dk = dec_ret; ck = 1.0f; }
                else { if (ci == 0) sm[s] = m; const float bl = usc[2 * s], am = usc[2 * s + 1]; const float mx = fmaxf(m, am); dk = __expf(m - mx); ck = __expf(am - mx); m = bl + mx; }
                acc[0] = dk * acc[0] + ck * bflo(v[s].x); acc[1] = dk * acc[1] + ck * bfhi(v[s].x); acc[2] = dk * acc[2] + ck * bflo(v[s].y); acc[3] = dk * acc[3] + ck * bfhi(v[s].y);
                acc[4] = dk * acc[4] + ck * bflo(v[s].z); acc[5] = dk * acc[5] + ck * bfhi(v[s].z); acc[6] = dk * acc[6] + ck * bflo(v[s].w); acc[7] = dk * acc[7] + ck * bfhi(v[s].w);
            }
        }
    }
}

template <int KIND>
__device__ __forceinline__ float load_state(const unsigned char* ws, int b, int h, int dir, int sc, LAS unsigned char* Simg, int tid) {
    const unsigned char* Sp = ws + WS_S + ((size_t)((((KIND * NB + b) * 4 + h) * 2 + dir) * 18) + sc) * U_BYTES;
    *(LAS u32x4*)(Simg + (tid >> 3) * IST + (tid & 7) * 16) = *(const u32x4*)(Sp + (size_t)tid * 16);
    if (KIND == 1 && tid < 8) *(LAS u32x4*)(Simg + 64 * IST + tid * 16) = *(const u32x4*)(Sp + (size_t)(512 + tid) * 16);
    return KIND == 1 ? ((const float*)(ws + WS_SM))[(size_t)((b * 4 + h) * 2 + dir) * 18 + sc] : 0.f;
}

template <int KIND>
__device__ __forceinline__ void phase_chunk_out(const Args& a, int l, bool need_ctx, LAS unsigned char* lds, int tid, int lane, int wave, int bid, int G) {
    unsigned char* ws = a.ws;
    const bf16_t* P = (const bf16_t*)(ws + WS_BIG); const bf16_t* MQK = (const bf16_t*)(ws + WS_MQK);
    const float* GT = (const float*)(ws + WS_GATES); bf16_t* MG = (bf16_t*)(ws + WS_H);
    LAS unsigned char* Qimg = lds; LAS unsigned char* Kimg = lds + 20480; LAS unsigned char* Vimg = lds + 40960;
    LAS unsigned char* SFimg = lds + 61440; LAS unsigned char* SBimg = lds + 74240;
    LAS float* AF = (LAS float*)(lds + 87040); LAS float* CF = AF + 128; LAS float* BF = AF + 256; LAS float* AB = AF + 384; LAS float* CB = AF + 512; LAS float* BB = AF + 640;
    const int nch = need_ctx ? 18 : 16, nitems = NB * 4 * nch;
    const int g = lane >> 4, qi = 16 * wave + (lane & 15);
    for (int it = bid; it < nitems; it += G) {
        const int cc = it % nch; const int bh = it / nch; const int h = bh & 3, b = bh >> 2;
        const bool isctx = cc >= 16; const int c = isctx ? cc - 16 : cc;
        const int row0 = isctx ? NLAT + b * CTXL + 128 * c : b * SEQ + 128 * c;
        const int scf = isctx ? c : 2 + c, scb = isctx ? 1 - c : 17 - c;
        __syncthreads();
        {
            const int r = tid >> 2, c8 = (tid & 3) * 16;
            const bf16_t* qsrc = KIND == 0 ? P + (size_t)(row0 + r) * NPW + PC_RQ + h * 64 + c8 : MQK + (size_t)(row0 + r) * 512 + h * 64 + c8;
            const bf16_t* ksrc = KIND == 0 ? P + (size_t)(row0 + r) * NPW + PC_RK + h * 64 + c8 : MQK + (size_t)(row0 + r) * 512 + 256 + h * 64 + c8;
            const bf16_t* vsrc = P + (size_t)(row0 + r) * NPW + (KIND == 0 ? PC_RV : PC_MV) + h * 64 + c8;
            const u32x4 q0 = *(const u32x4*)qsrc, q1 = *(const u32x4*)(qsrc + 8), k0 = *(const u32x4*)ksrc, k1 = *(const u32x4*)(ksrc + 8), v0 = *(const u32x4*)vsrc, v1 = *(const u32x4*)(vsrc + 8);
            *(LAS u32x4*)(Qimg + r * IST + c8 * 2) = q0; *(LAS u32x4*)(Qimg + r * IST + c8 * 2 + 16) = q1;
            *(LAS u32x4*)(Kimg + r * IST + c8 * 2) = k0; *(LAS u32x4*)(Kimg + r * IST + c8 * 2 + 16) = k1;
            *(LAS u32x4*)(Vimg + r * IST + c8 * 2) = v0; *(LAS u32x4*)(Vimg + r * IST + c8 * 2 + 16) = v1;
            if ((tid & 3) == 0) { unsigned zz, one; asm volatile("v_mov_b32 %0, 0\n\tv_mov_b32 %1, 0x3f80" : "=v"(zz), "=v"(one)); u32x4 e0; e0.x = one; e0.y = zz; e0.z = zz; e0.w = zz; u32x4 z; z.x = zz; z.y = zz; z.z = zz; z.w = zz;
                *(LAS u32x4*)(Vimg + r * IST + 128) = e0; *(LAS u32x4*)(Vimg + r * IST + 144) = z; }
        }
        const float mpf = load_state<KIND>(ws, b, h, 0, scf, SFimg, tid);
        const float mpb = load_state<KIND>(ws, b, h, 1, scb, SBimg, tid);
        if (KIND == 1 && wave == 0) {
            const size_t r0_ = (size_t)(row0 + lane) * 16, r1_ = (size_t)(row0 + 64 + lane) * 16;
#pragma unroll
            for (int dir = 0; dir < 2; ++dir) {
                const float i0 = GT[r0_ + 4 * dir + h], i1 = GT[r1_ + 4 * dir + h];
                const float f0 = logsigmoidf_(GT[r0_ + 8 + 4 * dir + h]), f1 = logsigmoidf_(GT[r1_ + 8 + 4 * dir + h]);
                float s0 = f0, s1 = f1;
#pragma unroll
                for (int o = 1; o < 64; o <<= 1) { const int sl = lane >= o ? lane - o : lane; const float u0 = lane_get(s0, sl), u1 = lane_get(s1, sl); if (lane >= o) { s0 += u0; s1 += u1; } }
                const float t0 = lane_bcast(s0, 63), t1 = lane_bcast(s1, 63);
                float b0, b1;
                if (dir == 0) { b0 = s0; b1 = t0 + s1; } else { b0 = t0 + t1 - s0 + f0; b1 = t1 - s1 + f1; }
                const float a0 = i0 - b0, a1 = i1 - b1;
                float x0 = a0, x1 = a1;
                if (dir == 0) {
#pragma unroll
                    for (int o = 1; o < 64; o <<= 1) { const int sl = lane >= o ? lane - o : lane; const float u0 = lane_get(x0, sl), u1 = lane_get(x1, sl); if (lane >= o) { x0 = fmaxf(x0, u0); x1 = fmaxf(x1, u1); } }
                    x1 = fmaxf(x1, lane_bcast(x0, 63));
                } else {
#pragma unroll
                    for (int o = 1; o < 64; o <<= 1) { const int sl = lane + o < 64 ? lane + o : lane; const float u0 = lane_get(x0, sl), u1 = lane_get(x1, sl); if (lane + o < 64) { x0 = fmaxf(x0, u0); x1 = fmaxf(x1, u1); } }
                    x0 = fmaxf(x0, lane_bcast(x1, 0));
                }
                const float mp = dir == 0 ? mpf : mpb;
                LAS float* A_ = dir == 0 ? AF : AB; LAS float* C_ = dir == 0 ? CF : CB; LAS float* B_ = dir == 0 ? BF : BB;
                A_[lane] = a0; A_[lane + 64] = a1; C_[lane] = fmaxf(x0, mp); C_[lane + 64] = fmaxf(x1, mp); B_[lane] = b0; B_[lane + 64] = b1;
            }
        }
        __syncthreads();
        const bf16x8 bq0 = frag_row(Qimg, 16 * wave, 0, lane), bq1 = frag_row(Qimg, 16 * wave, 32, lane);
        f32x4 st[8];
#pragma unroll
        for (int kt = 0; kt < 8; ++kt) { f32x4 z = {0.f, 0.f, 0.f, 0.f}; z = mfma16(frag_row(Kimg, 16 * kt, 0, lane), bq0, z); st[kt] = mfma16(frag_row(Kimg, 16 * kt, 32, lane), bq1, z); }
        const int row = row0 + qi;
        if (KIND == 0) {
            const float lgf = logsigmoidf_(a.in[9][(l * 2 + 0) * 4 + h]), lgb = logsigmoidf_(a.in[9][(l * 2 + 1) * 4 + h]);
            f32x4 acc[4];
#pragma unroll
            for (int et = 0; et < 4; ++et) {
                f32x4 zf = {0.f, 0.f, 0.f, 0.f}, zb = zf;
                zf = mfma16(frag_row(SFimg, 16 * et, 0, lane), bq0, zf); zf = mfma16(frag_row(SFimg, 16 * et, 32, lane), bq1, zf);
                zb = mfma16(frag_row(SBimg, 16 * et, 0, lane), bq0, zb); zb = mfma16(frag_row(SBimg, 16 * et, 32, lane), bq1, zb);
                acc[et] = zf * __expf(lgf * (float)(qi + 1)) + zb * __expf(lgb * (float)(128 - qi));
            }
#pragma unroll
            for (int T = 0; T < 4; ++T) {
                f32x4 p0, p1;
#pragma unroll
                for (int j = 0; j < 4; ++j) {
                    const int k0 = 32 * T + 4 * g + j, k1 = k0 + 16;
                    const float w0 = (k0 <= qi ? __expf(lgf * (float)(qi - k0)) : 0.f) + (k0 >= qi ? __expf(lgb * (float)(k0 - qi)) : 0.f);
                    const float w1 = (k1 <= qi ? __expf(lgf * (float)(qi - k1)) : 0.f) + (k1 >= qi ? __expf(lgb * (float)(k1 - qi)) : 0.f);
                    p0[j] = st[2 * T][j] * w0; p1[j] = st[2 * T + 1][j] * w1;
                }
                const bf16x8 bp = pack8(p0, p1);
{ bf16x8 va[4]; frag_tr_x4<true>(Vimg, 32 * T, 0, lane, va);
#pragma unroll
                for (int et = 0; et < 4; ++et) acc[et] = mfma16(va[et], bp, acc[et]); }
            }
            float ss = 0.f;
#pragma unroll
            for (int et = 0; et < 4; ++et) ss += (acc[et][0] * acc[et][0] + acc[et][1] * acc[et][1]) + (acc[et][2] * acc[et][2] + acc[et][3] * acc[et][3]);
            ss = sum_g4(ss);
            const float rs = rsqrtf(ss * (1.0f / 64.0f) + EPS);
#pragma unroll
            for (int et = 0; et < 4; ++et) { const int e0 = h * 64 + 16 * et + 4 * g;
                const u32x2 gw = *(const u32x2*)(P + (size_t)row * NPW + PC_RG + e0);
                u32x2 o; o.x = pk2(siluf_(bflo(gw.x)) * acc[et][0] * rs, siluf_(bfhi(gw.x)) * acc[et][1] * rs); o.y = pk2(siluf_(bflo(gw.y)) * acc[et][2] * rs, siluf_(bfhi(gw.y)) * acc[et][3] * rs);
                *(u32x2*)(MG + (size_t)row * DM + e0) = o; }
        } else {
            const float cf = CF[qi], cb = CB[qi];
            const float gf = __expf(mpf - cf), gb = __expf(mpb - cb);
            f32x4 af[5], ab[5];
#pragma unroll
            for (int et = 0; et < 5; ++et) {
                f32x4 zf = {0.f, 0.f, 0.f, 0.f}, zb = zf;
                zf = mfma16(frag_row(SFimg, 16 * et, 0, lane), bq0, zf); zf = mfma16(frag_row(SFimg, 16 * et, 32, lane), bq1, zf);
                zb = mfma16(frag_row(SBimg, 16 * et, 0, lane), bq0, zb); zb = mfma16(frag_row(SBimg, 16 * et, 32, lane), bq1, zb);
                af[et] = zf * gf; ab[et] = zb * gb;
            }
#pragma unroll
            for (int T = 0; T < 4; ++T) {
                const f32x4 a0f = *(const LAS f32x4*)(AF + 32 * T + 4 * g), a1f = *(const LAS f32x4*)(AF + 32 * T + 16 + 4 * g);
                const f32x4 a0b = *(const LAS f32x4*)(AB + 32 * T + 4 * g), a1b = *(const LAS f32x4*)(AB + 32 * T + 16 + 4 * g);
                f32x4 pf0, pf1, pb0, pb1;
#pragma unroll
                for (int j = 0; j < 4; ++j) {
                    const int k0 = 32 * T + 4 * g + j, k1 = k0 + 16;
                    pf0[j] = k0 <= qi ? st[2 * T][j] * __expf(a0f[j] - cf) : 0.f; pf1[j] = k1 <= qi ? st[2 * T + 1][j] * __expf(a1f[j] - cf) : 0.f;
                    pb0[j] = k0 >= qi ? st[2 * T][j] * __expf(a0b[j] - cb) : 0.f; pb1[j] = k1 >= qi ? st[2 * T + 1][j] * __expf(a1b[j] - cb) : 0.f;
                }
                const bf16x8 bpf = pack8(pf0, pf1), bpb = pack8(pb0, pb1);
{ bf16x8 va[4]; frag_tr_x4<true>(Vimg, 32 * T, 0, lane, va); const bf16x8 v4 = frag_tr<true>(Vimg, 32 * T, 64, lane);
#pragma unroll
                for (int et = 0; et < 4; ++et) { af[et] = mfma16(va[et], bpf, af[et]); ab[et] = mfma16(va[et], bpb, ab[et]); }
                af[4] = mfma16(v4, bpf, af[4]); ab[4] = mfma16(v4, bpb, ab[4]); }
            }
            const float denf = lane_get(af[4][0], lane & 15), denb = lane_get(ab[4][0], lane & 15);
            const float nf = 1.0f / fmaxf(fabsf(denf), __expf(-(BF[qi] + cf))), nb = 1.0f / fmaxf(fabsf(denb), __expf(-(BB[qi] + cb)));
            f32x4 y[4]; float ss = 0.f;
#pragma unroll
            for (int et = 0; et < 4; ++et) { y[et] = af[et] * nf + ab[et] * nb; ss += (y[et][0] * y[et][0] + y[et][1] * y[et][1]) + (y[et][2] * y[et][2] + y[et][3] * y[et][3]); }
            ss = sum_g4(ss);
            const float rs = rsqrtf(ss * (1.0f / 64.0f) + EPS);
#pragma unroll
            for (int et = 0; et < 4; ++et) { const int e0 = h * 64 + 16 * et + 4 * g;
                const u32x2 gw = *(const u32x2*)(P + (size_t)row * NPW + PC_MO + e0);
                u32x2 o; o.x = pk2(sigmoidf_(bflo(gw.x)) * y[et][0] * rs, sigmoidf_(bfhi(gw.x)) * y[et][1] * rs); o.y = pk2(sigmoidf_(bflo(gw.y)) * y[et][2] * rs, sigmoidf_(bfhi(gw.y)) * y[et][3] * rs);
                *(u32x2*)(MG + (size_t)row * DM + 256 + e0) = o; }
        }
    }
}

struct NaItem { int b, h, r, qrow0, sr, nblk, lat; };
__device__ __forceinline__ NaItem na_decode(int it, int nlat) {
    NaItem t; t.lat = it < nlat ? 1 : 0; t.r = 0; t.sr = 0;
    if (t.lat) { t.r = it & 31; t.h = (it >> 5) & 7; t.b = it >> 8; t.qrow0 = t.b * SEQ + t.r * 64; t.sr = min(max(t.r - 4, 0), NROWS - 8); t.nblk = 3; }
    else { const int j = it - nlat; const int qb = j & 3; t.h = (j >> 2) & 7; t.b = j >> 5; t.qrow0 = NLAT + t.b * CTXL + 64 * qb; t.nblk = 1; }
    return t;
}
__device__ __forceinline__ int na_krow0(const NaItem& t, int blk) { return (t.lat && blk < 2) ? t.b * SEQ + t.sr * 64 + 256 * blk : NLAT + t.b * CTXL; }
struct NaKV { u32x4 k[4], v[4]; };
__device__ __forceinline__ void na_load_kv(NaKV& x, const bf16_t* P, int krow0, int h, int tid) {
    const int rr = tid >> 1, c0 = (tid & 1) * 32; const bf16_t* ks = P + (size_t)(krow0 + rr) * NPW + PC_NK + h * 64 + c0; const bf16_t* vs = P + (size_t)(krow0 + rr) * NPW + PC_NV + h * 64 + c0;
#pragma unroll
    for (int i = 0; i < 4; ++i) { x.k[i] = *(const u32x4*)(ks + 8 * i); x.v[i] = *(const u32x4*)(vs + 8 * i); }
}
__device__ __forceinline__ void phase_natt_mfma(const Args& a, int l, bool need_ctx, LAS unsigned char* lds, int tid, int lane, int wave, int bid, int G) {
    unsigned char* ws = a.ws;
    const bf16_t* P = (const bf16_t*)(ws + WS_BIG); bf16_t* MG = (bf16_t*)(ws + WS_H);
    LAS unsigned char* Qimg = lds; LAS unsigned char* Kimg = lds + 10240; LAS unsigned char* Vimg = lds + 51200;
    LAS float* RPB = (LAS float*)(lds + 92160); LAS float* XCH = (LAS float*)(lds + 94208);
    const int nlat = NB * 8 * NROWS, nitems = nlat + (need_ctx ? NB * 8 * 4 : 0);
    const int g = lane >> 4, qt = wave & 3, kh = wave >> 2, ql = 16 * qt + (lane & 15);
    const int scq = min(max(ql - 8, 0), GRIDW - 16);
    const int tlo = min(max(16 * qt - 8, 0), 48), thi = min(max(16 * qt + 7, 0), 48) + 15;
    int it = bid; if (it >= nitems) return;
    NaItem cur = na_decode(it, nlat);
    NaKV kv; na_load_kv(kv, P, na_krow0(cur, 0), cur.h, tid);
    u32x4 qreg = *(const u32x4*)(P + (size_t)(cur.qrow0 + (tid >> 3)) * NPW + PC_NQ + cur.h * 64 + (tid & 7) * 8);
    float rpbreg = tid < 465 ? a.in[15][(size_t)(l * 8 + cur.h) * 465 + tid] : 0.f;
    for (;;) {
        const int itn = it + G; const bool has_next = itn < nitems; NaItem nxt = cur; if (has_next) nxt = na_decode(itn, nlat);
        float m_run = -1.0e30f, l_run = 0.f; f32x4 acc[4];
#pragma unroll
        for (int et = 0; et < 4; ++et) acc[et] = (f32x4){0.f, 0.f, 0.f, 0.f};
        for (int blk = 0; blk < cur.nblk; ++blk) {
            const bool local = cur.lat && blk < 2;
            __syncthreads();
            { const int rr = tid >> 1, c0 = (tid & 1) * 32;
#pragma unroll
              for (int i = 0; i < 4; ++i) { *(LAS u32x4*)(Kimg + rr * IST + (c0 + 8 * i) * 2) = kv.k[i]; *(LAS u32x4*)(Vimg + rr * IST + (c0 + 8 * i) * 2) = kv.v[i]; } }
            if (blk == 0) { *(LAS u32x4*)(Qimg + (tid >> 3) * IST + (tid & 7) * 16) = qreg; if (tid < 465) RPB[tid] = rpbreg; }
            __syncthreads();
            if (blk + 1 < cur.nblk) na_load_kv(kv, P, na_krow0(cur, blk + 1), cur.h, tid);
            else if (has_next) { na_load_kv(kv, P, na_krow0(nxt, 0), nxt.h, tid);
                qreg = *(const u32x4*)(P + (size_t)(nxt.qrow0 + (tid >> 3)) * NPW + PC_NQ + nxt.h * 64 + (tid & 7) * 8);
                rpbreg = tid < 465 ? a.in[15][(size_t)(l * 8 + nxt.h) * 465 + tid] : 0.f; }
            const bf16x8 bq0 = frag_row(Qimg, 16 * qt, 0, lane), bq1 = frag_row(Qimg, 16 * qt, 32, lane);
            f32x4 s[8]; float mx = -1.0e30f;
#pragma unroll
            for (int kt = 0; kt < 8; ++kt) {
                const int tk = 8 * kh + kt, ct = tk & 3; const bool tv = !local || (16 * ct + 15 >= tlo && 16 * ct <= thi);
                if (tv) {
                    f32x4 z = {0.f, 0.f, 0.f, 0.f}; z = mfma16(frag_row(Kimg, 16 * tk, 0, lane), bq0, z); z = mfma16(frag_row(Kimg, 16 * tk, 32, lane), bq1, z);
                    if (local) { const int kk = 4 * blk + (tk >> 2); const LAS float* brow = RPB + (cur.sr + kk - cur.r + 7) * 31;
#pragma unroll
                        for (int j = 0; j < 4; ++j) { const int kcol = 16 * ct + 4 * g + j; const bool ok = kcol >= scq && kcol < scq + 16;
                            z[j] = ok ? z[j] * 0.125f + brow[min(max(kcol - ql + 15, 0), 30)] : -1.0e30f; }
                    } else z = z * 0.125f;
                    s[kt] = z; mx = fmaxf(mx, fmaxf(fmaxf(z[0], z[1]), fmaxf(z[2], z[3])));
                } else s[kt] = (f32x4){-1.0e30f, -1.0e30f, -1.0e30f, -1.0e30f};
            }
            mx = max_g4(mx);
            const float m_new = fmaxf(m_run, mx), resc = __expf(m_run - m_new);
            m_run = m_new; l_run *= resc;
#pragma unroll
            for (int et = 0; et < 4; ++et) acc[et] = acc[et] * resc;
#pragma unroll
            for (int T = 0; T < 4; ++T) {
                f32x4 p0, p1;
#pragma unroll
                for (int j = 0; j < 4; ++j) { p0[j] = s[2 * T][j] > -1.0e29f ? __expf(s[2 * T][j] - m_new) : 0.f; p1[j] = s[2 * T + 1][j] > -1.0e29f ? __expf(s[2 * T + 1][j] - m_new) : 0.f; }
                l_run += (p0[0] + p0[1]) + (p0[2] + p0[3]) + (p1[0] + p1[1]) + (p1[2] + p1[3]);
                const bf16x8 bp = pack8(p0, p1);
                bf16x8 va[4]; frag_tr_x4<true>(Vimg, 128 * kh + 32 * T, 0, lane, va);
#pragma unroll
                for (int et = 0; et < 4; ++et) acc[et] = mfma16(va[et], bp, acc[et]);
            }
        }
        l_run = sum_g4(l_run);
        LAS float* xw = XCH + (qt * 64 + lane) * 18;
        if (kh == 1) { xw[0] = m_run; xw[1] = l_run;
#pragma unroll
            for (int et = 0; et < 4; ++et)
#pragma unroll
                for (int j = 0; j < 4; ++j) xw[2 + et * 4 + j] = acc[et][j]; }
        __syncthreads();
        if (kh == 0) {
            const float m1 = xw[0], l1 = xw[1]; const float mt = fmaxf(m_run, m1), f0 = __expf(m_run - mt), f1 = __expf(m1 - mt);
            const float inv = 1.0f / (l_run * f0 + l1 * f1);
            const int row = cur.qrow0 + ql;
#pragma unroll
            for (int et = 0; et < 4; ++et) { float o[4];
#pragma unroll
                for (int j = 0; j < 4; ++j) o[j] = (acc[et][j] * f0 + xw[2 + et * 4 + j] * f1) * inv;
                u32x2 w; w.x = pk2(o[0], o[1]); w.y = pk2(o[2], o[3]);
                *(u32x2*)(MG + (size_t)row * DM + 512 + cur.h * 64 + 16 * et + 4 * g) = w; }
        }
        if (!has_next) break;
        it = itn; cur = nxt;
    }
}

constexpr int MOE_TAB_OFF = 131072;
__device__ __forceinline__ void moe_tab_setup(const unsigned char* ws, LAS unsigned char* lds, int tid) {
    if (tid == 0) { LAS int* tab = (LAS int*)(lds + MOE_TAB_OFF); int p = 0;
        for (int e = 0; e < NEXP; ++e) { const int c = (int)__hip_atomic_load((const unsigned*)(ws + WS_CTL) + CW_MOE + 64 * e, __ATOMIC_RELAXED, __HIP_MEMORY_SCOPE_AGENT); tab[e] = p; tab[16 + e] = c; p += (c + 255) >> 8; }
        tab[8] = p; }
    __syncthreads();
}
namespace pg8 {
struct MoeOrder : StaticOrder {
    const PG8_LAS int* tab; const int* list; size_t bstride;
    __device__ __forceinline__ int expert(int pm) const { int e = 0;
#pragma unroll
        for (int k = 1; k < 8; ++k) e += (pm >= tab[k]) ? 1 : 0;
        return e; }
    __device__ __forceinline__ unsigned arow(const Unit& u, int R) const {
        const int Rr = (u.hs > 0 ? HALF : 0) + (u.hs >= 0 ? (R & (HALF - 1)) : R);
        if (!list) return (unsigned)(u.pm * BM + Rr);
        const int e = expert(u.pm), idx = (u.pm - tab[e]) * BM + Rr;
        return idx < tab[16 + e] ? (unsigned)list[e * NLAT + idx] : 0u; }
    __device__ __forceinline__ const char* bbase(const Unit& u) const { return Bt + (size_t)expert(u.pm) * bstride + (size_t)u.pn * BM * K2; }
};
}
__device__ __forceinline__ void phase_moe_combine(const Args& a, LAS unsigned char* lds, int lane, int wave, int bid, int G) {
    unsigned char* ws = a.ws; const LAS int* tab = (const LAS int*)(lds + MOE_TAB_OFF);
    const int* TOK = (const int*)(ws + WS_COMB); const bf16_t* Y = (const bf16_t*)(ws + WS_WTMUP);
    const float* g2 = (const float*)(ws + WS_MOD) + (size_t)9 * 6144 + 5120;
    for (int r = bid * NWAVES + wave; r < NLAT; r += G * NWAVES) {
        const int e1 = TOK[r * 8], e2 = TOK[r * 8 + 1], p1 = TOK[r * 8 + 2], p2 = TOK[r * 8 + 3]; const float w1 = __int_as_float(TOK[r * 8 + 4]), w2 = __int_as_float(TOK[r * 8 + 5]);
        const bf16_t* y1 = Y + ((size_t)tab[e1] * 256 + p1) * DM; const bf16_t* y2 = Y + ((size_t)tab[e2] * 256 + p2) * DM;
        const float* gr = g2 + (size_t)(r >> 11) * 6144; float* o = a.out + (size_t)r * DM;
#pragma unroll
        for (int j = 0; j < 4; ++j) { const int k = 4 * lane + 256 * j;
            const u32x2 a1 = *(const u32x2*)(y1 + k), a2 = *(const u32x2*)(y2 + k); const f32x4 x = *(const f32x4*)(o + k), gg = *(const f32x4*)(gr + k);
            f32x4 m; m.x = w1 * bflo(a1.x) + w2 * bflo(a2.x); m.y = w1 * bfhi(a1.x) + w2 * bfhi(a2.x); m.z = w1 * bflo(a1.y) + w2 * bflo(a2.y); m.w = w1 * bfhi(a1.y) + w2 * bfhi(a2.y);
            *(f32x4*)(o + k) = x + gg * m; }
    }
}
#ifndef DUP_VIRT
#define DUP_VIRT (-1)
#endif
#define PH_REP_OPEN
#define PH_REP_CLOSE
#ifndef DUP_PH
#define DUP_PH (-1)
#endif
#ifndef PH_ONLY
#define PH_ONLY 0
#endif
#ifndef MIX_NAIVE
#define MIX_NAIVE 0
#endif
#ifndef MIX_RET
#define MIX_RET 1
#endif
#ifndef MIX_ML
#define MIX_ML 1
#endif
#ifndef MIX_NA
#define MIX_NA 1
#endif
#ifndef EN_PRO
#define EN_PRO 1
#endif
#ifndef EN_NORM
#define EN_NORM 1
#endif
#ifndef EN_GIN
#define EN_GIN 1
#endif
#ifndef EN_POST
#define EN_POST 1
#endif
#ifndef EN_FCUM
#define EN_FCUM 1
#endif
#ifndef EN_QUAD
#define EN_QUAD 1
#endif
#ifndef EN_NATT
#define EN_NATT 1
#endif
#ifndef EN_MERGE
#define EN_MERGE 1
#endif
#ifndef EN_GOUT
#define EN_GOUT 1
#endif
#ifndef EN_NORM2
#define EN_NORM2 1
#endif
#ifndef EN_GUP
#define EN_GUP 1
#endif
#ifndef EN_GDN
#define EN_GDN 1
#endif

__global__ void __launch_bounds__(NTHR, 2) fwd_kernel(Args a_) {
    extern __shared__ __attribute__((aligned(16))) unsigned char lds_raw[];
    LAS unsigned char* lds = (LAS unsigned char*)lds_raw;
    const int tid0 = threadIdx.x, G = gridDim.x, bid = blockIdx.x; const int wave0 = __builtin_amdgcn_readfirstlane(tid0 >> 6);
    unsigned char* ws0 = a_.ws;
    volatile LAS unsigned* MISC = (volatile LAS unsigned*)(lds + MISC_OFF);
    if (tid0 < 32) MISC[tid0] = 0u;
    __syncthreads();
    const int lo = a_.ph_lo, hi = a_.ph_hi;
    XcdBarrier bar; bar.bar = (unsigned*)(ws0 + WS_CTL) + CW_BAR; bar.x = 0; bar.st = MISC + 8;
    if (hi - lo > 1) bar = xcd_barrier_post((unsigned*)(ws0 + WS_CTL) + CW_BAR, MISC + 8);
    int ph = 0;
#define PH_BEGIN if (ph >= lo && ph < hi) { asm volatile("; PHMARK_BEGIN %0" :: "i"(__LINE__)); int tid; asm volatile("v_mbcnt_lo_u32_b32 %0, -1, 0\n\tv_mbcnt_hi_u32_b32 %0, -1, %0" : "=v"(tid)); tid += wave0 * 64; Args a; { const __attribute__((address_space(4))) Args* ap = (const __attribute__((address_space(4))) Args*)__builtin_amdgcn_kernarg_segment_ptr(); asm volatile("" : "+s"(ap)); a = *(const Args*)ap; } unsigned char* ws = a.ws; (void)ws; PH_REP_OPEN if (PH_ONLY == 0 || PH_ONLY == __LINE__) { const int lane = tid & 63, wave = __builtin_amdgcn_readfirstlane(tid >> 6); (void)lane; (void)wave;
#define PH_END   } PH_REP_CLOSE asm volatile("; PHMARK_END %0" :: "i"(__LINE__)); if (ph + 1 < hi) xcd_barrier(bar); else __syncthreads(); } ++ph;

    PH_BEGIN
#if EN_PRO
 phase_prologue(a, lds, tid, lane, wave, bid, G);
#endif
 PH_END

    for (int l = 0; l < 2; ++l) {
        const bool need_ctx = (l == 0);
#define MODP ((const float*)(ws + WS_MOD) + (size_t)l * 9 * 6144)
        PH_BEGIN
#if EN_NORM
 phase_norm<0>(a, l, lds, tid, lane, wave, bid, G);
#endif
 PH_END
        PH_BEGIN
#if EN_GIN
 { pg8::Gemm g{(const bf16_t*)(ws + WS_H), (const bf16_t*)(ws + WS_WTIN) + (size_t)l * NPW * DM, MALL, NPW, DM};
                   pg8::StaticOrder S; S.init(MALL, NPW, G, bid); S.Bt = (const char*)g.Bt; S.K2 = 2 * DM; pg8::EpiBf16 E{(bf16_t*)(ws + WS_BIG), NPW};
                   pg8::gemm_phase<pg8::EpiBf16, pg8::StaticOrder, false>(lds, g, S, E, nullptr, tid); }
#endif
 PH_END
        PH_BEGIN
#if EN_POST
 phase_post(a, l, lane, wave, bid, G);
#endif
 PH_END
        PH_BEGIN
#if MIX_RET || MIX_ML
        phase_chunk_sums(a, l, lds, tid, lane, wave, bid, G);
#endif
        PH_END
        PH_BEGIN phase_chunk_states(a, l, tid, bid, G); PH_END
        PH_BEGIN
#if MIX_RET
        phase_chunk_out<0>(a, l, need_ctx, lds, tid, lane, wave, bid, G);
#endif
#if MIX_ML
        phase_chunk_out<1>(a, l, need_ctx, lds, tid, lane, wave, bid, G);
#endif
#if MIX_NA
        phase_natt_mfma(a, l, need_ctx, lds, tid, lane, wave, bid, G);
#endif
        PH_END
        PH_BEGIN
#if EN_GOUT
 { const int M = need_ctx ? MALL : NLAT;
                   pg8::Gemm g{(const bf16_t*)(ws + WS_H), (const bf16_t*)(ws + WS_WTOUT) + (size_t)l * DM * DM, M, DM, DM};
                   pg8::StaticOrder S; S.init(M, DM, G, bid); S.Bt = (const char*)g.Bt; S.K2 = 2 * DM;
                   pg8::EpiResid E{l == 0 ? a.in[0] : a.out, l == 0 ? a.in[2] : (const float*)(ws + WS_XC), a.out, (float*)(ws + WS_XC), MODP + 2048, nullptr, 0, NLAT / 256};
                   pg8::gemm_phase<pg8::EpiResid, pg8::StaticOrder, false>(lds, g, S, E, nullptr, tid); }
#endif
 PH_END
        if (l == 0) { PH_BEGIN
#if EN_NORM2
 phase_norm<1>(a, l, lds, tid, lane, wave, bid, G);
#endif
 PH_END }
        else        { PH_BEGIN
#if EN_NORM2
 phase_norm<2>(a, l, lds, tid, lane, wave, bid, G);
#endif
 PH_END }
        if (l == 0) {
            PH_BEGIN { pg8::Gemm g{(const bf16_t*)(ws + WS_H), (const bf16_t*)(ws + WS_WTUP), MALL, NUP, DM};
                       pg8::StaticOrder S; S.init(MALL, NUP, G, bid); S.Bt = (const char*)g.Bt; S.K2 = 2 * DM; pg8::EpiSwiGLU E{(bf16_t*)(ws + WS_BIG), DFF};
                       pg8::gemm_phase<pg8::EpiSwiGLU, pg8::StaticOrder, false>(lds, g, S, E, nullptr, tid); } PH_END
            PH_BEGIN { pg8::Gemm g{(const bf16_t*)(ws + WS_BIG), (const bf16_t*)(ws + WS_WTDN), MALL, DM, DFF};
                       pg8::StaticOrder S; S.init(MALL, DM, G, bid); S.Bt = (const char*)g.Bt; S.K2 = 2 * DFF;
                       pg8::EpiResid E{a.out, (const float*)(ws + WS_XC), a.out, (float*)(ws + WS_XC), MODP + 5120, nullptr, 0, NLAT / 256};
                       pg8::gemm_phase<pg8::EpiResid, pg8::StaticOrder, false>(lds, g, S, E, nullptr, tid); } PH_END
        } else {
            PH_BEGIN { moe_tab_setup(ws, lds, tid); const LAS int* tab = (const LAS int*)(lds + MOE_TAB_OFF);
                       pg8::Gemm g{(const bf16_t*)(ws + WS_H), (const bf16_t*)(ws + WS_WTMUP), 256 * tab[8], NUP, DM};
                       pg8::MoeOrder S; S.init(256 * tab[8], NUP, G, bid); S.Bt = (const char*)g.Bt; S.K2 = 2 * DM; S.tab = tab; S.list = (const int*)(ws + WS_LIST); S.bstride = (size_t)NUP * DM * 2;
                       pg8::EpiSwiGLU E{(bf16_t*)(ws + WS_BIG), DFF};
                       pg8::gemm_phase<pg8::EpiSwiGLU, pg8::MoeOrder, false>(lds, g, S, E, nullptr, tid); } PH_END
            PH_BEGIN { moe_tab_setup(ws, lds, tid); const LAS int* tab = (const LAS int*)(lds + MOE_TAB_OFF);
                       pg8::Gemm g{(const bf16_t*)(ws + WS_BIG), (const bf16_t*)(ws + WS_WTMDN), 256 * tab[8], DM, DFF};
                       pg8::MoeOrder S; S.init(256 * tab[8], DM, G, bid); S.Bt = (const char*)g.Bt; S.K2 = 2 * DFF; S.tab = tab; S.list = nullptr; S.bstride = (size_t)DM * DFF * 2;
                       pg8::EpiBf16 E{(bf16_t*)(ws + WS_WTMUP), DM};
                       pg8::gemm_phase<pg8::EpiBf16, pg8::MoeOrder, false>(lds, g, S, E, nullptr, tid); } PH_END
            PH_BEGIN { moe_tab_setup(ws, lds, tid); phase_moe_combine(a, lds, lane, wave, bid, G); } PH_END
        }
    }
#if N_LAUNCH_MODE == 1
    if (lo >= 100) {
        int tid; asm volatile("v_mbcnt_lo_u32_b32 %0, -1, 0\n\tv_mbcnt_hi_u32_b32 %0, -1, %0" : "=v"(tid)); tid += wave0 * 64; const int lane = tid & 63, wave = wave0;
        Args a = a_;
        if (lo == 100) phase_chunk_out<0>(a, 0, true, lds, tid, lane, wave, bid, G);
        if (lo == 101) phase_chunk_out<1>(a, 0, true, lds, tid, lane, wave, bid, G);
        if (lo == 102) phase_natt_mfma(a, 0, true, lds, tid, lane, wave, bid, G);
    }
#endif
#undef PH_BEGIN
#undef PH_END
}
constexpr int N_PHASES = 1 + 2 * 8 + 2 + 3;
#ifndef DBG_MAXPH
#define DBG_MAXPH 1000
#endif

extern "C" void kernel_launch(void* const* d_in, const int* in_sizes, int n_in, void* d_out, int out_size, void* d_ws, size_t ws_size, hipStream_t stream) {
    static int grid = 0;
    if (grid == 0) {
        if (n_in != 24 || out_size != NLAT * DM || ws_size < WS_END) { fprintf(stderr, "kernel_launch: unexpected sizes (n_in %d, out %d, ws %zu < %zu); nothing launched\n", n_in, out_size, ws_size, (size_t)WS_END); grid = -1; return; }
        int dev = 0, cus = 0;
        if (hipGetDevice(&dev) != hipSuccess || hipDeviceGetAttribute(&cus, hipDeviceAttributeMultiprocessorCount, dev) != hipSuccess) { grid = -1; return; }
        if (hipFuncSetAttribute((const void*)fwd_kernel, hipFuncAttributeMaxDynamicSharedMemorySize, LDS_BYTES) != hipSuccess) { fprintf(stderr, "kernel_launch: hipFuncSetAttribute failed\n"); grid = -1; return; }
        int per_cu = 0;
        if (hipOccupancyMaxActiveBlocksPerMultiprocessor(&per_cu, (const void*)fwd_kernel, NTHR, LDS_BYTES) != hipSuccess || per_cu < 1) { fprintf(stderr, "kernel_launch: occupancy query says %d\n", per_cu); }
        (void)hipGetLastError();
        grid = cus;
    }
    if (grid < 0) return;
    (void)hipMemsetAsync((char*)d_ws + WS_CTL, 0, CTL_BYTES, stream);
    Args a{};
    for (int i = 0; i < 24; ++i) a.in[i] = (const float*)d_in[i];
    a.out = (float*)d_out; a.ws = (unsigned char*)d_ws;
#if N_LAUNCH_MODE == 0
    a.ph_lo = 0; a.ph_hi = N_PHASES;
    hipLaunchKernelGGL(fwd_kernel, dim3(grid), dim3(NTHR), LDS_BYTES, stream, a);
#else
    for (int p = 0; p < N_PHASES && p < DBG_MAXPH; ++p) { a.ph_lo = p; a.ph_hi = p + 1; hipLaunchKernelGGL(fwd_kernel, dim3(grid), dim3(NTHR), LDS_BYTES, stream, a);
        if (p == DUP_PH) hipLaunchKernelGGL(fwd_kernel, dim3(grid), dim3(NTHR), LDS_BYTES, stream, a);
        if (p == 6 && DUP_VIRT >= 100) { a.ph_lo = DUP_VIRT; a.ph_hi = DUP_VIRT + 1; hipLaunchKernelGGL(fwd_kernel, dim3(grid), dim3(NTHR), LDS_BYTES, stream, a); } }
#endif
}
```

```cpp
#include <hip/hip_runtime.h>
#include <stdio.h>
#include <stdint.h>

#ifndef N_LAUNCH_MODE
#define N_LAUNCH_MODE 0
#endif

constexpr int NB = 8, SEQ = 2048, DM = 1024, CTXL = 256, HD = 64;
constexpr int NLAT = NB * SEQ, NCTX = NB * CTXL, MALL = NLAT + NCTX;
constexpr int DIN = 3600, NPW = 3584;
constexpr int DFF = 2816, NUP = 2 * DFF, NEXP = 8;
constexpr int GRIDW = 64, NROWS = 32;
constexpr float EPS = 1e-6f;
constexpr int PC_RQ = 0, PC_RK = 256, PC_RV = 512, PC_RG = 768, PC_MQ = 1024, PC_MK = 1280, PC_MV = 1536, PC_MO = 1792, PC_NQ = 2048, PC_NK = 2560, PC_NV = 3072;

constexpr size_t al256(size_t x) { return (x + 255) & ~(size_t)255; }
constexpr size_t WS_CTL = 0, CTL_BYTES = 1u << 20;
constexpr size_t WS_MOD = WS_CTL + CTL_BYTES;
constexpr size_t WS_ROPE = WS_MOD + al256((size_t)2 * 9 * 6144 * 4);
constexpr size_t WS_WTIN = WS_ROPE + al256(64 * 16 * 2 * 4);
constexpr size_t WS_WTOUT = WS_WTIN + (size_t)2 * NPW * DM * 2;
constexpr size_t WS_WTUP = WS_WTOUT + (size_t)2 * DM * DM * 2;
constexpr size_t WS_WTDN = WS_WTUP + (size_t)NUP * DM * 2;
constexpr size_t WS_WTMUP = WS_WTDN + (size_t)DM * DFF * 2;
constexpr size_t WS_WTMDN = WS_WTMUP + (size_t)NEXP * NUP * DM * 2;
constexpr size_t WS_H = WS_WTMDN + (size_t)NEXP * DM * DFF * 2;
constexpr size_t WS_XC = WS_H + (size_t)MALL * DM * 2;
constexpr size_t WS_GATES = WS_XC + (size_t)NCTX * DM * 4;
constexpr size_t WS_COMB = WS_GATES + (size_t)MALL * 16 * 4;
constexpr size_t WS_USC = WS_COMB + (size_t)NLAT * 8 * 4;
constexpr size_t WS_SM = WS_USC + al256((size_t)NB * 4 * 2 * 18 * 2 * 4);
constexpr size_t WS_LIST = WS_SM + al256((size_t)NB * 4 * 2 * 18 * 4);
constexpr size_t WS_BIG = WS_LIST + (size_t)NEXP * NLAT * 4;
constexpr size_t WS_MQK = WS_BIG + (size_t)MALL * NPW * 2;
constexpr size_t WS_U = WS_MQK + (size_t)MALL * 512 * 2;
constexpr size_t WS_S = WS_U + (size_t)2 * NB * 4 * 2 * 18 * 80 * 64 * 2;
constexpr size_t WS_END0 = WS_S + (size_t)2 * NB * 4 * 2 * 18 * 80 * 64 * 2;
constexpr size_t MOE_ROWS = 34816;
constexpr size_t WS_ACTM_END = WS_BIG + MOE_ROWS * DFF * 2;
constexpr size_t WS_END = WS_END0 > WS_ACTM_END ? WS_END0 : WS_ACTM_END;

typedef unsigned short bf16_t;
typedef float f32x4 __attribute__((ext_vector_type(4)));
typedef float f32x2 __attribute__((ext_vector_type(2)));
typedef unsigned u32x4 __attribute__((ext_vector_type(4)));
typedef unsigned u32x2 __attribute__((ext_vector_type(2)));
#define LAS __attribute__((address_space(3)))
#define GAS __attribute__((address_space(1)))

__device__ __forceinline__ float bf2f(bf16_t b) { return __uint_as_float(((unsigned)b) << 16); }
__device__ __forceinline__ unsigned f2bf(float f) { unsigned u = __float_as_uint(f); return (u + 0x7fffu + ((u >> 16) & 1u)) >> 16; }
typedef __bf16 bf16x2_t __attribute__((ext_vector_type(2)));
__device__ __forceinline__ unsigned pk2(float lo, float hi) { f32x2 v = {lo, hi}; bf16x2_t b = __builtin_convertvector(v, bf16x2_t); return __builtin_bit_cast(unsigned, b); }
__device__ __forceinline__ float bflo(unsigned w) { return __uint_as_float(w << 16); }
__device__ __forceinline__ float bfhi(unsigned w) { return __uint_as_float(w & 0xffff0000u); }
__device__ __forceinline__ float sigmoidf_(float x) { return 1.0f / (1.0f + __expf(-x)); }
__device__ __forceinline__ float siluf_(float x) { return x / (1.0f + __expf(-x)); }
__device__ __forceinline__ float logsigmoidf_(float x) { return fminf(x, 0.f) - log1pf(__expf(-fabsf(x))); }
template <int O> __device__ __forceinline__ float swz_xor(float v) { return __int_as_float(__builtin_amdgcn_ds_swizzle(__float_as_int(v), (O << 10) | 0x1f)); }
__device__ __forceinline__ float red32_sum(float v) { const auto r = __builtin_amdgcn_permlane32_swap(__float_as_uint(v), __float_as_uint(v), false, false); return __uint_as_float(r[0]) + __uint_as_float(r[1]); }
__device__ __forceinline__ float red32_max(float v) { const auto r = __builtin_amdgcn_permlane32_swap(__float_as_uint(v), __float_as_uint(v), false, false); return fmaxf(__uint_as_float(r[0]), __uint_as_float(r[1])); }
__device__ __forceinline__ float wave_sum(float v) { v += swz_xor<1>(v); v += swz_xor<2>(v); v += swz_xor<4>(v); v += swz_xor<8>(v); v += swz_xor<16>(v); return red32_sum(v); }
__device__ __forceinline__ float wave_max(float v) { v = fmaxf(v, swz_xor<1>(v)); v = fmaxf(v, swz_xor<2>(v)); v = fmaxf(v, swz_xor<4>(v)); v = fmaxf(v, swz_xor<8>(v)); v = fmaxf(v, swz_xor<16>(v)); return red32_max(v); }
__device__ __forceinline__ float sum_g4(float v) { v += swz_xor<16>(v); return red32_sum(v); }
__device__ __forceinline__ float max_g4(float v) { v = fmaxf(v, swz_xor<16>(v)); return red32_max(v); }
__device__ __forceinline__ float reduce16_lanes(const float (&p)[16], int lane) {
    float q[8], r[4], s[2];
#pragma unroll
    for (int j = 0; j < 8; ++j) { const auto x = __builtin_amdgcn_permlane32_swap(__float_as_uint(p[j]), __float_as_uint(p[j + 8]), false, false); q[j] = __uint_as_float(x[0]) + __uint_as_float(x[1]); }
    const bool b4 = (lane & 16) != 0, b3 = (lane & 8) != 0, b2 = (lane & 4) != 0;
#pragma unroll
    for (int j = 0; j < 4; ++j) { const float keep = b4 ? q[j + 4] : q[j], send = b4 ? q[j] : q[j + 4]; r[j] = keep + swz_xor<16>(send); }
#pragma unroll
    for (int j = 0; j < 2; ++j) { const float keep = b3 ? r[j + 2] : r[j], send = b3 ? r[j] : r[j + 2]; s[j] = keep + swz_xor<8>(send); }
    float v; { const float keep = b2 ? s[1] : s[0], send = b2 ? s[0] : s[1]; v = keep + swz_xor<4>(send); }
    v += swz_xor<2>(v); v += swz_xor<1>(v);
    return v;
}
__device__ __forceinline__ float reduce8_lanes(const float (&p)[8], int lane) {
    float q[4], r[2];
#pragma unroll
    for (int j = 0; j < 4; ++j) { const auto x = __builtin_amdgcn_permlane32_swap(__float_as_uint(p[j]), __float_as_uint(p[j + 4]), false, false); q[j] = __uint_as_float(x[0]) + __uint_as_float(x[1]); }
    const bool b4 = (lane & 16) != 0, b3 = (lane & 8) != 0;
#pragma unroll
    for (int j = 0; j < 2; ++j) { const float keep = b4 ? q[j + 2] : q[j], send = b4 ? q[j] : q[j + 2]; r[j] = keep + swz_xor<16>(send); }
    float v; { const float keep = b3 ? r[1] : r[0], send = b3 ? r[0] : r[1]; v = keep + swz_xor<8>(send); }
    v += swz_xor<4>(v); v += swz_xor<2>(v); v += swz_xor<1>(v);
    return v;
}
__device__ __forceinline__ float lane_get(float v, int src_lane) { return __int_as_float(__builtin_amdgcn_ds_bpermute(src_lane << 2, __float_as_int(v))); }
__device__ __forceinline__ float lane_bcast(float v, int k) { return __int_as_float(__builtin_amdgcn_readlane(__float_as_int(v), k)); }

struct Args {
    const float* in[24];
    float* out;
    unsigned char* ws;
    int ph_lo, ph_hi;
};
namespace pg8 {
#define PG8_LAS __attribute__((address_space(3)))
typedef unsigned short bf16_t;
typedef short bf16x8 __attribute__((ext_vector_type(8)));
typedef float f32x4 __attribute__((ext_vector_type(4)));
typedef unsigned u32x4 __attribute__((ext_vector_type(4)));
constexpr int BM = 256, BK = 64, HALF = 128, HTB = HALF * BK * 2  , STAGE_BYTES = 8 * HTB, NXCD = 8, WGM = 8;

__host__ __device__ __forceinline__ int lds_byte(int r, int c) { const int st = (r >> 4) * 2 + (c >> 5), rr = r & 15, cc = c & 31, ob = rr * 64 + cc * 2; return st * 1024 + (ob ^ (((ob >> 9) & 1) << 5)); }
__host__ __device__ __forceinline__ void stage_rc(int b, int& R, int& C) { const int st = b / 1024, sb = b % 1024, swz = sb ^ (((sb >> 9) & 1) << 5); R = (st >> 1) * 16 + swz / 64; C = (st & 1) * 32 + (swz % 64) / 2; }
__host__ __device__ __forceinline__ int perm32(int rho) { const int n = rho >> 4, i = rho & 15; return 8 * (i >> 2) + 4 * n + (i & 3); }

struct Unit { int pm, pn, hs; };
struct Gemm { const bf16_t* A; const bf16_t* Bt; int M, N, K; };

struct StaticOrder {
    int nM, nN, nwg, G, c;
    __host__ __device__ void init(int M, int N, int G_, int c_) { nM = M / BM; nN = N / BM; nwg = nM * nN; G = G_; c = c_; }
    __host__ __device__ bool next(int i, Unit& u) const {
        const int nfr = nwg / G, left = nwg - nfr * G; int wgid; u.hs = -1;
        if (i < nfr) wgid = i * G + c;
        else if (i == nfr && left > 0) { if (2 * left <= G) { if (c >= 2 * left) return false; wgid = nfr * G + (c >> 1); u.hs = c & 1; } else { if (c >= left) return false; wgid = nfr * G + c; } }
        else return false; { const int q = nwg / NXCD, r = nwg % NXCD, xcd = wgid % NXCD, off = wgid / NXCD; wgid = (xcd < r ? xcd * (q + 1) : r * (q + 1) + (xcd - r) * q) + off; }
        const int nig = WGM * nN, gid = wgid / nig, fm = gid * WGM, gsz = (nM - fm) < WGM ? (nM - fm) : WGM;
        u.pm = fm + ((wgid % nig) % gsz); u.pn = (wgid % nig) / gsz; return true;
    }
    __device__ __forceinline__ void a_ready(const Unit&) const {}
    __device__ __forceinline__ void done(const Unit&) const {}
    const char* Bt; int K2;
    __device__ __forceinline__ unsigned arow(const Unit& u, int R) const { return (unsigned)(u.pm * BM + (u.hs > 0 ? HALF : 0) + (u.hs >= 0 ? (R & (HALF - 1)) : R)); }
    __device__ __forceinline__ const char* bbase(const Unit& u) const { return Bt + (size_t)u.pn * BM * K2; }
};
__device__ __forceinline__ unsigned cvt_pk_bf16(float lo, float hi) { return ::pk2(lo, hi); }
typedef float f32x2 __attribute__((ext_vector_type(2)));
struct EpiBf16 {
    static constexpr bool PERM = true, AFTER_DRAIN = false;
    bf16_t* O; int ldc;
    __device__ __forceinline__ void operator()(const f32x4 (&acc)[2][2][4][2], const Unit& u, int wr, int wc, int fr, int fq) const {
        const int row0 = u.pm * BM + (u.hs > 0 ? HALF : 0) + wr * 64 + fr, col0 = u.pn * BM + wc * 32 + 8 * fq; const int nai = u.hs >= 0 ? 1 : 2;
#pragma unroll
        for (int ai = 0; ai < 2; ++ai) if (ai < nai)
#pragma unroll
            for (int m = 0; m < 4; ++m) { bf16_t* rowp = O + (size_t)(row0 + ai * HALF + m * 16) * ldc + col0;
#pragma unroll
                for (int bj = 0; bj < 2; ++bj) { const f32x4 v0 = acc[ai][bj][m][0], v1 = acc[ai][bj][m][1];
                    u32x4 w; w.x = cvt_pk_bf16(v0[0], v0[1]); w.y = cvt_pk_bf16(v0[2], v0[3]); w.z = cvt_pk_bf16(v1[0], v1[1]); w.w = cvt_pk_bf16(v1[2], v1[3]);
                    *(u32x4*)(rowp + bj * HALF) = w; } }
    }
};
struct EpiSwiGLU {
    static constexpr bool PERM = true, AFTER_DRAIN = false;
    bf16_t* O; int ldc;
    __device__ __forceinline__ void operator()(const f32x4 (&acc)[2][2][4][2], const Unit& u, int wr, int wc, int fr, int fq) const {
        const int row0 = u.pm * BM + (u.hs > 0 ? HALF : 0) + wr * 64 + fr, col0 = u.pn * HALF + wc * 32 + 8 * fq; const int nai = u.hs >= 0 ? 1 : 2;
#pragma unroll
        for (int ai = 0; ai < 2; ++ai) if (ai < nai)
#pragma unroll
            for (int m = 0; m < 4; ++m) { bf16_t* rowp = O + (size_t)(row0 + ai * HALF + m * 16) * ldc + col0;
                float r[8];
#pragma unroll
                for (int n = 0; n < 2; ++n)
#pragma unroll
                    for (int j = 0; j < 4; ++j) { const float g = acc[ai][0][m][n][j], uu = acc[ai][1][m][n][j]; r[n * 4 + j] = g / (1.0f + __expf(-g)) * uu; }
                u32x4 w; w.x = cvt_pk_bf16(r[0], r[1]); w.y = cvt_pk_bf16(r[2], r[3]); w.z = cvt_pk_bf16(r[4], r[5]); w.w = cvt_pk_bf16(r[6], r[7]);
                *(u32x4*)rowp = w; }
    }
};
struct EpiResid {
    static constexpr bool PERM = false, AFTER_DRAIN = false;
    const float* base_lat; const float* base_ctx; float* out_lat; float* out_ctx; const float* gate; const float* comb; int comb_ld; int nlat_tiles;
    __device__ __forceinline__ void operator()(const f32x4 (&acc)[2][2][4][2], const Unit& u, int wr, int wc, int fr, int fq) const {
        const bool isctx = u.pm >= nlat_tiles;
        const int rloc0 = (isctx ? (u.pm - nlat_tiles) : u.pm) * BM + (u.hs > 0 ? HALF : 0) + wr * 64 + fr, col0 = u.pn * BM + wc * 32 + 4 * fq; const int nai = u.hs >= 0 ? 1 : 2;
        const float* bp = isctx ? base_ctx : base_lat; float* op = isctx ? out_ctx : out_lat;
        const float* gp = gate + (size_t)(isctx ? 8 : (u.pm >> 3)) * 6144 + col0;
        f32x4 gv[2][2];
#pragma unroll
        for (int bj = 0; bj < 2; ++bj)
#pragma unroll
            for (int n = 0; n < 2; ++n) gv[bj][n] = *(const f32x4*)(gp + bj * HALF + n * 16);
#pragma unroll
        for (int ai = 0; ai < 2; ++ai) if (ai < nai)
#pragma unroll
            for (int m = 0; m < 4; ++m) { const int rl = rloc0 + ai * HALF + m * 16; const size_t off = (size_t)rl * 1024 + col0;
                const float cs = comb ? comb[(size_t)rl * comb_ld] : 1.0f;
#pragma unroll
                for (int bj = 0; bj < 2; ++bj)
#pragma unroll
                    for (int n = 0; n < 2; ++n) { const f32x4 bs = *(const f32x4*)(bp + off + bj * HALF + n * 16);
                        *(f32x4*)(op + off + bj * HALF + n * 16) = bs + gv[bj][n] * acc[ai][bj][m][n] * cs; } }
    }
};
template <class Epi, class Sched, bool STAMP = false>
__device__ __forceinline__ void gemm_phase(PG8_LAS unsigned char* lds, const Gemm g, const Sched& S, const Epi& E, unsigned long long* stamps, int tid_in) {
    int tid_ = tid_in; asm volatile("" : "+v"(tid_)); const int tid = tid_, wid = __builtin_amdgcn_readfirstlane(tid >> 6), lane = tid & 63, wr = wid >> 2, wc = wid & 3, fr = lane & 15, fq = lane >> 4;
    const int K = g.K, nt = K / BK;
    int ts_lo = 0, ts_hi = 0, nts = 0; const unsigned long long rt_entry = STAMP ? (unsigned long long)wall_clock64() : 0ull;
#define PG8_STAMP() do { if (STAMP && wid == 0 && nts < 64) { const unsigned long long _c = (unsigned long long)clock64(); \
        ts_lo = (lane == nts) ? (int)(unsigned)_c : ts_lo; ts_hi = (lane == nts) ? (int)(unsigned)(_c >> 32) : ts_hi; ++nts; } } while (0)
    PG8_STAMP();
    unsigned voffB[2]; int stR[2]; unsigned stC[2];
#pragma unroll
    for (int i = 0; i < 2; ++i) { int R, C; stage_rc(tid * 16 + i * 8192, R, C); const int Rb = Epi::PERM ? ((R & ~31) + perm32(R & 31)) : R;
        stR[i] = R; stC[i] = (unsigned)C * 2u; voffB[i] = (unsigned)(Rb * K + C) * 2u; }
    unsigned vAc0[2], vAc1[2], vAn0[2], vAn1[2];
#define PG8_AROWS(u, d0, d1) do { _Pragma("unroll") for (int _i = 0; _i < 2; ++_i) { d0[_i] = S.arow(u, stR[_i]) * (unsigned)(K * 2) + stC[_i]; d1[_i] = S.arow(u, HALF + stR[_i]) * (unsigned)(K * 2) + stC[_i]; } } while (0)
    const size_t kstep = (size_t)(BK * 2);
    const size_t hstep = (size_t)HALF * K * 2;
    const size_t tstep = 2 * hstep;
    const unsigned ldsw = (unsigned)wid * 1024u;
    const int aoff = lds_byte(wr * 64 + fr, fq * 8), boff = lds_byte(wc * 32 + fr, fq * 8);
#define PG8_SA(b, h) (((b) * 2 + (h)) * HTB)
#define PG8_SB(b, h) ((4 + (b) * 2 + (h)) * HTB)
#define PG8_STAGE(bufoff, gbase, voff) do { _Pragma("unroll") for (int _i = 0; _i < 2; ++_i) \
        __builtin_amdgcn_global_load_lds((const unsigned*)((const char*)(gbase) + (voff)[_i]), (PG8_LAS unsigned*)(lds + (bufoff) + ldsw + _i * 8192), 16, 0, 0); } while (0)
#define PG8_LDA(dst, b, h) do { _Pragma("unroll") for (int m = 0; m < 4; ++m) _Pragma("unroll") for (int k = 0; k < 2; ++k) dst[m][k] = *(const PG8_LAS bf16x8*)(lds + PG8_SA(b, h) + aoff + m * 2048 + k * 1024); } while (0)
#define PG8_LDB(dst, b, h) do { _Pragma("unroll") for (int n = 0; n < 2; ++n) _Pragma("unroll") for (int k = 0; k < 2; ++k) dst[n][k] = *(const PG8_LAS bf16x8*)(lds + PG8_SB(b, h) + boff + n * 2048 + k * 1024); } while (0)
#define PG8_MMA(ai, bj, At, Bt) do { __builtin_amdgcn_s_setprio(1); _Pragma("unroll") for (int m = 0; m < 4; ++m) _Pragma("unroll") for (int n = 0; n < 2; ++n) _Pragma("unroll") for (int k = 0; k < 2; ++k) \
        acc[ai][bj][m][n] = __builtin_amdgcn_mfma_f32_16x16x32_bf16(Bt[n][k], At[m][k], acc[ai][bj][m][n], 0, 0, 0); __builtin_amdgcn_s_setprio(0); } while (0)
#define PG8_WAIT_V(n) asm volatile("s_waitcnt vmcnt(" #n ")" ::: "memory")
#define PG8_WAIT_L(n) asm volatile("s_waitcnt lgkmcnt(" #n ")" ::: "memory")
#define PG8_BAR __builtin_amdgcn_s_barrier()
#define PG8_SCHED __builtin_amdgcn_sched_barrier(0)
    Unit cur, nxt; int ui = 0;
    if (!S.next(0, cur)) return;
    f32x4 acc[2][2][4][2];
#pragma unroll
    for (int a = 0; a < 2; ++a)
#pragma unroll
        for (int b = 0; b < 2; ++b)
#pragma unroll
            for (int m = 0; m < 4; ++m)
#pragma unroll
                for (int n = 0; n < 2; ++n) acc[a][b][m][n] = (f32x4){0.f, 0.f, 0.f, 0.f};
    bf16x8 At[4][2], B0[2][2], B1[2][2];
    const char* const cA = (const char*)g.A; const char* cB = S.bbase(cur);
    PG8_AROWS(cur, vAc0, vAc1);
    S.a_ready(cur);
    PG8_STAGE(PG8_SB(0, 0), cB, voffB); PG8_STAGE(PG8_SA(0, 0), cA, vAc0); PG8_STAGE(PG8_SB(0, 1), cB + hstep, voffB); PG8_STAGE(PG8_SA(0, 1), cA, vAc1);
    if (wr == 1) PG8_BAR;
    PG8_WAIT_V(4); PG8_BAR;
    PG8_STAGE(PG8_SB(1, 0), cB + kstep, voffB); PG8_STAGE(PG8_SA(1, 0), cA + kstep, vAc0); PG8_STAGE(PG8_SB(1, 1), cB + hstep + kstep, voffB);
    PG8_WAIT_V(6); PG8_BAR;
    PG8_STAMP();
    for (;;) {
        const bool has_next = S.next(ui + 1, nxt);
        const char* nB = has_next ? S.bbase(nxt) : cB;
        if (has_next) PG8_AROWS(nxt, vAn0, vAn1); else { _Pragma("unroll") for (int _i = 0; _i < 2; ++_i) { vAn0[_i] = vAc0[_i]; vAn1[_i] = vAc1[_i]; } }
        const bool full = cur.hs < 0;
        for (int t = 0; t < nt; t += 2) {
            const bool last = (t == nt - 2);
            const char* a1 = cA + (size_t)(t + 1) * kstep;
            const char* a2 = last ? cA : cA + (size_t)(t + 2) * kstep; const char* b2 = last ? nB : cB + (size_t)(t + 2) * kstep;
            const char* a3 = a2 + kstep; const char* b3 = b2 + kstep;
            unsigned v20[2], v21[2];
#pragma unroll
            for (int _i = 0; _i < 2; ++_i) { v20[_i] = last ? vAn0[_i] : vAc0[_i]; v21[_i] = last ? vAn1[_i] : vAc1[_i]; }
            if (last && has_next) S.a_ready(nxt);
            PG8_LDB(B0, 0, 0); PG8_SCHED; PG8_LDA(At, 0, 0); PG8_STAGE(PG8_SA(1, 1), a1, vAc1);
            PG8_WAIT_L(8); PG8_BAR; PG8_WAIT_L(0); PG8_MMA(0, 0, At, B0); PG8_BAR; PG8_SCHED;
            PG8_LDB(B1, 0, 1); PG8_STAGE(PG8_SB(0, 0), b2, voffB);
            PG8_BAR; PG8_WAIT_L(0); PG8_MMA(0, 1, At, B1); PG8_BAR;
            if (full) PG8_LDA(At, 0, 1); PG8_STAGE(PG8_SA(0, 0), a2, v20);
            PG8_BAR; PG8_WAIT_L(0); if (full) PG8_MMA(1, 0, At, B0); PG8_BAR; PG8_SCHED;
            PG8_STAGE(PG8_SB(0, 1), b2 + hstep, voffB);
            PG8_WAIT_V(6); PG8_BAR; if (full) PG8_MMA(1, 1, At, B1); PG8_BAR;
            PG8_LDB(B0, 1, 0); PG8_SCHED; PG8_LDA(At, 1, 0); PG8_STAGE(PG8_SA(0, 1), a2, v21);
            PG8_WAIT_L(8); PG8_BAR; PG8_WAIT_L(0); PG8_MMA(0, 0, At, B0); PG8_BAR; PG8_SCHED;
            PG8_LDB(B1, 1, 1); PG8_STAGE(PG8_SB(1, 0), b3, voffB);
            PG8_BAR; PG8_WAIT_L(0); PG8_MMA(0, 1, At, B1); PG8_BAR;
            if (full) PG8_LDA(At, 1, 1); PG8_STAGE(PG8_SA(1, 0), a3, v20);
            PG8_BAR; PG8_WAIT_L(0); if (full) PG8_MMA(1, 0, At, B0); PG8_BAR; PG8_SCHED;
            PG8_STAGE(PG8_SB(1, 1), b3 + hstep, voffB);
            PG8_WAIT_V(6); PG8_BAR; if (full) PG8_MMA(1, 1, At, B1); PG8_BAR;
        }
        PG8_STAMP();
        if constexpr (!Epi::AFTER_DRAIN) { E(acc, cur, wr, wc, fr, fq); S.done(cur); }
        PG8_STAMP();
        if (!has_next) break;
#pragma unroll
        for (int a = 0; a < 2; ++a)
#pragma unroll
            for (int b = 0; b < 2; ++b)
#pragma unroll
                for (int m = 0; m < 4; ++m)
#pragma unroll
                    for (int n = 0; n < 2; ++n) acc[a][b][m][n] = (f32x4){0.f, 0.f, 0.f, 0.f};
        cur = nxt; cB = nB; ++ui;
#pragma unroll
        for (int _i = 0; _i < 2; ++_i) { vAc0[_i] = vAn0[_i]; vAc1[_i] = vAn1[_i]; }
    }
    PG8_WAIT_V(0);
    if (wr == 0) PG8_BAR;
    PG8_BAR;
    if constexpr (Epi::AFTER_DRAIN) { E.fused(acc, cur, wr, wc, fr, fq, lds, wid, lane); S.done(cur); }
    PG8_STAMP();
    if (STAMP && wid == 0) { stamps[lane] = lane < nts ? (((unsigned long long)(unsigned)ts_hi << 32) | (unsigned)ts_lo) : 0ull;
        if (lane == 62) stamps[62] = rt_entry; if (lane == 63) stamps[63] = (unsigned long long)wall_clock64(); }
#undef PG8_STAMP
#undef PG8_SA
#undef PG8_AROWS
#undef PG8_SB
#undef PG8_STAGE
#undef PG8_LDA
#undef PG8_LDB
#undef PG8_MMA
#undef PG8_WAIT_V
#undef PG8_WAIT_L
#undef PG8_BAR
#undef PG8_SCHED
}
}
#define XB_TMO      128
#define XB_XCNT(j)  (256  + 64 * (j))
#define XB_XSUB(j)  (1280 + 64 * (j))
#define XB_XGEN(j)  (2304 + 64 * (j))
#define XB_TOP      3328
#define XB_TOPGEN   3392
#define XCD_BAR_WORDS 3456
#define XB_SPIN_CAP (1u << 24)

__device__ __forceinline__ unsigned xb_ld(unsigned* p)              { return __hip_atomic_load(p, __ATOMIC_RELAXED, __HIP_MEMORY_SCOPE_AGENT); }
__device__ __forceinline__ unsigned xb_add(unsigned* p, unsigned v) { return __hip_atomic_fetch_add(p, v, __ATOMIC_RELAXED, __HIP_MEMORY_SCOPE_AGENT); }
__device__ __forceinline__ unsigned xb_xcc_id() { return (unsigned)__builtin_amdgcn_s_getreg((3 << 11) | 20) & 0xFu; }
#define XB_SPIN(cond, bar) do { unsigned _sp = 0; while (cond) { __builtin_amdgcn_s_sleep(1); \
    if ((++_sp & 255u) == 0u) { if (xb_ld(&(bar)[XB_TMO])) break; if (_sp > XB_SPIN_CAP) { atomicAdd(&(bar)[XB_TMO], 1u); break; } } } } while (0)

struct XcdBarrier {
    unsigned* bar; unsigned x;
    volatile LAS unsigned* st;
};

__device__ __forceinline__ XcdBarrier xcd_barrier_post(unsigned* bar, volatile LAS unsigned* st) {
    XcdBarrier b; b.bar = bar; b.x = xb_xcc_id(); b.st = st;
    if (threadIdx.x == 0) (void)xb_add(&bar[XB_XCNT(b.x)], 1u);
    return b;
}
__device__ __forceinline__ void xcd_barrier_complete(unsigned* bar, unsigned x, unsigned& nloc, unsigned& nx) {
    const unsigned G = gridDim.x * gridDim.y * gridDim.z;
    unsigned sum, cnt, mine, sp = 0u;
    for (;;) {
        sum = 0u; cnt = 0u; mine = 0u;
#pragma unroll
        for (unsigned j = 0; j < 16; ++j) { const unsigned c = xb_ld(&bar[XB_XCNT(j)]); sum += c; cnt += (c > 0u) ? 1u : 0u; mine = (j == x) ? c : mine; }
        if (sum == G) break;
        __builtin_amdgcn_s_sleep(1);
        if ((++sp & 255u) == 0u) { if (xb_ld(&bar[XB_TMO])) break; if (sp > XB_SPIN_CAP) { atomicAdd(&bar[XB_TMO], 1u); break; } }
    }
    nloc = mine > 0u ? mine : 1u; nx = cnt > 0u ? cnt : 1u;
}

__device__ __forceinline__ void xcd_barrier(const XcdBarrier& b) {
    asm volatile("s_waitcnt vmcnt(0)" ::: "memory");
    __syncthreads();
    if (threadIdx.x == 0) {
        unsigned* bar = b.bar;
        __builtin_amdgcn_s_waitcnt(0);
        unsigned nloc = b.st[0], nx = b.st[1];
        if (nloc == 0u) { xcd_barrier_complete(bar, b.x, nloc, nx); b.st[0] = nloc; b.st[1] = nx; }
        const unsigned old = xb_add(&bar[XB_XSUB(b.x)], 1u);
        const unsigned gen = old / nloc;
        if (old + 1u == (gen + 1u) * nloc) {
            __builtin_amdgcn_fence(__ATOMIC_RELEASE, "agent");
            asm volatile("s_waitcnt vmcnt(0)" ::: "memory");
            const unsigned og = xb_add(&bar[XB_TOP], 1u);
            const unsigned tg = og / nx;
            if (og + 1u == (tg + 1u) * nx) xb_add(&bar[XB_TOPGEN], 1u);
            else XB_SPIN(xb_ld(&bar[XB_TOPGEN]) == tg, bar);
            __builtin_amdgcn_fence(__ATOMIC_ACQUIRE, "agent");
            xb_add(&bar[XB_XGEN(b.x)], 1u);
            asm volatile("s_waitcnt vmcnt(0)" ::: "memory");
        } else {
            XB_SPIN(xb_ld(&bar[XB_XGEN(b.x)]) == gen, bar);
            __builtin_amdgcn_fence(__ATOMIC_ACQUIRE, "agent");
            asm volatile("s_waitcnt vmcnt(0)" ::: "memory");
        }
    }
    __syncthreads();
}

constexpr int SCR_BYTES = 139264;
constexpr int MISC_OFF = SCR_BYTES;
constexpr int LDS_BYTES = 147456;
constexpr int CW_BAR = 4096;
constexpr int NTHR = 512, NWAVES = 8;
constexpr int CW_MOE = 8192;

__device__ __forceinline__ void transpose_item(const float* W, int ldw, int col0, int K, bf16_t* WT, int drow0, int kb, LAS float* scr, int lane) {
    const int k0 = 64 * kb;
#pragma unroll 8
    for (int i = 0; i < 32; ++i) { const int kk = 2 * i + (lane >> 5); scr[kk * 33 + (lane & 31)] = W[(size_t)(k0 + kk) * ldw + col0 + (lane & 31)]; }
    asm volatile("s_waitcnt lgkmcnt(0)" ::: "memory");
    const int c = lane & 7;
#pragma unroll
    for (int j = 0; j < 4; ++j) { const int n = (lane >> 3) + 8 * j; const LAS float* s = scr + (8 * c) * 33 + n;
        u32x4 o; o.x = pk2(s[0 * 33], s[1 * 33]); o.y = pk2(s[2 * 33], s[3 * 33]); o.z = pk2(s[4 * 33], s[5 * 33]); o.w = pk2(s[6 * 33], s[7 * 33]);
        *(u32x4*)(WT + (size_t)(drow0 + n) * K + k0 + 8 * c) = o; }
    asm volatile("s_waitcnt lgkmcnt(0)" ::: "memory");
}
__device__ __forceinline__ void up_item(const float* wg, const float* wu, bf16_t* WT, int it, LAS float* scr, int lane) {
    const int nb = it >> 4, kb = it & 15, r0 = 32 * nb, pn = r0 >> 8, p = r0 & 255;
    transpose_item(p < 128 ? wg : wu, DFF, 128 * pn + (p & 127), DM, WT, r0, kb, scr, lane);
}
__device__ __forceinline__ void dn_item(const float* wd, bf16_t* WT, int it, LAS float* scr, int lane) {
    const int nb = it / 44, kb = it % 44;
    transpose_item(wd, DM, 32 * nb, DFF, WT, 32 * nb, kb, scr, lane);
}
constexpr int IT_IN = 112 * 16, IT_OUT = 32 * 16, IT_UP = 176 * 16, IT_DN = 32 * 44;
constexpr int IT_TOTAL = 2 * IT_IN + 2 * IT_OUT + IT_UP + IT_DN + NEXP * (IT_UP + IT_DN);

__device__ __forceinline__ void phase_prologue(const Args& a, LAS unsigned char* lds, int tid, int lane, int wave, int bid, int G) {
    unsigned char* ws = a.ws;
    {
        LAS float* scr = (LAS float*)(lds + wave * 8704);
        const int gw = bid * NWAVES + wave, NGW = G * NWAVES;
        for (int it0 = gw; it0 < IT_TOTAL; it0 += NGW) {
            int it = it0;
            if (it < 2 * IT_IN) { const int l = it / IT_IN; it -= l * IT_IN; const int nb = it >> 4, kb = it & 15, r0 = 32 * nb;
                transpose_item(a.in[8] + (size_t)l * DM * DIN, DIN, r0 < 2048 ? r0 : r0 + 16, DM, (bf16_t*)(ws + WS_WTIN) + (size_t)l * NPW * DM, r0, kb, scr, lane); continue; }
            it -= 2 * IT_IN;
            if (it < 2 * IT_OUT) { const int l = it / IT_OUT; it -= l * IT_OUT; const int nb = it >> 4, kb = it & 15;
                transpose_item(a.in[16] + (size_t)l * DM * DM, DM, 32 * nb, DM, (bf16_t*)(ws + WS_WTOUT) + (size_t)l * DM * DM, 32 * nb, kb, scr, lane); continue; }
            it -= 2 * IT_OUT;
            if (it < IT_UP) { up_item(a.in[17], a.in[18], (bf16_t*)(ws + WS_WTUP), it, scr, lane); continue; }
            it -= IT_UP;
            if (it < IT_DN) { dn_item(a.in[19], (bf16_t*)(ws + WS_WTDN), it, scr, lane); continue; }
            it -= IT_DN;
            if (it < NEXP * IT_UP) { const int e = it / IT_UP; it -= e * IT_UP;
                up_item(a.in[21] + (size_t)e * DM * DFF, a.in[22] + (size_t)e * DM * DFF, (bf16_t*)(ws + WS_WTMUP) + (size_t)e * NUP * DM, it, scr, lane); continue; }
            it -= NEXP * IT_UP;
            { const int e = it / IT_DN; it -= e * IT_DN; dn_item(a.in[23] + (size_t)e * DFF * DM, (bf16_t*)(ws + WS_WTMDN) + (size_t)e * DM * DFF, it, scr, lane); }
        }
    }
    __syncthreads();
    {
        const int gt = bid * NTHR + tid;
        if (gt < 1024) { const int pos = gt >> 4, i = gt & 15;
            double inv = 1.0; for (int q = 0; q < i; ++q) inv *= 0.56234132519034908;
            const float angf = (float)pos * (float)inv; const double ang = (double)angf;
            const double kq = rint(ang * 0.63661977236758134); const double r = ang - kq * 1.5707963267948966 - kq * 6.123233995736766e-17; const double r2 = r * r;
            double sn = r * (1.0 + r2 * (-1.0 / 6 + r2 * (1.0 / 120 + r2 * (-1.0 / 5040 + r2 * (1.0 / 362880 + r2 * (-1.0 / 39916800 + r2 * (1.0 / 6227020800.0)))))));
            double cs = 1.0 + r2 * (-0.5 + r2 * (1.0 / 24 + r2 * (-1.0 / 720 + r2 * (1.0 / 40320 + r2 * (-1.0 / 3628800 + r2 * (1.0 / 479001600.0 + r2 * (-1.0 / 87178291200.0)))))));
            const int kk = ((int)kq) & 3; double c2, s2;
            if (kk == 0) { c2 = cs; s2 = sn; } else if (kk == 1) { c2 = -sn; s2 = cs; } else if (kk == 2) { c2 = -cs; s2 = -sn; } else { c2 = sn; s2 = -cs; }
            float* R = (float*)(ws + WS_ROPE); R[gt * 2] = (float)c2; R[gt * 2 + 1] = (float)s2; }
    }
    {
        LAS float* sc = (LAS float*)(lds + 73728);
        LAS float* red = (LAS float*)(lds + 73728 + 36864);
        for (int i = tid; i < 9 * 1024; i += NTHR) { const float v = i < 8192 ? a.in[1][i] : a.in[3][i - 8192]; sc[i] = v / (1.0f + __expf(-v)); }
        __syncthreads();
        for (int item = bid; item < 192; item += G) {
            const int l = item / 96, n0 = (item % 96) * 64;
            const float* wm = a.in[6] + (size_t)l * DM * 6144 + n0 + lane;
            float acc[9];
#pragma unroll
            for (int b = 0; b < 9; ++b) acc[b] = 0.f;
#pragma unroll 4
            for (int kk = 0; kk < 128; ++kk) { const int k = wave * 128 + kk; const float w = wm[(size_t)k * 6144];
#pragma unroll
                for (int b = 0; b < 9; ++b) acc[b] += sc[b * 1024 + k] * w; }
#pragma unroll
            for (int b = 0; b < 9; ++b) red[(wave * 9 + b) * 64 + lane] = acc[b];
            __syncthreads();
            for (int o = tid; o < 576; o += NTHR) { const int b = o >> 6, ln = o & 63; float s = a.in[7][(size_t)l * 6144 + n0 + ln];
#pragma unroll
                for (int w = 0; w < 8; ++w) s += red[(w * 9 + b) * 64 + ln];
                ((float*)(ws + WS_MOD))[((size_t)l * 9 + b) * 6144 + n0 + ln] = s; }
            __syncthreads();
        }
    }
}

template <int MODE>
__device__ __forceinline__ void phase_norm(const Args& a, int l, LAS unsigned char* lds, int tid, int lane, int wave, int bid, int G) {
    unsigned char* ws = a.ws;
    LAS float* WT = (LAS float*)lds;
    if (MODE == 0) { const float* w = a.in[8] + (size_t)l * DM * DIN + 2048; for (int i = tid; i < 16384; i += NTHR) { const int k = i >> 4, j = i & 15; WT[j * 1024 + k] = w[(size_t)k * DIN + j]; } __syncthreads(); }
    if (MODE == 2) { const float* w = a.in[20]; for (int i = tid; i < 8192; i += NTHR) { const int k = i >> 3, j = i & 7; WT[j * 1024 + k] = w[(size_t)k * 8 + j]; } __syncthreads(); }
    const float* gam = (MODE == 0 ? a.in[4] : a.in[5]) + (size_t)l * DM;
    const float* mod = (const float*)(ws + WS_MOD) + (size_t)l * 9 * 6144;
    const int shoff = MODE == 0 ? 0 : 3072, soff = MODE == 0 ? 1024 : 4096;
    const int nrows = (MODE == 2) ? NLAT : MALL;
    bf16_t* H = (bf16_t*)(ws + WS_H);
    int nrec = 0;
    for (int r = bid * NWAVES + wave; r < nrows; r += G * NWAVES) {
        const bool lat = r < NLAT; const int bi = lat ? (r >> 11) : 8;
        const float* src = (MODE == 0 && l == 0) ? (lat ? a.in[0] + (size_t)r * DM : a.in[2] + (size_t)(r - NLAT) * DM)
                                    : (lat ? a.out + (size_t)r * DM : (const float*)(ws + WS_XC) + (size_t)(r - NLAT) * DM);
        f32x4 v[4]; float ss = 0.f;
#pragma unroll
        for (int j = 0; j < 4; ++j) { v[j] = *(const f32x4*)(src + 4 * lane + 256 * j); ss += (v[j].x * v[j].x + v[j].y * v[j].y) + (v[j].z * v[j].z + v[j].w * v[j].w); }
        const float rstd = rsqrtf(wave_sum(ss) * (1.0f / DM) + EPS);
        const float* mrow = mod + (size_t)bi * 6144;
#pragma unroll
        for (int j = 0; j < 4; ++j) { const int k = 4 * lane + 256 * j;
            const f32x4 g = *(const f32x4*)(gam + k), s = *(const f32x4*)(mrow + soff + k), sh = *(const f32x4*)(mrow + shoff + k);
            v[j] = v[j] * rstd * g * (1.0f + s) + sh;
            u32x2 w; w.x = pk2(v[j].x, v[j].y); w.y = pk2(v[j].z, v[j].w);
            *(u32x2*)(H + (size_t)r * DM + k) = w; }
        if (MODE == 0) {
            float p[16];
#pragma unroll
            for (int jg = 0; jg < 16; ++jg) p[jg] = 0.f;
#pragma unroll
            for (int jg = 0; jg < 16; ++jg) {
#pragma unroll
                for (int j = 0; j < 4; ++j) { const f32x4 w = *(const LAS f32x4*)(WT + jg * 1024 + 4 * lane + 256 * j); p[jg] += (v[j].x * w.x + v[j].y * w.y) + (v[j].z * w.z + v[j].w * w.w); }
                if ((jg & 3) == 3) asm volatile("" ::: "memory"); }
            const float tot = reduce16_lanes(p, lane);
            const int gid = ((lane >> 5) & 1) * 8 + ((lane >> 4) & 1) * 4 + ((lane >> 3) & 1) * 2 + ((lane >> 2) & 1);
            if ((lane & 3) == 0) ((float*)(ws + WS_GATES))[(size_t)r * 16 + gid] = tot + a.in[12][l * 16 + gid];
        }
        if (MODE == 2) {
            float p[8];
#pragma unroll
            for (int e = 0; e < 8; ++e) p[e] = 0.f;
#pragma unroll
            for (int e = 0; e < 8; ++e) {
#pragma unroll
                for (int j = 0; j < 4; ++j) { const f32x4 w = *(const LAS f32x4*)(WT + e * 1024 + 4 * lane + 256 * j); p[e] += (v[j].x * w.x + v[j].y * w.y) + (v[j].z * w.z + v[j].w * w.w); }
                if ((e & 3) == 3) asm volatile("" ::: "memory"); }
            const float tot = reduce8_lanes(p, lane);
            int i1 = 0, i2 = 0; float v1 = -3.0e38f, v2 = -3.0e38f;
#pragma unroll
            for (int e = 0; e < 8; ++e) { const float s = lane_bcast(tot, 32 * (e >> 2) + 16 * ((e >> 1) & 1) + 8 * (e & 1));
                if (s > v1) { v2 = v1; i2 = i1; v1 = s; i1 = e; } else if (s > v2) { v2 = s; i2 = e; } }
            const float w2 = 1.0f / (1.0f + __expf(v1 - v2)), w1 = 1.0f - w2;
            if (lane == 0) { LAS int* rec = (LAS int*)(lds + 32768) + nrec * 32 + wave * 4; rec[0] = i1; rec[1] = i2; rec[2] = __float_as_int(w1); rec[3] = __float_as_int(w2); }
            ++nrec;
        }
    }
    if (MODE == 2) {
        __syncthreads();
        if (tid < 8) {
            const int e = tid; const LAS int* rec = (const LAS int*)(lds + 32768); int cnt = 0;
            const int nk = (nrows - bid * NWAVES + G * NWAVES - 1) / (G * NWAVES);
            for (int k = 0; k < nk; ++k) for (int w = 0; w < NWAVES; ++w) { const int r = bid * NWAVES + w + k * G * NWAVES; if (r < nrows) { const LAS int* q = rec + k * 32 + w * 4; cnt += (q[0] == e) + (q[1] == e); } }
            int pos = (int)atomicAdd((unsigned*)(ws + WS_CTL) + CW_MOE + 64 * e, (unsigned)cnt);
            int* LIST = (int*)(ws + WS_LIST) + e * NLAT; int* TOK = (int*)(ws + WS_COMB);
            for (int k = 0; k < nk; ++k) for (int w = 0; w < NWAVES; ++w) { const int r = bid * NWAVES + w + k * G * NWAVES; if (r < nrows) { const LAS int* q = rec + k * 32 + w * 4;
                if (q[0] == e) { LIST[pos] = r; TOK[r * 8 + 0] = e; TOK[r * 8 + 2] = pos; TOK[r * 8 + 4] = q[2]; ++pos; }
                if (q[1] == e) { LIST[pos] = r; TOK[r * 8 + 1] = e; TOK[r * 8 + 3] = pos; TOK[r * 8 + 5] = q[3]; ++pos; } } }
        }
    }
}

__device__ __forceinline__ void phase_post(const Args& a, int l, int lane, int wave, int bid, int G) {
    unsigned char* ws = a.ws;
    bf16_t* P = (bf16_t*)(ws + WS_BIG); bf16_t* MQK = (bf16_t*)(ws + WS_MQK);
    const float* ROPE = (const float*)(ws + WS_ROPE);
    const float* cw = a.in[10] + (size_t)l * 3 * 512; const float* cb = a.in[11] + (size_t)l * 512;
    const float qg = a.in[13][l * 64 + lane], kg = a.in[14][l * 64 + lane];
    for (int r = bid * NWAVES + wave; r < MALL; r += G * NWAVES) {
        const bool lat = r < NLAT; bf16_t* row = P + (size_t)r * NPW;
        int t, tlen; if (lat) { t = r & (SEQ - 1); tlen = SEQ; } else { t = (r - NLAT) & (CTXL - 1); tlen = CTXL; }
        if (lat) { const int gr = t >> 6, gc = t & 63;
#pragma unroll
            for (int blk = 0; blk < 2; ++blk)
#pragma unroll
                for (int ii = 0; ii < 2; ++ii) { const int pid = lane + 64 * ii, head = pid >> 5, half = (pid >> 4) & 1, i = pid & 15, c1 = (blk ? PC_RK : PC_RQ) + head * 64 + half * 32 + i;
                    const int pos = half ? gc : gr; const float cs = ROPE[(pos * 16 + i) * 2], sn = ROPE[(pos * 16 + i) * 2 + 1];
                    const float x1 = bf2f(row[c1]), x2 = bf2f(row[c1 + 16]); const float sc = blk ? 0.125f : 1.0f;
                    row[c1] = (bf16_t)f2bf((x1 * cs - x2 * sn) * sc); row[c1 + 16] = (bf16_t)f2bf((x1 * sn + x2 * cs) * sc); }
        } else {
#pragma unroll
            for (int ii = 0; ii < 4; ++ii) { const int c = PC_RK + lane + 64 * ii; row[c] = (bf16_t)f2bf(bf2f(row[c]) * 0.125f); }
        }
#pragma unroll
        for (int ii = 0; ii < 8; ++ii) { const int c = lane + 64 * ii;
            const float x0 = bf2f(row[PC_MQ + c]);
            const float xm = t > 0 ? bf2f(row[PC_MQ + c - NPW]) : 0.f, xp = t < tlen - 1 ? bf2f(row[PC_MQ + c + NPW]) : 0.f;
            float y = cb[c] + cw[c] * xm + cw[512 + c] * x0 + cw[1024 + c] * xp;
            y = y / (1.0f + __expf(-y)); if (c >= 256) y *= 0.125f;
            MQK[(size_t)r * 512 + c] = (bf16_t)f2bf(y); }
#pragma unroll
        for (int hh = 0; hh < 16; ++hh) { const int c = PC_NQ + hh * 64 + lane; const float v = bf2f(row[c]);
            const float rs = rsqrtf(wave_sum(v * v) * (1.0f / 64.0f) + EPS);
            row[c] = (bf16_t)f2bf(v * rs * (hh < 8 ? qg : kg)); }
    }
}


typedef short bf16x8 __attribute__((ext_vector_type(8)));
typedef short s16x4 __attribute__((ext_vector_type(4)));
constexpr int IST = 160;
__device__ __forceinline__ f32x4 mfma16(bf16x8 a, bf16x8 b, f32x4 c) { return __builtin_amdgcn_mfma_f32_16x16x32_bf16(a, b, c, 0, 0, 0); }
__device__ __forceinline__ bf16x8 frag_row(LAS const unsigned char* img, int row0, int k0, int lane) {
    return *(const LAS bf16x8*)(img + (row0 + (lane & 15)) * IST + (k0 + 8 * (lane >> 4)) * 2);
}
template <bool PERMK>
__device__ __forceinline__ bf16x8 frag_tr(LAS const unsigned char* img, int r0, int c0, int lane) {
    const int g = lane >> 4, i = lane & 15, q = i >> 2, p = i & 3;
    const unsigned addr = (unsigned)(size_t)(img + (r0 + (PERMK ? 4 : 8) * g + q) * IST + (c0 + 4 * p) * 2);
    s16x4 lo, hi;
    if (PERMK) asm volatile("ds_read_b64_tr_b16 %0, %2\n\tds_read_b64_tr_b16 %1, %2 offset:2560\n\ts_waitcnt lgkmcnt(0)" : "=&v"(lo), "=&v"(hi) : "v"(addr) : "memory");
    else       asm volatile("ds_read_b64_tr_b16 %0, %2\n\tds_read_b64_tr_b16 %1, %2 offset:640\n\ts_waitcnt lgkmcnt(0)" : "=&v"(lo), "=&v"(hi) : "v"(addr) : "memory");
    bf16x8 r; r[0] = lo[0]; r[1] = lo[1]; r[2] = lo[2]; r[3] = lo[3]; r[4] = hi[0]; r[5] = hi[1]; r[6] = hi[2]; r[7] = hi[3];
    return r;
}
template <bool PERMK>
__device__ __forceinline__ void frag_tr_x4(LAS const unsigned char* img, int r0, int c0, int lane, bf16x8 (&out)[4]) {
    const int g = lane >> 4, i = lane & 15, q = i >> 2, p = i & 3;
    const unsigned addr = (unsigned)(size_t)(img + (r0 + (PERMK ? 4 : 8) * g + q) * IST + (c0 + 4 * p) * 2);
    s16x4 l0, h0, l1, h1, l2, h2, l3, h3;
    if (PERMK) asm volatile("ds_read_b64_tr_b16 %0, %8\n\tds_read_b64_tr_b16 %1, %8 offset:2560\n\tds_read_b64_tr_b16 %2, %8 offset:32\n\tds_read_b64_tr_b16 %3, %8 offset:2592\n\t"
                            "ds_read_b64_tr_b16 %4, %8 offset:64\n\tds_read_b64_tr_b16 %5, %8 offset:2624\n\tds_read_b64_tr_b16 %6, %8 offset:96\n\tds_read_b64_tr_b16 %7, %8 offset:2656\n\ts_waitcnt lgkmcnt(0)"
                            : "=&v"(l0), "=&v"(h0), "=&v"(l1), "=&v"(h1), "=&v"(l2), "=&v"(h2), "=&v"(l3), "=&v"(h3) : "v"(addr) : "memory");
    else       asm volatile("ds_read_b64_tr_b16 %0, %8\n\tds_read_b64_tr_b16 %1, %8 offset:640\n\tds_read_b64_tr_b16 %2, %8 offset:32\n\tds_read_b64_tr_b16 %3, %8 offset:672\n\t"
                            "ds_read_b64_tr_b16 %4, %8 offset:64\n\tds_read_b64_tr_b16 %5, %8 offset:704\n\tds_read_b64_tr_b16 %6, %8 offset:96\n\tds_read_b64_tr_b16 %7, %8 offset:736\n\ts_waitcnt lgkmcnt(0)"
                            : "=&v"(l0), "=&v"(h0), "=&v"(l1), "=&v"(h1), "=&v"(l2), "=&v"(h2), "=&v"(l3), "=&v"(h3) : "v"(addr) : "memory");
#define FT_PACK(o, lo, hi) o[0] = lo[0]; o[1] = lo[1]; o[2] = lo[2]; o[3] = lo[3]; o[4] = hi[0]; o[5] = hi[1]; o[6] = hi[2]; o[7] = hi[3];
    FT_PACK(out[0], l0, h0) FT_PACK(out[1], l1, h1) FT_PACK(out[2], l2, h2) FT_PACK(out[3], l3, h3)
#undef FT_PACK
}
__device__ __forceinline__ bf16x8 pack8(f32x4 a, f32x4 b) {
    union { u32x4 u; bf16x8 v; } x; x.u.x = pk2(a[0], a[1]); x.u.y = pk2(a[2], a[3]); x.u.z = pk2(b[0], b[1]); x.u.w = pk2(b[2], b[3]); return x.v;
}
__device__ __forceinline__ int chunk_row0(int b, int dir, int sc) {
    if (dir == 0) return sc < 2 ? NLAT + b * CTXL + 128 * sc : b * SEQ + 128 * (sc - 2);
    return sc < 2 ? NLAT + b * CTXL + 128 * (1 - sc) : b * SEQ + 128 * (17 - sc);
}
constexpr size_t U_BYTES = 80 * 64 * 2;

__device__ __forceinline__ void phase_chunk_sums(const Args& a, int l, LAS unsigned char* lds, int tid, int lane, int wave, int bid, int G) {
    unsigned char* ws = a.ws;
    const bf16_t* P = (const bf16_t*)(ws + WS_BIG); const bf16_t* MQK = (const bf16_t*)(ws + WS_MQK);
    const float* GT = (const float*)(ws + WS_GATES);
    LAS unsigned char* Kimg = lds;
    LAS unsigned char* Vimg = lds + 128 * IST;
    LAS float* wk = (LAS float*)(lds + 256 * IST);
    LAS float* red = wk + 128;
    const int nitems = 2 * NB * 4 * 2 * 18;
    for (int it = bid; it < nitems; it += G) {
        const int sc = it % 18; int r_ = it / 18; const int dir = r_ & 1; r_ >>= 1; const int h = r_ & 3; r_ >>= 2; const int b = r_ & 7; const int kind = r_ >> 3;
        const int row0 = chunk_row0(b, dir, sc);
        __syncthreads();
        if (kind == 0) { if (tid < 128) { const float lg = logsigmoidf_(a.in[9][(l * 2 + dir) * 4 + h]); wk[tid] = __expf(lg * (float)(dir == 0 ? 127 - tid : tid)); } }
        else if (wave == 0) {
            const float g0i = GT[(size_t)(row0 + lane) * 16 + 4 * dir + h], g1i = GT[(size_t)(row0 + 64 + lane) * 16 + 4 * dir + h];
            const float f0 = logsigmoidf_(GT[(size_t)(row0 + lane) * 16 + 8 + 4 * dir + h]), f1 = logsigmoidf_(GT[(size_t)(row0 + 64 + lane) * 16 + 8 + 4 * dir + h]);
            float s0 = f0, s1 = f1;
#pragma unroll
            for (int o = 1; o < 64; o <<= 1) { const int sl = lane >= o ? lane - o : lane; const float u0 = lane_get(s0, sl), u1 = lane_get(s1, sl); if (lane >= o) { s0 += u0; s1 += u1; } }
            const float t0 = lane_bcast(s0, 63), t1 = lane_bcast(s1, 63), tot = t0 + t1;
            float b0, b1;
            if (dir == 0) { b0 = s0; b1 = t0 + s1; } else { b0 = tot - s0 + f0; b1 = t1 - s1 + f1; }
            const float a0 = g0i - b0, a1 = g1i - b1; const float amax = wave_max(fmaxf(a0, a1));
            wk[lane] = __expf(a0 - amax); wk[lane + 64] = __expf(a1 - amax);
            if (lane == 0) { float* usc = (float*)(ws + WS_USC) + ((size_t)((b * 4 + h) * 2 + dir) * 18 + sc) * 2; usc[0] = tot; usc[1] = amax; }
        }
        __syncthreads();
        {
            const int r = tid >> 2, c8 = (tid & 3) * 16;
            const bf16_t* ksrc = kind == 0 ? P + (size_t)(row0 + r) * NPW + PC_RK + h * 64 + c8 : MQK + (size_t)(row0 + r) * 512 + 256 + h * 64 + c8;
            const bf16_t* vsrc = P + (size_t)(row0 + r) * NPW + (kind == 0 ? PC_RV : PC_MV) + h * 64 + c8;
            const u32x4 k0 = *(const u32x4*)ksrc, k1 = *(const u32x4*)(ksrc + 8), v0 = *(const u32x4*)vsrc, v1 = *(const u32x4*)(vsrc + 8);
            *(LAS u32x4*)(Kimg + r * IST + c8 * 2) = k0; *(LAS u32x4*)(Kimg + r * IST + c8 * 2 + 16) = k1;
            const float w = wk[r];
            u32x4 o0, o1;
            o0.x = pk2(bflo(v0.x) * w, bfhi(v0.x) * w); o0.y = pk2(bflo(v0.y) * w, bfhi(v0.y) * w); o0.z = pk2(bflo(v0.z) * w, bfhi(v0.z) * w); o0.w = pk2(bflo(v0.w) * w, bfhi(v0.w) * w);
            o1.x = pk2(bflo(v1.x) * w, bfhi(v1.x) * w); o1.y = pk2(bflo(v1.y) * w, bfhi(v1.y) * w); o1.z = pk2(bflo(v1.z) * w, bfhi(v1.z) * w); o1.w = pk2(bflo(v1.w) * w, bfhi(v1.w) * w);
            *(LAS u32x4*)(Vimg + r * IST + c8 * 2) = o0; *(LAS u32x4*)(Vimg + r * IST + c8 * 2 + 16) = o1;
            if ((tid & 3) == 0) { unsigned zz; asm volatile("v_mov_b32 %0, 0" : "=v"(zz)); u32x4 e0; e0.x = f2bf(w); e0.y = zz; e0.z = zz; e0.w = zz; u32x4 z; z.x = zz; z.y = zz; z.z = zz; z.w = zz;
                *(LAS u32x4*)(Vimg + r * IST + 128) = e0; *(LAS u32x4*)(Vimg + r * IST + 144) = z; }
        }
        __syncthreads();
        {
            const int dt = wave & 3, et0 = 2 * (wave >> 2);
            f32x4 u0 = {0.f, 0.f, 0.f, 0.f}, u1 = u0, u2 = u0;
#pragma unroll
            for (int ks = 0; ks < 4; ++ks) {
                const bf16x8 af = frag_tr<false>(Kimg, 32 * ks, 16 * dt, lane);
                const bf16x8 b0 = frag_tr<false>(Vimg, 32 * ks, 16 * et0, lane), b1 = frag_tr<false>(Vimg, 32 * ks, 16 * et0 + 16, lane);
                u0 = mfma16(af, b0, u0); u1 = mfma16(af, b1, u1);
                if (wave < 4) { const bf16x8 b2 = frag_tr<false>(Vimg, 32 * ks, 64, lane); u2 = mfma16(af, b2, u2); }
            }
            bf16_t* U = (bf16_t*)(ws + WS_U + ((size_t)(((kind * NB + b) * 4 + h) * 2 + dir) * 18 + sc) * U_BYTES);
            const int g = lane >> 4, e = lane & 15, d0 = 16 * dt + 4 * g;
            { u32x2 w; w.x = pk2(u0[0], u0[1]); w.y = pk2(u0[2], u0[3]); *(u32x2*)(U + (size_t)(16 * et0 + e) * 64 + d0) = w; }
            { u32x2 w; w.x = pk2(u1[0], u1[1]); w.y = pk2(u1[2], u1[3]); *(u32x2*)(U + (size_t)(16 * et0 + 16 + e) * 64 + d0) = w; }
            if (wave < 4) { u32x2 w; w.x = pk2(u2[0], u2[1]); w.y = pk2(u2[2], u2[3]); *(u32x2*)(U + (size_t)(64 + e) * 64 + d0) = w; }
        }
    }
}

__device__ __forceinline__ void phase_chunk_states(const Args& a, int l, int tid, int bid, int G) {
    unsigned char* ws = a.ws;
    for (int it = bid; it < 2 * NB * 4 * 2; it += G) {
        const int dir = it & 1, h = (it >> 1) & 3, b = (it >> 3) & 7, kind = it >> 6;
        const size_t seq = (size_t)(((kind * NB + b) * 4 + h) * 2 + dir) * 18;
        const unsigned char* Ub = ws + WS_U + seq * U_BYTES; unsigned char* Sb = ws + WS_S + seq * U_BYTES;
        const float* usc = (const float*)(ws + WS_USC) + (size_t)((b * 4 + h) * 2 + dir) * 18 * 2;
        float* sm = (float*)(ws + WS_SM) + (size_t)((b * 4 + h) * 2 + dir) * 18;
        const float dec_ret = __expf(128.0f * logsigmoidf_(a.in[9][(l * 2 + dir) * 4 + h]));
        const int nrow = kind == 0 ? 512 : 520;
        for (int ci = tid; ci < nrow; ci += NTHR) {
            u32x4 v[18];
#pragma unroll
            for (int s = 0; s < 18; ++s) v[s] = *(const u32x4*)(Ub + (size_t)s * U_BYTES + (size_t)ci * 16);
            float acc[8];
#pragma unroll
            for (int j = 0; j < 8; ++j) acc[j] = 0.f;
            float m = 0.f;
#pragma unroll
            for (int s = 0; s < 18; ++s) {
                u32x4 o; o.x = pk2(acc[0], acc[1]); o.y = pk2(acc[2], acc[3]); o.z = pk2(acc[4], acc[5]); o.w = pk2(acc[6], acc[7]);
                *(u32x4*)(Sb + (size_t)s * U_BYTES + (size_t)ci * 16) = o;
                float dk, ck;
                if (kind == 0) { dk = dec_ret; ck = 1.0f; }
                else { if (ci == 0) sm[s] = m; const float bl = usc[2 * s], am = usc[2 * s + 1]; const float mx = fmaxf(m, am); dk = __expf(m - mx); ck = __expf(am - mx); m = bl + mx; }
                acc[0] = dk * acc[0] + ck * bflo(v[s].x); acc[1] = dk * acc[1] + ck * bfhi(v[s].x); acc[2] = dk * acc[2] + ck * bflo(v[s].y); acc[3] = dk * acc[3] + ck * bfhi(v[s].y);
                acc[4] = dk * acc[4] + ck * bflo(v[s].z); acc[5] = dk * acc[5] + ck * bfhi(v[s].z); acc[6] = dk * acc[6] + ck * bflo(v[s].w); acc[7] = dk * acc[7] + ck * bfhi(v[s].w);
            }
        }
    }
}

template <int KIND>
__device__ __forceinline__ float load_state(const unsigned char* ws, int b, int h, int dir, int sc, LAS unsigned char* Simg, int tid) {
    const unsigned char* Sp = ws + WS_S + ((size_t)((((KIND * NB + b) * 4 + h) * 2 + dir) * 18) + sc) * U_BYTES;
    *(LAS u32x4*)(Simg + (tid >> 3) * IST + (tid & 7) * 16) = *(const u32x4*)(Sp + (size_t)tid * 16);
    if (KIND == 1 && tid < 8) *(LAS u32x4*)(Simg + 64 * IST + tid * 16) = *(const u32x4*)(Sp + (size_t)(512 + tid) * 16);
    return KIND == 1 ? ((const float*)(ws + WS_SM))[(size_t)((b * 4 + h) * 2 + dir) * 18 + sc] : 0.f;
}

template <int KIND>
__device__ __forceinline__ void phase_chunk_out(const Args& a, int l, bool need_ctx, LAS unsigned char* lds, int tid, int lane, int wave, int bid, int G) {
    unsigned char* ws = a.ws;
    const bf16_t* P = (const bf16_t*)(ws + WS_BIG); const bf16_t* MQK = (const bf16_t*)(ws + WS_MQK);
    const float* GT = (const float*)(ws + WS_GATES); bf16_t* MG = (bf16_t*)(ws + WS_H);
    LAS unsigned char* Qimg = lds; LAS unsigned char* Kimg = lds + 20480; LAS unsigned char* Vimg = lds + 40960;
    LAS unsigned char* SFimg = lds + 61440; LAS unsigned char* SBimg = lds + 74240;
    LAS float* AF = (LAS float*)(lds + 87040); LAS float* CF = AF + 128; LAS float* BF = AF + 256; LAS float* AB = AF + 384; LAS float* CB = AF + 512; LAS float* BB = AF + 640;
    const int nch = need_ctx ? 18 : 16, nitems = NB * 4 * nch;
    const int g = lane >> 4, qi = 16 * wave + (lane & 15);
    for (int it = bid; it < nitems; it += G) {
        const int cc = it % nch; const int bh = it / nch; const int h = bh & 3, b = bh >> 2;
        const bool isctx = cc >= 16; const int c = isctx ? cc - 16 : cc;
        const int row0 = isctx ? NLAT + b * CTXL + 128 * c : b * SEQ + 128 * c;
        const int scf = isctx ? c : 2 + c, scb = isctx ? 1 - c : 17 - c;
        __syncthreads();
        {
            const int r = tid >> 2, c8 = (tid & 3) * 16;
            const bf16_t* qsrc = KIND == 0 ? P + (size_t)(row0 + r) * NPW + PC_RQ + h * 64 + c8 : MQK + (size_t)(row0 + r) * 512 + h * 64 + c8;
            const bf16_t* ksrc = KIND == 0 ? P + (size_t)(row0 + r) * NPW + PC_RK + h * 64 + c8 : MQK + (size_t)(row0 + r) * 512 + 256 + h * 64 + c8;
            const bf16_t* vsrc = P + (size_t)(row0 + r) * NPW + (KIND == 0 ? PC_RV : PC_MV) + h * 64 + c8;
            const u32x4 q0 = *(const u32x4*)qsrc, q1 = *(const u32x4*)(qsrc + 8), k0 = *(const u32x4*)ksrc, k1 = *(const u32x4*)(ksrc + 8), v0 = *(const u32x4*)vsrc, v1 = *(const u32x4*)(vsrc + 8);
            *(LAS u32x4*)(Qimg + r * IST + c8 * 2) = q0; *(LAS u32x4*)(Qimg + r * IST + c8 * 2 + 16) = q1;
            *(LAS u32x4*)(Kimg + r * IST + c8 * 2) = k0; *(LAS u32x4*)(Kimg + r * IST + c8 * 2 + 16) = k1;
            *(LAS u32x4*)(Vimg + r * IST + c8 * 2) = v0; *(LAS u32x4*)(Vimg + r * IST + c8 * 2 + 16) = v1;
            if ((tid & 3) == 0) { unsigned zz, one; asm volatile("v_mov_b32 %0, 0\n\tv_mov_b32 %1, 0x3f80" : "=v"(zz), "=v"(one)); u32x4 e0; e0.x = one; e0.y = zz; e0.z = zz; e0.w = zz; u32x4 z; z.x = zz; z.y = zz; z.z = zz; z.w = zz;
                *(LAS u32x4*)(Vimg + r * IST + 128) = e0; *(LAS u32x4*)(Vimg + r * IST + 144) = z; }
        }
        const float mpf = load_state<KIND>(ws, b, h, 0, scf, SFimg, tid);
        const float mpb = load_state<KIND>(ws, b, h, 1, scb, SBimg, tid);
        if (KIND == 1 && wave == 0) {
            const size_t r0_ = (size_t)(row0 + lane) * 16, r1_ = (size_t)(row0 + 64 + lane) * 16;
#pragma unroll
            for (int dir = 0; dir < 2; ++dir) {
                const float i0 = GT[r0_ + 4 * dir + h], i1 = GT[r1_ + 4 * dir + h];
                const float f0 = logsigmoidf_(GT[r0_ + 8 + 4 * dir + h]), f1 = logsigmoidf_(GT[r1_ + 8 + 4 * dir + h]);
                float s0 = f0, s1 = f1;
#pragma unroll
                for (int o = 1; o < 64; o <<= 1) { const int sl = lane >= o ? lane - o : lane; const float u0 = lane_get(s0, sl), u1 = lane_get(s1, sl); if (lane >= o) { s0 += u0; s1 += u1; } }
                const float t0 = lane_bcast(s0, 63), t1 = lane_bcast(s1, 63);
                float b0, b1;
                if (dir == 0) { b0 = s0; b1 = t0 + s1; } else { b0 = t0 + t1 - s0 + f0; b1 = t1 - s1 + f1; }
                const float a0 = i0 - b0, a1 = i1 - b1;
                float x0 = a0, x1 = a1;
                if (dir == 0) {
#pragma unroll
                    for (int o = 1; o < 64; o <<= 1) { const int sl = lane >= o ? lane - o : lane; const float u0 = lane_get(x0, sl), u1 = lane_get(x1, sl); if (lane >= o) { x0 = fmaxf(x0, u0); x1 = fmaxf(x1, u1); } }
                    x1 = fmaxf(x1, lane_bcast(x0, 63));
                } else {
#pragma unroll
                    for (int o = 1; o < 64; o <<= 1) { const int sl = lane + o < 64 ? lane + o : lane; const float u0 = lane_get(x0, sl), u1 = lane_get(x1, sl); if (lane + o < 64) { x0 = fmaxf(x0, u0); x1 = fmaxf(x1, u1); } }
                    x0 = fmaxf(x0, lane_bcast(x1, 0));
                }
                const float mp = dir == 0 ? mpf : mpb;
                LAS float* A_ = dir == 0 ? AF : AB; LAS float* C_ = dir == 0 ? CF : CB; LAS float* B_ = dir == 0 ? BF : BB;
                A_[lane] = a0; A_[lane + 64] = a1; C_[lane] = fmaxf(x0, mp); C_[lane + 64] = fmaxf(x1, mp); B_[lane] = b0; B_[lane + 64] = b1;
            }
        }
        __syncthreads();
        const bf16x8 bq0 = frag_row(Qimg, 16 * wave, 0, lane), bq1 = frag_row(Qimg, 16 * wave, 32, lane);
        f32x4 st[8];
#pragma unroll
        for (int kt = 0; kt < 8; ++kt) { f32x4 z = {0.f, 0.f, 0.f, 0.f}; z = mfma16(frag_row(Kimg, 16 * kt, 0, lane), bq0, z); st[kt] = mfma16(frag_row(Kimg, 16 * kt, 32, lane), bq1, z); }
        const int row = row0 + qi;
        if (KIND == 0) {
            const float lgf = logsigmoidf_(a.in[9][(l * 2 + 0) * 4 + h]), lgb = logsigmoidf_(a.in[9][(l * 2 + 1) * 4 + h]);
            f32x4 acc[4];
#pragma unroll
            for (int et = 0; et < 4; ++et) {
                f32x4 zf = {0.f, 0.f, 0.f, 0.f}, zb = zf;
                zf = mfma16(frag_row(SFimg, 16 * et, 0, lane), bq0, zf); zf = mfma16(frag_row(SFimg, 16 * et, 32, lane), bq1, zf);
                zb = mfma16(frag_row(SBimg, 16 * et, 0, lane), bq0, zb); zb = mfma16(frag_row(SBimg, 16 * et, 32, lane), bq1, zb);
                acc[et] = zf * __expf(lgf * (float)(qi + 1)) + zb * __expf(lgb * (float)(128 - qi));
            }
#pragma unroll
            for (int T = 0; T < 4; ++T) {
                f32x4 p0, p1;
#pragma unroll
                for (int j = 0; j < 4; ++j) {
                    const int k0 = 32 * T + 4 * g + j, k1 = k0 + 16;
                    const float w0 = (k0 <= qi ? __expf(lgf * (float)(qi - k0)) : 0.f) + (k0 >= qi ? __expf(lgb * (float)(k0 - qi)) : 0.f);
                    const float w1 = (k1 <= qi ? __expf(lgf * (float)(qi - k1)) : 0.f) + (k1 >= qi ? __expf(lgb * (float)(k1 - qi)) : 0.f);
                    p0[j] = st[2 * T][j] * w0; p1[j] = st[2 * T + 1][j] * w1;
                }
                const bf16x8 bp = pack8(p0, p1);
{ bf16x8 va[4]; frag_tr_x4<true>(Vimg, 32 * T, 0, lane, va);
#pragma unroll
                for (int et = 0; et < 4; ++et) acc[et] = mfma16(va[et], bp, acc[et]); }
            }
            float ss = 0.f;
#pragma unroll
            for (int et = 0; et < 4; ++et) ss += (acc[et][0] * acc[et][0] + acc[et][1] * acc[et][1]) + (acc[et][2] * acc[et][2] + acc[et][3] * acc[et][3]);
            ss = sum_g4(ss);
            const float rs = rsqrtf(ss * (1.0f / 64.0f) + EPS);
#pragma unroll
            for (int et = 0; et < 4; ++et) { const int e0 = h * 64 + 16 * et + 4 * g;
                const u32x2 gw = *(const u32x2*)(P + (size_t)row * NPW + PC_RG + e0);
                u32x2 o; o.x = pk2(siluf_(bflo(gw.x)) * acc[et][0] * rs, siluf_(bfhi(gw.x)) * acc[et][1] * rs); o.y = pk2(siluf_(bflo(gw.y)) * acc[et][2] * rs, siluf_(bfhi(gw.y)) * acc[et][3] * rs);
                *(u32x2*)(MG + (size_t)row * DM + e0) = o; }
        } else {
            const float cf = CF[qi], cb = CB[qi];
            const float gf = __expf(mpf - cf), gb = __expf(mpb - cb);
            f32x4 af[5], ab[5];
#pragma unroll
            for (int et = 0; et < 5; ++et) {
                f32x4 zf = {0.f, 0.f, 0.f, 0.f}, zb = zf;
                zf = mfma16(frag_row(SFimg, 16 * et, 0, lane), bq0, zf); zf = mfma16(frag_row(SFimg, 16 * et, 32, lane), bq1, zf);
                zb = mfma16(frag_row(SBimg, 16 * et, 0, lane), bq0, zb); zb = mfma16(frag_row(SBimg, 16 * et, 32, lane), bq1, zb);
                af[et] = zf * gf; ab[et] = zb * gb;
            }
#pragma unroll
            for (int T = 0; T < 4; ++T) {
                const f32x4 a0f = *(const LAS f32x4*)(AF + 32 * T + 4 * g), a1f = *(const LAS f32x4*)(AF + 32 * T + 16 + 4 * g);
                const f32x4 a0b = *(const LAS f32x4*)(AB + 32 * T + 4 * g), a1b = *(const LAS f32x4*)(AB + 32 * T + 16 + 4 * g);
                f32x4 pf0, pf1, pb0, pb1;
#pragma unroll
                for (int j = 0; j < 4; ++j) {
                    const int k0 = 32 * T + 4 * g + j, k1 = k0 + 16;
                    pf0[j] = k0 <= qi ? st[2 * T][j] * __expf(a0f[j] - cf) : 0.f; pf1[j] = k1 <= qi ? st[2 * T + 1][j] * __expf(a1f[j] - cf) : 0.f;
                    pb0[j] = k0 >= qi ? st[2 * T][j] * __expf(a0b[j] - cb) : 0.f; pb1[j] = k1 >= qi ? st[2 * T + 1][j] * __expf(a1b[j] - cb) : 0.f;
                }
                const bf16x8 bpf = pack8(pf0, pf1), bpb = pack8(pb0, pb1);
{ bf16x8 va[4]; frag_tr_x4<true>(Vimg, 32 * T, 0, lane, va); const bf16x8 v4 = frag_tr<true>(Vimg, 32 * T, 64, lane);
#pragma unroll
                for (int et = 0; et < 4; ++et) { af[et] = mfma16(va[et], bpf, af[et]); ab[et] = mfma16(va[et], bpb, ab[et]); }
                af[4] = mfma16(v4, bpf, af[4]); ab[4] = mfma16(v4, bpb, ab[4]); }
            }
            const float denf = lane_get(af[4][0], lane & 15), denb = lane_get(ab[4][0], lane & 15);
            const float nf = 1.0f / fmaxf(fabsf(denf), __expf(-(BF[qi] + cf))), nb = 1.0f / fmaxf(fabsf(denb), __expf(-(BB[qi] + cb)));
            f32x4 y[4]; float ss = 0.f;
#pragma unroll
            for (int et = 0; et < 4; ++et) { y[et] = af[et] * nf + ab[et] * nb; ss += (y[et][0] * y[et][0] + y[et][1] * y[et][1]) + (y[et][2] * y[et][2] + y[et][3] * y[et][3]); }
            ss = sum_g4(ss);
            const float rs = rsqrtf(ss * (1.0f / 64.0f) + EPS);
#pragma unroll
            for (int et = 0; et < 4; ++et) { const int e0 = h * 64 + 16 * et + 4 * g;
                const u32x2 gw = *(const u32x2*)(P + (size_t)row * NPW + PC_MO + e0);
                u32x2 o; o.x = pk2(sigmoidf_(bflo(gw.x)) * y[et][0] * rs, sigmoidf_(bfhi(gw.x)) * y[et][1] * rs); o.y = pk2(sigmoidf_(bflo(gw.y)) * y[et][2] * rs, sigmoidf_(bfhi(gw.y)) * y[et][3] * rs);
                *(u32x2*)(MG + (size_t)row * DM + 256 + e0) = o; }
        }
    }
}

struct NaItem { int b, h, r0, ur0, nlb, lat, qrow0; };
__device__ __forceinline__ NaItem na_decode(int it) {
    NaItem t;
    if (it < 512) { t.lat = 1; const int rg = it & 7; t.h = (it >> 3) & 7; t.b = it >> 6; t.r0 = 4 * rg; t.ur0 = min(max(t.r0 - 4, 0), NROWS - 8);
        const int last = min(max(t.r0 - 1, 0), NROWS - 8) + 7; t.nlb = (last - t.ur0 + 4) >> 2; t.qrow0 = t.b * SEQ + t.r0 * 64; }
    else { const int j = it - 512; t.lat = 0; t.h = j & 7; t.b = j >> 3; t.r0 = 0; t.ur0 = 0; t.nlb = 0; t.qrow0 = NLAT + t.b * CTXL; }
    return t;
}
__device__ __forceinline__ int na_krow0(const NaItem& t, int step) { return step == 0 ? NLAT + t.b * CTXL : t.b * SEQ + (t.ur0 + 4 * (step - 1)) * 64; }
struct NaKV { u32x4 k[4], v[4]; };
__device__ __forceinline__ void na_load_kv(NaKV& x, const bf16_t* P, int krow0, int h, int tid) {
    const int rr = tid >> 1, c0 = (tid & 1) * 32; const bf16_t* ks = P + (size_t)(krow0 + rr) * NPW + PC_NK + h * 64 + c0; const bf16_t* vs = P + (size_t)(krow0 + rr) * NPW + PC_NV + h * 64 + c0;
#pragma unroll
    for (int i = 0; i < 4; ++i) { x.k[i] = *(const u32x4*)(ks + 8 * i); x.v[i] = *(const u32x4*)(vs + 8 * i); }
}
struct NaQ { u32x4 q[4]; };
__device__ __forceinline__ void na_load_q(NaQ& x, const bf16_t* P, int qrow0, int h, int tid) {
    const bf16_t* qs = P + (size_t)(qrow0 + (tid >> 1)) * NPW + PC_NQ + h * 64 + (tid & 1) * 32;
#pragma unroll
    for (int i = 0; i < 4; ++i) x.q[i] = *(const u32x4*)(qs + 8 * i);
}
struct NaState { float m, l; f32x4 acc[4]; };
template <int NPAIR, unsigned VALID>
__device__ __forceinline__ void na_update(NaState& st, const f32x4 (&s)[2 * NPAIR], float mx, LAS const unsigned char* Vimg, int vrow0, int lane) {
    mx = max_g4(mx);
    const float m_new = fmaxf(st.m, mx), resc = __builtin_amdgcn_exp2f(st.m - m_new);
    st.m = m_new; st.l *= resc;
#pragma unroll
    for (int et = 0; et < 4; ++et) st.acc[et] = st.acc[et] * resc;
#pragma unroll
    for (int T = 0; T < NPAIR; ++T) {
        if (((VALID >> (2 * T)) & 3u) != 0u) {
            f32x4 p0 = {0.f, 0.f, 0.f, 0.f}, p1 = p0;
            if ((VALID >> (2 * T)) & 1u) {
#pragma unroll
                for (int j = 0; j < 4; ++j) p0[j] = __builtin_amdgcn_exp2f(s[2 * T][j] - m_new);
                st.l += (p0[0] + p0[1]) + (p0[2] + p0[3]); }
            if ((VALID >> (2 * T + 1)) & 1u) {
#pragma unroll
                for (int j = 0; j < 4; ++j) p1[j] = __builtin_amdgcn_exp2f(s[2 * T + 1][j] - m_new);
                st.l += (p1[0] + p1[1]) + (p1[2] + p1[3]); }
            asm volatile("" : "+v"(st.l));
            const bf16x8 bp = pack8(p0, p1);
            bf16x8 va[4]; frag_tr_x4<true>(Vimg, vrow0 + 32 * T, 0, lane, va);
#pragma unroll
            for (int et = 0; et < 4; ++et) st.acc[et] = mfma16(va[et], bp, st.acc[et]);
            __builtin_amdgcn_sched_barrier(0);
        }
    }
}
template <int QTA>
__device__ __forceinline__ void na_local_row(NaState& st, const bf16x8& bq0, const bf16x8& bq1, LAS const unsigned char* Kimg, LAS const unsigned char* Vimg, LAS const float* browb, int irow0, int lane) {
    constexpr int tlo = (16 * QTA - 8 < 0 ? 0 : (16 * QTA - 8 > 48 ? 48 : 16 * QTA - 8)), thi = (16 * QTA + 7 > 48 ? 48 : 16 * QTA + 7) + 15;
    constexpr unsigned VALID = ((15 >= tlo && 0 <= thi) ? 1u : 0u) | ((31 >= tlo && 16 <= thi) ? 2u : 0u) | ((47 >= tlo && 32 <= thi) ? 4u : 0u) | ((63 >= tlo && 48 <= thi) ? 8u : 0u);
    const int g = lane >> 4, ql = 16 * QTA + (lane & 15), scq = min(max(ql - 8, 0), GRIDW - 16);
    f32x4 s[4]; float mx = -1.0e30f;
#pragma unroll
    for (int ct = 0; ct < 4; ++ct) {
        if ((VALID >> ct) & 1u) {
            f32x4 z = {0.f, 0.f, 0.f, 0.f}; z = mfma16(frag_row(Kimg, irow0 + 16 * ct, 0, lane), bq0, z); z = mfma16(frag_row(Kimg, irow0 + 16 * ct, 32, lane), bq1, z);
            const LAS float* brow = browb + (16 * ct + 4 * g - ql + 63); const int t0 = 16 * ct + 4 * g - scq;
#pragma unroll
            for (int j = 0; j < 4; ++j) { const float bv = brow[j]; const float zz = z[j] * 0.18033688f + bv; z[j] = ((unsigned)(t0 + j) < 16u) ? zz : -1.0e30f; }
            s[ct] = z; mx = fmaxf(mx, fmaxf(fmaxf(z[0], z[1]), fmaxf(z[2], z[3]))); asm volatile("" ::: "memory");
        } else s[ct] = (f32x4){-1.0e30f, -1.0e30f, -1.0e30f, -1.0e30f};
    }
    na_update<2, VALID>(st, s, mx, Vimg, irow0, lane);
    __builtin_amdgcn_sched_barrier(0);
}
template <int QTA>
__device__ __forceinline__ void na_local_q(NaState& st, LAS const unsigned char* Qimg, LAS const unsigned char* Kimg, LAS const unsigned char* Vimg, LAS const float* RPB, int qimg_row, int lane, int kkb, int srw, int qrw) {
    const bf16x8 bq0 = frag_row(Qimg, qimg_row, 0, lane), bq1 = frag_row(Qimg, qimg_row, 32, lane);
#pragma unroll
    for (int kkl = 0; kkl < 4; ++kkl) { const int kk = kkb + kkl;
        if (kk >= srw && kk < srw + 8) na_local_row<QTA>(st, bq0, bq1, Kimg, Vimg, RPB + (kk - qrw + 7) * 128, 64 * kkl, lane); }
}
template <int WP>
__device__ __forceinline__ void na_local_step(NaState (&st)[2], LAS const unsigned char* Qimg, LAS const unsigned char* Kimg, LAS const unsigned char* Vimg, LAS const float* RPB, int wave, int lane, int kkb, int srw, int qrw) {
    na_local_q<2 * WP>(st[0], Qimg, Kimg, Vimg, RPB, 32 * wave, lane, kkb, srw, qrw);
    na_local_q<2 * WP + 1>(st[1], Qimg, Kimg, Vimg, RPB, 32 * wave + 16, lane, kkb, srw, qrw);
}
__device__ __forceinline__ void phase_natt_mfma(const Args& a, int l, bool need_ctx, LAS unsigned char* lds, int tid, int lane, int wave, int bid, int G) {
    unsigned char* ws = a.ws;
    const bf16_t* P = (const bf16_t*)(ws + WS_BIG); bf16_t* MG = (bf16_t*)(ws + WS_H);
    LAS unsigned char* Qimg = lds; LAS unsigned char* Kimg = lds + 40960; LAS unsigned char* Vimg = lds + 81920;
    LAS float* RPB = (LAS float*)(lds + 122880);
    const int nitems = 512 + (need_ctx ? NB * 8 : 0);
    const int g = lane >> 4;
    int it = bid; if (it >= nitems) return;
    NaItem cur = na_decode(it);
    NaKV kv; na_load_kv(kv, P, na_krow0(cur, 0), cur.h, tid);
    float rpbreg[4];
#pragma unroll
    for (int k = 0; k < 4; ++k) { const int idx = tid + 512 * k, dr = idx >> 7, dc = (idx & 127) - 48; rpbreg[k] = (idx < 1920 && dc >= 0 && dc <= 30) ? a.in[15][(size_t)(l * 8 + cur.h) * 465 + dr * 31 + dc] * 1.44269504f : 0.f; }
    for (;;) {
        const int itn = it + G; const bool has_next = itn < nitems; NaItem nxt = cur; if (has_next) nxt = na_decode(itn);
        const int nsteps = 1 + cur.nlb;
        const int qrw = cur.r0 + (wave >> 1), srw = min(max(qrw - 4, 0), NROWS - 8);
        NaState st[2];
#pragma unroll
        for (int q2 = 0; q2 < 2; ++q2) { st[q2].m = -1.0e30f; st[q2].l = 0.f;
#pragma unroll
            for (int et = 0; et < 4; ++et) st[q2].acc[et] = (f32x4){0.f, 0.f, 0.f, 0.f}; }
        for (int step = 0; step < nsteps; ++step) {
            int ts = tid; asm volatile("" : "+v"(ts));
            __syncthreads();
            { const int rr = ts >> 1, c0 = (ts & 1) * 32;
#pragma unroll
              for (int i = 0; i < 4; ++i) { *(LAS u32x4*)(Kimg + rr * IST + (c0 + 8 * i) * 2) = kv.k[i]; *(LAS u32x4*)(Vimg + rr * IST + (c0 + 8 * i) * 2) = kv.v[i]; }
              if (step == 0) { NaQ qr_; na_load_q(qr_, P, cur.qrow0, cur.h, ts);
#pragma unroll
                  for (int i = 0; i < 4; ++i) *(LAS u32x4*)(Qimg + rr * IST + (c0 + 8 * i) * 2) = qr_.q[i];
#pragma unroll
                  for (int k = 0; k < 4; ++k) if (ts + 512 * k < 1920) RPB[ts + 512 * k] = rpbreg[k]; } }
            __syncthreads();
            int tq = ts;
            if (step + 1 < nsteps) na_load_kv(kv, P, na_krow0(cur, step + 1), cur.h, tq);
            else if (has_next) { na_load_kv(kv, P, na_krow0(nxt, 0), nxt.h, tq);
#pragma unroll
                for (int k = 0; k < 4; ++k) { const int idx = tq + 512 * k, dr = idx >> 7, dc = (idx & 127) - 48; rpbreg[k] = (idx < 1920 && dc >= 0 && dc <= 30) ? a.in[15][(size_t)(l * 8 + nxt.h) * 465 + dr * 31 + dc] * 1.44269504f : 0.f; } }
            const int ln = ts & 63;
            if (step == 0) {
#pragma unroll
                for (int q2 = 0; q2 < 2; ++q2) {
                    const bf16x8 bq0 = frag_row(Qimg, 32 * wave + 16 * q2, 0, ln), bq1 = frag_row(Qimg, 32 * wave + 16 * q2, 32, ln);
#pragma unroll
                    for (int hf = 0; hf < 2; ++hf) {
                        f32x4 s[8]; float mx = -1.0e30f;
#pragma unroll
                        for (int t8 = 0; t8 < 8; ++t8) { f32x4 z = {0.f, 0.f, 0.f, 0.f}; z = mfma16(frag_row(Kimg, 128 * hf + 16 * t8, 0, ln), bq0, z); z = mfma16(frag_row(Kimg, 128 * hf + 16 * t8, 32, ln), bq1, z);
                            z = z * 0.18033688f; s[t8] = z; mx = fmaxf(mx, fmaxf(fmaxf(z[0], z[1]), fmaxf(z[2], z[3]))); if (t8 & 1) asm volatile("" ::: "memory"); }
                        na_update<4, 0xFFu>(st[q2], s, mx, Vimg, 128 * hf, ln);
                        __builtin_amdgcn_sched_barrier(0);
                    }
                }
            } else {
                const int kkb = cur.ur0 + 4 * (step - 1);
                if (wave & 1) na_local_step<1>(st, Qimg, Kimg, Vimg, RPB, wave, ln, kkb, srw, qrw);
                else          na_local_step<0>(st, Qimg, Kimg, Vimg, RPB, wave, ln, kkb, srw, qrw);
            }
        }
        int lf = lane; asm volatile("" : "+v"(lf)); const int gf = lf >> 4;
#pragma unroll
        for (int q2 = 0; q2 < 2; ++q2) {
            const float inv = 1.0f / sum_g4(st[q2].l);
            const int row = cur.qrow0 + 32 * wave + 16 * q2 + (lf & 15);
#pragma unroll
            for (int et = 0; et < 4; ++et) { u32x2 w; w.x = pk2(st[q2].acc[et][0] * inv, st[q2].acc[et][1] * inv); w.y = pk2(st[q2].acc[et][2] * inv, st[q2].acc[et][3] * inv);
                *(u32x2*)(MG + (size_t)row * DM + 512 + cur.h * 64 + 16 * et + 4 * gf) = w; }
        }
        if (!has_next) break;
        it = itn; cur = nxt;
    }
}

constexpr int MOE_TAB_OFF = 131072;
__device__ __forceinline__ void moe_tab_setup(const unsigned char* ws, LAS unsigned char* lds, int tid) {
    if (tid == 0) { LAS int* tab = (LAS int*)(lds + MOE_TAB_OFF); int p = 0;
        for (int e = 0; e < NEXP; ++e) { const int c = (int)__hip_atomic_load((const unsigned*)(ws + WS_CTL) + CW_MOE + 64 * e, __ATOMIC_RELAXED, __HIP_MEMORY_SCOPE_AGENT); tab[e] = p; tab[16 + e] = c; p += (c + 255) >> 8; }
        tab[8] = p; }
    __syncthreads();
}
namespace pg8 {
struct MoeOrder : StaticOrder {
    const PG8_LAS int* tab; const int* list; size_t bstride;
    __device__ __forceinline__ int expert(int pm) const { int e = 0;
#pragma unroll
        for (int k = 1; k < 8; ++k) e += (pm >= tab[k]) ? 1 : 0;
        return e; }
    __device__ __forceinline__ unsigned arow(const Unit& u, int R) const {
        const int Rr = (u.hs > 0 ? HALF : 0) + (u.hs >= 0 ? (R & (HALF - 1)) : R);
        if (!list) return (unsigned)(u.pm * BM + Rr);
        const int e = expert(u.pm), idx = (u.pm - tab[e]) * BM + Rr;
        return idx < tab[16 + e] ? (unsigned)list[e * NLAT + idx] : 0u; }
    __device__ __forceinline__ const char* bbase(const Unit& u) const { return Bt + (size_t)expert(u.pm) * bstride + (size_t)u.pn * BM * K2; }
};
}
__device__ __forceinline__ void phase_moe_combine(const Args& a, LAS unsigned char* lds, int lane, int wave, int bid, int G) {
    unsigned char* ws = a.ws; const LAS int* tab = (const LAS int*)(lds + MOE_TAB_OFF);
    const int* TOK = (const int*)(ws + WS_COMB); const bf16_t* Y = (const bf16_t*)(ws + WS_WTMUP);
    const float* g2 = (const float*)(ws + WS_MOD) + (size_t)9 * 6144 + 5120;
    for (int r = bid * NWAVES + wave; r < NLAT; r += G * NWAVES) {
        const int e1 = TOK[r * 8], e2 = TOK[r * 8 + 1], p1 = TOK[r * 8 + 2], p2 = TOK[r * 8 + 3]; const float w1 = __int_as_float(TOK[r * 8 + 4]), w2 = __int_as_float(TOK[r * 8 + 5]);
        const bf16_t* y1 = Y + ((size_t)tab[e1] * 256 + p1) * DM; const bf16_t* y2 = Y + ((size_t)tab[e2] * 256 + p2) * DM;
        const float* gr = g2 + (size_t)(r >> 11) * 6144; float* o = a.out + (size_t)r * DM;
#pragma unroll
        for (int j = 0; j < 4; ++j) { const int k = 4 * lane + 256 * j;
            const u32x2 a1 = *(const u32x2*)(y1 + k), a2 = *(const u32x2*)(y2 + k); const f32x4 x = *(const f32x4*)(o + k), gg = *(const f32x4*)(gr + k);
            f32x4 m; m.x = w1 * bflo(a1.x) + w2 * bflo(a2.x); m.y = w1 * bfhi(a1.x) + w2 * bfhi(a2.x); m.z = w1 * bflo(a1.y) + w2 * bflo(a2.y); m.w = w1 * bfhi(a1.y) + w2 * bfhi(a2.y);
            *(f32x4*)(o + k) = x + gg * m; }
    }
}
#ifndef DUP_VIRT
#define DUP_VIRT (-1)
#endif
#define PH_REP_OPEN
#define PH_REP_CLOSE
#ifndef DUP_PH
#define DUP_PH (-1)
#endif
#ifndef PH_ONLY
#define PH_ONLY 0
#endif
#ifndef MIX_NAIVE
#define MIX_NAIVE 0
#endif
#ifndef MIX_RET
#define MIX_RET 1
#endif
#ifndef MIX_ML
#define MIX_ML 1
#endif
#ifndef MIX_NA
#define MIX_NA 1
#endif
#ifndef EN_PRO
#define EN_PRO 1
#endif
#ifndef EN_NORM
#define EN_NORM 1
#endif
#ifndef EN_GIN
#define EN_GIN 1
#endif
#ifndef EN_POST
#define EN_POST 1
#endif
#ifndef EN_FCUM
#define EN_FCUM 1
#endif
#ifndef EN_QUAD
#define EN_QUAD 1
#endif
#ifndef EN_NATT
#define EN_NATT 1
#endif
#ifndef EN_MERGE
#define EN_MERGE 1
#endif
#ifndef EN_GOUT
#define EN_GOUT 1
#endif
#ifndef EN_NORM2
#define EN_NORM2 1
#endif
#ifndef EN_GUP
#define EN_GUP 1
#endif
#ifndef EN_GDN
#define EN_GDN 1
#endif

__global__ void __launch_bounds__(NTHR, 2) fwd_kernel(Args a_) {
    extern __shared__ __attribute__((aligned(16))) unsigned char lds_raw[];
    LAS unsigned char* lds = (LAS unsigned char*)lds_raw;
    const int tid0 = threadIdx.x, G = gridDim.x, bid = blockIdx.x; const int wave0 = __builtin_amdgcn_readfirstlane(tid0 >> 6);
    unsigned char* ws0 = a_.ws;
    volatile LAS unsigned* MISC = (volatile LAS unsigned*)(lds + MISC_OFF);
    if (tid0 < 32) MISC[tid0] = 0u;
    __syncthreads();
    const int lo = a_.ph_lo, hi = a_.ph_hi;
    XcdBarrier bar; bar.bar = (unsigned*)(ws0 + WS_CTL) + CW_BAR; bar.x = 0; bar.st = MISC + 8;
    if (hi - lo > 1) bar = xcd_barrier_post((unsigned*)(ws0 + WS_CTL) + CW_BAR, MISC + 8);
    int ph = 0;
#define PH_BEGIN if (ph >= lo && ph < hi) { asm volatile("; PHMARK_BEGIN %0" :: "i"(__LINE__)); int tid; asm volatile("v_mbcnt_lo_u32_b32 %0, -1, 0\n\tv_mbcnt_hi_u32_b32 %0, -1, %0" : "=v"(tid)); tid += wave0 * 64; Args a; { const __attribute__((address_space(4))) Args* ap = (const __attribute__((address_space(4))) Args*)__builtin_amdgcn_kernarg_segment_ptr(); asm volatile("" : "+s"(ap)); a = *(const Args*)ap; } unsigned char* ws = a.ws; (void)ws; PH_REP_OPEN if (PH_ONLY == 0 || PH_ONLY == __LINE__) { const int lane = tid & 63, wave = __builtin_amdgcn_readfirstlane(tid >> 6); (void)lane; (void)wave;
#define PH_END   } PH_REP_CLOSE asm volatile("; PHMARK_END %0" :: "i"(__LINE__)); if (ph + 1 < hi) xcd_barrier(bar); else __syncthreads(); } ++ph;

    PH_BEGIN
#if EN_PRO
 phase_prologue(a, lds, tid, lane, wave, bid, G);
#endif
 PH_END

    for (int l = 0; l < 2; ++l) {
        const bool need_ctx = (l == 0);
#define MODP ((const float*)(ws + WS_MOD) + (size_t)l * 9 * 6144)
        PH_BEGIN
#if EN_NORM
 phase_norm<0>(a, l, lds, tid, lane, wave, bid, G);
#endif
 PH_END
        PH_BEGIN
#if EN_GIN
 { pg8::Gemm g{(const bf16_t*)(ws + WS_H), (const bf16_t*)(ws + WS_WTIN) + (size_t)l * NPW * DM, MALL, NPW, DM};
                   pg8::StaticOrder S; S.init(MALL, NPW, G, bid); S.Bt = (const char*)g.Bt; S.K2 = 2 * DM; pg8::EpiBf16 E{(bf16_t*)(ws + WS_BIG), NPW};
                   pg8::gemm_phase<pg8::EpiBf16, pg8::StaticOrder, false>(lds, g, S, E, nullptr, tid); }
#endif
 PH_END
        PH_BEGIN
#if EN_POST
 phase_post(a, l, lane, wave, bid, G);
#endif
 PH_END
        PH_BEGIN
#if MIX_RET || MIX_ML
        phase_chunk_sums(a, l, lds, tid, lane, wave, bid, G);
#endif
        PH_END
        PH_BEGIN phase_chunk_states(a, l, tid, bid, G); PH_END
        PH_BEGIN
#if MIX_RET
        phase_chunk_out<0>(a, l, need_ctx, lds, tid, lane, wave, bid, G);
#endif
#if MIX_ML
        phase_chunk_out<1>(a, l, need_ctx, lds, tid, lane, wave, bid, G);
#endif
#if MIX_NA
        phase_natt_mfma(a, l, need_ctx, lds, tid, lane, wave, bid, G);
#endif
        PH_END
        PH_BEGIN
#if EN_GOUT
 { const int M = need_ctx ? MALL : NLAT;
                   pg8::Gemm g{(const bf16_t*)(ws + WS_H), (const bf16_t*)(ws + WS_WTOUT) + (size_t)l * DM * DM, M, DM, DM};
                   pg8::StaticOrder S; S.init(M, DM, G, bid); S.Bt = (const char*)g.Bt; S.K2 = 2 * DM;
                   pg8::EpiResid E{l == 0 ? a.in[0] : a.out, l == 0 ? a.in[2] : (const float*)(ws + WS_XC), a.out, (float*)(ws + WS_XC), MODP + 2048, nullptr, 0, NLAT / 256};
                   pg8::gemm_phase<pg8::EpiResid, pg8::StaticOrder, false>(lds, g, S, E, nullptr, tid); }
#endif
 PH_END
        if (l == 0) { PH_BEGIN
#if EN_NORM2
 phase_norm<1>(a, l, lds, tid, lane, wave, bid, G);
#endif
 PH_END }
        else        { PH_BEGIN
#if EN_NORM2
 phase_norm<2>(a, l, lds, tid, lane, wave, bid, G);
#endif
 PH_END }
        if (l == 0) {
            PH_BEGIN { pg8::Gemm g{(const bf16_t*)(ws + WS_H), (const bf16_t*)(ws + WS_WTUP), MALL, NUP, DM};
                       pg8::StaticOrder S; S.init(MALL, NUP, G, bid); S.Bt = (const char*)g.Bt; S.K2 = 2 * DM; pg8::EpiSwiGLU E{(bf16_t*)(ws + WS_BIG), DFF};
                       pg8::gemm_phase<pg8::EpiSwiGLU, pg8::StaticOrder, false>(lds, g, S, E, nullptr, tid); } PH_END
            PH_BEGIN { pg8::Gemm g{(const bf16_t*)(ws + WS_BIG), (const bf16_t*)(ws + WS_WTDN), MALL, DM, DFF};
                       pg8::StaticOrder S; S.init(MALL, DM, G, bid); S.Bt = (const char*)g.Bt; S.K2 = 2 * DFF;
                       pg8::EpiResid E{a.out, (const float*)(ws + WS_XC), a.out, (float*)(ws + WS_XC), MODP + 5120, nullptr, 0, NLAT / 256};
                       pg8::gemm_phase<pg8::EpiResid, pg8::StaticOrder, false>(lds, g, S, E, nullptr, tid); } PH_END
        } else {
            PH_BEGIN { moe_tab_setup(ws, lds, tid); const LAS int* tab = (const LAS int*)(lds + MOE_TAB_OFF);
                       pg8::Gemm g{(const bf16_t*)(ws + WS_H), (const bf16_t*)(ws + WS_WTMUP), 256 * tab[8], NUP, DM};
                       pg8::MoeOrder S; S.init(256 * tab[8], NUP, G, bid); S.Bt = (const char*)g.Bt; S.K2 = 2 * DM; S.tab = tab; S.list = (const int*)(ws + WS_LIST); S.bstride = (size_t)NUP * DM * 2;
                       pg8::EpiSwiGLU E{(bf16_t*)(ws + WS_BIG), DFF};
                       pg8::gemm_phase<pg8::EpiSwiGLU, pg8::MoeOrder, false>(lds, g, S, E, nullptr, tid); } PH_END
            PH_BEGIN { moe_tab_setup(ws, lds, tid); const LAS int* tab = (const LAS int*)(lds + MOE_TAB_OFF);
                       pg8::Gemm g{(const bf16_t*)(ws + WS_BIG), (const bf16_t*)(ws + WS_WTMDN), 256 * tab[8], DM, DFF};
                       pg8::MoeOrder S; S.init(256 * tab[8], DM, G, bid); S.Bt = (const char*)g.Bt; S.K2 = 2 * DFF; S.tab = tab; S.list = nullptr; S.bstride = (size_t)DM * DFF * 2;
                       pg8::EpiBf16 E{(bf16_t*)(ws + WS_WTMUP), DM};
                       pg8::gemm_phase<pg8::EpiBf16, pg8::MoeOrder, false>(lds, g, S, E, nullptr, tid); } PH_END
            PH_BEGIN { moe_tab_setup(ws, lds, tid); phase_moe_combine(a, lds, lane, wave, bid, G); } PH_END
        }
    }
#if N_LAUNCH_MODE == 1
    if (lo >= 100) {
        int tid; asm volatile("v_mbcnt_lo_u32_b32 %0, -1, 0\n\tv_mbcnt_hi_u32_b32 %0, -1, %0" : "=v"(tid)); tid += wave0 * 64; const int lane = tid & 63, wave = wave0;
        Args a = a_;
        if (lo == 100) phase_chunk_out<0>(a, 0, true, lds, tid, lane, wave, bid, G);
        if (lo == 101) phase_chunk_out<1>(a, 0, true, lds, tid, lane, wave, bid, G);
        if (lo == 102) phase_natt_mfma(a, 0, true, lds, tid, lane, wave, bid, G);
    }
#endif
#undef PH_BEGIN
#undef PH_END
}
constexpr int N_PHASES = 1 + 2 * 8 + 2 + 3;
#ifndef DBG_MAXPH
#define DBG_MAXPH 1000
#endif

extern "C" void kernel_launch(void* const* d_in, const int* in_sizes, int n_in, void* d_out, int out_size, void* d_ws, size_t ws_size, hipStream_t stream) {
    static int grid = 0;
    if (grid == 0) {
        if (n_in != 24 || out_size != NLAT * DM || ws_size < WS_END) { fprintf(stderr, "kernel_launch: unexpected sizes (n_in %d, out %d, ws %zu < %zu); nothing launched\n", n_in, out_size, ws_size, (size_t)WS_END); grid = -1; return; }
        int dev = 0, cus = 0;
        if (hipGetDevice(&dev) != hipSuccess || hipDeviceGetAttribute(&cus, hipDeviceAttributeMultiprocessorCount, dev) != hipSuccess) { grid = -1; return; }
        if (hipFuncSetAttribute((const void*)fwd_kernel, hipFuncAttributeMaxDynamicSharedMemorySize, LDS_BYTES) != hipSuccess) { fprintf(stderr, "kernel_launch: hipFuncSetAttribute failed\n"); grid = -1; return; }
        int per_cu = 0;
        if (hipOccupancyMaxActiveBlocksPerMultiprocessor(&per_cu, (const void*)fwd_kernel, NTHR, LDS_BYTES) != hipSuccess || per_cu < 1) { fprintf(stderr, "kernel_launch: occupancy query says %d\n", per_cu); }
        (void)hipGetLastError();
        grid = cus;
    }
    if (grid < 0) return;
    (void)hipMemsetAsync((char*)d_ws + WS_CTL, 0, CTL_BYTES, stream);
    Args a{};
    for (int i = 0; i < 24; ++i) a.in[i] = (const float*)d_in[i];
    a.out = (float*)d_out; a.ws = (unsigned char*)d_ws;
#if N_LAUNCH_MODE == 0
    a.ph_lo = 0; a.ph_hi = N_PHASES;
    hipLaunchKernelGGL(fwd_kernel, dim3(grid), dim3(NTHR), LDS_BYTES, stream, a);
#else
    for (int p = 0; p < N_PHASES && p < DBG_MAXPH; ++p) { a.ph_lo = p; a.ph_hi = p + 1; hipLaunchKernelGGL(fwd_kernel, dim3(grid), dim3(NTHR), LDS_BYTES, stream, a);
        if (p == DUP_PH) hipLaunchKernelGGL(fwd_kernel, dim3(grid), dim3(NTHR), LDS_BYTES, stream, a);
        if (p == 6 && DUP_VIRT >= 100) { a.ph_lo = DUP_VIRT; a.ph_hi = DUP_VIRT + 1; hipLaunchKernelGGL(fwd_kernel, dim3(grid), dim3(NTHR), LDS_BYTES, stream, a); } }
#endif
}
```

```cpp
#include <hip/hip_runtime.h>
#include <stdio.h>
#include <stdint.h>

#ifndef N_LAUNCH_MODE
#define N_LAUNCH_MODE 0
#endif

constexpr int NB = 8, SEQ = 2048, DM = 1024, CTXL = 256, HD = 64;
constexpr int NLAT = NB * SEQ, NCTX = NB * CTXL, MALL = NLAT + NCTX;
constexpr int DIN = 3600, NPW = 3584;
constexpr int DFF = 2816, NUP = 2 * DFF, NEXP = 8;
constexpr int GRIDW = 64, NROWS = 32;
constexpr float EPS = 1e-6f;
constexpr int PC_RQ = 0, PC_RK = 256, PC_RV = 512, PC_RG = 768, PC_MQ = 1024, PC_MK = 1280, PC_MV = 1536, PC_MO = 1792, PC_NQ = 2048, PC_NK = 2560, PC_NV = 3072;

constexpr size_t al256(size_t x) { return (x + 255) & ~(size_t)255; }
constexpr size_t WS_CTL = 0, CTL_BYTES = 1u << 20;
constexpr size_t WS_MOD = WS_CTL + CTL_BYTES;
constexpr size_t WS_ROPE = WS_MOD + al256((size_t)2 * 9 * 6144 * 4);
constexpr size_t WS_WTIN = WS_ROPE + al256(64 * 16 * 2 * 4);
constexpr size_t WS_WTOUT = WS_WTIN + (size_t)2 * NPW * DM * 2;
constexpr size_t WS_WTUP = WS_WTOUT + (size_t)2 * DM * DM * 2;
constexpr size_t WS_WTDN = WS_WTUP + (size_t)NUP * DM * 2;
constexpr size_t WS_WTMUP = WS_WTDN + (size_t)DM * DFF * 2;
constexpr size_t WS_WTMDN = WS_WTMUP + (size_t)NEXP * NUP * DM * 2;
constexpr size_t WS_H = WS_WTMDN + (size_t)NEXP * DM * DFF * 2;
constexpr size_t WS_XC = WS_H + (size_t)MALL * DM * 2;
constexpr size_t WS_GATES = WS_XC + (size_t)NCTX * DM * 4;
constexpr size_t WS_COMB = WS_GATES + (size_t)MALL * 16 * 4;
constexpr size_t WS_USC = WS_COMB + (size_t)NLAT * 8 * 4;
constexpr size_t WS_SM = WS_USC + al256((size_t)NB * 4 * 2 * 18 * 2 * 4);
constexpr size_t WS_LIST = WS_SM + al256((size_t)NB * 4 * 2 * 18 * 4);
constexpr size_t WS_BIG = WS_LIST + (size_t)NEXP * NLAT * 4;
constexpr size_t WS_MQK = WS_BIG + (size_t)MALL * NPW * 2;
constexpr size_t WS_U = WS_MQK + (size_t)MALL * 512 * 2;
constexpr size_t WS_S = WS_U + (size_t)2 * NB * 4 * 2 * 18 * 80 * 64 * 2;
constexpr size_t WS_END0 = WS_S + (size_t)2 * NB * 4 * 2 * 18 * 80 * 64 * 2;
constexpr size_t MOE_ROWS = 34816;
constexpr size_t WS_ACTM_END = WS_BIG + MOE_ROWS * DFF * 2;
constexpr size_t WS_END = WS_END0 > WS_ACTM_END ? WS_END0 : WS_ACTM_END;

typedef unsigned short bf16_t;
typedef float f32x4 __attribute__((ext_vector_type(4)));
typedef float f32x2 __attribute__((ext_vector_type(2)));
typedef unsigned u32x4 __attribute__((ext_vector_type(4)));
typedef unsigned u32x2 __attribute__((ext_vector_type(2)));
#define LAS __attribute__((address_space(3)))
#define GAS __attribute__((address_space(1)))

__device__ __forceinline__ float bf2f(bf16_t b) { return __uint_as_float(((unsigned)b) << 16); }
__device__ __forceinline__ unsigned f2bf(float f) { unsigned u = __float_as_uint(f); return (u + 0x7fffu + ((u >> 16) & 1u)) >> 16; }
typedef __bf16 bf16x2_t __attribute__((ext_vector_type(2)));
__device__ __forceinline__ unsigned pk2(float lo, float hi) { f32x2 v = {lo, hi}; bf16x2_t b = __builtin_convertvector(v, bf16x2_t); return __builtin_bit_cast(unsigned, b); }
__device__ __forceinline__ float bflo(unsigned w) { return __uint_as_float(w << 16); }
__device__ __forceinline__ float bfhi(unsigned w) { return __uint_as_float(w & 0xffff0000u); }
__device__ __forceinline__ float sigmoidf_(float x) { return 1.0f / (1.0f + __expf(-x)); }
__device__ __forceinline__ float siluf_(float x) { return x / (1.0f + __expf(-x)); }
__device__ __forceinline__ float logsigmoidf_(float x) { return fminf(x, 0.f) - log1pf(__expf(-fabsf(x))); }
template <int O> __device__ __forceinline__ float swz_xor(float v) { return __int_as_float(__builtin_amdgcn_ds_swizzle(__float_as_int(v), (O << 10) | 0x1f)); }
__device__ __forceinline__ float red32_sum(float v) { const auto r = __builtin_amdgcn_permlane32_swap(__float_as_uint(v), __float_as_uint(v), false, false); return __uint_as_float(r[0]) + __uint_as_float(r[1]); }
__device__ __forceinline__ float red32_max(float v) { const auto r = __builtin_amdgcn_permlane32_swap(__float_as_uint(v), __float_as_uint(v), false, false); return fmaxf(__uint_as_float(r[0]), __uint_as_float(r[1])); }
__device__ __forceinline__ float wave_sum(float v) { v += swz_xor<1>(v); v += swz_xor<2>(v); v += swz_xor<4>(v); v += swz_xor<8>(v); v += swz_xor<16>(v); return red32_sum(v); }
__device__ __forceinline__ float wave_max(float v) { v = fmaxf(v, swz_xor<1>(v)); v = fmaxf(v, swz_xor<2>(v)); v = fmaxf(v, swz_xor<4>(v)); v = fmaxf(v, swz_xor<8>(v)); v = fmaxf(v, swz_xor<16>(v)); return red32_max(v); }
__device__ __forceinline__ float sum_g4(float v) { v += swz_xor<16>(v); return red32_sum(v); }
__device__ __forceinline__ float max_g4(float v) { v = fmaxf(v, swz_xor<16>(v)); return red32_max(v); }
__device__ __forceinline__ float reduce16_lanes(const float (&p)[16], int lane) {
    float q[8], r[4], s[2];
#pragma unroll
    for (int j = 0; j < 8; ++j) { const auto x = __builtin_amdgcn_permlane32_swap(__float_as_uint(p[j]), __float_as_uint(p[j + 8]), false, false); q[j] = __uint_as_float(x[0]) + __uint_as_float(x[1]); }
    const bool b4 = (lane & 16) != 0, b3 = (lane & 8) != 0, b2 = (lane & 4) != 0;
#pragma unroll
    for (int j = 0; j < 4; ++j) { const float keep = b4 ? q[j + 4] : q[j], send = b4 ? q[j] : q[j + 4]; r[j] = keep + swz_xor<16>(send); }
#pragma unroll
    for (int j = 0; j < 2; ++j) { const float keep = b3 ? r[j + 2] : r[j], send = b3 ? r[j] : r[j + 2]; s[j] = keep + swz_xor<8>(send); }
    float v; { const float keep = b2 ? s[1] : s[0], send = b2 ? s[0] : s[1]; v = keep + swz_xor<4>(send); }
    v += swz_xor<2>(v); v += swz_xor<1>(v);
    return v;
}
__device__ __forceinline__ float reduce8_lanes(const float (&p)[8], int lane) {
    float q[4], r[2];
#pragma unroll
    for (int j = 0; j < 4; ++j) { const auto x = __builtin_amdgcn_permlane32_swap(__float_as_uint(p[j]), __float_as_uint(p[j + 4]), false, false); q[j] = __uint_as_float(x[0]) + __uint_as_float(x[1]); }
    const bool b4 = (lane & 16) != 0, b3 = (lane & 8) != 0;
#pragma unroll
    for (int j = 0; j < 2; ++j) { const float keep = b4 ? q[j + 2] : q[j], send = b4 ? q[j] : q[j + 2]; r[j] = keep + swz_xor<16>(send); }
    float v; { const float keep = b3 ? r[1] : r[0], send = b3 ? r[0] : r[1]; v = keep + swz_xor<8>(send); }
    v += swz_xor<4>(v); v += swz_xor<2>(v); v += swz_xor<1>(v);
    return v;
}
__device__ __forceinline__ float lane_get(float v, int src_lane) { return __int_as_float(__builtin_amdgcn_ds_bpermute(src_lane << 2, __float_as_int(v))); }
__device__ __forceinline__ float lane_bcast(float v, int k) { return __int_as_float(__builtin_amdgcn_readlane(__float_as_int(v), k)); }

struct Args {
    const float* in[24];
    float* out;
    unsigned char* ws;
    int ph_lo, ph_hi;
};
namespace pg8 {
#define PG8_LAS __attribute__((address_space(3)))
typedef unsigned short bf16_t;
typedef short bf16x8 __attribute__((ext_vector_type(8)));
typedef float f32x4 __attribute__((ext_vector_type(4)));
typedef unsigned u32x4 __attribute__((ext_vector_type(4)));
constexpr int BM = 256, BK = 64, HALF = 128, HTB = HALF * BK * 2  , STAGE_BYTES = 8 * HTB, NXCD = 8, WGM = 8;

__host__ __device__ __forceinline__ int lds_byte(int r, int c) { const int st = (r >> 4) * 2 + (c >> 5), rr = r & 15, cc = c & 31, ob = rr * 64 + cc * 2; return st * 1024 + (ob ^ (((ob >> 9) & 1) << 5)); }
__host__ __device__ __forceinline__ void stage_rc(int b, int& R, int& C) { const int st = b / 1024, sb = b % 1024, swz = sb ^ (((sb >> 9) & 1) << 5); R = (st >> 1) * 16 + swz / 64; C = (st & 1) * 32 + (swz % 64) / 2; }
__host__ __device__ __forceinline__ int perm32(int rho) { const int n = rho >> 4, i = rho & 15; return 8 * (i >> 2) + 4 * n + (i & 3); }

struct Unit { int pm, pn, hs; };
struct Gemm { const bf16_t* A; const bf16_t* Bt; int M, N, K; };

struct StaticOrder {
    int nM, nN, nwg, G, c;
    __host__ __device__ void init(int M, int N, int G_, int c_) { nM = M / BM; nN = N / BM; nwg = nM * nN; G = G_; c = c_; }
    __host__ __device__ bool next(int i, Unit& u) const {
        const int nfr = nwg / G, left = nwg - nfr * G; int wgid; u.hs = -1;
        if (i < nfr) wgid = i * G + c;
        else if (i == nfr && left > 0) { if (2 * left <= G) { if (c >= 2 * left) return false; wgid = nfr * G + (c >> 1); u.hs = c & 1; } else { if (c >= left) return false; wgid = nfr * G + c; } }
        else return false; { const int q = nwg / NXCD, r = nwg % NXCD, xcd = wgid % NXCD, off = wgid / NXCD; wgid = (xcd < r ? xcd * (q + 1) : r * (q + 1) + (xcd - r) * q) + off; }
        const int nig = WGM * nN, gid = wgid / nig, fm = gid * WGM, gsz = (nM - fm) < WGM ? (nM - fm) : WGM;
        u.pm = fm + ((wgid % nig) % gsz); u.pn = (wgid % nig) / gsz; return true;
    }
    __device__ __forceinline__ void a_ready(const Unit&) const {}
    __device__ __forceinline__ void done(const Unit&) const {}
    const char* Bt; int K2;
    __device__ __forceinline__ unsigned arow(const Unit& u, int R) const { return (unsigned)(u.pm * BM + (u.hs > 0 ? HALF : 0) + (u.hs >= 0 ? (R & (HALF - 1)) : R)); }
    __device__ __forceinline__ const char* bbase(const Unit& u) const { return Bt + (size_t)u.pn * BM * K2; }
};
__device__ __forceinline__ unsigned cvt_pk_bf16(float lo, float hi) { return ::pk2(lo, hi); }
typedef float f32x2 __attribute__((ext_vector_type(2)));
struct EpiBf16 {
    static constexpr bool PERM = true, AFTER_DRAIN = false;
    bf16_t* O; int ldc;
    __device__ __forceinline__ void operator()(const f32x4 (&acc)[2][2][4][2], const Unit& u, int wr, int wc, int fr, int fq) const {
        const int row0 = u.pm * BM + (u.hs > 0 ? HALF : 0) + wr * 64 + fr, col0 = u.pn * BM + wc * 32 + 8 * fq; const int nai = u.hs >= 0 ? 1 : 2;
#pragma unroll
        for (int ai = 0; ai < 2; ++ai) if (ai < nai)
#pragma unroll
            for (int m = 0; m < 4; ++m) { bf16_t* rowp = O + (size_t)(row0 + ai * HALF + m * 16) * ldc + col0;
#pragma unroll
                for (int bj = 0; bj < 2; ++bj) { const f32x4 v0 = acc[ai][bj][m][0], v1 = acc[ai][bj][m][1];
                    u32x4 w; w.x = cvt_pk_bf16(v0[0], v0[1]); w.y = cvt_pk_bf16(v0[2], v0[3]); w.z = cvt_pk_bf16(v1[0], v1[1]); w.w = cvt_pk_bf16(v1[2], v1[3]);
                    *(u32x4*)(rowp + bj * HALF) = w; } }
    }
};
struct EpiSwiGLU {
    static constexpr bool PERM = true, AFTER_DRAIN = false;
    bf16_t* O; int ldc;
    __device__ __forceinline__ void operator()(const f32x4 (&acc)[2][2][4][2], const Unit& u, int wr, int wc, int fr, int fq) const {
        const int row0 = u.pm * BM + (u.hs > 0 ? HALF : 0) + wr * 64 + fr, col0 = u.pn * HALF + wc * 32 + 8 * fq; const int nai = u.hs >= 0 ? 1 : 2;
#pragma unroll
        for (int ai = 0; ai < 2; ++ai) if (ai < nai)
#pragma unroll
            for (int m = 0; m < 4; ++m) { bf16_t* rowp = O + (size_t)(row0 + ai * HALF + m * 16) * ldc + col0;
                float r[8];
#pragma unroll
                for (int n = 0; n < 2; ++n)
#pragma unroll
                    for (int j = 0; j < 4; ++j) { const float g = acc[ai][0][m][n][j], uu = acc[ai][1][m][n][j]; r[n * 4 + j] = g / (1.0f + __expf(-g)) * uu; }
                u32x4 w; w.x = cvt_pk_bf16(r[0], r[1]); w.y = cvt_pk_bf16(r[2], r[3]); w.z = cvt_pk_bf16(r[4], r[5]); w.w = cvt_pk_bf16(r[6], r[7]);
                *(u32x4*)rowp = w; }
    }
};
struct EpiResid {
    static constexpr bool PERM = false, AFTER_DRAIN = false;
    const float* base_lat; const float* base_ctx; float* out_lat; float* out_ctx; const float* gate; const float* comb; int comb_ld; int nlat_tiles;
    __device__ __forceinline__ void operator()(const f32x4 (&acc)[2][2][4][2], const Unit& u, int wr, int wc, int fr, int fq) const {
        const bool isctx = u.pm >= nlat_tiles;
        const int rloc0 = (isctx ? (u.pm - nlat_tiles) : u.pm) * BM + (u.hs > 0 ? HALF : 0) + wr * 64 + fr, col0 = u.pn * BM + wc * 32 + 4 * fq; const int nai = u.hs >= 0 ? 1 : 2;
        const float* bp = isctx ? base_ctx : base_lat; float* op = isctx ? out_ctx : out_lat;
        const float* gp = gate + (size_t)(isctx ? 8 : (u.pm >> 3)) * 6144 + col0;
        f32x4 gv[2][2];
#pragma unroll
        for (int bj = 0; bj < 2; ++bj)
#pragma unroll
            for (int n = 0; n < 2; ++n) gv[bj][n] = *(const f32x4*)(gp + bj * HALF + n * 16);
#pragma unroll
        for (int ai = 0; ai < 2; ++ai) if (ai < nai)
#pragma unroll
            for (int m = 0; m < 4; ++m) { const int rl = rloc0 + ai * HALF + m * 16; const size_t off = (size_t)rl * 1024 + col0;
                const float cs = comb ? comb[(size_t)rl * comb_ld] : 1.0f;
#pragma unroll
                for (int bj = 0; bj < 2; ++bj)
#pragma unroll
                    for (int n = 0; n < 2; ++n) { const f32x4 bs = *(const f32x4*)(bp + off + bj * HALF + n * 16);
                        *(f32x4*)(op + off + bj * HALF + n * 16) = bs + gv[bj][n] * acc[ai][bj][m][n] * cs; } }
    }
};

struct EpiNull {
    static constexpr bool PERM = true, AFTER_DRAIN = false;
    bf16_t* O; int ldc;
    __device__ __forceinline__ void operator()(const f32x4 (&acc)[2][2][4][2], const Unit& u, int wr, int wc, int fr, int fq) const {
        float s = 0.f;
#pragma unroll
        for (int ai = 0; ai < 2; ++ai)
#pragma unroll
            for (int bj = 0; bj < 2; ++bj)
#pragma unroll
                for (int m = 0; m < 4; ++m)
#pragma unroll
                    for (int n = 0; n < 2; ++n) s += acc[ai][bj][m][n][0] + acc[ai][bj][m][n][1] + acc[ai][bj][m][n][2] + acc[ai][bj][m][n][3];
        if (s == 12345.678f) O[0] = (bf16_t)1;
    }
};

struct EpiProj {
    static constexpr bool PERM = true, AFTER_DRAIN = false;
    bf16_t* O; int ldc; const float* rope; const float* qgain; const float* kgain; int nlat_tiles;
    __device__ __forceinline__ void operator()(const f32x4 (&acc)[2][2][4][2], const Unit& u, int wr, int wc, int fr, int fq) const {
        const int row0 = u.pm * BM + (u.hs > 0 ? HALF : 0) + wr * 64 + fr, col0 = u.pn * BM + wc * 32 + 8 * fq; const int nai = u.hs >= 0 ? 1 : 2;
        const int pn = u.pn; const bool lat = u.pm < nlat_tiles;
        const bool isrope = pn < 2 && lat, isnorm = pn >= 8 && pn < 12; const float sc = (pn == 1) ? 0.125f : 1.0f;
        const float* gp = (pn < 10 ? qgain : kgain) + 32 * (fq >> 1) + 8 * (fq & 1);
#pragma unroll
        for (int ai = 0; ai < 2; ++ai) if (ai < nai)
#pragma unroll
            for (int m = 0; m < 4; ++m) { const int row = row0 + ai * HALF + m * 16; bf16_t* rowp = O + (size_t)row * ldc + col0;
                f32x4 x1[2] = {acc[ai][0][m][0], acc[ai][0][m][1]}, x2[2] = {acc[ai][1][m][0], acc[ai][1][m][1]};
                if (isrope) { const int t = row & (SEQ - 1); const int pos = (fq >> 1) ? (t & 63) : (t >> 6); const float* rp = rope + (size_t)(pos * 16 + 8 * (fq & 1)) * 2;
#pragma unroll
                    for (int n = 0; n < 2; ++n) { const f32x4 cs0 = *(const f32x4*)(rp + 8 * n), cs1 = *(const f32x4*)(rp + 8 * n + 4);
                        const f32x4 a1 = x1[n], a2 = x2[n];
                        x1[n] = (f32x4){a1[0] * cs0[0] - a2[0] * cs0[1], a1[1] * cs0[2] - a2[1] * cs0[3], a1[2] * cs1[0] - a2[2] * cs1[1], a1[3] * cs1[2] - a2[3] * cs1[3]};
                        x2[n] = (f32x4){a1[0] * cs0[1] + a2[0] * cs0[0], a1[1] * cs0[3] + a2[1] * cs0[2], a1[2] * cs1[1] + a2[2] * cs1[0], a1[3] * cs1[3] + a2[3] * cs1[2]}; } }
                if (isnorm) { float ss = 0.f;
#pragma unroll
                    for (int n = 0; n < 2; ++n) ss += (x1[n][0] * x1[n][0] + x1[n][1] * x1[n][1]) + (x1[n][2] * x1[n][2] + x1[n][3] * x1[n][3]) + (x2[n][0] * x2[n][0] + x2[n][1] * x2[n][1]) + (x2[n][2] * x2[n][2] + x2[n][3] * x2[n][3]);
                    ss = ::sum_g4(ss); const float rs = rsqrtf(ss * (1.0f / 64.0f) + 1e-6f);
#pragma unroll
                    for (int n = 0; n < 2; ++n) { x1[n] = x1[n] * rs * *(const f32x4*)(gp + 4 * n); x2[n] = x2[n] * rs * *(const f32x4*)(gp + 16 + 4 * n); } }
                u32x4 w1, w2;
                w1.x = cvt_pk_bf16(x1[0][0] * sc, x1[0][1] * sc); w1.y = cvt_pk_bf16(x1[0][2] * sc, x1[0][3] * sc); w1.z = cvt_pk_bf16(x1[1][0] * sc, x1[1][1] * sc); w1.w = cvt_pk_bf16(x1[1][2] * sc, x1[1][3] * sc);
                w2.x = cvt_pk_bf16(x2[0][0] * sc, x2[0][1] * sc); w2.y = cvt_pk_bf16(x2[0][2] * sc, x2[0][3] * sc); w2.z = cvt_pk_bf16(x2[1][0] * sc, x2[1][1] * sc); w2.w = cvt_pk_bf16(x2[1][2] * sc, x2[1][3] * sc);
                *(u32x4*)rowp = w1; *(u32x4*)(rowp + HALF) = w2;
                asm volatile("" ::: "memory"); }
    }
};
template <class Epi, class Sched, bool STAMP = false>
__device__ __forceinline__ void gemm_phase(PG8_LAS unsigned char* lds, const Gemm g, const Sched& S, const Epi& E, unsigned long long* stamps, int tid_in) {
    int tid_ = tid_in; asm volatile("" : "+v"(tid_)); const int tid = tid_, wid = __builtin_amdgcn_readfirstlane(tid >> 6), lane = tid & 63, wr = wid >> 2, wc = wid & 3, fr = lane & 15, fq = lane >> 4;
    const int K = g.K, nt = K / BK;
    int ts_lo = 0, ts_hi = 0, nts = 0; const unsigned long long rt_entry = STAMP ? (unsigned long long)wall_clock64() : 0ull;
#define PG8_STAMP() do { if (STAMP && wid == 0 && nts < 64) { const unsigned long long _c = (unsigned long long)clock64(); \
        ts_lo = (lane == nts) ? (int)(unsigned)_c : ts_lo; ts_hi = (lane == nts) ? (int)(unsigned)(_c >> 32) : ts_hi; ++nts; } } while (0)
    PG8_STAMP();
    unsigned voffB[2]; int stR[2]; unsigned stC[2];
#pragma unroll
    for (int i = 0; i < 2; ++i) { int R, C; stage_rc(tid * 16 + i * 8192, R, C); const int Rb = Epi::PERM ? ((R & ~31) + perm32(R & 31)) : R;
        stR[i] = R; stC[i] = (unsigned)C * 2u; voffB[i] = (unsigned)(Rb * K + C) * 2u; }
    unsigned vAc0[2], vAc1[2], vAn0[2], vAn1[2];
#define PG8_AROWS(u, d0, d1) do { _Pragma("unroll") for (int _i = 0; _i < 2; ++_i) { d0[_i] = S.arow(u, stR[_i]) * (unsigned)(K * 2) + stC[_i]; d1[_i] = S.arow(u, HALF + stR[_i]) * (unsigned)(K * 2) + stC[_i]; } } while (0)
    const size_t kstep = (size_t)(BK * 2);
    const size_t hstep = (size_t)HALF * K * 2;
    const size_t tstep = 2 * hstep;
    const unsigned ldsw = (unsigned)wid * 1024u;
    const int aoff = lds_byte(wr * 64 + fr, fq * 8), boff = lds_byte(wc * 32 + fr, fq * 8);
#define PG8_SA(b, h) (((b) * 2 + (h)) * HTB)
#define PG8_SB(b, h) ((4 + (b) * 2 + (h)) * HTB)
#define PG8_STAGE(bufoff, gbase, voff) do { _Pragma("unroll") for (int _i = 0; _i < 2; ++_i) \
        __builtin_amdgcn_global_load_lds((const unsigned*)((const char*)(gbase) + (voff)[_i]), (PG8_LAS unsigned*)(lds + (bufoff) + ldsw + _i * 8192), 16, 0, 0); } while (0)
#define PG8_LDA(dst, b, h) do { _Pragma("unroll") for (int m = 0; m < 4; ++m) _Pragma("unroll") for (int k = 0; k < 2; ++k) dst[m][k] = *(const PG8_LAS bf16x8*)(lds + PG8_SA(b, h) + aoff + m * 2048 + k * 1024); } while (0)
#define PG8_LDB(dst, b, h) do { _Pragma("unroll") for (int n = 0; n < 2; ++n) _Pragma("unroll") for (int k = 0; k < 2; ++k) dst[n][k] = *(const PG8_LAS bf16x8*)(lds + PG8_SB(b, h) + boff + n * 2048 + k * 1024); } while (0)
#define PG8_MMA(ai, bj, At, Bt) do { __builtin_amdgcn_s_setprio(1); _Pragma("unroll") for (int m = 0; m < 4; ++m) _Pragma("unroll") for (int n = 0; n < 2; ++n) _Pragma("unroll") for (int k = 0; k < 2; ++k) \
        acc[ai][bj][m][n] = __builtin_amdgcn_mfma_f32_16x16x32_bf16(Bt[n][k], At[m][k], acc[ai][bj][m][n], 0, 0, 0); __builtin_amdgcn_s_setprio(0); } while (0)
#define PG8_WAIT_V(n) asm volatile("s_waitcnt vmcnt(" #n ")" ::: "memory")
#define PG8_WAIT_L(n) asm volatile("s_waitcnt lgkmcnt(" #n ")" ::: "memory")
#define PG8_BAR __builtin_amdgcn_s_barrier()
#define PG8_SCHED __builtin_amdgcn_sched_barrier(0)
    Unit cur, nxt; int ui = 0;
    if (!S.next(0, cur)) return;
    f32x4 acc[2][2][4][2];
#pragma unroll
    for (int a = 0; a < 2; ++a)
#pragma unroll
        for (int b = 0; b < 2; ++b)
#pragma unroll
            for (int m = 0; m < 4; ++m)
#pragma unroll
                for (int n = 0; n < 2; ++n) acc[a][b][m][n] = (f32x4){0.f, 0.f, 0.f, 0.f};
    bf16x8 At[4][2], B0[2][2], B1[2][2];
    const char* const cA = (const char*)g.A; const char* cB = S.bbase(cur);
    PG8_AROWS(cur, vAc0, vAc1);
    S.a_ready(cur);
    PG8_STAGE(PG8_SB(0, 0), cB, voffB); PG8_STAGE(PG8_SA(0, 0), cA, vAc0); PG8_STAGE(PG8_SB(0, 1), cB + hstep, voffB); PG8_STAGE(PG8_SA(0, 1), cA, vAc1);
    if (wr == 1) PG8_BAR;
    PG8_WAIT_V(4); PG8_BAR;
    PG8_STAGE(PG8_SB(1, 0), cB + kstep, voffB); PG8_STAGE(PG8_SA(1, 0), cA + kstep, vAc0); PG8_STAGE(PG8_SB(1, 1), cB + hstep + kstep, voffB);
    PG8_WAIT_V(6); PG8_BAR;
    PG8_STAMP();
    for (;;) {
        const bool has_next = S.next(ui + 1, nxt);
        const char* nB = has_next ? S.bbase(nxt) : cB;
        if (has_next) PG8_AROWS(nxt, vAn0, vAn1); else { _Pragma("unroll") for (int _i = 0; _i < 2; ++_i) { vAn0[_i] = vAc0[_i]; vAn1[_i] = vAc1[_i]; } }
        const bool full = cur.hs < 0;
        for (int t = 0; t < nt; t += 2) {
            const bool last = (t == nt - 2);
            const char* a1 = cA + (size_t)(t + 1) * kstep;
            const char* a2 = last ? cA : cA + (size_t)(t + 2) * kstep; const char* b2 = last ? nB : cB + (size_t)(t + 2) * kstep;
            const char* a3 = a2 + kstep; const char* b3 = b2 + kstep;
            unsigned v20[2], v21[2];
#pragma unroll
            for (int _i = 0; _i < 2; ++_i) { v20[_i] = last ? vAn0[_i] : vAc0[_i]; v21[_i] = last ? vAn1[_i] : vAc1[_i]; }
            if (last && has_next) S.a_ready(nxt);
            PG8_LDB(B0, 0, 0); PG8_SCHED; PG8_LDA(At, 0, 0); PG8_STAGE(PG8_SA(1, 1), a1, vAc1);
            PG8_WAIT_L(8); PG8_BAR; PG8_WAIT_L(0); PG8_MMA(0, 0, At, B0); PG8_BAR; PG8_SCHED;
            PG8_LDB(B1, 0, 1); PG8_STAGE(PG8_SB(0, 0), b2, voffB);
            PG8_BAR; PG8_WAIT_L(0); PG8_MMA(0, 1, At, B1); PG8_BAR;
            if (full) PG8_LDA(At, 0, 1); PG8_STAGE(PG8_SA(0, 0), a2, v20);
            PG8_BAR; PG8_WAIT_L(0); if (full) PG8_MMA(1, 0, At, B0); PG8_BAR; PG8_SCHED;
            PG8_STAGE(PG8_SB(0, 1), b2 + hstep, voffB);
            PG8_WAIT_V(6); PG8_BAR; if (full) PG8_MMA(1, 1, At, B1); PG8_BAR;
            PG8_LDB(B0, 1, 0); PG8_SCHED; PG8_LDA(At, 1, 0); PG8_STAGE(PG8_SA(0, 1), a2, v21);
            PG8_WAIT_L(8); PG8_BAR; PG8_WAIT_L(0); PG8_MMA(0, 0, At, B0); PG8_BAR; PG8_SCHED;
            PG8_LDB(B1, 1, 1); PG8_STAGE(PG8_SB(1, 0), b3, voffB);
            PG8_BAR; PG8_WAIT_L(0); PG8_MMA(0, 1, At, B1); PG8_BAR;
            if (full) PG8_LDA(At, 1, 1); PG8_STAGE(PG8_SA(1, 0), a3, v20);
            PG8_BAR; PG8_WAIT_L(0); if (full) PG8_MMA(1, 0, At, B0); PG8_BAR; PG8_SCHED;
            PG8_STAGE(PG8_SB(1, 1), b3 + hstep, voffB);
            PG8_WAIT_V(6); PG8_BAR; if (full) PG8_MMA(1, 1, At, B1); PG8_BAR;
        }
        PG8_STAMP();
        if constexpr (!Epi::AFTER_DRAIN) { E(acc, cur, wr, wc, fr, fq); S.done(cur); }
        PG8_STAMP();
        if (!has_next) break;
#pragma unroll
        for (int a = 0; a < 2; ++a)
#pragma unroll
            for (int b = 0; b < 2; ++b)
#pragma unroll
                for (int m = 0; m < 4; ++m)
#pragma unroll
                    for (int n = 0; n < 2; ++n) acc[a][b][m][n] = (f32x4){0.f, 0.f, 0.f, 0.f};
        cur = nxt; cB = nB; ++ui;
#pragma unroll
        for (int _i = 0; _i < 2; ++_i) { vAc0[_i] = vAn0[_i]; vAc1[_i] = vAn1[_i]; }
    }
    PG8_WAIT_V(0);
    if (wr == 0) PG8_BAR;
    PG8_BAR;
    if constexpr (Epi::AFTER_DRAIN) { E.fused(acc, cur, wr, wc, fr, fq, lds, wid, lane); S.done(cur); }
    PG8_STAMP();
    if (STAMP && wid == 0) { stamps[lane] = lane < nts ? (((unsigned long long)(unsigned)ts_hi << 32) | (unsigned)ts_lo) : 0ull;
        if (lane == 62) stamps[62] = rt_entry; if (lane == 63) stamps[63] = (unsigned long long)wall_clock64(); }
#undef PG8_STAMP
#undef PG8_SA
#undef PG8_AROWS
#undef PG8_SB
#undef PG8_STAGE
#undef PG8_LDA
#undef PG8_LDB
#undef PG8_MMA
#undef PG8_WAIT_V
#undef PG8_WAIT_L
#undef PG8_BAR
#undef PG8_SCHED
}
}
#define XB_TMO      128
#define XB_XCNT(j)  (256  + 64 * (j))
#define XB_XSUB(j)  (1280 + 64 * (j))
#define XB_XGEN(j)  (2304 + 64 * (j))
#define XB_TOP      3328
#define XB_TOPGEN   3392
#define XCD_BAR_WORDS 3456
#define XB_SPIN_CAP (1u << 24)

__device__ __forceinline__ unsigned xb_ld(unsigned* p)              { return __hip_atomic_load(p, __ATOMIC_RELAXED, __HIP_MEMORY_SCOPE_AGENT); }
__device__ __forceinline__ unsigned xb_add(unsigned* p, unsigned v) { return __hip_atomic_fetch_add(p, v, __ATOMIC_RELAXED, __HIP_MEMORY_SCOPE_AGENT); }
__device__ __forceinline__ unsigned xb_xcc_id() { return (unsigned)__builtin_amdgcn_s_getreg((3 << 11) | 20) & 0xFu; }
#define XB_SPIN(cond, bar) do { unsigned _sp = 0; while (cond) { __builtin_amdgcn_s_sleep(1); \
    if ((++_sp & 255u) == 0u) { if (xb_ld(&(bar)[XB_TMO])) break; if (_sp > XB_SPIN_CAP) { atomicAdd(&(bar)[XB_TMO], 1u); break; } } } } while (0)

struct XcdBarrier {
    unsigned* bar; unsigned x;
    volatile LAS unsigned* st;
};

__device__ __forceinline__ XcdBarrier xcd_barrier_post(unsigned* bar, volatile LAS unsigned* st) {
    XcdBarrier b; b.bar = bar; b.x = xb_xcc_id(); b.st = st;
    if (threadIdx.x == 0) (void)xb_add(&bar[XB_XCNT(b.x)], 1u);
    return b;
}
__device__ __forceinline__ void xcd_barrier_complete(unsigned* bar, unsigned x, unsigned& nloc, unsigned& nx) {
    const unsigned G = gridDim.x * gridDim.y * gridDim.z;
    unsigned sum, cnt, mine, sp = 0u;
    for (;;) {
        sum = 0u; cnt = 0u; mine = 0u;
#pragma unroll
        for (unsigned j = 0; j < 16; ++j) { const unsigned c = xb_ld(&bar[XB_XCNT(j)]); sum += c; cnt += (c > 0u) ? 1u : 0u; mine = (j == x) ? c : mine; }
        if (sum == G) break;
        __builtin_amdgcn_s_sleep(1);
        if ((++sp & 255u) == 0u) { if (xb_ld(&bar[XB_TMO])) break; if (sp > XB_SPIN_CAP) { atomicAdd(&bar[XB_TMO], 1u); break; } }
    }
    nloc = mine > 0u ? mine : 1u; nx = cnt > 0u ? cnt : 1u;
}

__device__ __forceinline__ void xcd_barrier(const XcdBarrier& b) {
    asm volatile("s_waitcnt vmcnt(0)" ::: "memory");
    __syncthreads();
    if (threadIdx.x == 0) {
        unsigned* bar = b.bar;
        __builtin_amdgcn_s_waitcnt(0);
        unsigned nloc = b.st[0], nx = b.st[1];
        if (nloc == 0u) { xcd_barrier_complete(bar, b.x, nloc, nx); b.st[0] = nloc; b.st[1] = nx; }
        const unsigned old = xb_add(&bar[XB_XSUB(b.x)], 1u);
        const unsigned gen = old / nloc;
        if (old + 1u == (gen + 1u) * nloc) {
            __builtin_amdgcn_fence(__ATOMIC_RELEASE, "agent");
            asm volatile("s_waitcnt vmcnt(0)" ::: "memory");
            const unsigned og = xb_add(&bar[XB_TOP], 1u);
            const unsigned tg = og / nx;
            if (og + 1u == (tg + 1u) * nx) xb_add(&bar[XB_TOPGEN], 1u);
            else XB_SPIN(xb_ld(&bar[XB_TOPGEN]) == tg, bar);
            __builtin_amdgcn_fence(__ATOMIC_ACQUIRE, "agent");
            xb_add(&bar[XB_XGEN(b.x)], 1u);
            asm volatile("s_waitcnt vmcnt(0)" ::: "memory");
        } else {
            XB_SPIN(xb_ld(&bar[XB_XGEN(b.x)]) == gen, bar);
            __builtin_amdgcn_fence(__ATOMIC_ACQUIRE, "agent");
            asm volatile("s_waitcnt vmcnt(0)" ::: "memory");
        }
    }
    __syncthreads();
}

constexpr int SCR_BYTES = 139264;
constexpr int MISC_OFF = SCR_BYTES;
constexpr int LDS_BYTES = 147456;
constexpr int CW_BAR = 4096;
constexpr int NTHR = 512, NWAVES = 8;
constexpr int CW_MOE = 8192;

__device__ __forceinline__ void transpose_item(const float* W, int ldw, int col0, int K, bf16_t* WT, int drow0, int kb, LAS float* scr, int lane, int gap16 = 0) {
    const int k0 = 64 * kb; const int cs = col0 + (lane & 31) + ((lane & 16) ? gap16 : 0);
#pragma unroll 8
    for (int i = 0; i < 32; ++i) { const int kk = 2 * i + (lane >> 5); scr[kk * 33 + (lane & 31)] = W[(size_t)(k0 + kk) * ldw + cs]; }
    asm volatile("s_waitcnt lgkmcnt(0)" ::: "memory");
    const int c = lane & 7;
#pragma unroll
    for (int j = 0; j < 4; ++j) { const int n = (lane >> 3) + 8 * j; const LAS float* s = scr + (8 * c) * 33 + n;
        u32x4 o; o.x = pk2(s[0 * 33], s[1 * 33]); o.y = pk2(s[2 * 33], s[3 * 33]); o.z = pk2(s[4 * 33], s[5 * 33]); o.w = pk2(s[6 * 33], s[7 * 33]);
        *(u32x4*)(WT + (size_t)(drow0 + n) * K + k0 + 8 * c) = o; }
    asm volatile("s_waitcnt lgkmcnt(0)" ::: "memory");
}
__device__ __forceinline__ void up_item(const float* wg, const float* wu, bf16_t* WT, int it, LAS float* scr, int lane) {
    const int nb = it >> 4, kb = it & 15, r0 = 32 * nb, pn = r0 >> 8, p = r0 & 255;
    transpose_item(p < 128 ? wg : wu, DFF, 128 * pn + (p & 127), DM, WT, r0, kb, scr, lane);
}
__device__ __forceinline__ void dn_item(const float* wd, bf16_t* WT, int it, LAS float* scr, int lane) {
    const int nb = it / 44, kb = it % 44;
    transpose_item(wd, DM, 32 * nb, DFF, WT, 32 * nb, kb, scr, lane);
}
constexpr int IT_IN = 112 * 16, IT_OUT = 32 * 16, IT_UP = 176 * 16, IT_DN = 32 * 44;
constexpr int IT_TOTAL = 2 * IT_IN + 2 * IT_OUT + IT_UP + IT_DN + NEXP * (IT_UP + IT_DN);

__device__ __forceinline__ void phase_prologue(const Args& a, LAS unsigned char* lds, int tid, int lane, int wave, int bid, int G) {
    unsigned char* ws = a.ws;
    {
        LAS float* scr = (LAS float*)(lds + wave * 8704);
        const int gw = bid * NWAVES + wave, NGW = G * NWAVES;
        for (int it0 = gw; it0 < IT_TOTAL; it0 += NGW) {
            int it = it0;
            if (it < 2 * IT_IN) { const int l = it / IT_IN; it -= l * IT_IN; const int nb = it >> 4, kb = it & 15, r0 = 32 * nb;
                const int pn = r0 >> 8, p = r0 & 255; const bool hl = pn < 2 || (pn >= 8 && pn < 12);
                const int cbase = (pn < 8 ? 256 * pn : 256 * pn + 16);
                const int col0 = hl ? cbase + 64 * ((p >> 5) & 3) + 16 * (p >> 7) : cbase + p;
                transpose_item(a.in[8] + (size_t)l * DM * DIN, DIN, col0, DM, (bf16_t*)(ws + WS_WTIN) + (size_t)l * NPW * DM, r0, kb, scr, lane, hl ? 16 : 0); continue; }
            it -= 2 * IT_IN;
            if (it < 2 * IT_OUT) { const int l = it / IT_OUT; it -= l * IT_OUT; const int nb = it >> 4, kb = it & 15;
                transpose_item(a.in[16] + (size_t)l * DM * DM, DM, 32 * nb, DM, (bf16_t*)(ws + WS_WTOUT) + (size_t)l * DM * DM, 32 * nb, kb, scr, lane); continue; }
            it -= 2 * IT_OUT;
            if (it < IT_UP) { up_item(a.in[17], a.in[18], (bf16_t*)(ws + WS_WTUP), it, scr, lane); continue; }
            it -= IT_UP;
            if (it < IT_DN) { dn_item(a.in[19], (bf16_t*)(ws + WS_WTDN), it, scr, lane); continue; }
            it -= IT_DN;
            if (it < NEXP * IT_UP) { const int e = it / IT_UP; it -= e * IT_UP;
                up_item(a.in[21] + (size_t)e * DM * DFF, a.in[22] + (size_t)e * DM * DFF, (bf16_t*)(ws + WS_WTMUP) + (size_t)e * NUP * DM, it, scr, lane); continue; }
            it -= NEXP * IT_UP;
            { const int e = it / IT_DN; it -= e * IT_DN; dn_item(a.in[23] + (size_t)e * DFF * DM, (bf16_t*)(ws + WS_WTMDN) + (size_t)e * DM * DFF, it, scr, lane); }
        }
    }
    __syncthreads();
    {
        const int gt = bid * NTHR + tid;
        if (gt < 1024) { const int pos = gt >> 4, i = gt & 15;
            double inv = 1.0; for (int q = 0; q < i; ++q) inv *= 0.56234132519034908;
            const float angf = (float)pos * (float)inv; const double ang = (double)angf;
            const double kq = rint(ang * 0.63661977236758134); const double r = ang - kq * 1.5707963267948966 - kq * 6.123233995736766e-17; const double r2 = r * r;
            double sn = r * (1.0 + r2 * (-1.0 / 6 + r2 * (1.0 / 120 + r2 * (-1.0 / 5040 + r2 * (1.0 / 362880 + r2 * (-1.0 / 39916800 + r2 * (1.0 / 6227020800.0)))))));
            double cs = 1.0 + r2 * (-0.5 + r2 * (1.0 / 24 + r2 * (-1.0 / 720 + r2 * (1.0 / 40320 + r2 * (-1.0 / 3628800 + r2 * (1.0 / 479001600.0 + r2 * (-1.0 / 87178291200.0)))))));
            const int kk = ((int)kq) & 3; double c2, s2;
            if (kk == 0) { c2 = cs; s2 = sn; } else if (kk == 1) { c2 = -sn; s2 = cs; } else if (kk == 2) { c2 = -cs; s2 = -sn; } else { c2 = sn; s2 = -cs; }
            float* R = (float*)(ws + WS_ROPE); R[gt * 2] = (float)c2; R[gt * 2 + 1] = (float)s2; }
    }
    {
        LAS float* sc = (LAS float*)(lds + 73728);
        LAS float* red = (LAS float*)(lds + 73728 + 36864);
        for (int i = tid; i < 9 * 1024; i += NTHR) { const float v = i < 8192 ? a.in[1][i] : a.in[3][i - 8192]; sc[i] = v / (1.0f + __expf(-v)); }
        __syncthreads();
        for (int item = bid; item < 192; item += G) {
            const int l = item / 96, n0 = (item % 96) * 64;
            const float* wm = a.in[6] + (size_t)l * DM * 6144 + n0 + lane;
            float acc[9];
#pragma unroll
            for (int b = 0; b < 9; ++b) acc[b] = 0.f;
#pragma unroll 4
            for (int kk = 0; kk < 128; ++kk) { const int k = wave * 128 + kk; const float w = wm[(size_t)k * 6144];
#pragma unroll
                for (int b = 0; b < 9; ++b) acc[b] += sc[b * 1024 + k] * w; }
#pragma unroll
            for (int b = 0; b < 9; ++b) red[(wave * 9 + b) * 64 + lane] = acc[b];
            __syncthreads();
            for (int o = tid; o < 576; o += NTHR) { const int b = o >> 6, ln = o & 63; float s = a.in[7][(size_t)l * 6144 + n0 + ln];
#pragma unroll
                for (int w = 0; w < 8; ++w) s += red[(w * 9 + b) * 64 + ln];
                ((float*)(ws + WS_MOD))[((size_t)l * 9 + b) * 6144 + n0 + ln] = s; }
            __syncthreads();
        }
    }
}

template <int MODE>
__device__ __forceinline__ void phase_norm(const Args& a, int l, LAS unsigned char* lds, int tid, int lane, int wave, int bid, int G) {
    unsigned char* ws = a.ws;
    LAS float* WT = (LAS float*)lds;
    if (MODE == 0) { const float* w = a.in[8] + (size_t)l * DM * DIN + 2048; for (int i = tid; i < 16384; i += NTHR) { const int k = i >> 4, j = i & 15; WT[j * 1024 + k] = w[(size_t)k * DIN + j]; } __syncthreads(); }
    if (MODE == 2) { const float* w = a.in[20]; for (int i = tid; i < 8192; i += NTHR) { const int k = i >> 3, j = i & 7; WT[j * 1024 + k] = w[(size_t)k * 8 + j]; } __syncthreads(); }
    const float* gam = (MODE == 0 ? a.in[4] : a.in[5]) + (size_t)l * DM;
    const float* mod = (const float*)(ws + WS_MOD) + (size_t)l * 9 * 6144;
    const int shoff = MODE == 0 ? 0 : 3072, soff = MODE == 0 ? 1024 : 4096;
    const int nrows = (MODE == 2) ? NLAT : MALL;
    bf16_t* H = (bf16_t*)(ws + WS_H);
    int nrec = 0;
    for (int r = bid * NWAVES + wave; r < nrows; r += G * NWAVES) {
        const bool lat = r < NLAT; const int bi = lat ? (r >> 11) : 8;
        const float* src = (MODE == 0 && l == 0) ? (lat ? a.in[0] + (size_t)r * DM : a.in[2] + (size_t)(r - NLAT) * DM)
                                    : (lat ? a.out + (size_t)r * DM : (const float*)(ws + WS_XC) + (size_t)(r - NLAT) * DM);
        f32x4 v[4]; float ss = 0.f;
#pragma unroll
        for (int j = 0; j < 4; ++j) { v[j] = *(const f32x4*)(src + 4 * lane + 256 * j); ss += (v[j].x * v[j].x + v[j].y * v[j].y) + (v[j].z * v[j].z + v[j].w * v[j].w); }
        const float rstd = rsqrtf(wave_sum(ss) * (1.0f / DM) + EPS);
        const float* mrow = mod + (size_t)bi * 6144;
#pragma unroll
        for (int j = 0; j < 4; ++j) { const int k = 4 * lane + 256 * j;
            const f32x4 g = *(const f32x4*)(gam + k), s = *(const f32x4*)(mrow + soff + k), sh = *(const f32x4*)(mrow + shoff + k);
            v[j] = v[j] * rstd * g * (1.0f + s) + sh;
            u32x2 w; w.x = pk2(v[j].x, v[j].y); w.y = pk2(v[j].z, v[j].w);
            *(u32x2*)(H + (size_t)r * DM + k) = w; }
        if (MODE == 0) {
            float p[16];
#pragma unroll
            for (int jg = 0; jg < 16; ++jg) p[jg] = 0.f;
#pragma unroll
            for (int jg = 0; jg < 16; ++jg) {
#pragma unroll
                for (int j = 0; j < 4; ++j) { const f32x4 w = *(const LAS f32x4*)(WT + jg * 1024 + 4 * lane + 256 * j); p[jg] += (v[j].x * w.x + v[j].y * w.y) + (v[j].z * w.z + v[j].w * w.w); }
                if ((jg & 3) == 3) asm volatile("" ::: "memory"); }
            const float tot = reduce16_lanes(p, lane);
            const int gid = ((lane >> 5) & 1) * 8 + ((lane >> 4) & 1) * 4 + ((lane >> 3) & 1) * 2 + ((lane >> 2) & 1);
            if ((lane & 3) == 0) ((float*)(ws + WS_GATES))[(size_t)r * 16 + gid] = tot + a.in[12][l * 16 + gid];
        }
        if (MODE == 2) {
            float p[8];
#pragma unroll
            for (int e = 0; e < 8; ++e) p[e] = 0.f;
#pragma unroll
            for (int e = 0; e < 8; ++e) {
#pragma unroll
                for (int j = 0; j < 4; ++j) { const f32x4 w = *(const LAS f32x4*)(WT + e * 1024 + 4 * lane + 256 * j); p[e] += (v[j].x * w.x + v[j].y * w.y) + (v[j].z * w.z + v[j].w * w.w); }
                if ((e & 3) == 3) asm volatile("" ::: "memory"); }
            const float tot = reduce8_lanes(p, lane);
            int i1 = 0, i2 = 0; float v1 = -3.0e38f, v2 = -3.0e38f;
#pragma unroll
            for (int e = 0; e < 8; ++e) { const float s = lane_bcast(tot, 32 * (e >> 2) + 16 * ((e >> 1) & 1) + 8 * (e & 1));
                if (s > v1) { v2 = v1; i2 = i1; v1 = s; i1 = e; } else if (s > v2) { v2 = s; i2 = e; } }
            const float w2 = 1.0f / (1.0f + __expf(v1 - v2)), w1 = 1.0f - w2;
            if (lane == 0) { LAS int* rec = (LAS int*)(lds + 32768) + nrec * 32 + wave * 4; rec[0] = i1; rec[1] = i2; rec[2] = __float_as_int(w1); rec[3] = __float_as_int(w2); }
            ++nrec;
        }
    }
    if (MODE == 2) {
        __syncthreads();
        if (tid < 8) {
            const int e = tid; const LAS int* rec = (const LAS int*)(lds + 32768); int cnt = 0;
            const int nk = (nrows - bid * NWAVES + G * NWAVES - 1) / (G * NWAVES);
            for (int k = 0; k < nk; ++k) for (int w = 0; w < NWAVES; ++w) { const int r = bid * NWAVES + w + k * G * NWAVES; if (r < nrows) { const LAS int* q = rec + k * 32 + w * 4; cnt += (q[0] == e) + (q[1] == e); } }
            int pos = (int)atomicAdd((unsigned*)(ws + WS_CTL) + CW_MOE + 64 * e, (unsigned)cnt);
            int* LIST = (int*)(ws + WS_LIST) + e * NLAT; int* TOK = (int*)(ws + WS_COMB);
            for (int k = 0; k < nk; ++k) for (int w = 0; w < NWAVES; ++w) { const int r = bid * NWAVES + w + k * G * NWAVES; if (r < nrows) { const LAS int* q = rec + k * 32 + w * 4;
                if (q[0] == e) { LIST[pos] = r; TOK[r * 8 + 0] = e; TOK[r * 8 + 2] = pos; TOK[r * 8 + 4] = q[2]; ++pos; }
                if (q[1] == e) { LIST[pos] = r; TOK[r * 8 + 1] = e; TOK[r * 8 + 3] = pos; TOK[r * 8 + 5] = q[3]; ++pos; } } }
        }
    }
}

__device__ __forceinline__ void phase_post(const Args& a, int l, int lane, int wave, int bid, int G) {
    unsigned char* ws = a.ws;
    bf16_t* P = (bf16_t*)(ws + WS_BIG); bf16_t* MQK = (bf16_t*)(ws + WS_MQK);
    const float* ROPE = (const float*)(ws + WS_ROPE);
    const float* cw = a.in[10] + (size_t)l * 3 * 512; const float* cb = a.in[11] + (size_t)l * 512;
    const float qg = a.in[13][l * 64 + lane], kg = a.in[14][l * 64 + lane];
    for (int r = bid * NWAVES + wave; r < MALL; r += G * NWAVES) {
        const bool lat = r < NLAT; bf16_t* row = P + (size_t)r * NPW;
        int t, tlen; if (lat) { t = r & (SEQ - 1); tlen = SEQ; } else { t = (r - NLAT) & (CTXL - 1); tlen = CTXL; }
        if (lat) { const int gr = t >> 6, gc = t & 63;
#pragma unroll
            for (int blk = 0; blk < 2; ++blk)
#pragma unroll
                for (int ii = 0; ii < 2; ++ii) { const int pid = lane + 64 * ii, head = pid >> 5, half = (pid >> 4) & 1, i = pid & 15, c1 = (blk ? PC_RK : PC_RQ) + head * 64 + half * 32 + i;
                    const int pos = half ? gc : gr; const float cs = ROPE[(pos * 16 + i) * 2], sn = ROPE[(pos * 16 + i) * 2 + 1];
                    const float x1 = bf2f(row[c1]), x2 = bf2f(row[c1 + 16]); const float sc = blk ? 0.125f : 1.0f;
                    row[c1] = (bf16_t)f2bf((x1 * cs - x2 * sn) * sc); row[c1 + 16] = (bf16_t)f2bf((x1 * sn + x2 * cs) * sc); }
        } else {
#pragma unroll
            for (int ii = 0; ii < 4; ++ii) { const int c = PC_RK + lane + 64 * ii; row[c] = (bf16_t)f2bf(bf2f(row[c]) * 0.125f); }
        }
#pragma unroll
        for (int ii = 0; ii < 8; ++ii) { const int c = lane + 64 * ii;
            const float x0 = bf2f(row[PC_MQ + c]);
            const float xm = t > 0 ? bf2f(row[PC_MQ + c - NPW]) : 0.f, xp = t < tlen - 1 ? bf2f(row[PC_MQ + c + NPW]) : 0.f;
            float y = cb[c] + cw[c] * xm + cw[512 + c] * x0 + cw[1024 + c] * xp;
            y = y / (1.0f + __expf(-y)); if (c >= 256) y *= 0.125f;
            MQK[(size_t)r * 512 + c] = (bf16_t)f2bf(y); }
#pragma unroll
        for (int hh = 0; hh < 16; ++hh) { const int c = PC_NQ + hh * 64 + lane; const float v = bf2f(row[c]);
            const float rs = rsqrtf(wave_sum(v * v) * (1.0f / 64.0f) + EPS);
            row[c] = (bf16_t)f2bf(v * rs * (hh < 8 ? qg : kg)); }
    }
}


typedef short bf16x8 __attribute__((ext_vector_type(8)));
typedef short s16x4 __attribute__((ext_vector_type(4)));
constexpr int IST = 160;
__device__ __forceinline__ f32x4 mfma16(bf16x8 a, bf16x8 b, f32x4 c) { return __builtin_amdgcn_mfma_f32_16x16x32_bf16(a, b, c, 0, 0, 0); }
__device__ __forceinline__ bf16x8 frag_row(LAS const unsigned char* img, int row0, int k0, int lane) {
    return *(const LAS bf16x8*)(img + (row0 + (lane & 15)) * IST + (k0 + 8 * (lane >> 4)) * 2);
}
template <bool PERMK>
__device__ __forceinline__ bf16x8 frag_tr(LAS const unsigned char* img, int r0, int c0, int lane) {
    const int g = lane >> 4, i = lane & 15, q = i >> 2, p = i & 3;
    const unsigned addr = (unsigned)(size_t)(img + (r0 + (PERMK ? 4 : 8) * g + q) * IST + (c0 + 4 * p) * 2);
    s16x4 lo, hi;
    if (PERMK) asm volatile("ds_read_b64_tr_b16 %0, %2\n\tds_read_b64_tr_b16 %1, %2 offset:2560\n\ts_waitcnt lgkmcnt(0)" : "=&v"(lo), "=&v"(hi) : "v"(addr) : "memory");
    else       asm volatile("ds_read_b64_tr_b16 %0, %2\n\tds_read_b64_tr_b16 %1, %2 offset:640\n\ts_waitcnt lgkmcnt(0)" : "=&v"(lo), "=&v"(hi) : "v"(addr) : "memory");
    bf16x8 r; r[0] = lo[0]; r[1] = lo[1]; r[2] = lo[2]; r[3] = lo[3]; r[4] = hi[0]; r[5] = hi[1]; r[6] = hi[2]; r[7] = hi[3];
    return r;
}
template <bool PERMK>
__device__ __forceinline__ void frag_tr_x4(LAS const unsigned char* img, int r0, int c0, int lane, bf16x8 (&out)[4]) {
    const int g = lane >> 4, i = lane & 15, q = i >> 2, p = i & 3;
    const unsigned addr = (unsigned)(size_t)(img + (r0 + (PERMK ? 4 : 8) * g + q) * IST + (c0 + 4 * p) * 2);
    s16x4 l0, h0, l1, h1, l2, h2, l3, h3;
    if (PERMK) asm volatile("ds_read_b64_tr_b16 %0, %8\n\tds_read_b64_tr_b16 %1, %8 offset:2560\n\tds_read_b64_tr_b16 %2, %8 offset:32\n\tds_read_b64_tr_b16 %3, %8 offset:2592\n\t"
                            "ds_read_b64_tr_b16 %4, %8 offset:64\n\tds_read_b64_tr_b16 %5, %8 offset:2624\n\tds_read_b64_tr_b16 %6, %8 offset:96\n\tds_read_b64_tr_b16 %7, %8 offset:2656\n\ts_waitcnt lgkmcnt(0)"
                            : "=&v"(l0), "=&v"(h0), "=&v"(l1), "=&v"(h1), "=&v"(l2), "=&v"(h2), "=&v"(l3), "=&v"(h3) : "v"(addr) : "memory");
    else       asm volatile("ds_read_b64_tr_b16 %0, %8\n\tds_read_b64_tr_b16 %1, %8 offset:640\n\tds_read_b64_tr_b16 %2, %8 offset:32\n\tds_read_b64_tr_b16 %3, %8 offset:672\n\t"
                            "ds_read_b64_tr_b16 %4, %8 offset:64\n\tds_read_b64_tr_b16 %5, %8 offset:704\n\tds_read_b64_tr_b16 %6, %8 offset:96\n\tds_read_b64_tr_b16 %7, %8 offset:736\n\ts_waitcnt lgkmcnt(0)"
                            : "=&v"(l0), "=&v"(h0), "=&v"(l1), "=&v"(h1), "=&v"(l2), "=&v"(h2), "=&v"(l3), "=&v"(h3) : "v"(addr) : "memory");
#define FT_PACK(o, lo, hi) o[0] = lo[0]; o[1] = lo[1]; o[2] = lo[2]; o[3] = lo[3]; o[4] = hi[0]; o[5] = hi[1]; o[6] = hi[2]; o[7] = hi[3];
    FT_PACK(out[0], l0, h0) FT_PACK(out[1], l1, h1) FT_PACK(out[2], l2, h2) FT_PACK(out[3], l3, h3)
#undef FT_PACK
}
__device__ __forceinline__ bf16x8 pack8(f32x4 a, f32x4 b) {
    union { u32x4 u; bf16x8 v; } x; x.u.x = pk2(a[0], a[1]); x.u.y = pk2(a[2], a[3]); x.u.z = pk2(b[0], b[1]); x.u.w = pk2(b[2], b[3]); return x.v;
}
__device__ __forceinline__ int hl_off(int hl, int c) { return c < 32 ? 32 * hl + c : 128 + 32 * hl + (c - 32); }
__device__ __forceinline__ u32x4 conv8_pack(const bf16_t* P, int row, int ch, bool hasm, bool hasp, const LAS float* CW) {
    const bf16_t* src = P + (size_t)row * NPW + PC_MQ + ch;
    const u32x4 x0 = *(const u32x4*)src; u32x4 xm = {0u, 0u, 0u, 0u}, xp = xm;
    if (hasm) xm = *(const u32x4*)(src - NPW);
    if (hasp) xp = *(const u32x4*)(src + NPW);
    const f32x4 w0a = *(const LAS f32x4*)(CW + ch), w0b = *(const LAS f32x4*)(CW + ch + 4), w1a = *(const LAS f32x4*)(CW + 512 + ch), w1b = *(const LAS f32x4*)(CW + 512 + ch + 4);
    const f32x4 w2a = *(const LAS f32x4*)(CW + 1024 + ch), w2b = *(const LAS f32x4*)(CW + 1024 + ch + 4), ba = *(const LAS f32x4*)(CW + 1536 + ch), bb = *(const LAS f32x4*)(CW + 1536 + ch + 4);
    float y[8];
    y[0] = ba[0] + w0a[0] * bflo(xm.x) + w1a[0] * bflo(x0.x) + w2a[0] * bflo(xp.x); y[1] = ba[1] + w0a[1] * bfhi(xm.x) + w1a[1] * bfhi(x0.x) + w2a[1] * bfhi(xp.x);
    y[2] = ba[2] + w0a[2] * bflo(xm.y) + w1a[2] * bflo(x0.y) + w2a[2] * bflo(xp.y); y[3] = ba[3] + w0a[3] * bfhi(xm.y) + w1a[3] * bfhi(x0.y) + w2a[3] * bfhi(xp.y);
    y[4] = bb[0] + w0b[0] * bflo(xm.z) + w1b[0] * bflo(x0.z) + w2b[0] * bflo(xp.z); y[5] = bb[1] + w0b[1] * bfhi(xm.z) + w1b[1] * bfhi(x0.z) + w2b[1] * bfhi(xp.z);
    y[6] = bb[2] + w0b[2] * bflo(xm.w) + w1b[2] * bflo(x0.w) + w2b[2] * bflo(xp.w); y[7] = bb[3] + w0b[3] * bfhi(xm.w) + w1b[3] * bfhi(x0.w) + w2b[3] * bfhi(xp.w);
    const float sc = ch >= 256 ? 0.125f : 1.0f;
#pragma unroll
    for (int j = 0; j < 8; ++j) y[j] = y[j] / (1.0f + __expf(-y[j])) * sc;
    u32x4 o; o.x = pk2(y[0], y[1]); o.y = pk2(y[2], y[3]); o.z = pk2(y[4], y[5]); o.w = pk2(y[6], y[7]); return o;
}
__device__ __forceinline__ void conv_weights_to_lds(const Args& a, int l, LAS float* CW, int tid) {
    for (int i = tid; i < 2048; i += NTHR) CW[i] = i < 1536 ? a.in[10][(size_t)l * 1536 + i] : a.in[11][(size_t)l * 512 + (i - 1536)];
}
__device__ __forceinline__ int chunk_row0(int b, int dir, int sc) {
    if (dir == 0) return sc < 2 ? NLAT + b * CTXL + 128 * sc : b * SEQ + 128 * (sc - 2);
    return sc < 2 ? NLAT + b * CTXL + 128 * (1 - sc) : b * SEQ + 128 * (17 - sc);
}
constexpr size_t U_BYTES = 80 * 64 * 2;

__device__ __forceinline__ void phase_chunk_sums(const Args& a, int l, LAS unsigned char* lds, int tid, int lane, int wave, int bid, int G) {
    unsigned char* ws = a.ws;
    const bf16_t* P = (const bf16_t*)(ws + WS_BIG);
    const float* GT = (const float*)(ws + WS_GATES);
    LAS float* CW = (LAS float*)(lds + 49152); conv_weights_to_lds(a, l, CW, tid);
    LAS unsigned char* Kimg = lds;
    LAS unsigned char* Vimg = lds + 128 * IST;
    LAS float* wk = (LAS float*)(lds + 256 * IST);
    LAS float* red = wk + 128;
    const int nitems = 2 * NB * 4 * 2 * 18;
    for (int it = bid; it < nitems; it += G) {
        const int sc = it % 18; int r_ = it / 18; const int dir = r_ & 1; r_ >>= 1; const int h = r_ & 3; r_ >>= 2; const int b = r_ & 7; const int kind = r_ >> 3;
        const int row0 = chunk_row0(b, dir, sc);
        __syncthreads();
        if (kind == 0) { if (tid < 128) { const float lg = logsigmoidf_(a.in[9][(l * 2 + dir) * 4 + h]); wk[tid] = __expf(lg * (float)(dir == 0 ? 127 - tid : tid)); } }
        else if (wave == 0) {
            const float g0i = GT[(size_t)(row0 + lane) * 16 + 4 * dir + h], g1i = GT[(size_t)(row0 + 64 + lane) * 16 + 4 * dir + h];
            const float f0 = logsigmoidf_(GT[(size_t)(row0 + lane) * 16 + 8 + 4 * dir + h]), f1 = logsigmoidf_(GT[(size_t)(row0 + 64 + lane) * 16 + 8 + 4 * dir + h]);
            float s0 = f0, s1 = f1;
#pragma unroll
            for (int o = 1; o < 64; o <<= 1) { const int sl = lane >= o ? lane - o : lane; const float u0 = lane_get(s0, sl), u1 = lane_get(s1, sl); if (lane >= o) { s0 += u0; s1 += u1; } }
            const float t0 = lane_bcast(s0, 63), t1 = lane_bcast(s1, 63), tot = t0 + t1;
            float b0, b1;
            if (dir == 0) { b0 = s0; b1 = t0 + s1; } else { b0 = tot - s0 + f0; b1 = t1 - s1 + f1; }
            const float a0 = g0i - b0, a1 = g1i - b1; const float amax = wave_max(fmaxf(a0, a1));
            wk[lane] = __expf(a0 - amax); wk[lane + 64] = __expf(a1 - amax);
            if (lane == 0) { float* usc = (float*)(ws + WS_USC) + ((size_t)((b * 4 + h) * 2 + dir) * 18 + sc) * 2; usc[0] = tot; usc[1] = amax; }
        }
        __syncthreads();
        {
            const int r = tid >> 2, c8 = (tid & 3) * 16;
            const bf16_t* vsrc = P + (size_t)(row0 + r) * NPW + (kind == 0 ? PC_RV : PC_MV) + h * 64 + c8;
            u32x4 k0, k1;
            if (kind == 0) { const bf16_t* ksrc = P + (size_t)(row0 + r) * NPW + PC_RK + hl_off(h, c8); k0 = *(const u32x4*)ksrc; k1 = *(const u32x4*)(ksrc + 8); }
            else { const int t = (sc < 2 ? 128 * (dir == 0 ? sc : 1 - sc) : 128 * (dir == 0 ? sc - 2 : 17 - sc)) + r; const bool hasm = t > 0, hasp = t < (sc < 2 ? CTXL : SEQ) - 1;
                k0 = conv8_pack(P, row0 + r, 256 + h * 64 + c8, hasm, hasp, CW); k1 = conv8_pack(P, row0 + r, 256 + h * 64 + c8 + 8, hasm, hasp, CW); }
            const u32x4 v0 = *(const u32x4*)vsrc, v1 = *(const u32x4*)(vsrc + 8);
            *(LAS u32x4*)(Kimg + r * IST + c8 * 2) = k0; *(LAS u32x4*)(Kimg + r * IST + c8 * 2 + 16) = k1;
            const float w = wk[r];
            u32x4 o0, o1;
            o0.x = pk2(bflo(v0.x) * w, bfhi(v0.x) * w); o0.y = pk2(bflo(v0.y) * w, bfhi(v0.y) * w); o0.z = pk2(bflo(v0.z) * w, bfhi(v0.z) * w); o0.w = pk2(bflo(v0.w) * w, bfhi(v0.w) * w);
            o1.x = pk2(bflo(v1.x) * w, bfhi(v1.x) * w); o1.y = pk2(bflo(v1.y) * w, bfhi(v1.y) * w); o1.z = pk2(bflo(v1.z) * w, bfhi(v1.z) * w); o1.w = pk2(bflo(v1.w) * w, bfhi(v1.w) * w);
            *(LAS u32x4*)(Vimg + r * IST + c8 * 2) = o0; *(LAS u32x4*)(Vimg + r * IST + c8 * 2 + 16) = o1;
            if ((tid & 3) == 0) { unsigned zz; asm volatile("v_mov_b32 %0, 0" : "=v"(zz)); u32x4 e0; e0.x = f2bf(w); e0.y = zz; e0.z = zz; e0.w = zz; u32x4 z; z.x = zz; z.y = zz; z.z = zz; z.w = zz;
                *(LAS u32x4*)(Vimg + r * IST + 128) = e0; *(LAS u32x4*)(Vimg + r * IST + 144) = z; }
        }
        __syncthreads();
        {
            const int dt = wave & 3, et0 = 2 * (wave >> 2);
            f32x4 u0 = {0.f, 0.f, 0.f, 0.f}, u1 = u0, u2 = u0;
#pragma unroll
            for (int ks = 0; ks < 4; ++ks) {
                const bf16x8 af = frag_tr<false>(Kimg, 32 * ks, 16 * dt, lane);
                const bf16x8 b0 = frag_tr<false>(Vimg, 32 * ks, 16 * et0, lane), b1 = frag_tr<false>(Vimg, 32 * ks, 16 * et0 + 16, lane);
                u0 = mfma16(af, b0, u0); u1 = mfma16(af, b1, u1);
                if (wave < 4) { const bf16x8 b2 = frag_tr<false>(Vimg, 32 * ks, 64, lane); u2 = mfma16(af, b2, u2); }
            }
            bf16_t* U = (bf16_t*)(ws + WS_U + ((size_t)(((kind * NB + b) * 4 + h) * 2 + dir) * 18 + sc) * U_BYTES);
            const int g = lane >> 4, e = lane & 15, d0 = 16 * dt + 4 * g;
            { u32x2 w; w.x = pk2(u0[0], u0[1]); w.y = pk2(u0[2], u0[3]); *(u32x2*)(U + (size_t)(16 * et0 + e) * 64 + d0) = w; }
            { u32x2 w; w.x = pk2(u1[0], u1[1]); w.y = pk2(u1[2], u1[3]); *(u32x2*)(U + (size_t)(16 * et0 + 16 + e) * 64 + d0) = w; }
            if (wave < 4) { u32x2 w; w.x = pk2(u2[0], u2[1]); w.y = pk2(u2[2], u2[3]); *(u32x2*)(U + (size_t)(64 + e) * 64 + d0) = w; }
        }
    }
}

__device__ __forceinline__ void phase_chunk_states(const Args& a, int l, int tid, int bid, int G) {
    unsigned char* ws = a.ws;
    for (int it = bid; it < 2 * NB * 4 * 2; it += G) {
        const int dir = it & 1, h = (it >> 1) & 3, b = (it >> 3) & 7, kind = it >> 6;
        const size_t seq = (size_t)(((kind * NB + b) * 4 + h) * 2 + dir) * 18;
        const unsigned char* Ub = ws + WS_U + seq * U_BYTES; unsigned char* Sb = ws + WS_S + seq * U_BYTES;
        const float* usc = (const float*)(ws + WS_USC) + (size_t)((b * 4 + h) * 2 + dir) * 18 * 2;
        float* sm = (float*)(ws + WS_SM) + (size_t)((b * 4 + h) * 2 + dir) * 18;
        const float dec_ret = __expf(128.0f * logsigmoidf_(a.in[9][(l * 2 + dir) * 4 + h]));
        const int nrow = kind == 0 ? 512 : 520;
        for (int ci = tid; ci < nrow; ci += NTHR) {
            u32x4 v[18];
#pragma unroll
            for (int s = 0; s < 18; ++s) v[s] = *(const u32x4*)(Ub + (size_t)s * U_BYTES + (size_t)ci * 16);
            float acc[8];
#pragma unroll
            for (int j = 0; j < 8; ++j) acc[j] = 0.f;
            float m = 0.f;
#pragma unroll
            for (int s = 0; s < 18; ++s) {
                u32x4 o; o.x = pk2(acc[0], acc[1]); o.y = pk2(acc[2], acc[3]); o.z = pk2(acc[4], acc[5]); o.w = pk2(acc[6], acc[7]);
                *(u32x4*)(Sb + (size_t)s * U_BYTES + (size_t)ci * 16) = o;
                float dk, ck;
                if (kind == 0) { dk = dec_ret; ck = 1.0f; }
                else { if (ci == 0) sm[s] = m; const float bl = usc[2 * s], am = usc[2 * s + 1]; const float mx = fmaxf(m, am); dk = __expf(m - mx); ck = __expf(am - mx); m = bl + mx; }
                acc[0] = dk * acc[0] + ck * bflo(v[s].x); acc[1] = dk * acc[1] + ck * bfhi(v[s].x); acc[2] = dk * acc[2] + ck * bflo(v[s].y); acc[3] = dk * acc[3] + ck * bfhi(v[s].y);
                acc[4] = dk * acc[4] + ck * bflo(v[s].z); acc[5] = dk * acc[5] + ck * bfhi(v[s].z); acc[6] = dk * acc[6] + ck * bflo(v[s].w); acc[7] = dk * acc[7] + ck * bfhi(v[s].w);
            }
        }
    }
}

template <int KIND>
__device__ __forceinline__ float load_state(const unsigned char* ws, int b, int h, int dir, int sc, LAS unsigned char* Simg, int tid) {
    const unsigned char* Sp = ws + WS_S + ((size_t)((((KIND * NB + b) * 4 + h) * 2 + dir) * 18) + sc) * U_BYTES;
    *(LAS u32x4*)(Simg + (tid >> 3) * IST + (tid & 7) * 16) = *(const u32x4*)(Sp + (size_t)tid * 16);
    if (KIND == 1 && tid < 8) *(LAS u32x4*)(Simg + 64 * IST + tid * 16) = *(const u32x4*)(Sp + (size_t)(512 + tid) * 16);
    return KIND == 1 ? ((const float*)(ws + WS_SM))[(size_t)((b * 4 + h) * 2 + dir) * 18 + sc] : 0.f;
}

template <int KIND>
__device__ __forceinline__ void phase_chunk_out(const Args& a, int l, bool need_ctx, LAS unsigned char* lds, int tid, int lane, int wave, int bid, int G) {
    unsigned char* ws = a.ws;
    const bf16_t* P = (const bf16_t*)(ws + WS_BIG);
    const float* GT = (const float*)(ws + WS_GATES); bf16_t* MG = (bf16_t*)(ws + WS_H);
    LAS float* CW = (LAS float*)(lds + 98304); if (KIND == 1) conv_weights_to_lds(a, l, CW, tid);
    LAS unsigned char* Qimg = lds; LAS unsigned char* Kimg = lds + 20480; LAS unsigned char* Vimg = lds + 40960;
    LAS unsigned char* SFimg = lds + 61440; LAS unsigned char* SBimg = lds + 74240;
    LAS float* AF = (LAS float*)(lds + 87040); LAS float* CF = AF + 128; LAS float* BF = AF + 256; LAS float* AB = AF + 384; LAS float* CB = AF + 512; LAS float* BB = AF + 640;
    const int nch = need_ctx ? 18 : 16, nitems = NB * 4 * nch;
    const int g = lane >> 4, qi = 16 * wave + (lane & 15);
    for (int it = bid; it < nitems; it += G) {
        const int cc = it % nch; const int bh = it / nch; const int h = bh & 3, b = bh >> 2;
        const bool isctx = cc >= 16; const int c = isctx ? cc - 16 : cc;
        const int row0 = isctx ? NLAT + b * CTXL + 128 * c : b * SEQ + 128 * c;
        const int scf = isctx ? c : 2 + c, scb = isctx ? 1 - c : 17 - c;
        __syncthreads();
        {
            const int r = tid >> 2, c8 = (tid & 3) * 16;
            const bf16_t* vsrc = P + (size_t)(row0 + r) * NPW + (KIND == 0 ? PC_RV : PC_MV) + h * 64 + c8;
            u32x4 q0, q1, k0, k1;
            if (KIND == 0) { const bf16_t* qsrc = P + (size_t)(row0 + r) * NPW + PC_RQ + hl_off(h, c8); const bf16_t* ksrc = P + (size_t)(row0 + r) * NPW + PC_RK + hl_off(h, c8);
                q0 = *(const u32x4*)qsrc; q1 = *(const u32x4*)(qsrc + 8); k0 = *(const u32x4*)ksrc; k1 = *(const u32x4*)(ksrc + 8); }
            else { const int t = 128 * c + r; const bool hasm = t > 0, hasp = t < (isctx ? CTXL : SEQ) - 1;
                q0 = conv8_pack(P, row0 + r, h * 64 + c8, hasm, hasp, CW); q1 = conv8_pack(P, row0 + r, h * 64 + c8 + 8, hasm, hasp, CW);
                k0 = conv8_pack(P, row0 + r, 256 + h * 64 + c8, hasm, hasp, CW); k1 = conv8_pack(P, row0 + r, 256 + h * 64 + c8 + 8, hasm, hasp, CW); }
            const u32x4 v0 = *(const u32x4*)vsrc, v1 = *(const u32x4*)(vsrc + 8);
            *(LAS u32x4*)(Qimg + r * IST + c8 * 2) = q0; *(LAS u32x4*)(Qimg + r * IST + c8 * 2 + 16) = q1;
            *(LAS u32x4*)(Kimg + r * IST + c8 * 2) = k0; *(LAS u32x4*)(Kimg + r * IST + c8 * 2 + 16) = k1;
            *(LAS u32x4*)(Vimg + r * IST + c8 * 2) = v0; *(LAS u32x4*)(Vimg + r * IST + c8 * 2 + 16) = v1;
            if ((tid & 3) == 0) { unsigned zz, one; asm volatile("v_mov_b32 %0, 0\n\tv_mov_b32 %1, 0x3f80" : "=v"(zz), "=v"(one)); u32x4 e0; e0.x = one; e0.y = zz; e0.z = zz; e0.w = zz; u32x4 z; z.x = zz; z.y = zz; z.z = zz; z.w = zz;
                *(LAS u32x4*)(Vimg + r * IST + 128) = e0; *(LAS u32x4*)(Vimg + r * IST + 144) = z; }
        }
        const float mpf = load_state<KIND>(ws, b, h, 0, scf, SFimg, tid);
        const float mpb = load_state<KIND>(ws, b, h, 1, scb, SBimg, tid);
        if (KIND == 1 && wave == 0) {
            const size_t r0_ = (size_t)(row0 + lane) * 16, r1_ = (size_t)(row0 + 64 + lane) * 16;
#pragma unroll
            for (int dir = 0; dir < 2; ++dir) {
                const float i0 = GT[r0_ + 4 * dir + h], i1 = GT[r1_ + 4 * dir + h];
                const float f0 = logsigmoidf_(GT[r0_ + 8 + 4 * dir + h]), f1 = logsigmoidf_(GT[r1_ + 8 + 4 * dir + h]);
                float s0 = f0, s1 = f1;
#pragma unroll
                for (int o = 1; o < 64; o <<= 1) { const int sl = lane >= o ? lane - o : lane; const float u0 = lane_get(s0, sl), u1 = lane_get(s1, sl); if (lane >= o) { s0 += u0; s1 += u1; } }
                const float t0 = lane_bcast(s0, 63), t1 = lane_bcast(s1, 63);
                float b0, b1;
                if (dir == 0) { b0 = s0; b1 = t0 + s1; } else { b0 = t0 + t1 - s0 + f0; b1 = t1 - s1 + f1; }
                const float a0 = i0 - b0, a1 = i1 - b1;
                float x0 = a0, x1 = a1;
                if (dir == 0) {
#pragma unroll
                    for (int o = 1; o < 64; o <<= 1) { const int sl = lane >= o ? lane - o : lane; const float u0 = lane_get(x0, sl), u1 = lane_get(x1, sl); if (lane >= o) { x0 = fmaxf(x0, u0); x1 = fmaxf(x1, u1); } }
                    x1 = fmaxf(x1, lane_bcast(x0, 63));
                } else {
#pragma unroll
                    for (int o = 1; o < 64; o <<= 1) { const int sl = lane + o < 64 ? lane + o : lane; const float u0 = lane_get(x0, sl), u1 = lane_get(x1, sl); if (lane + o < 64) { x0 = fmaxf(x0, u0); x1 = fmaxf(x1, u1); } }
                    x0 = fmaxf(x0, lane_bcast(x1, 0));
                }
                const float mp = dir == 0 ? mpf : mpb;
                LAS float* A_ = dir == 0 ? AF : AB; LAS float* C_ = dir == 0 ? CF : CB; LAS float* B_ = dir == 0 ? BF : BB;
                A_[lane] = a0; A_[lane + 64] = a1; C_[lane] = fmaxf(x0, mp); C_[lane + 64] = fmaxf(x1, mp); B_[lane] = b0; B_[lane + 64] = b1;
            }
        }
        __syncthreads();
        const bf16x8 bq0 = frag_row(Qimg, 16 * wave, 0, lane), bq1 = frag_row(Qimg, 16 * wave, 32, lane);
        f32x4 st[8];
#pragma unroll
        for (int kt = 0; kt < 8; ++kt) { f32x4 z = {0.f, 0.f, 0.f, 0.f}; z = mfma16(frag_row(Kimg, 16 * kt, 0, lane), bq0, z); st[kt] = mfma16(frag_row(Kimg, 16 * kt, 32, lane), bq1, z); }
        const int row = row0 + qi;
        if (KIND == 0) {
            const float lgf = logsigmoidf_(a.in[9][(l * 2 + 0) * 4 + h]), lgb = logsigmoidf_(a.in[9][(l * 2 + 1) * 4 + h]);
            f32x4 acc[4];
#pragma unroll
            for (int et = 0; et < 4; ++et) {
                f32x4 zf = {0.f, 0.f, 0.f, 0.f}, zb = zf;
                zf = mfma16(frag_row(SFimg, 16 * et, 0, lane), bq0, zf); zf = mfma16(frag_row(SFimg, 16 * et, 32, lane), bq1, zf);
                zb = mfma16(frag_row(SBimg, 16 * et, 0, lane), bq0, zb); zb = mfma16(frag_row(SBimg, 16 * et, 32, lane), bq1, zb);
                acc[et] = zf * __expf(lgf * (float)(qi + 1)) + zb * __expf(lgb * (float)(128 - qi));
            }
#pragma unroll
            for (int T = 0; T < 4; ++T) {
                f32x4 p0, p1;
#pragma unroll
                for (int j = 0; j < 4; ++j) {
                    const int k0 = 32 * T + 4 * g + j, k1 = k0 + 16;
                    const float w0 = (k0 <= qi ? __expf(lgf * (float)(qi - k0)) : 0.f) + (k0 >= qi ? __expf(lgb * (float)(k0 - qi)) : 0.f);
                    const float w1 = (k1 <= qi ? __expf(lgf * (float)(qi - k1)) : 0.f) + (k1 >= qi ? __expf(lgb * (float)(k1 - qi)) : 0.f);
                    p0[j] = st[2 * T][j] * w0; p1[j] = st[2 * T + 1][j] * w1;
                }
                const bf16x8 bp = pack8(p0, p1);
{ bf16x8 va[4]; frag_tr_x4<true>(Vimg, 32 * T, 0, lane, va);
#pragma unroll
                for (int et = 0; et < 4; ++et) acc[et] = mfma16(va[et], bp, acc[et]); }
            }
            float ss = 0.f;
#pragma unroll
            for (int et = 0; et < 4; ++et) ss += (acc[et][0] * acc[et][0] + acc[et][1] * acc[et][1]) + (acc[et][2] * acc[et][2] + acc[et][3] * acc[et][3]);
            ss = sum_g4(ss);
            const float rs = rsqrtf(ss * (1.0f / 64.0f) + EPS);
#pragma unroll
            for (int et = 0; et < 4; ++et) { const int e0 = h * 64 + 16 * et + 4 * g;
                const u32x2 gw = *(const u32x2*)(P + (size_t)row * NPW + PC_RG + e0);
                u32x2 o; o.x = pk2(siluf_(bflo(gw.x)) * acc[et][0] * rs, siluf_(bfhi(gw.x)) * acc[et][1] * rs); o.y = pk2(siluf_(bflo(gw.y)) * acc[et][2] * rs, siluf_(bfhi(gw.y)) * acc[et][3] * rs);
                *(u32x2*)(MG + (size_t)row * DM + e0) = o; }
        } else {
            const float cf = CF[qi], cb = CB[qi];
            const float gf = __expf(mpf - cf), gb = __expf(mpb - cb);
            f32x4 af[5], ab[5];
#pragma unroll
            for (int et = 0; et < 5; ++et) {
                f32x4 zf = {0.f, 0.f, 0.f, 0.f}, zb = zf;
                zf = mfma16(frag_row(SFimg, 16 * et, 0, lane), bq0, zf); zf = mfma16(frag_row(SFimg, 16 * et, 32, lane), bq1, zf);
                zb = mfma16(frag_row(SBimg, 16 * et, 0, lane), bq0, zb); zb = mfma16(frag_row(SBimg, 16 * et, 32, lane), bq1, zb);
                af[et] = zf * gf; ab[et] = zb * gb;
            }
#pragma unroll
            for (int T = 0; T < 4; ++T) {
                const f32x4 a0f = *(const LAS f32x4*)(AF + 32 * T + 4 * g), a1f = *(const LAS f32x4*)(AF + 32 * T + 16 + 4 * g);
                const f32x4 a0b = *(const LAS f32x4*)(AB + 32 * T + 4 * g), a1b = *(const LAS f32x4*)(AB + 32 * T + 16 + 4 * g);
                f32x4 pf0, pf1, pb0, pb1;
#pragma unroll
                for (int j = 0; j < 4; ++j) {
                    const int k0 = 32 * T + 4 * g + j, k1 = k0 + 16;
                    pf0[j] = k0 <= qi ? st[2 * T][j] * __expf(a0f[j] - cf) : 0.f; pf1[j] = k1 <= qi ? st[2 * T + 1][j] * __expf(a1f[j] - cf) : 0.f;
                    pb0[j] = k0 >= qi ? st[2 * T][j] * __expf(a0b[j] - cb) : 0.f; pb1[j] = k1 >= qi ? st[2 * T + 1][j] * __expf(a1b[j] - cb) : 0.f;
                }
                const bf16x8 bpf = pack8(pf0, pf1), bpb = pack8(pb0, pb1);
{ bf16x8 va[4]; frag_tr_x4<true>(Vimg, 32 * T, 0, lane, va); const bf16x8 v4 = frag_tr<true>(Vimg, 32 * T, 64, lane);
#pragma unroll
                for (int et = 0; et < 4; ++et) { af[et] = mfma16(va[et], bpf, af[et]); ab[et] = mfma16(va[et], bpb, ab[et]); }
                af[4] = mfma16(v4, bpf, af[4]); ab[4] = mfma16(v4, bpb, ab[4]); }
            }
            const float denf = lane_get(af[4][0], lane & 15), denb = lane_get(ab[4][0], lane & 15);
            const float nf = 1.0f / fmaxf(fabsf(denf), __expf(-(BF[qi] + cf))), nb = 1.0f / fmaxf(fabsf(denb), __expf(-(BB[qi] + cb)));
            f32x4 y[4]; float ss = 0.f;
#pragma unroll
            for (int et = 0; et < 4; ++et) { y[et] = af[et] * nf + ab[et] * nb; ss += (y[et][0] * y[et][0] + y[et][1] * y[et][1]) + (y[et][2] * y[et][2] + y[et][3] * y[et][3]); }
            ss = sum_g4(ss);
            const float rs = rsqrtf(ss * (1.0f / 64.0f) + EPS);
#pragma unroll
            for (int et = 0; et < 4; ++et) { const int e0 = h * 64 + 16 * et + 4 * g;
                const u32x2 gw = *(const u32x2*)(P + (size_t)row * NPW + PC_MO + e0);
                u32x2 o; o.x = pk2(sigmoidf_(bflo(gw.x)) * y[et][0] * rs, sigmoidf_(bfhi(gw.x)) * y[et][1] * rs); o.y = pk2(sigmoidf_(bflo(gw.y)) * y[et][2] * rs, sigmoidf_(bfhi(gw.y)) * y[et][3] * rs);
                *(u32x2*)(MG + (size_t)row * DM + 256 + e0) = o; }
        }
    }
}

struct NaItem { int b, h, r0, ur0, nlb, lat, qrow0; };
__device__ __forceinline__ NaItem na_decode(int it) {
    NaItem t;
    if (it < 512) { t.lat = 1; const int rg = it & 7; t.h = (it >> 3) & 7; t.b = it >> 6; t.r0 = 4 * rg; t.ur0 = min(max(t.r0 - 4, 0), NROWS - 8);
        const int last = min(max(t.r0 - 1, 0), NROWS - 8) + 7; t.nlb = (last - t.ur0 + 4) >> 2; t.qrow0 = t.b * SEQ + t.r0 * 64; }
    else { const int j = it - 512; t.lat = 0; t.h = j & 7; t.b = j >> 3; t.r0 = 0; t.ur0 = 0; t.nlb = 0; t.qrow0 = NLAT + t.b * CTXL; }
    return t;
}
__device__ __forceinline__ int na_krow0(const NaItem& t, int step) { return step == 0 ? NLAT + t.b * CTXL : t.b * SEQ + (t.ur0 + 4 * (step - 1)) * 64; }
struct NaKV { u32x4 k[4], v[4]; };
__device__ __forceinline__ void na_load_kv(NaKV& x, const bf16_t* P, int krow0, int h, int tid) {
    const int rr = tid >> 1, c0 = (tid & 1) * 32; const bf16_t* ks = P + (size_t)(krow0 + rr) * NPW + PC_NK + 256 * (h >> 2) + hl_off(h & 3, c0); const bf16_t* vs = P + (size_t)(krow0 + rr) * NPW + PC_NV + h * 64 + c0;
#pragma unroll
    for (int i = 0; i < 4; ++i) { x.k[i] = *(const u32x4*)(ks + 8 * i); x.v[i] = *(const u32x4*)(vs + 8 * i); }
}
struct NaQ { u32x4 q[4]; };
__device__ __forceinline__ void na_load_q(NaQ& x, const bf16_t* P, int qrow0, int h, int tid) {
    const bf16_t* qs = P + (size_t)(qrow0 + (tid >> 1)) * NPW + PC_NQ + 256 * (h >> 2) + hl_off(h & 3, (tid & 1) * 32);
#pragma unroll
    for (int i = 0; i < 4; ++i) x.q[i] = *(const u32x4*)(qs + 8 * i);
}
struct NaState { float m, l; f32x4 acc[4]; };
template <int NPAIR, unsigned VALID>
__device__ __forceinline__ void na_update(NaState& st, const f32x4 (&s)[2 * NPAIR], float mx, LAS const unsigned char* Vimg, int vrow0, int lane) {
    mx = max_g4(mx);
    const float m_new = fmaxf(st.m, mx), resc = __builtin_amdgcn_exp2f(st.m - m_new);
    st.m = m_new; st.l *= resc;
#pragma unroll
    for (int et = 0; et < 4; ++et) st.acc[et] = st.acc[et] * resc;
#pragma unroll
    for (int T = 0; T < NPAIR; ++T) {
        if (((VALID >> (2 * T)) & 3u) != 0u) {
            f32x4 p0 = {0.f, 0.f, 0.f, 0.f}, p1 = p0;
            if ((VALID >> (2 * T)) & 1u) {
#pragma unroll
                for (int j = 0; j < 4; ++j) p0[j] = __builtin_amdgcn_exp2f(s[2 * T][j] - m_new);
                st.l += (p0[0] + p0[1]) + (p0[2] + p0[3]); }
            if ((VALID >> (2 * T + 1)) & 1u) {
#pragma unroll
                for (int j = 0; j < 4; ++j) p1[j] = __builtin_amdgcn_exp2f(s[2 * T + 1][j] - m_new);
                st.l += (p1[0] + p1[1]) + (p1[2] + p1[3]); }
            asm volatile("" : "+v"(st.l));
            const bf16x8 bp = pack8(p0, p1);
            bf16x8 va[4]; frag_tr_x4<true>(Vimg, vrow0 + 32 * T, 0, lane, va);
#pragma unroll
            for (int et = 0; et < 4; ++et) st.acc[et] = mfma16(va[et], bp, st.acc[et]);
            __builtin_amdgcn_sched_barrier(0);
        }
    }
}
template <int QTA>
__device__ __forceinline__ void na_local_row(NaState& st, const bf16x8& bq0, const bf16x8& bq1, LAS const unsigned char* Kimg, LAS const unsigned char* Vimg, LAS const float* browb, int irow0, int lane) {
    constexpr int tlo = (16 * QTA - 8 < 0 ? 0 : (16 * QTA - 8 > 48 ? 48 : 16 * QTA - 8)), thi = (16 * QTA + 7 > 48 ? 48 : 16 * QTA + 7) + 15;
    constexpr unsigned VALID = ((15 >= tlo && 0 <= thi) ? 1u : 0u) | ((31 >= tlo && 16 <= thi) ? 2u : 0u) | ((47 >= tlo && 32 <= thi) ? 4u : 0u) | ((63 >= tlo && 48 <= thi) ? 8u : 0u);
    const int g = lane >> 4, ql = 16 * QTA + (lane & 15), scq = min(max(ql - 8, 0), GRIDW - 16);
    f32x4 s[4]; float mx = -1.0e30f;
#pragma unroll
    for (int ct = 0; ct < 4; ++ct) {
        if ((VALID >> ct) & 1u) {
            f32x4 z = {0.f, 0.f, 0.f, 0.f}; z = mfma16(frag_row(Kimg, irow0 + 16 * ct, 0, lane), bq0, z); z = mfma16(frag_row(Kimg, irow0 + 16 * ct, 32, lane), bq1, z);
            const LAS float* brow = browb + (16 * ct + 4 * g - ql + 63); const int t0 = 16 * ct + 4 * g - scq;
#pragma unroll
            for (int j = 0; j < 4; ++j) { const float bv = brow[j]; const float zz = z[j] * 0.18033688f + bv; z[j] = ((unsigned)(t0 + j) < 16u) ? zz : -1.0e30f; }
            s[ct] = z; mx = fmaxf(mx, fmaxf(fmaxf(z[0], z[1]), fmaxf(z[2], z[3]))); asm volatile("" ::: "memory");
        } else s[ct] = (f32x4){-1.0e30f, -1.0e30f, -1.0e30f, -1.0e30f};
    }
    na_update<2, VALID>(st, s, mx, Vimg, irow0, lane);
    __builtin_amdgcn_sched_barrier(0);
}
template <int QTA>
__device__ __forceinline__ void na_local_q(NaState& st, LAS const unsigned char* Qimg, LAS const unsigned char* Kimg, LAS const unsigned char* Vimg, LAS const float* RPB, int qimg_row, int lane, int kkb, int srw, int qrw) {
    const bf16x8 bq0 = frag_row(Qimg, qimg_row, 0, lane), bq1 = frag_row(Qimg, qimg_row, 32, lane);
#pragma unroll
    for (int kkl = 0; kkl < 4; ++kkl) { const int kk = kkb + kkl;
        if (kk >= srw && kk < srw + 8) na_local_row<QTA>(st, bq0, bq1, Kimg, Vimg, RPB + (kk - qrw + 7) * 128, 64 * kkl, lane); }
}
template <int WP>
__device__ __forceinline__ void na_local_step(NaState (&st)[2], LAS const unsigned char* Qimg, LAS const unsigned char* Kimg, LAS const unsigned char* Vimg, LAS const float* RPB, int wave, int lane, int kkb, int srw, int qrw) {
    na_local_q<2 * WP>(st[0], Qimg, Kimg, Vimg, RPB, 32 * wave, lane, kkb, srw, qrw);
    na_local_q<2 * WP + 1>(st[1], Qimg, Kimg, Vimg, RPB, 32 * wave + 16, lane, kkb, srw, qrw);
}
__device__ __forceinline__ void phase_natt_mfma(const Args& a, int l, bool need_ctx, LAS unsigned char* lds, int tid, int lane, int wave, int bid, int G) {
    unsigned char* ws = a.ws;
    const bf16_t* P = (const bf16_t*)(ws + WS_BIG); bf16_t* MG = (bf16_t*)(ws + WS_H);
    LAS unsigned char* Qimg = lds; LAS unsigned char* Kimg = lds + 40960; LAS unsigned char* Vimg = lds + 81920;
    LAS float* RPB = (LAS float*)(lds + 122880);
    const int nitems = 512 + (need_ctx ? NB * 8 : 0);
    const int g = lane >> 4;
    int it = bid; if (it >= nitems) return;
    NaItem cur = na_decode(it);
    NaKV kv; na_load_kv(kv, P, na_krow0(cur, 0), cur.h, tid);
    float rpbreg[4];
#pragma unroll
    for (int k = 0; k < 4; ++k) { const int idx = tid + 512 * k, dr = idx >> 7, dc = (idx & 127) - 48; rpbreg[k] = (idx < 1920 && dc >= 0 && dc <= 30) ? a.in[15][(size_t)(l * 8 + cur.h) * 465 + dr * 31 + dc] * 1.44269504f : 0.f; }
    for (;;) {
        const int itn = it + G; const bool has_next = itn < nitems; NaItem nxt = cur; if (has_next) nxt = na_decode(itn);
        const int nsteps = 1 + cur.nlb;
        const int qrw = cur.r0 + (wave >> 1), srw = min(max(qrw - 4, 0), NROWS - 8);
        NaState st[2];
#pragma unroll
        for (int q2 = 0; q2 < 2; ++q2) { st[q2].m = -1.0e30f; st[q2].l = 0.f;
#pragma unroll
            for (int et = 0; et < 4; ++et) st[q2].acc[et] = (f32x4){0.f, 0.f, 0.f, 0.f}; }
        for (int step = 0; step < nsteps; ++step) {
            int ts = tid; asm volatile("" : "+v"(ts));
            __syncthreads();
            { const int rr = ts >> 1, c0 = (ts & 1) * 32;
#pragma unroll
              for (int i = 0; i < 4; ++i) { *(LAS u32x4*)(Kimg + rr * IST + (c0 + 8 * i) * 2) = kv.k[i]; *(LAS u32x4*)(Vimg + rr * IST + (c0 + 8 * i) * 2) = kv.v[i]; }
              if (step == 0) { NaQ qr_; na_load_q(qr_, P, cur.qrow0, cur.h, ts);
#pragma unroll
                  for (int i = 0; i < 4; ++i) *(LAS u32x4*)(Qimg + rr * IST + (c0 + 8 * i) * 2) = qr_.q[i];
#pragma unroll
                  for (int k = 0; k < 4; ++k) if (ts + 512 * k < 1920) RPB[ts + 512 * k] = rpbreg[k]; } }
            __syncthreads();
            int tq = ts;
            if (step + 1 < nsteps) na_load_kv(kv, P, na_krow0(cur, step + 1), cur.h, tq);
            else if (has_next) { na_load_kv(kv, P, na_krow0(nxt, 0), nxt.h, tq);
#pragma unroll
                for (int k = 0; k < 4; ++k) { const int idx = tq + 512 * k, dr = idx >> 7, dc = (idx & 127) - 48; rpbreg[k] = (idx < 1920 && dc >= 0 && dc <= 30) ? a.in[15][(size_t)(l * 8 + nxt.h) * 465 + dr * 31 + dc] * 1.44269504f : 0.f; } }
            const int ln = ts & 63;
            if (step == 0) {
#pragma unroll
                for (int q2 = 0; q2 < 2; ++q2) {
                    const bf16x8 bq0 = frag_row(Qimg, 32 * wave + 16 * q2, 0, ln), bq1 = frag_row(Qimg, 32 * wave + 16 * q2, 32, ln);
#pragma unroll
                    for (int hf = 0; hf < 2; ++hf) {
                        f32x4 s[8]; float mx = -1.0e30f;
#pragma unroll
                        for (int t8 = 0; t8 < 8; ++t8) { f32x4 z = {0.f, 0.f, 0.f, 0.f}; z = mfma16(frag_row(Kimg, 128 * hf + 16 * t8, 0, ln), bq0, z); z = mfma16(frag_row(Kimg, 128 * hf + 16 * t8, 32, ln), bq1, z);
                            z = z * 0.18033688f; s[t8] = z; mx = fmaxf(mx, fmaxf(fmaxf(z[0], z[1]), fmaxf(z[2], z[3]))); if (t8 & 1) asm volatile("" ::: "memory"); }
                        na_update<4, 0xFFu>(st[q2], s, mx, Vimg, 128 * hf, ln);
                        __builtin_amdgcn_sched_barrier(0);
                    }
                }
            } else {
                const int kkb = cur.ur0 + 4 * (step - 1);
                if (wave & 1) na_local_step<1>(st, Qimg, Kimg, Vimg, RPB, wave, ln, kkb, srw, qrw);
                else          na_local_step<0>(st, Qimg, Kimg, Vimg, RPB, wave, ln, kkb, srw, qrw);
            }
        }
        int lf = lane; asm volatile("" : "+v"(lf)); const int gf = lf >> 4;
#pragma unroll
        for (int q2 = 0; q2 < 2; ++q2) {
            const float inv = 1.0f / sum_g4(st[q2].l);
            const int row = cur.qrow0 + 32 * wave + 16 * q2 + (lf & 15);
#pragma unroll
            for (int et = 0; et < 4; ++et) { u32x2 w; w.x = pk2(st[q2].acc[et][0] * inv, st[q2].acc[et][1] * inv); w.y = pk2(st[q2].acc[et][2] * inv, st[q2].acc[et][3] * inv);
                *(u32x2*)(MG + (size_t)row * DM + 512 + cur.h * 64 + 16 * et + 4 * gf) = w; }
        }
        if (!has_next) break;
        it = itn; cur = nxt;
    }
}

constexpr int MOE_TAB_OFF = 131072;
__device__ __forceinline__ void moe_tab_setup(const unsigned char* ws, LAS unsigned char* lds, int tid) {
    if (tid == 0) { LAS int* tab = (LAS int*)(lds + MOE_TAB_OFF); int p = 0;
        for (int e = 0; e < NEXP; ++e) { const int c = (int)__hip_atomic_load((const unsigned*)(ws + WS_CTL) + CW_MOE + 64 * e, __ATOMIC_RELAXED, __HIP_MEMORY_SCOPE_AGENT); tab[e] = p; tab[16 + e] = c; p += (c + 255) >> 8; }
        tab[8] = p; }
    __syncthreads();
}
namespace pg8 {
struct MoeOrder : StaticOrder {
    const PG8_LAS int* tab; const int* list; size_t bstride;
    __device__ __forceinline__ int expert(int pm) const { int e = 0;
#pragma unroll
        for (int k = 1; k < 8; ++k) e += (pm >= tab[k]) ? 1 : 0;
        return e; }
    __device__ __forceinline__ unsigned arow(const Unit& u, int R) const {
        const int Rr = (u.hs > 0 ? HALF : 0) + (u.hs >= 0 ? (R & (HALF - 1)) : R);
        if (!list) return (unsigned)(u.pm * BM + Rr);
        const int e = expert(u.pm), idx = (u.pm - tab[e]) * BM + Rr;
        return idx < tab[16 + e] ? (unsigned)list[e * NLAT + idx] : 0u; }
    __device__ __forceinline__ const char* bbase(const Unit& u) const { return Bt + (size_t)expert(u.pm) * bstride + (size_t)u.pn * BM * K2; }
};
}
__device__ __forceinline__ void phase_moe_combine(const Args& a, LAS unsigned char* lds, int lane, int wave, int bid, int G) {
    unsigned char* ws = a.ws; const LAS int* tab = (const LAS int*)(lds + MOE_TAB_OFF);
    const int* TOK = (const int*)(ws + WS_COMB); const bf16_t* Y = (const bf16_t*)(ws + WS_WTMUP);
    const float* g2 = (const float*)(ws + WS_MOD) + (size_t)9 * 6144 + 5120;
    for (int r = bid * NWAVES + wave; r < NLAT; r += G * NWAVES) {
        const int e1 = TOK[r * 8], e2 = TOK[r * 8 + 1], p1 = TOK[r * 8 + 2], p2 = TOK[r * 8 + 3]; const float w1 = __int_as_float(TOK[r * 8 + 4]), w2 = __int_as_float(TOK[r * 8 + 5]);
        const bf16_t* y1 = Y + ((size_t)tab[e1] * 256 + p1) * DM; const bf16_t* y2 = Y + ((size_t)tab[e2] * 256 + p2) * DM;
        const float* gr = g2 + (size_t)(r >> 11) * 6144; float* o = a.out + (size_t)r * DM;
#pragma unroll
        for (int j = 0; j < 4; ++j) { const int k = 4 * lane + 256 * j;
            const u32x2 a1 = *(const u32x2*)(y1 + k), a2 = *(const u32x2*)(y2 + k); const f32x4 x = *(const f32x4*)(o + k), gg = *(const f32x4*)(gr + k);
            f32x4 m; m.x = w1 * bflo(a1.x) + w2 * bflo(a2.x); m.y = w1 * bfhi(a1.x) + w2 * bfhi(a2.x); m.z = w1 * bflo(a1.y) + w2 * bflo(a2.y); m.w = w1 * bfhi(a1.y) + w2 * bfhi(a2.y);
            *(f32x4*)(o + k) = x + gg * m; }
    }
}
#ifndef DUP_VIRT
#define DUP_VIRT (-1)
#endif
#define PH_REP_OPEN
#define PH_REP_CLOSE
#ifndef DUP_PH
#define DUP_PH (-1)
#endif
#ifndef PH_ONLY
#define PH_ONLY 0
#endif
#ifndef MIX_NAIVE
#define MIX_NAIVE 0
#endif
#ifndef MIX_RET
#define MIX_RET 1
#endif
#ifndef MIX_ML
#define MIX_ML 1
#endif
#ifndef MIX_NA
#define MIX_NA 1
#endif
#ifndef EN_PRO
#define EN_PRO 1
#endif
#ifndef EN_NORM
#define EN_NORM 1
#endif
#ifndef EN_GIN
#define EN_GIN 1
#endif
#ifndef EN_POST
#define EN_POST 1
#endif
#ifndef EN_FCUM
#define EN_FCUM 1
#endif
#ifndef EN_QUAD
#define EN_QUAD 1
#endif
#ifndef EN_NATT
#define EN_NATT 1
#endif
#ifndef EN_MERGE
#define EN_MERGE 1
#endif
#ifndef EN_GOUT
#define EN_GOUT 1
#endif
#ifndef EN_NORM2
#define EN_NORM2 1
#endif
#ifndef EN_GUP
#define EN_GUP 1
#endif
#ifndef EN_GDN
#define EN_GDN 1
#endif

__global__ void __launch_bounds__(NTHR, 2) fwd_kernel(Args a_) {
    extern __shared__ __attribute__((aligned(16))) unsigned char lds_raw[];
    LAS unsigned char* lds = (LAS unsigned char*)lds_raw;
    const int tid0 = threadIdx.x, G = gridDim.x, bid = blockIdx.x; const int wave0 = __builtin_amdgcn_readfirstlane(tid0 >> 6);
    unsigned char* ws0 = a_.ws;
    volatile LAS unsigned* MISC = (volatile LAS unsigned*)(lds + MISC_OFF);
    if (tid0 < 32) MISC[tid0] = 0u;
    __syncthreads();
    const int lo = a_.ph_lo, hi = a_.ph_hi;
    XcdBarrier bar; bar.bar = (unsigned*)(ws0 + WS_CTL) + CW_BAR; bar.x = 0; bar.st = MISC + 8;
    if (hi - lo > 1) bar = xcd_barrier_post((unsigned*)(ws0 + WS_CTL) + CW_BAR, MISC + 8);
    int ph = 0;
#define PH_BEGIN if (ph >= lo && ph < hi) { asm volatile("; PHMARK_BEGIN %0" :: "i"(__LINE__)); int tid; asm volatile("v_mbcnt_lo_u32_b32 %0, -1, 0\n\tv_mbcnt_hi_u32_b32 %0, -1, %0" : "=v"(tid)); tid += wave0 * 64; Args a; { const __attribute__((address_space(4))) Args* ap = (const __attribute__((address_space(4))) Args*)__builtin_amdgcn_kernarg_segment_ptr(); asm volatile("" : "+s"(ap)); a = *(const Args*)ap; } unsigned char* ws = a.ws; (void)ws; PH_REP_OPEN if (PH_ONLY == 0 || PH_ONLY == __LINE__) { const int lane = tid & 63, wave = __builtin_amdgcn_readfirstlane(tid >> 6); (void)lane; (void)wave;
#define PH_END   } PH_REP_CLOSE asm volatile("; PHMARK_END %0" :: "i"(__LINE__)); if (ph + 1 < hi) xcd_barrier(bar); else __syncthreads(); } ++ph;

    PH_BEGIN
#if EN_PRO
 phase_prologue(a, lds, tid, lane, wave, bid, G);
#endif
 PH_END

    for (int l = 0; l < 2; ++l) {
        const bool need_ctx = (l == 0);
#define MODP ((const float*)(ws + WS_MOD) + (size_t)l * 9 * 6144)
        PH_BEGIN
#if EN_NORM
 phase_norm<0>(a, l, lds, tid, lane, wave, bid, G);
#endif
 PH_END
        PH_BEGIN
#if EN_GIN
 { pg8::Gemm g{(const bf16_t*)(ws + WS_H), (const bf16_t*)(ws + WS_WTIN) + (size_t)l * NPW * DM, MALL, NPW, DM};
                   pg8::StaticOrder S; S.init(MALL, NPW, G, bid); S.Bt = (const char*)g.Bt; S.K2 = 2 * DM; pg8::EpiProj E{(bf16_t*)(ws + WS_BIG), NPW, (const float*)(ws + WS_ROPE), a.in[13] + l * 64, a.in[14] + l * 64, NLAT / 256};
                   pg8::gemm_phase<pg8::EpiProj, pg8::StaticOrder, false>(lds, g, S, E, nullptr, tid); }
#endif
 PH_END
        PH_BEGIN
#if MIX_RET || MIX_ML
        phase_chunk_sums(a, l, lds, tid, lane, wave, bid, G);
#endif
        PH_END
        PH_BEGIN phase_chunk_states(a, l, tid, bid, G); PH_END
        PH_BEGIN
#if MIX_RET
        phase_chunk_out<0>(a, l, need_ctx, lds, tid, lane, wave, bid, G);
#endif
#if MIX_ML
        phase_chunk_out<1>(a, l, need_ctx, lds, tid, lane, wave, bid, G);
#endif
#if MIX_NA
        phase_natt_mfma(a, l, need_ctx, lds, tid, lane, wave, bid, G);
#endif
        PH_END
        PH_BEGIN
#if EN_GOUT
 { const int M = need_ctx ? MALL : NLAT;
                   pg8::Gemm g{(const bf16_t*)(ws + WS_H), (const bf16_t*)(ws + WS_WTOUT) + (size_t)l * DM * DM, M, DM, DM};
                   pg8::StaticOrder S; S.init(M, DM, G, bid); S.Bt = (const char*)g.Bt; S.K2 = 2 * DM;
                   pg8::EpiResid E{l == 0 ? a.in[0] : a.out, l == 0 ? a.in[2] : (const float*)(ws + WS_XC), a.out, (float*)(ws + WS_XC), MODP + 2048, nullptr, 0, NLAT / 256};
                   pg8::gemm_phase<pg8::EpiResid, pg8::StaticOrder, false>(lds, g, S, E, nullptr, tid); }
#endif
 PH_END
        if (l == 0) { PH_BEGIN
#if EN_NORM2
 phase_norm<1>(a, l, lds, tid, lane, wave, bid, G);
#endif
 PH_END }
        else        { PH_BEGIN
#if EN_NORM2
 phase_norm<2>(a, l, lds, tid, lane, wave, bid, G);
#endif
 PH_END }
        if (l == 0) {
            PH_BEGIN { pg8::Gemm g{(const bf16_t*)(ws + WS_H), (const bf16_t*)(ws + WS_WTUP), MALL, NUP, DM};
                       pg8::StaticOrder S; S.init(MALL, NUP, G, bid); S.Bt = (const char*)g.Bt; S.K2 = 2 * DM; pg8::EpiSwiGLU E{(bf16_t*)(ws + WS_BIG), DFF};
                       pg8::gemm_phase<pg8::EpiSwiGLU, pg8::StaticOrder, false>(lds, g, S, E, nullptr, tid); } PH_END
            PH_BEGIN { pg8::Gemm g{(const bf16_t*)(ws + WS_BIG), (const bf16_t*)(ws + WS_WTDN), MALL, DM, DFF};
                       pg8::StaticOrder S; S.init(MALL, DM, G, bid); S.Bt = (const char*)g.Bt; S.K2 = 2 * DFF;
                       pg8::EpiResid E{a.out, (const float*)(ws + WS_XC), a.out, (float*)(ws + WS_XC), MODP + 5120, nullptr, 0, NLAT / 256};
                       pg8::gemm_phase<pg8::EpiResid, pg8::StaticOrder, false>(lds, g, S, E, nullptr, tid); } PH_END
        } else {
            PH_BEGIN { moe_tab_setup(ws, lds, tid); const LAS int* tab = (const LAS int*)(lds + MOE_TAB_OFF);
                       pg8::Gemm g{(const bf16_t*)(ws + WS_H), (const bf16_t*)(ws + WS_WTMUP), 256 * tab[8], NUP, DM};
                       pg8::MoeOrder S; S.init(256 * tab[8], NUP, G, bid); S.Bt = (const char*)g.Bt; S.K2 = 2 * DM; S.tab = tab; S.list = (const int*)(ws + WS_LIST); S.bstride = (size_t)NUP * DM * 2;
                       pg8::EpiSwiGLU E{(bf16_t*)(ws + WS_BIG), DFF};
                       pg8::gemm_phase<pg8::EpiSwiGLU, pg8::MoeOrder, false>(lds, g, S, E, nullptr, tid); } PH_END
            PH_BEGIN { moe_tab_setup(ws, lds, tid); const LAS int* tab = (const LAS int*)(lds + MOE_TAB_OFF);
                       pg8::Gemm g{(const bf16_t*)(ws + WS_BIG), (const bf16_t*)(ws + WS_WTMDN), 256 * tab[8], DM, DFF};
                       pg8::MoeOrder S; S.init(256 * tab[8], DM, G, bid); S.Bt = (const char*)g.Bt; S.K2 = 2 * DFF; S.tab = tab; S.list = nullptr; S.bstride = (size_t)DM * DFF * 2;
                       pg8::EpiBf16 E{(bf16_t*)(ws + WS_WTMUP), DM};
                       pg8::gemm_phase<pg8::EpiBf16, pg8::MoeOrder, false>(lds, g, S, E, nullptr, tid); } PH_END
            PH_BEGIN { moe_tab_setup(ws, lds, tid); phase_moe_combine(a, lds, lane, wave, bid, G); } PH_END
        }
    }
#if N_LAUNCH_MODE == 1
    if (lo >= 100) {
        int tid; asm volatile("v_mbcnt_lo_u32_b32 %0, -1, 0\n\tv_mbcnt_hi_u32_b32 %0, -1, %0" : "=v"(tid)); tid += wave0 * 64; const int lane = tid & 63, wave = wave0;
        Args a = a_;
        if (lo == 100) phase_chunk_out<0>(a, 0, true, lds, tid, lane, wave, bid, G);
        if (lo == 101) phase_chunk_out<1>(a, 0, true, lds, tid, lane, wave, bid, G);
        if (lo == 102) phase_natt_mfma(a, 0, true, lds, tid, lane, wave, bid, G);
        if (lo == 103) { unsigned char* ws = a.ws; pg8::Gemm g{(const bf16_t*)(ws + WS_H), (const bf16_t*)(ws + WS_WTIN), MALL, NPW, DM};
                   pg8::StaticOrder S; S.init(MALL, NPW, G, bid); S.Bt = (const char*)g.Bt; S.K2 = 2 * DM; pg8::EpiNull E{(bf16_t*)(ws + WS_BIG), NPW};
                   pg8::gemm_phase<pg8::EpiNull, pg8::StaticOrder, false>(lds, g, S, E, nullptr, tid); }
    }
#endif
#undef PH_BEGIN
#undef PH_END
}
constexpr int N_PHASES = 1 + 2 * 7 + 2 + 3;
#ifndef DBG_MAXPH
#define DBG_MAXPH 1000
#endif

extern "C" void kernel_launch(void* const* d_in, const int* in_sizes, int n_in, void* d_out, int out_size, void* d_ws, size_t ws_size, hipStream_t stream) {
    static int grid = 0;
    if (grid == 0) {
        if (n_in != 24 || out_size != NLAT * DM || ws_size < WS_END) { fprintf(stderr, "kernel_launch: unexpected sizes (n_in %d, out %d, ws %zu < %zu); nothing launched\n", n_in, out_size, ws_size, (size_t)WS_END); grid = -1; return; }
        int dev = 0, cus = 0;
        if (hipGetDevice(&dev) != hipSuccess || hipDeviceGetAttribute(&cus, hipDeviceAttributeMultiprocessorCount, dev) != hipSuccess) { grid = -1; return; }
        if (hipFuncSetAttribute((const void*)fwd_kernel, hipFuncAttributeMaxDynamicSharedMemorySize, LDS_BYTES) != hipSuccess) { fprintf(stderr, "kernel_launch: hipFuncSetAttribute failed\n"); grid = -1; return; }
        int per_cu = 0;
        if (hipOccupancyMaxActiveBlocksPerMultiprocessor(&per_cu, (const void*)fwd_kernel, NTHR, LDS_BYTES) != hipSuccess || per_cu < 1) { fprintf(stderr, "kernel_launch: occupancy query says %d\n", per_cu); }
        (void)hipGetLastError();
        grid = cus;
    }
    if (grid < 0) return;
    (void)hipMemsetAsync((char*)d_ws + WS_CTL, 0, CTL_BYTES, stream);
    Args a{};
    for (int i = 0; i < 24; ++i) a.in[i] = (const float*)d_in[i];
    a.out = (float*)d_out; a.ws = (unsigned char*)d_ws;
#if N_LAUNCH_MODE == 0
    a.ph_lo = 0; a.ph_hi = N_PHASES;
    hipLaunchKernelGGL(fwd_kernel, dim3(grid), dim3(NTHR), LDS_BYTES, stream, a);
#else
    for (int p = 0; p < N_PHASES && p < DBG_MAXPH; ++p) { a.ph_lo = p; a.ph_hi = p + 1; hipLaunchKernelGGL(fwd_kernel, dim3(grid), dim3(NTHR), LDS_BYTES, stream, a);
        if (p == DUP_PH) hipLaunchKernelGGL(fwd_kernel, dim3(grid), dim3(NTHR), LDS_BYTES, stream, a);
        if (p == 6 && DUP_VIRT >= 100) { a.ph_lo = DUP_VIRT; a.ph_hi = DUP_VIRT + 1; hipLaunchKernelGGL(fwd_kernel, dim3(grid), dim3(NTHR), LDS_BYTES, stream, a); } }
#endif
}
```

```cpp
#include <hip/hip_runtime.h>
#include <stdio.h>
#include <stdint.h>

#ifndef N_LAUNCH_MODE
#define N_LAUNCH_MODE 0
#endif

constexpr int NB = 8, SEQ = 2048, DM = 1024, CTXL = 256, HD = 64;
constexpr int NLAT = NB * SEQ, NCTX = NB * CTXL, MALL = NLAT + NCTX;
constexpr int DIN = 3600, NPW = 3584;
constexpr int DFF = 2816, NUP = 2 * DFF, NEXP = 8;
constexpr int GRIDW = 64, NROWS = 32;
constexpr float EPS = 1e-6f;
constexpr int PC_RQ = 0, PC_RK = 256, PC_RV = 512, PC_RG = 768, PC_MQ = 1024, PC_MK = 1280, PC_MV = 1536, PC_MO = 1792, PC_NQ = 2048, PC_NK = 2560, PC_NV = 3072;

constexpr size_t al256(size_t x) { return (x + 255) & ~(size_t)255; }
constexpr size_t WS_CTL = 0, CTL_BYTES = 1u << 20;
constexpr size_t WS_MOD = WS_CTL + CTL_BYTES;
constexpr size_t WS_ROPE = WS_MOD + al256((size_t)2 * 9 * 6144 * 4);
constexpr size_t WS_WTIN = WS_ROPE + al256(64 * 16 * 2 * 4);
constexpr size_t WS_WTOUT = WS_WTIN + (size_t)2 * NPW * DM * 2;
constexpr size_t WS_WTUP = WS_WTOUT + (size_t)2 * DM * DM * 2;
constexpr size_t WS_WTDN = WS_WTUP + (size_t)NUP * DM * 2;
constexpr size_t WS_WTMUP = WS_WTDN + (size_t)DM * DFF * 2;
constexpr size_t WS_WTMDN = WS_WTMUP + (size_t)NEXP * NUP * DM * 2;
constexpr size_t WS_H = WS_WTMDN + (size_t)NEXP * DM * DFF * 2;
constexpr size_t WS_XC = WS_H + (size_t)MALL * DM * 2;
constexpr size_t WS_GATES = WS_XC + (size_t)NCTX * DM * 4;
constexpr size_t WS_COMB = WS_GATES + (size_t)MALL * 16 * 4;
constexpr size_t WS_USC = WS_COMB + (size_t)NLAT * 8 * 4;
constexpr size_t WS_SM = WS_USC + al256((size_t)NB * 4 * 2 * 18 * 2 * 4);
constexpr size_t WS_LIST = WS_SM + al256((size_t)NB * 4 * 2 * 18 * 4);
constexpr size_t WS_BIG = WS_LIST + (size_t)NEXP * NLAT * 4;
constexpr size_t WS_MQK = WS_BIG + (size_t)MALL * NPW * 2;
constexpr size_t WS_U = WS_MQK + (size_t)MALL * 512 * 2;
constexpr size_t WS_S = WS_U + (size_t)2 * NB * 4 * 2 * 18 * 80 * 64 * 2;
constexpr size_t WS_END0 = WS_S + (size_t)2 * NB * 4 * 2 * 18 * 80 * 64 * 2;
constexpr size_t MOE_ROWS = 34816;
constexpr size_t WS_ACTM_END = WS_BIG + MOE_ROWS * DFF * 2;
constexpr size_t WS_END = WS_END0 > WS_ACTM_END ? WS_END0 : WS_ACTM_END;

typedef unsigned short bf16_t;
typedef float f32x4 __attribute__((ext_vector_type(4)));
typedef float f32x2 __attribute__((ext_vector_type(2)));
typedef unsigned u32x4 __attribute__((ext_vector_type(4)));
typedef unsigned u32x2 __attribute__((ext_vector_type(2)));
#define LAS __attribute__((address_space(3)))
#define GAS __attribute__((address_space(1)))

__device__ __forceinline__ float bf2f(bf16_t b) { return __uint_as_float(((unsigned)b) << 16); }
__device__ __forceinline__ unsigned f2bf(float f) { unsigned u = __float_as_uint(f); return (u + 0x7fffu + ((u >> 16) & 1u)) >> 16; }
typedef __bf16 bf16x2_t __attribute__((ext_vector_type(2)));
__device__ __forceinline__ unsigned pk2(float lo, float hi) { f32x2 v = {lo, hi}; bf16x2_t b = __builtin_convertvector(v, bf16x2_t); return __builtin_bit_cast(unsigned, b); }
__device__ __forceinline__ float bflo(unsigned w) { return __uint_as_float(w << 16); }
__device__ __forceinline__ float bfhi(unsigned w) { return __uint_as_float(w & 0xffff0000u); }
__device__ __forceinline__ float sigmoidf_(float x) { return 1.0f / (1.0f + __expf(-x)); }
__device__ __forceinline__ float siluf_(float x) { return x / (1.0f + __expf(-x)); }
__device__ __forceinline__ float logsigmoidf_(float x) { return fminf(x, 0.f) - log1pf(__expf(-fabsf(x))); }
template <int O> __device__ __forceinline__ float swz_xor(float v) { return __int_as_float(__builtin_amdgcn_ds_swizzle(__float_as_int(v), (O << 10) | 0x1f)); }
__device__ __forceinline__ float red32_sum(float v) { const auto r = __builtin_amdgcn_permlane32_swap(__float_as_uint(v), __float_as_uint(v), false, false); return __uint_as_float(r[0]) + __uint_as_float(r[1]); }
__device__ __forceinline__ float red32_max(float v) { const auto r = __builtin_amdgcn_permlane32_swap(__float_as_uint(v), __float_as_uint(v), false, false); return fmaxf(__uint_as_float(r[0]), __uint_as_float(r[1])); }
__device__ __forceinline__ float wave_sum(float v) { v += swz_xor<1>(v); v += swz_xor<2>(v); v += swz_xor<4>(v); v += swz_xor<8>(v); v += swz_xor<16>(v); return red32_sum(v); }
__device__ __forceinline__ float wave_max(float v) { v = fmaxf(v, swz_xor<1>(v)); v = fmaxf(v, swz_xor<2>(v)); v = fmaxf(v, swz_xor<4>(v)); v = fmaxf(v, swz_xor<8>(v)); v = fmaxf(v, swz_xor<16>(v)); return red32_max(v); }
__device__ __forceinline__ float sum_g4(float v) { v += swz_xor<16>(v); return red32_sum(v); }
__device__ __forceinline__ float max_g4(float v) { v = fmaxf(v, swz_xor<16>(v)); return red32_max(v); }
__device__ __forceinline__ float reduce16_lanes(const float (&p)[16], int lane) {
    float q[8], r[4], s[2];
#pragma unroll
    for (int j = 0; j < 8; ++j) { const auto x = __builtin_amdgcn_permlane32_swap(__float_as_uint(p[j]), __float_as_uint(p[j + 8]), false, false); q[j] = __uint_as_float(x[0]) + __uint_as_float(x[1]); }
    const bool b4 = (lane & 16) != 0, b3 = (lane & 8) != 0, b2 = (lane & 4) != 0;
#pragma unroll
    for (int j = 0; j < 4; ++j) { const float keep = b4 ? q[j + 4] : q[j], send = b4 ? q[j] : q[j + 4]; r[j] = keep + swz_xor<16>(send); }
#pragma unroll
    for (int j = 0; j < 2; ++j) { const float keep = b3 ? r[j + 2] : r[j], send = b3 ? r[j] : r[j + 2]; s[j] = keep + swz_xor<8>(send); }
    float v; { const float keep = b2 ? s[1] : s[0], send = b2 ? s[0] : s[1]; v = keep + swz_xor<4>(send); }
    v += swz_xor<2>(v); v += swz_xor<1>(v);
    return v;
}
__device__ __forceinline__ float reduce8_lanes(const float (&p)[8], int lane) {
    float q[4], r[2];
#pragma unroll
    for (int j = 0; j < 4; ++j) { const auto x = __builtin_amdgcn_permlane32_swap(__float_as_uint(p[j]), __float_as_uint(p[j + 4]), false, false); q[j] = __uint_as_float(x[0]) + __uint_as_float(x[1]); }
    const bool b4 = (lane & 16) != 0, b3 = (lane & 8) != 0;
#pragma unroll
    for (int j = 0; j < 2; ++j) { const float keep = b4 ? q[j + 2] : q[j], send = b4 ? q[j] : q[j + 2]; r[j] = keep + swz_xor<16>(send); }
    float v; { const float keep = b3 ? r[1] : r[0], send = b3 ? r[0] : r[1]; v = keep + swz_xor<8>(send); }
    v += swz_xor<4>(v); v += swz_xor<2>(v); v += swz_xor<1>(v);
    return v;
}
__device__ __forceinline__ float lane_get(float v, int src_lane) { return __int_as_float(__builtin_amdgcn_ds_bpermute(src_lane << 2, __float_as_int(v))); }
__device__ __forceinline__ float lane_bcast(float v, int k) { return __int_as_float(__builtin_amdgcn_readlane(__float_as_int(v), k)); }

struct Args {
    const float* in[24];
    float* out;
    unsigned char* ws;
    int ph_lo, ph_hi;
};
namespace pg8 {
#define PG8_LAS __attribute__((address_space(3)))
typedef unsigned short bf16_t;
typedef short bf16x8 __attribute__((ext_vector_type(8)));
typedef float f32x4 __attribute__((ext_vector_type(4)));
typedef unsigned u32x4 __attribute__((ext_vector_type(4)));
constexpr int BM = 256, BK = 64, HALF = 128, HTB = HALF * BK * 2  , STAGE_BYTES = 8 * HTB, NXCD = 8, WGM = 8;

__host__ __device__ __forceinline__ int lds_byte(int r, int c) { const int st = (r >> 4) * 2 + (c >> 5), rr = r & 15, cc = c & 31, ob = rr * 64 + cc * 2; return st * 1024 + (ob ^ (((ob >> 9) & 1) << 5)); }
__host__ __device__ __forceinline__ void stage_rc(int b, int& R, int& C) { const int st = b / 1024, sb = b % 1024, swz = sb ^ (((sb >> 9) & 1) << 5); R = (st >> 1) * 16 + swz / 64; C = (st & 1) * 32 + (swz % 64) / 2; }
__host__ __device__ __forceinline__ int perm32(int rho) { const int n = rho >> 4, i = rho & 15; return 8 * (i >> 2) + 4 * n + (i & 3); }

struct Unit { int pm, pn, hs; };
struct Gemm { const bf16_t* A; const bf16_t* Bt; int M, N, K; };

struct StaticOrder {
    int nM, nN, nwg, G, c;
    __host__ __device__ void init(int M, int N, int G_, int c_) { nM = M / BM; nN = N / BM; nwg = nM * nN; G = G_; c = c_; }
    __host__ __device__ bool next(int i, Unit& u) const {
        const int nfr = nwg / G, left = nwg - nfr * G; int wgid; u.hs = -1;
        if (i < nfr) wgid = i * G + c;
        else if (i == nfr && left > 0) { if (2 * left <= G) { if (c >= 2 * left) return false; wgid = nfr * G + (c >> 1); u.hs = c & 1; } else { if (c >= left) return false; wgid = nfr * G + c; } }
        else return false; { const int q = nwg / NXCD, r = nwg % NXCD, xcd = wgid % NXCD, off = wgid / NXCD; wgid = (xcd < r ? xcd * (q + 1) : r * (q + 1) + (xcd - r) * q) + off; }
        const int nig = WGM * nN, gid = wgid / nig, fm = gid * WGM, gsz = (nM - fm) < WGM ? (nM - fm) : WGM;
        u.pm = fm + ((wgid % nig) % gsz); u.pn = (wgid % nig) / gsz; return true;
    }
    __device__ __forceinline__ void a_ready(const Unit&) const {}
    __device__ __forceinline__ void done(const Unit&) const {}
    __device__ __forceinline__ int idle_class() const { const int nfr = nwg / G, left = nwg - nfr * G; if (left == 0) return 3; if (2 * left <= G) return c < 2 * left ? 0 : 1; return c < left ? 0 : 2; }
    const char* Bt; int K2;
    __device__ __forceinline__ unsigned arow(const Unit& u, int R) const { return (unsigned)(u.pm * BM + (u.hs > 0 ? HALF : 0) + (u.hs >= 0 ? (R & (HALF - 1)) : R)); }
    __device__ __forceinline__ const char* bbase(const Unit& u) const { return Bt + (size_t)u.pn * BM * K2; }
};
__device__ __forceinline__ unsigned cvt_pk_bf16(float lo, float hi) { return ::pk2(lo, hi); }
typedef float f32x2 __attribute__((ext_vector_type(2)));
struct EpiBf16 {
    static constexpr bool PERM = true, AFTER_DRAIN = false;
    bf16_t* O; int ldc;
    __device__ __forceinline__ void operator()(const f32x4 (&acc)[2][2][4][2], const Unit& u, int wr, int wc, int fr, int fq) const {
        const int row0 = u.pm * BM + (u.hs > 0 ? HALF : 0) + wr * 64 + fr, col0 = u.pn * BM + wc * 32 + 8 * fq; const int nai = u.hs >= 0 ? 1 : 2;
#pragma unroll
        for (int ai = 0; ai < 2; ++ai) if (ai < nai)
#pragma unroll
            for (int m = 0; m < 4; ++m) { bf16_t* rowp = O + (size_t)(row0 + ai * HALF + m * 16) * ldc + col0;
#pragma unroll
                for (int bj = 0; bj < 2; ++bj) { const f32x4 v0 = acc[ai][bj][m][0], v1 = acc[ai][bj][m][1];
                    u32x4 w; w.x = cvt_pk_bf16(v0[0], v0[1]); w.y = cvt_pk_bf16(v0[2], v0[3]); w.z = cvt_pk_bf16(v1[0], v1[1]); w.w = cvt_pk_bf16(v1[2], v1[3]);
                    *(u32x4*)(rowp + bj * HALF) = w; } }
    }
};
struct EpiSwiGLU {
    static constexpr bool PERM = true, AFTER_DRAIN = false;
    bf16_t* O; int ldc;
    __device__ __forceinline__ void operator()(const f32x4 (&acc)[2][2][4][2], const Unit& u, int wr, int wc, int fr, int fq) const {
        const int row0 = u.pm * BM + (u.hs > 0 ? HALF : 0) + wr * 64 + fr, col0 = u.pn * HALF + wc * 32 + 8 * fq; const int nai = u.hs >= 0 ? 1 : 2;
#pragma unroll
        for (int ai = 0; ai < 2; ++ai) if (ai < nai)
#pragma unroll
            for (int m = 0; m < 4; ++m) { bf16_t* rowp = O + (size_t)(row0 + ai * HALF + m * 16) * ldc + col0;
                float r[8];
#pragma unroll
                for (int n = 0; n < 2; ++n)
#pragma unroll
                    for (int j = 0; j < 4; ++j) { const float g = acc[ai][0][m][n][j], uu = acc[ai][1][m][n][j]; r[n * 4 + j] = g / (1.0f + __expf(-g)) * uu; }
                u32x4 w; w.x = cvt_pk_bf16(r[0], r[1]); w.y = cvt_pk_bf16(r[2], r[3]); w.z = cvt_pk_bf16(r[4], r[5]); w.w = cvt_pk_bf16(r[6], r[7]);
                *(u32x4*)rowp = w; }
    }
};
struct EpiResid {
    static constexpr bool PERM = false, AFTER_DRAIN = false;
    const float* base_lat; const float* base_ctx; float* out_lat; float* out_ctx; const float* gate; const float* comb; int comb_ld; int nlat_tiles;
    __device__ __forceinline__ void operator()(const f32x4 (&acc)[2][2][4][2], const Unit& u, int wr, int wc, int fr, int fq) const {
        const bool isctx = u.pm >= nlat_tiles;
        const int rloc0 = (isctx ? (u.pm - nlat_tiles) : u.pm) * BM + (u.hs > 0 ? HALF : 0) + wr * 64 + fr, col0 = u.pn * BM + wc * 32 + 4 * fq; const int nai = u.hs >= 0 ? 1 : 2;
        const float* bp = isctx ? base_ctx : base_lat; float* op = isctx ? out_ctx : out_lat;
        const float* gp = gate + (size_t)(isctx ? 8 : (u.pm >> 3)) * 6144 + col0;
        f32x4 gv[2][2];
#pragma unroll
        for (int bj = 0; bj < 2; ++bj)
#pragma unroll
            for (int n = 0; n < 2; ++n) gv[bj][n] = *(const f32x4*)(gp + bj * HALF + n * 16);
#pragma unroll
        for (int ai = 0; ai < 2; ++ai) if (ai < nai)
#pragma unroll
            for (int m = 0; m < 4; ++m) { const int rl = rloc0 + ai * HALF + m * 16; const size_t off = (size_t)rl * 1024 + col0;
                const float cs = comb ? comb[(size_t)rl * comb_ld] : 1.0f;
#pragma unroll
                for (int bj = 0; bj < 2; ++bj)
#pragma unroll
                    for (int n = 0; n < 2; ++n) { const f32x4 bs = *(const f32x4*)(bp + off + bj * HALF + n * 16);
                        *(f32x4*)(op + off + bj * HALF + n * 16) = bs + gv[bj][n] * acc[ai][bj][m][n] * cs; } }
    }
};

struct EpiNull {
    static constexpr bool PERM = true, AFTER_DRAIN = false;
    bf16_t* O; int ldc;
    __device__ __forceinline__ void operator()(const f32x4 (&acc)[2][2][4][2], const Unit& u, int wr, int wc, int fr, int fq) const {
        float s = 0.f;
#pragma unroll
        for (int ai = 0; ai < 2; ++ai)
#pragma unroll
            for (int bj = 0; bj < 2; ++bj)
#pragma unroll
                for (int m = 0; m < 4; ++m)
#pragma unroll
                    for (int n = 0; n < 2; ++n) s += acc[ai][bj][m][n][0] + acc[ai][bj][m][n][1] + acc[ai][bj][m][n][2] + acc[ai][bj][m][n][3];
        if (s == 12345.678f) O[0] = (bf16_t)1;
    }
};

struct EpiProj {
    static constexpr bool PERM = true, AFTER_DRAIN = false;
    bf16_t* O; int ldc; const float* rope; const float* qgain; const float* kgain; int nlat_tiles;
    __device__ __forceinline__ void operator()(const f32x4 (&acc)[2][2][4][2], const Unit& u, int wr, int wc, int fr, int fq) const {
        const int row0 = u.pm * BM + (u.hs > 0 ? HALF : 0) + wr * 64 + fr, col0 = u.pn * BM + wc * 32 + 8 * fq; const int nai = u.hs >= 0 ? 1 : 2;
        const int pn = u.pn; const bool lat = u.pm < nlat_tiles;
        const bool isrope = pn < 2 && lat, isnorm = pn >= 8 && pn < 12; const float sc = (pn == 1) ? 0.125f : 1.0f;
        const float* gp = (pn < 10 ? qgain : kgain) + 32 * (fq >> 1) + 8 * (fq & 1);
#pragma unroll
        for (int ai = 0; ai < 2; ++ai) if (ai < nai)
#pragma unroll
            for (int m = 0; m < 4; ++m) { const int row = row0 + ai * HALF + m * 16; bf16_t* rowp = O + (size_t)row * ldc + col0;
                f32x4 x1[2] = {acc[ai][0][m][0], acc[ai][0][m][1]}, x2[2] = {acc[ai][1][m][0], acc[ai][1][m][1]};
                if (isrope) { const int t = row & (SEQ - 1); const int pos = (fq >> 1) ? (t & 63) : (t >> 6); const float* rp = rope + (size_t)(pos * 16 + 8 * (fq & 1)) * 2;
#pragma unroll
                    for (int n = 0; n < 2; ++n) { const f32x4 cs0 = *(const f32x4*)(rp + 8 * n), cs1 = *(const f32x4*)(rp + 8 * n + 4);
                        const f32x4 a1 = x1[n], a2 = x2[n];
                        x1[n] = (f32x4){a1[0] * cs0[0] - a2[0] * cs0[1], a1[1] * cs0[2] - a2[1] * cs0[3], a1[2] * cs1[0] - a2[2] * cs1[1], a1[3] * cs1[2] - a2[3] * cs1[3]};
                        x2[n] = (f32x4){a1[0] * cs0[1] + a2[0] * cs0[0], a1[1] * cs0[3] + a2[1] * cs0[2], a1[2] * cs1[1] + a2[2] * cs1[0], a1[3] * cs1[3] + a2[3] * cs1[2]}; } }
                if (isnorm) { float ss = 0.f;
#pragma unroll
                    for (int n = 0; n < 2; ++n) ss += (x1[n][0] * x1[n][0] + x1[n][1] * x1[n][1]) + (x1[n][2] * x1[n][2] + x1[n][3] * x1[n][3]) + (x2[n][0] * x2[n][0] + x2[n][1] * x2[n][1]) + (x2[n][2] * x2[n][2] + x2[n][3] * x2[n][3]);
                    ss = ::sum_g4(ss); const float rs = rsqrtf(ss * (1.0f / 64.0f) + 1e-6f);
#pragma unroll
                    for (int n = 0; n < 2; ++n) { x1[n] = x1[n] * rs * *(const f32x4*)(gp + 4 * n); x2[n] = x2[n] * rs * *(const f32x4*)(gp + 16 + 4 * n); } }
                u32x4 w1, w2;
                w1.x = cvt_pk_bf16(x1[0][0] * sc, x1[0][1] * sc); w1.y = cvt_pk_bf16(x1[0][2] * sc, x1[0][3] * sc); w1.z = cvt_pk_bf16(x1[1][0] * sc, x1[1][1] * sc); w1.w = cvt_pk_bf16(x1[1][2] * sc, x1[1][3] * sc);
                w2.x = cvt_pk_bf16(x2[0][0] * sc, x2[0][1] * sc); w2.y = cvt_pk_bf16(x2[0][2] * sc, x2[0][3] * sc); w2.z = cvt_pk_bf16(x2[1][0] * sc, x2[1][1] * sc); w2.w = cvt_pk_bf16(x2[1][2] * sc, x2[1][3] * sc);
                *(u32x4*)rowp = w1; *(u32x4*)(rowp + HALF) = w2;
                asm volatile("" ::: "memory"); }
    }
};
template <class Epi, class Sched, bool STAMP = false>
__device__ __forceinline__ void gemm_phase(PG8_LAS unsigned char* lds, const Gemm g, const Sched& S, const Epi& E, unsigned long long* stamps, int tid_in) {
    int tid_ = tid_in; asm volatile("" : "+v"(tid_)); const int tid = tid_, wid = __builtin_amdgcn_readfirstlane(tid >> 6), lane = tid & 63, wr = wid >> 2, wc = wid & 3, fr = lane & 15, fq = lane >> 4;
    const int K = g.K, nt = K / BK;
    int ts_lo = 0, ts_hi = 0, nts = 0; const unsigned long long rt_entry = STAMP ? (unsigned long long)wall_clock64() : 0ull;
#define PG8_STAMP() do { if (STAMP && wid == 0 && nts < 64) { const unsigned long long _c = (unsigned long long)clock64(); \
        ts_lo = (lane == nts) ? (int)(unsigned)_c : ts_lo; ts_hi = (lane == nts) ? (int)(unsigned)(_c >> 32) : ts_hi; ++nts; } } while (0)
    PG8_STAMP();
    unsigned voffB[2]; int stR[2]; unsigned stC[2];
#pragma unroll
    for (int i = 0; i < 2; ++i) { int R, C; stage_rc(tid * 16 + i * 8192, R, C); const int Rb = Epi::PERM ? ((R & ~31) + perm32(R & 31)) : R;
        stR[i] = R; stC[i] = (unsigned)C * 2u; voffB[i] = (unsigned)(Rb * K + C) * 2u; }
    unsigned vAc0[2], vAc1[2], vAn0[2], vAn1[2];
#define PG8_AROWS(u, d0, d1) do { _Pragma("unroll") for (int _i = 0; _i < 2; ++_i) { d0[_i] = S.arow(u, stR[_i]) * (unsigned)(K * 2) + stC[_i]; d1[_i] = S.arow(u, HALF + stR[_i]) * (unsigned)(K * 2) + stC[_i]; } } while (0)
    const size_t kstep = (size_t)(BK * 2);
    const size_t hstep = (size_t)HALF * K * 2;
    const size_t tstep = 2 * hstep;
    const unsigned ldsw = (unsigned)wid * 1024u;
    const int aoff = lds_byte(wr * 64 + fr, fq * 8), boff = lds_byte(wc * 32 + fr, fq * 8);
#define PG8_SA(b, h) (((b) * 2 + (h)) * HTB)
#define PG8_SB(b, h) ((4 + (b) * 2 + (h)) * HTB)
#define PG8_STAGE(bufoff, gbase, voff) do { _Pragma("unroll") for (int _i = 0; _i < 2; ++_i) \
        __builtin_amdgcn_global_load_lds((const unsigned*)((const char*)(gbase) + (voff)[_i]), (PG8_LAS unsigned*)(lds + (bufoff) + ldsw + _i * 8192), 16, 0, 0); } while (0)
#define PG8_LDA(dst, b, h) do { _Pragma("unroll") for (int m = 0; m < 4; ++m) _Pragma("unroll") for (int k = 0; k < 2; ++k) dst[m][k] = *(const PG8_LAS bf16x8*)(lds + PG8_SA(b, h) + aoff + m * 2048 + k * 1024); } while (0)
#define PG8_LDB(dst, b, h) do { _Pragma("unroll") for (int n = 0; n < 2; ++n) _Pragma("unroll") for (int k = 0; k < 2; ++k) dst[n][k] = *(const PG8_LAS bf16x8*)(lds + PG8_SB(b, h) + boff + n * 2048 + k * 1024); } while (0)
#define PG8_MMA(ai, bj, At, Bt) do { __builtin_amdgcn_s_setprio(1); _Pragma("unroll") for (int m = 0; m < 4; ++m) _Pragma("unroll") for (int n = 0; n < 2; ++n) _Pragma("unroll") for (int k = 0; k < 2; ++k) \
        acc[ai][bj][m][n] = __builtin_amdgcn_mfma_f32_16x16x32_bf16(Bt[n][k], At[m][k], acc[ai][bj][m][n], 0, 0, 0); __builtin_amdgcn_s_setprio(0); } while (0)
#define PG8_WAIT_V(n) asm volatile("s_waitcnt vmcnt(" #n ")" ::: "memory")
#define PG8_WAIT_L(n) asm volatile("s_waitcnt lgkmcnt(" #n ")" ::: "memory")
#define PG8_BAR __builtin_amdgcn_s_barrier()
#define PG8_SCHED __builtin_amdgcn_sched_barrier(0)
    Unit cur, nxt; int ui = 0;
    if (!S.next(0, cur)) return;
    f32x4 acc[2][2][4][2];
#pragma unroll
    for (int a = 0; a < 2; ++a)
#pragma unroll
        for (int b = 0; b < 2; ++b)
#pragma unroll
            for (int m = 0; m < 4; ++m)
#pragma unroll
                for (int n = 0; n < 2; ++n) acc[a][b][m][n] = (f32x4){0.f, 0.f, 0.f, 0.f};
    bf16x8 At[4][2], B0[2][2], B1[2][2];
    const char* const cA = (const char*)g.A; const char* cB = S.bbase(cur);
    PG8_AROWS(cur, vAc0, vAc1);
    S.a_ready(cur);
    PG8_STAGE(PG8_SB(0, 0), cB, voffB); PG8_STAGE(PG8_SA(0, 0), cA, vAc0); PG8_STAGE(PG8_SB(0, 1), cB + hstep, voffB); PG8_STAGE(PG8_SA(0, 1), cA, vAc1);
    if (wr == 1) PG8_BAR;
    PG8_WAIT_V(4); PG8_BAR;
    PG8_STAGE(PG8_SB(1, 0), cB + kstep, voffB); PG8_STAGE(PG8_SA(1, 0), cA + kstep, vAc0); PG8_STAGE(PG8_SB(1, 1), cB + hstep + kstep, voffB);
    PG8_WAIT_V(6); PG8_BAR;
    PG8_STAMP();
    for (;;) {
        const bool has_next = S.next(ui + 1, nxt);
        const char* nB = has_next ? S.bbase(nxt) : cB;
        if (has_next) PG8_AROWS(nxt, vAn0, vAn1); else { _Pragma("unroll") for (int _i = 0; _i < 2; ++_i) { vAn0[_i] = vAc0[_i]; vAn1[_i] = vAc1[_i]; } }
        const bool full = cur.hs < 0;
        for (int t = 0; t < nt; t += 2) {
            const bool last = (t == nt - 2);
            const char* a1 = cA + (size_t)(t + 1) * kstep;
            const char* a2 = last ? cA : cA + (size_t)(t + 2) * kstep; const char* b2 = last ? nB : cB + (size_t)(t + 2) * kstep;
            const char* a3 = a2 + kstep; const char* b3 = b2 + kstep;
            unsigned v20[2], v21[2];
#pragma unroll
            for (int _i = 0; _i < 2; ++_i) { v20[_i] = last ? vAn0[_i] : vAc0[_i]; v21[_i] = last ? vAn1[_i] : vAc1[_i]; }
            if (last && has_next) S.a_ready(nxt);
            PG8_LDB(B0, 0, 0); PG8_SCHED; PG8_LDA(At, 0, 0); PG8_STAGE(PG8_SA(1, 1), a1, vAc1);
            PG8_WAIT_L(8); PG8_BAR; PG8_WAIT_L(0); PG8_MMA(0, 0, At, B0); PG8_BAR; PG8_SCHED;
            PG8_LDB(B1, 0, 1); PG8_STAGE(PG8_SB(0, 0), b2, voffB);
            PG8_BAR; PG8_WAIT_L(0); PG8_MMA(0, 1, At, B1); PG8_BAR;
            if (full) PG8_LDA(At, 0, 1); PG8_STAGE(PG8_SA(0, 0), a2, v20);
            PG8_BAR; PG8_WAIT_L(0); if (full) PG8_MMA(1, 0, At, B0); PG8_BAR; PG8_SCHED;
            PG8_STAGE(PG8_SB(0, 1), b2 + hstep, voffB);
            PG8_WAIT_V(6); PG8_BAR; if (full) PG8_MMA(1, 1, At, B1); PG8_BAR;
            PG8_LDB(B0, 1, 0); PG8_SCHED; PG8_LDA(At, 1, 0); PG8_STAGE(PG8_SA(0, 1), a2, v21);
            PG8_WAIT_L(8); PG8_BAR; PG8_WAIT_L(0); PG8_MMA(0, 0, At, B0); PG8_BAR; PG8_SCHED;
            PG8_LDB(B1, 1, 1); PG8_STAGE(PG8_SB(1, 0), b3, voffB);
            PG8_BAR; PG8_WAIT_L(0); PG8_MMA(0, 1, At, B1); PG8_BAR;
            if (full) PG8_LDA(At, 1, 1); PG8_STAGE(PG8_SA(1, 0), a3, v20);
            PG8_BAR; PG8_WAIT_L(0); if (full) PG8_MMA(1, 0, At, B0); PG8_BAR; PG8_SCHED;
            PG8_STAGE(PG8_SB(1, 1), b3 + hstep, voffB);
            PG8_WAIT_V(6); PG8_BAR; if (full) PG8_MMA(1, 1, At, B1); PG8_BAR;
        }
        PG8_STAMP();
        if constexpr (!Epi::AFTER_DRAIN) { E(acc, cur, wr, wc, fr, fq); S.done(cur); }
        PG8_STAMP();
        if (!has_next) break;
#pragma unroll
        for (int a = 0; a < 2; ++a)
#pragma unroll
            for (int b = 0; b < 2; ++b)
#pragma unroll
                for (int m = 0; m < 4; ++m)
#pragma unroll
                    for (int n = 0; n < 2; ++n) acc[a][b][m][n] = (f32x4){0.f, 0.f, 0.f, 0.f};
        cur = nxt; cB = nB; ++ui;
#pragma unroll
        for (int _i = 0; _i < 2; ++_i) { vAc0[_i] = vAn0[_i]; vAc1[_i] = vAn1[_i]; }
    }
    PG8_WAIT_V(0);
    if (wr == 0) PG8_BAR;
    PG8_BAR;
    if constexpr (Epi::AFTER_DRAIN) { E.fused(acc, cur, wr, wc, fr, fq, lds, wid, lane); S.done(cur); }
    PG8_STAMP();
    if (STAMP && wid == 0) { stamps[lane] = lane < nts ? (((unsigned long long)(unsigned)ts_hi << 32) | (unsigned)ts_lo) : 0ull;
        if (lane == 62) stamps[62] = rt_entry; if (lane == 63) stamps[63] = (unsigned long long)wall_clock64(); }
#undef PG8_STAMP
#undef PG8_SA
#undef PG8_AROWS
#undef PG8_SB
#undef PG8_STAGE
#undef PG8_LDA
#undef PG8_LDB
#undef PG8_MMA
#undef PG8_WAIT_V
#undef PG8_WAIT_L
#undef PG8_BAR
#undef PG8_SCHED
}
}
#define XB_TMO      128
#define XB_XCNT(j)  (256  + 64 * (j))
#define XB_XSUB(j)  (1280 + 64 * (j))
#define XB_XGEN(j)  (2304 + 64 * (j))
#define XB_TOP      3328
#define XB_TOPGEN   3392
#define XCD_BAR_WORDS 3456
#define XB_SPIN_CAP (1u << 24)

__device__ __forceinline__ unsigned xb_ld(unsigned* p)              { return __hip_atomic_load(p, __ATOMIC_RELAXED, __HIP_MEMORY_SCOPE_AGENT); }
__device__ __forceinline__ unsigned xb_add(unsigned* p, unsigned v) { return __hip_atomic_fetch_add(p, v, __ATOMIC_RELAXED, __HIP_MEMORY_SCOPE_AGENT); }
__device__ __forceinline__ unsigned xb_xcc_id() { return (unsigned)__builtin_amdgcn_s_getreg((3 << 11) | 20) & 0xFu; }
#define XB_SPIN(cond, bar) do { unsigned _sp = 0; while (cond) { __builtin_amdgcn_s_sleep(1); \
    if ((++_sp & 255u) == 0u) { if (xb_ld(&(bar)[XB_TMO])) break; if (_sp > XB_SPIN_CAP) { atomicAdd(&(bar)[XB_TMO], 1u); break; } } } } while (0)

struct XcdBarrier {
    unsigned* bar; unsigned x;
    volatile LAS unsigned* st;
};

__device__ __forceinline__ XcdBarrier xcd_barrier_post(unsigned* bar, volatile LAS unsigned* st) {
    XcdBarrier b; b.bar = bar; b.x = xb_xcc_id(); b.st = st;
    if (threadIdx.x == 0) (void)xb_add(&bar[XB_XCNT(b.x)], 1u);
    return b;
}
__device__ __forceinline__ void xcd_barrier_complete(unsigned* bar, unsigned x, unsigned& nloc, unsigned& nx) {
    const unsigned G = gridDim.x * gridDim.y * gridDim.z;
    unsigned sum, cnt, mine, sp = 0u;
    for (;;) {
        sum = 0u; cnt = 0u; mine = 0u;
#pragma unroll
        for (unsigned j = 0; j < 16; ++j) { const unsigned c = xb_ld(&bar[XB_XCNT(j)]); sum += c; cnt += (c > 0u) ? 1u : 0u; mine = (j == x) ? c : mine; }
        if (sum == G) break;
        __builtin_amdgcn_s_sleep(1);
        if ((++sp & 255u) == 0u) { if (xb_ld(&bar[XB_TMO])) break; if (sp > XB_SPIN_CAP) { atomicAdd(&bar[XB_TMO], 1u); break; } }
    }
    nloc = mine > 0u ? mine : 1u; nx = cnt > 0u ? cnt : 1u;
}

__device__ __forceinline__ void xcd_barrier(const XcdBarrier& b) {
    asm volatile("s_waitcnt vmcnt(0)" ::: "memory");
    __syncthreads();
    if (threadIdx.x == 0) {
        unsigned* bar = b.bar;
        __builtin_amdgcn_s_waitcnt(0);
        unsigned nloc = b.st[0], nx = b.st[1];
        if (nloc == 0u) { xcd_barrier_complete(bar, b.x, nloc, nx); b.st[0] = nloc; b.st[1] = nx; }
        const unsigned old = xb_add(&bar[XB_XSUB(b.x)], 1u);
        const unsigned gen = old / nloc;
        if (old + 1u == (gen + 1u) * nloc) {
            __builtin_amdgcn_fence(__ATOMIC_RELEASE, "agent");
            asm volatile("s_waitcnt vmcnt(0)" ::: "memory");
            const unsigned og = xb_add(&bar[XB_TOP], 1u);
            const unsigned tg = og / nx;
            if (og + 1u == (tg + 1u) * nx) xb_add(&bar[XB_TOPGEN], 1u);
            else XB_SPIN(xb_ld(&bar[XB_TOPGEN]) == tg, bar);
            __builtin_amdgcn_fence(__ATOMIC_ACQUIRE, "agent");
            xb_add(&bar[XB_XGEN(b.x)], 1u);
            asm volatile("s_waitcnt vmcnt(0)" ::: "memory");
        } else {
            XB_SPIN(xb_ld(&bar[XB_XGEN(b.x)]) == gen, bar);
            __builtin_amdgcn_fence(__ATOMIC_ACQUIRE, "agent");
            asm volatile("s_waitcnt vmcnt(0)" ::: "memory");
        }
    }
    __syncthreads();
}

constexpr int SCR_BYTES = 139264;
constexpr int MISC_OFF = SCR_BYTES;
constexpr int LDS_BYTES = 147456;
constexpr int CW_BAR = 4096;
constexpr int NTHR = 512, NWAVES = 8;
constexpr int CW_MOE = 8192;

__device__ __forceinline__ void transpose_item(const float* W, int ldw, int col0, int K, bf16_t* WT, int drow0, int kb, LAS float* scr, int lane, int gap16 = 0) {
    const int k0 = 64 * kb; const int cs = col0 + (lane & 31) + ((lane & 16) ? gap16 : 0);
    float v[32];
#pragma unroll
    for (int i = 0; i < 32; ++i) v[i] = W[(size_t)(k0 + 2 * i + (lane >> 5)) * ldw + cs];
#pragma unroll
    for (int i = 0; i < 32; ++i) scr[(2 * i + (lane >> 5)) * 33 + (lane & 31)] = v[i];
    asm volatile("s_waitcnt lgkmcnt(0)" ::: "memory");
    const int c = lane & 7;
#pragma unroll
    for (int j = 0; j < 4; ++j) { const int n = (lane >> 3) + 8 * j; const LAS float* s = scr + (8 * c) * 33 + n;
        u32x4 o; o.x = pk2(s[0 * 33], s[1 * 33]); o.y = pk2(s[2 * 33], s[3 * 33]); o.z = pk2(s[4 * 33], s[5 * 33]); o.w = pk2(s[6 * 33], s[7 * 33]);
        *(u32x4*)(WT + (size_t)(drow0 + n) * K + k0 + 8 * c) = o; }
    asm volatile("s_waitcnt lgkmcnt(0)" ::: "memory");
}
__device__ __forceinline__ void up_item(const float* wg, const float* wu, bf16_t* WT, int it, LAS float* scr, int lane) {
    const int nb = it >> 4, kb = it & 15, r0 = 32 * nb, pn = r0 >> 8, p = r0 & 255;
    transpose_item(p < 128 ? wg : wu, DFF, 128 * pn + (p & 127), DM, WT, r0, kb, scr, lane);
}
__device__ __forceinline__ void dn_item(const float* wd, bf16_t* WT, int it, LAS float* scr, int lane) {
    const int nb = it / 44, kb = it % 44;
    transpose_item(wd, DM, 32 * nb, DFF, WT, 32 * nb, kb, scr, lane);
}
constexpr int IT_IN = 112 * 16, IT_OUT = 32 * 16, IT_UP = 176 * 16, IT_DN = 32 * 44;
constexpr int IT_TOTAL = 2 * IT_IN + 2 * IT_OUT + IT_UP + IT_DN + NEXP * (IT_UP + IT_DN);

__device__ __forceinline__ void convert_flat_item(const Args& a, unsigned char* ws, int it, LAS float* scr, int lane) {
    if (it < 2 * IT_IN) { const int l = it / IT_IN; it -= l * IT_IN; const int nb = it >> 4, kb = it & 15, r0 = 32 * nb;
        const int pn = r0 >> 8, p = r0 & 255; const bool hl = pn < 2 || (pn >= 8 && pn < 12);
        const int cbase = (pn < 8 ? 256 * pn : 256 * pn + 16);
        const int col0 = hl ? cbase + 64 * ((p >> 5) & 3) + 16 * (p >> 7) : cbase + p;
        transpose_item(a.in[8] + (size_t)l * DM * DIN, DIN, col0, DM, (bf16_t*)(ws + WS_WTIN) + (size_t)l * NPW * DM, r0, kb, scr, lane, hl ? 16 : 0); return; }
    it -= 2 * IT_IN;
    if (it < 2 * IT_OUT) { const int l = it / IT_OUT; it -= l * IT_OUT; const int nb = it >> 4, kb = it & 15;
        transpose_item(a.in[16] + (size_t)l * DM * DM, DM, 32 * nb, DM, (bf16_t*)(ws + WS_WTOUT) + (size_t)l * DM * DM, 32 * nb, kb, scr, lane); return; }
    it -= 2 * IT_OUT;
    if (it < IT_UP) { up_item(a.in[17], a.in[18], (bf16_t*)(ws + WS_WTUP), it, scr, lane); return; }
    it -= IT_UP;
    if (it < IT_DN) { dn_item(a.in[19], (bf16_t*)(ws + WS_WTDN), it, scr, lane); return; }
    it -= IT_DN;
    if (it < NEXP * IT_UP) { const int e = it / IT_UP; it -= e * IT_UP;
        up_item(a.in[21] + (size_t)e * DM * DFF, a.in[22] + (size_t)e * DM * DFF, (bf16_t*)(ws + WS_WTMUP) + (size_t)e * NUP * DM, it, scr, lane); return; }
    it -= NEXP * IT_UP;
    { const int e = it / IT_DN; it -= e * IT_DN; dn_item(a.in[23] + (size_t)e * DFF * DM, (bf16_t*)(ws + WS_WTMDN) + (size_t)e * DM * DFF, it, scr, lane); }
}
constexpr int N_EARLY = IT_IN + IT_OUT + IT_UP + IT_DN, N_DEFER = IT_TOTAL - N_EARLY, N_DEFER_L1 = IT_IN + IT_OUT;
__device__ __forceinline__ int early_to_flat(int i) { if (i < IT_IN) return i; i -= IT_IN; if (i < IT_OUT) return 2 * IT_IN + i; return 2 * IT_IN + 2 * IT_OUT + (i - IT_OUT); }
__device__ __forceinline__ int defer_to_flat(int d) { if (d < IT_IN) return IT_IN + d; d -= IT_IN; if (d < IT_OUT) return 2 * IT_IN + IT_OUT + d; return 2 * IT_IN + 2 * IT_OUT + IT_UP + IT_DN + (d - IT_OUT); }
#ifndef CVN1
#define CVN1 0
#define CVN2 0
#define CVN3 0
#endif
constexpr int N_MOE_ITEMS = NEXP * (IT_UP + IT_DN);
constexpr int CV_BASE2 = 192 * 8 * CVN1, CV_BASE3 = CV_BASE2 + 160 * 8 * CVN2, CV_HIDDEN_ = CV_BASE3 + 192 * 8 * CVN3, CV_HIDDEN = CV_HIDDEN_ < N_MOE_ITEMS ? CV_HIDDEN_ : N_MOE_ITEMS;
__device__ __forceinline__ void convert_window(const Args& a, LAS unsigned char* lds, int lane, int wave, int G, int base, int rank, int n) {
    if (G != 256) return;
    unsigned char* ws = a.ws; LAS float* scr = (LAS float*)(lds + 65536 + wave * 8704);
    for (int j = 0; j < n; ++j) { const int m = base + (rank * NWAVES + wave) * n + j; if (m < CV_HIDDEN) convert_flat_item(a, ws, defer_to_flat(N_DEFER_L1 + m), scr, lane); }
}
__device__ __forceinline__ void phase_prologue(const Args& a, LAS unsigned char* lds, int tid, int lane, int wave, int bid, int G) {
    unsigned char* ws = a.ws;
    {
        LAS float* scr = (LAS float*)(lds + wave * 8704);
        const int gw = bid * NWAVES + wave, NGW = G * NWAVES;
        const int hid = (G == 256) ? CV_HIDDEN : 0, npro = N_EARLY + N_DEFER - hid;
        for (int i = gw; i < npro; i += NGW) { const int dd = i - N_EARLY; convert_flat_item(a, ws, i < N_EARLY ? early_to_flat(i) : defer_to_flat(dd < N_DEFER_L1 ? dd : dd + hid), scr, lane); }
    }
    __syncthreads();
    {
        const int gt = bid * NTHR + tid;
        if (gt < 1024) { const int pos = gt >> 4, i = gt & 15;
            double inv = 1.0; for (int q = 0; q < i; ++q) inv *= 0.56234132519034908;
            const float angf = (float)pos * (float)inv; const double ang = (double)angf;
            const double kq = rint(ang * 0.63661977236758134); const double r = ang - kq * 1.5707963267948966 - kq * 6.123233995736766e-17; const double r2 = r * r;
            double sn = r * (1.0 + r2 * (-1.0 / 6 + r2 * (1.0 / 120 + r2 * (-1.0 / 5040 + r2 * (1.0 / 362880 + r2 * (-1.0 / 39916800 + r2 * (1.0 / 6227020800.0)))))));
            double cs = 1.0 + r2 * (-0.5 + r2 * (1.0 / 24 + r2 * (-1.0 / 720 + r2 * (1.0 / 40320 + r2 * (-1.0 / 3628800 + r2 * (1.0 / 479001600.0 + r2 * (-1.0 / 87178291200.0)))))));
            const int kk = ((int)kq) & 3; double c2, s2;
            if (kk == 0) { c2 = cs; s2 = sn; } else if (kk == 1) { c2 = -sn; s2 = cs; } else if (kk == 2) { c2 = -cs; s2 = -sn; } else { c2 = sn; s2 = -cs; }
            float* R = (float*)(ws + WS_ROPE); R[gt * 2] = (float)c2; R[gt * 2 + 1] = (float)s2; }
    }
    {
        LAS float* sc = (LAS float*)(lds + 73728);
        LAS float* red = (LAS float*)(lds + 73728 + 36864);
        for (int i = tid; i < 9 * 1024; i += NTHR) { const float v = i < 8192 ? a.in[1][i] : a.in[3][i - 8192]; sc[i] = v / (1.0f + __expf(-v)); }
        __syncthreads();
        for (int item = bid; item < 192; item += G) {
            const int l = item / 96, n0 = (item % 96) * 64;
            const float* wm = a.in[6] + (size_t)l * DM * 6144 + n0 + lane;
            float acc[9];
#pragma unroll
            for (int b = 0; b < 9; ++b) acc[b] = 0.f;
#pragma unroll 4
            for (int kk = 0; kk < 128; ++kk) { const int k = wave * 128 + kk; const float w = wm[(size_t)k * 6144];
#pragma unroll
                for (int b = 0; b < 9; ++b) acc[b] += sc[b * 1024 + k] * w; }
#pragma unroll
            for (int b = 0; b < 9; ++b) red[(wave * 9 + b) * 64 + lane] = acc[b];
            __syncthreads();
            for (int o = tid; o < 576; o += NTHR) { const int b = o >> 6, ln = o & 63; float s = a.in[7][(size_t)l * 6144 + n0 + ln];
#pragma unroll
                for (int w = 0; w < 8; ++w) s += red[(w * 9 + b) * 64 + ln];
                ((float*)(ws + WS_MOD))[((size_t)l * 9 + b) * 6144 + n0 + ln] = s; }
            __syncthreads();
        }
    }
}

typedef short bf16x8 __attribute__((ext_vector_type(8)));
typedef short s16x4 __attribute__((ext_vector_type(4)));
constexpr int IST = 160;
__device__ __forceinline__ f32x4 mfma16(bf16x8 a, bf16x8 b, f32x4 c) { return __builtin_amdgcn_mfma_f32_16x16x32_bf16(a, b, c, 0, 0, 0); }
__device__ __forceinline__ bf16x8 frag_row(LAS const unsigned char* img, int row0, int k0, int lane) {
    return *(const LAS bf16x8*)(img + (row0 + (lane & 15)) * IST + (k0 + 8 * (lane >> 4)) * 2);
}
template <bool PERMK>
__device__ __forceinline__ bf16x8 frag_tr(LAS const unsigned char* img, int r0, int c0, int lane) {
    const int g = lane >> 4, i = lane & 15, q = i >> 2, p = i & 3;
    const unsigned addr = (unsigned)(size_t)(img + (r0 + (PERMK ? 4 : 8) * g + q) * IST + (c0 + 4 * p) * 2);
    s16x4 lo, hi;
    if (PERMK) asm volatile("ds_read_b64_tr_b16 %0, %2\n\tds_read_b64_tr_b16 %1, %2 offset:2560\n\ts_waitcnt lgkmcnt(0)" : "=&v"(lo), "=&v"(hi) : "v"(addr) : "memory");
    else       asm volatile("ds_read_b64_tr_b16 %0, %2\n\tds_read_b64_tr_b16 %1, %2 offset:640\n\ts_waitcnt lgkmcnt(0)" : "=&v"(lo), "=&v"(hi) : "v"(addr) : "memory");
    bf16x8 r; r[0] = lo[0]; r[1] = lo[1]; r[2] = lo[2]; r[3] = lo[3]; r[4] = hi[0]; r[5] = hi[1]; r[6] = hi[2]; r[7] = hi[3];
    return r;
}
template <bool PERMK>
__device__ __forceinline__ void frag_tr_x4(LAS const unsigned char* img, int r0, int c0, int lane, bf16x8 (&out)[4]) {
    const int g = lane >> 4, i = lane & 15, q = i >> 2, p = i & 3;
    const unsigned addr = (unsigned)(size_t)(img + (r0 + (PERMK ? 4 : 8) * g + q) * IST + (c0 + 4 * p) * 2);
    s16x4 l0, h0, l1, h1, l2, h2, l3, h3;
    if (PERMK) asm volatile("ds_read_b64_tr_b16 %0, %8\n\tds_read_b64_tr_b16 %1, %8 offset:2560\n\tds_read_b64_tr_b16 %2, %8 offset:32\n\tds_read_b64_tr_b16 %3, %8 offset:2592\n\t"
                            "ds_read_b64_tr_b16 %4, %8 offset:64\n\tds_read_b64_tr_b16 %5, %8 offset:2624\n\tds_read_b64_tr_b16 %6, %8 offset:96\n\tds_read_b64_tr_b16 %7, %8 offset:2656\n\ts_waitcnt lgkmcnt(0)"
                            : "=&v"(l0), "=&v"(h0), "=&v"(l1), "=&v"(h1), "=&v"(l2), "=&v"(h2), "=&v"(l3), "=&v"(h3) : "v"(addr) : "memory");
    else       asm volatile("ds_read_b64_tr_b16 %0, %8\n\tds_read_b64_tr_b16 %1, %8 offset:640\n\tds_read_b64_tr_b16 %2, %8 offset:32\n\tds_read_b64_tr_b16 %3, %8 offset:672\n\t"
                            "ds_read_b64_tr_b16 %4, %8 offset:64\n\tds_read_b64_tr_b16 %5, %8 offset:704\n\tds_read_b64_tr_b16 %6, %8 offset:96\n\tds_read_b64_tr_b16 %7, %8 offset:736\n\ts_waitcnt lgkmcnt(0)"
                            : "=&v"(l0), "=&v"(h0), "=&v"(l1), "=&v"(h1), "=&v"(l2), "=&v"(h2), "=&v"(l3), "=&v"(h3) : "v"(addr) : "memory");
#define FT_PACK(o, lo, hi) o[0] = lo[0]; o[1] = lo[1]; o[2] = lo[2]; o[3] = lo[3]; o[4] = hi[0]; o[5] = hi[1]; o[6] = hi[2]; o[7] = hi[3];
    FT_PACK(out[0], l0, h0) FT_PACK(out[1], l1, h1) FT_PACK(out[2], l2, h2) FT_PACK(out[3], l3, h3)
#undef FT_PACK
}
__device__ __forceinline__ bf16x8 pack8(f32x4 a, f32x4 b) {
    union { u32x4 u; bf16x8 v; } x; x.u.x = pk2(a[0], a[1]); x.u.y = pk2(a[2], a[3]); x.u.z = pk2(b[0], b[1]); x.u.w = pk2(b[2], b[3]); return x.v;
}

__device__ __forceinline__ void phase_norm1(const Args& a, int l, LAS unsigned char* lds, int tid, int lane, int wave, int bid, int G) {
    unsigned char* ws = a.ws;
    constexpr int RST = 2064;
    LAS unsigned char* WgT = lds; LAS unsigned char* Himg = lds + 16 * RST; LAS float* red = (LAS float*)(lds + 32 * RST);
    { const float* w = a.in[8] + (size_t)l * DM * DIN + 2048;
      for (int i = tid; i < 16384; i += NTHR) { const int k = i >> 4, j = i & 15; *(LAS bf16_t*)(WgT + j * RST + k * 2) = (bf16_t)f2bf(w[(size_t)k * DIN + j]); } }
    __syncthreads();
    const float* gam = a.in[4] + (size_t)l * DM;
    const float* mod = (const float*)(ws + WS_MOD) + (size_t)l * 9 * 6144;
    bf16_t* H = (bf16_t*)(ws + WS_H);
    for (int gi = bid; gi < MALL / 16; gi += G) {
#pragma unroll
        for (int rr = 0; rr < 2; ++rr) {
            const int r = 16 * gi + 2 * wave + rr; const bool lat = r < NLAT; const int bi = lat ? (r >> 11) : 8;
            const float* src = (l == 0) ? (lat ? a.in[0] + (size_t)r * DM : a.in[2] + (size_t)(r - NLAT) * DM) : (lat ? a.out + (size_t)r * DM : (const float*)(ws + WS_XC) + (size_t)(r - NLAT) * DM);
            f32x4 v[4]; float ss = 0.f;
#pragma unroll
            for (int j = 0; j < 4; ++j) { v[j] = *(const f32x4*)(src + 4 * lane + 256 * j); ss += (v[j].x * v[j].x + v[j].y * v[j].y) + (v[j].z * v[j].z + v[j].w * v[j].w); }
            const float rstd = rsqrtf(wave_sum(ss) * (1.0f / DM) + EPS);
            const float* mrow = mod + (size_t)bi * 6144;
#pragma unroll
            for (int j = 0; j < 4; ++j) { const int k = 4 * lane + 256 * j;
                const f32x4 g = *(const f32x4*)(gam + k), s = *(const f32x4*)(mrow + 1024 + k), sh = *(const f32x4*)(mrow + k);
                const f32x4 hv = v[j] * rstd * g * (1.0f + s) + sh;
                u32x2 w; w.x = pk2(hv.x, hv.y); w.y = pk2(hv.z, hv.w);
                *(u32x2*)(H + (size_t)r * DM + k) = w; *(LAS u32x2*)(Himg + (2 * wave + rr) * RST + k * 2) = w; }
        }
        __syncthreads();
        f32x4 acc = {0.f, 0.f, 0.f, 0.f};
#pragma unroll
        for (int ks = 0; ks < 4; ++ks) { const int off = (lane & 15) * RST + (128 * wave + 32 * ks + 8 * (lane >> 4)) * 2;
            acc = mfma16(*(const LAS bf16x8*)(Himg + off), *(const LAS bf16x8*)(WgT + off), acc); }
        *(LAS f32x4*)(red + wave * 256 + lane * 4) = acc;
        __syncthreads();
        if (tid < 256) { const int ln = tid & 63, j = tid >> 6; float s = 0.f;
#pragma unroll
            for (int w = 0; w < 8; ++w) s += red[w * 256 + ln * 4 + j];
            const int row = 16 * gi + 4 * (ln >> 4) + j, gate = ln & 15;
            ((float*)(ws + WS_GATES))[(size_t)row * 16 + gate] = s + a.in[12][l * 16 + gate]; }
    }
}

template <int MODE>
__device__ __forceinline__ void phase_norm(const Args& a, int l, LAS unsigned char* lds, int tid, int lane, int wave, int bid, int G) {
    unsigned char* ws = a.ws;
    LAS float* WT = (LAS float*)lds;
    if (MODE == 0) { const float* w = a.in[8] + (size_t)l * DM * DIN + 2048; for (int i = tid; i < 16384; i += NTHR) { const int k = i >> 4, j = i & 15; WT[j * 1024 + k] = w[(size_t)k * DIN + j]; } __syncthreads(); }
    if (MODE == 2) { const float* w = a.in[20]; for (int i = tid; i < 8192; i += NTHR) { const int k = i >> 3, j = i & 7; WT[j * 1024 + k] = w[(size_t)k * 8 + j]; } __syncthreads(); }
    const float* gam = (MODE == 0 ? a.in[4] : a.in[5]) + (size_t)l * DM;
    const float* mod = (const float*)(ws + WS_MOD) + (size_t)l * 9 * 6144;
    const int shoff = MODE == 0 ? 0 : 3072, soff = MODE == 0 ? 1024 : 4096;
    const int nrows = (MODE == 2) ? NLAT : MALL;
    bf16_t* H = (bf16_t*)(ws + WS_H);
    int nrec = 0;
    for (int r = bid * NWAVES + wave; r < nrows; r += G * NWAVES) {
        const bool lat = r < NLAT; const int bi = lat ? (r >> 11) : 8;
        const float* src = (MODE == 0 && l == 0) ? (lat ? a.in[0] + (size_t)r * DM : a.in[2] + (size_t)(r - NLAT) * DM)
                                    : (lat ? a.out + (size_t)r * DM : (const float*)(ws + WS_XC) + (size_t)(r - NLAT) * DM);
        f32x4 v[4]; float ss = 0.f;
#pragma unroll
        for (int j = 0; j < 4; ++j) { v[j] = *(const f32x4*)(src + 4 * lane + 256 * j); ss += (v[j].x * v[j].x + v[j].y * v[j].y) + (v[j].z * v[j].z + v[j].w * v[j].w); }
        const float rstd = rsqrtf(wave_sum(ss) * (1.0f / DM) + EPS);
        const float* mrow = mod + (size_t)bi * 6144;
#pragma unroll
        for (int j = 0; j < 4; ++j) { const int k = 4 * lane + 256 * j;
            const f32x4 g = *(const f32x4*)(gam + k), s = *(const f32x4*)(mrow + soff + k), sh = *(const f32x4*)(mrow + shoff + k);
            v[j] = v[j] * rstd * g * (1.0f + s) + sh;
            u32x2 w; w.x = pk2(v[j].x, v[j].y); w.y = pk2(v[j].z, v[j].w);
            *(u32x2*)(H + (size_t)r * DM + k) = w; }
        if (MODE == 0) {
            float p[16];
#pragma unroll
            for (int jg = 0; jg < 16; ++jg) p[jg] = 0.f;
#pragma unroll
            for (int jg = 0; jg < 16; ++jg) {
#pragma unroll
                for (int j = 0; j < 4; ++j) { const f32x4 w = *(const LAS f32x4*)(WT + jg * 1024 + 4 * lane + 256 * j); p[jg] += (v[j].x * w.x + v[j].y * w.y) + (v[j].z * w.z + v[j].w * w.w); }
                if ((jg & 3) == 3) asm volatile("" ::: "memory"); }
            const float tot = reduce16_lanes(p, lane);
            const int gid = ((lane >> 5) & 1) * 8 + ((lane >> 4) & 1) * 4 + ((lane >> 3) & 1) * 2 + ((lane >> 2) & 1);
            if ((lane & 3) == 0) ((float*)(ws + WS_GATES))[(size_t)r * 16 + gid] = tot + a.in[12][l * 16 + gid];
        }
        if (MODE == 2) {
            float p[8];
#pragma unroll
            for (int e = 0; e < 8; ++e) p[e] = 0.f;
#pragma unroll
            for (int e = 0; e < 8; ++e) {
#pragma unroll
                for (int j = 0; j < 4; ++j) { const f32x4 w = *(const LAS f32x4*)(WT + e * 1024 + 4 * lane + 256 * j); p[e] += (v[j].x * w.x + v[j].y * w.y) + (v[j].z * w.z + v[j].w * w.w); }
                if ((e & 3) == 3) asm volatile("" ::: "memory"); }
            const float tot = reduce8_lanes(p, lane);
            int i1 = 0, i2 = 0; float v1 = -3.0e38f, v2 = -3.0e38f;
#pragma unroll
            for (int e = 0; e < 8; ++e) { const float s = lane_bcast(tot, 32 * (e >> 2) + 16 * ((e >> 1) & 1) + 8 * (e & 1));
                if (s > v1) { v2 = v1; i2 = i1; v1 = s; i1 = e; } else if (s > v2) { v2 = s; i2 = e; } }
            const float w2 = 1.0f / (1.0f + __expf(v1 - v2)), w1 = 1.0f - w2;
            if (lane == 0) { LAS int* rec = (LAS int*)(lds + 32768) + nrec * 32 + wave * 4; rec[0] = i1; rec[1] = i2; rec[2] = __float_as_int(w1); rec[3] = __float_as_int(w2); }
            ++nrec;
        }
    }
    if (MODE == 2) {
        __syncthreads();
        if (tid < 8) {
            const int e = tid; const LAS int* rec = (const LAS int*)(lds + 32768); int cnt = 0;
            const int nk = (nrows - bid * NWAVES + G * NWAVES - 1) / (G * NWAVES);
            for (int k = 0; k < nk; ++k) for (int w = 0; w < NWAVES; ++w) { const int r = bid * NWAVES + w + k * G * NWAVES; if (r < nrows) { const LAS int* q = rec + k * 32 + w * 4; cnt += (q[0] == e) + (q[1] == e); } }
            int pos = (int)atomicAdd((unsigned*)(ws + WS_CTL) + CW_MOE + 64 * e, (unsigned)cnt);
            int* LIST = (int*)(ws + WS_LIST) + e * NLAT; int* TOK = (int*)(ws + WS_COMB);
            for (int k = 0; k < nk; ++k) for (int w = 0; w < NWAVES; ++w) { const int r = bid * NWAVES + w + k * G * NWAVES; if (r < nrows) { const LAS int* q = rec + k * 32 + w * 4;
                if (q[0] == e) { LIST[pos] = r; TOK[r * 8 + 0] = e; TOK[r * 8 + 2] = pos; TOK[r * 8 + 4] = q[2]; ++pos; }
                if (q[1] == e) { LIST[pos] = r; TOK[r * 8 + 1] = e; TOK[r * 8 + 3] = pos; TOK[r * 8 + 5] = q[3]; ++pos; } } }
        }
    }
}

__device__ __forceinline__ void phase_post(const Args& a, int l, int lane, int wave, int bid, int G) {
    unsigned char* ws = a.ws;
    bf16_t* P = (bf16_t*)(ws + WS_BIG); bf16_t* MQK = (bf16_t*)(ws + WS_MQK);
    const float* ROPE = (const float*)(ws + WS_ROPE);
    const float* cw = a.in[10] + (size_t)l * 3 * 512; const float* cb = a.in[11] + (size_t)l * 512;
    const float qg = a.in[13][l * 64 + lane], kg = a.in[14][l * 64 + lane];
    for (int r = bid * NWAVES + wave; r < MALL; r += G * NWAVES) {
        const bool lat = r < NLAT; bf16_t* row = P + (size_t)r * NPW;
        int t, tlen; if (lat) { t = r & (SEQ - 1); tlen = SEQ; } else { t = (r - NLAT) & (CTXL - 1); tlen = CTXL; }
        if (lat) { const int gr = t >> 6, gc = t & 63;
#pragma unroll
            for (int blk = 0; blk < 2; ++blk)
#pragma unroll
                for (int ii = 0; ii < 2; ++ii) { const int pid = lane + 64 * ii, head = pid >> 5, half = (pid >> 4) & 1, i = pid & 15, c1 = (blk ? PC_RK : PC_RQ) + head * 64 + half * 32 + i;
                    const int pos = half ? gc : gr; const float cs = ROPE[(pos * 16 + i) * 2], sn = ROPE[(pos * 16 + i) * 2 + 1];
                    const float x1 = bf2f(row[c1]), x2 = bf2f(row[c1 + 16]); const float sc = blk ? 0.125f : 1.0f;
                    row[c1] = (bf16_t)f2bf((x1 * cs - x2 * sn) * sc); row[c1 + 16] = (bf16_t)f2bf((x1 * sn + x2 * cs) * sc); }
        } else {
#pragma unroll
            for (int ii = 0; ii < 4; ++ii) { const int c = PC_RK + lane + 64 * ii; row[c] = (bf16_t)f2bf(bf2f(row[c]) * 0.125f); }
        }
#pragma unroll
        for (int ii = 0; ii < 8; ++ii) { const int c = lane + 64 * ii;
            const float x0 = bf2f(row[PC_MQ + c]);
            const float xm = t > 0 ? bf2f(row[PC_MQ + c - NPW]) : 0.f, xp = t < tlen - 1 ? bf2f(row[PC_MQ + c + NPW]) : 0.f;
            float y = cb[c] + cw[c] * xm + cw[512 + c] * x0 + cw[1024 + c] * xp;
            y = y / (1.0f + __expf(-y)); if (c >= 256) y *= 0.125f;
            MQK[(size_t)r * 512 + c] = (bf16_t)f2bf(y); }
#pragma unroll
        for (int hh = 0; hh < 16; ++hh) { const int c = PC_NQ + hh * 64 + lane; const float v = bf2f(row[c]);
            const float rs = rsqrtf(wave_sum(v * v) * (1.0f / 64.0f) + EPS);
            row[c] = (bf16_t)f2bf(v * rs * (hh < 8 ? qg : kg)); }
    }
}


__device__ __forceinline__ int hl_off(int hl, int c) { return c < 32 ? 32 * hl + c : 128 + 32 * hl + (c - 32); }
__device__ __forceinline__ u32x4 conv8_pack(const bf16_t* P, int row, int ch, bool hasm, bool hasp, const LAS float* CW) {
    const bf16_t* src = P + (size_t)row * NPW + PC_MQ + ch;
    const u32x4 x0 = *(const u32x4*)src; u32x4 xm = {0u, 0u, 0u, 0u}, xp = xm;
    if (hasm) xm = *(const u32x4*)(src - NPW);
    if (hasp) xp = *(const u32x4*)(src + NPW);
    const f32x4 w0a = *(const LAS f32x4*)(CW + ch), w0b = *(const LAS f32x4*)(CW + ch + 4), w1a = *(const LAS f32x4*)(CW + 512 + ch), w1b = *(const LAS f32x4*)(CW + 512 + ch + 4);
    const f32x4 w2a = *(const LAS f32x4*)(CW + 1024 + ch), w2b = *(const LAS f32x4*)(CW + 1024 + ch + 4), ba = *(const LAS f32x4*)(CW + 1536 + ch), bb = *(const LAS f32x4*)(CW + 1536 + ch + 4);
    float y[8];
    y[0] = ba[0] + w0a[0] * bflo(xm.x) + w1a[0] * bflo(x0.x) + w2a[0] * bflo(xp.x); y[1] = ba[1] + w0a[1] * bfhi(xm.x) + w1a[1] * bfhi(x0.x) + w2a[1] * bfhi(xp.x);
    y[2] = ba[2] + w0a[2] * bflo(xm.y) + w1a[2] * bflo(x0.y) + w2a[2] * bflo(xp.y); y[3] = ba[3] + w0a[3] * bfhi(xm.y) + w1a[3] * bfhi(x0.y) + w2a[3] * bfhi(xp.y);
    y[4] = bb[0] + w0b[0] * bflo(xm.z) + w1b[0] * bflo(x0.z) + w2b[0] * bflo(xp.z); y[5] = bb[1] + w0b[1] * bfhi(xm.z) + w1b[1] * bfhi(x0.z) + w2b[1] * bfhi(xp.z);
    y[6] = bb[2] + w0b[2] * bflo(xm.w) + w1b[2] * bflo(x0.w) + w2b[2] * bflo(xp.w); y[7] = bb[3] + w0b[3] * bfhi(xm.w) + w1b[3] * bfhi(x0.w) + w2b[3] * bfhi(xp.w);
    const float sc = ch >= 256 ? 0.125f : 1.0f;
#pragma unroll
    for (int j = 0; j < 8; ++j) y[j] = y[j] / (1.0f + __expf(-y[j])) * sc;
    u32x4 o; o.x = pk2(y[0], y[1]); o.y = pk2(y[2], y[3]); o.z = pk2(y[4], y[5]); o.w = pk2(y[6], y[7]); return o;
}
__device__ __forceinline__ void conv_weights_to_lds(const Args& a, int l, LAS float* CW, int tid) {
    for (int i = tid; i < 2048; i += NTHR) CW[i] = i < 1536 ? a.in[10][(size_t)l * 1536 + i] : a.in[11][(size_t)l * 512 + (i - 1536)];
}
__device__ __forceinline__ int chunk_row0(int b, int dir, int sc) {
    if (dir == 0) return sc < 2 ? NLAT + b * CTXL + 128 * sc : b * SEQ + 128 * (sc - 2);
    return sc < 2 ? NLAT + b * CTXL + 128 * (1 - sc) : b * SEQ + 128 * (17 - sc);
}
constexpr size_t U_BYTES = 80 * 64 * 2;

__device__ __forceinline__ void phase_chunk_sums(const Args& a, int l, LAS unsigned char* lds, int tid, int lane, int wave, int bid, int G) {
    unsigned char* ws = a.ws;
    const bf16_t* P = (const bf16_t*)(ws + WS_BIG);
    const float* GT = (const float*)(ws + WS_GATES);
    LAS float* CW = (LAS float*)(lds + 49152); conv_weights_to_lds(a, l, CW, tid);
    LAS unsigned char* Kimg = lds;
    LAS unsigned char* Vimg = lds + 128 * IST;
    LAS float* wk = (LAS float*)(lds + 256 * IST);
    LAS float* red = wk + 128;
    const int nitems = 2 * NB * 4 * 2 * 18;
    for (int it = bid; it < nitems; it += G) {
        const int sc = it % 18; int r_ = it / 18; const int dir = r_ & 1; r_ >>= 1; const int h = r_ & 3; r_ >>= 2; const int b = r_ & 7; const int kind = r_ >> 3;
        const int row0 = chunk_row0(b, dir, sc);
        __syncthreads();
        if (kind == 0) { if (tid < 128) { const float lg = logsigmoidf_(a.in[9][(l * 2 + dir) * 4 + h]); wk[tid] = __expf(lg * (float)(dir == 0 ? 127 - tid : tid)); } }
        else if (wave == 0) {
            const float g0i = GT[(size_t)(row0 + lane) * 16 + 4 * dir + h], g1i = GT[(size_t)(row0 + 64 + lane) * 16 + 4 * dir + h];
            const float f0 = logsigmoidf_(GT[(size_t)(row0 + lane) * 16 + 8 + 4 * dir + h]), f1 = logsigmoidf_(GT[(size_t)(row0 + 64 + lane) * 16 + 8 + 4 * dir + h]);
            float s0 = f0, s1 = f1;
#pragma unroll
            for (int o = 1; o < 64; o <<= 1) { const int sl = lane >= o ? lane - o : lane; const float u0 = lane_get(s0, sl), u1 = lane_get(s1, sl); if (lane >= o) { s0 += u0; s1 += u1; } }
            const float t0 = lane_bcast(s0, 63), t1 = lane_bcast(s1, 63), tot = t0 + t1;
            float b0, b1;
            if (dir == 0) { b0 = s0; b1 = t0 + s1; } else { b0 = tot - s0 + f0; b1 = t1 - s1 + f1; }
            const float a0 = g0i - b0, a1 = g1i - b1; const float amax = wave_max(fmaxf(a0, a1));
            wk[lane] = __expf(a0 - amax); wk[lane + 64] = __expf(a1 - amax);
            if (lane == 0) { float* usc = (float*)(ws + WS_USC) + ((size_t)((b * 4 + h) * 2 + dir) * 18 + sc) * 2; usc[0] = tot; usc[1] = amax; }
        }
        __syncthreads();
        {
            const int r = tid >> 2, c8 = (tid & 3) * 16;
            const bf16_t* vsrc = P + (size_t)(row0 + r) * NPW + (kind == 0 ? PC_RV : PC_MV) + h * 64 + c8;
            u32x4 k0, k1;
            if (kind == 0) { const bf16_t* ksrc = P + (size_t)(row0 + r) * NPW + PC_RK + hl_off(h, c8); k0 = *(const u32x4*)ksrc; k1 = *(const u32x4*)(ksrc + 8); }
            else { const int t = (sc < 2 ? 128 * (dir == 0 ? sc : 1 - sc) : 128 * (dir == 0 ? sc - 2 : 17 - sc)) + r; const bool hasm = t > 0, hasp = t < (sc < 2 ? CTXL : SEQ) - 1;
                k0 = conv8_pack(P, row0 + r, 256 + h * 64 + c8, hasm, hasp, CW); k1 = conv8_pack(P, row0 + r, 256 + h * 64 + c8 + 8, hasm, hasp, CW); }
            const u32x4 v0 = *(const u32x4*)vsrc, v1 = *(const u32x4*)(vsrc + 8);
            *(LAS u32x4*)(Kimg + r * IST + c8 * 2) = k0; *(LAS u32x4*)(Kimg + r * IST + c8 * 2 + 16) = k1;
            const float w = wk[r];
            u32x4 o0, o1;
            o0.x = pk2(bflo(v0.x) * w, bfhi(v0.x) * w); o0.y = pk2(bflo(v0.y) * w, bfhi(v0.y) * w); o0.z = pk2(bflo(v0.z) * w, bfhi(v0.z) * w); o0.w = pk2(bflo(v0.w) * w, bfhi(v0.w) * w);
            o1.x = pk2(bflo(v1.x) * w, bfhi(v1.x) * w); o1.y = pk2(bflo(v1.y) * w, bfhi(v1.y) * w); o1.z = pk2(bflo(v1.z) * w, bfhi(v1.z) * w); o1.w = pk2(bflo(v1.w) * w, bfhi(v1.w) * w);
            *(LAS u32x4*)(Vimg + r * IST + c8 * 2) = o0; *(LAS u32x4*)(Vimg + r * IST + c8 * 2 + 16) = o1;
            if ((tid & 3) == 0) { unsigned zz; asm volatile("v_mov_b32 %0, 0" : "=v"(zz)); u32x4 e0; e0.x = f2bf(w); e0.y = zz; e0.z = zz; e0.w = zz; u32x4 z; z.x = zz; z.y = zz; z.z = zz; z.w = zz;
                *(LAS u32x4*)(Vimg + r * IST + 128) = e0; *(LAS u32x4*)(Vimg + r * IST + 144) = z; }
        }
        __syncthreads();
        {
            const int dt = wave & 3, et0 = 2 * (wave >> 2);
            f32x4 u0 = {0.f, 0.f, 0.f, 0.f}, u1 = u0, u2 = u0;
#pragma unroll
            for (int ks = 0; ks < 4; ++ks) {
                const bf16x8 af = frag_tr<false>(Kimg, 32 * ks, 16 * dt, lane);
                const bf16x8 b0 = frag_tr<false>(Vimg, 32 * ks, 16 * et0, lane), b1 = frag_tr<false>(Vimg, 32 * ks, 16 * et0 + 16, lane);
                u0 = mfma16(af, b0, u0); u1 = mfma16(af, b1, u1);
                if (wave < 4) { const bf16x8 b2 = frag_tr<false>(Vimg, 32 * ks, 64, lane); u2 = mfma16(af, b2, u2); }
            }
            bf16_t* U = (bf16_t*)(ws + WS_U + ((size_t)(((kind * NB + b) * 4 + h) * 2 + dir) * 18 + sc) * U_BYTES);
            const int g = lane >> 4, e = lane & 15, d0 = 16 * dt + 4 * g;
            { u32x2 w; w.x = pk2(u0[0], u0[1]); w.y = pk2(u0[2], u0[3]); *(u32x2*)(U + (size_t)(16 * et0 + e) * 64 + d0) = w; }
            { u32x2 w; w.x = pk2(u1[0], u1[1]); w.y = pk2(u1[2], u1[3]); *(u32x2*)(U + (size_t)(16 * et0 + 16 + e) * 64 + d0) = w; }
            if (wave < 4) { u32x2 w; w.x = pk2(u2[0], u2[1]); w.y = pk2(u2[2], u2[3]); *(u32x2*)(U + (size_t)(64 + e) * 64 + d0) = w; }
        }
    }
}

__device__ __forceinline__ void phase_chunk_states(const Args& a, int l, int tid, int bid, int G) {
    unsigned char* ws = a.ws;
    for (int it = bid; it < 2 * NB * 4 * 2; it += G) {
        const int dir = it & 1, h = (it >> 1) & 3, b = (it >> 3) & 7, kind = it >> 6;
        const size_t seq = (size_t)(((kind * NB + b) * 4 + h) * 2 + dir) * 18;
        const unsigned char* Ub = ws + WS_U + seq * U_BYTES; unsigned char* Sb = ws + WS_S + seq * U_BYTES;
        const float* usc = (const float*)(ws + WS_USC) + (size_t)((b * 4 + h) * 2 + dir) * 18 * 2;
        float* sm = (float*)(ws + WS_SM) + (size_t)((b * 4 + h) * 2 + dir) * 18;
        const float dec_ret = __expf(128.0f * logsigmoidf_(a.in[9][(l * 2 + dir) * 4 + h]));
        const int nrow = kind == 0 ? 512 : 520;
        for (int ci = tid; ci < nrow; ci += NTHR) {
            u32x4 v[18];
#pragma unroll
            for (int s = 0; s < 18; ++s) v[s] = *(const u32x4*)(Ub + (size_t)s * U_BYTES + (size_t)ci * 16);
            float acc[8];
#pragma unroll
            for (int j = 0; j < 8; ++j) acc[j] = 0.f;
            float m = 0.f;
#pragma unroll
            for (int s = 0; s < 18; ++s) {
                u32x4 o; o.x = pk2(acc[0], acc[1]); o.y = pk2(acc[2], acc[3]); o.z = pk2(acc[4], acc[5]); o.w = pk2(acc[6], acc[7]);
                *(u32x4*)(Sb + (size_t)s * U_BYTES + (size_t)ci * 16) = o;
                float dk, ck;
                if (kind == 0) { dk = dec_ret; ck = 1.0f; }
                else { if (ci == 0) sm[s] = m; const float bl = usc[2 * s], am = usc[2 * s + 1]; const float mx = fmaxf(m, am); dk = __expf(m - mx); ck = __expf(am - mx); m = bl + mx; }
                acc[0] = dk * acc[0] + ck * bflo(v[s].x); acc[1] = dk * acc[1] + ck * bfhi(v[s].x); acc[2] = dk * acc[2] + ck * bflo(v[s].y); acc[3] = dk * acc[3] + ck * bfhi(v[s].y);
                acc[4] = dk * acc[4] + ck * bflo(v[s].z); acc[5] = dk * acc[5] + ck * bfhi(v[s].z); acc[6] = dk * acc[6] + ck * bflo(v[s].w); acc[7] = dk * acc[7] + ck * bfhi(v[s].w);
            }
        }
    }
}

template <int KIND>
__device__ __forceinline__ float load_state(const unsigned char* ws, int b, int h, int dir, int sc, LAS unsigned char* Simg, int tid) {
    const unsigned char* Sp = ws + WS_S + ((size_t)((((KIND * NB + b) * 4 + h) * 2 + dir) * 18) + sc) * U_BYTES;
    *(LAS u32x4*)(Simg + (tid >> 3) * IST + (tid & 7) * 16) = *(const u32x4*)(Sp + (size_t)tid * 16);
    if (KIND == 1 && tid < 8) *(LAS u32x4*)(Simg + 64 * IST + tid * 16) = *(const u32x4*)(Sp + (size_t)(512 + tid) * 16);
    return KIND == 1 ? ((const float*)(ws + WS_SM))[(size_t)((b * 4 + h) * 2 + dir) * 18 + sc] : 0.f;
}

template <int KIND>
__device__ __forceinline__ void phase_chunk_out(const Args& a, int l, bool need_ctx, LAS unsigned char* lds, int tid, int lane, int wave, int bid, int G) {
    unsigned char* ws = a.ws;
    const bf16_t* P = (const bf16_t*)(ws + WS_BIG);
    const float* GT = (const float*)(ws + WS_GATES); bf16_t* MG = (bf16_t*)(ws + WS_H);
    LAS float* CW = (LAS float*)(lds + 98304); if (KIND == 1) conv_weights_to_lds(a, l, CW, tid);
    LAS unsigned char* Qimg = lds; LAS unsigned char* Kimg = lds + 20480; LAS unsigned char* Vimg = lds + 40960;
    LAS unsigned char* SFimg = lds + 61440; LAS unsigned char* SBimg = lds + 74240;
    LAS float* AF = (LAS float*)(lds + 87040); LAS float* CF = AF + 128; LAS float* BF = AF + 256; LAS float* AB = AF + 384; LAS float* CB = AF + 512; LAS float* BB = AF + 640;
    const int nch = need_ctx ? 18 : 16, nitems = NB * 4 * nch;
    const int g = lane >> 4, qi = 16 * wave + (lane & 15);
    for (int it = (bid + G - (KIND == 0 ? 0 : 64) % G) % G; it < nitems; it += G) {
        const int cc = it % nch; const int bh = it / nch; const int h = bh & 3, b = bh >> 2;
        const bool isctx = cc >= 16; const int c = isctx ? cc - 16 : cc;
        const int row0 = isctx ? NLAT + b * CTXL + 128 * c : b * SEQ + 128 * c;
        const int scf = isctx ? c : 2 + c, scb = isctx ? 1 - c : 17 - c;
        __syncthreads();
        {
            const int r = tid >> 2, c8 = (tid & 3) * 16;
            const bf16_t* vsrc = P + (size_t)(row0 + r) * NPW + (KIND == 0 ? PC_RV : PC_MV) + h * 64 + c8;
            u32x4 q0, q1, k0, k1;
            if (KIND == 0) { const bf16_t* qsrc = P + (size_t)(row0 + r) * NPW + PC_RQ + hl_off(h, c8); const bf16_t* ksrc = P + (size_t)(row0 + r) * NPW + PC_RK + hl_off(h, c8);
                q0 = *(const u32x4*)qsrc; q1 = *(const u32x4*)(qsrc + 8); k0 = *(const u32x4*)ksrc; k1 = *(const u32x4*)(ksrc + 8); }
            else { const int t = 128 * c + r; const bool hasm = t > 0, hasp = t < (isctx ? CTXL : SEQ) - 1;
                q0 = conv8_pack(P, row0 + r, h * 64 + c8, hasm, hasp, CW); q1 = conv8_pack(P, row0 + r, h * 64 + c8 + 8, hasm, hasp, CW);
                k0 = conv8_pack(P, row0 + r, 256 + h * 64 + c8, hasm, hasp, CW); k1 = conv8_pack(P, row0 + r, 256 + h * 64 + c8 + 8, hasm, hasp, CW); }
            const u32x4 v0 = *(const u32x4*)vsrc, v1 = *(const u32x4*)(vsrc + 8);
            *(LAS u32x4*)(Qimg + r * IST + c8 * 2) = q0; *(LAS u32x4*)(Qimg + r * IST + c8 * 2 + 16) = q1;
            *(LAS u32x4*)(Kimg + r * IST + c8 * 2) = k0; *(LAS u32x4*)(Kimg + r * IST + c8 * 2 + 16) = k1;
            *(LAS u32x4*)(Vimg + r * IST + c8 * 2) = v0; *(LAS u32x4*)(Vimg + r * IST + c8 * 2 + 16) = v1;
            if ((tid & 3) == 0) { unsigned zz, one; asm volatile("v_mov_b32 %0, 0\n\tv_mov_b32 %1, 0x3f80" : "=v"(zz), "=v"(one)); u32x4 e0; e0.x = one; e0.y = zz; e0.z = zz; e0.w = zz; u32x4 z; z.x = zz; z.y = zz; z.z = zz; z.w = zz;
                *(LAS u32x4*)(Vimg + r * IST + 128) = e0; *(LAS u32x4*)(Vimg + r * IST + 144) = z; }
        }
        const float mpf = load_state<KIND>(ws, b, h, 0, scf, SFimg, tid);
        const float mpb = load_state<KIND>(ws, b, h, 1, scb, SBimg, tid);
        if (KIND == 1 && wave == 0) {
            const size_t r0_ = (size_t)(row0 + lane) * 16, r1_ = (size_t)(row0 + 64 + lane) * 16;
#pragma unroll
            for (int dir = 0; dir < 2; ++dir) {
                const float i0 = GT[r0_ + 4 * dir + h], i1 = GT[r1_ + 4 * dir + h];
                const float f0 = logsigmoidf_(GT[r0_ + 8 + 4 * dir + h]), f1 = logsigmoidf_(GT[r1_ + 8 + 4 * dir + h]);
                float s0 = f0, s1 = f1;
#pragma unroll
                for (int o = 1; o < 64; o <<= 1) { const int sl = lane >= o ? lane - o : lane; const float u0 = lane_get(s0, sl), u1 = lane_get(s1, sl); if (lane >= o) { s0 += u0; s1 += u1; } }
                const float t0 = lane_bcast(s0, 63), t1 = lane_bcast(s1, 63);
                float b0, b1;
                if (dir == 0) { b0 = s0; b1 = t0 + s1; } else { b0 = t0 + t1 - s0 + f0; b1 = t1 - s1 + f1; }
                const float a0 = i0 - b0, a1 = i1 - b1;
                float x0 = a0, x1 = a1;
                if (dir == 0) {
#pragma unroll
                    for (int o = 1; o < 64; o <<= 1) { const int sl = lane >= o ? lane - o : lane; const float u0 = lane_get(x0, sl), u1 = lane_get(x1, sl); if (lane >= o) { x0 = fmaxf(x0, u0); x1 = fmaxf(x1, u1); } }
                    x1 = fmaxf(x1, lane_bcast(x0, 63));
                } else {
#pragma unroll
                    for (int o = 1; o < 64; o <<= 1) { const int sl = lane + o < 64 ? lane + o : lane; const float u0 = lane_get(x0, sl), u1 = lane_get(x1, sl); if (lane + o < 64) { x0 = fmaxf(x0, u0); x1 = fmaxf(x1, u1); } }
                    x0 = fmaxf(x0, lane_bcast(x1, 0));
                }
                const float mp = dir == 0 ? mpf : mpb;
                LAS float* A_ = dir == 0 ? AF : AB; LAS float* C_ = dir == 0 ? CF : CB; LAS float* B_ = dir == 0 ? BF : BB;
                A_[lane] = a0; A_[lane + 64] = a1; C_[lane] = fmaxf(x0, mp); C_[lane + 64] = fmaxf(x1, mp); B_[lane] = b0; B_[lane + 64] = b1;
            }
        }
        __syncthreads();
        const bf16x8 bq0 = frag_row(Qimg, 16 * wave, 0, lane), bq1 = frag_row(Qimg, 16 * wave, 32, lane);
        f32x4 st[8];
#pragma unroll
        for (int kt = 0; kt < 8; ++kt) { f32x4 z = {0.f, 0.f, 0.f, 0.f}; z = mfma16(frag_row(Kimg, 16 * kt, 0, lane), bq0, z); st[kt] = mfma16(frag_row(Kimg, 16 * kt, 32, lane), bq1, z); }
        const int row = row0 + qi;
        if (KIND == 0) {
            const float lgf = logsigmoidf_(a.in[9][(l * 2 + 0) * 4 + h]), lgb = logsigmoidf_(a.in[9][(l * 2 + 1) * 4 + h]);
            f32x4 acc[4];
#pragma unroll
            for (int et = 0; et < 4; ++et) {
                f32x4 zf = {0.f, 0.f, 0.f, 0.f}, zb = zf;
                zf = mfma16(frag_row(SFimg, 16 * et, 0, lane), bq0, zf); zf = mfma16(frag_row(SFimg, 16 * et, 32, lane), bq1, zf);
                zb = mfma16(frag_row(SBimg, 16 * et, 0, lane), bq0, zb); zb = mfma16(frag_row(SBimg, 16 * et, 32, lane), bq1, zb);
                acc[et] = zf * __expf(lgf * (float)(qi + 1)) + zb * __expf(lgb * (float)(128 - qi));
            }
#pragma unroll
            for (int T = 0; T < 4; ++T) {
                f32x4 p0, p1;
#pragma unroll
                for (int j = 0; j < 4; ++j) {
                    const int k0 = 32 * T + 4 * g + j, k1 = k0 + 16;
                    const float w0 = (k0 <= qi ? __expf(lgf * (float)(qi - k0)) : 0.f) + (k0 >= qi ? __expf(lgb * (float)(k0 - qi)) : 0.f);
                    const float w1 = (k1 <= qi ? __expf(lgf * (float)(qi - k1)) : 0.f) + (k1 >= qi ? __expf(lgb * (float)(k1 - qi)) : 0.f);
                    p0[j] = st[2 * T][j] * w0; p1[j] = st[2 * T + 1][j] * w1;
                }
                const bf16x8 bp = pack8(p0, p1);
{ bf16x8 va[4]; frag_tr_x4<true>(Vimg, 32 * T, 0, lane, va);
#pragma unroll
                for (int et = 0; et < 4; ++et) acc[et] = mfma16(va[et], bp, acc[et]); }
            }
            float ss = 0.f;
#pragma unroll
            for (int et = 0; et < 4; ++et) ss += (acc[et][0] * acc[et][0] + acc[et][1] * acc[et][1]) + (acc[et][2] * acc[et][2] + acc[et][3] * acc[et][3]);
            ss = sum_g4(ss);
            const float rs = rsqrtf(ss * (1.0f / 64.0f) + EPS);
#pragma unroll
            for (int et = 0; et < 4; ++et) { const int e0 = h * 64 + 16 * et + 4 * g;
                const u32x2 gw = *(const u32x2*)(P + (size_t)row * NPW + PC_RG + e0);
                u32x2 o; o.x = pk2(siluf_(bflo(gw.x)) * acc[et][0] * rs, siluf_(bfhi(gw.x)) * acc[et][1] * rs); o.y = pk2(siluf_(bflo(gw.y)) * acc[et][2] * rs, siluf_(bfhi(gw.y)) * acc[et][3] * rs);
                *(u32x2*)(MG + (size_t)row * DM + e0) = o; }
        } else {
            const float cf = CF[qi], cb = CB[qi];
            const float gf = __expf(mpf - cf), gb = __expf(mpb - cb);
            f32x4 af[5], ab[5];
#pragma unroll
            for (int et = 0; et < 5; ++et) {
                f32x4 zf = {0.f, 0.f, 0.f, 0.f}, zb = zf;
                zf = mfma16(frag_row(SFimg, 16 * et, 0, lane), bq0, zf); zf = mfma16(frag_row(SFimg, 16 * et, 32, lane), bq1, zf);
                zb = mfma16(frag_row(SBimg, 16 * et, 0, lane), bq0, zb); zb = mfma16(frag_row(SBimg, 16 * et, 32, lane), bq1, zb);
                af[et] = zf * gf; ab[et] = zb * gb;
            }
#pragma unroll
            for (int T = 0; T < 4; ++T) {
                const f32x4 a0f = *(const LAS f32x4*)(AF + 32 * T + 4 * g), a1f = *(const LAS f32x4*)(AF + 32 * T + 16 + 4 * g);
                const f32x4 a0b = *(const LAS f32x4*)(AB + 32 * T + 4 * g), a1b = *(const LAS f32x4*)(AB + 32 * T + 16 + 4 * g);
                f32x4 pf0, pf1, pb0, pb1;
#pragma unroll
                for (int j = 0; j < 4; ++j) {
                    const int k0 = 32 * T + 4 * g + j, k1 = k0 + 16;
                    pf0[j] = k0 <= qi ? st[2 * T][j] * __expf(a0f[j] - cf) : 0.f; pf1[j] = k1 <= qi ? st[2 * T + 1][j] * __expf(a1f[j] - cf) : 0.f;
                    pb0[j] = k0 >= qi ? st[2 * T][j] * __expf(a0b[j] - cb) : 0.f; pb1[j] = k1 >= qi ? st[2 * T + 1][j] * __expf(a1b[j] - cb) : 0.f;
                }
                const bf16x8 bpf = pack8(pf0, pf1), bpb = pack8(pb0, pb1);
{ bf16x8 va[4]; frag_tr_x4<true>(Vimg, 32 * T, 0, lane, va); const bf16x8 v4 = frag_tr<true>(Vimg, 32 * T, 64, lane);
#pragma unroll
                for (int et = 0; et < 4; ++et) { af[et] = mfma16(va[et], bpf, af[et]); ab[et] = mfma16(va[et], bpb, ab[et]); }
                af[4] = mfma16(v4, bpf, af[4]); ab[4] = mfma16(v4, bpb, ab[4]); }
            }
            const float denf = lane_get(af[4][0], lane & 15), denb = lane_get(ab[4][0], lane & 15);
            const float nf = 1.0f / fmaxf(fabsf(denf), __expf(-(BF[qi] + cf))), nb = 1.0f / fmaxf(fabsf(denb), __expf(-(BB[qi] + cb)));
            f32x4 y[4]; float ss = 0.f;
#pragma unroll
            for (int et = 0; et < 4; ++et) { y[et] = af[et] * nf + ab[et] * nb; ss += (y[et][0] * y[et][0] + y[et][1] * y[et][1]) + (y[et][2] * y[et][2] + y[et][3] * y[et][3]); }
            ss = sum_g4(ss);
            const float rs = rsqrtf(ss * (1.0f / 64.0f) + EPS);
#pragma unroll
            for (int et = 0; et < 4; ++et) { const int e0 = h * 64 + 16 * et + 4 * g;
                const u32x2 gw = *(const u32x2*)(P + (size_t)row * NPW + PC_MO + e0);
                u32x2 o; o.x = pk2(sigmoidf_(bflo(gw.x)) * y[et][0] * rs, sigmoidf_(bfhi(gw.x)) * y[et][1] * rs); o.y = pk2(sigmoidf_(bflo(gw.y)) * y[et][2] * rs, sigmoidf_(bfhi(gw.y)) * y[et][3] * rs);
                *(u32x2*)(MG + (size_t)row * DM + 256 + e0) = o; }
        }
    }
}

struct NaItem { int b, h, r0, ur0, nlb, lat, qrow0; };
__device__ __forceinline__ NaItem na_decode(int it) {
    NaItem t;
    if (it < 512) { t.lat = 1; const int rg = it & 7; t.h = (it >> 3) & 7; t.b = it >> 6; t.r0 = 4 * rg; t.ur0 = min(max(t.r0 - 4, 0), NROWS - 8);
        const int last = min(max(t.r0 - 1, 0), NROWS - 8) + 7; t.nlb = (last - t.ur0 + 4) >> 2; t.qrow0 = t.b * SEQ + t.r0 * 64; }
    else { const int j = it - 512; t.lat = 0; t.h = j & 7; t.b = j >> 3; t.r0 = 0; t.ur0 = 0; t.nlb = 0; t.qrow0 = NLAT + t.b * CTXL; }
    return t;
}
__device__ __forceinline__ int na_krow0(const NaItem& t, int step) { return step == 0 ? NLAT + t.b * CTXL : t.b * SEQ + (t.ur0 + 4 * (step - 1)) * 64; }
struct NaKV { u32x4 k[4], v[4]; };
__device__ __forceinline__ void na_load_kv(NaKV& x, const bf16_t* P, int krow0, int h, int tid) {
    const int rr = tid >> 1, c0 = (tid & 1) * 32; const bf16_t* ks = P + (size_t)(krow0 + rr) * NPW + PC_NK + 256 * (h >> 2) + hl_off(h & 3, c0); const bf16_t* vs = P + (size_t)(krow0 + rr) * NPW + PC_NV + h * 64 + c0;
#pragma unroll
    for (int i = 0; i < 4; ++i) { x.k[i] = *(const u32x4*)(ks + 8 * i); x.v[i] = *(const u32x4*)(vs + 8 * i); }
}
struct NaQ { u32x4 q[4]; };
__device__ __forceinline__ void na_load_q(NaQ& x, const bf16_t* P, int qrow0, int h, int tid) {
    const bf16_t* qs = P + (size_t)(qrow0 + (tid >> 1)) * NPW + PC_NQ + 256 * (h >> 2) + hl_off(h & 3, (tid & 1) * 32);
#pragma unroll
    for (int i = 0; i < 4; ++i) x.q[i] = *(const u32x4*)(qs + 8 * i);
}
struct NaState { float m, l; f32x4 acc[4]; };
template <int NPAIR, unsigned VALID>
__device__ __forceinline__ void na_update(NaState& st, const f32x4 (&s)[2 * NPAIR], float mx, LAS const unsigned char* Vimg, int vrow0, int lane) {
    mx = max_g4(mx);
    const float m_new = fmaxf(st.m, mx), resc = __builtin_amdgcn_exp2f(st.m - m_new);
    st.m = m_new; st.l *= resc;
#pragma unroll
    for (int et = 0; et < 4; ++et) st.acc[et] = st.acc[et] * resc;
#pragma unroll
    for (int T = 0; T < NPAIR; ++T) {
        if (((VALID >> (2 * T)) & 3u) != 0u) {
            f32x4 p0 = {0.f, 0.f, 0.f, 0.f}, p1 = p0;
            if ((VALID >> (2 * T)) & 1u) {
#pragma unroll
                for (int j = 0; j < 4; ++j) p0[j] = __builtin_amdgcn_exp2f(s[2 * T][j] - m_new);
                st.l += (p0[0] + p0[1]) + (p0[2] + p0[3]); }
            if ((VALID >> (2 * T + 1)) & 1u) {
#pragma unroll
                for (int j = 0; j < 4; ++j) p1[j] = __builtin_amdgcn_exp2f(s[2 * T + 1][j] - m_new);
                st.l += (p1[0] + p1[1]) + (p1[2] + p1[3]); }
            asm volatile("" : "+v"(st.l));
            const bf16x8 bp = pack8(p0, p1);
            bf16x8 va[4]; frag_tr_x4<true>(Vimg, vrow0 + 32 * T, 0, lane, va);
#pragma unroll
            for (int et = 0; et < 4; ++et) st.acc[et] = mfma16(va[et], bp, st.acc[et]);
            __builtin_amdgcn_sched_barrier(0);
        }
    }
}
template <int QTA>
__device__ __forceinline__ void na_local_row(NaState& st, const bf16x8& bq0, const bf16x8& bq1, LAS const unsigned char* Kimg, LAS const unsigned char* Vimg, LAS const float* browb, int irow0, int lane) {
    constexpr int tlo = (16 * QTA - 8 < 0 ? 0 : (16 * QTA - 8 > 48 ? 48 : 16 * QTA - 8)), thi = (16 * QTA + 7 > 48 ? 48 : 16 * QTA + 7) + 15;
    constexpr unsigned VALID = ((15 >= tlo && 0 <= thi) ? 1u : 0u) | ((31 >= tlo && 16 <= thi) ? 2u : 0u) | ((47 >= tlo && 32 <= thi) ? 4u : 0u) | ((63 >= tlo && 48 <= thi) ? 8u : 0u);
    const int g = lane >> 4, ql = 16 * QTA + (lane & 15), scq = min(max(ql - 8, 0), GRIDW - 16);
    f32x4 s[4]; float mx = -1.0e30f;
#pragma unroll
    for (int ct = 0; ct < 4; ++ct) {
        if ((VALID >> ct) & 1u) {
            f32x4 z = {0.f, 0.f, 0.f, 0.f}; z = mfma16(frag_row(Kimg, irow0 + 16 * ct, 0, lane), bq0, z); z = mfma16(frag_row(Kimg, irow0 + 16 * ct, 32, lane), bq1, z);
            const LAS float* brow = browb + (16 * ct + 4 * g - ql + 63); const int t0 = 16 * ct + 4 * g - scq;
#pragma unroll
            for (int j = 0; j < 4; ++j) { const float bv = brow[j]; const float zz = z[j] * 0.18033688f + bv; z[j] = ((unsigned)(t0 + j) < 16u) ? zz : -1.0e30f; }
            s[ct] = z; mx = fmaxf(mx, fmaxf(fmaxf(z[0], z[1]), fmaxf(z[2], z[3]))); asm volatile("" ::: "memory");
        } else s[ct] = (f32x4){-1.0e30f, -1.0e30f, -1.0e30f, -1.0e30f};
    }
    na_update<2, VALID>(st, s, mx, Vimg, irow0, lane);
    __builtin_amdgcn_sched_barrier(0);
}
template <int QTA>
__device__ __forceinline__ void na_local_q(NaState& st, LAS const unsigned char* Qimg, LAS const unsigned char* Kimg, LAS const unsigned char* Vimg, LAS const float* RPB, int qimg_row, int lane, int kkb, int srw, int qrw) {
    const bf16x8 bq0 = frag_row(Qimg, qimg_row, 0, lane), bq1 = frag_row(Qimg, qimg_row, 32, lane);
#pragma unroll
    for (int kkl = 0; kkl < 4; ++kkl) { const int kk = kkb + kkl;
        if (kk >= srw && kk < srw + 8) na_local_row<QTA>(st, bq0, bq1, Kimg, Vimg, RPB + (kk - qrw + 7) * 128, 64 * kkl, lane); }
}
template <int WP>
__device__ __forceinline__ void na_local_step(NaState (&st)[2], LAS const unsigned char* Qimg, LAS const unsigned char* Kimg, LAS const unsigned char* Vimg, LAS const float* RPB, int wave, int lane, int kkb, int srw, int qrw) {
    na_local_q<2 * WP>(st[0], Qimg, Kimg, Vimg, RPB, 32 * wave, lane, kkb, srw, qrw);
    na_local_q<2 * WP + 1>(st[1], Qimg, Kimg, Vimg, RPB, 32 * wave + 16, lane, kkb, srw, qrw);
}
__device__ __forceinline__ void phase_natt_mfma(const Args& a, int l, bool need_ctx, LAS unsigned char* lds, int tid, int lane, int wave, int bid, int G) {
    unsigned char* ws = a.ws;
    const bf16_t* P = (const bf16_t*)(ws + WS_BIG); bf16_t* MG = (bf16_t*)(ws + WS_H);
    LAS unsigned char* Qimg = lds; LAS unsigned char* Kimg = lds + 40960; LAS unsigned char* Vimg = lds + 81920;
    LAS float* RPB = (LAS float*)(lds + 122880);
    const int nitems = 512 + (need_ctx ? NB * 8 : 0);
    const int g = lane >> 4;
    int it = (bid + G - 128 % G) % G; if (it >= nitems) return;
    NaItem cur = na_decode(it);
    NaKV kv; na_load_kv(kv, P, na_krow0(cur, 0), cur.h, tid);
    float rpbreg[4];
#pragma unroll
    for (int k = 0; k < 4; ++k) { const int idx = tid + 512 * k, dr = idx >> 7, dc = (idx & 127) - 48; rpbreg[k] = (idx < 1920 && dc >= 0 && dc <= 30) ? a.in[15][(size_t)(l * 8 + cur.h) * 465 + dr * 31 + dc] * 1.44269504f : 0.f; }
    for (;;) {
        const int itn = it + G; const bool has_next = itn < nitems; NaItem nxt = cur; if (has_next) nxt = na_decode(itn);
        const int nsteps = 1 + cur.nlb;
        const int qrw = cur.r0 + (wave >> 1), srw = min(max(qrw - 4, 0), NROWS - 8);
        NaState st[2];
#pragma unroll
        for (int q2 = 0; q2 < 2; ++q2) { st[q2].m = -1.0e30f; st[q2].l = 0.f;
#pragma unroll
            for (int et = 0; et < 4; ++et) st[q2].acc[et] = (f32x4){0.f, 0.f, 0.f, 0.f}; }
        for (int step = 0; step < nsteps; ++step) {
            int ts = tid; asm volatile("" : "+v"(ts));
            __syncthreads();
            { const int rr = ts >> 1, c0 = (ts & 1) * 32;
#pragma unroll
              for (int i = 0; i < 4; ++i) { *(LAS u32x4*)(Kimg + rr * IST + (c0 + 8 * i) * 2) = kv.k[i]; *(LAS u32x4*)(Vimg + rr * IST + (c0 + 8 * i) * 2) = kv.v[i]; }
              if (step == 0) { NaQ qr_; na_load_q(qr_, P, cur.qrow0, cur.h, ts);
#pragma unroll
                  for (int i = 0; i < 4; ++i) *(LAS u32x4*)(Qimg + rr * IST + (c0 + 8 * i) * 2) = qr_.q[i];
#pragma unroll
                  for (int k = 0; k < 4; ++k) if (ts + 512 * k < 1920) RPB[ts + 512 * k] = rpbreg[k]; } }
            __syncthreads();
            int tq = ts;
            if (step + 1 < nsteps) na_load_kv(kv, P, na_krow0(cur, step + 1), cur.h, tq);
            else if (has_next) { na_load_kv(kv, P, na_krow0(nxt, 0), nxt.h, tq);
#pragma unroll
                for (int k = 0; k < 4; ++k) { const int idx = tq + 512 * k, dr = idx >> 7, dc = (idx & 127) - 48; rpbreg[k] = (idx < 1920 && dc >= 0 && dc <= 30) ? a.in[15][(size_t)(l * 8 + nxt.h) * 465 + dr * 31 + dc] * 1.44269504f : 0.f; } }
            const int ln = ts & 63;
            if (step == 0) {
#pragma unroll
                for (int q2 = 0; q2 < 2; ++q2) {
                    const bf16x8 bq0 = frag_row(Qimg, 32 * wave + 16 * q2, 0, ln), bq1 = frag_row(Qimg, 32 * wave + 16 * q2, 32, ln);
#pragma unroll
                    for (int hf = 0; hf < 2; ++hf) {
                        f32x4 s[8]; float mx = -1.0e30f;
#pragma unroll
                        for (int t8 = 0; t8 < 8; ++t8) { f32x4 z = {0.f, 0.f, 0.f, 0.f}; z = mfma16(frag_row(Kimg, 128 * hf + 16 * t8, 0, ln), bq0, z); z = mfma16(frag_row(Kimg, 128 * hf + 16 * t8, 32, ln), bq1, z);
                            z = z * 0.18033688f; s[t8] = z; mx = fmaxf(mx, fmaxf(fmaxf(z[0], z[1]), fmaxf(z[2], z[3]))); if (t8 & 1) asm volatile("" ::: "memory"); }
                        na_update<4, 0xFFu>(st[q2], s, mx, Vimg, 128 * hf, ln);
                        __builtin_amdgcn_sched_barrier(0);
                    }
                }
            } else {
                const int kkb = cur.ur0 + 4 * (step - 1);
                if (wave & 1) na_local_step<1>(st, Qimg, Kimg, Vimg, RPB, wave, ln, kkb, srw, qrw);
                else          na_local_step<0>(st, Qimg, Kimg, Vimg, RPB, wave, ln, kkb, srw, qrw);
            }
        }
        int lf = lane; asm volatile("" : "+v"(lf)); const int gf = lf >> 4;
#pragma unroll
        for (int q2 = 0; q2 < 2; ++q2) {
            const float inv = 1.0f / sum_g4(st[q2].l);
            const int row = cur.qrow0 + 32 * wave + 16 * q2 + (lf & 15);
#pragma unroll
            for (int et = 0; et < 4; ++et) { u32x2 w; w.x = pk2(st[q2].acc[et][0] * inv, st[q2].acc[et][1] * inv); w.y = pk2(st[q2].acc[et][2] * inv, st[q2].acc[et][3] * inv);
                *(u32x2*)(MG + (size_t)row * DM + 512 + cur.h * 64 + 16 * et + 4 * gf) = w; }
        }
        if (!has_next) break;
        it = itn; cur = nxt;
    }
}

constexpr int MOE_TAB_OFF = 131072;
__device__ __forceinline__ void moe_tab_setup(const unsigned char* ws, LAS unsigned char* lds, int tid) {
    if (tid == 0) { LAS int* tab = (LAS int*)(lds + MOE_TAB_OFF); int p = 0;
        for (int e = 0; e < NEXP; ++e) { const int c = (int)__hip_atomic_load((const unsigned*)(ws + WS_CTL) + CW_MOE + 64 * e, __ATOMIC_RELAXED, __HIP_MEMORY_SCOPE_AGENT); tab[e] = p; tab[16 + e] = c; p += (c + 255) >> 8; }
        tab[8] = p; }
    __syncthreads();
}
namespace pg8 {
struct MoeOrder : StaticOrder {
    const PG8_LAS int* tab; const int* list; size_t bstride;
    __device__ __forceinline__ int expert(int pm) const { int e = 0;
#pragma unroll
        for (int k = 1; k < 8; ++k) e += (pm >= tab[k]) ? 1 : 0;
        return e; }
    __device__ __forceinline__ unsigned arow(const Unit& u, int R) const {
        const int Rr = (u.hs > 0 ? HALF : 0) + (u.hs >= 0 ? (R & (HALF - 1)) : R);
        if (!list) return (unsigned)(u.pm * BM + Rr);
        const int e = expert(u.pm), idx = (u.pm - tab[e]) * BM + Rr;
        return idx < tab[16 + e] ? (unsigned)list[e * NLAT + idx] : 0u; }
    __device__ __forceinline__ const char* bbase(const Unit& u) const { return Bt + (size_t)expert(u.pm) * bstride + (size_t)u.pn * BM * K2; }
};
}
__device__ __forceinline__ void phase_moe_combine(const Args& a, LAS unsigned char* lds, int lane, int wave, int bid, int G) {
    unsigned char* ws = a.ws; const LAS int* tab = (const LAS int*)(lds + MOE_TAB_OFF);
    const int* TOK = (const int*)(ws + WS_COMB); const bf16_t* Y = (const bf16_t*)(ws + WS_WTMUP);
    const float* g2 = (const float*)(ws + WS_MOD) + (size_t)9 * 6144 + 5120;
    for (int r = bid * NWAVES + wave; r < NLAT; r += G * NWAVES) {
        const int e1 = TOK[r * 8], e2 = TOK[r * 8 + 1], p1 = TOK[r * 8 + 2], p2 = TOK[r * 8 + 3]; const float w1 = __int_as_float(TOK[r * 8 + 4]), w2 = __int_as_float(TOK[r * 8 + 5]);
        const bf16_t* y1 = Y + ((size_t)tab[e1] * 256 + p1) * DM; const bf16_t* y2 = Y + ((size_t)tab[e2] * 256 + p2) * DM;
        const float* gr = g2 + (size_t)(r >> 11) * 6144; float* o = a.out + (size_t)r * DM;
#pragma unroll
        for (int j = 0; j < 4; ++j) { const int k = 4 * lane + 256 * j;
            const u32x2 a1 = *(const u32x2*)(y1 + k), a2 = *(const u32x2*)(y2 + k); const f32x4 x = *(const f32x4*)(o + k), gg = *(const f32x4*)(gr + k);
            f32x4 m; m.x = w1 * bflo(a1.x) + w2 * bflo(a2.x); m.y = w1 * bfhi(a1.x) + w2 * bfhi(a2.x); m.z = w1 * bflo(a1.y) + w2 * bflo(a2.y); m.w = w1 * bfhi(a1.y) + w2 * bfhi(a2.y);
            *(f32x4*)(o + k) = x + gg * m; }
    }
}
#ifndef DUP_VIRT
#define DUP_VIRT (-1)
#endif
#define PH_REP_OPEN
#define PH_REP_CLOSE
#ifndef DUP_PH
#define DUP_PH (-1)
#endif
#ifndef PH_ONLY
#define PH_ONLY 0
#endif
#ifndef MIX_NAIVE
#define MIX_NAIVE 0
#endif
#ifndef MIX_RET
#define MIX_RET 1
#endif
#ifndef MIX_ML
#define MIX_ML 1
#endif
#ifndef MIX_NA
#define MIX_NA 1
#endif
#ifndef EN_PRO
#define EN_PRO 1
#endif
#ifndef EN_NORM
#define EN_NORM 1
#endif
#ifndef EN_GIN
#define EN_GIN 1
#endif
#ifndef EN_POST
#define EN_POST 1
#endif
#ifndef EN_FCUM
#define EN_FCUM 1
#endif
#ifndef EN_QUAD
#define EN_QUAD 1
#endif
#ifndef EN_NATT
#define EN_NATT 1
#endif
#ifndef EN_MERGE
#define EN_MERGE 1
#endif
#ifndef EN_GOUT
#define EN_GOUT 1
#endif
#ifndef EN_NORM2
#define EN_NORM2 1
#endif
#ifndef EN_GUP
#define EN_GUP 1
#endif
#ifndef EN_GDN
#define EN_GDN 1
#endif

__global__ void __launch_bounds__(NTHR, 2) fwd_kernel(Args a_) {
    extern __shared__ __attribute__((aligned(16))) unsigned char lds_raw[];
    LAS unsigned char* lds = (LAS unsigned char*)lds_raw;
    const int tid0 = threadIdx.x, G = gridDim.x, bid = blockIdx.x; const int wave0 = __builtin_amdgcn_readfirstlane(tid0 >> 6);
    unsigned char* ws0 = a_.ws;
    volatile LAS unsigned* MISC = (volatile LAS unsigned*)(lds + MISC_OFF);
    if (tid0 < 32) MISC[tid0] = 0u;
    __syncthreads();
    const int lo = a_.ph_lo, hi = a_.ph_hi;
    XcdBarrier bar; bar.bar = (unsigned*)(ws0 + WS_CTL) + CW_BAR; bar.x = 0; bar.st = MISC + 8;
    if (hi - lo > 1) bar = xcd_barrier_post((unsigned*)(ws0 + WS_CTL) + CW_BAR, MISC + 8);
    int ph = 0;
#define PH_BEGIN if (ph >= lo && ph < hi) { asm volatile("; PHMARK_BEGIN %0" :: "i"(__LINE__)); int tid; asm volatile("v_mbcnt_lo_u32_b32 %0, -1, 0\n\tv_mbcnt_hi_u32_b32 %0, -1, %0" : "=v"(tid)); tid += wave0 * 64; Args a; { const __attribute__((address_space(4))) Args* ap = (const __attribute__((address_space(4))) Args*)__builtin_amdgcn_kernarg_segment_ptr(); asm volatile("" : "+s"(ap)); a = *(const Args*)ap; } unsigned char* ws = a.ws; (void)ws; PH_REP_OPEN if (PH_ONLY == 0 || PH_ONLY == __LINE__) { const int lane = tid & 63, wave = __builtin_amdgcn_readfirstlane(tid >> 6); (void)lane; (void)wave;
#define PH_END   } PH_REP_CLOSE asm volatile("; PHMARK_END %0" :: "i"(__LINE__)); if (ph + 1 < hi) xcd_barrier(bar); else __syncthreads(); } ++ph;

    PH_BEGIN
#if EN_PRO
 phase_prologue(a, lds, tid, lane, wave, bid, G);
#endif
 PH_END

    for (int l = 0; l < 2; ++l) {
        const bool need_ctx = (l == 0);
#define MODP ((const float*)(ws + WS_MOD) + (size_t)l * 9 * 6144)
        PH_BEGIN
#if EN_NORM
 phase_norm1(a, l, lds, tid, lane, wave, bid, G);
#endif
 PH_END
        PH_BEGIN
#if EN_GIN
 { pg8::Gemm g{(const bf16_t*)(ws + WS_H), (const bf16_t*)(ws + WS_WTIN) + (size_t)l * NPW * DM, MALL, NPW, DM};
                   pg8::StaticOrder S; S.init(MALL, NPW, G, bid); S.Bt = (const char*)g.Bt; S.K2 = 2 * DM; pg8::EpiProj E{(bf16_t*)(ws + WS_BIG), NPW, (const float*)(ws + WS_ROPE), a.in[13] + l * 64, a.in[14] + l * 64, NLAT / 256};
                   pg8::gemm_phase<pg8::EpiProj, pg8::StaticOrder, false>(lds, g, S, E, nullptr, tid); }
#endif
 PH_END
        PH_BEGIN
#if MIX_RET || MIX_ML
        phase_chunk_sums(a, l, lds, tid, lane, wave, bid, G);
#endif
        PH_END
        PH_BEGIN phase_chunk_states(a, l, tid, bid, G); PH_END
        PH_BEGIN
#if MIX_RET
        phase_chunk_out<0>(a, l, need_ctx, lds, tid, lane, wave, bid, G);
#endif
#if MIX_ML
        phase_chunk_out<1>(a, l, need_ctx, lds, tid, lane, wave, bid, G);
#endif
#if MIX_NA
        phase_natt_mfma(a, l, need_ctx, lds, tid, lane, wave, bid, G);
#endif
        PH_END
        PH_BEGIN
#if EN_GOUT
 { const int M = need_ctx ? MALL : NLAT;
                   pg8::Gemm g{(const bf16_t*)(ws + WS_H), (const bf16_t*)(ws + WS_WTOUT) + (size_t)l * DM * DM, M, DM, DM};
                   pg8::StaticOrder S; S.init(M, DM, G, bid); S.Bt = (const char*)g.Bt; S.K2 = 2 * DM;
                   pg8::EpiResid E{l == 0 ? a.in[0] : a.out, l == 0 ? a.in[2] : (const float*)(ws + WS_XC), a.out, (float*)(ws + WS_XC), MODP + 2048, nullptr, 0, NLAT / 256};
                   pg8::gemm_phase<pg8::EpiResid, pg8::StaticOrder, false>(lds, g, S, E, nullptr, tid);
                   if (l == 0 && bid >= 64) convert_window(a, lds, lane, wave, G, 0, bid - 64, CVN1); }
#endif
 PH_END
        if (l == 0) { PH_BEGIN
#if EN_NORM2
 phase_norm<1>(a, l, lds, tid, lane, wave, bid, G);
#endif
 PH_END }
        else        { PH_BEGIN
#if EN_NORM2
 phase_norm<2>(a, l, lds, tid, lane, wave, bid, G);
#endif
 PH_END }
        if (l == 0) {
            PH_BEGIN { pg8::Gemm g{(const bf16_t*)(ws + WS_H), (const bf16_t*)(ws + WS_WTUP), MALL, NUP, DM};
                       pg8::StaticOrder S; S.init(MALL, NUP, G, bid); S.Bt = (const char*)g.Bt; S.K2 = 2 * DM; pg8::EpiSwiGLU E{(bf16_t*)(ws + WS_BIG), DFF};
                       pg8::gemm_phase<pg8::EpiSwiGLU, pg8::StaticOrder, false>(lds, g, S, E, nullptr, tid);
                       if (bid >= 96) convert_window(a, lds, lane, wave, G, CV_BASE2, bid - 96, CVN2); } PH_END
            PH_BEGIN { pg8::Gemm g{(const bf16_t*)(ws + WS_BIG), (const bf16_t*)(ws + WS_WTDN), MALL, DM, DFF};
                       pg8::StaticOrder S; S.init(MALL, DM, G, bid); S.Bt = (const char*)g.Bt; S.K2 = 2 * DFF;
                       pg8::EpiResid E{a.out, (const float*)(ws + WS_XC), a.out, (float*)(ws + WS_XC), MODP + 5120, nullptr, 0, NLAT / 256};
                       pg8::gemm_phase<pg8::EpiResid, pg8::StaticOrder, false>(lds, g, S, E, nullptr, tid);
                       if (bid >= 64) convert_window(a, lds, lane, wave, G, CV_BASE3, bid - 64, CVN3); } PH_END
        } else {
            PH_BEGIN { moe_tab_setup(ws, lds, tid); const LAS int* tab = (const LAS int*)(lds + MOE_TAB_OFF);
                       pg8::Gemm g{(const bf16_t*)(ws + WS_H), (const bf16_t*)(ws + WS_WTMUP), 256 * tab[8], NUP, DM};
                       pg8::MoeOrder S; S.init(256 * tab[8], NUP, G, bid); S.Bt = (const char*)g.Bt; S.K2 = 2 * DM; S.tab = tab; S.list = (const int*)(ws + WS_LIST); S.bstride = (size_t)NUP * DM * 2;
                       pg8::EpiSwiGLU E{(bf16_t*)(ws + WS_BIG), DFF};
                       pg8::gemm_phase<pg8::EpiSwiGLU, pg8::MoeOrder, false>(lds, g, S, E, nullptr, tid); } PH_END
            PH_BEGIN { moe_tab_setup(ws, lds, tid); const LAS int* tab = (const LAS int*)(lds + MOE_TAB_OFF);
                       pg8::Gemm g{(const bf16_t*)(ws + WS_BIG), (const bf16_t*)(ws + WS_WTMDN), 256 * tab[8], DM, DFF};
                       pg8::MoeOrder S; S.init(256 * tab[8], DM, G, bid); S.Bt = (const char*)g.Bt; S.K2 = 2 * DFF; S.tab = tab; S.list = nullptr; S.bstride = (size_t)DM * DFF * 2;
                       pg8::EpiBf16 E{(bf16_t*)(ws + WS_WTMUP), DM};
                       pg8::gemm_phase<pg8::EpiBf16, pg8::MoeOrder, false>(lds, g, S, E, nullptr, tid); } PH_END
            PH_BEGIN { moe_tab_setup(ws, lds, tid); phase_moe_combine(a, lds, lane, wave, bid, G); } PH_END
        }
    }
#if N_LAUNCH_MODE == 1
    if (lo >= 100) {
        int tid; asm volatile("v_mbcnt_lo_u32_b32 %0, -1, 0\n\tv_mbcnt_hi_u32_b32 %0, -1, %0" : "=v"(tid)); tid += wave0 * 64; const int lane = tid & 63, wave = wave0;
        Args a = a_;
        if (lo == 100) phase_chunk_out<0>(a, 0, true, lds, tid, lane, wave, bid, G);
        if (lo == 101) phase_chunk_out<1>(a, 0, true, lds, tid, lane, wave, bid, G);
        if (lo == 102) phase_natt_mfma(a, 0, true, lds, tid, lane, wave, bid, G);
        if (lo == 103) { unsigned char* ws = a.ws; pg8::Gemm g{(const bf16_t*)(ws + WS_H), (const bf16_t*)(ws + WS_WTIN), MALL, NPW, DM};
                   pg8::StaticOrder S; S.init(MALL, NPW, G, bid); S.Bt = (const char*)g.Bt; S.K2 = 2 * DM; pg8::EpiNull E{(bf16_t*)(ws + WS_BIG), NPW};
                   pg8::gemm_phase<pg8::EpiNull, pg8::StaticOrder, false>(lds, g, S, E, nullptr, tid); }
    }
#endif
#undef PH_BEGIN
#undef PH_END
}
constexpr int N_PHASES = 1 + 2 * 7 + 2 + 3;
#ifndef DBG_MAXPH
#define DBG_MAXPH 1000
#endif

extern "C" void kernel_launch(void* const* d_in, const int* in_sizes, int n_in, void* d_out, int out_size, void* d_ws, size_t ws_size, hipStream_t stream) {
    static int grid = 0;
    if (grid == 0) {
        if (n_in != 24 || out_size != NLAT * DM || ws_size < WS_END) { fprintf(stderr, "kernel_launch: unexpected sizes (n_in %d, out %d, ws %zu < %zu); nothing launched\n", n_in, out_size, ws_size, (size_t)WS_END); grid = -1; return; }
        int dev = 0, cus = 0;
        if (hipGetDevice(&dev) != hipSuccess || hipDeviceGetAttribute(&cus, hipDeviceAttributeMultiprocessorCount, dev) != hipSuccess) { grid = -1; return; }
        if (hipFuncSetAttribute((const void*)fwd_kernel, hipFuncAttributeMaxDynamicSharedMemorySize, LDS_BYTES) != hipSuccess) { fprintf(stderr, "kernel_launch: hipFuncSetAttribute failed\n"); grid = -1; return; }
        int per_cu = 0;
        if (hipOccupancyMaxActiveBlocksPerMultiprocessor(&per_cu, (const void*)fwd_kernel, NTHR, LDS_BYTES) != hipSuccess || per_cu < 1) { fprintf(stderr, "kernel_launch: occupancy query says %d\n", per_cu); }
        (void)hipGetLastError();
        grid = cus;
    }
    if (grid < 0) return;
    (void)hipMemsetAsync((char*)d_ws + WS_CTL, 0, CTL_BYTES, stream);
    Args a{};
    for (int i = 0; i < 24; ++i) a.in[i] = (const float*)d_in[i];
    a.out = (float*)d_out; a.ws = (unsigned char*)d_ws;
#if N_LAUNCH_MODE == 0
    a.ph_lo = 0; a.ph_hi = N_PHASES;
    hipLaunchKernelGGL(fwd_kernel, dim3(grid), dim3(NTHR), LDS_BYTES, stream, a);
#else
    for (int p = 0; p < N_PHASES && p < DBG_MAXPH; ++p) { a.ph_lo = p; a.ph_hi = p + 1; hipLaunchKernelGGL(fwd_kernel, dim3(grid), dim3(NTHR), LDS_BYTES, stream, a);
        if (p == DUP_PH) hipLaunchKernelGGL(fwd_kernel, dim3(grid), dim3(NTHR), LDS_BYTES, stream, a);
        if (p == 6 && DUP_VIRT >= 100) { a.ph_lo = DUP_VIRT; a.ph_hi = DUP_VIRT + 1; hipLaunchKernelGGL(fwd_kernel, dim3(grid), dim3(NTHR), LDS_BYTES, stream, a); } }
#endif
}
```

```cpp
#include <hip/hip_runtime.h>
#include <stdio.h>
#include <stdint.h>

#ifndef N_LAUNCH_MODE
#define N_LAUNCH_MODE 0
#endif

constexpr int NB = 8, SEQ = 2048, DM = 1024, CTXL = 256, HD = 64;
constexpr int NLAT = NB * SEQ, NCTX = NB * CTXL, MALL = NLAT + NCTX;
constexpr int DIN = 3600, NPW = 3584;
constexpr int DFF = 2816, NUP = 2 * DFF, NEXP = 8;
constexpr int GRIDW = 64, NROWS = 32;
constexpr float EPS = 1e-6f;
constexpr int PC_RQ = 0, PC_RK = 256, PC_RV = 512, PC_RG = 768, PC_MQ = 1024, PC_MK = 1280, PC_MV = 1536, PC_MO = 1792, PC_NQ = 2048, PC_NK = 2560, PC_NV = 3072;

constexpr size_t al256(size_t x) { return (x + 255) & ~(size_t)255; }
constexpr size_t WS_CTL = 0, CTL_BYTES = 1u << 20;
constexpr size_t WS_MOD = WS_CTL + CTL_BYTES;
constexpr size_t WS_ROPE = WS_MOD + al256((size_t)2 * 9 * 6144 * 4);
constexpr size_t WS_WTIN = WS_ROPE + al256(64 * 16 * 2 * 4);
constexpr size_t WS_WTOUT = WS_WTIN + (size_t)2 * NPW * DM * 2;
constexpr size_t WS_WTUP = WS_WTOUT + (size_t)2 * DM * DM * 2;
constexpr size_t WS_WTDN = WS_WTUP + (size_t)NUP * DM * 2;
constexpr size_t WS_WTMUP = WS_WTDN + (size_t)DM * DFF * 2;
constexpr size_t WS_WTMDN = WS_WTMUP + (size_t)NEXP * NUP * DM * 2;
constexpr size_t WS_H = WS_WTMDN + (size_t)NEXP * DM * DFF * 2;
constexpr size_t WS_XC = WS_H + (size_t)MALL * DM * 2;
constexpr size_t WS_GATES = WS_XC + (size_t)NCTX * DM * 4;
constexpr size_t WS_COMB = WS_GATES + (size_t)MALL * 16 * 4;
constexpr size_t WS_USC = WS_COMB + (size_t)NLAT * 8 * 4;
constexpr size_t WS_SM = WS_USC + al256((size_t)NB * 4 * 2 * 18 * 2 * 4);
constexpr size_t WS_LIST = WS_SM + al256((size_t)NB * 4 * 2 * 18 * 4);
constexpr size_t WS_BIG = WS_LIST + (size_t)NEXP * NLAT * 4;
constexpr size_t WS_MQK = WS_BIG + (size_t)MALL * NPW * 2;
constexpr size_t WS_U = WS_MQK + (size_t)MALL * 512 * 2;
constexpr size_t WS_S = WS_U + (size_t)2 * NB * 4 * 2 * 18 * 80 * 64 * 2;
constexpr size_t WS_GARR = WS_S + (size_t)2 * NB * 4 * 2 * 18 * 80 * 64 * 2;
constexpr size_t WS_HS = WS_GARR + (size_t)NB * 4 * 18 * 2 * 3 * 128 * 4;
constexpr size_t WS_END0 = WS_HS + al256((size_t)MALL * 4);
constexpr size_t MOE_ROWS = 34816;
constexpr size_t WS_ACTM_END = WS_BIG + MOE_ROWS * DFF * 2;
constexpr size_t WS_END = WS_END0 > WS_ACTM_END ? WS_END0 : WS_ACTM_END;

typedef unsigned short bf16_t;
typedef float f32x4 __attribute__((ext_vector_type(4)));
typedef float f32x2 __attribute__((ext_vector_type(2)));
typedef unsigned u32x4 __attribute__((ext_vector_type(4)));
typedef unsigned u32x2 __attribute__((ext_vector_type(2)));
#define LAS __attribute__((address_space(3)))
#define GAS __attribute__((address_space(1)))

__device__ __forceinline__ float bf2f(bf16_t b) { return __uint_as_float(((unsigned)b) << 16); }
__device__ __forceinline__ unsigned f2bf(float f) { unsigned u = __float_as_uint(f); return (u + 0x7fffu + ((u >> 16) & 1u)) >> 16; }
typedef __bf16 bf16x2_t __attribute__((ext_vector_type(2)));
__device__ __forceinline__ unsigned pk2(float lo, float hi) { f32x2 v = {lo, hi}; bf16x2_t b = __builtin_convertvector(v, bf16x2_t); return __builtin_bit_cast(unsigned, b); }
__device__ __forceinline__ float bflo(unsigned w) { return __uint_as_float(w << 16); }
__device__ __forceinline__ float bfhi(unsigned w) { return __uint_as_float(w & 0xffff0000u); }
__device__ __forceinline__ float sigmoidf_(float x) { return 1.0f / (1.0f + __expf(-x)); }
__device__ __forceinline__ float siluf_(float x) { return x / (1.0f + __expf(-x)); }
__device__ __forceinline__ float logsigmoidf_(float x) { return fminf(x, 0.f) - log1pf(__expf(-fabsf(x))); }
template <int O> __device__ __forceinline__ float swz_xor(float v) { return __int_as_float(__builtin_amdgcn_ds_swizzle(__float_as_int(v), (O << 10) | 0x1f)); }
__device__ __forceinline__ float red32_sum(float v) { const auto r = __builtin_amdgcn_permlane32_swap(__float_as_uint(v), __float_as_uint(v), false, false); return __uint_as_float(r[0]) + __uint_as_float(r[1]); }
__device__ __forceinline__ float red32_max(float v) { const auto r = __builtin_amdgcn_permlane32_swap(__float_as_uint(v), __float_as_uint(v), false, false); return fmaxf(__uint_as_float(r[0]), __uint_as_float(r[1])); }
__device__ __forceinline__ float wave_sum(float v) { v += swz_xor<1>(v); v += swz_xor<2>(v); v += swz_xor<4>(v); v += swz_xor<8>(v); v += swz_xor<16>(v); return red32_sum(v); }
__device__ __forceinline__ float wave_max(float v) { v = fmaxf(v, swz_xor<1>(v)); v = fmaxf(v, swz_xor<2>(v)); v = fmaxf(v, swz_xor<4>(v)); v = fmaxf(v, swz_xor<8>(v)); v = fmaxf(v, swz_xor<16>(v)); return red32_max(v); }
__device__ __forceinline__ float sum_g4(float v) { v += swz_xor<16>(v); return red32_sum(v); }
__device__ __forceinline__ float max_g4(float v) { v = fmaxf(v, swz_xor<16>(v)); return red32_max(v); }
__device__ __forceinline__ float reduce16_lanes(const float (&p)[16], int lane) {
    float q[8], r[4], s[2];
#pragma unroll
    for (int j = 0; j < 8; ++j) { const auto x = __builtin_amdgcn_permlane32_swap(__float_as_uint(p[j]), __float_as_uint(p[j + 8]), false, false); q[j] = __uint_as_float(x[0]) + __uint_as_float(x[1]); }
    const bool b4 = (lane & 16) != 0, b3 = (lane & 8) != 0, b2 = (lane & 4) != 0;
#pragma unroll
    for (int j = 0; j < 4; ++j) { const float keep = b4 ? q[j + 4] : q[j], send = b4 ? q[j] : q[j + 4]; r[j] = keep + swz_xor<16>(send); }
#pragma unroll
    for (int j = 0; j < 2; ++j) { const float keep = b3 ? r[j + 2] : r[j], send = b3 ? r[j] : r[j + 2]; s[j] = keep + swz_xor<8>(send); }
    float v; { const float keep = b2 ? s[1] : s[0], send = b2 ? s[0] : s[1]; v = keep + swz_xor<4>(send); }
    v += swz_xor<2>(v); v += swz_xor<1>(v);
    return v;
}
__device__ __forceinline__ float reduce8_lanes(const float (&p)[8], int lane) {
    float q[4], r[2];
#pragma unroll
    for (int j = 0; j < 4; ++j) { const auto x = __builtin_amdgcn_permlane32_swap(__float_as_uint(p[j]), __float_as_uint(p[j + 4]), false, false); q[j] = __uint_as_float(x[0]) + __uint_as_float(x[1]); }
    const bool b4 = (lane & 16) != 0, b3 = (lane & 8) != 0;
#pragma unroll
    for (int j = 0; j < 2; ++j) { const float keep = b4 ? q[j + 2] : q[j], send = b4 ? q[j] : q[j + 2]; r[j] = keep + swz_xor<16>(send); }
    float v; { const float keep = b3 ? r[1] : r[0], send = b3 ? r[0] : r[1]; v = keep + swz_xor<8>(send); }
    v += swz_xor<4>(v); v += swz_xor<2>(v); v += swz_xor<1>(v);
    return v;
}
__device__ __forceinline__ float lane_get(float v, int src_lane) { return __int_as_float(__builtin_amdgcn_ds_bpermute(src_lane << 2, __float_as_int(v))); }
__device__ __forceinline__ float lane_bcast(float v, int k) { return __int_as_float(__builtin_amdgcn_readlane(__float_as_int(v), k)); }

struct Args {
    const float* in[24];
    float* out;
    unsigned char* ws;
    int ph_lo, ph_hi;
};
namespace pg8 {
#define PG8_LAS __attribute__((address_space(3)))
typedef unsigned short bf16_t;
typedef short bf16x8 __attribute__((ext_vector_type(8)));
typedef float f32x4 __attribute__((ext_vector_type(4)));
typedef unsigned u32x4 __attribute__((ext_vector_type(4)));
constexpr int BM = 256, BK = 64, HALF = 128, HTB = HALF * BK * 2  , STAGE_BYTES = 8 * HTB, NXCD = 8, WGM = 8;

__host__ __device__ __forceinline__ int lds_byte(int r, int c) { const int st = (r >> 4) * 2 + (c >> 5), rr = r & 15, cc = c & 31, ob = rr * 64 + cc * 2; return st * 1024 + (ob ^ (((ob >> 9) & 1) << 5)); }
__host__ __device__ __forceinline__ void stage_rc(int b, int& R, int& C) { const int st = b / 1024, sb = b % 1024, swz = sb ^ (((sb >> 9) & 1) << 5); R = (st >> 1) * 16 + swz / 64; C = (st & 1) * 32 + (swz % 64) / 2; }
__host__ __device__ __forceinline__ int perm32(int rho) { const int n = rho >> 4, i = rho & 15; return 8 * (i >> 2) + 4 * n + (i & 3); }

struct Unit { int pm, pn, hs, idx; };
struct Gemm { const bf16_t* A; const bf16_t* Bt; int M, N, K; };

struct StaticOrder {
    int nM, nN, nwg, G, c;
    __host__ __device__ void init(int M, int N, int G_, int c_) { nM = M / BM; nN = N / BM; nwg = nM * nN; G = G_; c = c_; }
    __host__ __device__ bool next(int i, Unit& u) const {
        const int nfr = nwg / G, left = nwg - nfr * G; int wgid; u.hs = -1; u.idx = i;
        if (i < nfr) wgid = i * G + c;
        else if (i == nfr && left > 0) { if (2 * left <= G) { if (c >= 2 * left) return false; wgid = nfr * G + (c >> 1); u.hs = c & 1; } else { if (c >= left) return false; wgid = nfr * G + c; } }
        else return false; { const int q = nwg / NXCD, r = nwg % NXCD, xcd = wgid % NXCD, off = wgid / NXCD; wgid = (xcd < r ? xcd * (q + 1) : r * (q + 1) + (xcd - r) * q) + off; }
        const int nig = WGM * nN, gid = wgid / nig, fm = gid * WGM, gsz = (nM - fm) < WGM ? (nM - fm) : WGM;
        u.pm = fm + ((wgid % nig) % gsz); u.pn = (wgid % nig) / gsz; return true;
    }
    __device__ __forceinline__ void a_ready(const Unit&) const {}
    __device__ __forceinline__ void done(const Unit&) const {}
    __device__ __forceinline__ int idle_class() const { const int nfr = nwg / G, left = nwg - nfr * G; if (left == 0) return 3; if (2 * left <= G) return c < 2 * left ? 0 : 1; return c < left ? 0 : 2; }
    const char* Bt; int K2;
    __device__ __forceinline__ unsigned arow(const Unit& u, int R) const { return (unsigned)(u.pm * BM + (u.hs > 0 ? HALF : 0) + (u.hs >= 0 ? (R & (HALF - 1)) : R)); }
    __device__ __forceinline__ const char* bbase(const Unit& u) const { return Bt + (size_t)u.pn * BM * K2; }
};
__device__ __forceinline__ unsigned cvt_pk_bf16(float lo, float hi) { return ::pk2(lo, hi); }
typedef float f32x2 __attribute__((ext_vector_type(2)));
typedef int i32x4 __attribute__((ext_vector_type(4)));
template <bool I8> struct AccSel { typedef f32x4 T; static __device__ __forceinline__ T zero() { return (f32x4){0.f, 0.f, 0.f, 0.f}; } };
template <> struct AccSel<true> { typedef i32x4 T; static __device__ __forceinline__ T zero() { return (i32x4){0, 0, 0, 0}; } };
template <bool I8> __device__ __forceinline__ typename AccSel<I8>::T mma_op(bf16x8 a, bf16x8 b, typename AccSel<I8>::T c);
template <> __device__ __forceinline__ f32x4 mma_op<false>(bf16x8 a, bf16x8 b, f32x4 c) { return __builtin_amdgcn_mfma_f32_16x16x32_bf16(a, b, c, 0, 0, 0); }
template <> __device__ __forceinline__ i32x4 mma_op<true>(bf16x8 a, bf16x8 b, i32x4 c) { return __builtin_amdgcn_mfma_i32_16x16x64_i8(__builtin_bit_cast(i32x4, a), __builtin_bit_cast(i32x4, b), c, 0, 0, 0); }
struct EpiBf16 {
    static constexpr bool PERM = true, AFTER_DRAIN = false, I8 = false;
    bf16_t* O; int ldc;
    __device__ __forceinline__ void operator()(const f32x4 (&acc)[2][2][4][2], const Unit& u, int wr, int wc, int fr, int fq) const {
        const int row0 = u.pm * BM + (u.hs > 0 ? HALF : 0) + wr * 64 + fr, col0 = u.pn * BM + wc * 32 + 8 * fq; const int nai = u.hs >= 0 ? 1 : 2;
#pragma unroll
        for (int ai = 0; ai < 2; ++ai) if (ai < nai)
#pragma unroll
            for (int m = 0; m < 4; ++m) { bf16_t* rowp = O + (size_t)(row0 + ai * HALF + m * 16) * ldc + col0;
#pragma unroll
                for (int bj = 0; bj < 2; ++bj) { const f32x4 v0 = acc[ai][bj][m][0], v1 = acc[ai][bj][m][1];
                    u32x4 w; w.x = cvt_pk_bf16(v0[0], v0[1]); w.y = cvt_pk_bf16(v0[2], v0[3]); w.z = cvt_pk_bf16(v1[0], v1[1]); w.w = cvt_pk_bf16(v1[2], v1[3]);
                    *(u32x4*)(rowp + bj * HALF) = w; } }
    }
};
struct EpiSwiGLU {
    static constexpr bool PERM = true, AFTER_DRAIN = false, I8 = false;
    bf16_t* O; int ldc;
    __device__ __forceinline__ void operator()(const f32x4 (&acc)[2][2][4][2], const Unit& u, int wr, int wc, int fr, int fq) const {
        const int row0 = u.pm * BM + (u.hs > 0 ? HALF : 0) + wr * 64 + fr, col0 = u.pn * HALF + wc * 32 + 8 * fq; const int nai = u.hs >= 0 ? 1 : 2;
#pragma unroll
        for (int ai = 0; ai < 2; ++ai) if (ai < nai)
#pragma unroll
            for (int m = 0; m < 4; ++m) { bf16_t* rowp = O + (size_t)(row0 + ai * HALF + m * 16) * ldc + col0;
                float r[8];
#pragma unroll
                for (int n = 0; n < 2; ++n)
#pragma unroll
                    for (int j = 0; j < 4; ++j) { const float g = acc[ai][0][m][n][j], uu = acc[ai][1][m][n][j]; r[n * 4 + j] = g / (1.0f + __expf(-g)) * uu; }
                u32x4 w; w.x = cvt_pk_bf16(r[0], r[1]); w.y = cvt_pk_bf16(r[2], r[3]); w.z = cvt_pk_bf16(r[4], r[5]); w.w = cvt_pk_bf16(r[6], r[7]);
                *(u32x4*)rowp = w; }
    }
};
struct EpiResid {
    static constexpr bool PERM = false, AFTER_DRAIN = false, I8 = false;
    const float* base_lat; const float* base_ctx; float* out_lat; float* out_ctx; const float* gate; const float* comb; int comb_ld; int nlat_tiles;
    __device__ __forceinline__ void operator()(const f32x4 (&acc)[2][2][4][2], const Unit& u, int wr, int wc, int fr, int fq) const {
        const bool isctx = u.pm >= nlat_tiles;
        const int rloc0 = (isctx ? (u.pm - nlat_tiles) : u.pm) * BM + (u.hs > 0 ? HALF : 0) + wr * 64 + fr, col0 = u.pn * BM + wc * 32 + 4 * fq; const int nai = u.hs >= 0 ? 1 : 2;
        const float* bp = isctx ? base_ctx : base_lat; float* op = isctx ? out_ctx : out_lat;
        const float* gp = gate + (size_t)(isctx ? 8 : (u.pm >> 3)) * 6144 + col0;
        f32x4 gv[2][2];
#pragma unroll
        for (int bj = 0; bj < 2; ++bj)
#pragma unroll
            for (int n = 0; n < 2; ++n) gv[bj][n] = *(const f32x4*)(gp + bj * HALF + n * 16);
#pragma unroll
        for (int ai = 0; ai < 2; ++ai) if (ai < nai)
#pragma unroll
            for (int m = 0; m < 4; ++m) { const int rl = rloc0 + ai * HALF + m * 16; const size_t off = (size_t)rl * 1024 + col0;
                const float cs = comb ? comb[(size_t)rl * comb_ld] : 1.0f;
#pragma unroll
                for (int bj = 0; bj < 2; ++bj)
#pragma unroll
                    for (int n = 0; n < 2; ++n) { const f32x4 bs = *(const f32x4*)(bp + off + bj * HALF + n * 16);
                        *(f32x4*)(op + off + bj * HALF + n * 16) = bs + gv[bj][n] * acc[ai][bj][m][n] * cs; } }
    }
};

struct EpiNull {
    static constexpr bool PERM = true, AFTER_DRAIN = false, I8 = false;
    bf16_t* O; int ldc;
    __device__ __forceinline__ void operator()(const f32x4 (&acc)[2][2][4][2], const Unit& u, int wr, int wc, int fr, int fq) const {
        float s = 0.f;
#pragma unroll
        for (int ai = 0; ai < 2; ++ai)
#pragma unroll
            for (int bj = 0; bj < 2; ++bj)
#pragma unroll
                for (int m = 0; m < 4; ++m)
#pragma unroll
                    for (int n = 0; n < 2; ++n) s += acc[ai][bj][m][n][0] + acc[ai][bj][m][n][1] + acc[ai][bj][m][n][2] + acc[ai][bj][m][n][3];
        if (s == 12345.678f) O[0] = (bf16_t)1;
    }
};

struct EpiProj {
    static constexpr bool PERM = true, AFTER_DRAIN = false, I8 = false;
    bf16_t* O; int ldc; const float* rope; const float* qgain; const float* kgain; int nlat_tiles;
    __device__ __forceinline__ void operator()(const f32x4 (&acc)[2][2][4][2], const Unit& u, int wr, int wc, int fr, int fq) const {
        const int row0 = u.pm * BM + (u.hs > 0 ? HALF : 0) + wr * 64 + fr, col0 = u.pn * BM + wc * 32 + 8 * fq; const int nai = u.hs >= 0 ? 1 : 2;
        const int pn = u.pn; const bool lat = u.pm < nlat_tiles;
        const bool isrope = pn < 2 && lat, isnorm = pn >= 8 && pn < 12; const float sc = (pn == 1) ? 0.125f : 1.0f;
        const float* gp = (pn < 10 ? qgain : kgain) + 32 * (fq >> 1) + 8 * (fq & 1);
#pragma unroll
        for (int ai = 0; ai < 2; ++ai) if (ai < nai)
#pragma unroll
            for (int m = 0; m < 4; ++m) { const int row = row0 + ai * HALF + m * 16; bf16_t* rowp = O + (size_t)row * ldc + col0;
                f32x4 x1[2] = {acc[ai][0][m][0], acc[ai][0][m][1]}, x2[2] = {acc[ai][1][m][0], acc[ai][1][m][1]};
                if (isrope) { const int t = row & (SEQ - 1); const int pos = (fq >> 1) ? (t & 63) : (t >> 6); const float* rp = rope + (size_t)(pos * 16 + 8 * (fq & 1)) * 2;
#pragma unroll
                    for (int n = 0; n < 2; ++n) { const f32x4 cs0 = *(const f32x4*)(rp + 8 * n), cs1 = *(const f32x4*)(rp + 8 * n + 4);
                        const f32x4 a1 = x1[n], a2 = x2[n];
                        x1[n] = (f32x4){a1[0] * cs0[0] - a2[0] * cs0[1], a1[1] * cs0[2] - a2[1] * cs0[3], a1[2] * cs1[0] - a2[2] * cs1[1], a1[3] * cs1[2] - a2[3] * cs1[3]};
                        x2[n] = (f32x4){a1[0] * cs0[1] + a2[0] * cs0[0], a1[1] * cs0[3] + a2[1] * cs0[2], a1[2] * cs1[1] + a2[2] * cs1[0], a1[3] * cs1[3] + a2[3] * cs1[2]}; } }
                if (isnorm) { float ss = 0.f;
#pragma unroll
                    for (int n = 0; n < 2; ++n) ss += (x1[n][0] * x1[n][0] + x1[n][1] * x1[n][1]) + (x1[n][2] * x1[n][2] + x1[n][3] * x1[n][3]) + (x2[n][0] * x2[n][0] + x2[n][1] * x2[n][1]) + (x2[n][2] * x2[n][2] + x2[n][3] * x2[n][3]);
                    ss = ::sum_g4(ss); const float rs = rsqrtf(ss * (1.0f / 64.0f) + 1e-6f);
#pragma unroll
                    for (int n = 0; n < 2; ++n) { x1[n] = x1[n] * rs * *(const f32x4*)(gp + 4 * n); x2[n] = x2[n] * rs * *(const f32x4*)(gp + 16 + 4 * n); } }
                u32x4 w1, w2;
                w1.x = cvt_pk_bf16(x1[0][0] * sc, x1[0][1] * sc); w1.y = cvt_pk_bf16(x1[0][2] * sc, x1[0][3] * sc); w1.z = cvt_pk_bf16(x1[1][0] * sc, x1[1][1] * sc); w1.w = cvt_pk_bf16(x1[1][2] * sc, x1[1][3] * sc);
                w2.x = cvt_pk_bf16(x2[0][0] * sc, x2[0][1] * sc); w2.y = cvt_pk_bf16(x2[0][2] * sc, x2[0][3] * sc); w2.z = cvt_pk_bf16(x2[1][0] * sc, x2[1][1] * sc); w2.w = cvt_pk_bf16(x2[1][2] * sc, x2[1][3] * sc);
                *(u32x4*)rowp = w1; *(u32x4*)(rowp + HALF) = w2;
                asm volatile("" ::: "memory"); }
    }
};

struct EpiSwiGLUI8 {
    static constexpr bool PERM = true, AFTER_DRAIN = false, I8 = true;
    bf16_t* O; int ldc; const float* sa; const unsigned* colmax; const PG8_LAS int* tab; const PG8_LAS int* rowtab; int ncol_e;
    __device__ __forceinline__ void operator()(const i32x4 (&acc)[2][2][4][2], const Unit& u, int wr, int wc, int fr, int fq) const {
        const int rt0 = (u.hs > 0 ? HALF : 0) + wr * 64 + fr, row0 = u.pm * BM + rt0, col0 = u.pn * HALF + wc * 32 + 8 * fq; const int nai = u.hs >= 0 ? 1 : 2;
        int e = 0; if (tab) {
#pragma unroll
            for (int k = 1; k < 8; ++k) e += (u.pm >= tab[k]) ? 1 : 0; }
        const unsigned* cm = colmax + (size_t)e * ncol_e + u.pn * BM + wc * 32 + 8 * fq;
        float sg[8], su[8];
#pragma unroll
        for (int i = 0; i < 8; ++i) { sg[i] = __uint_as_float(cm[i]) * (1.0f / 127.0f); su[i] = __uint_as_float(cm[HALF + i]) * (1.0f / 127.0f); }
#pragma unroll
        for (int ai = 0; ai < 2; ++ai) if (ai < nai)
#pragma unroll
            for (int m = 0; m < 4; ++m) { const int rt = rt0 + ai * HALF + m * 16; bf16_t* rowp = O + (size_t)(u.pm * BM + rt) * ldc + col0;
                int arow = u.pm * BM + rt;
                if (tab) arow = rowtab[u.idx * BM + rt];
                const float s_a = sa[arow];
                float r[8];
#pragma unroll
                for (int n = 0; n < 2; ++n)
#pragma unroll
                    for (int j = 0; j < 4; ++j) { const float g = (float)acc[ai][0][m][n][j] * (s_a * sg[n * 4 + j]), uu = (float)acc[ai][1][m][n][j] * (s_a * su[n * 4 + j]); r[n * 4 + j] = g / (1.0f + __expf(-g)) * uu; }
                u32x4 w; w.x = cvt_pk_bf16(r[0], r[1]); w.y = cvt_pk_bf16(r[2], r[3]); w.z = cvt_pk_bf16(r[4], r[5]); w.w = cvt_pk_bf16(r[6], r[7]);
                *(u32x4*)rowp = w; }
        (void)row0;
    }
};
struct EpiProjI8 {
    static constexpr bool PERM = true, AFTER_DRAIN = false, I8 = true;
    bf16_t* O; int ldc; const float* rope; const float* qgain; const float* kgain; int nlat_tiles; const float* sa; const unsigned* colmax;
    __device__ __forceinline__ void operator()(const i32x4 (&acc)[2][2][4][2], const Unit& u, int wr, int wc, int fr, int fq) const {
        const int row0 = u.pm * BM + (u.hs > 0 ? HALF : 0) + wr * 64 + fr, col0 = u.pn * BM + wc * 32 + 8 * fq; const int nai = u.hs >= 0 ? 1 : 2;
        const int pn = u.pn; const bool lat = u.pm < nlat_tiles;
        const bool isrope = pn < 2 && lat, isnorm = pn >= 8 && pn < 12; const float sc = (pn == 1) ? 0.125f : 1.0f;
        const float* gp = (pn < 10 ? qgain : kgain) + 32 * (fq >> 1) + 8 * (fq & 1);
        const unsigned* cm = colmax + col0;
#pragma unroll
        for (int ai = 0; ai < 2; ++ai) if (ai < nai)
#pragma unroll
            for (int m = 0; m < 4; ++m) { const int row = row0 + ai * HALF + m * 16; bf16_t* rowp = O + (size_t)row * ldc + col0;
                const float s_a = sa[row] * (1.0f / 127.0f);
                f32x4 x1[2], x2[2];
#pragma unroll
                for (int n = 0; n < 2; ++n)
#pragma unroll
                    for (int j = 0; j < 4; ++j) { x1[n][j] = (float)acc[ai][0][m][n][j] * (s_a * __uint_as_float(cm[4 * n + j])); x2[n][j] = (float)acc[ai][1][m][n][j] * (s_a * __uint_as_float(cm[HALF + 4 * n + j])); }
                if (isrope) { const int t = row & (SEQ - 1); const int pos = (fq >> 1) ? (t & 63) : (t >> 6); const float* rp = rope + (size_t)(pos * 16 + 8 * (fq & 1)) * 2;
#pragma unroll
                    for (int n = 0; n < 2; ++n) { const f32x4 cs0 = *(const f32x4*)(rp + 8 * n), cs1 = *(const f32x4*)(rp + 8 * n + 4);
                        const f32x4 a1 = x1[n], a2 = x2[n];
                        x1[n] = (f32x4){a1[0] * cs0[0] - a2[0] * cs0[1], a1[1] * cs0[2] - a2[1] * cs0[3], a1[2] * cs1[0] - a2[2] * cs1[1], a1[3] * cs1[2] - a2[3] * cs1[3]};
                        x2[n] = (f32x4){a1[0] * cs0[1] + a2[0] * cs0[0], a1[1] * cs0[3] + a2[1] * cs0[2], a1[2] * cs1[1] + a2[2] * cs1[0], a1[3] * cs1[3] + a2[3] * cs1[2]}; } }
                if (isnorm) { float ss = 0.f;
#pragma unroll
                    for (int n = 0; n < 2; ++n) ss += (x1[n][0] * x1[n][0] + x1[n][1] * x1[n][1]) + (x1[n][2] * x1[n][2] + x1[n][3] * x1[n][3]) + (x2[n][0] * x2[n][0] + x2[n][1] * x2[n][1]) + (x2[n][2] * x2[n][2] + x2[n][3] * x2[n][3]);
                    ss = ::sum_g4(ss); const float rs = rsqrtf(ss * (1.0f / 64.0f) + 1e-6f);
#pragma unroll
                    for (int n = 0; n < 2; ++n) { x1[n] = x1[n] * rs * *(const f32x4*)(gp + 4 * n); x2[n] = x2[n] * rs * *(const f32x4*)(gp + 16 + 4 * n); } }
                u32x4 w1, w2;
                w1.x = cvt_pk_bf16(x1[0][0] * sc, x1[0][1] * sc); w1.y = cvt_pk_bf16(x1[0][2] * sc, x1[0][3] * sc); w1.z = cvt_pk_bf16(x1[1][0] * sc, x1[1][1] * sc); w1.w = cvt_pk_bf16(x1[1][2] * sc, x1[1][3] * sc);
                w2.x = cvt_pk_bf16(x2[0][0] * sc, x2[0][1] * sc); w2.y = cvt_pk_bf16(x2[0][2] * sc, x2[0][3] * sc); w2.z = cvt_pk_bf16(x2[1][0] * sc, x2[1][1] * sc); w2.w = cvt_pk_bf16(x2[1][2] * sc, x2[1][3] * sc);
                *(u32x4*)rowp = w1; *(u32x4*)(rowp + HALF) = w2;
                asm volatile("" ::: "memory"); }
    }
};
template <class Epi, class Sched, bool STAMP = false>
__device__ __forceinline__ void gemm_phase(PG8_LAS unsigned char* lds, const Gemm g, const Sched& S, const Epi& E, unsigned long long* stamps, int tid_in) {
    int tid_ = tid_in; asm volatile("" : "+v"(tid_)); const int tid = tid_, wid = __builtin_amdgcn_readfirstlane(tid >> 6), lane = tid & 63, wr = wid >> 2, wc = wid & 3, fr = lane & 15, fq = lane >> 4;
    const int K = g.K, nt = K / BK;
    int ts_lo = 0, ts_hi = 0, nts = 0; const unsigned long long rt_entry = STAMP ? (unsigned long long)wall_clock64() : 0ull;
#define PG8_STAMP() do { if (STAMP && wid == 0 && nts < 64) { const unsigned long long _c = (unsigned long long)clock64(); \
        ts_lo = (lane == nts) ? (int)(unsigned)_c : ts_lo; ts_hi = (lane == nts) ? (int)(unsigned)(_c >> 32) : ts_hi; ++nts; } } while (0)
    PG8_STAMP();
    unsigned voffB[2]; int stR[2]; unsigned stC[2];
#pragma unroll
    for (int i = 0; i < 2; ++i) { int R, C; stage_rc(tid * 16 + i * 8192, R, C); const int Rb = Epi::PERM ? ((R & ~31) + perm32(R & 31)) : R;
        stR[i] = R; stC[i] = (unsigned)C * 2u; voffB[i] = (unsigned)Rb * (unsigned)S.K2 + (unsigned)C * 2u; }
    unsigned vAc0[2], vAc1[2], vAn0[2], vAn1[2];
#define PG8_AROWS(u, d0, d1) do { _Pragma("unroll") for (int _i = 0; _i < 2; ++_i) { d0[_i] = S.arow(u, stR[_i]) * (unsigned)(K * 2) + stC[_i]; d1[_i] = S.arow(u, HALF + stR[_i]) * (unsigned)(K * 2) + stC[_i]; } } while (0)
    const size_t kstep = (size_t)(BK * 2);
    const size_t hstep = (size_t)HALF * S.K2;
    const size_t tstep = 2 * hstep;
    const unsigned ldsw = (unsigned)wid * 1024u;
    const int aoff = lds_byte(wr * 64 + fr, fq * 8), boff = lds_byte(wc * 32 + fr, fq * 8);
#define PG8_SA(b, h) (((b) * 2 + (h)) * HTB)
#define PG8_SB(b, h) ((4 + (b) * 2 + (h)) * HTB)
#define PG8_STAGE(bufoff, gbase, voff) do { _Pragma("unroll") for (int _i = 0; _i < 2; ++_i) \
        __builtin_amdgcn_global_load_lds((const unsigned*)((const char*)(gbase) + (voff)[_i]), (PG8_LAS unsigned*)(lds + (bufoff) + ldsw + _i * 8192), 16, 0, 0); } while (0)
#define PG8_LDA(dst, b, h) do { _Pragma("unroll") for (int m = 0; m < 4; ++m) _Pragma("unroll") for (int k = 0; k < 2; ++k) dst[m][k] = *(const PG8_LAS bf16x8*)(lds + PG8_SA(b, h) + aoff + m * 2048 + k * 1024); } while (0)
#define PG8_LDB(dst, b, h) do { _Pragma("unroll") for (int n = 0; n < 2; ++n) _Pragma("unroll") for (int k = 0; k < 2; ++k) dst[n][k] = *(const PG8_LAS bf16x8*)(lds + PG8_SB(b, h) + boff + n * 2048 + k * 1024); } while (0)
#define PG8_MMA(ai, bj, At, Bt) do { __builtin_amdgcn_s_setprio(1); _Pragma("unroll") for (int m = 0; m < 4; ++m) _Pragma("unroll") for (int n = 0; n < 2; ++n) _Pragma("unroll") for (int k = 0; k < 2; ++k) \
        acc[ai][bj][m][n] = mma_op<Epi::I8>(Bt[n][k], At[m][k], acc[ai][bj][m][n]); __builtin_amdgcn_s_setprio(0); } while (0)
#define PG8_WAIT_V(n) asm volatile("s_waitcnt vmcnt(" #n ")" ::: "memory")
#define PG8_WAIT_L(n) asm volatile("s_waitcnt lgkmcnt(" #n ")" ::: "memory")
#define PG8_BAR __builtin_amdgcn_s_barrier()
#define PG8_SCHED __builtin_amdgcn_sched_barrier(0)
    Unit cur, nxt; int ui = 0;
    if (!S.next(0, cur)) return;
    typename AccSel<Epi::I8>::T acc[2][2][4][2];
#pragma unroll
    for (int a = 0; a < 2; ++a)
#pragma unroll
        for (int b = 0; b < 2; ++b)
#pragma unroll
            for (int m = 0; m < 4; ++m)
#pragma unroll
                for (int n = 0; n < 2; ++n) acc[a][b][m][n] = AccSel<Epi::I8>::zero();
    bf16x8 At[4][2], B0[2][2], B1[2][2];
    const char* const cA = (const char*)g.A; const char* cB = S.bbase(cur);
    PG8_AROWS(cur, vAc0, vAc1);
    S.a_ready(cur);
    PG8_STAGE(PG8_SB(0, 0), cB, voffB); PG8_STAGE(PG8_SA(0, 0), cA, vAc0); PG8_STAGE(PG8_SB(0, 1), cB + hstep, voffB); PG8_STAGE(PG8_SA(0, 1), cA, vAc1);
    if (wr == 1) PG8_BAR;
    PG8_WAIT_V(4); PG8_BAR;
    PG8_STAGE(PG8_SB(1, 0), cB + kstep, voffB); PG8_STAGE(PG8_SA(1, 0), cA + kstep, vAc0); PG8_STAGE(PG8_SB(1, 1), cB + hstep + kstep, voffB);
    PG8_WAIT_V(6); PG8_BAR;
    PG8_STAMP();
    for (;;) {
        const bool has_next = S.next(ui + 1, nxt);
        const char* nB = has_next ? S.bbase(nxt) : cB;
        if (has_next) PG8_AROWS(nxt, vAn0, vAn1); else { _Pragma("unroll") for (int _i = 0; _i < 2; ++_i) { vAn0[_i] = vAc0[_i]; vAn1[_i] = vAc1[_i]; } }
        const bool full = cur.hs < 0;
        for (int t = 0; t < nt; t += 2) {
            const bool last = (t == nt - 2);
            const char* a1 = cA + (size_t)(t + 1) * kstep;
            const char* a2 = last ? cA : cA + (size_t)(t + 2) * kstep; const char* b2 = last ? nB : cB + (size_t)(t + 2) * kstep;
            const char* a3 = a2 + kstep; const char* b3 = b2 + kstep;
            unsigned v20[2], v21[2];
#pragma unroll
            for (int _i = 0; _i < 2; ++_i) { v20[_i] = last ? vAn0[_i] : vAc0[_i]; v21[_i] = last ? vAn1[_i] : vAc1[_i]; }
            if (last && has_next) S.a_ready(nxt);
            PG8_LDB(B0, 0, 0); PG8_SCHED; PG8_LDA(At, 0, 0); PG8_STAGE(PG8_SA(1, 1), a1, vAc1);
            PG8_WAIT_L(8); PG8_BAR; PG8_WAIT_L(0); PG8_MMA(0, 0, At, B0); PG8_BAR; PG8_SCHED;
            PG8_LDB(B1, 0, 1); PG8_STAGE(PG8_SB(0, 0), b2, voffB);
            PG8_BAR; PG8_WAIT_L(0); PG8_MMA(0, 1, At, B1); PG8_BAR;
            if (full) PG8_LDA(At, 0, 1); PG8_STAGE(PG8_SA(0, 0), a2, v20);
            PG8_BAR; PG8_WAIT_L(0); if (full) PG8_MMA(1, 0, At, B0); PG8_BAR; PG8_SCHED;
            PG8_STAGE(PG8_SB(0, 1), b2 + hstep, voffB);
            PG8_WAIT_V(6); PG8_BAR; if (full) PG8_MMA(1, 1, At, B1); PG8_BAR;
            PG8_LDB(B0, 1, 0); PG8_SCHED; PG8_LDA(At, 1, 0); PG8_STAGE(PG8_SA(0, 1), a2, v21);
            PG8_WAIT_L(8); PG8_BAR; PG8_WAIT_L(0); PG8_MMA(0, 0, At, B0); PG8_BAR; PG8_SCHED;
            PG8_LDB(B1, 1, 1); PG8_STAGE(PG8_SB(1, 0), b3, voffB);
            PG8_BAR; PG8_WAIT_L(0); PG8_MMA(0, 1, At, B1); PG8_BAR;
            if (full) PG8_LDA(At, 1, 1); PG8_STAGE(PG8_SA(1, 0), a3, v20);
            PG8_BAR; PG8_WAIT_L(0); if (full) PG8_MMA(1, 0, At, B0); PG8_BAR; PG8_SCHED;
            PG8_STAGE(PG8_SB(1, 1), b3 + hstep, voffB);
            PG8_WAIT_V(6); PG8_BAR; if (full) PG8_MMA(1, 1, At, B1); PG8_BAR;
        }
        PG8_STAMP();
        if constexpr (!Epi::AFTER_DRAIN) { E(acc, cur, wr, wc, fr, fq); S.done(cur); }
        PG8_STAMP();
        if (!has_next) break;
#pragma unroll
        for (int a = 0; a < 2; ++a)
#pragma unroll
            for (int b = 0; b < 2; ++b)
#pragma unroll
                for (int m = 0; m < 4; ++m)
#pragma unroll
                    for (int n = 0; n < 2; ++n) acc[a][b][m][n] = AccSel<Epi::I8>::zero();
        cur = nxt; cB = nB; ++ui;
#pragma unroll
        for (int _i = 0; _i < 2; ++_i) { vAc0[_i] = vAn0[_i]; vAc1[_i] = vAn1[_i]; }
    }
    PG8_WAIT_V(0);
    if (wr == 0) PG8_BAR;
    PG8_BAR;
    if constexpr (Epi::AFTER_DRAIN) { E.fused(acc, cur, wr, wc, fr, fq, lds, wid, lane); S.done(cur); }
    PG8_STAMP();
    if (STAMP && wid == 0) { stamps[lane] = lane < nts ? (((unsigned long long)(unsigned)ts_hi << 32) | (unsigned)ts_lo) : 0ull;
        if (lane == 62) stamps[62] = rt_entry; if (lane == 63) stamps[63] = (unsigned long long)wall_clock64(); }
#undef PG8_STAMP
#undef PG8_SA
#undef PG8_AROWS
#undef PG8_SB
#undef PG8_STAGE
#undef PG8_LDA
#undef PG8_LDB
#undef PG8_MMA
#undef PG8_WAIT_V
#undef PG8_WAIT_L
#undef PG8_BAR
#undef PG8_SCHED
}
}
#define XB_TMO      128
#define XB_XCNT(j)  (256  + 64 * (j))
#define XB_XSUB(j)  (1280 + 64 * (j))
#define XB_XGEN(j)  (2304 + 64 * (j))
#define XB_TOP      3328
#define XB_TOPGEN   3392
#define XCD_BAR_WORDS 3456
#define XB_SPIN_CAP (1u << 24)

__device__ __forceinline__ unsigned xb_ld(unsigned* p)              { return __hip_atomic_load(p, __ATOMIC_RELAXED, __HIP_MEMORY_SCOPE_AGENT); }
__device__ __forceinline__ unsigned xb_add(unsigned* p, unsigned v) { return __hip_atomic_fetch_add(p, v, __ATOMIC_RELAXED, __HIP_MEMORY_SCOPE_AGENT); }
__device__ __forceinline__ unsigned xb_xcc_id() { return (unsigned)__builtin_amdgcn_s_getreg((3 << 11) | 20) & 0xFu; }
#define XB_SPIN(cond, bar) do { unsigned _sp = 0; while (cond) { __builtin_amdgcn_s_sleep(1); \
    if ((++_sp & 255u) == 0u) { if (xb_ld(&(bar)[XB_TMO])) break; if (_sp > XB_SPIN_CAP) { atomicAdd(&(bar)[XB_TMO], 1u); break; } } } } while (0)

struct XcdBarrier {
    unsigned* bar; unsigned x;
    volatile LAS unsigned* st;
};

__device__ __forceinline__ XcdBarrier xcd_barrier_post(unsigned* bar, volatile LAS unsigned* st) {
    XcdBarrier b; b.bar = bar; b.x = xb_xcc_id(); b.st = st;
    if (threadIdx.x == 0) (void)xb_add(&bar[XB_XCNT(b.x)], 1u);
    return b;
}
__device__ __forceinline__ void xcd_barrier_complete(unsigned* bar, unsigned x, unsigned& nloc, unsigned& nx) {
    const unsigned G = gridDim.x * gridDim.y * gridDim.z;
    unsigned sum, cnt, mine, sp = 0u;
    for (;;) {
        sum = 0u; cnt = 0u; mine = 0u;
#pragma unroll
        for (unsigned j = 0; j < 16; ++j) { const unsigned c = xb_ld(&bar[XB_XCNT(j)]); sum += c; cnt += (c > 0u) ? 1u : 0u; mine = (j == x) ? c : mine; }
        if (sum == G) break;
        __builtin_amdgcn_s_sleep(1);
        if ((++sp & 255u) == 0u) { if (xb_ld(&bar[XB_TMO])) break; if (sp > XB_SPIN_CAP) { atomicAdd(&bar[XB_TMO], 1u); break; } }
    }
    nloc = mine > 0u ? mine : 1u; nx = cnt > 0u ? cnt : 1u;
}

__device__ __forceinline__ void xcd_barrier(const XcdBarrier& b) {
    asm volatile("s_waitcnt vmcnt(0)" ::: "memory");
    __syncthreads();
    if (threadIdx.x == 0) {
        unsigned* bar = b.bar;
        __builtin_amdgcn_s_waitcnt(0);
        unsigned nloc = b.st[0], nx = b.st[1];
        if (nloc == 0u) { xcd_barrier_complete(bar, b.x, nloc, nx); b.st[0] = nloc; b.st[1] = nx; }
        const unsigned old = xb_add(&bar[XB_XSUB(b.x)], 1u);
        const unsigned gen = old / nloc;
        if (old + 1u == (gen + 1u) * nloc) {
            __builtin_amdgcn_fence(__ATOMIC_RELEASE, "agent");
            asm volatile("s_waitcnt vmcnt(0)" ::: "memory");
            const unsigned og = xb_add(&bar[XB_TOP], 1u);
            const unsigned tg = og / nx;
            if (og + 1u == (tg + 1u) * nx) xb_add(&bar[XB_TOPGEN], 1u);
            else XB_SPIN(xb_ld(&bar[XB_TOPGEN]) == tg, bar);
            __builtin_amdgcn_fence(__ATOMIC_ACQUIRE, "agent");
            xb_add(&bar[XB_XGEN(b.x)], 1u);
            asm volatile("s_waitcnt vmcnt(0)" ::: "memory");
        } else {
            XB_SPIN(xb_ld(&bar[XB_XGEN(b.x)]) == gen, bar);
            __builtin_amdgcn_fence(__ATOMIC_ACQUIRE, "agent");
            asm volatile("s_waitcnt vmcnt(0)" ::: "memory");
        }
    }
    __syncthreads();
}

constexpr int SCR_BYTES = 139264;
constexpr int MISC_OFF = 147456 - 128;
constexpr int LDS_BYTES = 147456;
constexpr int CW_BAR = 4096;
constexpr int NTHR = 512, NWAVES = 8;
constexpr int CW_COLMAX = 131072;
constexpr int N_QROWS = 2 * NPW + NUP + NEXP * NUP;
constexpr int CW_MOE = 8192;

__device__ __forceinline__ void transpose_item(const float* W, int ldw, int col0, int K, bf16_t* WT, int drow0, int kb, LAS float* scr, int lane, int gap16 = 0, unsigned* cmax = nullptr) {
    const int k0 = 64 * kb; const int cs = col0 + (lane & 31) + ((lane & 16) ? gap16 : 0);
    float v[32];
#pragma unroll
    for (int i = 0; i < 32; ++i) v[i] = W[(size_t)(k0 + 2 * i + (lane >> 5)) * ldw + cs];
#pragma unroll
    for (int i = 0; i < 32; ++i) scr[(2 * i + (lane >> 5)) * 33 + (lane & 31)] = v[i];
    asm volatile("s_waitcnt lgkmcnt(0)" ::: "memory");
    const int c = lane & 7;
#pragma unroll
    for (int j = 0; j < 4; ++j) { const int n = (lane >> 3) + 8 * j; const LAS float* s = scr + (8 * c) * 33 + n;
        u32x4 o; o.x = pk2(s[0 * 33], s[1 * 33]); o.y = pk2(s[2 * 33], s[3 * 33]); o.z = pk2(s[4 * 33], s[5 * 33]); o.w = pk2(s[6 * 33], s[7 * 33]);
        *(u32x4*)(WT + (size_t)(drow0 + n) * K + k0 + 8 * c) = o;
        if (cmax) {
            float am = fmaxf(fmaxf(fmaxf(fabsf(bflo(o.x)), fabsf(bfhi(o.x))), fmaxf(fabsf(bflo(o.y)), fabsf(bfhi(o.y)))), fmaxf(fmaxf(fabsf(bflo(o.z)), fabsf(bfhi(o.z))), fmaxf(fabsf(bflo(o.w)), fabsf(bfhi(o.w)))));
            am = fmaxf(am, swz_xor<1>(am)); am = fmaxf(am, swz_xor<2>(am)); am = fmaxf(am, swz_xor<4>(am));
            if (c == 0) atomicMax(cmax + drow0 + n, __float_as_uint(am)); } }
    asm volatile("s_waitcnt lgkmcnt(0)" ::: "memory");
}
__device__ __forceinline__ void up_item(const float* wg, const float* wu, bf16_t* WT, int it, LAS float* scr, int lane, unsigned* cmax) {
    const int nb = it >> 4, kb = it & 15, r0 = 32 * nb, pn = r0 >> 8, p = r0 & 255;
    transpose_item(p < 128 ? wg : wu, DFF, 128 * pn + (p & 127), DM, WT, r0, kb, scr, lane, 0, cmax);
}
__device__ __forceinline__ void dn_item(const float* wd, bf16_t* WT, int it, LAS float* scr, int lane) {
    const int nb = it / 44, kb = it % 44;
    transpose_item(wd, DM, 32 * nb, DFF, WT, 32 * nb, kb, scr, lane);
}
constexpr int IT_IN = 112 * 16, IT_OUT = 32 * 16, IT_UP = 176 * 16, IT_DN = 32 * 44;
constexpr int IT_TOTAL = 2 * IT_IN + 2 * IT_OUT + IT_UP + IT_DN + NEXP * (IT_UP + IT_DN);

__device__ __forceinline__ void convert_flat_item(const Args& a, unsigned char* ws, int it, LAS float* scr, int lane) {
    if (it < 2 * IT_IN) { const int l = it / IT_IN; it -= l * IT_IN; const int nb = it >> 4, kb = it & 15, r0 = 32 * nb;
        const int pn = r0 >> 8, p = r0 & 255; const bool hl = pn < 2 || (pn >= 8 && pn < 12);
        const int cbase = (pn < 8 ? 256 * pn : 256 * pn + 16);
        const int col0 = hl ? cbase + 64 * ((p >> 5) & 3) + 16 * (p >> 7) : cbase + p;
        transpose_item(a.in[8] + (size_t)l * DM * DIN, DIN, col0, DM, (bf16_t*)(ws + WS_WTIN) + (size_t)l * NPW * DM, r0, kb, scr, lane, hl ? 16 : 0, (unsigned*)(ws + WS_CTL) + CW_COLMAX + l * NPW); return; }
    it -= 2 * IT_IN;
    if (it < 2 * IT_OUT) { const int l = it / IT_OUT; it -= l * IT_OUT; const int nb = it >> 4, kb = it & 15;
        transpose_item(a.in[16] + (size_t)l * DM * DM, DM, 32 * nb, DM, (bf16_t*)(ws + WS_WTOUT) + (size_t)l * DM * DM, 32 * nb, kb, scr, lane); return; }
    it -= 2 * IT_OUT;
    if (it < IT_UP) { up_item(a.in[17], a.in[18], (bf16_t*)(ws + WS_WTUP), it, scr, lane, (unsigned*)(ws + WS_CTL) + CW_COLMAX + 2 * NPW); return; }
    it -= IT_UP;
    if (it < IT_DN) { dn_item(a.in[19], (bf16_t*)(ws + WS_WTDN), it, scr, lane); return; }
    it -= IT_DN;
    if (it < NEXP * IT_UP) { const int e = it / IT_UP; it -= e * IT_UP;
        up_item(a.in[21] + (size_t)e * DM * DFF, a.in[22] + (size_t)e * DM * DFF, (bf16_t*)(ws + WS_WTMUP) + (size_t)e * NUP * DM, it, scr, lane, (unsigned*)(ws + WS_CTL) + CW_COLMAX + 2 * NPW + NUP + e * NUP); return; }
    it -= NEXP * IT_UP;
    { const int e = it / IT_DN; it -= e * IT_DN; dn_item(a.in[23] + (size_t)e * DFF * DM, (bf16_t*)(ws + WS_WTMDN) + (size_t)e * DM * DFF, it, scr, lane); }
}
constexpr int N_EARLY = IT_IN + IT_OUT + IT_UP + IT_DN, N_DEFER = IT_TOTAL - N_EARLY, N_DEFER_L1 = IT_IN + IT_OUT;
__device__ __forceinline__ int early_to_flat(int i) { if (i < IT_IN) return i; i -= IT_IN; if (i < IT_OUT) return 2 * IT_IN + i; return 2 * IT_IN + 2 * IT_OUT + (i - IT_OUT); }
__device__ __forceinline__ int defer_to_flat(int d) { if (d < IT_IN) return IT_IN + d; d -= IT_IN; if (d < IT_OUT) return 2 * IT_IN + IT_OUT + d; return 2 * IT_IN + 2 * IT_OUT + IT_UP + IT_DN + (d - IT_OUT); }
#ifndef CVN1
#define CVN1 0
#define CVN2 0
#define CVN3 0
#endif
constexpr int N_MOE_ITEMS = NEXP * (IT_UP + IT_DN);
constexpr int CV_BASE2 = 192 * 8 * CVN1, CV_BASE3 = CV_BASE2 + 160 * 8 * CVN2, CV_HIDDEN_ = CV_BASE3 + 192 * 8 * CVN3, CV_HIDDEN = CV_HIDDEN_ < N_MOE_ITEMS ? CV_HIDDEN_ : N_MOE_ITEMS;
__device__ __forceinline__ void convert_window(const Args& a, LAS unsigned char* lds, int lane, int wave, int G, int base, int rank, int n) {
    if (G != 256) return;
    unsigned char* ws = a.ws; LAS float* scr = (LAS float*)(lds + 65536 + wave * 8704);
    for (int j = 0; j < n; ++j) { const int m = base + (rank * NWAVES + wave) * n + j; if (m < CV_HIDDEN) convert_flat_item(a, ws, defer_to_flat(N_DEFER_L1 + m), scr, lane); }
}
__device__ __forceinline__ void phase_prologue(const Args& a, LAS unsigned char* lds, int tid, int lane, int wave, int bid, int G) {
    unsigned char* ws = a.ws;
    {
        LAS float* scr = (LAS float*)(lds + wave * 8704);
        const int gw = bid * NWAVES + wave, NGW = G * NWAVES;
        const int hid = (G == 256) ? CV_HIDDEN : 0, npro = N_EARLY + N_DEFER - hid;
        for (int i = gw; i < npro; i += NGW) { const int dd = i - N_EARLY; convert_flat_item(a, ws, i < N_EARLY ? early_to_flat(i) : defer_to_flat(dd < N_DEFER_L1 ? dd : dd + hid), scr, lane); }
    }
    __syncthreads();
    {
        const int gt = bid * NTHR + tid;
        if (gt < 1024) { const int pos = gt >> 4, i = gt & 15;
            double inv = 1.0; for (int q = 0; q < i; ++q) inv *= 0.56234132519034908;
            const float angf = (float)pos * (float)inv; const double ang = (double)angf;
            const double kq = rint(ang * 0.63661977236758134); const double r = ang - kq * 1.5707963267948966 - kq * 6.123233995736766e-17; const double r2 = r * r;
            double sn = r * (1.0 + r2 * (-1.0 / 6 + r2 * (1.0 / 120 + r2 * (-1.0 / 5040 + r2 * (1.0 / 362880 + r2 * (-1.0 / 39916800 + r2 * (1.0 / 6227020800.0)))))));
            double cs = 1.0 + r2 * (-0.5 + r2 * (1.0 / 24 + r2 * (-1.0 / 720 + r2 * (1.0 / 40320 + r2 * (-1.0 / 3628800 + r2 * (1.0 / 479001600.0 + r2 * (-1.0 / 87178291200.0)))))));
            const int kk = ((int)kq) & 3; double c2, s2;
            if (kk == 0) { c2 = cs; s2 = sn; } else if (kk == 1) { c2 = -sn; s2 = cs; } else if (kk == 2) { c2 = -cs; s2 = -sn; } else { c2 = sn; s2 = -cs; }
            float* R = (float*)(ws + WS_ROPE); R[gt * 2] = (float)c2; R[gt * 2 + 1] = (float)s2; }
    }
    {
        LAS float* sc = (LAS float*)(lds + 73728);
        LAS float* red = (LAS float*)(lds + 73728 + 36864);
        for (int i = tid; i < 9 * 1024; i += NTHR) { const float v = i < 8192 ? a.in[1][i] : a.in[3][i - 8192]; sc[i] = v / (1.0f + __expf(-v)); }
        __syncthreads();
        for (int item = bid; item < 192; item += G) {
            const int l = item / 96, n0 = (item % 96) * 64;
            const float* wm = a.in[6] + (size_t)l * DM * 6144 + n0 + lane;
            float acc[9];
#pragma unroll
            for (int b = 0; b < 9; ++b) acc[b] = 0.f;
#pragma unroll 4
            for (int kk = 0; kk < 128; ++kk) { const int k = wave * 128 + kk; const float w = wm[(size_t)k * 6144];
#pragma unroll
                for (int b = 0; b < 9; ++b) acc[b] += sc[b * 1024 + k] * w; }
#pragma unroll
            for (int b = 0; b < 9; ++b) red[(wave * 9 + b) * 64 + lane] = acc[b];
            __syncthreads();
            for (int o = tid; o < 576; o += NTHR) { const int b = o >> 6, ln = o & 63; float s = a.in[7][(size_t)l * 6144 + n0 + ln];
#pragma unroll
                for (int w = 0; w < 8; ++w) s += red[(w * 9 + b) * 64 + ln];
                ((float*)(ws + WS_MOD))[((size_t)l * 9 + b) * 6144 + n0 + ln] = s; }
            __syncthreads();
        }
    }
}

__device__ __forceinline__ unsigned pack_i8x4(float a, float b, float c, float d) {
    const int ia = __float2int_rn(a), ib = __float2int_rn(b), ic = __float2int_rn(c), id = __float2int_rn(d);
    return (unsigned)(ia & 0xff) | ((unsigned)(ib & 0xff) << 8) | ((unsigned)(ic & 0xff) << 16) | ((unsigned)(id & 0xff) << 24);
}
__device__ __forceinline__ void quantize_weight_rows(unsigned char* ws, int qrow_lo, int qrow_hi, int lane, int gw, int ngw) {
    const unsigned* cm = (const unsigned*)(ws + WS_CTL) + CW_COLMAX;
    for (int qr = qrow_lo + gw; qr < qrow_hi; qr += ngw) {
        unsigned char* rowp;
        if (qr < 2 * NPW) rowp = ws + WS_WTIN + (size_t)qr * 2048; else if (qr < 2 * NPW + NUP) rowp = ws + WS_WTUP + (size_t)(qr - 2 * NPW) * 2048; else rowp = ws + WS_WTMUP + (size_t)(qr - 2 * NPW - NUP) * 2048;
        const float am = __uint_as_float(__hip_atomic_load(cm + qr, __ATOMIC_RELAXED, __HIP_MEMORY_SCOPE_AGENT)); const float inv = am > 0.f ? 127.0f / am : 0.f;
        const u32x4 v0 = *(const u32x4*)(rowp + 32 * lane), v1 = *(const u32x4*)(rowp + 32 * lane + 16);
        u32x4 o;
        o.x = pack_i8x4(bflo(v0.x) * inv, bfhi(v0.x) * inv, bflo(v0.y) * inv, bfhi(v0.y) * inv); o.y = pack_i8x4(bflo(v0.z) * inv, bfhi(v0.z) * inv, bflo(v0.w) * inv, bfhi(v0.w) * inv);
        o.z = pack_i8x4(bflo(v1.x) * inv, bfhi(v1.x) * inv, bflo(v1.y) * inv, bfhi(v1.y) * inv); o.w = pack_i8x4(bflo(v1.z) * inv, bfhi(v1.z) * inv, bflo(v1.w) * inv, bfhi(v1.w) * inv);
        asm volatile("" ::: "memory");
        *(u32x4*)(rowp + 16 * lane) = o;
    }
}

typedef short bf16x8 __attribute__((ext_vector_type(8)));
typedef short s16x4 __attribute__((ext_vector_type(4)));
constexpr int IST = 160;
__device__ __forceinline__ f32x4 mfma16(bf16x8 a, bf16x8 b, f32x4 c) { return __builtin_amdgcn_mfma_f32_16x16x32_bf16(a, b, c, 0, 0, 0); }
__device__ __forceinline__ bf16x8 frag_row(LAS const unsigned char* img, int row0, int k0, int lane) {
    return *(const LAS bf16x8*)(img + (row0 + (lane & 15)) * IST + (k0 + 8 * (lane >> 4)) * 2);
}
template <bool PERMK>
__device__ __forceinline__ bf16x8 frag_tr(LAS const unsigned char* img, int r0, int c0, int lane) {
    const int g = lane >> 4, i = lane & 15, q = i >> 2, p = i & 3;
    const unsigned addr = (unsigned)(size_t)(img + (r0 + (PERMK ? 4 : 8) * g + q) * IST + (c0 + 4 * p) * 2);
    s16x4 lo, hi;
    if (PERMK) asm volatile("ds_read_b64_tr_b16 %0, %2\n\tds_read_b64_tr_b16 %1, %2 offset:2560\n\ts_waitcnt lgkmcnt(0)" : "=&v"(lo), "=&v"(hi) : "v"(addr) : "memory");
    else       asm volatile("ds_read_b64_tr_b16 %0, %2\n\tds_read_b64_tr_b16 %1, %2 offset:640\n\ts_waitcnt lgkmcnt(0)" : "=&v"(lo), "=&v"(hi) : "v"(addr) : "memory");
    bf16x8 r; r[0] = lo[0]; r[1] = lo[1]; r[2] = lo[2]; r[3] = lo[3]; r[4] = hi[0]; r[5] = hi[1]; r[6] = hi[2]; r[7] = hi[3];
    return r;
}
template <bool PERMK>
__device__ __forceinline__ void frag_tr_x4(LAS const unsigned char* img, int r0, int c0, int lane, bf16x8 (&out)[4]) {
    const int g = lane >> 4, i = lane & 15, q = i >> 2, p = i & 3;
    const unsigned addr = (unsigned)(size_t)(img + (r0 + (PERMK ? 4 : 8) * g + q) * IST + (c0 + 4 * p) * 2);
    s16x4 l0, h0, l1, h1, l2, h2, l3, h3;
    if (PERMK) asm volatile("ds_read_b64_tr_b16 %0, %8\n\tds_read_b64_tr_b16 %1, %8 offset:2560\n\tds_read_b64_tr_b16 %2, %8 offset:32\n\tds_read_b64_tr_b16 %3, %8 offset:2592\n\t"
                            "ds_read_b64_tr_b16 %4, %8 offset:64\n\tds_read_b64_tr_b16 %5, %8 offset:2624\n\tds_read_b64_tr_b16 %6, %8 offset:96\n\tds_read_b64_tr_b16 %7, %8 offset:2656\n\ts_waitcnt lgkmcnt(0)"
                            : "=&v"(l0), "=&v"(h0), "=&v"(l1), "=&v"(h1), "=&v"(l2), "=&v"(h2), "=&v"(l3), "=&v"(h3) : "v"(addr) : "memory");
    else       asm volatile("ds_read_b64_tr_b16 %0, %8\n\tds_read_b64_tr_b16 %1, %8 offset:640\n\tds_read_b64_tr_b16 %2, %8 offset:32\n\tds_read_b64_tr_b16 %3, %8 offset:672\n\t"
                            "ds_read_b64_tr_b16 %4, %8 offset:64\n\tds_read_b64_tr_b16 %5, %8 offset:704\n\tds_read_b64_tr_b16 %6, %8 offset:96\n\tds_read_b64_tr_b16 %7, %8 offset:736\n\ts_waitcnt lgkmcnt(0)"
                            : "=&v"(l0), "=&v"(h0), "=&v"(l1), "=&v"(h1), "=&v"(l2), "=&v"(h2), "=&v"(l3), "=&v"(h3) : "v"(addr) : "memory");
#define FT_PACK(o, lo, hi) o[0] = lo[0]; o[1] = lo[1]; o[2] = lo[2]; o[3] = lo[3]; o[4] = hi[0]; o[5] = hi[1]; o[6] = hi[2]; o[7] = hi[3];
    FT_PACK(out[0], l0, h0) FT_PACK(out[1], l1, h1) FT_PACK(out[2], l2, h2) FT_PACK(out[3], l3, h3)
#undef FT_PACK
}
__device__ __forceinline__ bf16x8 pack8(f32x4 a, f32x4 b) {
    union { u32x4 u; bf16x8 v; } x; x.u.x = pk2(a[0], a[1]); x.u.y = pk2(a[2], a[3]); x.u.z = pk2(b[0], b[1]); x.u.w = pk2(b[2], b[3]); return x.v;
}

__device__ __forceinline__ void phase_norm1(const Args& a, int l, LAS unsigned char* lds, int tid, int lane, int wave, int bid, int G) {
    unsigned char* ws = a.ws;
    constexpr int RST = 2064;
    LAS unsigned char* WgT = lds; LAS unsigned char* Himg = lds + 16 * RST; LAS float* red = (LAS float*)(lds + 32 * RST);
    { const float* w = a.in[8] + (size_t)l * DM * DIN + 2048;
      for (int i = tid; i < 16384; i += NTHR) { const int k = i >> 4, j = i & 15; *(LAS bf16_t*)(WgT + j * RST + k * 2) = (bf16_t)f2bf(w[(size_t)k * DIN + j]); } }
    __syncthreads();
    const float* gam = a.in[4] + (size_t)l * DM;
    const float* mod = (const float*)(ws + WS_MOD) + (size_t)l * 9 * 6144;
    unsigned char* H8 = ws + WS_H;
    for (int gi = bid; gi < MALL / 16; gi += G) {
#pragma unroll
        for (int rr = 0; rr < 2; ++rr) {
            const int r = 16 * gi + 2 * wave + rr; const bool lat = r < NLAT; const int bi = lat ? (r >> 11) : 8;
            const float* src = (l == 0) ? (lat ? a.in[0] + (size_t)r * DM : a.in[2] + (size_t)(r - NLAT) * DM) : (lat ? a.out + (size_t)r * DM : (const float*)(ws + WS_XC) + (size_t)(r - NLAT) * DM);
            f32x4 v[4]; float ss = 0.f;
#pragma unroll
            for (int j = 0; j < 4; ++j) { v[j] = *(const f32x4*)(src + 4 * lane + 256 * j); ss += (v[j].x * v[j].x + v[j].y * v[j].y) + (v[j].z * v[j].z + v[j].w * v[j].w); }
            const float rstd = rsqrtf(wave_sum(ss) * (1.0f / DM) + EPS);
            const float* mrow = mod + (size_t)bi * 6144;
#pragma unroll
            for (int j = 0; j < 4; ++j) { const int k = 4 * lane + 256 * j;
                const f32x4 g = *(const f32x4*)(gam + k), s = *(const f32x4*)(mrow + 1024 + k), sh = *(const f32x4*)(mrow + k);
                const f32x4 hv = v[j] * rstd * g * (1.0f + s) + sh; v[j] = hv;
                u32x2 w; w.x = pk2(hv.x, hv.y); w.y = pk2(hv.z, hv.w);
                *(LAS u32x2*)(Himg + (2 * wave + rr) * RST + k * 2) = w; }
            float am = 0.f;
#pragma unroll
            for (int j = 0; j < 4; ++j) am = fmaxf(am, fmaxf(fmaxf(fabsf(v[j].x), fabsf(v[j].y)), fmaxf(fabsf(v[j].z), fabsf(v[j].w))));
            am = wave_max(am); const float qs = am > 0.f ? 127.0f / am : 0.f;
#pragma unroll
            for (int j = 0; j < 4; ++j) *(unsigned*)(H8 + (size_t)r * DM + 4 * lane + 256 * j) = pack_i8x4(v[j].x * qs, v[j].y * qs, v[j].z * qs, v[j].w * qs);
            if (lane == 0) ((float*)(ws + WS_HS))[r] = am * (1.0f / 127.0f);
        }
        __syncthreads();
        f32x4 acc = {0.f, 0.f, 0.f, 0.f};
#pragma unroll
        for (int ks = 0; ks < 4; ++ks) { const int off = (lane & 15) * RST + (128 * wave + 32 * ks + 8 * (lane >> 4)) * 2;
            acc = mfma16(*(const LAS bf16x8*)(Himg + off), *(const LAS bf16x8*)(WgT + off), acc); }
        *(LAS f32x4*)(red + wave * 256 + lane * 4) = acc;
        __syncthreads();
        if (tid < 256) { const int ln = tid & 63, j = tid >> 6; float s = 0.f;
#pragma unroll
            for (int w = 0; w < 8; ++w) s += red[w * 256 + ln * 4 + j];
            const int row = 16 * gi + 4 * (ln >> 4) + j, gate = ln & 15;
            ((float*)(ws + WS_GATES))[(size_t)row * 16 + gate] = s + a.in[12][l * 16 + gate]; }
    }
}

template <int MODE>
__device__ __forceinline__ void phase_norm(const Args& a, int l, LAS unsigned char* lds, int tid, int lane, int wave, int bid, int G) {
    unsigned char* ws = a.ws;
    LAS float* WT = (LAS float*)lds;
    if (MODE == 0) { const float* w = a.in[8] + (size_t)l * DM * DIN + 2048; for (int i = tid; i < 16384; i += NTHR) { const int k = i >> 4, j = i & 15; WT[j * 1024 + k] = w[(size_t)k * DIN + j]; } __syncthreads(); }
    if (MODE == 2) { const float* w = a.in[20]; for (int i = tid; i < 8192; i += NTHR) { const int k = i >> 3, j = i & 7; WT[j * 1024 + k] = w[(size_t)k * 8 + j]; } __syncthreads(); }
    const float* gam = (MODE == 0 ? a.in[4] : a.in[5]) + (size_t)l * DM;
    const float* mod = (const float*)(ws + WS_MOD) + (size_t)l * 9 * 6144;
    const int shoff = MODE == 0 ? 0 : 3072, soff = MODE == 0 ? 1024 : 4096;
    const int nrows = (MODE == 2) ? NLAT : MALL;
    unsigned char* H8 = ws + WS_H;
    int nrec = 0;
    const int rstride = G * NWAVES;
    f32x4 vnext[4];
    { const int r = bid * NWAVES + wave; if (r < nrows) { const bool lat = r < NLAT;
        const float* src = (MODE == 0 && l == 0) ? (lat ? a.in[0] + (size_t)r * DM : a.in[2] + (size_t)(r - NLAT) * DM) : (lat ? a.out + (size_t)r * DM : (const float*)(ws + WS_XC) + (size_t)(r - NLAT) * DM);
#pragma unroll
        for (int j = 0; j < 4; ++j) vnext[j] = *(const f32x4*)(src + 4 * lane + 256 * j); } }
    for (int r = bid * NWAVES + wave; r < nrows; r += rstride) {
        const bool lat = r < NLAT; const int bi = lat ? (r >> 11) : 8;
        f32x4 v[4]; float ss = 0.f;
#pragma unroll
        for (int j = 0; j < 4; ++j) { v[j] = vnext[j]; ss += (v[j].x * v[j].x + v[j].y * v[j].y) + (v[j].z * v[j].z + v[j].w * v[j].w); }
        { const int rn = r + rstride; if (rn < nrows) { const bool latn = rn < NLAT;
            const float* srcn = (MODE == 0 && l == 0) ? (latn ? a.in[0] + (size_t)rn * DM : a.in[2] + (size_t)(rn - NLAT) * DM) : (latn ? a.out + (size_t)rn * DM : (const float*)(ws + WS_XC) + (size_t)(rn - NLAT) * DM);
#pragma unroll
            for (int j = 0; j < 4; ++j) vnext[j] = *(const f32x4*)(srcn + 4 * lane + 256 * j); } }
        const float rstd = rsqrtf(wave_sum(ss) * (1.0f / DM) + EPS);
        const float* mrow = mod + (size_t)bi * 6144;
#pragma unroll
        for (int j = 0; j < 4; ++j) { const int k = 4 * lane + 256 * j;
            const f32x4 g = *(const f32x4*)(gam + k), s = *(const f32x4*)(mrow + soff + k), sh = *(const f32x4*)(mrow + shoff + k);
            v[j] = v[j] * rstd * g * (1.0f + s) + sh; }
        { float am = 0.f;
#pragma unroll
          for (int j = 0; j < 4; ++j) am = fmaxf(am, fmaxf(fmaxf(fabsf(v[j].x), fabsf(v[j].y)), fmaxf(fabsf(v[j].z), fabsf(v[j].w))));
          am = wave_max(am); const float qs = am > 0.f ? 127.0f / am : 0.f;
#pragma unroll
          for (int j = 0; j < 4; ++j) *(unsigned*)(H8 + (size_t)r * DM + 4 * lane + 256 * j) = pack_i8x4(v[j].x * qs, v[j].y * qs, v[j].z * qs, v[j].w * qs);
          if (lane == 0) ((float*)(ws + WS_HS))[r] = am * (1.0f / 127.0f); }
        if (MODE == 0) {
            float p[16];
#pragma unroll
            for (int jg = 0; jg < 16; ++jg) p[jg] = 0.f;
#pragma unroll
            for (int jg = 0; jg < 16; ++jg) {
#pragma unroll
                for (int j = 0; j < 4; ++j) { const f32x4 w = *(const LAS f32x4*)(WT + jg * 1024 + 4 * lane + 256 * j); p[jg] += (v[j].x * w.x + v[j].y * w.y) + (v[j].z * w.z + v[j].w * w.w); }
                if ((jg & 3) == 3) asm volatile("" ::: "memory"); }
            const float tot = reduce16_lanes(p, lane);
            const int gid = ((lane >> 5) & 1) * 8 + ((lane >> 4) & 1) * 4 + ((lane >> 3) & 1) * 2 + ((lane >> 2) & 1);
            if ((lane & 3) == 0) ((float*)(ws + WS_GATES))[(size_t)r * 16 + gid] = tot + a.in[12][l * 16 + gid];
        }
        if (MODE == 2) {
            float p[8];
#pragma unroll
            for (int e = 0; e < 8; ++e) p[e] = 0.f;
#pragma unroll
            for (int e = 0; e < 8; ++e) {
#pragma unroll
                for (int j = 0; j < 4; ++j) { const f32x4 w = *(const LAS f32x4*)(WT + e * 1024 + 4 * lane + 256 * j); p[e] += (v[j].x * w.x + v[j].y * w.y) + (v[j].z * w.z + v[j].w * w.w); }
                if ((e & 3) == 3) asm volatile("" ::: "memory"); }
            const float tot = reduce8_lanes(p, lane);
            int i1 = 0, i2 = 0; float v1 = -3.0e38f, v2 = -3.0e38f;
#pragma unroll
            for (int e = 0; e < 8; ++e) { const float s = lane_bcast(tot, 32 * (e >> 2) + 16 * ((e >> 1) & 1) + 8 * (e & 1));
                if (s > v1) { v2 = v1; i2 = i1; v1 = s; i1 = e; } else if (s > v2) { v2 = s; i2 = e; } }
            const float w2 = 1.0f / (1.0f + __expf(v1 - v2)), w1 = 1.0f - w2;
            if (lane == 0) { LAS int* rec = (LAS int*)(lds + 32768) + nrec * 32 + wave * 4; rec[0] = i1; rec[1] = i2; rec[2] = __float_as_int(w1); rec[3] = __float_as_int(w2); }
            ++nrec;
        }
    }
    if (MODE == 2) {
        __syncthreads();
        if (tid < 8) {
            const int e = tid; const LAS int* rec = (const LAS int*)(lds + 32768); int cnt = 0;
            const int nk = (nrows - bid * NWAVES + G * NWAVES - 1) / (G * NWAVES);
            for (int k = 0; k < nk; ++k) for (int w = 0; w < NWAVES; ++w) { const int r = bid * NWAVES + w + k * G * NWAVES; if (r < nrows) { const LAS int* q = rec + k * 32 + w * 4; cnt += (q[0] == e) + (q[1] == e); } }
            int pos = (int)atomicAdd((unsigned*)(ws + WS_CTL) + CW_MOE + 64 * e, (unsigned)cnt);
            int* LIST = (int*)(ws + WS_LIST) + e * NLAT; int* TOK = (int*)(ws + WS_COMB);
            for (int k = 0; k < nk; ++k) for (int w = 0; w < NWAVES; ++w) { const int r = bid * NWAVES + w + k * G * NWAVES; if (r < nrows) { const LAS int* q = rec + k * 32 + w * 4;
                if (q[0] == e) { LIST[pos] = r; TOK[r * 8 + 0] = e; TOK[r * 8 + 2] = pos; TOK[r * 8 + 4] = q[2]; ++pos; }
                if (q[1] == e) { LIST[pos] = r; TOK[r * 8 + 1] = e; TOK[r * 8 + 3] = pos; TOK[r * 8 + 5] = q[3]; ++pos; } } }
        }
    }
}

__device__ __forceinline__ void phase_post(const Args& a, int l, int lane, int wave, int bid, int G) {
    unsigned char* ws = a.ws;
    bf16_t* P = (bf16_t*)(ws + WS_BIG); bf16_t* MQK = (bf16_t*)(ws + WS_MQK);
    const float* ROPE = (const float*)(ws + WS_ROPE);
    const float* cw = a.in[10] + (size_t)l * 3 * 512; const float* cb = a.in[11] + (size_t)l * 512;
    const float qg = a.in[13][l * 64 + lane], kg = a.in[14][l * 64 + lane];
    for (int r = bid * NWAVES + wave; r < MALL; r += G * NWAVES) {
        const bool lat = r < NLAT; bf16_t* row = P + (size_t)r * NPW;
        int t, tlen; if (lat) { t = r & (SEQ - 1); tlen = SEQ; } else { t = (r - NLAT) & (CTXL - 1); tlen = CTXL; }
        if (lat) { const int gr = t >> 6, gc = t & 63;
#pragma unroll
            for (int blk = 0; blk < 2; ++blk)
#pragma unroll
                for (int ii = 0; ii < 2; ++ii) { const int pid = lane + 64 * ii, head = pid >> 5, half = (pid >> 4) & 1, i = pid & 15, c1 = (blk ? PC_RK : PC_RQ) + head * 64 + half * 32 + i;
                    const int pos = half ? gc : gr; const float cs = ROPE[(pos * 16 + i) * 2], sn = ROPE[(pos * 16 + i) * 2 + 1];
                    const float x1 = bf2f(row[c1]), x2 = bf2f(row[c1 + 16]); const float sc = blk ? 0.125f : 1.0f;
                    row[c1] = (bf16_t)f2bf((x1 * cs - x2 * sn) * sc); row[c1 + 16] = (bf16_t)f2bf((x1 * sn + x2 * cs) * sc); }
        } else {
#pragma unroll
            for (int ii = 0; ii < 4; ++ii) { const int c = PC_RK + lane + 64 * ii; row[c] = (bf16_t)f2bf(bf2f(row[c]) * 0.125f); }
        }
#pragma unroll
        for (int ii = 0; ii < 8; ++ii) { const int c = lane + 64 * ii;
            const float x0 = bf2f(row[PC_MQ + c]);
            const float xm = t > 0 ? bf2f(row[PC_MQ + c - NPW]) : 0.f, xp = t < tlen - 1 ? bf2f(row[PC_MQ + c + NPW]) : 0.f;
            float y = cb[c] + cw[c] * xm + cw[512 + c] * x0 + cw[1024 + c] * xp;
            y = y / (1.0f + __expf(-y)); if (c >= 256) y *= 0.125f;
            MQK[(size_t)r * 512 + c] = (bf16_t)f2bf(y); }
#pragma unroll
        for (int hh = 0; hh < 16; ++hh) { const int c = PC_NQ + hh * 64 + lane; const float v = bf2f(row[c]);
            const float rs = rsqrtf(wave_sum(v * v) * (1.0f / 64.0f) + EPS);
            row[c] = (bf16_t)f2bf(v * rs * (hh < 8 ? qg : kg)); }
    }
}


__device__ __forceinline__ int hl_off(int hl, int c) { return c < 32 ? 32 * hl + c : 128 + 32 * hl + (c - 32); }
__device__ __forceinline__ u32x4 conv8_pack(const bf16_t* P, int row, int ch, bool hasm, bool hasp, const LAS float* CW) {
    const bf16_t* src = P + (size_t)row * NPW + PC_MQ + ch;
    const u32x4 x0 = *(const u32x4*)src; u32x4 xm = {0u, 0u, 0u, 0u}, xp = xm;
    if (hasm) xm = *(const u32x4*)(src - NPW);
    if (hasp) xp = *(const u32x4*)(src + NPW);
    const f32x4 w0a = *(const LAS f32x4*)(CW + ch), w0b = *(const LAS f32x4*)(CW + ch + 4), w1a = *(const LAS f32x4*)(CW + 512 + ch), w1b = *(const LAS f32x4*)(CW + 512 + ch + 4);
    const f32x4 w2a = *(const LAS f32x4*)(CW + 1024 + ch), w2b = *(const LAS f32x4*)(CW + 1024 + ch + 4), ba = *(const LAS f32x4*)(CW + 1536 + ch), bb = *(const LAS f32x4*)(CW + 1536 + ch + 4);
    float y[8];
    y[0] = ba[0] + w0a[0] * bflo(xm.x) + w1a[0] * bflo(x0.x) + w2a[0] * bflo(xp.x); y[1] = ba[1] + w0a[1] * bfhi(xm.x) + w1a[1] * bfhi(x0.x) + w2a[1] * bfhi(xp.x);
    y[2] = ba[2] + w0a[2] * bflo(xm.y) + w1a[2] * bflo(x0.y) + w2a[2] * bflo(xp.y); y[3] = ba[3] + w0a[3] * bfhi(xm.y) + w1a[3] * bfhi(x0.y) + w2a[3] * bfhi(xp.y);
    y[4] = bb[0] + w0b[0] * bflo(xm.z) + w1b[0] * bflo(x0.z) + w2b[0] * bflo(xp.z); y[5] = bb[1] + w0b[1] * bfhi(xm.z) + w1b[1] * bfhi(x0.z) + w2b[1] * bfhi(xp.z);
    y[6] = bb[2] + w0b[2] * bflo(xm.w) + w1b[2] * bflo(x0.w) + w2b[2] * bflo(xp.w); y[7] = bb[3] + w0b[3] * bfhi(xm.w) + w1b[3] * bfhi(x0.w) + w2b[3] * bfhi(xp.w);
    const float sc = ch >= 256 ? 0.125f : 1.0f;
#pragma unroll
    for (int j = 0; j < 8; ++j) y[j] = y[j] / (1.0f + __expf(-y[j])) * sc;
    u32x4 o; o.x = pk2(y[0], y[1]); o.y = pk2(y[2], y[3]); o.z = pk2(y[4], y[5]); o.w = pk2(y[6], y[7]); return o;
}
__device__ __forceinline__ void conv_weights_to_lds(const Args& a, int l, LAS float* CW, int tid) {
    for (int i = tid; i < 2048; i += NTHR) CW[i] = i < 1536 ? a.in[10][(size_t)l * 1536 + i] : a.in[11][(size_t)l * 512 + (i - 1536)];
}
__device__ __forceinline__ int chunk_row0(int b, int dir, int sc) {
    if (dir == 0) return sc < 2 ? NLAT + b * CTXL + 128 * sc : b * SEQ + 128 * (sc - 2);
    return sc < 2 ? NLAT + b * CTXL + 128 * (1 - sc) : b * SEQ + 128 * (17 - sc);
}
constexpr size_t U_BYTES = 80 * 64 * 2;

__device__ __forceinline__ void phase_chunk_sums(const Args& a, int l, LAS unsigned char* lds, int tid, int lane, int wave, int bid, int G) {
    unsigned char* ws = a.ws;
    const bf16_t* P = (const bf16_t*)(ws + WS_BIG);
    const float* GT = (const float*)(ws + WS_GATES);
    LAS unsigned char* Kimg = lds; LAS unsigned char* VFimg = lds + 20480; LAS unsigned char* VBimg = lds + 40960;
    LAS float* wkF = (LAS float*)(lds + 61440); LAS float* wkB = wkF + 128;
    LAS float* CW = (LAS float*)(lds + 62464); conv_weights_to_lds(a, l, CW, tid);
    const int nitems = 2 * NB * 4 * 18;
    for (int it = bid; it < nitems; it += G) {
        const int cc = it % 18; int r_ = it / 18; const int h = r_ & 3; r_ >>= 2; const int b = r_ & 7; const int kind = r_ >> 3;
        const bool isctx = cc >= 16; const int c = isctx ? cc - 16 : cc;
        const int row0 = isctx ? NLAT + b * CTXL + 128 * c : b * SEQ + 128 * c;
        const int scf = isctx ? c : 2 + c, scb = isctx ? 1 - c : 17 - c;
        __syncthreads();
        if (kind == 0) { if (tid < 256) { const int dir = tid >> 7, i = tid & 127; const float lg = logsigmoidf_(a.in[9][(l * 2 + dir) * 4 + h]); (dir ? wkB : wkF)[i] = __expf(lg * (float)(dir == 0 ? 127 - i : i)); } }
        else if (wave < 2) {
            const int dir = wave;
            const float g0i = GT[(size_t)(row0 + lane) * 16 + 4 * dir + h], g1i = GT[(size_t)(row0 + 64 + lane) * 16 + 4 * dir + h];
            const float f0 = logsigmoidf_(GT[(size_t)(row0 + lane) * 16 + 8 + 4 * dir + h]), f1 = logsigmoidf_(GT[(size_t)(row0 + 64 + lane) * 16 + 8 + 4 * dir + h]);
            float s0 = f0, s1 = f1;
#pragma unroll
            for (int o = 1; o < 64; o <<= 1) { const int sl = lane >= o ? lane - o : lane; const float u0 = lane_get(s0, sl), u1 = lane_get(s1, sl); if (lane >= o) { s0 += u0; s1 += u1; } }
            const float t0 = lane_bcast(s0, 63), t1 = lane_bcast(s1, 63), tot = t0 + t1;
            float b0, b1;
            if (dir == 0) { b0 = s0; b1 = t0 + s1; } else { b0 = tot - s0 + f0; b1 = t1 - s1 + f1; }
            const float a0 = g0i - b0, a1 = g1i - b1; const float amax = wave_max(fmaxf(a0, a1));
            float x0 = a0, x1 = a1;
            if (dir == 0) {
#pragma unroll
                for (int o = 1; o < 64; o <<= 1) { const int sl = lane >= o ? lane - o : lane; const float u0 = lane_get(x0, sl), u1 = lane_get(x1, sl); if (lane >= o) { x0 = fmaxf(x0, u0); x1 = fmaxf(x1, u1); } }
                x1 = fmaxf(x1, lane_bcast(x0, 63));
            } else {
#pragma unroll
                for (int o = 1; o < 64; o <<= 1) { const int sl = lane + o < 64 ? lane + o : lane; const float u0 = lane_get(x0, sl), u1 = lane_get(x1, sl); if (lane + o < 64) { x0 = fmaxf(x0, u0); x1 = fmaxf(x1, u1); } }
                x0 = fmaxf(x0, lane_bcast(x1, 0));
            }
            LAS float* wk = dir ? wkB : wkF;
            wk[lane] = __expf(a0 - amax); wk[lane + 64] = __expf(a1 - amax);
            float* ga = (float*)(ws + WS_GARR) + ((size_t)(((b * 4 + h) * 18 + cc) * 2 + dir)) * 384;
            ga[lane] = a0; ga[lane + 64] = a1; ga[128 + lane] = b0; ga[128 + lane + 64] = b1; ga[256 + lane] = x0; ga[256 + lane + 64] = x1;
            if (lane == 0) { float* usc = (float*)(ws + WS_USC) + ((size_t)((b * 4 + h) * 2 + dir) * 18 + (dir ? scb : scf)) * 2; usc[0] = tot; usc[1] = amax; }
        }
        __syncthreads();
        {
            const int r = tid >> 2, c8 = (tid & 3) * 16;
            const bf16_t* vsrc = P + (size_t)(row0 + r) * NPW + (kind == 0 ? PC_RV : PC_MV) + h * 64 + c8;
            u32x4 k0, k1;
            if (kind == 0) { const bf16_t* ksrc = P + (size_t)(row0 + r) * NPW + PC_RK + hl_off(h, c8); k0 = *(const u32x4*)ksrc; k1 = *(const u32x4*)(ksrc + 8); }
            else { const int t = 128 * c + r; const bool hasm = t > 0, hasp = t < (isctx ? CTXL : SEQ) - 1;
                k0 = conv8_pack(P, row0 + r, 256 + h * 64 + c8, hasm, hasp, CW); k1 = conv8_pack(P, row0 + r, 256 + h * 64 + c8 + 8, hasm, hasp, CW);
                bf16_t* mq = (bf16_t*)(ws + WS_MQK) + (size_t)(row0 + r) * 512 + h * 64 + c8;
                *(u32x4*)(mq + 256) = k0; *(u32x4*)(mq + 256 + 8) = k1;
                *(u32x4*)mq = conv8_pack(P, row0 + r, h * 64 + c8, hasm, hasp, CW); *(u32x4*)(mq + 8) = conv8_pack(P, row0 + r, h * 64 + c8 + 8, hasm, hasp, CW); }
            const u32x4 v0 = *(const u32x4*)vsrc, v1 = *(const u32x4*)(vsrc + 8);
            *(LAS u32x4*)(Kimg + r * IST + c8 * 2) = k0; *(LAS u32x4*)(Kimg + r * IST + c8 * 2 + 16) = k1;
#pragma unroll
            for (int dir = 0; dir < 2; ++dir) {
                const float w = (dir ? wkB : wkF)[r]; LAS unsigned char* Vimg = dir ? VBimg : VFimg;
                u32x4 o0, o1;
                o0.x = pk2(bflo(v0.x) * w, bfhi(v0.x) * w); o0.y = pk2(bflo(v0.y) * w, bfhi(v0.y) * w); o0.z = pk2(bflo(v0.z) * w, bfhi(v0.z) * w); o0.w = pk2(bflo(v0.w) * w, bfhi(v0.w) * w);
                o1.x = pk2(bflo(v1.x) * w, bfhi(v1.x) * w); o1.y = pk2(bflo(v1.y) * w, bfhi(v1.y) * w); o1.z = pk2(bflo(v1.z) * w, bfhi(v1.z) * w); o1.w = pk2(bflo(v1.w) * w, bfhi(v1.w) * w);
                *(LAS u32x4*)(Vimg + r * IST + c8 * 2) = o0; *(LAS u32x4*)(Vimg + r * IST + c8 * 2 + 16) = o1;
                if ((tid & 3) == 0) { unsigned zz; asm volatile("v_mov_b32 %0, 0" : "=v"(zz)); u32x4 e0; e0.x = f2bf(w); e0.y = zz; e0.z = zz; e0.w = zz; u32x4 z; z.x = zz; z.y = zz; z.z = zz; z.w = zz;
                    *(LAS u32x4*)(Vimg + r * IST + 128) = e0; *(LAS u32x4*)(Vimg + r * IST + 144) = z; }
            }
        }
        __syncthreads();
        {
            const int dt = wave & 3, dir = wave >> 2; LAS const unsigned char* Vimg = dir ? VBimg : VFimg;
            f32x4 u[5];
#pragma unroll
            for (int et = 0; et < 5; ++et) u[et] = (f32x4){0.f, 0.f, 0.f, 0.f};
#pragma unroll
            for (int ks = 0; ks < 4; ++ks) {
                const bf16x8 af = frag_tr<false>(Kimg, 32 * ks, 16 * dt, lane);
                bf16x8 bx[4]; frag_tr_x4<false>(Vimg, 32 * ks, 0, lane, bx); const bf16x8 b4 = frag_tr<false>(Vimg, 32 * ks, 64, lane);
#pragma unroll
                for (int et = 0; et < 4; ++et) u[et] = mfma16(af, bx[et], u[et]);
                u[4] = mfma16(af, b4, u[4]);
            }
            bf16_t* U = (bf16_t*)(ws + WS_U + ((size_t)(((kind * NB + b) * 4 + h) * 2 + dir) * 18 + (dir ? scb : scf)) * U_BYTES);
            const int g = lane >> 4, e = lane & 15, d0 = 16 * dt + 4 * g;
#pragma unroll
            for (int et = 0; et < 5; ++et) if (et < 4 || kind == 1) { u32x2 w; w.x = pk2(u[et][0], u[et][1]); w.y = pk2(u[et][2], u[et][3]); *(u32x2*)(U + (size_t)(16 * et + e) * 64 + d0) = w; }
        }
    }
}

__device__ __forceinline__ void phase_chunk_states(const Args& a, int l, int tid, int bid, int G) {
    unsigned char* ws = a.ws;
    for (int it = bid; it < 2 * NB * 4 * 2; it += G) {
        const int dir = it & 1, h = (it >> 1) & 3, b = (it >> 3) & 7, kind = it >> 6;
        const size_t seq = (size_t)(((kind * NB + b) * 4 + h) * 2 + dir) * 18;
        const unsigned char* Ub = ws + WS_U + seq * U_BYTES; unsigned char* Sb = ws + WS_S + seq * U_BYTES;
        const float* usc = (const float*)(ws + WS_USC) + (size_t)((b * 4 + h) * 2 + dir) * 18 * 2;
        float* sm = (float*)(ws + WS_SM) + (size_t)((b * 4 + h) * 2 + dir) * 18;
        const float dec_ret = __expf(128.0f * logsigmoidf_(a.in[9][(l * 2 + dir) * 4 + h]));
        float blv[18], amv[18];
#pragma unroll
        for (int s = 0; s < 18; ++s) { blv[s] = kind == 0 ? 0.f : usc[2 * s]; amv[s] = kind == 0 ? 0.f : usc[2 * s + 1]; }
        const int nrow = kind == 0 ? 512 : 520;
        for (int ci = tid; ci < nrow; ci += NTHR) {
            u32x4 v[18];
#pragma unroll
            for (int s = 0; s < 18; ++s) v[s] = *(const u32x4*)(Ub + (size_t)s * U_BYTES + (size_t)ci * 16);
            float acc[8];
#pragma unroll
            for (int j = 0; j < 8; ++j) acc[j] = 0.f;
            float m = 0.f;
#pragma unroll
            for (int s = 0; s < 18; ++s) {
                u32x4 o; o.x = pk2(acc[0], acc[1]); o.y = pk2(acc[2], acc[3]); o.z = pk2(acc[4], acc[5]); o.w = pk2(acc[6], acc[7]);
                *(u32x4*)(Sb + (size_t)s * U_BYTES + (size_t)ci * 16) = o;
                float dk, ck;
                if (kind == 0) { dk = dec_ret; ck = 1.0f; }
                else { if (ci == 0) sm[s] = m; const float bl = blv[s], am = amv[s]; const float mx = fmaxf(m, am); dk = __expf(m - mx); ck = __expf(am - mx); m = bl + mx; }
                acc[0] = dk * acc[0] + ck * bflo(v[s].x); acc[1] = dk * acc[1] + ck * bfhi(v[s].x); acc[2] = dk * acc[2] + ck * bflo(v[s].y); acc[3] = dk * acc[3] + ck * bfhi(v[s].y);
                acc[4] = dk * acc[4] + ck * bflo(v[s].z); acc[5] = dk * acc[5] + ck * bfhi(v[s].z); acc[6] = dk * acc[6] + ck * bflo(v[s].w); acc[7] = dk * acc[7] + ck * bfhi(v[s].w);
            }
        }
    }
}

template <int KIND>
__device__ __forceinline__ float load_state(const unsigned char* ws, int b, int h, int dir, int sc, LAS unsigned char* Simg, int tid) {
    const unsigned char* Sp = ws + WS_S + ((size_t)((((KIND * NB + b) * 4 + h) * 2 + dir) * 18) + sc) * U_BYTES;
    *(LAS u32x4*)(Simg + (tid >> 3) * IST + (tid & 7) * 16) = *(const u32x4*)(Sp + (size_t)tid * 16);
    if (KIND == 1 && tid < 8) *(LAS u32x4*)(Simg + 64 * IST + tid * 16) = *(const u32x4*)(Sp + (size_t)(512 + tid) * 16);
    return KIND == 1 ? ((const float*)(ws + WS_SM))[(size_t)((b * 4 + h) * 2 + dir) * 18 + sc] : 0.f;
}

template <int KIND>
__device__ __forceinline__ void phase_chunk_out(const Args& a, int l, bool need_ctx, LAS unsigned char* lds, int tid, int lane, int wave, int bid, int G) {
    unsigned char* ws = a.ws;
    const bf16_t* P = (const bf16_t*)(ws + WS_BIG);
    const float* GT = (const float*)(ws + WS_GATES); bf16_t* MG = (bf16_t*)(ws + WS_H);
    LAS unsigned char* Qimg = lds; LAS unsigned char* Kimg = lds + 20480; LAS unsigned char* Vimg = lds + 40960;
    LAS unsigned char* SFimg = lds + 61440; LAS unsigned char* SBimg = lds + 74240;
    LAS float* AF = (LAS float*)(lds + 87040); LAS float* CF = AF + 128; LAS float* BF = AF + 256; LAS float* AB = AF + 384; LAS float* CB = AF + 512; LAS float* BB = AF + 640;
    const int nch = need_ctx ? 18 : 16, nitems = NB * 4 * nch;
    const int g = lane >> 4, qi = 16 * wave + (lane & 15);
    for (int it = (bid + G - (KIND == 0 ? 0 : 64) % G) % G; it < nitems; it += G) {
        const int cc = it % nch; const int bh = it / nch; const int h = bh & 3, b = bh >> 2;
        const bool isctx = cc >= 16; const int c = isctx ? cc - 16 : cc;
        const int row0 = isctx ? NLAT + b * CTXL + 128 * c : b * SEQ + 128 * c;
        const int scf = isctx ? c : 2 + c, scb = isctx ? 1 - c : 17 - c;
        __syncthreads();
        {
            const int r = tid >> 2, c8 = (tid & 3) * 16;
            const bf16_t* vsrc = P + (size_t)(row0 + r) * NPW + (KIND == 0 ? PC_RV : PC_MV) + h * 64 + c8;
            u32x4 q0, q1, k0, k1;
            if (KIND == 0) { const bf16_t* qsrc = P + (size_t)(row0 + r) * NPW + PC_RQ + hl_off(h, c8); const bf16_t* ksrc = P + (size_t)(row0 + r) * NPW + PC_RK + hl_off(h, c8);
                q0 = *(const u32x4*)qsrc; q1 = *(const u32x4*)(qsrc + 8); k0 = *(const u32x4*)ksrc; k1 = *(const u32x4*)(ksrc + 8); }
            else { const bf16_t* mq = (const bf16_t*)(ws + WS_MQK) + (size_t)(row0 + r) * 512 + h * 64 + c8;
                q0 = *(const u32x4*)mq; q1 = *(const u32x4*)(mq + 8); k0 = *(const u32x4*)(mq + 256); k1 = *(const u32x4*)(mq + 256 + 8); }
            const u32x4 v0 = *(const u32x4*)vsrc, v1 = *(const u32x4*)(vsrc + 8);
            *(LAS u32x4*)(Qimg + r * IST + c8 * 2) = q0; *(LAS u32x4*)(Qimg + r * IST + c8 * 2 + 16) = q1;
            *(LAS u32x4*)(Kimg + r * IST + c8 * 2) = k0; *(LAS u32x4*)(Kimg + r * IST + c8 * 2 + 16) = k1;
            *(LAS u32x4*)(Vimg + r * IST + c8 * 2) = v0; *(LAS u32x4*)(Vimg + r * IST + c8 * 2 + 16) = v1;
            if ((tid & 3) == 0) { unsigned zz, one; asm volatile("v_mov_b32 %0, 0\n\tv_mov_b32 %1, 0x3f80" : "=v"(zz), "=v"(one)); u32x4 e0; e0.x = one; e0.y = zz; e0.z = zz; e0.w = zz; u32x4 z; z.x = zz; z.y = zz; z.z = zz; z.w = zz;
                *(LAS u32x4*)(Vimg + r * IST + 128) = e0; *(LAS u32x4*)(Vimg + r * IST + 144) = z; }
        }
        const float mpf = load_state<KIND>(ws, b, h, 0, scf, SFimg, tid);
        const float mpb = load_state<KIND>(ws, b, h, 1, scb, SBimg, tid);
        if (KIND == 1) {
            const float* ga = (const float*)(ws + WS_GARR) + (size_t)((b * 4 + h) * 18 + cc) * 768;
            for (int i = tid; i < 768; i += NTHR) { const int dir = i / 384, which = (i - dir * 384) >> 7, j = i & 127; float v = ga[i];
                if (which == 2) v = fmaxf(v, dir ? mpb : mpf);
                AF[dir * 384 + (which == 0 ? 0 : (which == 1 ? 256 : 128)) + j] = v; }
        }
        __syncthreads();
        const bf16x8 bq0 = frag_row(Qimg, 16 * wave, 0, lane), bq1 = frag_row(Qimg, 16 * wave, 32, lane);
        f32x4 st[8];
#pragma unroll
        for (int kt = 0; kt < 8; ++kt) { f32x4 z = {0.f, 0.f, 0.f, 0.f}; z = mfma16(frag_row(Kimg, 16 * kt, 0, lane), bq0, z); st[kt] = mfma16(frag_row(Kimg, 16 * kt, 32, lane), bq1, z); }
        const int row = row0 + qi;
        if (KIND == 0) {
            const float lgf = logsigmoidf_(a.in[9][(l * 2 + 0) * 4 + h]), lgb = logsigmoidf_(a.in[9][(l * 2 + 1) * 4 + h]);
            f32x4 acc[4];
#pragma unroll
            for (int et = 0; et < 4; ++et) {
                f32x4 zf = {0.f, 0.f, 0.f, 0.f}, zb = zf;
                zf = mfma16(frag_row(SFimg, 16 * et, 0, lane), bq0, zf); zf = mfma16(frag_row(SFimg, 16 * et, 32, lane), bq1, zf);
                zb = mfma16(frag_row(SBimg, 16 * et, 0, lane), bq0, zb); zb = mfma16(frag_row(SBimg, 16 * et, 32, lane), bq1, zb);
                acc[et] = zf * __expf(lgf * (float)(qi + 1)) + zb * __expf(lgb * (float)(128 - qi));
            }
#pragma unroll
            for (int T = 0; T < 4; ++T) {
                f32x4 p0, p1;
#pragma unroll
                for (int j = 0; j < 4; ++j) {
                    const int k0 = 32 * T + 4 * g + j, k1 = k0 + 16;
                    const float w0 = (k0 <= qi ? __expf(lgf * (float)(qi - k0)) : 0.f) + (k0 >= qi ? __expf(lgb * (float)(k0 - qi)) : 0.f);
                    const float w1 = (k1 <= qi ? __expf(lgf * (float)(qi - k1)) : 0.f) + (k1 >= qi ? __expf(lgb * (float)(k1 - qi)) : 0.f);
                    p0[j] = st[2 * T][j] * w0; p1[j] = st[2 * T + 1][j] * w1;
                }
                const bf16x8 bp = pack8(p0, p1);
{ bf16x8 va[4]; frag_tr_x4<true>(Vimg, 32 * T, 0, lane, va);
#pragma unroll
                for (int et = 0; et < 4; ++et) acc[et] = mfma16(va[et], bp, acc[et]); }
            }
            float ss = 0.f;
#pragma unroll
            for (int et = 0; et < 4; ++et) ss += (acc[et][0] * acc[et][0] + acc[et][1] * acc[et][1]) + (acc[et][2] * acc[et][2] + acc[et][3] * acc[et][3]);
            ss = sum_g4(ss);
            const float rs = rsqrtf(ss * (1.0f / 64.0f) + EPS);
#pragma unroll
            for (int et = 0; et < 4; ++et) { const int e0 = h * 64 + 16 * et + 4 * g;
                const u32x2 gw = *(const u32x2*)(P + (size_t)row * NPW + PC_RG + e0);
                u32x2 o; o.x = pk2(siluf_(bflo(gw.x)) * acc[et][0] * rs, siluf_(bfhi(gw.x)) * acc[et][1] * rs); o.y = pk2(siluf_(bflo(gw.y)) * acc[et][2] * rs, siluf_(bfhi(gw.y)) * acc[et][3] * rs);
                *(u32x2*)(MG + (size_t)row * DM + e0) = o; }
        } else {
            const float cf = CF[qi], cb = CB[qi];
            const float gf = __expf(mpf - cf), gb = __expf(mpb - cb);
            f32x4 af[5], ab[5];
#pragma unroll
            for (int et = 0; et < 5; ++et) {
                f32x4 zf = {0.f, 0.f, 0.f, 0.f}, zb = zf;
                zf = mfma16(frag_row(SFimg, 16 * et, 0, lane), bq0, zf); zf = mfma16(frag_row(SFimg, 16 * et, 32, lane), bq1, zf);
                zb = mfma16(frag_row(SBimg, 16 * et, 0, lane), bq0, zb); zb = mfma16(frag_row(SBimg, 16 * et, 32, lane), bq1, zb);
                af[et] = zf * gf; ab[et] = zb * gb;
            }
#pragma unroll
            for (int T = 0; T < 4; ++T) {
                const f32x4 a0f = *(const LAS f32x4*)(AF + 32 * T + 4 * g), a1f = *(const LAS f32x4*)(AF + 32 * T + 16 + 4 * g);
                const f32x4 a0b = *(const LAS f32x4*)(AB + 32 * T + 4 * g), a1b = *(const LAS f32x4*)(AB + 32 * T + 16 + 4 * g);
                f32x4 pf0, pf1, pb0, pb1;
#pragma unroll
                for (int j = 0; j < 4; ++j) {
                    const int k0 = 32 * T + 4 * g + j, k1 = k0 + 16;
                    pf0[j] = k0 <= qi ? st[2 * T][j] * __expf(a0f[j] - cf) : 0.f; pf1[j] = k1 <= qi ? st[2 * T + 1][j] * __expf(a1f[j] - cf) : 0.f;
                    pb0[j] = k0 >= qi ? st[2 * T][j] * __expf(a0b[j] - cb) : 0.f; pb1[j] = k1 >= qi ? st[2 * T + 1][j] * __expf(a1b[j] - cb) : 0.f;
                }
                const bf16x8 bpf = pack8(pf0, pf1), bpb = pack8(pb0, pb1);
{ bf16x8 va[4]; frag_tr_x4<true>(Vimg, 32 * T, 0, lane, va); const bf16x8 v4 = frag_tr<true>(Vimg, 32 * T, 64, lane);
#pragma unroll
                for (int et = 0; et < 4; ++et) { af[et] = mfma16(va[et], bpf, af[et]); ab[et] = mfma16(va[et], bpb, ab[et]); }
                af[4] = mfma16(v4, bpf, af[4]); ab[4] = mfma16(v4, bpb, ab[4]); }
            }
            const float denf = lane_get(af[4][0], lane & 15), denb = lane_get(ab[4][0], lane & 15);
            const float nf = 1.0f / fmaxf(fabsf(denf), __expf(-(BF[qi] + cf))), nb = 1.0f / fmaxf(fabsf(denb), __expf(-(BB[qi] + cb)));
            f32x4 y[4]; float ss = 0.f;
#pragma unroll
            for (int et = 0; et < 4; ++et) { y[et] = af[et] * nf + ab[et] * nb; ss += (y[et][0] * y[et][0] + y[et][1] * y[et][1]) + (y[et][2] * y[et][2] + y[et][3] * y[et][3]); }
            ss = sum_g4(ss);
            const float rs = rsqrtf(ss * (1.0f / 64.0f) + EPS);
#pragma unroll
            for (int et = 0; et < 4; ++et) { const int e0 = h * 64 + 16 * et + 4 * g;
                const u32x2 gw = *(const u32x2*)(P + (size_t)row * NPW + PC_MO + e0);
                u32x2 o; o.x = pk2(sigmoidf_(bflo(gw.x)) * y[et][0] * rs, sigmoidf_(bfhi(gw.x)) * y[et][1] * rs); o.y = pk2(sigmoidf_(bflo(gw.y)) * y[et][2] * rs, sigmoidf_(bfhi(gw.y)) * y[et][3] * rs);
                *(u32x2*)(MG + (size_t)row * DM + 256 + e0) = o; }
        }
    }
}

struct NaItem { int b, h, r0, ur0, nlb, lat, qrow0; };
__device__ __forceinline__ NaItem na_decode(int it) {
    NaItem t;
    if (it < 512) { t.lat = 1; const int rg = it & 7; t.h = (it >> 3) & 7; t.b = it >> 6; t.r0 = 4 * rg; t.ur0 = min(max(t.r0 - 4, 0), NROWS - 8);
        const int last = min(max(t.r0 - 1, 0), NROWS - 8) + 7; t.nlb = (last - t.ur0 + 4) >> 2; t.qrow0 = t.b * SEQ + t.r0 * 64; }
    else { const int j = it - 512; t.lat = 0; t.h = j & 7; t.b = j >> 3; t.r0 = 0; t.ur0 = 0; t.nlb = 0; t.qrow0 = NLAT + t.b * CTXL; }
    return t;
}
__device__ __forceinline__ int na_krow0(const NaItem& t, int step) { return step == 0 ? NLAT + t.b * CTXL : t.b * SEQ + (t.ur0 + 4 * (step - 1)) * 64; }
struct NaKV { u32x4 k[4], v[4]; };
__device__ __forceinline__ void na_load_kv(NaKV& x, const bf16_t* P, int krow0, int h, int tid) {
    const int rr = tid >> 1, c0 = (tid & 1) * 32; const bf16_t* ks = P + (size_t)(krow0 + rr) * NPW + PC_NK + 256 * (h >> 2) + hl_off(h & 3, c0); const bf16_t* vs = P + (size_t)(krow0 + rr) * NPW + PC_NV + h * 64 + c0;
#pragma unroll
    for (int i = 0; i < 4; ++i) { x.k[i] = *(const u32x4*)(ks + 8 * i); x.v[i] = *(const u32x4*)(vs + 8 * i); }
}
struct NaQ { u32x4 q[4]; };
__device__ __forceinline__ void na_load_q(NaQ& x, const bf16_t* P, int qrow0, int h, int tid) {
    const bf16_t* qs = P + (size_t)(qrow0 + (tid >> 1)) * NPW + PC_NQ + 256 * (h >> 2) + hl_off(h & 3, (tid & 1) * 32);
#pragma unroll
    for (int i = 0; i < 4; ++i) x.q[i] = *(const u32x4*)(qs + 8 * i);
}
struct NaState { float m, l; f32x4 acc[4]; };
template <int NPAIR, unsigned VALID>
__device__ __forceinline__ void na_update(NaState& st, const f32x4 (&s)[2 * NPAIR], float mx, LAS const unsigned char* Vimg, int vrow0, int lane) {
    mx = max_g4(mx);
    const float m_new = fmaxf(st.m, mx), resc = __builtin_amdgcn_exp2f(st.m - m_new);
    st.m = m_new; st.l *= resc;
#pragma unroll
    for (int et = 0; et < 4; ++et) st.acc[et] = st.acc[et] * resc;
#pragma unroll
    for (int T = 0; T < NPAIR; ++T) {
        if (((VALID >> (2 * T)) & 3u) != 0u) {
            f32x4 p0 = {0.f, 0.f, 0.f, 0.f}, p1 = p0;
            if ((VALID >> (2 * T)) & 1u) {
#pragma unroll
                for (int j = 0; j < 4; ++j) p0[j] = __builtin_amdgcn_exp2f(s[2 * T][j] - m_new);
                st.l += (p0[0] + p0[1]) + (p0[2] + p0[3]); }
            if ((VALID >> (2 * T + 1)) & 1u) {
#pragma unroll
                for (int j = 0; j < 4; ++j) p1[j] = __builtin_amdgcn_exp2f(s[2 * T + 1][j] - m_new);
                st.l += (p1[0] + p1[1]) + (p1[2] + p1[3]); }
            asm volatile("" : "+v"(st.l));
            const bf16x8 bp = pack8(p0, p1);
            bf16x8 va[4]; frag_tr_x4<true>(Vimg, vrow0 + 32 * T, 0, lane, va);
#pragma unroll
            for (int et = 0; et < 4; ++et) st.acc[et] = mfma16(va[et], bp, st.acc[et]);
            __builtin_amdgcn_sched_barrier(0);
        }
    }
}
template <int QTA>
__device__ __forceinline__ void na_local_row(NaState& st, const bf16x8& bq0, const bf16x8& bq1, LAS const unsigned char* Kimg, LAS const unsigned char* Vimg, LAS const float* browb, int irow0, int lane) {
    constexpr int tlo = (16 * QTA - 8 < 0 ? 0 : (16 * QTA - 8 > 48 ? 48 : 16 * QTA - 8)), thi = (16 * QTA + 7 > 48 ? 48 : 16 * QTA + 7) + 15;
    constexpr unsigned VALID = ((15 >= tlo && 0 <= thi) ? 1u : 0u) | ((31 >= tlo && 16 <= thi) ? 2u : 0u) | ((47 >= tlo && 32 <= thi) ? 4u : 0u) | ((63 >= tlo && 48 <= thi) ? 8u : 0u);
    const int g = lane >> 4, ql = 16 * QTA + (lane & 15), scq = min(max(ql - 8, 0), GRIDW - 16);
    f32x4 s[4]; float mx = -1.0e30f;
#pragma unroll
    for (int ct = 0; ct < 4; ++ct) {
        if ((VALID >> ct) & 1u) {
            f32x4 z = {0.f, 0.f, 0.f, 0.f}; z = mfma16(frag_row(Kimg, irow0 + 16 * ct, 0, lane), bq0, z); z = mfma16(frag_row(Kimg, irow0 + 16 * ct, 32, lane), bq1, z);
            const LAS float* brow = browb + (16 * ct + 4 * g - ql + 63); const int t0 = 16 * ct + 4 * g - scq;
#pragma unroll
            for (int j = 0; j < 4; ++j) { const float bv = brow[j]; const float zz = z[j] * 0.18033688f + bv; z[j] = ((unsigned)(t0 + j) < 16u) ? zz : -1.0e30f; }
            s[ct] = z; mx = fmaxf(mx, fmaxf(fmaxf(z[0], z[1]), fmaxf(z[2], z[3]))); asm volatile("" ::: "memory");
        } else s[ct] = (f32x4){-1.0e30f, -1.0e30f, -1.0e30f, -1.0e30f};
    }
    na_update<2, VALID>(st, s, mx, Vimg, irow0, lane);
    __builtin_amdgcn_sched_barrier(0);
}
template <int QTA>
__device__ __forceinline__ void na_local_q(NaState& st, LAS const unsigned char* Qimg, LAS const unsigned char* Kimg, LAS const unsigned char* Vimg, LAS const float* RPB, int qimg_row, int lane, int kkb, int srw, int qrw) {
    const bf16x8 bq0 = frag_row(Qimg, qimg_row, 0, lane), bq1 = frag_row(Qimg, qimg_row, 32, lane);
#pragma unroll
    for (int kkl = 0; kkl < 4; ++kkl) { const int kk = kkb + kkl;
        if (kk >= srw && kk < srw + 8) na_local_row<QTA>(st, bq0, bq1, Kimg, Vimg, RPB + (kk - qrw + 7) * 128, 64 * kkl, lane); }
}
template <int WP>
__device__ __forceinline__ void na_local_step(NaState (&st)[2], LAS const unsigned char* Qimg, LAS const unsigned char* Kimg, LAS const unsigned char* Vimg, LAS const float* RPB, int wave, int lane, int kkb, int srw, int qrw) {
    na_local_q<2 * WP>(st[0], Qimg, Kimg, Vimg, RPB, 32 * wave, lane, kkb, srw, qrw);
    na_local_q<2 * WP + 1>(st[1], Qimg, Kimg, Vimg, RPB, 32 * wave + 16, lane, kkb, srw, qrw);
}
__device__ __forceinline__ void phase_natt_mfma(const Args& a, int l, bool need_ctx, LAS unsigned char* lds, int tid, int lane, int wave, int bid, int G) {
    unsigned char* ws = a.ws;
    const bf16_t* P = (const bf16_t*)(ws + WS_BIG); bf16_t* MG = (bf16_t*)(ws + WS_H);
    LAS unsigned char* Qimg = lds; LAS unsigned char* Kimg = lds + 40960; LAS unsigned char* Vimg = lds + 81920;
    LAS float* RPB = (LAS float*)(lds + 122880);
    const int nitems = 512 + (need_ctx ? NB * 8 : 0);
    const int g = lane >> 4;
    int it = (bid + G - 128 % G) % G; if (it >= nitems) return;
    NaItem cur = na_decode(it);
    NaKV kv; na_load_kv(kv, P, na_krow0(cur, 0), cur.h, tid);
    float rpbreg[4];
#pragma unroll
    for (int k = 0; k < 4; ++k) { const int idx = tid + 512 * k, dr = idx >> 7, dc = (idx & 127) - 48; rpbreg[k] = (idx < 1920 && dc >= 0 && dc <= 30) ? a.in[15][(size_t)(l * 8 + cur.h) * 465 + dr * 31 + dc] * 1.44269504f : 0.f; }
    for (;;) {
        const int itn = it + G; const bool has_next = itn < nitems; NaItem nxt = cur; if (has_next) nxt = na_decode(itn);
        const int nsteps = 1 + cur.nlb;
        const int qrw = cur.r0 + (wave >> 1), srw = min(max(qrw - 4, 0), NROWS - 8);
        NaState st[2];
#pragma unroll
        for (int q2 = 0; q2 < 2; ++q2) { st[q2].m = -1.0e30f; st[q2].l = 0.f;
#pragma unroll
            for (int et = 0; et < 4; ++et) st[q2].acc[et] = (f32x4){0.f, 0.f, 0.f, 0.f}; }
        for (int step = 0; step < nsteps; ++step) {
            int ts = tid; asm volatile("" : "+v"(ts));
            __syncthreads();
            { const int rr = ts >> 1, c0 = (ts & 1) * 32;
#pragma unroll
              for (int i = 0; i < 4; ++i) { *(LAS u32x4*)(Kimg + rr * IST + (c0 + 8 * i) * 2) = kv.k[i]; *(LAS u32x4*)(Vimg + rr * IST + (c0 + 8 * i) * 2) = kv.v[i]; }
              if (step == 0) { NaQ qr_; na_load_q(qr_, P, cur.qrow0, cur.h, ts);
#pragma unroll
                  for (int i = 0; i < 4; ++i) *(LAS u32x4*)(Qimg + rr * IST + (c0 + 8 * i) * 2) = qr_.q[i];
#pragma unroll
                  for (int k = 0; k < 4; ++k) if (ts + 512 * k < 1920) RPB[ts + 512 * k] = rpbreg[k]; } }
            __syncthreads();
            int tq = ts;
            if (step + 1 < nsteps) na_load_kv(kv, P, na_krow0(cur, step + 1), cur.h, tq);
            else if (has_next) { na_load_kv(kv, P, na_krow0(nxt, 0), nxt.h, tq);
#pragma unroll
                for (int k = 0; k < 4; ++k) { const int idx = tq + 512 * k, dr = idx >> 7, dc = (idx & 127) - 48; rpbreg[k] = (idx < 1920 && dc >= 0 && dc <= 30) ? a.in[15][(size_t)(l * 8 + nxt.h) * 465 + dr * 31 + dc] * 1.44269504f : 0.f; } }
            const int ln = ts & 63;
            if (step == 0) {
#pragma unroll
                for (int q2 = 0; q2 < 2; ++q2) {
                    const bf16x8 bq0 = frag_row(Qimg, 32 * wave + 16 * q2, 0, ln), bq1 = frag_row(Qimg, 32 * wave + 16 * q2, 32, ln);
#pragma unroll
                    for (int hf = 0; hf < 2; ++hf) {
                        f32x4 s[8]; float mx = -1.0e30f;
#pragma unroll
                        for (int t8 = 0; t8 < 8; ++t8) { f32x4 z = {0.f, 0.f, 0.f, 0.f}; z = mfma16(frag_row(Kimg, 128 * hf + 16 * t8, 0, ln), bq0, z); z = mfma16(frag_row(Kimg, 128 * hf + 16 * t8, 32, ln), bq1, z);
                            z = z * 0.18033688f; s[t8] = z; mx = fmaxf(mx, fmaxf(fmaxf(z[0], z[1]), fmaxf(z[2], z[3]))); if (t8 & 1) asm volatile("" ::: "memory"); }
                        na_update<4, 0xFFu>(st[q2], s, mx, Vimg, 128 * hf, ln);
                        __builtin_amdgcn_sched_barrier(0);
                    }
                }
            } else {
                const int kkb = cur.ur0 + 4 * (step - 1);
                if (wave & 1) na_local_step<1>(st, Qimg, Kimg, Vimg, RPB, wave, ln, kkb, srw, qrw);
                else          na_local_step<0>(st, Qimg, Kimg, Vimg, RPB, wave, ln, kkb, srw, qrw);
            }
        }
        int lf = lane; asm volatile("" : "+v"(lf)); const int gf = lf >> 4;
#pragma unroll
        for (int q2 = 0; q2 < 2; ++q2) {
            const float inv = 1.0f / sum_g4(st[q2].l);
            const int row = cur.qrow0 + 32 * wave + 16 * q2 + (lf & 15);
#pragma unroll
            for (int et = 0; et < 4; ++et) { u32x2 w; w.x = pk2(st[q2].acc[et][0] * inv, st[q2].acc[et][1] * inv); w.y = pk2(st[q2].acc[et][2] * inv, st[q2].acc[et][3] * inv);
                *(u32x2*)(MG + (size_t)row * DM + 512 + cur.h * 64 + 16 * et + 4 * gf) = w; }
        }
        if (!has_next) break;
        it = itn; cur = nxt;
    }
}

constexpr int MOE_TAB_OFF = 131072;
__device__ __forceinline__ void moe_tab_setup(const unsigned char* ws, LAS unsigned char* lds, int tid) {
    if (tid == 0) { LAS int* tab = (LAS int*)(lds + MOE_TAB_OFF); int p = 0;
        for (int e = 0; e < NEXP; ++e) { const int c = (int)__hip_atomic_load((const unsigned*)(ws + WS_CTL) + CW_MOE + 64 * e, __ATOMIC_RELAXED, __HIP_MEMORY_SCOPE_AGENT); tab[e] = p; tab[16 + e] = c; p += (c + 255) >> 8; }
        tab[8] = p; }
    __syncthreads();
}
namespace pg8 {
struct MoeOrder : StaticOrder {
    const PG8_LAS int* tab; const int* list; size_t bstride;
    __device__ __forceinline__ int expert(int pm) const { int e = 0;
#pragma unroll
        for (int k = 1; k < 8; ++k) e += (pm >= tab[k]) ? 1 : 0;
        return e; }
    const PG8_LAS int* rowtab;
    __device__ __forceinline__ unsigned arow(const Unit& u, int R) const {
        const int Rr = (u.hs > 0 ? HALF : 0) + (u.hs >= 0 ? (R & (HALF - 1)) : R);
        if (!list) return (unsigned)(u.pm * BM + Rr);
        return (unsigned)rowtab[u.idx * BM + Rr]; }
    __device__ __forceinline__ unsigned arow_global(const Unit& u, int Rr) const { const int e = expert(u.pm), idx = (u.pm - tab[e]) * BM + Rr; return idx < tab[16 + e] ? (unsigned)list[e * NLAT + idx] : 0u; }
    __device__ __forceinline__ const char* bbase(const Unit& u) const { return Bt + (size_t)expert(u.pm) * bstride + (size_t)u.pn * BM * K2; }
};
}
constexpr int MOE_ROWTAB_OFF = 131072 + 256, MOE_ROWTAB_UNITS = 15;
__device__ __forceinline__ void moe_rowtab_fill(const pg8::MoeOrder& S, LAS unsigned char* lds, int tid) {
    LAS int* rt = (LAS int*)(lds + MOE_ROWTAB_OFF);
    for (int i = 0; i < MOE_ROWTAB_UNITS; ++i) { pg8::Unit u; if (!S.next(i, u)) break; if (tid < 256) rt[i * 256 + tid] = (int)S.arow_global(u, tid); }
    __syncthreads();
}
__device__ __forceinline__ void phase_moe_combine(const Args& a, LAS unsigned char* lds, int lane, int wave, int bid, int G) {
    unsigned char* ws = a.ws; const LAS int* tab = (const LAS int*)(lds + MOE_TAB_OFF);
    const int* TOK = (const int*)(ws + WS_COMB); const bf16_t* Y = (const bf16_t*)(ws + WS_WTMUP);
    const float* g2 = (const float*)(ws + WS_MOD) + (size_t)9 * 6144 + 5120;
    for (int r0 = bid * NWAVES + wave; r0 < NLAT; r0 += 2 * G * NWAVES) {
        const bf16_t* y1[2]; const bf16_t* y2[2]; float w1[2], w2[2]; bool ok[2];
#pragma unroll
        for (int u = 0; u < 2; ++u) { const int r = r0 + u * G * NWAVES; ok[u] = r < NLAT; const int rr = ok[u] ? r : r0;
            const int e1 = TOK[rr * 8], e2 = TOK[rr * 8 + 1], p1 = TOK[rr * 8 + 2], p2 = TOK[rr * 8 + 3]; w1[u] = __int_as_float(TOK[rr * 8 + 4]); w2[u] = __int_as_float(TOK[rr * 8 + 5]);
            y1[u] = Y + ((size_t)tab[e1] * 256 + p1) * DM; y2[u] = Y + ((size_t)tab[e2] * 256 + p2) * DM; }
#pragma unroll
        for (int u = 0; u < 2; ++u) if (ok[u]) { const int r = r0 + u * G * NWAVES;
            const float* gr = g2 + (size_t)(r >> 11) * 6144; float* o = a.out + (size_t)r * DM;
#pragma unroll
            for (int j = 0; j < 4; ++j) { const int k = 4 * lane + 256 * j;
                const u32x2 a1 = *(const u32x2*)(y1[u] + k), a2 = *(const u32x2*)(y2[u] + k); const f32x4 x = *(const f32x4*)(o + k), gg = *(const f32x4*)(gr + k);
                f32x4 mm; mm.x = w1[u] * bflo(a1.x) + w2[u] * bflo(a2.x); mm.y = w1[u] * bfhi(a1.x) + w2[u] * bfhi(a2.x); mm.z = w1[u] * bflo(a1.y) + w2[u] * bflo(a2.y); mm.w = w1[u] * bfhi(a1.y) + w2[u] * bfhi(a2.y);
                *(f32x4*)(o + k) = x + gg * mm; } }
    }
}
#ifndef DUP_VIRT
#define DUP_VIRT (-1)
#endif
#define PH_REP_OPEN
#define PH_REP_CLOSE
#ifndef DUP_PH
#define DUP_PH (-1)
#endif
#ifndef PH_ONLY
#define PH_ONLY 0
#endif
#ifndef MIX_NAIVE
#define MIX_NAIVE 0
#endif
#ifndef MIX_RET
#define MIX_RET 1
#endif
#ifndef MIX_ML
#define MIX_ML 1
#endif
#ifndef MIX_NA
#define MIX_NA 1
#endif
#ifndef EN_PRO
#define EN_PRO 1
#endif
#ifndef EN_NORM
#define EN_NORM 1
#endif
#ifndef EN_GIN
#define EN_GIN 1
#endif
#ifndef EN_POST
#define EN_POST 1
#endif
#ifndef EN_FCUM
#define EN_FCUM 1
#endif
#ifndef EN_QUAD
#define EN_QUAD 1
#endif
#ifndef EN_NATT
#define EN_NATT 1
#endif
#ifndef EN_MERGE
#define EN_MERGE 1
#endif
#ifndef EN_GOUT
#define EN_GOUT 1
#endif
#ifndef EN_NORM2
#define EN_NORM2 1
#endif
#ifndef EN_GUP
#define EN_GUP 1
#endif
#ifndef EN_GDN
#define EN_GDN 1
#endif

__global__ void __launch_bounds__(NTHR, 2) fwd_kernel(Args a_) {
    extern __shared__ __attribute__((aligned(16))) unsigned char lds_raw[];
    LAS unsigned char* lds = (LAS unsigned char*)lds_raw;
    const int tid0 = threadIdx.x, G = gridDim.x, bid = blockIdx.x; const int wave0 = __builtin_amdgcn_readfirstlane(tid0 >> 6);
    unsigned char* ws0 = a_.ws;
    volatile LAS unsigned* MISC = (volatile LAS unsigned*)(lds + MISC_OFF);
    if (tid0 < 32) MISC[tid0] = 0u;
    __syncthreads();
    const int lo = a_.ph_lo, hi = a_.ph_hi;
    XcdBarrier bar; bar.bar = (unsigned*)(ws0 + WS_CTL) + CW_BAR; bar.x = 0; bar.st = MISC + 8;
    if (hi - lo > 1) bar = xcd_barrier_post((unsigned*)(ws0 + WS_CTL) + CW_BAR, MISC + 8);
    int ph = 0;
#define PH_BEGIN if (ph >= lo && ph < hi) { asm volatile("; PHMARK_BEGIN %0" :: "i"(__LINE__)); int tid; asm volatile("v_mbcnt_lo_u32_b32 %0, -1, 0\n\tv_mbcnt_hi_u32_b32 %0, -1, %0" : "=v"(tid)); tid += wave0 * 64; Args a; { const __attribute__((address_space(4))) Args* ap = (const __attribute__((address_space(4))) Args*)__builtin_amdgcn_kernarg_segment_ptr(); asm volatile("" : "+s"(ap)); a = *(const Args*)ap; } unsigned char* ws = a.ws; (void)ws; PH_REP_OPEN if (PH_ONLY == 0 || PH_ONLY == __LINE__) { const int lane = tid & 63, wave = __builtin_amdgcn_readfirstlane(tid >> 6); (void)lane; (void)wave;
#define PH_END   } PH_REP_CLOSE asm volatile("; PHMARK_END %0" :: "i"(__LINE__)); if (ph + 1 < hi) xcd_barrier(bar); else __syncthreads(); } ++ph;

    PH_BEGIN
#if EN_PRO
 phase_prologue(a, lds, tid, lane, wave, bid, G);
#endif
 PH_END

    for (int l = 0; l < 2; ++l) {
        const bool need_ctx = (l == 0);
#define MODP ((const float*)(ws + WS_MOD) + (size_t)l * 9 * 6144)
        PH_BEGIN
#if EN_NORM
 if (l == 0) quantize_weight_rows(ws, 0, N_QROWS, lane, bid * NWAVES + wave, G * NWAVES);
 phase_norm1(a, l, lds, tid, lane, wave, bid, G);
#endif
 PH_END
        PH_BEGIN
#if EN_GIN
 { pg8::Gemm g{(const bf16_t*)(ws + WS_H), (const bf16_t*)(ws + WS_WTIN) + (size_t)l * NPW * DM, MALL, NPW, DM / 2};
                   pg8::StaticOrder S; S.init(MALL, NPW, G, bid); S.Bt = (const char*)g.Bt; S.K2 = 2 * DM;
                   pg8::EpiProjI8 E{(bf16_t*)(ws + WS_BIG), NPW, (const float*)(ws + WS_ROPE), a.in[13] + l * 64, a.in[14] + l * 64, NLAT / 256, (const float*)(ws + WS_HS), (const unsigned*)(ws + WS_CTL) + CW_COLMAX + l * NPW};
                   pg8::gemm_phase<pg8::EpiProjI8, pg8::StaticOrder, false>(lds, g, S, E, nullptr, tid); }
#endif
 PH_END
        PH_BEGIN
#if MIX_RET || MIX_ML
        phase_chunk_sums(a, l, lds, tid, lane, wave, bid, G);
#endif
        PH_END
        PH_BEGIN phase_chunk_states(a, l, tid, bid, G); PH_END
        PH_BEGIN
#if MIX_RET
        phase_chunk_out<0>(a, l, need_ctx, lds, tid, lane, wave, bid, G);
#endif
#if MIX_ML
        phase_chunk_out<1>(a, l, need_ctx, lds, tid, lane, wave, bid, G);
#endif
#if MIX_NA
        phase_natt_mfma(a, l, need_ctx, lds, tid, lane, wave, bid, G);
#endif
        PH_END
        PH_BEGIN
#if EN_GOUT
 { const int M = need_ctx ? MALL : NLAT;
                   pg8::Gemm g{(const bf16_t*)(ws + WS_H), (const bf16_t*)(ws + WS_WTOUT) + (size_t)l * DM * DM, M, DM, DM};
                   pg8::StaticOrder S; S.init(M, DM, G, bid); S.Bt = (const char*)g.Bt; S.K2 = 2 * DM;
                   pg8::EpiResid E{l == 0 ? a.in[0] : a.out, l == 0 ? a.in[2] : (const float*)(ws + WS_XC), a.out, (float*)(ws + WS_XC), MODP + 2048, nullptr, 0, NLAT / 256};
                   pg8::gemm_phase<pg8::EpiResid, pg8::StaticOrder, false>(lds, g, S, E, nullptr, tid);
                   if (l == 0 && bid >= 64) convert_window(a, lds, lane, wave, G, 0, bid - 64, CVN1); }
#endif
 PH_END
        if (l == 0) { PH_BEGIN
#if EN_NORM2
 phase_norm<1>(a, l, lds, tid, lane, wave, bid, G);
#endif
 PH_END }
        else        { PH_BEGIN
#if EN_NORM2
 phase_norm<2>(a, l, lds, tid, lane, wave, bid, G);
#endif
 PH_END }
        if (l == 0) {
            PH_BEGIN { pg8::Gemm g{(const bf16_t*)(ws + WS_H), (const bf16_t*)(ws + WS_WTUP), MALL, NUP, DM / 2};
                       pg8::StaticOrder S; S.init(MALL, NUP, G, bid); S.Bt = (const char*)g.Bt; S.K2 = 2 * DM;
                       pg8::EpiSwiGLUI8 E{(bf16_t*)(ws + WS_BIG), DFF, (const float*)(ws + WS_HS), (const unsigned*)(ws + WS_CTL) + CW_COLMAX + 2 * NPW, nullptr, nullptr, 0};
                       pg8::gemm_phase<pg8::EpiSwiGLUI8, pg8::StaticOrder, false>(lds, g, S, E, nullptr, tid);
                       if (bid >= 96) convert_window(a, lds, lane, wave, G, CV_BASE2, bid - 96, CVN2); } PH_END
            PH_BEGIN { pg8::Gemm g{(const bf16_t*)(ws + WS_BIG), (const bf16_t*)(ws + WS_WTDN), MALL, DM, DFF};
                       pg8::StaticOrder S; S.init(MALL, DM, G, bid); S.Bt = (const char*)g.Bt; S.K2 = 2 * DFF;
                       pg8::EpiResid E{a.out, (const float*)(ws + WS_XC), a.out, (float*)(ws + WS_XC), MODP + 5120, nullptr, 0, NLAT / 256};
                       pg8::gemm_phase<pg8::EpiResid, pg8::StaticOrder, false>(lds, g, S, E, nullptr, tid);
                       if (bid >= 64) convert_window(a, lds, lane, wave, G, CV_BASE3, bid - 64, CVN3); } PH_END
        } else {
            PH_BEGIN { moe_tab_setup(ws, lds, tid); const LAS int* tab = (const LAS int*)(lds + MOE_TAB_OFF);
                       pg8::Gemm g{(const bf16_t*)(ws + WS_H), (const bf16_t*)(ws + WS_WTMUP), 256 * tab[8], NUP, DM / 2};
                       pg8::MoeOrder S; S.init(256 * tab[8], NUP, G, bid); S.Bt = (const char*)g.Bt; S.K2 = 2 * DM; S.tab = tab; S.list = (const int*)(ws + WS_LIST); S.bstride = (size_t)NUP * DM * 2; S.rowtab = (const LAS int*)(lds + MOE_ROWTAB_OFF); moe_rowtab_fill(S, lds, tid);
                       pg8::EpiSwiGLUI8 E{(bf16_t*)(ws + WS_BIG), DFF, (const float*)(ws + WS_HS), (const unsigned*)(ws + WS_CTL) + CW_COLMAX + 2 * NPW + NUP, tab, (const LAS int*)(lds + MOE_ROWTAB_OFF), NUP};
                       pg8::gemm_phase<pg8::EpiSwiGLUI8, pg8::MoeOrder, false>(lds, g, S, E, nullptr, tid); } PH_END
            PH_BEGIN { moe_tab_setup(ws, lds, tid); const LAS int* tab = (const LAS int*)(lds + MOE_TAB_OFF);
                       pg8::Gemm g{(const bf16_t*)(ws + WS_BIG), (const bf16_t*)(ws + WS_WTMDN), 256 * tab[8], DM, DFF};
                       pg8::MoeOrder S; S.init(256 * tab[8], DM, G, bid); S.Bt = (const char*)g.Bt; S.K2 = 2 * DFF; S.tab = tab; S.list = nullptr; S.rowtab = nullptr; S.bstride = (size_t)DM * DFF * 2;
                       pg8::EpiBf16 E{(bf16_t*)(ws + WS_WTMUP), DM};
                       pg8::gemm_phase<pg8::EpiBf16, pg8::MoeOrder, false>(lds, g, S, E, nullptr, tid); } PH_END
            PH_BEGIN { moe_tab_setup(ws, lds, tid); phase_moe_combine(a, lds, lane, wave, bid, G); } PH_END
        }
    }
#if N_LAUNCH_MODE == 1
    if (lo >= 100) {
        int tid; asm volatile("v_mbcnt_lo_u32_b32 %0, -1, 0\n\tv_mbcnt_hi_u32_b32 %0, -1, %0" : "=v"(tid)); tid += wave0 * 64; const int lane = tid & 63, wave = wave0;
        Args a = a_;
        if (lo == 100) phase_chunk_out<0>(a, 0, true, lds, tid, lane, wave, bid, G);
        if (lo == 101) phase_chunk_out<1>(a, 0, true, lds, tid, lane, wave, bid, G);
        if (lo == 102) phase_natt_mfma(a, 0, true, lds, tid, lane, wave, bid, G);
        if (lo == 103) { unsigned char* ws = a.ws; pg8::Gemm g{(const bf16_t*)(ws + WS_H), (const bf16_t*)(ws + WS_WTIN), MALL, NPW, DM};
                   pg8::StaticOrder S; S.init(MALL, NPW, G, bid); S.Bt = (const char*)g.Bt; S.K2 = 2 * DM; pg8::EpiNull E{(bf16_t*)(ws + WS_BIG), NPW};
                   pg8::gemm_phase<pg8::EpiNull, pg8::StaticOrder, false>(lds, g, S, E, nullptr, tid); }
    }
#endif
#undef PH_BEGIN
#undef PH_END
}
constexpr int N_PHASES = 1 + 2 * 7 + 2 + 3;
#ifndef DBG_MAXPH
#define DBG_MAXPH 1000
#endif

extern "C" void kernel_launch(void* const* d_in, const int* in_sizes, int n_in, void* d_out, int out_size, void* d_ws, size_t ws_size, hipStream_t stream) {
    static int grid = 0;
    if (grid == 0) {
        if (n_in != 24 || out_size != NLAT * DM || ws_size < WS_END) { fprintf(stderr, "kernel_launch: unexpected sizes (n_in %d, out %d, ws %zu < %zu); nothing launched\n", n_in, out_size, ws_size, (size_t)WS_END); grid = -1; return; }
        int dev = 0, cus = 0;
        if (hipGetDevice(&dev) != hipSuccess || hipDeviceGetAttribute(&cus, hipDeviceAttributeMultiprocessorCount, dev) != hipSuccess) { grid = -1; return; }
        if (hipFuncSetAttribute((const void*)fwd_kernel, hipFuncAttributeMaxDynamicSharedMemorySize, LDS_BYTES) != hipSuccess) { fprintf(stderr, "kernel_launch: hipFuncSetAttribute failed\n"); grid = -1; return; }
        int per_cu = 0;
        if (hipOccupancyMaxActiveBlocksPerMultiprocessor(&per_cu, (const void*)fwd_kernel, NTHR, LDS_BYTES) != hipSuccess || per_cu < 1) { fprintf(stderr, "kernel_launch: occupancy query says %d\n", per_cu); }
        (void)hipGetLastError();
        grid = cus;
    }
    if (grid < 0) return;
    (void)hipMemsetAsync((char*)d_ws + WS_CTL, 0, CTL_BYTES, stream);
    Args a{};
    for (int i = 0; i < 24; ++i) a.in[i] = (const float*)d_in[i];
    a.out = (float*)d_out; a.ws = (unsigned char*)d_ws;
#if N_LAUNCH_MODE == 0
    a.ph_lo = 0; a.ph_hi = N_PHASES;
    hipLaunchKernelGGL(fwd_kernel, dim3(grid), dim3(NTHR), LDS_BYTES, stream, a);
#else
    for (int p = 0; p < N_PHASES && p < DBG_MAXPH; ++p) { a.ph_lo = p; a.ph_hi = p + 1; hipLaunchKernelGGL(fwd_kernel, dim3(grid), dim3(NTHR), LDS_BYTES, stream, a);
        if (p == DUP_PH) hipLaunchKernelGGL(fwd_kernel, dim3(grid), dim3(NTHR), LDS_BYTES, stream, a);
        if (p == 5 && DUP_VIRT >= 100) { a.ph_lo = DUP_VIRT; a.ph_hi = DUP_VIRT + 1; hipLaunchKernelGGL(fwd_kernel, dim3(grid), dim3(NTHR), LDS_BYTES, stream, a); } }
#endif
}
```

```cpp
#include <hip/hip_runtime.h>
#include <stdio.h>
#include <stdint.h>

#ifndef N_LAUNCH_MODE
#define N_LAUNCH_MODE 0
#endif

constexpr int NB = 8, SEQ = 2048, DM = 1024, CTXL = 256, HD = 64;
constexpr int NLAT = NB * SEQ, NCTX = NB * CTXL, MALL = NLAT + NCTX;
constexpr int DIN = 3600, NPW = 3584;
constexpr int DFF = 2816, NUP = 2 * DFF, NEXP = 8;
constexpr int GRIDW = 64, NROWS = 32;
constexpr float EPS = 1e-6f;
constexpr int PC_RQ = 0, PC_RK = 256, PC_RV = 512, PC_RG = 768, PC_MQ = 1024, PC_MK = 1280, PC_MV = 1536, PC_MO = 1792, PC_NQ = 2048, PC_NK = 2560, PC_NV = 3072;

constexpr size_t al256(size_t x) { return (x + 255) & ~(size_t)255; }
constexpr size_t WS_CTL = 0, CTL_BYTES = 1u << 20;
constexpr size_t WS_MOD = WS_CTL + CTL_BYTES;
constexpr size_t WS_ROPE = WS_MOD + al256((size_t)2 * 9 * 6144 * 4);
constexpr size_t WS_WTIN = WS_ROPE + al256(64 * 16 * 2 * 4);
constexpr size_t WS_WTOUT = WS_WTIN + (size_t)2 * NPW * DM * 2;
constexpr size_t WS_WTUP = WS_WTOUT + (size_t)2 * DM * DM * 2;
constexpr size_t WS_WTDN = WS_WTUP + (size_t)NUP * DM * 2;
constexpr size_t WS_WTMUP = WS_WTDN + (size_t)DM * DFF * 2;
constexpr size_t WS_WTMDN = WS_WTMUP + (size_t)NEXP * NUP * DM * 2;
constexpr size_t WS_H = WS_WTMDN + (size_t)NEXP * DM * DFF * 2;
constexpr size_t WS_XC = WS_H + (size_t)MALL * DM * 2;
constexpr size_t WS_GATES = WS_XC + (size_t)NCTX * DM * 4;
constexpr size_t WS_COMB = WS_GATES + (size_t)MALL * 16 * 4;
constexpr size_t WS_USC = WS_COMB + (size_t)NLAT * 8 * 4;
constexpr size_t WS_SM = WS_USC + al256((size_t)NB * 4 * 2 * 18 * 2 * 4);
constexpr size_t WS_LIST = WS_SM + al256((size_t)NB * 4 * 2 * 18 * 4);
constexpr size_t WS_BIG = WS_LIST + (size_t)NEXP * NLAT * 4;
constexpr size_t WS_MQK = WS_BIG + (size_t)MALL * NPW * 2;
constexpr size_t WS_U = WS_MQK + (size_t)MALL * 512 * 2;
constexpr size_t WS_S = WS_U + (size_t)2 * NB * 4 * 2 * 18 * 80 * 64 * 2;
constexpr size_t WS_GARR = WS_S + (size_t)2 * NB * 4 * 2 * 18 * 80 * 64 * 2;
constexpr size_t WS_HS = WS_GARR + (size_t)NB * 4 * 18 * 2 * 3 * 128 * 4;
constexpr size_t WS_END0 = WS_HS + al256((size_t)MALL * 4);
constexpr size_t MOE_ROWS = 34816;
constexpr size_t WS_ACTM_END = WS_BIG + MOE_ROWS * DFF * 2;
constexpr size_t WS_END = WS_END0 > WS_ACTM_END ? WS_END0 : WS_ACTM_END;

typedef unsigned short bf16_t;
typedef float f32x4 __attribute__((ext_vector_type(4)));
typedef float f32x2 __attribute__((ext_vector_type(2)));
typedef unsigned u32x4 __attribute__((ext_vector_type(4)));
typedef unsigned u32x2 __attribute__((ext_vector_type(2)));
#define LAS __attribute__((address_space(3)))
#define GAS __attribute__((address_space(1)))

__device__ __forceinline__ float bf2f(bf16_t b) { return __uint_as_float(((unsigned)b) << 16); }
__device__ __forceinline__ unsigned f2bf(float f) { unsigned u = __float_as_uint(f); return (u + 0x7fffu + ((u >> 16) & 1u)) >> 16; }
typedef __bf16 bf16x2_t __attribute__((ext_vector_type(2)));
__device__ __forceinline__ unsigned pk2(float lo, float hi) { f32x2 v = {lo, hi}; bf16x2_t b = __builtin_convertvector(v, bf16x2_t); return __builtin_bit_cast(unsigned, b); }
__device__ __forceinline__ float bflo(unsigned w) { return __uint_as_float(w << 16); }
__device__ __forceinline__ float bfhi(unsigned w) { return __uint_as_float(w & 0xffff0000u); }
__device__ __forceinline__ float sigmoidf_(float x) { return 1.0f / (1.0f + __expf(-x)); }
__device__ __forceinline__ float siluf_(float x) { return x / (1.0f + __expf(-x)); }
__device__ __forceinline__ float logsigmoidf_(float x) { return fminf(x, 0.f) - log1pf(__expf(-fabsf(x))); }
template <int O> __device__ __forceinline__ float swz_xor(float v) { return __int_as_float(__builtin_amdgcn_ds_swizzle(__float_as_int(v), (O << 10) | 0x1f)); }
__device__ __forceinline__ float red32_sum(float v) { const auto r = __builtin_amdgcn_permlane32_swap(__float_as_uint(v), __float_as_uint(v), false, false); return __uint_as_float(r[0]) + __uint_as_float(r[1]); }
__device__ __forceinline__ float red32_max(float v) { const auto r = __builtin_amdgcn_permlane32_swap(__float_as_uint(v), __float_as_uint(v), false, false); return fmaxf(__uint_as_float(r[0]), __uint_as_float(r[1])); }
__device__ __forceinline__ float wave_sum(float v) { v += swz_xor<1>(v); v += swz_xor<2>(v); v += swz_xor<4>(v); v += swz_xor<8>(v); v += swz_xor<16>(v); return red32_sum(v); }
__device__ __forceinline__ float wave_max(float v) { v = fmaxf(v, swz_xor<1>(v)); v = fmaxf(v, swz_xor<2>(v)); v = fmaxf(v, swz_xor<4>(v)); v = fmaxf(v, swz_xor<8>(v)); v = fmaxf(v, swz_xor<16>(v)); return red32_max(v); }
__device__ __forceinline__ float sum_g4(float v) { v += swz_xor<16>(v); return red32_sum(v); }
__device__ __forceinline__ float max_g4(float v) { v = fmaxf(v, swz_xor<16>(v)); return red32_max(v); }
__device__ __forceinline__ float reduce16_lanes(const float (&p)[16], int lane) {
    float q[8], r[4], s[2];
#pragma unroll
    for (int j = 0; j < 8; ++j) { const auto x = __builtin_amdgcn_permlane32_swap(__float_as_uint(p[j]), __float_as_uint(p[j + 8]), false, false); q[j] = __uint_as_float(x[0]) + __uint_as_float(x[1]); }
    const bool b4 = (lane & 16) != 0, b3 = (lane & 8) != 0, b2 = (lane & 4) != 0;
#pragma unroll
    for (int j = 0; j < 4; ++j) { const float keep = b4 ? q[j + 4] : q[j], send = b4 ? q[j] : q[j + 4]; r[j] = keep + swz_xor<16>(send); }
#pragma unroll
    for (int j = 0; j < 2; ++j) { const float keep = b3 ? r[j + 2] : r[j], send = b3 ? r[j] : r[j + 2]; s[j] = keep + swz_xor<8>(send); }
    float v; { const float keep = b2 ? s[1] : s[0], send = b2 ? s[0] : s[1]; v = keep + swz_xor<4>(send); }
    v += swz_xor<2>(v); v += swz_xor<1>(v);
    return v;
}
__device__ __forceinline__ float reduce8_lanes(const float (&p)[8], int lane) {
    float q[4], r[2];
#pragma unroll
    for (int j = 0; j < 4; ++j) { const auto x = __builtin_amdgcn_permlane32_swap(__float_as_uint(p[j]), __float_as_uint(p[j + 4]), false, false); q[j] = __uint_as_float(x[0]) + __uint_as_float(x[1]); }
    const bool b4 = (lane & 16) != 0, b3 = (lane & 8) != 0;
#pragma unroll
    for (int j = 0; j < 2; ++j) { const float keep = b4 ? q[j + 2] : q[j], send = b4 ? q[j] : q[j + 2]; r[j] = keep + swz_xor<16>(send); }
    float v; { const float keep = b3 ? r[1] : r[0], send = b3 ? r[0] : r[1]; v = keep + swz_xor<8>(send); }
    v += swz_xor<4>(v); v += swz_xor<2>(v); v += swz_xor<1>(v);
    return v;
}
__device__ __forceinline__ float lane_get(float v, int src_lane) { return __int_as_float(__builtin_amdgcn_ds_bpermute(src_lane << 2, __float_as_int(v))); }
__device__ __forceinline__ float lane_bcast(float v, int k) { return __int_as_float(__builtin_amdgcn_readlane(__float_as_int(v), k)); }

struct Args {
    const float* in[24];
    float* out;
    unsigned char* ws;
    int ph_lo, ph_hi;
};
namespace pg8 {
#define PG8_LAS __attribute__((address_space(3)))
typedef unsigned short bf16_t;
typedef short bf16x8 __attribute__((ext_vector_type(8)));
typedef float f32x4 __attribute__((ext_vector_type(4)));
typedef unsigned u32x4 __attribute__((ext_vector_type(4)));
constexpr int BM = 256, BK = 64, HALF = 128, HTB = HALF * BK * 2  , STAGE_BYTES = 8 * HTB, NXCD = 8, WGM = 8;

__host__ __device__ __forceinline__ int lds_byte(int r, int c) { const int st = (r >> 4) * 2 + (c >> 5), rr = r & 15, cc = c & 31, ob = rr * 64 + cc * 2; return st * 1024 + (ob ^ (((ob >> 9) & 1) << 5)); }
__host__ __device__ __forceinline__ void stage_rc(int b, int& R, int& C) { const int st = b / 1024, sb = b % 1024, swz = sb ^ (((sb >> 9) & 1) << 5); R = (st >> 1) * 16 + swz / 64; C = (st & 1) * 32 + (swz % 64) / 2; }
__host__ __device__ __forceinline__ int perm32(int rho) { const int n = rho >> 4, i = rho & 15; return 8 * (i >> 2) + 4 * n + (i & 3); }

struct Unit { int pm, pn, hs, idx; };
struct Gemm { const bf16_t* A; const bf16_t* Bt; int M, N, K; };

struct StaticOrder {
    int nM, nN, nwg, G, c;
    __host__ __device__ void init(int M, int N, int G_, int c_) { nM = M / BM; nN = N / BM; nwg = nM * nN; G = G_; c = c_; }
    __host__ __device__ bool next(int i, Unit& u) const {
        const int nfr = nwg / G, left = nwg - nfr * G; int wgid; u.hs = -1; u.idx = i;
        if (i < nfr) wgid = i * G + c;
        else if (i == nfr && left > 0) { if (2 * left <= G) { if (c >= 2 * left) return false; wgid = nfr * G + (c >> 1); u.hs = c & 1; } else { if (c >= left) return false; wgid = nfr * G + c; } }
        else return false; { const int q = nwg / NXCD, r = nwg % NXCD, xcd = wgid % NXCD, off = wgid / NXCD; wgid = (xcd < r ? xcd * (q + 1) : r * (q + 1) + (xcd - r) * q) + off; }
        const int nig = WGM * nN, gid = wgid / nig, fm = gid * WGM, gsz = (nM - fm) < WGM ? (nM - fm) : WGM;
        u.pm = fm + ((wgid % nig) % gsz); u.pn = (wgid % nig) / gsz; return true;
    }
    __device__ __forceinline__ void a_ready(const Unit&) const {}
    __device__ __forceinline__ void done(const Unit&) const {}
    __device__ __forceinline__ int idle_class() const { const int nfr = nwg / G, left = nwg - nfr * G; if (left == 0) return 3; if (2 * left <= G) return c < 2 * left ? 0 : 1; return c < left ? 0 : 2; }
    const char* Bt; int K2;
    __device__ __forceinline__ unsigned arow(const Unit& u, int R) const { return (unsigned)(u.pm * BM + (u.hs > 0 ? HALF : 0) + (u.hs >= 0 ? (R & (HALF - 1)) : R)); }
    __device__ __forceinline__ const char* bbase(const Unit& u) const { return Bt + (size_t)u.pn * BM * K2; }
};
__device__ __forceinline__ unsigned cvt_pk_bf16(float lo, float hi) { return ::pk2(lo, hi); }
typedef float f32x2 __attribute__((ext_vector_type(2)));
typedef int i32x4 __attribute__((ext_vector_type(4)));
template <bool I8> struct AccSel { typedef f32x4 T; static __device__ __forceinline__ T zero() { return (f32x4){0.f, 0.f, 0.f, 0.f}; } };
template <> struct AccSel<true> { typedef i32x4 T; static __device__ __forceinline__ T zero() { return (i32x4){0, 0, 0, 0}; } };
template <bool I8> __device__ __forceinline__ typename AccSel<I8>::T mma_op(bf16x8 a, bf16x8 b, typename AccSel<I8>::T c);
template <> __device__ __forceinline__ f32x4 mma_op<false>(bf16x8 a, bf16x8 b, f32x4 c) { return __builtin_amdgcn_mfma_f32_16x16x32_bf16(a, b, c, 0, 0, 0); }
template <> __device__ __forceinline__ i32x4 mma_op<true>(bf16x8 a, bf16x8 b, i32x4 c) { return __builtin_amdgcn_mfma_i32_16x16x64_i8(__builtin_bit_cast(i32x4, a), __builtin_bit_cast(i32x4, b), c, 0, 0, 0); }
struct EpiBf16 {
    static constexpr bool PERM = true, AFTER_DRAIN = false, I8 = false;
    bf16_t* O; int ldc;
    __device__ __forceinline__ void operator()(const f32x4 (&acc)[2][2][4][2], const Unit& u, int wr, int wc, int fr, int fq) const {
        const int row0 = u.pm * BM + (u.hs > 0 ? HALF : 0) + wr * 64 + fr, col0 = u.pn * BM + wc * 32 + 8 * fq; const int nai = u.hs >= 0 ? 1 : 2;
#pragma unroll
        for (int ai = 0; ai < 2; ++ai) if (ai < nai)
#pragma unroll
            for (int m = 0; m < 4; ++m) { bf16_t* rowp = O + (size_t)(row0 + ai * HALF + m * 16) * ldc + col0;
#pragma unroll
                for (int bj = 0; bj < 2; ++bj) { const f32x4 v0 = acc[ai][bj][m][0], v1 = acc[ai][bj][m][1];
                    u32x4 w; w.x = cvt_pk_bf16(v0[0], v0[1]); w.y = cvt_pk_bf16(v0[2], v0[3]); w.z = cvt_pk_bf16(v1[0], v1[1]); w.w = cvt_pk_bf16(v1[2], v1[3]);
                    *(u32x4*)(rowp + bj * HALF) = w; } }
    }
};
struct EpiSwiGLU {
    static constexpr bool PERM = true, AFTER_DRAIN = false, I8 = false;
    bf16_t* O; int ldc;
    __device__ __forceinline__ void operator()(const f32x4 (&acc)[2][2][4][2], const Unit& u, int wr, int wc, int fr, int fq) const {
        const int row0 = u.pm * BM + (u.hs > 0 ? HALF : 0) + wr * 64 + fr, col0 = u.pn * HALF + wc * 32 + 8 * fq; const int nai = u.hs >= 0 ? 1 : 2;
#pragma unroll
        for (int ai = 0; ai < 2; ++ai) if (ai < nai)
#pragma unroll
            for (int m = 0; m < 4; ++m) { bf16_t* rowp = O + (size_t)(row0 + ai * HALF + m * 16) * ldc + col0;
                float r[8];
#pragma unroll
                for (int n = 0; n < 2; ++n)
#pragma unroll
                    for (int j = 0; j < 4; ++j) { const float g = acc[ai][0][m][n][j], uu = acc[ai][1][m][n][j]; r[n * 4 + j] = g / (1.0f + __expf(-g)) * uu; }
                u32x4 w; w.x = cvt_pk_bf16(r[0], r[1]); w.y = cvt_pk_bf16(r[2], r[3]); w.z = cvt_pk_bf16(r[4], r[5]); w.w = cvt_pk_bf16(r[6], r[7]);
                *(u32x4*)rowp = w; }
    }
};
struct EpiResid {
    static constexpr bool PERM = false, AFTER_DRAIN = false, I8 = false;
    const float* base_lat; const float* base_ctx; float* out_lat; float* out_ctx; const float* gate; const float* comb; int comb_ld; int nlat_tiles;
    __device__ __forceinline__ void operator()(const f32x4 (&acc)[2][2][4][2], const Unit& u, int wr, int wc, int fr, int fq) const {
        const bool isctx = u.pm >= nlat_tiles;
        const int rloc0 = (isctx ? (u.pm - nlat_tiles) : u.pm) * BM + (u.hs > 0 ? HALF : 0) + wr * 64 + fr, col0 = u.pn * BM + wc * 32 + 4 * fq; const int nai = u.hs >= 0 ? 1 : 2;
        const float* bp = isctx ? base_ctx : base_lat; float* op = isctx ? out_ctx : out_lat;
        const float* gp = gate + (size_t)(isctx ? 8 : (u.pm >> 3)) * 6144 + col0;
        f32x4 gv[2][2];
#pragma unroll
        for (int bj = 0; bj < 2; ++bj)
#pragma unroll
            for (int n = 0; n < 2; ++n) gv[bj][n] = *(const f32x4*)(gp + bj * HALF + n * 16);
#pragma unroll
        for (int ai = 0; ai < 2; ++ai) if (ai < nai)
#pragma unroll
            for (int m = 0; m < 4; ++m) { const int rl = rloc0 + ai * HALF + m * 16; const size_t off = (size_t)rl * 1024 + col0;
                const float cs = comb ? comb[(size_t)rl * comb_ld] : 1.0f;
#pragma unroll
                for (int bj = 0; bj < 2; ++bj)
#pragma unroll
                    for (int n = 0; n < 2; ++n) { const f32x4 bs = *(const f32x4*)(bp + off + bj * HALF + n * 16);
                        *(f32x4*)(op + off + bj * HALF + n * 16) = bs + gv[bj][n] * acc[ai][bj][m][n] * cs; } }
    }
};

struct EpiNull {
    static constexpr bool PERM = true, AFTER_DRAIN = false, I8 = false;
    bf16_t* O; int ldc;
    __device__ __forceinline__ void operator()(const f32x4 (&acc)[2][2][4][2], const Unit& u, int wr, int wc, int fr, int fq) const {
        float s = 0.f;
#pragma unroll
        for (int ai = 0; ai < 2; ++ai)
#pragma unroll
            for (int bj = 0; bj < 2; ++bj)
#pragma unroll
                for (int m = 0; m < 4; ++m)
#pragma unroll
                    for (int n = 0; n < 2; ++n) s += acc[ai][bj][m][n][0] + acc[ai][bj][m][n][1] + acc[ai][bj][m][n][2] + acc[ai][bj][m][n][3];
        if (s == 12345.678f) O[0] = (bf16_t)1;
    }
};

struct EpiProj {
    static constexpr bool PERM = true, AFTER_DRAIN = false, I8 = false;
    bf16_t* O; int ldc; const float* rope; const float* qgain; const float* kgain; int nlat_tiles;
    __device__ __forceinline__ void operator()(const f32x4 (&acc)[2][2][4][2], const Unit& u, int wr, int wc, int fr, int fq) const {
        const int row0 = u.pm * BM + (u.hs > 0 ? HALF : 0) + wr * 64 + fr, col0 = u.pn * BM + wc * 32 + 8 * fq; const int nai = u.hs >= 0 ? 1 : 2;
        const int pn = u.pn; const bool lat = u.pm < nlat_tiles;
        const bool isrope = pn < 2 && lat, isnorm = pn >= 8 && pn < 12; const float sc = (pn == 1) ? 0.125f : 1.0f;
        const float* gp = (pn < 10 ? qgain : kgain) + 32 * (fq >> 1) + 8 * (fq & 1);
#pragma unroll
        for (int ai = 0; ai < 2; ++ai) if (ai < nai)
#pragma unroll
            for (int m = 0; m < 4; ++m) { const int row = row0 + ai * HALF + m * 16; bf16_t* rowp = O + (size_t)row * ldc + col0;
                f32x4 x1[2] = {acc[ai][0][m][0], acc[ai][0][m][1]}, x2[2] = {acc[ai][1][m][0], acc[ai][1][m][1]};
                if (isrope) { const int t = row & (SEQ - 1); const int pos = (fq >> 1) ? (t & 63) : (t >> 6); const float* rp = rope + (size_t)(pos * 16 + 8 * (fq & 1)) * 2;
#pragma unroll
                    for (int n = 0; n < 2; ++n) { const f32x4 cs0 = *(const f32x4*)(rp + 8 * n), cs1 = *(const f32x4*)(rp + 8 * n + 4);
                        const f32x4 a1 = x1[n], a2 = x2[n];
                        x1[n] = (f32x4){a1[0] * cs0[0] - a2[0] * cs0[1], a1[1] * cs0[2] - a2[1] * cs0[3], a1[2] * cs1[0] - a2[2] * cs1[1], a1[3] * cs1[2] - a2[3] * cs1[3]};
                        x2[n] = (f32x4){a1[0] * cs0[1] + a2[0] * cs0[0], a1[1] * cs0[3] + a2[1] * cs0[2], a1[2] * cs1[1] + a2[2] * cs1[0], a1[3] * cs1[3] + a2[3] * cs1[2]}; } }
                if (isnorm) { float ss = 0.f;
#pragma unroll
                    for (int n = 0; n < 2; ++n) ss += (x1[n][0] * x1[n][0] + x1[n][1] * x1[n][1]) + (x1[n][2] * x1[n][2] + x1[n][3] * x1[n][3]) + (x2[n][0] * x2[n][0] + x2[n][1] * x2[n][1]) + (x2[n][2] * x2[n][2] + x2[n][3] * x2[n][3]);
                    ss = ::sum_g4(ss); const float rs = rsqrtf(ss * (1.0f / 64.0f) + 1e-6f);
#pragma unroll
                    for (int n = 0; n < 2; ++n) { x1[n] = x1[n] * rs * *(const f32x4*)(gp + 4 * n); x2[n] = x2[n] * rs * *(const f32x4*)(gp + 16 + 4 * n); } }
                u32x4 w1, w2;
                w1.x = cvt_pk_bf16(x1[0][0] * sc, x1[0][1] * sc); w1.y = cvt_pk_bf16(x1[0][2] * sc, x1[0][3] * sc); w1.z = cvt_pk_bf16(x1[1][0] * sc, x1[1][1] * sc); w1.w = cvt_pk_bf16(x1[1][2] * sc, x1[1][3] * sc);
                w2.x = cvt_pk_bf16(x2[0][0] * sc, x2[0][1] * sc); w2.y = cvt_pk_bf16(x2[0][2] * sc, x2[0][3] * sc); w2.z = cvt_pk_bf16(x2[1][0] * sc, x2[1][1] * sc); w2.w = cvt_pk_bf16(x2[1][2] * sc, x2[1][3] * sc);
                *(u32x4*)rowp = w1; *(u32x4*)(rowp + HALF) = w2;
                asm volatile("" ::: "memory"); }
    }
};

struct EpiSwiGLUI8 {
    static constexpr bool PERM = true, AFTER_DRAIN = false, I8 = true;
    bf16_t* O; int ldc; const float* sa; const unsigned* colmax; const PG8_LAS int* tab; const PG8_LAS int* rowtab; int ncol_e;
    __device__ __forceinline__ void operator()(const i32x4 (&acc)[2][2][4][2], const Unit& u, int wr, int wc, int fr, int fq) const {
        const int rt0 = (u.hs > 0 ? HALF : 0) + wr * 64 + fr, row0 = u.pm * BM + rt0, col0 = u.pn * HALF + wc * 32 + 8 * fq; const int nai = u.hs >= 0 ? 1 : 2;
        int e = 0; if (tab) {
#pragma unroll
            for (int k = 1; k < 8; ++k) e += (u.pm >= tab[k]) ? 1 : 0; }
        const unsigned* cm = colmax + (size_t)e * ncol_e + u.pn * BM + wc * 32 + 8 * fq;
        float sg[8], su[8];
#pragma unroll
        for (int i = 0; i < 8; ++i) { sg[i] = __uint_as_float(cm[i]) * (1.0f / 127.0f); su[i] = __uint_as_float(cm[HALF + i]) * (1.0f / 127.0f); }
#pragma unroll
        for (int ai = 0; ai < 2; ++ai) if (ai < nai)
#pragma unroll
            for (int m = 0; m < 4; ++m) { const int rt = rt0 + ai * HALF + m * 16; bf16_t* rowp = O + (size_t)(u.pm * BM + rt) * ldc + col0;
                int arow = u.pm * BM + rt;
                if (tab) arow = rowtab[u.idx * BM + rt];
                const float s_a = sa[arow];
                float r[8];
#pragma unroll
                for (int n = 0; n < 2; ++n)
#pragma unroll
                    for (int j = 0; j < 4; ++j) { const float g = (float)acc[ai][0][m][n][j] * (s_a * sg[n * 4 + j]), uu = (float)acc[ai][1][m][n][j] * (s_a * su[n * 4 + j]); r[n * 4 + j] = g / (1.0f + __expf(-g)) * uu; }
                u32x4 w; w.x = cvt_pk_bf16(r[0], r[1]); w.y = cvt_pk_bf16(r[2], r[3]); w.z = cvt_pk_bf16(r[4], r[5]); w.w = cvt_pk_bf16(r[6], r[7]);
                *(u32x4*)rowp = w; }
        (void)row0;
    }
};
struct EpiProjI8 {
    static constexpr bool PERM = true, AFTER_DRAIN = false, I8 = true;
    bf16_t* O; int ldc; const float* rope; const float* qgain; const float* kgain; int nlat_tiles; const float* sa; const unsigned* colmax;
    __device__ __forceinline__ void operator()(const i32x4 (&acc)[2][2][4][2], const Unit& u, int wr, int wc, int fr, int fq) const {
        const int row0 = u.pm * BM + (u.hs > 0 ? HALF : 0) + wr * 64 + fr, col0 = u.pn * BM + wc * 32 + 8 * fq; const int nai = u.hs >= 0 ? 1 : 2;
        const int pn = u.pn; const bool lat = u.pm < nlat_tiles;
        const bool isrope = pn < 2 && lat, isnorm = pn >= 8 && pn < 12; const float sc = (pn == 1) ? 0.125f : 1.0f;
        const float* gp = (pn < 10 ? qgain : kgain) + 32 * (fq >> 1) + 8 * (fq & 1);
        const unsigned* cm = colmax + col0;
#pragma unroll
        for (int ai = 0; ai < 2; ++ai) if (ai < nai)
#pragma unroll
            for (int m = 0; m < 4; ++m) { const int row = row0 + ai * HALF + m * 16; bf16_t* rowp = O + (size_t)row * ldc + col0;
                const float s_a = sa[row] * (1.0f / 127.0f);
                f32x4 x1[2], x2[2];
#pragma unroll
                for (int n = 0; n < 2; ++n)
#pragma unroll
                    for (int j = 0; j < 4; ++j) { x1[n][j] = (float)acc[ai][0][m][n][j] * (s_a * __uint_as_float(cm[4 * n + j])); x2[n][j] = (float)acc[ai][1][m][n][j] * (s_a * __uint_as_float(cm[HALF + 4 * n + j])); }
                if (isrope) { const int t = row & (SEQ - 1); const int pos = (fq >> 1) ? (t & 63) : (t >> 6); const float* rp = rope + (size_t)(pos * 16 + 8 * (fq & 1)) * 2;
#pragma unroll
                    for (int n = 0; n < 2; ++n) { const f32x4 cs0 = *(const f32x4*)(rp + 8 * n), cs1 = *(const f32x4*)(rp + 8 * n + 4);
                        const f32x4 a1 = x1[n], a2 = x2[n];
                        x1[n] = (f32x4){a1[0] * cs0[0] - a2[0] * cs0[1], a1[1] * cs0[2] - a2[1] * cs0[3], a1[2] * cs1[0] - a2[2] * cs1[1], a1[3] * cs1[2] - a2[3] * cs1[3]};
                        x2[n] = (f32x4){a1[0] * cs0[1] + a2[0] * cs0[0], a1[1] * cs0[3] + a2[1] * cs0[2], a1[2] * cs1[1] + a2[2] * cs1[0], a1[3] * cs1[3] + a2[3] * cs1[2]}; } }
                if (isnorm) { float ss = 0.f;
#pragma unroll
                    for (int n = 0; n < 2; ++n) ss += (x1[n][0] * x1[n][0] + x1[n][1] * x1[n][1]) + (x1[n][2] * x1[n][2] + x1[n][3] * x1[n][3]) + (x2[n][0] * x2[n][0] + x2[n][1] * x2[n][1]) + (x2[n][2] * x2[n][2] + x2[n][3] * x2[n][3]);
                    ss = ::sum_g4(ss); const float rs = rsqrtf(ss * (1.0f / 64.0f) + 1e-6f);
#pragma unroll
                    for (int n = 0; n < 2; ++n) { x1[n] = x1[n] * rs * *(const f32x4*)(gp + 4 * n); x2[n] = x2[n] * rs * *(const f32x4*)(gp + 16 + 4 * n); } }
                u32x4 w1, w2;
                w1.x = cvt_pk_bf16(x1[0][0] * sc, x1[0][1] * sc); w1.y = cvt_pk_bf16(x1[0][2] * sc, x1[0][3] * sc); w1.z = cvt_pk_bf16(x1[1][0] * sc, x1[1][1] * sc); w1.w = cvt_pk_bf16(x1[1][2] * sc, x1[1][3] * sc);
                w2.x = cvt_pk_bf16(x2[0][0] * sc, x2[0][1] * sc); w2.y = cvt_pk_bf16(x2[0][2] * sc, x2[0][3] * sc); w2.z = cvt_pk_bf16(x2[1][0] * sc, x2[1][1] * sc); w2.w = cvt_pk_bf16(x2[1][2] * sc, x2[1][3] * sc);
                *(u32x4*)rowp = w1; *(u32x4*)(rowp + HALF) = w2;
                asm volatile("" ::: "memory"); }
    }
};
template <class Epi, class Sched, bool STAMP = false>
__device__ __forceinline__ void gemm_phase(PG8_LAS unsigned char* lds, const Gemm g, const Sched& S, const Epi& E, unsigned long long* stamps, int tid_in) {
    int tid_ = tid_in; asm volatile("" : "+v"(tid_)); const int tid = tid_, wid = __builtin_amdgcn_readfirstlane(tid >> 6), lane = tid & 63, wr = wid >> 2, wc = wid & 3, fr = lane & 15, fq = lane >> 4;
    const int K = g.K, nt = K / BK;
    int ts_lo = 0, ts_hi = 0, nts = 0; const unsigned long long rt_entry = STAMP ? (unsigned long long)wall_clock64() : 0ull;
#define PG8_STAMP() do { if (STAMP && wid == 0 && nts < 64) { const unsigned long long _c = (unsigned long long)clock64(); \
        ts_lo = (lane == nts) ? (int)(unsigned)_c : ts_lo; ts_hi = (lane == nts) ? (int)(unsigned)(_c >> 32) : ts_hi; ++nts; } } while (0)
    PG8_STAMP();
    unsigned voffB[2]; int stR[2]; unsigned stC[2];
#pragma unroll
    for (int i = 0; i < 2; ++i) { int R, C; stage_rc(tid * 16 + i * 8192, R, C); const int Rb = Epi::PERM ? ((R & ~31) + perm32(R & 31)) : R;
        stR[i] = R; stC[i] = (unsigned)C * 2u; voffB[i] = (unsigned)Rb * (unsigned)S.K2 + (unsigned)C * 2u; }
    unsigned vAc0[2], vAc1[2], vAn0[2], vAn1[2];
#define PG8_AROWS(u, d0, d1) do { _Pragma("unroll") for (int _i = 0; _i < 2; ++_i) { d0[_i] = S.arow(u, stR[_i]) * (unsigned)(K * 2) + stC[_i]; d1[_i] = S.arow(u, HALF + stR[_i]) * (unsigned)(K * 2) + stC[_i]; } } while (0)
    const size_t kstep = (size_t)(BK * 2);
    const size_t hstep = (size_t)HALF * S.K2;
    const size_t tstep = 2 * hstep;
    const unsigned ldsw = (unsigned)wid * 1024u;
    const int aoff = lds_byte(wr * 64 + fr, fq * 8), boff = lds_byte(wc * 32 + fr, fq * 8);
#define PG8_SA(b, h) (((b) * 2 + (h)) * HTB)
#define PG8_SB(b, h) ((4 + (b) * 2 + (h)) * HTB)
#define PG8_STAGE(bufoff, gbase, voff) do { _Pragma("unroll") for (int _i = 0; _i < 2; ++_i) \
        __builtin_amdgcn_global_load_lds((const unsigned*)((const char*)(gbase) + (voff)[_i]), (PG8_LAS unsigned*)(lds + (bufoff) + ldsw + _i * 8192), 16, 0, 0); } while (0)
#define PG8_LDA(dst, b, h) do { _Pragma("unroll") for (int m = 0; m < 4; ++m) _Pragma("unroll") for (int k = 0; k < 2; ++k) dst[m][k] = *(const PG8_LAS bf16x8*)(lds + PG8_SA(b, h) + aoff + m * 2048 + k * 1024); } while (0)
#define PG8_LDB(dst, b, h) do { _Pragma("unroll") for (int n = 0; n < 2; ++n) _Pragma("unroll") for (int k = 0; k < 2; ++k) dst[n][k] = *(const PG8_LAS bf16x8*)(lds + PG8_SB(b, h) + boff + n * 2048 + k * 1024); } while (0)
#define PG8_MMA(ai, bj, At, Bt) do { __builtin_amdgcn_s_setprio(1); _Pragma("unroll") for (int m = 0; m < 4; ++m) _Pragma("unroll") for (int n = 0; n < 2; ++n) _Pragma("unroll") for (int k = 0; k < 2; ++k) \
        acc[ai][bj][m][n] = mma_op<Epi::I8>(Bt[n][k], At[m][k], acc[ai][bj][m][n]); __builtin_amdgcn_s_setprio(0); } while (0)
#define PG8_WAIT_V(n) asm volatile("s_waitcnt vmcnt(" #n ")" ::: "memory")
#define PG8_WAIT_L(n) asm volatile("s_waitcnt lgkmcnt(" #n ")" ::: "memory")
#define PG8_BAR __builtin_amdgcn_s_barrier()
#define PG8_SCHED __builtin_amdgcn_sched_barrier(0)
    Unit cur, nxt; int ui = 0;
    if (!S.next(0, cur)) return;
    typename AccSel<Epi::I8>::T acc[2][2][4][2];
#pragma unroll
    for (int a = 0; a < 2; ++a)
#pragma unroll
        for (int b = 0; b < 2; ++b)
#pragma unroll
            for (int m = 0; m < 4; ++m)
#pragma unroll
                for (int n = 0; n < 2; ++n) acc[a][b][m][n] = AccSel<Epi::I8>::zero();
    bf16x8 At[4][2], B0[2][2], B1[2][2];
    const char* const cA = (const char*)g.A; const char* cB = S.bbase(cur);
    PG8_AROWS(cur, vAc0, vAc1);
    S.a_ready(cur);
    PG8_STAGE(PG8_SB(0, 0), cB, voffB); PG8_STAGE(PG8_SA(0, 0), cA, vAc0); PG8_STAGE(PG8_SB(0, 1), cB + hstep, voffB); PG8_STAGE(PG8_SA(0, 1), cA, vAc1);
    if (wr == 1) PG8_BAR;
    PG8_WAIT_V(4); PG8_BAR;
    PG8_STAGE(PG8_SB(1, 0), cB + kstep, voffB); PG8_STAGE(PG8_SA(1, 0), cA + kstep, vAc0); PG8_STAGE(PG8_SB(1, 1), cB + hstep + kstep, voffB);
    PG8_WAIT_V(6); PG8_BAR;
    PG8_STAMP();
    for (;;) {
        const bool has_next = S.next(ui + 1, nxt);
        const char* nB = has_next ? S.bbase(nxt) : cB;
        if (has_next) PG8_AROWS(nxt, vAn0, vAn1); else { _Pragma("unroll") for (int _i = 0; _i < 2; ++_i) { vAn0[_i] = vAc0[_i]; vAn1[_i] = vAc1[_i]; } }
        const bool full = cur.hs < 0;
        for (int t = 0; t < nt; t += 2) {
            const bool last = (t == nt - 2);
            const char* a1 = cA + (size_t)(t + 1) * kstep;
            const char* a2 = last ? cA : cA + (size_t)(t + 2) * kstep; const char* b2 = last ? nB : cB + (size_t)(t + 2) * kstep;
            const char* a3 = a2 + kstep; const char* b3 = b2 + kstep;
            unsigned v20[2], v21[2];
#pragma unroll
            for (int _i = 0; _i < 2; ++_i) { v20[_i] = last ? vAn0[_i] : vAc0[_i]; v21[_i] = last ? vAn1[_i] : vAc1[_i]; }
            if (last && has_next) S.a_ready(nxt);
            PG8_LDB(B0, 0, 0); PG8_SCHED; PG8_LDA(At, 0, 0); PG8_STAGE(PG8_SA(1, 1), a1, vAc1);
            PG8_WAIT_L(8); PG8_BAR; PG8_WAIT_L(0); PG8_MMA(0, 0, At, B0); PG8_BAR; PG8_SCHED;
            PG8_LDB(B1, 0, 1); PG8_STAGE(PG8_SB(0, 0), b2, voffB);
            PG8_BAR; PG8_WAIT_L(0); PG8_MMA(0, 1, At, B1); PG8_BAR;
            if (full) PG8_LDA(At, 0, 1); PG8_STAGE(PG8_SA(0, 0), a2, v20);
            PG8_BAR; PG8_WAIT_L(0); if (full) PG8_MMA(1, 0, At, B0); PG8_BAR; PG8_SCHED;
            PG8_STAGE(PG8_SB(0, 1), b2 + hstep, voffB);
            PG8_WAIT_V(6); PG8_BAR; if (full) PG8_MMA(1, 1, At, B1); PG8_BAR;
            PG8_LDB(B0, 1, 0); PG8_SCHED; PG8_LDA(At, 1, 0); PG8_STAGE(PG8_SA(0, 1), a2, v21);
            PG8_WAIT_L(8); PG8_BAR; PG8_WAIT_L(0); PG8_MMA(0, 0, At, B0); PG8_BAR; PG8_SCHED;
            PG8_LDB(B1, 1, 1); PG8_STAGE(PG8_SB(1, 0), b3, voffB);
            PG8_BAR; PG8_WAIT_L(0); PG8_MMA(0, 1, At, B1); PG8_BAR;
            if (full) PG8_LDA(At, 1, 1); PG8_STAGE(PG8_SA(1, 0), a3, v20);
            PG8_BAR; PG8_WAIT_L(0); if (full) PG8_MMA(1, 0, At, B0); PG8_BAR; PG8_SCHED;
            PG8_STAGE(PG8_SB(1, 1), b3 + hstep, voffB);
            PG8_WAIT_V(6); PG8_BAR; if (full) PG8_MMA(1, 1, At, B1); PG8_BAR;
        }
        PG8_STAMP();
        if constexpr (!Epi::AFTER_DRAIN) { E(acc, cur, wr, wc, fr, fq); S.done(cur); }
        PG8_STAMP();
        if (!has_next) break;
#pragma unroll
        for (int a = 0; a < 2; ++a)
#pragma unroll
            for (int b = 0; b < 2; ++b)
#pragma unroll
                for (int m = 0; m < 4; ++m)
#pragma unroll
                    for (int n = 0; n < 2; ++n) acc[a][b][m][n] = AccSel<Epi::I8>::zero();
        cur = nxt; cB = nB; ++ui;
#pragma unroll
        for (int _i = 0; _i < 2; ++_i) { vAc0[_i] = vAn0[_i]; vAc1[_i] = vAn1[_i]; }
    }
    PG8_WAIT_V(0);
    if (wr == 0) PG8_BAR;
    PG8_BAR;
    if constexpr (Epi::AFTER_DRAIN) { E.fused(acc, cur, wr, wc, fr, fq, lds, wid, lane); S.done(cur); }
    PG8_STAMP();
    if (STAMP && wid == 0) { stamps[lane] = lane < nts ? (((unsigned long long)(unsigned)ts_hi << 32) | (unsigned)ts_lo) : 0ull;
        if (lane == 62) stamps[62] = rt_entry; if (lane == 63) stamps[63] = (unsigned long long)wall_clock64(); }
#undef PG8_STAMP
#undef PG8_SA
#undef PG8_AROWS
#undef PG8_SB
#undef PG8_STAGE
#undef PG8_LDA
#undef PG8_LDB
#undef PG8_MMA
#undef PG8_WAIT_V
#undef PG8_WAIT_L
#undef PG8_BAR
#undef PG8_SCHED
}
}
#define XB_TMO      128
#define XB_XCNT(j)  (256  + 64 * (j))
#define XB_XSUB(j)  (1280 + 64 * (j))
#define XB_XGEN(j)  (2304 + 64 * (j))
#define XB_TOP      3328
#define XB_TOPGEN   3392
#define XCD_BAR_WORDS 3456
#define XB_SPIN_CAP (1u << 24)

__device__ __forceinline__ unsigned xb_ld(unsigned* p)              { return __hip_atomic_load(p, __ATOMIC_RELAXED, __HIP_MEMORY_SCOPE_AGENT); }
__device__ __forceinline__ unsigned xb_add(unsigned* p, unsigned v) { return __hip_atomic_fetch_add(p, v, __ATOMIC_RELAXED, __HIP_MEMORY_SCOPE_AGENT); }
__device__ __forceinline__ unsigned xb_xcc_id() { return (unsigned)__builtin_amdgcn_s_getreg((3 << 11) | 20) & 0xFu; }
#define XB_SPIN(cond, bar) do { unsigned _sp = 0; while (cond) { __builtin_amdgcn_s_sleep(1); \
    if ((++_sp & 255u) == 0u) { if (xb_ld(&(bar)[XB_TMO])) break; if (_sp > XB_SPIN_CAP) { atomicAdd(&(bar)[XB_TMO], 1u); break; } } } } while (0)

struct XcdBarrier {
    unsigned* bar; unsigned x;
    volatile LAS unsigned* st;
};

__device__ __forceinline__ XcdBarrier xcd_barrier_post(unsigned* bar, volatile LAS unsigned* st) {
    XcdBarrier b; b.bar = bar; b.x = xb_xcc_id(); b.st = st;
    if (threadIdx.x == 0) (void)xb_add(&bar[XB_XCNT(b.x)], 1u);
    return b;
}
__device__ __forceinline__ void xcd_barrier_complete(unsigned* bar, unsigned x, unsigned& nloc, unsigned& nx) {
    const unsigned G = gridDim.x * gridDim.y * gridDim.z;
    unsigned sum, cnt, mine, sp = 0u;
    for (;;) {
        sum = 0u; cnt = 0u; mine = 0u;
#pragma unroll
        for (unsigned j = 0; j < 16; ++j) { const unsigned c = xb_ld(&bar[XB_XCNT(j)]); sum += c; cnt += (c > 0u) ? 1u : 0u; mine = (j == x) ? c : mine; }
        if (sum == G) break;
        __builtin_amdgcn_s_sleep(1);
        if ((++sp & 255u) == 0u) { if (xb_ld(&bar[XB_TMO])) break; if (sp > XB_SPIN_CAP) { atomicAdd(&bar[XB_TMO], 1u); break; } }
    }
    nloc = mine > 0u ? mine : 1u; nx = cnt > 0u ? cnt : 1u;
}

__device__ __forceinline__ void xcd_barrier(const XcdBarrier& b) {
    asm volatile("s_waitcnt vmcnt(0)" ::: "memory");
    __syncthreads();
    if (threadIdx.x == 0) {
        unsigned* bar = b.bar;
        __builtin_amdgcn_s_waitcnt(0);
        unsigned nloc = b.st[0], nx = b.st[1];
        if (nloc == 0u) { xcd_barrier_complete(bar, b.x, nloc, nx); b.st[0] = nloc; b.st[1] = nx; }
        const unsigned old = xb_add(&bar[XB_XSUB(b.x)], 1u);
        const unsigned gen = old / nloc;
        if (old + 1u == (gen + 1u) * nloc) {
            __builtin_amdgcn_fence(__ATOMIC_RELEASE, "agent");
            asm volatile("s_waitcnt vmcnt(0)" ::: "memory");
            const unsigned og = xb_add(&bar[XB_TOP], 1u);
            const unsigned tg = og / nx;
            if (og + 1u == (tg + 1u) * nx) xb_add(&bar[XB_TOPGEN], 1u);
            else XB_SPIN(xb_ld(&bar[XB_TOPGEN]) == tg, bar);
            __builtin_amdgcn_fence(__ATOMIC_ACQUIRE, "agent");
            xb_add(&bar[XB_XGEN(b.x)], 1u);
            asm volatile("s_waitcnt vmcnt(0)" ::: "memory");
        } else {
            XB_SPIN(xb_ld(&bar[XB_XGEN(b.x)]) == gen, bar);
            __builtin_amdgcn_fence(__ATOMIC_ACQUIRE, "agent");
            asm volatile("s_waitcnt vmcnt(0)" ::: "memory");
        }
    }
    __syncthreads();
}

constexpr int SCR_BYTES = 139264;
constexpr int MISC_OFF = 147456 - 128;
constexpr int LDS_BYTES = 147456;
constexpr int CW_BAR = 4096;
constexpr int NTHR = 512, NWAVES = 8;
constexpr int CW_COLMAX = 131072;
constexpr int N_QROWS = 2 * NPW + NUP + NEXP * NUP;
constexpr int CW_MOE = 8192;

__device__ __forceinline__ void transpose_item(const float* W, int ldw, int col0, int K, bf16_t* WT, int drow0, int kb, LAS float* scr, int lane, int gap16 = 0, unsigned* cmax = nullptr) {
    const int k0 = 64 * kb; const int cs = col0 + (lane & 31) + ((lane & 16) ? gap16 : 0);
    float v[32];
#pragma unroll
    for (int i = 0; i < 32; ++i) v[i] = W[(size_t)(k0 + 2 * i + (lane >> 5)) * ldw + cs];
#pragma unroll
    for (int i = 0; i < 32; ++i) scr[(2 * i + (lane >> 5)) * 33 + (lane & 31)] = v[i];
    asm volatile("s_waitcnt lgkmcnt(0)" ::: "memory");
    const int c = lane & 7;
#pragma unroll
    for (int j = 0; j < 4; ++j) { const int n = (lane >> 3) + 8 * j; const LAS float* s = scr + (8 * c) * 33 + n;
        u32x4 o; o.x = pk2(s[0 * 33], s[1 * 33]); o.y = pk2(s[2 * 33], s[3 * 33]); o.z = pk2(s[4 * 33], s[5 * 33]); o.w = pk2(s[6 * 33], s[7 * 33]);
        *(u32x4*)(WT + (size_t)(drow0 + n) * K + k0 + 8 * c) = o;
        if (cmax) {
            float am = fmaxf(fmaxf(fmaxf(fabsf(bflo(o.x)), fabsf(bfhi(o.x))), fmaxf(fabsf(bflo(o.y)), fabsf(bfhi(o.y)))), fmaxf(fmaxf(fabsf(bflo(o.z)), fabsf(bfhi(o.z))), fmaxf(fabsf(bflo(o.w)), fabsf(bfhi(o.w)))));
            am = fmaxf(am, swz_xor<1>(am)); am = fmaxf(am, swz_xor<2>(am)); am = fmaxf(am, swz_xor<4>(am));
            if (c == 0) atomicMax(cmax + drow0 + n, __float_as_uint(am)); } }
    asm volatile("s_waitcnt lgkmcnt(0)" ::: "memory");
}
__device__ __forceinline__ void up_item(const float* wg, const float* wu, bf16_t* WT, int it, LAS float* scr, int lane, unsigned* cmax) {
    const int nb = it >> 4, kb = it & 15, r0 = 32 * nb, pn = r0 >> 8, p = r0 & 255;
    transpose_item(p < 128 ? wg : wu, DFF, 128 * pn + (p & 127), DM, WT, r0, kb, scr, lane, 0, cmax);
}
__device__ __forceinline__ void dn_item(const float* wd, bf16_t* WT, int it, LAS float* scr, int lane) {
    const int nb = it / 44, kb = it % 44;
    transpose_item(wd, DM, 32 * nb, DFF, WT, 32 * nb, kb, scr, lane);
}
constexpr int IT_IN = 112 * 16, IT_OUT = 32 * 16, IT_UP = 176 * 16, IT_DN = 32 * 44;
constexpr int IT_TOTAL = 2 * IT_IN + 2 * IT_OUT + IT_UP + IT_DN + NEXP * (IT_UP + IT_DN);

__device__ __forceinline__ void convert_flat_item(const Args& a, unsigned char* ws, int it, LAS float* scr, int lane) {
    if (it < 2 * IT_IN) { const int l = it / IT_IN; it -= l * IT_IN; const int nb = it >> 4, kb = it & 15, r0 = 32 * nb;
        const int pn = r0 >> 8, p = r0 & 255; const bool hl = pn < 2 || (pn >= 8 && pn < 12);
        const int cbase = (pn < 8 ? 256 * pn : 256 * pn + 16);
        const int col0 = hl ? cbase + 64 * ((p >> 5) & 3) + 16 * (p >> 7) : cbase + p;
        transpose_item(a.in[8] + (size_t)l * DM * DIN, DIN, col0, DM, (bf16_t*)(ws + WS_WTIN) + (size_t)l * NPW * DM, r0, kb, scr, lane, hl ? 16 : 0, (unsigned*)(ws + WS_CTL) + CW_COLMAX + l * NPW); return; }
    it -= 2 * IT_IN;
    if (it < 2 * IT_OUT) { const int l = it / IT_OUT; it -= l * IT_OUT; const int nb = it >> 4, kb = it & 15;
        transpose_item(a.in[16] + (size_t)l * DM * DM, DM, 32 * nb, DM, (bf16_t*)(ws + WS_WTOUT) + (size_t)l * DM * DM, 32 * nb, kb, scr, lane); return; }
    it -= 2 * IT_OUT;
    if (it < IT_UP) { up_item(a.in[17], a.in[18], (bf16_t*)(ws + WS_WTUP), it, scr, lane, (unsigned*)(ws + WS_CTL) + CW_COLMAX + 2 * NPW); return; }
    it -= IT_UP;
    if (it < IT_DN) { dn_item(a.in[19], (bf16_t*)(ws + WS_WTDN), it, scr, lane); return; }
    it -= IT_DN;
    if (it < NEXP * IT_UP) { const int e = it / IT_UP; it -= e * IT_UP;
        up_item(a.in[21] + (size_t)e * DM * DFF, a.in[22] + (size_t)e * DM * DFF, (bf16_t*)(ws + WS_WTMUP) + (size_t)e * NUP * DM, it, scr, lane, (unsigned*)(ws + WS_CTL) + CW_COLMAX + 2 * NPW + NUP + e * NUP); return; }
    it -= NEXP * IT_UP;
    { const int e = it / IT_DN; it -= e * IT_DN; dn_item(a.in[23] + (size_t)e * DFF * DM, (bf16_t*)(ws + WS_WTMDN) + (size_t)e * DM * DFF, it, scr, lane); }
}
constexpr int N_EARLY = IT_IN + IT_OUT + IT_UP + IT_DN, N_DEFER = IT_TOTAL - N_EARLY, N_DEFER_L1 = IT_IN + IT_OUT;
__device__ __forceinline__ int early_to_flat(int i) { if (i < IT_IN) return i; i -= IT_IN; if (i < IT_OUT) return 2 * IT_IN + i; return 2 * IT_IN + 2 * IT_OUT + (i - IT_OUT); }
__device__ __forceinline__ int defer_to_flat(int d) { if (d < IT_IN) return IT_IN + d; d -= IT_IN; if (d < IT_OUT) return 2 * IT_IN + IT_OUT + d; return 2 * IT_IN + 2 * IT_OUT + IT_UP + IT_DN + (d - IT_OUT); }
#ifndef CVNB
#define CVNB 0
#endif
constexpr int N_MOE_ITEMS = NEXP * (IT_UP + IT_DN), CV_FIRST = NEXP * IT_UP;
constexpr int CV_HIDDEN_ = 2 * 128 * 8 * CVNB, CV_HIDDEN = CV_HIDDEN_ < NEXP * IT_DN ? CV_HIDDEN_ : NEXP * IT_DN;
__device__ __forceinline__ void convert_window(const Args& a, LAS unsigned char* lds, int lane, int wave, int G, int ph, int rank) {
    if (G != 256) return;
    unsigned char* ws = a.ws; LAS float* scr = (LAS float*)(lds + 65536 + wave * 8704);
    for (int j = 0; j < CVNB; ++j) { const int m = ((ph * 128 + rank) * NWAVES + wave) * CVNB + j; if (m < CV_HIDDEN) convert_flat_item(a, ws, defer_to_flat(N_DEFER_L1 + CV_FIRST + m), scr, lane); }
}
__device__ __forceinline__ unsigned pack_i8x4(float a, float b, float c, float d) {
    const int ia = __float2int_rn(a), ib = __float2int_rn(b), ic = __float2int_rn(c), id = __float2int_rn(d);
    return (unsigned)(ia & 0xff) | ((unsigned)(ib & 0xff) << 8) | ((unsigned)(ic & 0xff) << 16) | ((unsigned)(id & 0xff) << 24);
}
struct QStrip { const float* src; int ldw; unsigned char* dst; int qrow0; };
__device__ __forceinline__ QStrip quant_strip_decode(const Args& a, unsigned char* ws, int tid, int st) {
    const float* W; int ldw, col0, gap = 0; unsigned char* dst;
    if (st < 2 * (NPW / 32)) { const int l = st / (NPW / 32), r0 = 32 * (st - l * (NPW / 32)); const int pn = r0 >> 8, p = r0 & 255; const bool hl = pn < 2 || (pn >= 8 && pn < 12);
        const int cbase = (pn < 8 ? 256 * pn : 256 * pn + 16);
        W = a.in[8] + (size_t)l * DM * DIN; ldw = DIN; col0 = hl ? cbase + 64 * ((p >> 5) & 3) + 16 * (p >> 7) : cbase + p; gap = hl ? 16 : 0; dst = ws + WS_WTIN + (size_t)(l * NPW + r0) * 2048; }
    else { int s2 = st - 2 * (NPW / 32); const float* wg; const float* wu; unsigned char* base;
        if (s2 < NUP / 32) { wg = a.in[17]; wu = a.in[18]; base = ws + WS_WTUP; }
        else { s2 -= NUP / 32; const int e = s2 / (NUP / 32); s2 -= e * (NUP / 32); wg = a.in[21] + (size_t)e * DM * DFF; wu = a.in[22] + (size_t)e * DM * DFF; base = ws + WS_WTMUP + (size_t)e * NUP * 2048; }
        const int r0 = 32 * s2, pn = r0 >> 8, p = r0 & 255; W = p < 128 ? wg : wu; ldw = DFF; col0 = 128 * pn + (p & 127); dst = base + (size_t)r0 * 2048; }
    const int kk = tid >> 3, c4 = (tid & 7) * 4;
    QStrip q; q.src = W + col0 + c4 + (c4 >= 16 ? gap : 0) + (size_t)kk * ldw; q.ldw = ldw; q.dst = dst; q.qrow0 = 32 * st; return q;
}
__device__ __forceinline__ void quant_strip_load(const QStrip& q, f32x4 (&v)[16]) {
#pragma unroll
    for (int i = 0; i < 16; ++i) v[i] = *(const f32x4*)(q.src + (size_t)(64 * i) * q.ldw);
}
__device__ __forceinline__ void quant_strips(const Args& a, unsigned char* ws, LAS unsigned char* lds, int tid, int bid, int G) {
    LAS float* tile = (LAS float*)lds; LAS float* red = (LAS float*)(lds + 1024 * 33 * 4);
    const int nst = N_QROWS / 32; int st = bid; if (st >= nst) return;
    QStrip cur = quant_strip_decode(a, ws, tid, st); f32x4 v[16]; quant_strip_load(cur, v);
    for (;;) {
        __syncthreads();
        { const int kk = tid >> 3, c4 = (tid & 7) * 4;
#pragma unroll
          for (int i = 0; i < 16; ++i) { LAS float* tp = tile + (kk + 64 * i) * 33 + c4; tp[0] = v[i].x; tp[1] = v[i].y; tp[2] = v[i].z; tp[3] = v[i].w; } }
        __syncthreads();
        const int stn = st + G; const bool more = stn < nst; QStrip nxt = cur;
        if (more) { nxt = quant_strip_decode(a, ws, tid, stn); quant_strip_load(nxt, v); }
        const int n = tid & 31, ks = (tid >> 5) * 64;
        { float am = 0.f;
#pragma unroll 8
          for (int i = 0; i < 64; ++i) am = fmaxf(am, fabsf(tile[(ks + i) * 33 + n]));
          red[(tid >> 5) * 32 + n] = am; }
        __syncthreads();
        if (tid < 32) { float am = 0.f;
#pragma unroll
            for (int g = 0; g < 16; ++g) am = fmaxf(am, red[g * 32 + tid]);
            red[512 + tid] = am; ((unsigned*)(ws + WS_CTL) + CW_COLMAX)[cur.qrow0 + tid] = __float_as_uint(am); }
        __syncthreads();
        { const float am = red[512 + n]; const float inv = am > 0.f ? 127.0f / am : 0.f;
          unsigned char* op = cur.dst + (size_t)n * 2048 + ks;
#pragma unroll
          for (int q = 0; q < 4; ++q) { u32x4 o;
              o.x = pack_i8x4(tile[(ks + 16 * q + 0) * 33 + n] * inv, tile[(ks + 16 * q + 1) * 33 + n] * inv, tile[(ks + 16 * q + 2) * 33 + n] * inv, tile[(ks + 16 * q + 3) * 33 + n] * inv);
              o.y = pack_i8x4(tile[(ks + 16 * q + 4) * 33 + n] * inv, tile[(ks + 16 * q + 5) * 33 + n] * inv, tile[(ks + 16 * q + 6) * 33 + n] * inv, tile[(ks + 16 * q + 7) * 33 + n] * inv);
              o.z = pack_i8x4(tile[(ks + 16 * q + 8) * 33 + n] * inv, tile[(ks + 16 * q + 9) * 33 + n] * inv, tile[(ks + 16 * q + 10) * 33 + n] * inv, tile[(ks + 16 * q + 11) * 33 + n] * inv);
              o.w = pack_i8x4(tile[(ks + 16 * q + 12) * 33 + n] * inv, tile[(ks + 16 * q + 13) * 33 + n] * inv, tile[(ks + 16 * q + 14) * 33 + n] * inv, tile[(ks + 16 * q + 15) * 33 + n] * inv);
              *(u32x4*)(op + 16 * q) = o; } }
        if (!more) break;
        st = stn; cur = nxt;
    }
}
__device__ __forceinline__ void phase_prologue(const Args& a, LAS unsigned char* lds, int tid, int lane, int wave, int bid, int G) {
    unsigned char* ws = a.ws;
    quant_strips(a, ws, lds, tid, bid, G);
    __syncthreads();
    {
        LAS float* scr = (LAS float*)(lds + wave * 8704);
        const int gw = bid * NWAVES + wave, NGW = G * NWAVES;
        const int hid = (G == 256) ? CV_HIDDEN : 0, npro = N_EARLY + N_DEFER - hid;
        constexpr int NB16 = 2 * IT_OUT + IT_DN + NEXP * IT_DN;
        for (int i = gw; i < NB16; i += NGW) { int it = i;
            if (it < 2 * IT_OUT) { convert_flat_item(a, ws, 2 * IT_IN + it, scr, lane); continue; } it -= 2 * IT_OUT;
            if (it < IT_DN) { convert_flat_item(a, ws, 2 * IT_IN + 2 * IT_OUT + IT_UP + it, scr, lane); continue; } it -= IT_DN;
            convert_flat_item(a, ws, 2 * IT_IN + 2 * IT_OUT + IT_UP + IT_DN + NEXP * IT_UP + it, scr, lane); }
        (void)hid; (void)npro;
    }
    __syncthreads();
    {
        const int gt = bid * NTHR + tid;
        if (gt < 1024) { const int pos = gt >> 4, i = gt & 15;
            double inv = 1.0; for (int q = 0; q < i; ++q) inv *= 0.56234132519034908;
            const float angf = (float)pos * (float)inv; const double ang = (double)angf;
            const double kq = rint(ang * 0.63661977236758134); const double r = ang - kq * 1.5707963267948966 - kq * 6.123233995736766e-17; const double r2 = r * r;
            double sn = r * (1.0 + r2 * (-1.0 / 6 + r2 * (1.0 / 120 + r2 * (-1.0 / 5040 + r2 * (1.0 / 362880 + r2 * (-1.0 / 39916800 + r2 * (1.0 / 6227020800.0)))))));
            double cs = 1.0 + r2 * (-0.5 + r2 * (1.0 / 24 + r2 * (-1.0 / 720 + r2 * (1.0 / 40320 + r2 * (-1.0 / 3628800 + r2 * (1.0 / 479001600.0 + r2 * (-1.0 / 87178291200.0)))))));
            const int kk = ((int)kq) & 3; double c2, s2;
            if (kk == 0) { c2 = cs; s2 = sn; } else if (kk == 1) { c2 = -sn; s2 = cs; } else if (kk == 2) { c2 = -cs; s2 = -sn; } else { c2 = sn; s2 = -cs; }
            float* R = (float*)(ws + WS_ROPE); R[gt * 2] = (float)c2; R[gt * 2 + 1] = (float)s2; }
    }
    {
        LAS float* sc = (LAS float*)(lds + 73728);
        LAS float* red = (LAS float*)(lds + 73728 + 36864);
        for (int i = tid; i < 9 * 1024; i += NTHR) { const float v = i < 8192 ? a.in[1][i] : a.in[3][i - 8192]; sc[i] = v / (1.0f + __expf(-v)); }
        __syncthreads();
        for (int item = bid; item < 192; item += G) {
            const int l = item / 96, n0 = (item % 96) * 64;
            const float* wm = a.in[6] + (size_t)l * DM * 6144 + n0 + lane;
            float acc[9];
#pragma unroll
            for (int b = 0; b < 9; ++b) acc[b] = 0.f;
#pragma unroll 4
            for (int kk = 0; kk < 128; ++kk) { const int k = wave * 128 + kk; const float w = wm[(size_t)k * 6144];
#pragma unroll
                for (int b = 0; b < 9; ++b) acc[b] += sc[b * 1024 + k] * w; }
#pragma unroll
            for (int b = 0; b < 9; ++b) red[(wave * 9 + b) * 64 + lane] = acc[b];
            __syncthreads();
            for (int o = tid; o < 576; o += NTHR) { const int b = o >> 6, ln = o & 63; float s = a.in[7][(size_t)l * 6144 + n0 + ln];
#pragma unroll
                for (int w = 0; w < 8; ++w) s += red[(w * 9 + b) * 64 + ln];
                ((float*)(ws + WS_MOD))[((size_t)l * 9 + b) * 6144 + n0 + ln] = s; }
            __syncthreads();
        }
    }
}


typedef short bf16x8 __attribute__((ext_vector_type(8)));
typedef short s16x4 __attribute__((ext_vector_type(4)));
constexpr int IST = 160;
__device__ __forceinline__ f32x4 mfma16(bf16x8 a, bf16x8 b, f32x4 c) { return __builtin_amdgcn_mfma_f32_16x16x32_bf16(a, b, c, 0, 0, 0); }
__device__ __forceinline__ bf16x8 frag_row(LAS const unsigned char* img, int row0, int k0, int lane) {
    return *(const LAS bf16x8*)(img + (row0 + (lane & 15)) * IST + (k0 + 8 * (lane >> 4)) * 2);
}
template <bool PERMK>
__device__ __forceinline__ bf16x8 frag_tr(LAS const unsigned char* img, int r0, int c0, int lane) {
    const int g = lane >> 4, i = lane & 15, q = i >> 2, p = i & 3;
    const unsigned addr = (unsigned)(size_t)(img + (r0 + (PERMK ? 4 : 8) * g + q) * IST + (c0 + 4 * p) * 2);
    s16x4 lo, hi;
    if (PERMK) asm volatile("ds_read_b64_tr_b16 %0, %2\n\tds_read_b64_tr_b16 %1, %2 offset:2560\n\ts_waitcnt lgkmcnt(0)" : "=&v"(lo), "=&v"(hi) : "v"(addr) : "memory");
    else       asm volatile("ds_read_b64_tr_b16 %0, %2\n\tds_read_b64_tr_b16 %1, %2 offset:640\n\ts_waitcnt lgkmcnt(0)" : "=&v"(lo), "=&v"(hi) : "v"(addr) : "memory");
    bf16x8 r; r[0] = lo[0]; r[1] = lo[1]; r[2] = lo[2]; r[3] = lo[3]; r[4] = hi[0]; r[5] = hi[1]; r[6] = hi[2]; r[7] = hi[3];
    return r;
}
template <bool PERMK>
__device__ __forceinline__ void frag_tr_x4(LAS const unsigned char* img, int r0, int c0, int lane, bf16x8 (&out)[4]) {
    const int g = lane >> 4, i = lane & 15, q = i >> 2, p = i & 3;
    const unsigned addr = (unsigned)(size_t)(img + (r0 + (PERMK ? 4 : 8) * g + q) * IST + (c0 + 4 * p) * 2);
    s16x4 l0, h0, l1, h1, l2, h2, l3, h3;
    if (PERMK) asm volatile("ds_read_b64_tr_b16 %0, %8\n\tds_read_b64_tr_b16 %1, %8 offset:2560\n\tds_read_b64_tr_b16 %2, %8 offset:32\n\tds_read_b64_tr_b16 %3, %8 offset:2592\n\t"
                            "ds_read_b64_tr_b16 %4, %8 offset:64\n\tds_read_b64_tr_b16 %5, %8 offset:2624\n\tds_read_b64_tr_b16 %6, %8 offset:96\n\tds_read_b64_tr_b16 %7, %8 offset:2656\n\ts_waitcnt lgkmcnt(0)"
                            : "=&v"(l0), "=&v"(h0), "=&v"(l1), "=&v"(h1), "=&v"(l2), "=&v"(h2), "=&v"(l3), "=&v"(h3) : "v"(addr) : "memory");
    else       asm volatile("ds_read_b64_tr_b16 %0, %8\n\tds_read_b64_tr_b16 %1, %8 offset:640\n\tds_read_b64_tr_b16 %2, %8 offset:32\n\tds_read_b64_tr_b16 %3, %8 offset:672\n\t"
                            "ds_read_b64_tr_b16 %4, %8 offset:64\n\tds_read_b64_tr_b16 %5, %8 offset:704\n\tds_read_b64_tr_b16 %6, %8 offset:96\n\tds_read_b64_tr_b16 %7, %8 offset:736\n\ts_waitcnt lgkmcnt(0)"
                            : "=&v"(l0), "=&v"(h0), "=&v"(l1), "=&v"(h1), "=&v"(l2), "=&v"(h2), "=&v"(l3), "=&v"(h3) : "v"(addr) : "memory");
#define FT_PACK(o, lo, hi) o[0] = lo[0]; o[1] = lo[1]; o[2] = lo[2]; o[3] = lo[3]; o[4] = hi[0]; o[5] = hi[1]; o[6] = hi[2]; o[7] = hi[3];
    FT_PACK(out[0], l0, h0) FT_PACK(out[1], l1, h1) FT_PACK(out[2], l2, h2) FT_PACK(out[3], l3, h3)
#undef FT_PACK
}
__device__ __forceinline__ bf16x8 pack8(f32x4 a, f32x4 b) {
    union { u32x4 u; bf16x8 v; } x; x.u.x = pk2(a[0], a[1]); x.u.y = pk2(a[2], a[3]); x.u.z = pk2(b[0], b[1]); x.u.w = pk2(b[2], b[3]); return x.v;
}

__device__ __forceinline__ void phase_norm1(const Args& a, int l, LAS unsigned char* lds, int tid, int lane, int wave, int bid, int G) {
    unsigned char* ws = a.ws;
    constexpr int RST = 2064;
    LAS unsigned char* WgT = lds; LAS unsigned char* Himg = lds + 16 * RST; LAS float* red = (LAS float*)(lds + 32 * RST);
    { const float* w = a.in[8] + (size_t)l * DM * DIN + 2048;
      for (int i = tid; i < 16384; i += NTHR) { const int k = i >> 4, j = i & 15; *(LAS bf16_t*)(WgT + j * RST + k * 2) = (bf16_t)f2bf(w[(size_t)k * DIN + j]); } }
    __syncthreads();
    const float* gam = a.in[4] + (size_t)l * DM;
    const float* mod = (const float*)(ws + WS_MOD) + (size_t)l * 9 * 6144;
    unsigned char* H8 = ws + WS_H;
    for (int gi = bid; gi < MALL / 16; gi += G) {
#pragma unroll
        for (int rr = 0; rr < 2; ++rr) {
            const int r = 16 * gi + 2 * wave + rr; const bool lat = r < NLAT; const int bi = lat ? (r >> 11) : 8;
            const float* src = (l == 0) ? (lat ? a.in[0] + (size_t)r * DM : a.in[2] + (size_t)(r - NLAT) * DM) : (lat ? a.out + (size_t)r * DM : (const float*)(ws + WS_XC) + (size_t)(r - NLAT) * DM);
            f32x4 v[4]; float ss = 0.f;
#pragma unroll
            for (int j = 0; j < 4; ++j) { v[j] = *(const f32x4*)(src + 4 * lane + 256 * j); ss += (v[j].x * v[j].x + v[j].y * v[j].y) + (v[j].z * v[j].z + v[j].w * v[j].w); }
            const float rstd = rsqrtf(wave_sum(ss) * (1.0f / DM) + EPS);
            const float* mrow = mod + (size_t)bi * 6144;
#pragma unroll
            for (int j = 0; j < 4; ++j) { const int k = 4 * lane + 256 * j;
                const f32x4 g = *(const f32x4*)(gam + k), s = *(const f32x4*)(mrow + 1024 + k), sh = *(const f32x4*)(mrow + k);
                const f32x4 hv = v[j] * rstd * g * (1.0f + s) + sh; v[j] = hv;
                u32x2 w; w.x = pk2(hv.x, hv.y); w.y = pk2(hv.z, hv.w);
                *(LAS u32x2*)(Himg + (2 * wave + rr) * RST + k * 2) = w; }
            float am = 0.f;
#pragma unroll
            for (int j = 0; j < 4; ++j) am = fmaxf(am, fmaxf(fmaxf(fabsf(v[j].x), fabsf(v[j].y)), fmaxf(fabsf(v[j].z), fabsf(v[j].w))));
            am = wave_max(am); const float qs = am > 0.f ? 127.0f / am : 0.f;
#pragma unroll
            for (int j = 0; j < 4; ++j) *(unsigned*)(H8 + (size_t)r * DM + 4 * lane + 256 * j) = pack_i8x4(v[j].x * qs, v[j].y * qs, v[j].z * qs, v[j].w * qs);
            if (lane == 0) ((float*)(ws + WS_HS))[r] = am * (1.0f / 127.0f);
        }
        __syncthreads();
        f32x4 acc = {0.f, 0.f, 0.f, 0.f};
#pragma unroll
        for (int ks = 0; ks < 4; ++ks) { const int off = (lane & 15) * RST + (128 * wave + 32 * ks + 8 * (lane >> 4)) * 2;
            acc = mfma16(*(const LAS bf16x8*)(Himg + off), *(const LAS bf16x8*)(WgT + off), acc); }
        *(LAS f32x4*)(red + wave * 256 + lane * 4) = acc;
        __syncthreads();
        if (tid < 256) { const int ln = tid & 63, j = tid >> 6; float s = 0.f;
#pragma unroll
            for (int w = 0; w < 8; ++w) s += red[w * 256 + ln * 4 + j];
            const int row = 16 * gi + 4 * (ln >> 4) + j, gate = ln & 15;
            ((float*)(ws + WS_GATES))[(size_t)row * 16 + gate] = s + a.in[12][l * 16 + gate]; }
    }
}

template <int MODE>
__device__ __forceinline__ void phase_norm(const Args& a, int l, LAS unsigned char* lds, int tid, int lane, int wave, int bid, int G) {
    unsigned char* ws = a.ws;
    LAS float* WT = (LAS float*)lds;
    if (MODE == 0) { const float* w = a.in[8] + (size_t)l * DM * DIN + 2048; for (int i = tid; i < 16384; i += NTHR) { const int k = i >> 4, j = i & 15; WT[j * 1024 + k] = w[(size_t)k * DIN + j]; } __syncthreads(); }
    if (MODE == 2) { const float* w = a.in[20]; for (int i = tid; i < 8192; i += NTHR) { const int k = i >> 3, j = i & 7; WT[j * 1024 + k] = w[(size_t)k * 8 + j]; } __syncthreads(); }
    const float* gam = (MODE == 0 ? a.in[4] : a.in[5]) + (size_t)l * DM;
    const float* mod = (const float*)(ws + WS_MOD) + (size_t)l * 9 * 6144;
    const int shoff = MODE == 0 ? 0 : 3072, soff = MODE == 0 ? 1024 : 4096;
    const int nrows = (MODE == 2) ? NLAT : MALL;
    unsigned char* H8 = ws + WS_H;
    int nrec = 0;
    const int rstride = G * NWAVES;
    f32x4 vnext[4];
    { const int r = bid * NWAVES + wave; if (r < nrows) { const bool lat = r < NLAT;
        const float* src = (MODE == 0 && l == 0) ? (lat ? a.in[0] + (size_t)r * DM : a.in[2] + (size_t)(r - NLAT) * DM) : (lat ? a.out + (size_t)r * DM : (const float*)(ws + WS_XC) + (size_t)(r - NLAT) * DM);
#pragma unroll
        for (int j = 0; j < 4; ++j) vnext[j] = *(const f32x4*)(src + 4 * lane + 256 * j); } }
    for (int r = bid * NWAVES + wave; r < nrows; r += rstride) {
        const bool lat = r < NLAT; const int bi = lat ? (r >> 11) : 8;
        f32x4 v[4]; float ss = 0.f;
#pragma unroll
        for (int j = 0; j < 4; ++j) { v[j] = vnext[j]; ss += (v[j].x * v[j].x + v[j].y * v[j].y) + (v[j].z * v[j].z + v[j].w * v[j].w); }
        { const int rn = r + rstride; if (rn < nrows) { const bool latn = rn < NLAT;
            const float* srcn = (MODE == 0 && l == 0) ? (latn ? a.in[0] + (size_t)rn * DM : a.in[2] + (size_t)(rn - NLAT) * DM) : (latn ? a.out + (size_t)rn * DM : (const float*)(ws + WS_XC) + (size_t)(rn - NLAT) * DM);
#pragma unroll
            for (int j = 0; j < 4; ++j) vnext[j] = *(const f32x4*)(srcn + 4 * lane + 256 * j); } }
        const float rstd = rsqrtf(wave_sum(ss) * (1.0f / DM) + EPS);
        const float* mrow = mod + (size_t)bi * 6144;
#pragma unroll
        for (int j = 0; j < 4; ++j) { const int k = 4 * lane + 256 * j;
            const f32x4 g = *(const f32x4*)(gam + k), s = *(const f32x4*)(mrow + soff + k), sh = *(const f32x4*)(mrow + shoff + k);
            v[j] = v[j] * rstd * g * (1.0f + s) + sh; }
        { float am = 0.f;
#pragma unroll
          for (int j = 0; j < 4; ++j) am = fmaxf(am, fmaxf(fmaxf(fabsf(v[j].x), fabsf(v[j].y)), fmaxf(fabsf(v[j].z), fabsf(v[j].w))));
          am = wave_max(am); const float qs = am > 0.f ? 127.0f / am : 0.f;
#pragma unroll
          for (int j = 0; j < 4; ++j) *(unsigned*)(H8 + (size_t)r * DM + 4 * lane + 256 * j) = pack_i8x4(v[j].x * qs, v[j].y * qs, v[j].z * qs, v[j].w * qs);
          if (lane == 0) ((float*)(ws + WS_HS))[r] = am * (1.0f / 127.0f); }
        if (MODE == 0) {
            float p[16];
#pragma unroll
            for (int jg = 0; jg < 16; ++jg) p[jg] = 0.f;
#pragma unroll
            for (int jg = 0; jg < 16; ++jg) {
#pragma unroll
                for (int j = 0; j < 4; ++j) { const f32x4 w = *(const LAS f32x4*)(WT + jg * 1024 + 4 * lane + 256 * j); p[jg] += (v[j].x * w.x + v[j].y * w.y) + (v[j].z * w.z + v[j].w * w.w); }
                if ((jg & 3) == 3) asm volatile("" ::: "memory"); }
            const float tot = reduce16_lanes(p, lane);
            const int gid = ((lane >> 5) & 1) * 8 + ((lane >> 4) & 1) * 4 + ((lane >> 3) & 1) * 2 + ((lane >> 2) & 1);
            if ((lane & 3) == 0) ((float*)(ws + WS_GATES))[(size_t)r * 16 + gid] = tot + a.in[12][l * 16 + gid];
        }
        if (MODE == 2) {
            float p[8];
#pragma unroll
            for (int e = 0; e < 8; ++e) p[e] = 0.f;
#pragma unroll
            for (int e = 0; e < 8; ++e) {
#pragma unroll
                for (int j = 0; j < 4; ++j) { const f32x4 w = *(const LAS f32x4*)(WT + e * 1024 + 4 * lane + 256 * j); p[e] += (v[j].x * w.x + v[j].y * w.y) + (v[j].z * w.z + v[j].w * w.w); }
                if ((e & 3) == 3) asm volatile("" ::: "memory"); }
            const float tot = reduce8_lanes(p, lane);
            int i1 = 0, i2 = 0; float v1 = -3.0e38f, v2 = -3.0e38f;
#pragma unroll
            for (int e = 0; e < 8; ++e) { const float s = lane_bcast(tot, 32 * (e >> 2) + 16 * ((e >> 1) & 1) + 8 * (e & 1));
                if (s > v1) { v2 = v1; i2 = i1; v1 = s; i1 = e; } else if (s > v2) { v2 = s; i2 = e; } }
            const float w2 = 1.0f / (1.0f + __expf(v1 - v2)), w1 = 1.0f - w2;
            if (lane == 0) { LAS int* rec = (LAS int*)(lds + 32768) + nrec * 32 + wave * 4; rec[0] = i1; rec[1] = i2; rec[2] = __float_as_int(w1); rec[3] = __float_as_int(w2); }
            ++nrec;
        }
    }
    if (MODE == 2) {
        __syncthreads();
        if (tid < 8) {
            const int e = tid; const LAS int* rec = (const LAS int*)(lds + 32768); int cnt = 0;
            const int nk = (nrows - bid * NWAVES + G * NWAVES - 1) / (G * NWAVES);
            for (int k = 0; k < nk; ++k) for (int w = 0; w < NWAVES; ++w) { const int r = bid * NWAVES + w + k * G * NWAVES; if (r < nrows) { const LAS int* q = rec + k * 32 + w * 4; cnt += (q[0] == e) + (q[1] == e); } }
            int pos = (int)atomicAdd((unsigned*)(ws + WS_CTL) + CW_MOE + 64 * e, (unsigned)cnt);
            int* LIST = (int*)(ws + WS_LIST) + e * NLAT; int* TOK = (int*)(ws + WS_COMB);
            for (int k = 0; k < nk; ++k) for (int w = 0; w < NWAVES; ++w) { const int r = bid * NWAVES + w + k * G * NWAVES; if (r < nrows) { const LAS int* q = rec + k * 32 + w * 4;
                if (q[0] == e) { LIST[pos] = r; TOK[r * 8 + 0] = e; TOK[r * 8 + 2] = pos; TOK[r * 8 + 4] = q[2]; ++pos; }
                if (q[1] == e) { LIST[pos] = r; TOK[r * 8 + 1] = e; TOK[r * 8 + 3] = pos; TOK[r * 8 + 5] = q[3]; ++pos; } } }
        }
    }
}

__device__ __forceinline__ void phase_post(const Args& a, int l, int lane, int wave, int bid, int G) {
    unsigned char* ws = a.ws;
    bf16_t* P = (bf16_t*)(ws + WS_BIG); bf16_t* MQK = (bf16_t*)(ws + WS_MQK);
    const float* ROPE = (const float*)(ws + WS_ROPE);
    const float* cw = a.in[10] + (size_t)l * 3 * 512; const float* cb = a.in[11] + (size_t)l * 512;
    const float qg = a.in[13][l * 64 + lane], kg = a.in[14][l * 64 + lane];
    for (int r = bid * NWAVES + wave; r < MALL; r += G * NWAVES) {
        const bool lat = r < NLAT; bf16_t* row = P + (size_t)r * NPW;
        int t, tlen; if (lat) { t = r & (SEQ - 1); tlen = SEQ; } else { t = (r - NLAT) & (CTXL - 1); tlen = CTXL; }
        if (lat) { const int gr = t >> 6, gc = t & 63;
#pragma unroll
            for (int blk = 0; blk < 2; ++blk)
#pragma unroll
                for (int ii = 0; ii < 2; ++ii) { const int pid = lane + 64 * ii, head = pid >> 5, half = (pid >> 4) & 1, i = pid & 15, c1 = (blk ? PC_RK : PC_RQ) + head * 64 + half * 32 + i;
                    const int pos = half ? gc : gr; const float cs = ROPE[(pos * 16 + i) * 2], sn = ROPE[(pos * 16 + i) * 2 + 1];
                    const float x1 = bf2f(row[c1]), x2 = bf2f(row[c1 + 16]); const float sc = blk ? 0.125f : 1.0f;
                    row[c1] = (bf16_t)f2bf((x1 * cs - x2 * sn) * sc); row[c1 + 16] = (bf16_t)f2bf((x1 * sn + x2 * cs) * sc); }
        } else {
#pragma unroll
            for (int ii = 0; ii < 4; ++ii) { const int c = PC_RK + lane + 64 * ii; row[c] = (bf16_t)f2bf(bf2f(row[c]) * 0.125f); }
        }
#pragma unroll
        for (int ii = 0; ii < 8; ++ii) { const int c = lane + 64 * ii;
            const float x0 = bf2f(row[PC_MQ + c]);
            const float xm = t > 0 ? bf2f(row[PC_MQ + c - NPW]) : 0.f, xp = t < tlen - 1 ? bf2f(row[PC_MQ + c + NPW]) : 0.f;
            float y = cb[c] + cw[c] * xm + cw[512 + c] * x0 + cw[1024 + c] * xp;
            y = y / (1.0f + __expf(-y)); if (c >= 256) y *= 0.125f;
            MQK[(size_t)r * 512 + c] = (bf16_t)f2bf(y); }
#pragma unroll
        for (int hh = 0; hh < 16; ++hh) { const int c = PC_NQ + hh * 64 + lane; const float v = bf2f(row[c]);
            const float rs = rsqrtf(wave_sum(v * v) * (1.0f / 64.0f) + EPS);
            row[c] = (bf16_t)f2bf(v * rs * (hh < 8 ? qg : kg)); }
    }
}


__device__ __forceinline__ int hl_off(int hl, int c) { return c < 32 ? 32 * hl + c : 128 + 32 * hl + (c - 32); }
__device__ __forceinline__ u32x4 conv8_pack(const bf16_t* P, int row, int ch, bool hasm, bool hasp, const LAS float* CW) {
    const bf16_t* src = P + (size_t)row * NPW + PC_MQ + ch;
    const u32x4 x0 = *(const u32x4*)src; u32x4 xm = {0u, 0u, 0u, 0u}, xp = xm;
    if (hasm) xm = *(const u32x4*)(src - NPW);
    if (hasp) xp = *(const u32x4*)(src + NPW);
    const f32x4 w0a = *(const LAS f32x4*)(CW + ch), w0b = *(const LAS f32x4*)(CW + ch + 4), w1a = *(const LAS f32x4*)(CW + 512 + ch), w1b = *(const LAS f32x4*)(CW + 512 + ch + 4);
    const f32x4 w2a = *(const LAS f32x4*)(CW + 1024 + ch), w2b = *(const LAS f32x4*)(CW + 1024 + ch + 4), ba = *(const LAS f32x4*)(CW + 1536 + ch), bb = *(const LAS f32x4*)(CW + 1536 + ch + 4);
    float y[8];
    y[0] = ba[0] + w0a[0] * bflo(xm.x) + w1a[0] * bflo(x0.x) + w2a[0] * bflo(xp.x); y[1] = ba[1] + w0a[1] * bfhi(xm.x) + w1a[1] * bfhi(x0.x) + w2a[1] * bfhi(xp.x);
    y[2] = ba[2] + w0a[2] * bflo(xm.y) + w1a[2] * bflo(x0.y) + w2a[2] * bflo(xp.y); y[3] = ba[3] + w0a[3] * bfhi(xm.y) + w1a[3] * bfhi(x0.y) + w2a[3] * bfhi(xp.y);
    y[4] = bb[0] + w0b[0] * bflo(xm.z) + w1b[0] * bflo(x0.z) + w2b[0] * bflo(xp.z); y[5] = bb[1] + w0b[1] * bfhi(xm.z) + w1b[1] * bfhi(x0.z) + w2b[1] * bfhi(xp.z);
    y[6] = bb[2] + w0b[2] * bflo(xm.w) + w1b[2] * bflo(x0.w) + w2b[2] * bflo(xp.w); y[7] = bb[3] + w0b[3] * bfhi(xm.w) + w1b[3] * bfhi(x0.w) + w2b[3] * bfhi(xp.w);
    const float sc = ch >= 256 ? 0.125f : 1.0f;
#pragma unroll
    for (int j = 0; j < 8; ++j) y[j] = y[j] / (1.0f + __expf(-y[j])) * sc;
    u32x4 o; o.x = pk2(y[0], y[1]); o.y = pk2(y[2], y[3]); o.z = pk2(y[4], y[5]); o.w = pk2(y[6], y[7]); return o;
}
__device__ __forceinline__ void conv_weights_to_lds(const Args& a, int l, LAS float* CW, int tid) {
    for (int i = tid; i < 2048; i += NTHR) CW[i] = i < 1536 ? a.in[10][(size_t)l * 1536 + i] : a.in[11][(size_t)l * 512 + (i - 1536)];
}
__device__ __forceinline__ int chunk_row0(int b, int dir, int sc) {
    if (dir == 0) return sc < 2 ? NLAT + b * CTXL + 128 * sc : b * SEQ + 128 * (sc - 2);
    return sc < 2 ? NLAT + b * CTXL + 128 * (1 - sc) : b * SEQ + 128 * (17 - sc);
}
constexpr size_t U_BYTES = 80 * 64 * 2;

__device__ __forceinline__ void phase_chunk_sums(const Args& a, int l, LAS unsigned char* lds, int tid, int lane, int wave, int bid, int G) {
    unsigned char* ws = a.ws;
    const bf16_t* P = (const bf16_t*)(ws + WS_BIG);
    const float* GT = (const float*)(ws + WS_GATES);
    LAS unsigned char* Kimg = lds; LAS unsigned char* VFimg = lds + 20480; LAS unsigned char* VBimg = lds + 40960;
    LAS float* wkF = (LAS float*)(lds + 61440); LAS float* wkB = wkF + 128;
    LAS float* CW = (LAS float*)(lds + 62464); conv_weights_to_lds(a, l, CW, tid);
    const int nitems = 2 * NB * 4 * 18;
    for (int it = bid; it < nitems; it += G) {
        const int cc = it % 18; int r_ = it / 18; const int h = r_ & 3; r_ >>= 2; const int b = r_ & 7; const int kind = r_ >> 3;
        const bool isctx = cc >= 16; const int c = isctx ? cc - 16 : cc;
        const int row0 = isctx ? NLAT + b * CTXL + 128 * c : b * SEQ + 128 * c;
        const int scf = isctx ? c : 2 + c, scb = isctx ? 1 - c : 17 - c;
        __syncthreads();
        if (kind == 0) { if (tid < 256) { const int dir = tid >> 7, i = tid & 127; const float lg = logsigmoidf_(a.in[9][(l * 2 + dir) * 4 + h]); (dir ? wkB : wkF)[i] = __expf(lg * (float)(dir == 0 ? 127 - i : i)); } }
        else if (wave < 2) {
            const int dir = wave;
            const float g0i = GT[(size_t)(row0 + lane) * 16 + 4 * dir + h], g1i = GT[(size_t)(row0 + 64 + lane) * 16 + 4 * dir + h];
            const float f0 = logsigmoidf_(GT[(size_t)(row0 + lane) * 16 + 8 + 4 * dir + h]), f1 = logsigmoidf_(GT[(size_t)(row0 + 64 + lane) * 16 + 8 + 4 * dir + h]);
            float s0 = f0, s1 = f1;
#pragma unroll
            for (int o = 1; o < 64; o <<= 1) { const int sl = lane >= o ? lane - o : lane; const float u0 = lane_get(s0, sl), u1 = lane_get(s1, sl); if (lane >= o) { s0 += u0; s1 += u1; } }
            const float t0 = lane_bcast(s0, 63), t1 = lane_bcast(s1, 63), tot = t0 + t1;
            float b0, b1;
            if (dir == 0) { b0 = s0; b1 = t0 + s1; } else { b0 = tot - s0 + f0; b1 = t1 - s1 + f1; }
            const float a0 = g0i - b0, a1 = g1i - b1; const float amax = wave_max(fmaxf(a0, a1));
            float x0 = a0, x1 = a1;
            if (dir == 0) {
#pragma unroll
                for (int o = 1; o < 64; o <<= 1) { const int sl = lane >= o ? lane - o : lane; const float u0 = lane_get(x0, sl), u1 = lane_get(x1, sl); if (lane >= o) { x0 = fmaxf(x0, u0); x1 = fmaxf(x1, u1); } }
                x1 = fmaxf(x1, lane_bcast(x0, 63));
            } else {
#pragma unroll
                for (int o = 1; o < 64; o <<= 1) { const int sl = lane + o < 64 ? lane + o : lane; const float u0 = lane_get(x0, sl), u1 = lane_get(x1, sl); if (lane + o < 64) { x0 = fmaxf(x0, u0); x1 = fmaxf(x1, u1); } }
                x0 = fmaxf(x0, lane_bcast(x1, 0));
            }
            LAS float* wk = dir ? wkB : wkF;
            wk[lane] = __expf(a0 - amax); wk[lane + 64] = __expf(a1 - amax);
            float* ga = (float*)(ws + WS_GARR) + ((size_t)(((b * 4 + h) * 18 + cc) * 2 + dir)) * 384;
            ga[lane] = a0; ga[lane + 64] = a1; ga[128 + lane] = b0; ga[128 + lane + 64] = b1; ga[256 + lane] = x0; ga[256 + lane + 64] = x1;
            if (lane == 0) { float* usc = (float*)(ws + WS_USC) + ((size_t)((b * 4 + h) * 2 + dir) * 18 + (dir ? scb : scf)) * 2; usc[0] = tot; usc[1] = amax; }
        }
        __syncthreads();
        {
            const int r = tid >> 2, c8 = (tid & 3) * 16;
            const bf16_t* vsrc = P + (size_t)(row0 + r) * NPW + (kind == 0 ? PC_RV : PC_MV) + h * 64 + c8;
            u32x4 k0, k1;
            if (kind == 0) { const bf16_t* ksrc = P + (size_t)(row0 + r) * NPW + PC_RK + hl_off(h, c8); k0 = *(const u32x4*)ksrc; k1 = *(const u32x4*)(ksrc + 8); }
            else { const int t = 128 * c + r; const bool hasm = t > 0, hasp = t < (isctx ? CTXL : SEQ) - 1;
                k0 = conv8_pack(P, row0 + r, 256 + h * 64 + c8, hasm, hasp, CW); k1 = conv8_pack(P, row0 + r, 256 + h * 64 + c8 + 8, hasm, hasp, CW);
                bf16_t* mq = (bf16_t*)(ws + WS_MQK) + (size_t)(row0 + r) * 512 + h * 64 + c8;
                *(u32x4*)(mq + 256) = k0; *(u32x4*)(mq + 256 + 8) = k1;
                *(u32x4*)mq = conv8_pack(P, row0 + r, h * 64 + c8, hasm, hasp, CW); *(u32x4*)(mq + 8) = conv8_pack(P, row0 + r, h * 64 + c8 + 8, hasm, hasp, CW); }
            const u32x4 v0 = *(const u32x4*)vsrc, v1 = *(const u32x4*)(vsrc + 8);
            *(LAS u32x4*)(Kimg + r * IST + c8 * 2) = k0; *(LAS u32x4*)(Kimg + r * IST + c8 * 2 + 16) = k1;
#pragma unroll
            for (int dir = 0; dir < 2; ++dir) {
                const float w = (dir ? wkB : wkF)[r]; LAS unsigned char* Vimg = dir ? VBimg : VFimg;
                u32x4 o0, o1;
                o0.x = pk2(bflo(v0.x) * w, bfhi(v0.x) * w); o0.y = pk2(bflo(v0.y) * w, bfhi(v0.y) * w); o0.z = pk2(bflo(v0.z) * w, bfhi(v0.z) * w); o0.w = pk2(bflo(v0.w) * w, bfhi(v0.w) * w);
                o1.x = pk2(bflo(v1.x) * w, bfhi(v1.x) * w); o1.y = pk2(bflo(v1.y) * w, bfhi(v1.y) * w); o1.z = pk2(bflo(v1.z) * w, bfhi(v1.z) * w); o1.w = pk2(bflo(v1.w) * w, bfhi(v1.w) * w);
                *(LAS u32x4*)(Vimg + r * IST + c8 * 2) = o0; *(LAS u32x4*)(Vimg + r * IST + c8 * 2 + 16) = o1;
                if ((tid & 3) == 0) { unsigned zz; asm volatile("v_mov_b32 %0, 0" : "=v"(zz)); u32x4 e0; e0.x = f2bf(w); e0.y = zz; e0.z = zz; e0.w = zz; u32x4 z; z.x = zz; z.y = zz; z.z = zz; z.w = zz;
                    *(LAS u32x4*)(Vimg + r * IST + 128) = e0; *(LAS u32x4*)(Vimg + r * IST + 144) = z; }
            }
        }
        __syncthreads();
        {
            const int dt = wave & 3, dir = wave >> 2; LAS const unsigned char* Vimg = dir ? VBimg : VFimg;
            f32x4 u[5];
#pragma unroll
            for (int et = 0; et < 5; ++et) u[et] = (f32x4){0.f, 0.f, 0.f, 0.f};
#pragma unroll
            for (int ks = 0; ks < 4; ++ks) {
                const bf16x8 af = frag_tr<false>(Kimg, 32 * ks, 16 * dt, lane);
                bf16x8 bx[4]; frag_tr_x4<false>(Vimg, 32 * ks, 0, lane, bx); const bf16x8 b4 = frag_tr<false>(Vimg, 32 * ks, 64, lane);
#pragma unroll
                for (int et = 0; et < 4; ++et) u[et] = mfma16(af, bx[et], u[et]);
                u[4] = mfma16(af, b4, u[4]);
            }
            bf16_t* U = (bf16_t*)(ws + WS_U + ((size_t)(((kind * NB + b) * 4 + h) * 2 + dir) * 18 + (dir ? scb : scf)) * U_BYTES);
            const int g = lane >> 4, e = lane & 15, d0 = 16 * dt + 4 * g;
#pragma unroll
            for (int et = 0; et < 5; ++et) if (et < 4 || kind == 1) { u32x2 w; w.x = pk2(u[et][0], u[et][1]); w.y = pk2(u[et][2], u[et][3]); *(u32x2*)(U + (size_t)(16 * et + e) * 64 + d0) = w; }
        }
    }
}

__device__ __forceinline__ void phase_chunk_states(const Args& a, int l, int tid, int bid, int G) {
    unsigned char* ws = a.ws;
    for (int it = bid; it < 2 * NB * 4 * 2; it += G) {
        const int dir = it & 1, h = (it >> 1) & 3, b = (it >> 3) & 7, kind = it >> 6;
        const size_t seq = (size_t)(((kind * NB + b) * 4 + h) * 2 + dir) * 18;
        const unsigned char* Ub = ws + WS_U + seq * U_BYTES; unsigned char* Sb = ws + WS_S + seq * U_BYTES;
        const float* usc = (const float*)(ws + WS_USC) + (size_t)((b * 4 + h) * 2 + dir) * 18 * 2;
        float* sm = (float*)(ws + WS_SM) + (size_t)((b * 4 + h) * 2 + dir) * 18;
        const float dec_ret = __expf(128.0f * logsigmoidf_(a.in[9][(l * 2 + dir) * 4 + h]));
        float blv[18], amv[18];
#pragma unroll
        for (int s = 0; s < 18; ++s) { blv[s] = kind == 0 ? 0.f : usc[2 * s]; amv[s] = kind == 0 ? 0.f : usc[2 * s + 1]; }
        const int nrow = kind == 0 ? 512 : 520;
        for (int ci = tid; ci < nrow; ci += NTHR) {
            u32x4 v[18];
#pragma unroll
            for (int s = 0; s < 18; ++s) v[s] = *(const u32x4*)(Ub + (size_t)s * U_BYTES + (size_t)ci * 16);
            float acc[8];
#pragma unroll
            for (int j = 0; j < 8; ++j) acc[j] = 0.f;
            float m = 0.f;
#pragma unroll
            for (int s = 0; s < 18; ++s) {
                u32x4 o; o.x = pk2(acc[0], acc[1]); o.y = pk2(acc[2], acc[3]); o.z = pk2(acc[4], acc[5]); o.w = pk2(acc[6], acc[7]);
                *(u32x4*)(Sb + (size_t)s * U_BYTES + (size_t)ci * 16) = o;
                float dk, ck;
                if (kind == 0) { dk = dec_ret; ck = 1.0f; }
                else { if (ci == 0) sm[s] = m; const float bl = blv[s], am = amv[s]; const float mx = fmaxf(m, am); dk = __expf(m - mx); ck = __expf(am - mx); m = bl + mx; }
                acc[0] = dk * acc[0] + ck * bflo(v[s].x); acc[1] = dk * acc[1] + ck * bfhi(v[s].x); acc[2] = dk * acc[2] + ck * bflo(v[s].y); acc[3] = dk * acc[3] + ck * bfhi(v[s].y);
                acc[4] = dk * acc[4] + ck * bflo(v[s].z); acc[5] = dk * acc[5] + ck * bfhi(v[s].z); acc[6] = dk * acc[6] + ck * bflo(v[s].w); acc[7] = dk * acc[7] + ck * bfhi(v[s].w);
            }
        }
    }
}

template <int KIND>
__device__ __forceinline__ float load_state(const unsigned char* ws, int b, int h, int dir, int sc, LAS unsigned char* Simg, int tid) {
    const unsigned char* Sp = ws + WS_S + ((size_t)((((KIND * NB + b) * 4 + h) * 2 + dir) * 18) + sc) * U_BYTES;
    *(LAS u32x4*)(Simg + (tid >> 3) * IST + (tid & 7) * 16) = *(const u32x4*)(Sp + (size_t)tid * 16);
    if (KIND == 1 && tid < 8) *(LAS u32x4*)(Simg + 64 * IST + tid * 16) = *(const u32x4*)(Sp + (size_t)(512 + tid) * 16);
    return KIND == 1 ? ((const float*)(ws + WS_SM))[(size_t)((b * 4 + h) * 2 + dir) * 18 + sc] : 0.f;
}

template <int KIND>
__device__ __forceinline__ void phase_chunk_out(const Args& a, int l, bool need_ctx, LAS unsigned char* lds, int tid, int lane, int wave, int bid, int G) {
    unsigned char* ws = a.ws;
    const bf16_t* P = (const bf16_t*)(ws + WS_BIG);
    const float* GT = (const float*)(ws + WS_GATES); bf16_t* MG = (bf16_t*)(ws + WS_H);
    LAS unsigned char* Qimg = lds; LAS unsigned char* Kimg = lds + 20480; LAS unsigned char* Vimg = lds + 40960;
    LAS unsigned char* SFimg = lds + 61440; LAS unsigned char* SBimg = lds + 74240;
    LAS float* AF = (LAS float*)(lds + 87040); LAS float* CF = AF + 128; LAS float* BF = AF + 256; LAS float* AB = AF + 384; LAS float* CB = AF + 512; LAS float* BB = AF + 640;
    const int nch = need_ctx ? 18 : 16, nitems = NB * 4 * nch;
    const int g = lane >> 4, qi = 16 * wave + (lane & 15);
    for (int it = (bid + G - (KIND == 0 ? 0 : 64) % G) % G; it < nitems; it += G) {
        const int cc = it % nch; const int bh = it / nch; const int h = bh & 3, b = bh >> 2;
        const bool isctx = cc >= 16; const int c = isctx ? cc - 16 : cc;
        const int row0 = isctx ? NLAT + b * CTXL + 128 * c : b * SEQ + 128 * c;
        const int scf = isctx ? c : 2 + c, scb = isctx ? 1 - c : 17 - c;
        __syncthreads();
        {
            const int r = tid >> 2, c8 = (tid & 3) * 16;
            const bf16_t* vsrc = P + (size_t)(row0 + r) * NPW + (KIND == 0 ? PC_RV : PC_MV) + h * 64 + c8;
            u32x4 q0, q1, k0, k1;
            if (KIND == 0) { const bf16_t* qsrc = P + (size_t)(row0 + r) * NPW + PC_RQ + hl_off(h, c8); const bf16_t* ksrc = P + (size_t)(row0 + r) * NPW + PC_RK + hl_off(h, c8);
                q0 = *(const u32x4*)qsrc; q1 = *(const u32x4*)(qsrc + 8); k0 = *(const u32x4*)ksrc; k1 = *(const u32x4*)(ksrc + 8); }
            else { const bf16_t* mq = (const bf16_t*)(ws + WS_MQK) + (size_t)(row0 + r) * 512 + h * 64 + c8;
                q0 = *(const u32x4*)mq; q1 = *(const u32x4*)(mq + 8); k0 = *(const u32x4*)(mq + 256); k1 = *(const u32x4*)(mq + 256 + 8); }
            const u32x4 v0 = *(const u32x4*)vsrc, v1 = *(const u32x4*)(vsrc + 8);
            *(LAS u32x4*)(Qimg + r * IST + c8 * 2) = q0; *(LAS u32x4*)(Qimg + r * IST + c8 * 2 + 16) = q1;
            *(LAS u32x4*)(Kimg + r * IST + c8 * 2) = k0; *(LAS u32x4*)(Kimg + r * IST + c8 * 2 + 16) = k1;
            *(LAS u32x4*)(Vimg + r * IST + c8 * 2) = v0; *(LAS u32x4*)(Vimg + r * IST + c8 * 2 + 16) = v1;
            if ((tid & 3) == 0) { unsigned zz, one; asm volatile("v_mov_b32 %0, 0\n\tv_mov_b32 %1, 0x3f80" : "=v"(zz), "=v"(one)); u32x4 e0; e0.x = one; e0.y = zz; e0.z = zz; e0.w = zz; u32x4 z; z.x = zz; z.y = zz; z.z = zz; z.w = zz;
                *(LAS u32x4*)(Vimg + r * IST + 128) = e0; *(LAS u32x4*)(Vimg + r * IST + 144) = z; }
        }
        const float mpf = load_state<KIND>(ws, b, h, 0, scf, SFimg, tid);
        const float mpb = load_state<KIND>(ws, b, h, 1, scb, SBimg, tid);
        if (KIND == 1) {
            const float* ga = (const float*)(ws + WS_GARR) + (size_t)((b * 4 + h) * 18 + cc) * 768;
            for (int i = tid; i < 768; i += NTHR) { const int dir = i / 384, which = (i - dir * 384) >> 7, j = i & 127; float v = ga[i];
                if (which == 2) v = fmaxf(v, dir ? mpb : mpf);
                AF[dir * 384 + (which == 0 ? 0 : (which == 1 ? 256 : 128)) + j] = v; }
        }
        __syncthreads();
        const bf16x8 bq0 = frag_row(Qimg, 16 * wave, 0, lane), bq1 = frag_row(Qimg, 16 * wave, 32, lane);
        f32x4 st[8];
#pragma unroll
        for (int kt = 0; kt < 8; ++kt) { f32x4 z = {0.f, 0.f, 0.f, 0.f}; z = mfma16(frag_row(Kimg, 16 * kt, 0, lane), bq0, z); st[kt] = mfma16(frag_row(Kimg, 16 * kt, 32, lane), bq1, z); }
        const int row = row0 + qi;
        if (KIND == 0) {
            const float lgf = logsigmoidf_(a.in[9][(l * 2 + 0) * 4 + h]), lgb = logsigmoidf_(a.in[9][(l * 2 + 1) * 4 + h]);
            f32x4 acc[4];
#pragma unroll
            for (int et = 0; et < 4; ++et) {
                f32x4 zf = {0.f, 0.f, 0.f, 0.f}, zb = zf;
                zf = mfma16(frag_row(SFimg, 16 * et, 0, lane), bq0, zf); zf = mfma16(frag_row(SFimg, 16 * et, 32, lane), bq1, zf);
                zb = mfma16(frag_row(SBimg, 16 * et, 0, lane), bq0, zb); zb = mfma16(frag_row(SBimg, 16 * et, 32, lane), bq1, zb);
                acc[et] = zf * __expf(lgf * (float)(qi + 1)) + zb * __expf(lgb * (float)(128 - qi));
            }
#pragma unroll
            for (int T = 0; T < 4; ++T) {
                f32x4 p0, p1;
#pragma unroll
                for (int j = 0; j < 4; ++j) {
                    const int k0 = 32 * T + 4 * g + j, k1 = k0 + 16;
                    const float w0 = (k0 <= qi ? __expf(lgf * (float)(qi - k0)) : 0.f) + (k0 >= qi ? __expf(lgb * (float)(k0 - qi)) : 0.f);
                    const float w1 = (k1 <= qi ? __expf(lgf * (float)(qi - k1)) : 0.f) + (k1 >= qi ? __expf(lgb * (float)(k1 - qi)) : 0.f);
                    p0[j] = st[2 * T][j] * w0; p1[j] = st[2 * T + 1][j] * w1;
                }
                const bf16x8 bp = pack8(p0, p1);
{ bf16x8 va[4]; frag_tr_x4<true>(Vimg, 32 * T, 0, lane, va);
#pragma unroll
                for (int et = 0; et < 4; ++et) acc[et] = mfma16(va[et], bp, acc[et]); }
            }
            float ss = 0.f;
#pragma unroll
            for (int et = 0; et < 4; ++et) ss += (acc[et][0] * acc[et][0] + acc[et][1] * acc[et][1]) + (acc[et][2] * acc[et][2] + acc[et][3] * acc[et][3]);
            ss = sum_g4(ss);
            const float rs = rsqrtf(ss * (1.0f / 64.0f) + EPS);
#pragma unroll
            for (int et = 0; et < 4; ++et) { const int e0 = h * 64 + 16 * et + 4 * g;
                const u32x2 gw = *(const u32x2*)(P + (size_t)row * NPW + PC_RG + e0);
                u32x2 o; o.x = pk2(siluf_(bflo(gw.x)) * acc[et][0] * rs, siluf_(bfhi(gw.x)) * acc[et][1] * rs); o.y = pk2(siluf_(bflo(gw.y)) * acc[et][2] * rs, siluf_(bfhi(gw.y)) * acc[et][3] * rs);
                *(u32x2*)(MG + (size_t)row * DM + e0) = o; }
        } else {
            const float cf = CF[qi], cb = CB[qi];
            const float gf = __expf(mpf - cf), gb = __expf(mpb - cb);
            f32x4 af[5], ab[5];
#pragma unroll
            for (int et = 0; et < 5; ++et) {
                f32x4 zf = {0.f, 0.f, 0.f, 0.f}, zb = zf;
                zf = mfma16(frag_row(SFimg, 16 * et, 0, lane), bq0, zf); zf = mfma16(frag_row(SFimg, 16 * et, 32, lane), bq1, zf);
                zb = mfma16(frag_row(SBimg, 16 * et, 0, lane), bq0, zb); zb = mfma16(frag_row(SBimg, 16 * et, 32, lane), bq1, zb);
                af[et] = zf * gf; ab[et] = zb * gb;
            }
#pragma unroll
            for (int T = 0; T < 4; ++T) {
                const f32x4 a0f = *(const LAS f32x4*)(AF + 32 * T + 4 * g), a1f = *(const LAS f32x4*)(AF + 32 * T + 16 + 4 * g);
                const f32x4 a0b = *(const LAS f32x4*)(AB + 32 * T + 4 * g), a1b = *(const LAS f32x4*)(AB + 32 * T + 16 + 4 * g);
                f32x4 pf0, pf1, pb0, pb1;
#pragma unroll
                for (int j = 0; j < 4; ++j) {
                    const int k0 = 32 * T + 4 * g + j, k1 = k0 + 16;
                    pf0[j] = k0 <= qi ? st[2 * T][j] * __expf(a0f[j] - cf) : 0.f; pf1[j] = k1 <= qi ? st[2 * T + 1][j] * __expf(a1f[j] - cf) : 0.f;
                    pb0[j] = k0 >= qi ? st[2 * T][j] * __expf(a0b[j] - cb) : 0.f; pb1[j] = k1 >= qi ? st[2 * T + 1][j] * __expf(a1b[j] - cb) : 0.f;
                }
                const bf16x8 bpf = pack8(pf0, pf1), bpb = pack8(pb0, pb1);
{ bf16x8 va[4]; frag_tr_x4<true>(Vimg, 32 * T, 0, lane, va); const bf16x8 v4 = frag_tr<true>(Vimg, 32 * T, 64, lane);
#pragma unroll
                for (int et = 0; et < 4; ++et) { af[et] = mfma16(va[et], bpf, af[et]); ab[et] = mfma16(va[et], bpb, ab[et]); }
                af[4] = mfma16(v4, bpf, af[4]); ab[4] = mfma16(v4, bpb, ab[4]); }
            }
            const float denf = lane_get(af[4][0], lane & 15), denb = lane_get(ab[4][0], lane & 15);
            const float nf = 1.0f / fmaxf(fabsf(denf), __expf(-(BF[qi] + cf))), nb = 1.0f / fmaxf(fabsf(denb), __expf(-(BB[qi] + cb)));
            f32x4 y[4]; float ss = 0.f;
#pragma unroll
            for (int et = 0; et < 4; ++et) { y[et] = af[et] * nf + ab[et] * nb; ss += (y[et][0] * y[et][0] + y[et][1] * y[et][1]) + (y[et][2] * y[et][2] + y[et][3] * y[et][3]); }
            ss = sum_g4(ss);
            const float rs = rsqrtf(ss * (1.0f / 64.0f) + EPS);
#pragma unroll
            for (int et = 0; et < 4; ++et) { const int e0 = h * 64 + 16 * et + 4 * g;
                const u32x2 gw = *(const u32x2*)(P + (size_t)row * NPW + PC_MO + e0);
                u32x2 o; o.x = pk2(sigmoidf_(bflo(gw.x)) * y[et][0] * rs, sigmoidf_(bfhi(gw.x)) * y[et][1] * rs); o.y = pk2(sigmoidf_(bflo(gw.y)) * y[et][2] * rs, sigmoidf_(bfhi(gw.y)) * y[et][3] * rs);
                *(u32x2*)(MG + (size_t)row * DM + 256 + e0) = o; }
        }
    }
}

struct NaItem { int b, h, r0, ur0, nlb, lat, qrow0; };
__device__ __forceinline__ NaItem na_decode(int it) {
    NaItem t;
    if (it < 512) { t.lat = 1; const int rg = it & 7; t.h = (it >> 3) & 7; t.b = it >> 6; t.r0 = 4 * rg; t.ur0 = min(max(t.r0 - 4, 0), NROWS - 8);
        const int last = min(max(t.r0 - 1, 0), NROWS - 8) + 7; t.nlb = (last - t.ur0 + 4) >> 2; t.qrow0 = t.b * SEQ + t.r0 * 64; }
    else { const int j = it - 512; t.lat = 0; t.h = j & 7; t.b = j >> 3; t.r0 = 0; t.ur0 = 0; t.nlb = 0; t.qrow0 = NLAT + t.b * CTXL; }
    return t;
}
__device__ __forceinline__ int na_krow0(const NaItem& t, int step) { return step == 0 ? NLAT + t.b * CTXL : t.b * SEQ + (t.ur0 + 4 * (step - 1)) * 64; }
struct NaKV { u32x4 k[4], v[4]; };
__device__ __forceinline__ void na_load_kv(NaKV& x, const bf16_t* P, int krow0, int h, int tid) {
    const int rr = tid >> 1, c0 = (tid & 1) * 32; const bf16_t* ks = P + (size_t)(krow0 + rr) * NPW + PC_NK + 256 * (h >> 2) + hl_off(h & 3, c0); const bf16_t* vs = P + (size_t)(krow0 + rr) * NPW + PC_NV + h * 64 + c0;
#pragma unroll
    for (int i = 0; i < 4; ++i) { x.k[i] = *(const u32x4*)(ks + 8 * i); x.v[i] = *(const u32x4*)(vs + 8 * i); }
}
struct NaQ { u32x4 q[4]; };
__device__ __forceinline__ void na_load_q(NaQ& x, const bf16_t* P, int qrow0, int h, int tid) {
    const bf16_t* qs = P + (size_t)(qrow0 + (tid >> 1)) * NPW + PC_NQ + 256 * (h >> 2) + hl_off(h & 3, (tid & 1) * 32);
#pragma unroll
    for (int i = 0; i < 4; ++i) x.q[i] = *(const u32x4*)(qs + 8 * i);
}
struct NaState { float m, l; f32x4 acc[4]; };
template <int NPAIR, unsigned VALID>
__device__ __forceinline__ void na_update(NaState& st, const f32x4 (&s)[2 * NPAIR], float mx, LAS const unsigned char* Vimg, int vrow0, int lane) {
    mx = max_g4(mx);
    const float m_new = fmaxf(st.m, mx), resc = __builtin_amdgcn_exp2f(st.m - m_new);
    st.m = m_new; st.l *= resc;
#pragma unroll
    for (int et = 0; et < 4; ++et) st.acc[et] = st.acc[et] * resc;
#pragma unroll
    for (int T = 0; T < NPAIR; ++T) {
        if (((VALID >> (2 * T)) & 3u) != 0u) {
            f32x4 p0 = {0.f, 0.f, 0.f, 0.f}, p1 = p0;
            if ((VALID >> (2 * T)) & 1u) {
#pragma unroll
                for (int j = 0; j < 4; ++j) p0[j] = __builtin_amdgcn_exp2f(s[2 * T][j] - m_new);
                st.l += (p0[0] + p0[1]) + (p0[2] + p0[3]); }
            if ((VALID >> (2 * T + 1)) & 1u) {
#pragma unroll
                for (int j = 0; j < 4; ++j) p1[j] = __builtin_amdgcn_exp2f(s[2 * T + 1][j] - m_new);
                st.l += (p1[0] + p1[1]) + (p1[2] + p1[3]); }
            asm volatile("" : "+v"(st.l));
            const bf16x8 bp = pack8(p0, p1);
            bf16x8 va[4]; frag_tr_x4<true>(Vimg, vrow0 + 32 * T, 0, lane, va);
#pragma unroll
            for (int et = 0; et < 4; ++et) st.acc[et] = mfma16(va[et], bp, st.acc[et]);
            __builtin_amdgcn_sched_barrier(0);
        }
    }
}
template <int QTA>
__device__ __forceinline__ void na_local_row(NaState& st, const bf16x8& bq0, const bf16x8& bq1, LAS const unsigned char* Kimg, LAS const unsigned char* Vimg, LAS const float* browb, int irow0, int lane) {
    constexpr int tlo = (16 * QTA - 8 < 0 ? 0 : (16 * QTA - 8 > 48 ? 48 : 16 * QTA - 8)), thi = (16 * QTA + 7 > 48 ? 48 : 16 * QTA + 7) + 15;
    constexpr unsigned VALID = ((15 >= tlo && 0 <= thi) ? 1u : 0u) | ((31 >= tlo && 16 <= thi) ? 2u : 0u) | ((47 >= tlo && 32 <= thi) ? 4u : 0u) | ((63 >= tlo && 48 <= thi) ? 8u : 0u);
    const int g = lane >> 4, ql = 16 * QTA + (lane & 15), scq = min(max(ql - 8, 0), GRIDW - 16);
    f32x4 s[4]; float mx = -1.0e30f;
#pragma unroll
    for (int ct = 0; ct < 4; ++ct) {
        if ((VALID >> ct) & 1u) {
            f32x4 z = {0.f, 0.f, 0.f, 0.f}; z = mfma16(frag_row(Kimg, irow0 + 16 * ct, 0, lane), bq0, z); z = mfma16(frag_row(Kimg, irow0 + 16 * ct, 32, lane), bq1, z);
            const LAS float* brow = browb + (16 * ct + 4 * g - ql + 63); const int t0 = 16 * ct + 4 * g - scq;
#pragma unroll
            for (int j = 0; j < 4; ++j) { const float bv = brow[j]; const float zz = z[j] * 0.18033688f + bv; z[j] = ((unsigned)(t0 + j) < 16u) ? zz : -1.0e30f; }
            s[ct] = z; mx = fmaxf(mx, fmaxf(fmaxf(z[0], z[1]), fmaxf(z[2], z[3]))); asm volatile("" ::: "memory");
        } else s[ct] = (f32x4){-1.0e30f, -1.0e30f, -1.0e30f, -1.0e30f};
    }
    na_update<2, VALID>(st, s, mx, Vimg, irow0, lane);
    __builtin_amdgcn_sched_barrier(0);
}
template <int QTA>
__device__ __forceinline__ void na_local_q(NaState& st, LAS const unsigned char* Qimg, LAS const unsigned char* Kimg, LAS const unsigned char* Vimg, LAS const float* RPB, int qimg_row, int lane, int kkb, int srw, int qrw) {
    const bf16x8 bq0 = frag_row(Qimg, qimg_row, 0, lane), bq1 = frag_row(Qimg, qimg_row, 32, lane);
#pragma unroll
    for (int kkl = 0; kkl < 4; ++kkl) { const int kk = kkb + kkl;
        if (kk >= srw && kk < srw + 8) na_local_row<QTA>(st, bq0, bq1, Kimg, Vimg, RPB + (kk - qrw + 7) * 128, 64 * kkl, lane); }
}
template <int WP>
__device__ __forceinline__ void na_local_step(NaState (&st)[2], LAS const unsigned char* Qimg, LAS const unsigned char* Kimg, LAS const unsigned char* Vimg, LAS const float* RPB, int wave, int lane, int kkb, int srw, int qrw) {
    na_local_q<2 * WP>(st[0], Qimg, Kimg, Vimg, RPB, 32 * wave, lane, kkb, srw, qrw);
    na_local_q<2 * WP + 1>(st[1], Qimg, Kimg, Vimg, RPB, 32 * wave + 16, lane, kkb, srw, qrw);
}
__device__ __forceinline__ void phase_natt_mfma(const Args& a, int l, bool need_ctx, LAS unsigned char* lds, int tid, int lane, int wave, int bid, int G) {
    unsigned char* ws = a.ws;
    const bf16_t* P = (const bf16_t*)(ws + WS_BIG); bf16_t* MG = (bf16_t*)(ws + WS_H);
    LAS unsigned char* Qimg = lds; LAS unsigned char* Kimg = lds + 40960; LAS unsigned char* Vimg = lds + 81920;
    LAS float* RPB = (LAS float*)(lds + 122880);
    const int nitems = 512 + (need_ctx ? NB * 8 : 0);
    const int g = lane >> 4;
    int it = (bid + G - 128 % G) % G; if (it >= nitems) return;
    NaItem cur = na_decode(it);
    NaKV kv; na_load_kv(kv, P, na_krow0(cur, 0), cur.h, tid);
    float rpbreg[4];
#pragma unroll
    for (int k = 0; k < 4; ++k) { const int idx = tid + 512 * k, dr = idx >> 7, dc = (idx & 127) - 48; rpbreg[k] = (idx < 1920 && dc >= 0 && dc <= 30) ? a.in[15][(size_t)(l * 8 + cur.h) * 465 + dr * 31 + dc] * 1.44269504f : 0.f; }
    for (;;) {
        const int itn = it + G; const bool has_next = itn < nitems; NaItem nxt = cur; if (has_next) nxt = na_decode(itn);
        const int nsteps = 1 + cur.nlb;
        const int qrw = cur.r0 + (wave >> 1), srw = min(max(qrw - 4, 0), NROWS - 8);
        NaState st[2];
#pragma unroll
        for (int q2 = 0; q2 < 2; ++q2) { st[q2].m = -1.0e30f; st[q2].l = 0.f;
#pragma unroll
            for (int et = 0; et < 4; ++et) st[q2].acc[et] = (f32x4){0.f, 0.f, 0.f, 0.f}; }
        for (int step = 0; step < nsteps; ++step) {
            int ts = tid; asm volatile("" : "+v"(ts));
            __syncthreads();
            { const int rr = ts >> 1, c0 = (ts & 1) * 32;
#pragma unroll
              for (int i = 0; i < 4; ++i) { *(LAS u32x4*)(Kimg + rr * IST + (c0 + 8 * i) * 2) = kv.k[i]; *(LAS u32x4*)(Vimg + rr * IST + (c0 + 8 * i) * 2) = kv.v[i]; }
              if (step == 0) { NaQ qr_; na_load_q(qr_, P, cur.qrow0, cur.h, ts);
#pragma unroll
                  for (int i = 0; i < 4; ++i) *(LAS u32x4*)(Qimg + rr * IST + (c0 + 8 * i) * 2) = qr_.q[i];
#pragma unroll
                  for (int k = 0; k < 4; ++k) if (ts + 512 * k < 1920) RPB[ts + 512 * k] = rpbreg[k]; } }
            __syncthreads();
            int tq = ts;
            if (step + 1 < nsteps) na_load_kv(kv, P, na_krow0(cur, step + 1), cur.h, tq);
            else if (has_next) { na_load_kv(kv, P, na_krow0(nxt, 0), nxt.h, tq);
#pragma unroll
                for (int k = 0; k < 4; ++k) { const int idx = tq + 512 * k, dr = idx >> 7, dc = (idx & 127) - 48; rpbreg[k] = (idx < 1920 && dc >= 0 && dc <= 30) ? a.in[15][(size_t)(l * 8 + nxt.h) * 465 + dr * 31 + dc] * 1.44269504f : 0.f; } }
            const int ln = ts & 63;
            if (step == 0) {
#pragma unroll
                for (int q2 = 0; q2 < 2; ++q2) {
                    const bf16x8 bq0 = frag_row(Qimg, 32 * wave + 16 * q2, 0, ln), bq1 = frag_row(Qimg, 32 * wave + 16 * q2, 32, ln);
#pragma unroll
                    for (int hf = 0; hf < 2; ++hf) {
                        f32x4 s[8]; float mx = -1.0e30f;
#pragma unroll
                        for (int t8 = 0; t8 < 8; ++t8) { f32x4 z = {0.f, 0.f, 0.f, 0.f}; z = mfma16(frag_row(Kimg, 128 * hf + 16 * t8, 0, ln), bq0, z); z = mfma16(frag_row(Kimg, 128 * hf + 16 * t8, 32, ln), bq1, z);
                            z = z * 0.18033688f; s[t8] = z; mx = fmaxf(mx, fmaxf(fmaxf(z[0], z[1]), fmaxf(z[2], z[3]))); if (t8 & 1) asm volatile("" ::: "memory"); }
                        na_update<4, 0xFFu>(st[q2], s, mx, Vimg, 128 * hf, ln);
                        __builtin_amdgcn_sched_barrier(0);
                    }
                }
            } else {
                const int kkb = cur.ur0 + 4 * (step - 1);
                if (wave & 1) na_local_step<1>(st, Qimg, Kimg, Vimg, RPB, wave, ln, kkb, srw, qrw);
                else          na_local_step<0>(st, Qimg, Kimg, Vimg, RPB, wave, ln, kkb, srw, qrw);
            }
        }
        int lf = lane; asm volatile("" : "+v"(lf)); const int gf = lf >> 4;
#pragma unroll
        for (int q2 = 0; q2 < 2; ++q2) {
            const float inv = 1.0f / sum_g4(st[q2].l);
            const int row = cur.qrow0 + 32 * wave + 16 * q2 + (lf & 15);
#pragma unroll
            for (int et = 0; et < 4; ++et) { u32x2 w; w.x = pk2(st[q2].acc[et][0] * inv, st[q2].acc[et][1] * inv); w.y = pk2(st[q2].acc[et][2] * inv, st[q2].acc[et][3] * inv);
                *(u32x2*)(MG + (size_t)row * DM + 512 + cur.h * 64 + 16 * et + 4 * gf) = w; }
        }
        if (!has_next) break;
        it = itn; cur = nxt;
    }
}

constexpr int MOE_TAB_OFF = 131072;
__device__ __forceinline__ void moe_tab_setup(const unsigned char* ws, LAS unsigned char* lds, int tid) {
    if (tid == 0) { LAS int* tab = (LAS int*)(lds + MOE_TAB_OFF); int p = 0;
        for (int e = 0; e < NEXP; ++e) { const int c = (int)__hip_atomic_load((const unsigned*)(ws + WS_CTL) + CW_MOE + 64 * e, __ATOMIC_RELAXED, __HIP_MEMORY_SCOPE_AGENT); tab[e] = p; tab[16 + e] = c; p += (c + 255) >> 8; }
        tab[8] = p; }
    __syncthreads();
}
namespace pg8 {
struct MoeOrder : StaticOrder {
    const PG8_LAS int* tab; const int* list; size_t bstride;
    __device__ __forceinline__ int expert(int pm) const { int e = 0;
#pragma unroll
        for (int k = 1; k < 8; ++k) e += (pm >= tab[k]) ? 1 : 0;
        return e; }
    const PG8_LAS int* rowtab;
    __device__ __forceinline__ unsigned arow(const Unit& u, int R) const {
        const int Rr = (u.hs > 0 ? HALF : 0) + (u.hs >= 0 ? (R & (HALF - 1)) : R);
        if (!list) return (unsigned)(u.pm * BM + Rr);
        return (unsigned)rowtab[u.idx * BM + Rr]; }
    __device__ __forceinline__ unsigned arow_global(const Unit& u, int Rr) const { const int e = expert(u.pm), idx = (u.pm - tab[e]) * BM + Rr; return idx < tab[16 + e] ? (unsigned)list[e * NLAT + idx] : 0u; }
    __device__ __forceinline__ const char* bbase(const Unit& u) const { return Bt + (size_t)expert(u.pm) * bstride + (size_t)u.pn * BM * K2; }
};
}
constexpr int MOE_ROWTAB_OFF = 131072 + 256, MOE_ROWTAB_UNITS = 15;
__device__ __forceinline__ void moe_rowtab_fill(const pg8::MoeOrder& S, LAS unsigned char* lds, int tid) {
    LAS int* rt = (LAS int*)(lds + MOE_ROWTAB_OFF);
    for (int i = 0; i < MOE_ROWTAB_UNITS; ++i) { pg8::Unit u; if (!S.next(i, u)) break; if (tid < 256) rt[i * 256 + tid] = (int)S.arow_global(u, tid); }
    __syncthreads();
}
__device__ __forceinline__ void phase_moe_combine(const Args& a, LAS unsigned char* lds, int lane, int wave, int bid, int G) {
    unsigned char* ws = a.ws; const LAS int* tab = (const LAS int*)(lds + MOE_TAB_OFF);
    const int* TOK = (const int*)(ws + WS_COMB); const bf16_t* Y = (const bf16_t*)(ws + WS_WTMUP);
    const float* g2 = (const float*)(ws + WS_MOD) + (size_t)9 * 6144 + 5120;
    for (int r0 = bid * NWAVES + wave; r0 < NLAT; r0 += 2 * G * NWAVES) {
        const bf16_t* y1[2]; const bf16_t* y2[2]; float w1[2], w2[2]; bool ok[2];
#pragma unroll
        for (int u = 0; u < 2; ++u) { const int r = r0 + u * G * NWAVES; ok[u] = r < NLAT; const int rr = ok[u] ? r : r0;
            const int e1 = TOK[rr * 8], e2 = TOK[rr * 8 + 1], p1 = TOK[rr * 8 + 2], p2 = TOK[rr * 8 + 3]; w1[u] = __int_as_float(TOK[rr * 8 + 4]); w2[u] = __int_as_float(TOK[rr * 8 + 5]);
            y1[u] = Y + ((size_t)tab[e1] * 256 + p1) * DM; y2[u] = Y + ((size_t)tab[e2] * 256 + p2) * DM; }
#pragma unroll
        for (int u = 0; u < 2; ++u) if (ok[u]) { const int r = r0 + u * G * NWAVES;
            const float* gr = g2 + (size_t)(r >> 11) * 6144; float* o = a.out + (size_t)r * DM;
#pragma unroll
            for (int j = 0; j < 4; ++j) { const int k = 4 * lane + 256 * j;
                const u32x2 a1 = *(const u32x2*)(y1[u] + k), a2 = *(const u32x2*)(y2[u] + k); const f32x4 x = *(const f32x4*)(o + k), gg = *(const f32x4*)(gr + k);
                f32x4 mm; mm.x = w1[u] * bflo(a1.x) + w2[u] * bflo(a2.x); mm.y = w1[u] * bfhi(a1.x) + w2[u] * bfhi(a2.x); mm.z = w1[u] * bflo(a1.y) + w2[u] * bflo(a2.y); mm.w = w1[u] * bfhi(a1.y) + w2[u] * bfhi(a2.y);
                *(f32x4*)(o + k) = x + gg * mm; } }
    }
}
#ifndef DUP_VIRT
#define DUP_VIRT (-1)
#endif
#define PH_REP_OPEN
#define PH_REP_CLOSE
#ifndef DUP_PH
#define DUP_PH (-1)
#endif
#ifndef PH_ONLY
#define PH_ONLY 0
#endif
#ifndef MIX_NAIVE
#define MIX_NAIVE 0
#endif
#ifndef MIX_RET
#define MIX_RET 1
#endif
#ifndef MIX_ML
#define MIX_ML 1
#endif
#ifndef MIX_NA
#define MIX_NA 1
#endif
#ifndef EN_PRO
#define EN_PRO 1
#endif
#ifndef EN_NORM
#define EN_NORM 1
#endif
#ifndef EN_GIN
#define EN_GIN 1
#endif
#ifndef EN_POST
#define EN_POST 1
#endif
#ifndef EN_FCUM
#define EN_FCUM 1
#endif
#ifndef EN_QUAD
#define EN_QUAD 1
#endif
#ifndef EN_NATT
#define EN_NATT 1
#endif
#ifndef EN_MERGE
#define EN_MERGE 1
#endif
#ifndef EN_GOUT
#define EN_GOUT 1
#endif
#ifndef EN_NORM2
#define EN_NORM2 1
#endif
#ifndef EN_GUP
#define EN_GUP 1
#endif
#ifndef EN_GDN
#define EN_GDN 1
#endif

__global__ void __launch_bounds__(NTHR, 2) fwd_kernel(Args a_) {
    extern __shared__ __attribute__((aligned(16))) unsigned char lds_raw[];
    LAS unsigned char* lds = (LAS unsigned char*)lds_raw;
    const int tid0 = threadIdx.x, G = gridDim.x, bid = blockIdx.x; const int wave0 = __builtin_amdgcn_readfirstlane(tid0 >> 6);
    unsigned char* ws0 = a_.ws;
    volatile LAS unsigned* MISC = (volatile LAS unsigned*)(lds + MISC_OFF);
    if (tid0 < 32) MISC[tid0] = 0u;
    __syncthreads();
    const int lo = a_.ph_lo, hi = a_.ph_hi;
    XcdBarrier bar; bar.bar = (unsigned*)(ws0 + WS_CTL) + CW_BAR; bar.x = 0; bar.st = MISC + 8;
    if (hi - lo > 1) bar = xcd_barrier_post((unsigned*)(ws0 + WS_CTL) + CW_BAR, MISC + 8);
    int ph = 0;
#define PH_BEGIN if (ph >= lo && ph < hi) { asm volatile("; PHMARK_BEGIN %0" :: "i"(__LINE__)); int tid; asm volatile("v_mbcnt_lo_u32_b32 %0, -1, 0\n\tv_mbcnt_hi_u32_b32 %0, -1, %0" : "=v"(tid)); tid += wave0 * 64; Args a; { const __attribute__((address_space(4))) Args* ap = (const __attribute__((address_space(4))) Args*)__builtin_amdgcn_kernarg_segment_ptr(); asm volatile("" : "+s"(ap)); a = *(const Args*)ap; } unsigned char* ws = a.ws; (void)ws; PH_REP_OPEN if (PH_ONLY == 0 || PH_ONLY == __LINE__) { const int lane = tid & 63, wave = __builtin_amdgcn_readfirstlane(tid >> 6); (void)lane; (void)wave;
#define PH_END   } PH_REP_CLOSE asm volatile("; PHMARK_END %0" :: "i"(__LINE__)); if (ph + 1 < hi) xcd_barrier(bar); else __syncthreads(); } ++ph;

    PH_BEGIN
#if EN_PRO
 phase_prologue(a, lds, tid, lane, wave, bid, G);
#endif
 PH_END

    for (int l = 0; l < 2; ++l) {
        const bool need_ctx = (l == 0);
#define MODP ((const float*)(ws + WS_MOD) + (size_t)l * 9 * 6144)
        PH_BEGIN
#if EN_NORM
 phase_norm1(a, l, lds, tid, lane, wave, bid, G);
#endif
 PH_END
        PH_BEGIN
#if EN_GIN
 { pg8::Gemm g{(const bf16_t*)(ws + WS_H), (const bf16_t*)(ws + WS_WTIN) + (size_t)l * NPW * DM, MALL, NPW, DM / 2};
                   pg8::StaticOrder S; S.init(MALL, NPW, G, bid); S.Bt = (const char*)g.Bt; S.K2 = 2 * DM;
                   pg8::EpiProjI8 E{(bf16_t*)(ws + WS_BIG), NPW, (const float*)(ws + WS_ROPE), a.in[13] + l * 64, a.in[14] + l * 64, NLAT / 256, (const float*)(ws + WS_HS), (const unsigned*)(ws + WS_CTL) + CW_COLMAX + l * NPW};
                   pg8::gemm_phase<pg8::EpiProjI8, pg8::StaticOrder, false>(lds, g, S, E, nullptr, tid); }
#endif
 PH_END
        PH_BEGIN
#if MIX_RET || MIX_ML
        phase_chunk_sums(a, l, lds, tid, lane, wave, bid, G);
#endif
        PH_END
        PH_BEGIN phase_chunk_states(a, l, tid, bid, G); if (bid >= 128) convert_window(a, lds, lane, wave, G, l, bid - 128); PH_END
        PH_BEGIN
#if MIX_RET
        phase_chunk_out<0>(a, l, need_ctx, lds, tid, lane, wave, bid, G);
#endif
#if MIX_ML
        phase_chunk_out<1>(a, l, need_ctx, lds, tid, lane, wave, bid, G);
#endif
#if MIX_NA
        phase_natt_mfma(a, l, need_ctx, lds, tid, lane, wave, bid, G);
#endif
        PH_END
        PH_BEGIN
#if EN_GOUT
 { const int M = need_ctx ? MALL : NLAT;
                   pg8::Gemm g{(const bf16_t*)(ws + WS_H), (const bf16_t*)(ws + WS_WTOUT) + (size_t)l * DM * DM, M, DM, DM};
                   pg8::StaticOrder S; S.init(M, DM, G, bid); S.Bt = (const char*)g.Bt; S.K2 = 2 * DM;
                   pg8::EpiResid E{l == 0 ? a.in[0] : a.out, l == 0 ? a.in[2] : (const float*)(ws + WS_XC), a.out, (float*)(ws + WS_XC), MODP + 2048, nullptr, 0, NLAT / 256};
                   pg8::gemm_phase<pg8::EpiResid, pg8::StaticOrder, false>(lds, g, S, E, nullptr, tid); }
#endif
 PH_END
        if (l == 0) { PH_BEGIN
#if EN_NORM2
 phase_norm<1>(a, l, lds, tid, lane, wave, bid, G);
#endif
 PH_END }
        else        { PH_BEGIN
#if EN_NORM2
 phase_norm<2>(a, l, lds, tid, lane, wave, bid, G);
#endif
 PH_END }
        if (l == 0) {
            PH_BEGIN { pg8::Gemm g{(const bf16_t*)(ws + WS_H), (const bf16_t*)(ws + WS_WTUP), MALL, NUP, DM / 2};
                       pg8::StaticOrder S; S.init(MALL, NUP, G, bid); S.Bt = (const char*)g.Bt; S.K2 = 2 * DM;
                       pg8::EpiSwiGLUI8 E{(bf16_t*)(ws + WS_BIG), DFF, (const float*)(ws + WS_HS), (const unsigned*)(ws + WS_CTL) + CW_COLMAX + 2 * NPW, nullptr, nullptr, 0};
                       pg8::gemm_phase<pg8::EpiSwiGLUI8, pg8::StaticOrder, false>(lds, g, S, E, nullptr, tid); } PH_END
            PH_BEGIN { pg8::Gemm g{(const bf16_t*)(ws + WS_BIG), (const bf16_t*)(ws + WS_WTDN), MALL, DM, DFF};
                       pg8::StaticOrder S; S.init(MALL, DM, G, bid); S.Bt = (const char*)g.Bt; S.K2 = 2 * DFF;
                       pg8::EpiResid E{a.out, (const float*)(ws + WS_XC), a.out, (float*)(ws + WS_XC), MODP + 5120, nullptr, 0, NLAT / 256};
                       pg8::gemm_phase<pg8::EpiResid, pg8::StaticOrder, false>(lds, g, S, E, nullptr, tid); } PH_END
        } else {
            PH_BEGIN { moe_tab_setup(ws, lds, tid); const LAS int* tab = (const LAS int*)(lds + MOE_TAB_OFF);
                       pg8::Gemm g{(const bf16_t*)(ws + WS_H), (const bf16_t*)(ws + WS_WTMUP), 256 * tab[8], NUP, DM / 2};
                       pg8::MoeOrder S; S.init(256 * tab[8], NUP, G, bid); S.Bt = (const char*)g.Bt; S.K2 = 2 * DM; S.tab = tab; S.list = (const int*)(ws + WS_LIST); S.bstride = (size_t)NUP * DM * 2; S.rowtab = (const LAS int*)(lds + MOE_ROWTAB_OFF); moe_rowtab_fill(S, lds, tid);
                       pg8::EpiSwiGLUI8 E{(bf16_t*)(ws + WS_BIG), DFF, (const float*)(ws + WS_HS), (const unsigned*)(ws + WS_CTL) + CW_COLMAX + 2 * NPW + NUP, tab, (const LAS int*)(lds + MOE_ROWTAB_OFF), NUP};
                       pg8::gemm_phase<pg8::EpiSwiGLUI8, pg8::MoeOrder, false>(lds, g, S, E, nullptr, tid); } PH_END
            PH_BEGIN { moe_tab_setup(ws, lds, tid); const LAS int* tab = (const LAS int*)(lds + MOE_TAB_OFF);
                       pg8::Gemm g{(const bf16_t*)(ws + WS_BIG), (const bf16_t*)(ws + WS_WTMDN), 256 * tab[8], DM, DFF};
                       pg8::MoeOrder S; S.init(256 * tab[8], DM, G, bid); S.Bt = (const char*)g.Bt; S.K2 = 2 * DFF; S.tab = tab; S.list = nullptr; S.rowtab = nullptr; S.bstride = (size_t)DM * DFF * 2;
                       pg8::EpiBf16 E{(bf16_t*)(ws + WS_WTMUP), DM};
                       pg8::gemm_phase<pg8::EpiBf16, pg8::MoeOrder, false>(lds, g, S, E, nullptr, tid); } PH_END
            PH_BEGIN { moe_tab_setup(ws, lds, tid); phase_moe_combine(a, lds, lane, wave, bid, G); } PH_END
        }
    }
#if N_LAUNCH_MODE == 1
    if (lo >= 100) {
        int tid; asm volatile("v_mbcnt_lo_u32_b32 %0, -1, 0\n\tv_mbcnt_hi_u32_b32 %0, -1, %0" : "=v"(tid)); tid += wave0 * 64; const int lane = tid & 63, wave = wave0;
        Args a = a_;
        if (lo == 100) phase_chunk_out<0>(a, 0, true, lds, tid, lane, wave, bid, G);
        if (lo == 101) phase_chunk_out<1>(a, 0, true, lds, tid, lane, wave, bid, G);
        if (lo == 102) phase_natt_mfma(a, 0, true, lds, tid, lane, wave, bid, G);
        if (lo == 103) { unsigned char* ws = a.ws; pg8::Gemm g{(const bf16_t*)(ws + WS_H), (const bf16_t*)(ws + WS_WTIN), MALL, NPW, DM};
                   pg8::StaticOrder S; S.init(MALL, NPW, G, bid); S.Bt = (const char*)g.Bt; S.K2 = 2 * DM; pg8::EpiNull E{(bf16_t*)(ws + WS_BIG), NPW};
                   pg8::gemm_phase<pg8::EpiNull, pg8::StaticOrder, false>(lds, g, S, E, nullptr, tid); }
    }
#endif
#undef PH_BEGIN
#undef PH_END
}
constexpr int N_PHASES = 1 + 2 * 7 + 2 + 3;
#ifndef DBG_MAXPH
#define DBG_MAXPH 1000
#endif

extern "C" void kernel_launch(void* const* d_in, const int* in_sizes, int n_in, void* d_out, int out_size, void* d_ws, size_t ws_size, hipStream_t stream) {
    static int grid = 0;
    if (grid == 0) {
        if (n_in != 24 || out_size != NLAT * DM || ws_size < WS_END) { fprintf(stderr, "kernel_launch: unexpected sizes (n_in %d, out %d, ws %zu < %zu); nothing launched\n", n_in, out_size, ws_size, (size_t)WS_END); grid = -1; return; }
        int dev = 0, cus = 0;
        if (hipGetDevice(&dev) != hipSuccess || hipDeviceGetAttribute(&cus, hipDeviceAttributeMultiprocessorCount, dev) != hipSuccess) { grid = -1; return; }
        if (hipFuncSetAttribute((const void*)fwd_kernel, hipFuncAttributeMaxDynamicSharedMemorySize, LDS_BYTES) != hipSuccess) { fprintf(stderr, "kernel_launch: hipFuncSetAttribute failed\n"); grid = -1; return; }
        int per_cu = 0;
        if (hipOccupancyMaxActiveBlocksPerMultiprocessor(&per_cu, (const void*)fwd_kernel, NTHR, LDS_BYTES) != hipSuccess || per_cu < 1) { fprintf(stderr, "kernel_launch: occupancy query says %d\n", per_cu); }
        (void)hipGetLastError();
        grid = cus;
    }
    if (grid < 0) return;
    (void)hipMemsetAsync((char*)d_ws + WS_CTL, 0, CTL_BYTES, stream);
    Args a{};
    for (int i = 0; i < 24; ++i) a.in[i] = (const float*)d_in[i];
    a.out = (float*)d_out; a.ws = (unsigned char*)d_ws;
#if N_LAUNCH_MODE == 0
    a.ph_lo = 0; a.ph_hi = N_PHASES;
    hipLaunchKernelGGL(fwd_kernel, dim3(grid), dim3(NTHR), LDS_BYTES, stream, a);
#else
    for (int p = 0; p < N_PHASES && p < DBG_MAXPH; ++p) { a.ph_lo = p; a.ph_hi = p + 1; hipLaunchKernelGGL(fwd_kernel, dim3(grid), dim3(NTHR), LDS_BYTES, stream, a);
        if (p == DUP_PH) hipLaunchKernelGGL(fwd_kernel, dim3(grid), dim3(NTHR), LDS_BYTES, stream, a);
        if (p == 5 && DUP_VIRT >= 100) { a.ph_lo = DUP_VIRT; a.ph_hi = DUP_VIRT + 1; hipLaunchKernelGGL(fwd_kernel, dim3(grid), dim3(NTHR), LDS_BYTES, stream, a); } }
#endif
}
```

```cpp
#include <hip/hip_runtime.h>
#include <stdio.h>
#include <stdint.h>

#ifndef N_LAUNCH_MODE
#define N_LAUNCH_MODE 0
#endif

constexpr int NB = 8, SEQ = 2048, DM = 1024, CTXL = 256, HD = 64;
constexpr int NLAT = NB * SEQ, NCTX = NB * CTXL, MALL = NLAT + NCTX;
constexpr int DIN = 3600, NPW = 3584;
constexpr int DFF = 2816, NUP = 2 * DFF, NEXP = 8;
constexpr int GRIDW = 64, NROWS = 32;
constexpr float EPS = 1e-6f;
constexpr int PC_RQ = 0, PC_RK = 256, PC_RV = 512, PC_RG = 768, PC_MQ = 1024, PC_MK = 1280, PC_MV = 1536, PC_MO = 1792, PC_NQ = 2048, PC_NK = 2560, PC_NV = 3072;

constexpr size_t al256(size_t x) { return (x + 255) & ~(size_t)255; }
constexpr size_t WS_CTL = 0, CTL_BYTES = 1u << 20;
constexpr size_t WS_MOD = WS_CTL + CTL_BYTES;
constexpr size_t WS_ROPE = WS_MOD + al256((size_t)2 * 9 * 6144 * 4);
constexpr size_t WS_WTIN = WS_ROPE + al256(64 * 16 * 2 * 4);
constexpr size_t WS_WTOUT = WS_WTIN + (size_t)2 * NPW * DM * 2;
constexpr size_t WS_WTUP = WS_WTOUT + (size_t)2 * DM * DM * 2;
constexpr size_t WS_WTDN = WS_WTUP + (size_t)NUP * DM * 2;
constexpr size_t WS_WTMUP = WS_WTDN + (size_t)DM * DFF * 2;
constexpr size_t WS_WTMDN = WS_WTMUP + (size_t)NEXP * NUP * DM * 2;
constexpr size_t WS_H = WS_WTMDN + (size_t)NEXP * DM * DFF * 2;
constexpr size_t WS_XC = WS_H + (size_t)MALL * DM * 2;
constexpr size_t WS_GATES = WS_XC + (size_t)NCTX * DM * 4;
constexpr size_t WS_COMB = WS_GATES + (size_t)MALL * 16 * 4;
constexpr size_t WS_USC = WS_COMB + (size_t)NLAT * 8 * 4;
constexpr size_t WS_SM = WS_USC + al256((size_t)NB * 4 * 2 * 18 * 2 * 4);
constexpr size_t WS_LIST = WS_SM + al256((size_t)NB * 4 * 2 * 18 * 4);
constexpr size_t WS_BIG = WS_LIST + (size_t)NEXP * NLAT * 4;
constexpr size_t WS_MQK = WS_BIG + (size_t)MALL * NPW * 2;
constexpr size_t WS_U = WS_MQK + (size_t)MALL * 512 * 2;
constexpr size_t WS_S = WS_U + (size_t)2 * NB * 4 * 2 * 18 * 80 * 64 * 2;
constexpr size_t WS_GARR = WS_S + (size_t)2 * NB * 4 * 2 * 18 * 80 * 64 * 2;
constexpr size_t WS_HS = WS_GARR + (size_t)NB * 4 * 18 * 2 * 3 * 128 * 4;
constexpr size_t WS_END0 = WS_HS + al256((size_t)MALL * 4);
constexpr size_t MOE_ROWS = 34816;
constexpr size_t WS_ACTM_END = WS_BIG + MOE_ROWS * DFF * 2;
constexpr size_t WS_END = WS_END0 > WS_ACTM_END ? WS_END0 : WS_ACTM_END;

typedef unsigned short bf16_t;
typedef float f32x4 __attribute__((ext_vector_type(4)));
typedef float f32x2 __attribute__((ext_vector_type(2)));
typedef unsigned u32x4 __attribute__((ext_vector_type(4)));
typedef unsigned u32x2 __attribute__((ext_vector_type(2)));
#define LAS __attribute__((address_space(3)))
#define GAS __attribute__((address_space(1)))

__device__ __forceinline__ float bf2f(bf16_t b) { return __uint_as_float(((unsigned)b) << 16); }
__device__ __forceinline__ unsigned f2bf(float f) { unsigned u = __float_as_uint(f); return (u + 0x7fffu + ((u >> 16) & 1u)) >> 16; }
typedef __bf16 bf16x2_t __attribute__((ext_vector_type(2)));
__device__ __forceinline__ unsigned pk2(float lo, float hi) { f32x2 v = {lo, hi}; bf16x2_t b = __builtin_convertvector(v, bf16x2_t); return __builtin_bit_cast(unsigned, b); }
__device__ __forceinline__ float bflo(unsigned w) { return __uint_as_float(w << 16); }
__device__ __forceinline__ float bfhi(unsigned w) { return __uint_as_float(w & 0xffff0000u); }
__device__ __forceinline__ float sigmoidf_(float x) { return 1.0f / (1.0f + __expf(-x)); }
__device__ __forceinline__ float siluf_(float x) { return x / (1.0f + __expf(-x)); }
__device__ __forceinline__ float logsigmoidf_(float x) { return fminf(x, 0.f) - log1pf(__expf(-fabsf(x))); }
template <int O> __device__ __forceinline__ float swz_xor(float v) { return __int_as_float(__builtin_amdgcn_ds_swizzle(__float_as_int(v), (O << 10) | 0x1f)); }
__device__ __forceinline__ float red32_sum(float v) { const auto r = __builtin_amdgcn_permlane32_swap(__float_as_uint(v), __float_as_uint(v), false, false); return __uint_as_float(r[0]) + __uint_as_float(r[1]); }
__device__ __forceinline__ float red32_max(float v) { const auto r = __builtin_amdgcn_permlane32_swap(__float_as_uint(v), __float_as_uint(v), false, false); return fmaxf(__uint_as_float(r[0]), __uint_as_float(r[1])); }
__device__ __forceinline__ float wave_sum(float v) { v += swz_xor<1>(v); v += swz_xor<2>(v); v += swz_xor<4>(v); v += swz_xor<8>(v); v += swz_xor<16>(v); return red32_sum(v); }
__device__ __forceinline__ float wave_max(float v) { v = fmaxf(v, swz_xor<1>(v)); v = fmaxf(v, swz_xor<2>(v)); v = fmaxf(v, swz_xor<4>(v)); v = fmaxf(v, swz_xor<8>(v)); v = fmaxf(v, swz_xor<16>(v)); return red32_max(v); }
__device__ __forceinline__ float sum_g4(float v) { v += swz_xor<16>(v); return red32_sum(v); }
__device__ __forceinline__ float max_g4(float v) { v = fmaxf(v, swz_xor<16>(v)); return red32_max(v); }
__device__ __forceinline__ float reduce16_lanes(const float (&p)[16], int lane) {
    float q[8], r[4], s[2];
#pragma unroll
    for (int j = 0; j < 8; ++j) { const auto x = __builtin_amdgcn_permlane32_swap(__float_as_uint(p[j]), __float_as_uint(p[j + 8]), false, false); q[j] = __uint_as_float(x[0]) + __uint_as_float(x[1]); }
    const bool b4 = (lane & 16) != 0, b3 = (lane & 8) != 0, b2 = (lane & 4) != 0;
#pragma unroll
    for (int j = 0; j < 4; ++j) { const float keep = b4 ? q[j + 4] : q[j], send = b4 ? q[j] : q[j + 4]; r[j] = keep + swz_xor<16>(send); }
#pragma unroll
    for (int j = 0; j < 2; ++j) { const float keep = b3 ? r[j + 2] : r[j], send = b3 ? r[j] : r[j + 2]; s[j] = keep + swz_xor<8>(send); }
    float v; { const float keep = b2 ? s[1] : s[0], send = b2 ? s[0] : s[1]; v = keep + swz_xor<4>(send); }
    v += swz_xor<2>(v); v += swz_xor<1>(v);
    return v;
}
__device__ __forceinline__ float reduce8_lanes(const float (&p)[8], int lane) {
    float q[4], r[2];
#pragma unroll
    for (int j = 0; j < 4; ++j) { const auto x = __builtin_amdgcn_permlane32_swap(__float_as_uint(p[j]), __float_as_uint(p[j + 4]), false, false); q[j] = __uint_as_float(x[0]) + __uint_as_float(x[1]); }
    const bool b4 = (lane & 16) != 0, b3 = (lane & 8) != 0;
#pragma unroll
    for (int j = 0; j < 2; ++j) { const float keep = b4 ? q[j + 2] : q[j], send = b4 ? q[j] : q[j + 2]; r[j] = keep + swz_xor<16>(send); }
    float v; { const float keep = b3 ? r[1] : r[0], send = b3 ? r[0] : r[1]; v = keep + swz_xor<8>(send); }
    v += swz_xor<4>(v); v += swz_xor<2>(v); v += swz_xor<1>(v);
    return v;
}
__device__ __forceinline__ float lane_get(float v, int src_lane) { return __int_as_float(__builtin_amdgcn_ds_bpermute(src_lane << 2, __float_as_int(v))); }
__device__ __forceinline__ float lane_bcast(float v, int k) { return __int_as_float(__builtin_amdgcn_readlane(__float_as_int(v), k)); }

struct Args {
    const float* in[24];
    float* out;
    unsigned char* ws;
    int ph_lo, ph_hi;
};
namespace pg8 {
#define PG8_LAS __attribute__((address_space(3)))
typedef unsigned short bf16_t;
typedef short bf16x8 __attribute__((ext_vector_type(8)));
typedef float f32x4 __attribute__((ext_vector_type(4)));
typedef unsigned u32x4 __attribute__((ext_vector_type(4)));
constexpr int BM = 256, BK = 64, HALF = 128, HTB = HALF * BK * 2  , STAGE_BYTES = 8 * HTB, NXCD = 8, WGM = 8;

__host__ __device__ __forceinline__ int lds_byte(int r, int c) { const int st = (r >> 4) * 2 + (c >> 5), rr = r & 15, cc = c & 31, ob = rr * 64 + cc * 2; return st * 1024 + (ob ^ (((ob >> 9) & 1) << 5)); }
__host__ __device__ __forceinline__ void stage_rc(int b, int& R, int& C) { const int st = b / 1024, sb = b % 1024, swz = sb ^ (((sb >> 9) & 1) << 5); R = (st >> 1) * 16 + swz / 64; C = (st & 1) * 32 + (swz % 64) / 2; }
__host__ __device__ __forceinline__ int perm32(int rho) { const int n = rho >> 4, i = rho & 15; return 8 * (i >> 2) + 4 * n + (i & 3); }

struct Unit { int pm, pn, hs, idx; };
struct Gemm { const bf16_t* A; const bf16_t* Bt; int M, N, K; };

struct StaticOrder {
    int nM, nN, nwg, G, c;
    __host__ __device__ void init(int M, int N, int G_, int c_) { nM = M / BM; nN = N / BM; nwg = nM * nN; G = G_; c = c_; }
    __host__ __device__ bool next(int i, Unit& u) const {
        const int nfr = nwg / G, left = nwg - nfr * G; int wgid; u.hs = -1; u.idx = i;
        if (i < nfr) wgid = i * G + c;
        else if (i == nfr && left > 0) { if (2 * left <= G) { if (c >= 2 * left) return false; wgid = nfr * G + (c >> 1); u.hs = c & 1; } else { if (c >= left) return false; wgid = nfr * G + c; } }
        else return false; { const int q = nwg / NXCD, r = nwg % NXCD, xcd = wgid % NXCD, off = wgid / NXCD; wgid = (xcd < r ? xcd * (q + 1) : r * (q + 1) + (xcd - r) * q) + off; }
        const int nig = WGM * nN, gid = wgid / nig, fm = gid * WGM, gsz = (nM - fm) < WGM ? (nM - fm) : WGM;
        u.pm = fm + ((wgid % nig) % gsz); u.pn = (wgid % nig) / gsz; return true;
    }
    __device__ __forceinline__ void a_ready(const Unit&) const {}
    __device__ __forceinline__ void done(const Unit&) const {}
    __device__ __forceinline__ int idle_class() const { const int nfr = nwg / G, left = nwg - nfr * G; if (left == 0) return 3; if (2 * left <= G) return c < 2 * left ? 0 : 1; return c < left ? 0 : 2; }
    const char* Bt; int K2;
    __device__ __forceinline__ unsigned arow(const Unit& u, int R) const { return (unsigned)(u.pm * BM + (u.hs > 0 ? HALF : 0) + (u.hs >= 0 ? (R & (HALF - 1)) : R)); }
    __device__ __forceinline__ const char* bbase(const Unit& u) const { return Bt + (size_t)u.pn * BM * K2; }
};
#define PG8_EPI_CONST_OFF (131072 + 256 + 4096)
#define PG8_EPI_TAB_OFF (131072 + 256)
__device__ __forceinline__ unsigned cvt_pk_bf16(float lo, float hi) { return ::pk2(lo, hi); }
typedef float f32x2 __attribute__((ext_vector_type(2)));
typedef int i32x4 __attribute__((ext_vector_type(4)));
template <bool I8> struct AccSel { typedef f32x4 T; static __device__ __forceinline__ T zero() { return (f32x4){0.f, 0.f, 0.f, 0.f}; } };
template <> struct AccSel<true> { typedef i32x4 T; static __device__ __forceinline__ T zero() { return (i32x4){0, 0, 0, 0}; } };
template <bool I8> __device__ __forceinline__ typename AccSel<I8>::T mma_op(bf16x8 a, bf16x8 b, typename AccSel<I8>::T c);
template <> __device__ __forceinline__ f32x4 mma_op<false>(bf16x8 a, bf16x8 b, f32x4 c) { return __builtin_amdgcn_mfma_f32_16x16x32_bf16(a, b, c, 0, 0, 0); }
template <> __device__ __forceinline__ i32x4 mma_op<true>(bf16x8 a, bf16x8 b, i32x4 c) { return __builtin_amdgcn_mfma_i32_16x16x64_i8(__builtin_bit_cast(i32x4, a), __builtin_bit_cast(i32x4, b), c, 0, 0, 0); }
struct EpiBf16 {
    static constexpr bool PERM = true, AFTER_DRAIN = false, I8 = false;
    template <class Sched> __device__ __forceinline__ float pf_load(const Sched&, const Unit&, int) const { return 0.f; }
    __device__ __forceinline__ void pf_store(float, PG8_LAS unsigned char*, int, int) const {}
    bf16_t* O; int ldc;
    __device__ __forceinline__ void operator()(const f32x4 (&acc)[2][2][4][2], const Unit& u, int wr, int wc, int fr, int fq, PG8_LAS unsigned char* lds, int ui) const {
        const int row0 = u.pm * BM + (u.hs > 0 ? HALF : 0) + wr * 64 + fr, col0 = u.pn * BM + wc * 32 + 8 * fq; const int nai = u.hs >= 0 ? 1 : 2;
#pragma unroll
        for (int ai = 0; ai < 2; ++ai) if (ai < nai)
#pragma unroll
            for (int m = 0; m < 4; ++m) { bf16_t* rowp = O + (size_t)(row0 + ai * HALF + m * 16) * ldc + col0;
#pragma unroll
                for (int bj = 0; bj < 2; ++bj) { const f32x4 v0 = acc[ai][bj][m][0], v1 = acc[ai][bj][m][1];
                    u32x4 w; w.x = cvt_pk_bf16(v0[0], v0[1]); w.y = cvt_pk_bf16(v0[2], v0[3]); w.z = cvt_pk_bf16(v1[0], v1[1]); w.w = cvt_pk_bf16(v1[2], v1[3]);
                    *(u32x4*)(rowp + bj * HALF) = w; } }
    }
};
struct EpiSwiGLU {
    static constexpr bool PERM = true, AFTER_DRAIN = false, I8 = false;
    template <class Sched> __device__ __forceinline__ float pf_load(const Sched&, const Unit&, int) const { return 0.f; }
    __device__ __forceinline__ void pf_store(float, PG8_LAS unsigned char*, int, int) const {}
    bf16_t* O; int ldc;
    __device__ __forceinline__ void operator()(const f32x4 (&acc)[2][2][4][2], const Unit& u, int wr, int wc, int fr, int fq, PG8_LAS unsigned char* lds, int ui) const {
        const int row0 = u.pm * BM + (u.hs > 0 ? HALF : 0) + wr * 64 + fr, col0 = u.pn * HALF + wc * 32 + 8 * fq; const int nai = u.hs >= 0 ? 1 : 2;
#pragma unroll
        for (int ai = 0; ai < 2; ++ai) if (ai < nai)
#pragma unroll
            for (int m = 0; m < 4; ++m) { bf16_t* rowp = O + (size_t)(row0 + ai * HALF + m * 16) * ldc + col0;
                float r[8];
#pragma unroll
                for (int n = 0; n < 2; ++n)
#pragma unroll
                    for (int j = 0; j < 4; ++j) { const float g = acc[ai][0][m][n][j], uu = acc[ai][1][m][n][j]; r[n * 4 + j] = g / (1.0f + __expf(-g)) * uu; }
                u32x4 w; w.x = cvt_pk_bf16(r[0], r[1]); w.y = cvt_pk_bf16(r[2], r[3]); w.z = cvt_pk_bf16(r[4], r[5]); w.w = cvt_pk_bf16(r[6], r[7]);
                *(u32x4*)rowp = w; }
    }
};
struct EpiResid {
    static constexpr bool PERM = false, AFTER_DRAIN = false, I8 = false;
    template <class Sched> __device__ __forceinline__ float pf_load(const Sched&, const Unit&, int) const { return 0.f; }
    __device__ __forceinline__ void pf_store(float, PG8_LAS unsigned char*, int, int) const {}
    const float* base_lat; const float* base_ctx; float* out_lat; float* out_ctx; const float* gate; const float* comb; int comb_ld; int nlat_tiles;
    __device__ __forceinline__ void operator()(const f32x4 (&acc)[2][2][4][2], const Unit& u, int wr, int wc, int fr, int fq, PG8_LAS unsigned char* lds, int ui) const {
        const bool isctx = u.pm >= nlat_tiles;
        const int rloc0 = (isctx ? (u.pm - nlat_tiles) : u.pm) * BM + (u.hs > 0 ? HALF : 0) + wr * 64 + fr, col0 = u.pn * BM + wc * 32 + 4 * fq; const int nai = u.hs >= 0 ? 1 : 2;
        const float* bp = isctx ? base_ctx : base_lat; float* op = isctx ? out_ctx : out_lat;
        const float* gp = gate + (size_t)(isctx ? 8 : (u.pm >> 3)) * 6144 + col0;
        f32x4 gv[2][2];
#pragma unroll
        for (int bj = 0; bj < 2; ++bj)
#pragma unroll
            for (int n = 0; n < 2; ++n) gv[bj][n] = *(const f32x4*)(gp + bj * HALF + n * 16);
#pragma unroll
        for (int ai = 0; ai < 2; ++ai) if (ai < nai)
#pragma unroll
            for (int m = 0; m < 4; ++m) { const int rl = rloc0 + ai * HALF + m * 16; const size_t off = (size_t)rl * 1024 + col0;
                const float cs = comb ? comb[(size_t)rl * comb_ld] : 1.0f;
#pragma unroll
                for (int bj = 0; bj < 2; ++bj)
#pragma unroll
                    for (int n = 0; n < 2; ++n) { const f32x4 bs = *(const f32x4*)(bp + off + bj * HALF + n * 16);
                        *(f32x4*)(op + off + bj * HALF + n * 16) = bs + gv[bj][n] * acc[ai][bj][m][n] * cs; } }
    }
};

struct EpiNull {
    static constexpr bool PERM = true, AFTER_DRAIN = false, I8 = false;
    template <class Sched> __device__ __forceinline__ float pf_load(const Sched&, const Unit&, int) const { return 0.f; }
    __device__ __forceinline__ void pf_store(float, PG8_LAS unsigned char*, int, int) const {}
    bf16_t* O; int ldc;
    __device__ __forceinline__ void operator()(const f32x4 (&acc)[2][2][4][2], const Unit& u, int wr, int wc, int fr, int fq, PG8_LAS unsigned char* lds, int ui) const {
        float s = 0.f;
#pragma unroll
        for (int ai = 0; ai < 2; ++ai)
#pragma unroll
            for (int bj = 0; bj < 2; ++bj)
#pragma unroll
                for (int m = 0; m < 4; ++m)
#pragma unroll
                    for (int n = 0; n < 2; ++n) s += acc[ai][bj][m][n][0] + acc[ai][bj][m][n][1] + acc[ai][bj][m][n][2] + acc[ai][bj][m][n][3];
        if (s == 12345.678f) O[0] = (bf16_t)1;
    }
};

struct EpiProj {
    static constexpr bool PERM = true, AFTER_DRAIN = false, I8 = false;
    template <class Sched> __device__ __forceinline__ float pf_load(const Sched&, const Unit&, int) const { return 0.f; }
    __device__ __forceinline__ void pf_store(float, PG8_LAS unsigned char*, int, int) const {}
    bf16_t* O; int ldc; const float* rope; const float* qgain; const float* kgain; int nlat_tiles;
    __device__ __forceinline__ void operator()(const f32x4 (&acc)[2][2][4][2], const Unit& u, int wr, int wc, int fr, int fq, PG8_LAS unsigned char* lds, int ui) const {
        const int row0 = u.pm * BM + (u.hs > 0 ? HALF : 0) + wr * 64 + fr, col0 = u.pn * BM + wc * 32 + 8 * fq; const int nai = u.hs >= 0 ? 1 : 2;
        const int pn = u.pn; const bool lat = u.pm < nlat_tiles;
        const bool isrope = pn < 2 && lat, isnorm = pn >= 8 && pn < 12; const float sc = (pn == 1) ? 0.125f : 1.0f;
        const float* gp = (pn < 10 ? qgain : kgain) + 32 * (fq >> 1) + 8 * (fq & 1);
#pragma unroll
        for (int ai = 0; ai < 2; ++ai) if (ai < nai)
#pragma unroll
            for (int m = 0; m < 4; ++m) { const int row = row0 + ai * HALF + m * 16; bf16_t* rowp = O + (size_t)row * ldc + col0;
                f32x4 x1[2] = {acc[ai][0][m][0], acc[ai][0][m][1]}, x2[2] = {acc[ai][1][m][0], acc[ai][1][m][1]};
                if (isrope) { const int t = row & (SEQ - 1); const int pos = (fq >> 1) ? (t & 63) : (t >> 6); const float* rp = rope + (size_t)(pos * 16 + 8 * (fq & 1)) * 2;
#pragma unroll
                    for (int n = 0; n < 2; ++n) { const f32x4 cs0 = *(const f32x4*)(rp + 8 * n), cs1 = *(const f32x4*)(rp + 8 * n + 4);
                        const f32x4 a1 = x1[n], a2 = x2[n];
                        x1[n] = (f32x4){a1[0] * cs0[0] - a2[0] * cs0[1], a1[1] * cs0[2] - a2[1] * cs0[3], a1[2] * cs1[0] - a2[2] * cs1[1], a1[3] * cs1[2] - a2[3] * cs1[3]};
                        x2[n] = (f32x4){a1[0] * cs0[1] + a2[0] * cs0[0], a1[1] * cs0[3] + a2[1] * cs0[2], a1[2] * cs1[1] + a2[2] * cs1[0], a1[3] * cs1[3] + a2[3] * cs1[2]}; } }
                if (isnorm) { float ss = 0.f;
#pragma unroll
                    for (int n = 0; n < 2; ++n) ss += (x1[n][0] * x1[n][0] + x1[n][1] * x1[n][1]) + (x1[n][2] * x1[n][2] + x1[n][3] * x1[n][3]) + (x2[n][0] * x2[n][0] + x2[n][1] * x2[n][1]) + (x2[n][2] * x2[n][2] + x2[n][3] * x2[n][3]);
                    ss = ::sum_g4(ss); const float rs = rsqrtf(ss * (1.0f / 64.0f) + 1e-6f);
#pragma unroll
                    for (int n = 0; n < 2; ++n) { x1[n] = x1[n] * rs * *(const f32x4*)(gp + 4 * n); x2[n] = x2[n] * rs * *(const f32x4*)(gp + 16 + 4 * n); } }
                u32x4 w1, w2;
                w1.x = cvt_pk_bf16(x1[0][0] * sc, x1[0][1] * sc); w1.y = cvt_pk_bf16(x1[0][2] * sc, x1[0][3] * sc); w1.z = cvt_pk_bf16(x1[1][0] * sc, x1[1][1] * sc); w1.w = cvt_pk_bf16(x1[1][2] * sc, x1[1][3] * sc);
                w2.x = cvt_pk_bf16(x2[0][0] * sc, x2[0][1] * sc); w2.y = cvt_pk_bf16(x2[0][2] * sc, x2[0][3] * sc); w2.z = cvt_pk_bf16(x2[1][0] * sc, x2[1][1] * sc); w2.w = cvt_pk_bf16(x2[1][2] * sc, x2[1][3] * sc);
                *(u32x4*)rowp = w1; *(u32x4*)(rowp + HALF) = w2;
                asm volatile("" ::: "memory"); }
    }
};

struct EpiSwiGLUI8 {
    static constexpr bool PERM = true, AFTER_DRAIN = false, I8 = true;
    template <class Sched> __device__ __forceinline__ float pf_load(const Sched& S, const Unit& u, int tid_) const {
        int tid = tid_; asm volatile("" : "+v"(tid));
        int e = 0; if (tab) {
#pragma unroll
            for (int k = 1; k < 8; ++k) e += (u.pm >= tab[k]) ? 1 : 0; }
        const float* p0 = sa + S.arow(u, (u.hs >= 0) ? (tid & (HALF - 1)) : (tid & 255)); const float* p1 = (const float*)(colmax + (size_t)e * ncol_e + u.pn * BM + (tid & 255));
        const float* pp = tid < 256 ? p0 : p1;
        return *pp;
    }
    __device__ __forceinline__ void pf_store(float v, PG8_LAS unsigned char* lds, int tid, int ui) const {
        ((PG8_LAS float*)(lds + PG8_EPI_TAB_OFF + (ui & 1) * 2048))[tid] = tid < 256 ? v : v * (1.0f / 127.0f); }
    bf16_t* O; int ldc; const float* sa; const unsigned* colmax; const PG8_LAS int* tab; const void* unused_; int ncol_e;
    __device__ __forceinline__ void operator()(const i32x4 (&acc)[2][2][4][2], const Unit& u, int wr, int wc, int fr, int fq, PG8_LAS unsigned char* lds, int ui) const {
        const int rt0 = (u.hs > 0 ? HALF : 0) + wr * 64 + fr, row0 = u.pm * BM + rt0, col0 = u.pn * HALF + wc * 32 + 8 * fq; const int nai = u.hs >= 0 ? 1 : 2;
        const PG8_LAS float* tb = (const PG8_LAS float*)(lds + PG8_EPI_TAB_OFF + (ui & 1) * 2048);
        float sg[8], su[8];
        { const f32x4 g0 = *(const PG8_LAS f32x4*)(tb + 256 + wc * 32 + 8 * fq), g1 = *(const PG8_LAS f32x4*)(tb + 256 + wc * 32 + 8 * fq + 4), u0 = *(const PG8_LAS f32x4*)(tb + 256 + HALF + wc * 32 + 8 * fq), u1 = *(const PG8_LAS f32x4*)(tb + 256 + HALF + wc * 32 + 8 * fq + 4);
#pragma unroll
          for (int i = 0; i < 4; ++i) { sg[i] = g0[i]; sg[4 + i] = g1[i]; su[i] = u0[i]; su[4 + i] = u1[i]; } }
#pragma unroll
        for (int ai = 0; ai < 2; ++ai) if (ai < nai)
#pragma unroll
            for (int m = 0; m < 4; ++m) { const int rt = rt0 + ai * HALF + m * 16; bf16_t* rowp = O + (size_t)(u.pm * BM + rt) * ldc + col0;
                const float s_a = tb[(u.hs >= 0) ? (rt & (HALF - 1)) : rt];
                float r[8];
#pragma unroll
                for (int n = 0; n < 2; ++n)
#pragma unroll
                    for (int j = 0; j < 4; ++j) { const float g = (float)acc[ai][0][m][n][j] * (s_a * sg[n * 4 + j]), uu = (float)acc[ai][1][m][n][j] * (s_a * su[n * 4 + j]); r[n * 4 + j] = g / (1.0f + __expf(-g)) * uu; }
                u32x4 w; w.x = cvt_pk_bf16(r[0], r[1]); w.y = cvt_pk_bf16(r[2], r[3]); w.z = cvt_pk_bf16(r[4], r[5]); w.w = cvt_pk_bf16(r[6], r[7]);
                *(u32x4*)rowp = w; }
        (void)row0;
    }
};
struct EpiSwiGLUI8LS {
    static constexpr bool PERM = true, AFTER_DRAIN = false, I8 = true;
    template <class Sched> __device__ __forceinline__ float pf_load(const Sched& S, const Unit& u, int tid_) const {
        int tid = tid_; asm volatile("" : "+v"(tid));
        int e = 0; if (tab) {
#pragma unroll
            for (int k = 1; k < 8; ++k) e += (u.pm >= tab[k]) ? 1 : 0; }
        const float* p0 = sa + S.arow(u, (u.hs >= 0) ? (tid & (HALF - 1)) : (tid & 255)); const float* p1 = (const float*)(colmax + (size_t)e * ncol_e + u.pn * BM + (tid & 255));
        const float* pp = tid < 256 ? p0 : p1;
        return *pp;
    }
    __device__ __forceinline__ void pf_store(float v, PG8_LAS unsigned char* lds, int tid, int ui) const {
        ((PG8_LAS float*)(lds + PG8_EPI_TAB_OFF + (ui & 1) * 2048))[tid] = tid < 256 ? v : v * (1.0f / 127.0f); }
    bf16_t* O; int ldc; const float* sa; const unsigned* colmax; const PG8_LAS int* tab; const void* unused_; int ncol_e;
    __device__ __forceinline__ void operator()(const i32x4 (&acc)[2][2][4][2], const Unit& u, int wr, int wc, int fr, int fq, PG8_LAS unsigned char* lds, int ui) const {
        const int rt0 = (u.hs > 0 ? HALF : 0) + wr * 64 + fr, row0 = u.pm * BM + rt0, col0 = u.pn * HALF + wc * 32 + 8 * fq; const int nai = u.hs >= 0 ? 1 : 2;
        const PG8_LAS float* tb = (const PG8_LAS float*)(lds + PG8_EPI_TAB_OFF + (ui & 1) * 2048);
        float sg[8], su[8];
        { const f32x4 g0 = *(const PG8_LAS f32x4*)(tb + 256 + wc * 32 + 8 * fq), g1 = *(const PG8_LAS f32x4*)(tb + 256 + wc * 32 + 8 * fq + 4), u0 = *(const PG8_LAS f32x4*)(tb + 256 + HALF + wc * 32 + 8 * fq), u1 = *(const PG8_LAS f32x4*)(tb + 256 + HALF + wc * 32 + 8 * fq + 4);
#pragma unroll
          for (int i = 0; i < 4; ++i) { sg[i] = g0[i]; sg[4 + i] = g1[i]; su[i] = u0[i]; su[4 + i] = u1[i]; } }
#pragma unroll
        for (int ai = 0; ai < 2; ++ai) if (ai < nai)
#pragma unroll
            for (int m = 0; m < 4; ++m) { const int rt = rt0 + ai * HALF + m * 16; bf16_t* rowp = O + (size_t)blockIdx.x * 32768 + (size_t)rt * 128 + (col0 & 127);
                const float s_a = tb[(u.hs >= 0) ? (rt & (HALF - 1)) : rt];
                float r[8];
#pragma unroll
                for (int n = 0; n < 2; ++n)
#pragma unroll
                    for (int j = 0; j < 4; ++j) { const float g = (float)acc[ai][0][m][n][j] * (s_a * sg[n * 4 + j]), uu = (float)acc[ai][1][m][n][j] * (s_a * su[n * 4 + j]); r[n * 4 + j] = g / (1.0f + __expf(-g)) * uu; }
                u32x4 w; w.x = cvt_pk_bf16(r[0], r[1]); w.y = cvt_pk_bf16(r[2], r[3]); w.z = cvt_pk_bf16(r[4], r[5]); w.w = cvt_pk_bf16(r[6], r[7]);
                *(u32x4*)rowp = w; }
        (void)row0;
    }
};
struct EpiSwiGLUI8NS {
    static constexpr bool PERM = true, AFTER_DRAIN = false, I8 = true;
    template <class Sched> __device__ __forceinline__ float pf_load(const Sched& S, const Unit& u, int tid_) const {
        int tid = tid_; asm volatile("" : "+v"(tid));
        int e = 0; if (tab) {
#pragma unroll
            for (int k = 1; k < 8; ++k) e += (u.pm >= tab[k]) ? 1 : 0; }
        const float* p0 = sa + S.arow(u, (u.hs >= 0) ? (tid & (HALF - 1)) : (tid & 255)); const float* p1 = (const float*)(colmax + (size_t)e * ncol_e + u.pn * BM + (tid & 255));
        const float* pp = tid < 256 ? p0 : p1;
        return *pp;
    }
    __device__ __forceinline__ void pf_store(float v, PG8_LAS unsigned char* lds, int tid, int ui) const {
        ((PG8_LAS float*)(lds + PG8_EPI_TAB_OFF + (ui & 1) * 2048))[tid] = tid < 256 ? v : v * (1.0f / 127.0f); }
    bf16_t* O; int ldc; const float* sa; const unsigned* colmax; const PG8_LAS int* tab; const void* unused_; int ncol_e;
    __device__ __forceinline__ void operator()(const i32x4 (&acc)[2][2][4][2], const Unit& u, int wr, int wc, int fr, int fq, PG8_LAS unsigned char* lds, int ui) const {
        const int rt0 = (u.hs > 0 ? HALF : 0) + wr * 64 + fr, row0 = u.pm * BM + rt0, col0 = u.pn * HALF + wc * 32 + 8 * fq; const int nai = u.hs >= 0 ? 1 : 2;
        const PG8_LAS float* tb = (const PG8_LAS float*)(lds + PG8_EPI_TAB_OFF + (ui & 1) * 2048);
        float sg[8], su[8];
        { const f32x4 g0 = *(const PG8_LAS f32x4*)(tb + 256 + wc * 32 + 8 * fq), g1 = *(const PG8_LAS f32x4*)(tb + 256 + wc * 32 + 8 * fq + 4), u0 = *(const PG8_LAS f32x4*)(tb + 256 + HALF + wc * 32 + 8 * fq), u1 = *(const PG8_LAS f32x4*)(tb + 256 + HALF + wc * 32 + 8 * fq + 4);
#pragma unroll
          for (int i = 0; i < 4; ++i) { sg[i] = g0[i]; sg[4 + i] = g1[i]; su[i] = u0[i]; su[4 + i] = u1[i]; } }
#pragma unroll
        for (int ai = 0; ai < 2; ++ai) if (ai < nai)
#pragma unroll
            for (int m = 0; m < 4; ++m) { const int rt = rt0 + ai * HALF + m * 16; bf16_t* rowp = O + (size_t)(u.pm * BM + rt) * ldc + col0;
                const float s_a = tb[(u.hs >= 0) ? (rt & (HALF - 1)) : rt];
                float r[8];
#pragma unroll
                for (int n = 0; n < 2; ++n)
#pragma unroll
                    for (int j = 0; j < 4; ++j) { const float g = (float)acc[ai][0][m][n][j] * (s_a * sg[n * 4 + j]), uu = (float)acc[ai][1][m][n][j] * (s_a * su[n * 4 + j]); r[n * 4 + j] = g / (1.0f + __expf(-g)) * uu; }
                u32x4 w; w.x = cvt_pk_bf16(r[0], r[1]); w.y = cvt_pk_bf16(r[2], r[3]); w.z = cvt_pk_bf16(r[4], r[5]); w.w = cvt_pk_bf16(r[6], r[7]);
                if (w.x == 0x12345678u && w.y == 0x9abcdef0u) *(u32x4*)rowp = w; }
        (void)row0;
    }
};
struct EpiProjI8 {
    static constexpr bool PERM = true, AFTER_DRAIN = false, I8 = true;
    template <class Sched> __device__ __forceinline__ float pf_load(const Sched& S, const Unit& u, int tid_) const {
        int tid = tid_; asm volatile("" : "+v"(tid));
        const float* p0 = sa + S.arow(u, (u.hs >= 0) ? (tid & (HALF - 1)) : (tid & 255)); const float* p1 = (const float*)(colmax + u.pn * BM + (tid & 255));
        const float* pp = tid < 256 ? p0 : p1;
        return *pp;
    }
    __device__ __forceinline__ void pf_store(float v, PG8_LAS unsigned char* lds, int tid, int ui) const {
        ((PG8_LAS float*)(lds + PG8_EPI_TAB_OFF + (ui & 1) * 2048))[tid] = tid < 256 ? v * (1.0f / 127.0f) : v; }
    bf16_t* O; int ldc; const float* rope; const float* qgain; const float* kgain; int nlat_tiles; const float* sa; const unsigned* colmax;
    __device__ __forceinline__ void operator()(const i32x4 (&acc)[2][2][4][2], const Unit& u, int wr, int wc, int fr, int fq, PG8_LAS unsigned char* lds, int ui) const {
        const int row0 = u.pm * BM + (u.hs > 0 ? HALF : 0) + wr * 64 + fr, col0 = u.pn * BM + wc * 32 + 8 * fq; const int nai = u.hs >= 0 ? 1 : 2;
        const int pn = u.pn; const bool lat = u.pm < nlat_tiles;
        const bool isrope = pn < 2 && lat, isnorm = pn >= 8 && pn < 12; const float sc = (pn == 1) ? 0.125f : 1.0f;
        const PG8_LAS float* tb = (const PG8_LAS float*)(lds + PG8_EPI_TAB_OFF + (ui & 1) * 2048);
        const PG8_LAS float* ropeL = (const PG8_LAS float*)(lds + PG8_EPI_CONST_OFF);
        const PG8_LAS float* gp = ropeL + 2048 + (pn < 10 ? 0 : 64) + 32 * (fq >> 1) + 8 * (fq & 1);
        float c1[8], c2[8];
        { const f32x4 a0 = *(const PG8_LAS f32x4*)(tb + 256 + wc * 32 + 8 * fq), a1 = *(const PG8_LAS f32x4*)(tb + 256 + wc * 32 + 8 * fq + 4), b0 = *(const PG8_LAS f32x4*)(tb + 256 + HALF + wc * 32 + 8 * fq), b1 = *(const PG8_LAS f32x4*)(tb + 256 + HALF + wc * 32 + 8 * fq + 4);
#pragma unroll
          for (int i = 0; i < 4; ++i) { c1[i] = a0[i]; c1[4 + i] = a1[i]; c2[i] = b0[i]; c2[4 + i] = b1[i]; } }
        const int rt0 = (u.hs > 0 ? HALF : 0) + wr * 64 + fr;
#pragma unroll
        for (int ai = 0; ai < 2; ++ai) if (ai < nai)
#pragma unroll
            for (int m = 0; m < 4; ++m) { const int row = row0 + ai * HALF + m * 16; bf16_t* rowp = O + (size_t)row * ldc + col0;
                const int rt = rt0 + ai * HALF + m * 16; const float s_a = tb[(u.hs >= 0) ? (rt & (HALF - 1)) : rt];
                f32x4 x1[2], x2[2];
#pragma unroll
                for (int n = 0; n < 2; ++n)
#pragma unroll
                    for (int j = 0; j < 4; ++j) { x1[n][j] = (float)acc[ai][0][m][n][j] * (s_a * c1[4 * n + j]); x2[n][j] = (float)acc[ai][1][m][n][j] * (s_a * c2[4 * n + j]); }
                if (isrope) { const int t = row & (SEQ - 1); const int pos = (fq >> 1) ? (t & 63) : (t >> 6); const PG8_LAS float* rp = ropeL + (pos * 16 + 8 * (fq & 1)) * 2;
#pragma unroll
                    for (int n = 0; n < 2; ++n) { const f32x4 cs0 = *(const PG8_LAS f32x4*)(rp + 8 * n), cs1 = *(const PG8_LAS f32x4*)(rp + 8 * n + 4);
                        const f32x4 a1 = x1[n], a2 = x2[n];
                        x1[n] = (f32x4){a1[0] * cs0[0] - a2[0] * cs0[1], a1[1] * cs0[2] - a2[1] * cs0[3], a1[2] * cs1[0] - a2[2] * cs1[1], a1[3] * cs1[2] - a2[3] * cs1[3]};
                        x2[n] = (f32x4){a1[0] * cs0[1] + a2[0] * cs0[0], a1[1] * cs0[3] + a2[1] * cs0[2], a1[2] * cs1[1] + a2[2] * cs1[0], a1[3] * cs1[3] + a2[3] * cs1[2]}; } }
                if (isnorm) { float ss = 0.f;
#pragma unroll
                    for (int n = 0; n < 2; ++n) ss += (x1[n][0] * x1[n][0] + x1[n][1] * x1[n][1]) + (x1[n][2] * x1[n][2] + x1[n][3] * x1[n][3]) + (x2[n][0] * x2[n][0] + x2[n][1] * x2[n][1]) + (x2[n][2] * x2[n][2] + x2[n][3] * x2[n][3]);
                    ss = ::sum_g4(ss); const float rs = rsqrtf(ss * (1.0f / 64.0f) + 1e-6f);
#pragma unroll
                    for (int n = 0; n < 2; ++n) { x1[n] = x1[n] * rs * *(const PG8_LAS f32x4*)(gp + 4 * n); x2[n] = x2[n] * rs * *(const PG8_LAS f32x4*)(gp + 16 + 4 * n); } }
                u32x4 w1, w2;
                w1.x = cvt_pk_bf16(x1[0][0] * sc, x1[0][1] * sc); w1.y = cvt_pk_bf16(x1[0][2] * sc, x1[0][3] * sc); w1.z = cvt_pk_bf16(x1[1][0] * sc, x1[1][1] * sc); w1.w = cvt_pk_bf16(x1[1][2] * sc, x1[1][3] * sc);
                w2.x = cvt_pk_bf16(x2[0][0] * sc, x2[0][1] * sc); w2.y = cvt_pk_bf16(x2[0][2] * sc, x2[0][3] * sc); w2.z = cvt_pk_bf16(x2[1][0] * sc, x2[1][1] * sc); w2.w = cvt_pk_bf16(x2[1][2] * sc, x2[1][3] * sc);
                *(u32x4*)rowp = w1; *(u32x4*)(rowp + HALF) = w2;
                asm volatile("" ::: "memory"); }
    }
};

struct EpiNullI8 {
    static constexpr bool PERM = true, AFTER_DRAIN = false, I8 = true;
    template <class Sched> __device__ __forceinline__ float pf_load(const Sched&, const Unit&, int) const { return 0.f; }
    __device__ __forceinline__ void pf_store(float, PG8_LAS unsigned char*, int, int) const {}
    bf16_t* O; int ldc;
    __device__ __forceinline__ void operator()(const i32x4 (&acc)[2][2][4][2], const Unit& u, int wr, int wc, int fr, int fq, PG8_LAS unsigned char* lds, int ui) const {
        int s = 0;
#pragma unroll
        for (int ai = 0; ai < 2; ++ai)
#pragma unroll
            for (int bj = 0; bj < 2; ++bj)
#pragma unroll
                for (int m = 0; m < 4; ++m)
#pragma unroll
                    for (int n = 0; n < 2; ++n) s += acc[ai][bj][m][n][0] + acc[ai][bj][m][n][1] + acc[ai][bj][m][n][2] + acc[ai][bj][m][n][3];
        if (s == 123456789) O[0] = (bf16_t)1;
    }
};
template <class Epi, class Sched, bool STAMP = false>
__device__ __forceinline__ void gemm_phase(PG8_LAS unsigned char* lds, const Gemm g, const Sched& S, const Epi& E, unsigned long long* stamps, int tid_in) {
    int tid_ = tid_in; asm volatile("" : "+v"(tid_)); const int tid = tid_, wid = __builtin_amdgcn_readfirstlane(tid >> 6), lane = tid & 63, wr = wid >> 2, wc = wid & 3, fr = lane & 15, fq = lane >> 4;
    const int K = g.K, nt = K / BK;
    int ts_lo = 0, ts_hi = 0, nts = 0; const unsigned long long rt_entry = STAMP ? (unsigned long long)wall_clock64() : 0ull;
#define PG8_STAMP() do { if (STAMP && wid == 0 && nts < 64) { const unsigned long long _c = (unsigned long long)clock64(); \
        ts_lo = (lane == nts) ? (int)(unsigned)_c : ts_lo; ts_hi = (lane == nts) ? (int)(unsigned)(_c >> 32) : ts_hi; ++nts; } } while (0)
    PG8_STAMP();
    unsigned voffB[2]; int stR[2]; unsigned stC[2];
#pragma unroll
    for (int i = 0; i < 2; ++i) { int R, C; stage_rc(tid * 16 + i * 8192, R, C); const int Rb = Epi::PERM ? ((R & ~31) + perm32(R & 31)) : R;
        stR[i] = R; stC[i] = (unsigned)C * 2u; voffB[i] = (unsigned)Rb * (unsigned)S.K2 + (unsigned)C * 2u; }
    unsigned vAc0[2], vAc1[2], vAn0[2], vAn1[2];
#define PG8_AROWS(u, d0, d1) do { _Pragma("unroll") for (int _i = 0; _i < 2; ++_i) { d0[_i] = S.arow(u, stR[_i]) * (unsigned)(K * 2) + stC[_i]; d1[_i] = S.arow(u, HALF + stR[_i]) * (unsigned)(K * 2) + stC[_i]; } } while (0)
    const size_t kstep = (size_t)(BK * 2);
    const size_t hstep = (size_t)HALF * S.K2;
    const size_t tstep = 2 * hstep;
    const unsigned ldsw = (unsigned)wid * 1024u;
    const int aoff = lds_byte(wr * 64 + fr, fq * 8), boff = lds_byte(wc * 32 + fr, fq * 8);
#define PG8_SA(b, h) (((b) * 2 + (h)) * HTB)
#define PG8_SB(b, h) ((4 + (b) * 2 + (h)) * HTB)
#define PG8_STAGE(bufoff, gbase, voff) do { _Pragma("unroll") for (int _i = 0; _i < 2; ++_i) \
        __builtin_amdgcn_global_load_lds((const unsigned*)((const char*)(gbase) + (voff)[_i]), (PG8_LAS unsigned*)(lds + (bufoff) + ldsw + _i * 8192), 16, 0, 0); } while (0)
#define PG8_LDA(dst, b, h) do { _Pragma("unroll") for (int m = 0; m < 4; ++m) _Pragma("unroll") for (int k = 0; k < 2; ++k) dst[m][k] = *(const PG8_LAS bf16x8*)(lds + PG8_SA(b, h) + aoff + m * 2048 + k * 1024); } while (0)
#define PG8_LDB(dst, b, h) do { _Pragma("unroll") for (int n = 0; n < 2; ++n) _Pragma("unroll") for (int k = 0; k < 2; ++k) dst[n][k] = *(const PG8_LAS bf16x8*)(lds + PG8_SB(b, h) + boff + n * 2048 + k * 1024); } while (0)
#define PG8_MMA(ai, bj, At, Bt) do { __builtin_amdgcn_s_setprio(1); _Pragma("unroll") for (int m = 0; m < 4; ++m) _Pragma("unroll") for (int n = 0; n < 2; ++n) _Pragma("unroll") for (int k = 0; k < 2; ++k) \
        acc[ai][bj][m][n] = mma_op<Epi::I8>(Bt[n][k], At[m][k], acc[ai][bj][m][n]); __builtin_amdgcn_s_setprio(0); } while (0)
#define PG8_WAIT_V(n) asm volatile("s_waitcnt vmcnt(" #n ")" ::: "memory")
#define PG8_WAIT_L(n) asm volatile("s_waitcnt lgkmcnt(" #n ")" ::: "memory")
#define PG8_BAR __builtin_amdgcn_s_barrier()
#define PG8_SCHED __builtin_amdgcn_sched_barrier(0)
    Unit cur, nxt; int ui = 0;
    if (!S.next(0, cur)) return;
    typename AccSel<Epi::I8>::T acc[2][2][4][2];
#pragma unroll
    for (int a = 0; a < 2; ++a)
#pragma unroll
        for (int b = 0; b < 2; ++b)
#pragma unroll
            for (int m = 0; m < 4; ++m)
#pragma unroll
                for (int n = 0; n < 2; ++n) acc[a][b][m][n] = AccSel<Epi::I8>::zero();
    bf16x8 At[4][2], B0[2][2], B1[2][2];
    const char* const cA = (const char*)g.A; const char* cB = S.bbase(cur);
    PG8_AROWS(cur, vAc0, vAc1);
    S.a_ready(cur);
    { const float pfv0 = E.pf_load(S, cur, tid); E.pf_store(pfv0, lds, tid, 0); }
    PG8_STAGE(PG8_SB(0, 0), cB, voffB); PG8_STAGE(PG8_SA(0, 0), cA, vAc0); PG8_STAGE(PG8_SB(0, 1), cB + hstep, voffB); PG8_STAGE(PG8_SA(0, 1), cA, vAc1);
    if (wr == 1) PG8_BAR;
    PG8_WAIT_V(4); PG8_BAR;
    PG8_STAGE(PG8_SB(1, 0), cB + kstep, voffB); PG8_STAGE(PG8_SA(1, 0), cA + kstep, vAc0); PG8_STAGE(PG8_SB(1, 1), cB + hstep + kstep, voffB);
    PG8_WAIT_V(6); PG8_BAR;
    PG8_STAMP();
    for (;;) {
        const bool has_next = S.next(ui + 1, nxt);
        const char* nB = has_next ? S.bbase(nxt) : cB;
        if (has_next) PG8_AROWS(nxt, vAn0, vAn1); else { _Pragma("unroll") for (int _i = 0; _i < 2; ++_i) { vAn0[_i] = vAc0[_i]; vAn1[_i] = vAc1[_i]; } }
        const bool full = cur.hs < 0;
        for (int t = 0; t < nt; t += 2) {
            const bool last = (t == nt - 2);
            const char* a1 = cA + (size_t)(t + 1) * kstep;
            const char* a2 = last ? cA : cA + (size_t)(t + 2) * kstep; const char* b2 = last ? nB : cB + (size_t)(t + 2) * kstep;
            const char* a3 = a2 + kstep; const char* b3 = b2 + kstep;
            unsigned v20[2], v21[2];
#pragma unroll
            for (int _i = 0; _i < 2; ++_i) { v20[_i] = last ? vAn0[_i] : vAc0[_i]; v21[_i] = last ? vAn1[_i] : vAc1[_i]; }
            if (last && has_next) S.a_ready(nxt);
            PG8_LDB(B0, 0, 0); PG8_SCHED; PG8_LDA(At, 0, 0); PG8_STAGE(PG8_SA(1, 1), a1, vAc1);
            PG8_WAIT_L(8); PG8_BAR; PG8_WAIT_L(0); PG8_MMA(0, 0, At, B0); PG8_BAR; PG8_SCHED;
            PG8_LDB(B1, 0, 1); PG8_STAGE(PG8_SB(0, 0), b2, voffB);
            PG8_BAR; PG8_WAIT_L(0); PG8_MMA(0, 1, At, B1); PG8_BAR;
            if (full) PG8_LDA(At, 0, 1); PG8_STAGE(PG8_SA(0, 0), a2, v20);
            PG8_BAR; PG8_WAIT_L(0); if (full) PG8_MMA(1, 0, At, B0); PG8_BAR; PG8_SCHED;
            PG8_STAGE(PG8_SB(0, 1), b2 + hstep, voffB);
            PG8_WAIT_V(6); PG8_BAR; if (full) PG8_MMA(1, 1, At, B1); PG8_BAR;
            PG8_LDB(B0, 1, 0); PG8_SCHED; PG8_LDA(At, 1, 0); PG8_STAGE(PG8_SA(0, 1), a2, v21);
            PG8_WAIT_L(8); PG8_BAR; PG8_WAIT_L(0); PG8_MMA(0, 0, At, B0); PG8_BAR; PG8_SCHED;
            PG8_LDB(B1, 1, 1); PG8_STAGE(PG8_SB(1, 0), b3, voffB);
            PG8_BAR; PG8_WAIT_L(0); PG8_MMA(0, 1, At, B1); PG8_BAR;
            if (full) PG8_LDA(At, 1, 1); PG8_STAGE(PG8_SA(1, 0), a3, v20);
            PG8_BAR; PG8_WAIT_L(0); if (full) PG8_MMA(1, 0, At, B0); PG8_BAR; PG8_SCHED;
            PG8_STAGE(PG8_SB(1, 1), b3 + hstep, voffB);
            PG8_WAIT_V(6); PG8_BAR; if (full) PG8_MMA(1, 1, At, B1); PG8_BAR;
        }
        PG8_STAMP();
        const float pfv = has_next ? E.pf_load(S, nxt, tid) : 0.f;
        if constexpr (!Epi::AFTER_DRAIN) { E(acc, cur, wr, wc, fr, fq, lds, ui); S.done(cur); }
        if (has_next) E.pf_store(pfv, lds, tid, ui + 1);
        PG8_STAMP();
        if (!has_next) break;
#pragma unroll
        for (int a = 0; a < 2; ++a)
#pragma unroll
            for (int b = 0; b < 2; ++b)
#pragma unroll
                for (int m = 0; m < 4; ++m)
#pragma unroll
                    for (int n = 0; n < 2; ++n) acc[a][b][m][n] = AccSel<Epi::I8>::zero();
        cur = nxt; cB = nB; ++ui;
#pragma unroll
        for (int _i = 0; _i < 2; ++_i) { vAc0[_i] = vAn0[_i]; vAc1[_i] = vAn1[_i]; }
    }
    PG8_WAIT_V(0);
    if (wr == 0) PG8_BAR;
    PG8_BAR;
    if constexpr (Epi::AFTER_DRAIN) { E.fused(acc, cur, wr, wc, fr, fq, lds, wid, lane); S.done(cur); }
    PG8_STAMP();
    if (STAMP && wid == 0) { stamps[lane] = lane < nts ? (((unsigned long long)(unsigned)ts_hi << 32) | (unsigned)ts_lo) : 0ull;
        if (lane == 62) stamps[62] = rt_entry; if (lane == 63) stamps[63] = (unsigned long long)wall_clock64(); }
#undef PG8_STAMP
#undef PG8_SA
#undef PG8_AROWS
#undef PG8_SB
#undef PG8_STAGE
#undef PG8_LDA
#undef PG8_LDB
#undef PG8_MMA
#undef PG8_WAIT_V
#undef PG8_WAIT_L
#undef PG8_BAR
#undef PG8_SCHED
}
}
#define XB_TMO      128
#define XB_XCNT(j)  (256  + 64 * (j))
#define XB_XSUB(j)  (1280 + 64 * (j))
#define XB_XGEN(j)  (2304 + 64 * (j))
#define XB_TOP      3328
#define XB_TOPGEN   3392
#define XCD_BAR_WORDS 3456
#define XB_SPIN_CAP (1u << 24)

__device__ __forceinline__ unsigned xb_ld(unsigned* p)              { return __hip_atomic_load(p, __ATOMIC_RELAXED, __HIP_MEMORY_SCOPE_AGENT); }
__device__ __forceinline__ unsigned xb_add(unsigned* p, unsigned v) { return __hip_atomic_fetch_add(p, v, __ATOMIC_RELAXED, __HIP_MEMORY_SCOPE_AGENT); }
__device__ __forceinline__ unsigned xb_xcc_id() { return (unsigned)__builtin_amdgcn_s_getreg((3 << 11) | 20) & 0xFu; }
#define XB_SPIN(cond, bar) do { unsigned _sp = 0; while (cond) { __builtin_amdgcn_s_sleep(1); \
    if ((++_sp & 255u) == 0u) { if (xb_ld(&(bar)[XB_TMO])) break; if (_sp > XB_SPIN_CAP) { atomicAdd(&(bar)[XB_TMO], 1u); break; } } } } while (0)

struct XcdBarrier {
    unsigned* bar; unsigned x;
    volatile LAS unsigned* st;
};

__device__ __forceinline__ XcdBarrier xcd_barrier_post(unsigned* bar, volatile LAS unsigned* st) {
    XcdBarrier b; b.bar = bar; b.x = xb_xcc_id(); b.st = st;
    if (threadIdx.x == 0) (void)xb_add(&bar[XB_XCNT(b.x)], 1u);
    return b;
}
__device__ __forceinline__ void xcd_barrier_complete(unsigned* bar, unsigned x, unsigned& nloc, unsigned& nx) {
    const unsigned G = gridDim.x * gridDim.y * gridDim.z;
    unsigned sum, cnt, mine, sp = 0u;
    for (;;) {
        sum = 0u; cnt = 0u; mine = 0u;
#pragma unroll
        for (unsigned j = 0; j < 16; ++j) { const unsigned c = xb_ld(&bar[XB_XCNT(j)]); sum += c; cnt += (c > 0u) ? 1u : 0u; mine = (j == x) ? c : mine; }
        if (sum == G) break;
        __builtin_amdgcn_s_sleep(1);
        if ((++sp & 255u) == 0u) { if (xb_ld(&bar[XB_TMO])) break; if (sp > XB_SPIN_CAP) { atomicAdd(&bar[XB_TMO], 1u); break; } }
    }
    nloc = mine > 0u ? mine : 1u; nx = cnt > 0u ? cnt : 1u;
}

__device__ __forceinline__ void xcd_barrier(const XcdBarrier& b) {
    asm volatile("s_waitcnt vmcnt(0)" ::: "memory");
    __syncthreads();
    if (threadIdx.x == 0) {
        unsigned* bar = b.bar;
        __builtin_amdgcn_s_waitcnt(0);
        unsigned nloc = b.st[0], nx = b.st[1];
        if (nloc == 0u) { xcd_barrier_complete(bar, b.x, nloc, nx); b.st[0] = nloc; b.st[1] = nx; }
        const unsigned old = xb_add(&bar[XB_XSUB(b.x)], 1u);
        const unsigned gen = old / nloc;
        if (old + 1u == (gen + 1u) * nloc) {
            __builtin_amdgcn_fence(__ATOMIC_RELEASE, "agent");
            asm volatile("s_waitcnt vmcnt(0)" ::: "memory");
            const unsigned og = xb_add(&bar[XB_TOP], 1u);
            const unsigned tg = og / nx;
            if (og + 1u == (tg + 1u) * nx) xb_add(&bar[XB_TOPGEN], 1u);
            else XB_SPIN(xb_ld(&bar[XB_TOPGEN]) == tg, bar);
            __builtin_amdgcn_fence(__ATOMIC_ACQUIRE, "agent");
            xb_add(&bar[XB_XGEN(b.x)], 1u);
            asm volatile("s_waitcnt vmcnt(0)" ::: "memory");
        } else {
            XB_SPIN(xb_ld(&bar[XB_XGEN(b.x)]) == gen, bar);
            __builtin_amdgcn_fence(__ATOMIC_ACQUIRE, "agent");
            asm volatile("s_waitcnt vmcnt(0)" ::: "memory");
        }
    }
    __syncthreads();
}

constexpr int SCR_BYTES = 139264;
constexpr int MISC_OFF = 147456 - 128;
constexpr int LDS_BYTES = 147456;
constexpr int CW_BAR = 4096;
constexpr int NTHR = 512, NWAVES = 8;
constexpr int CW_COLMAX = 131072;
constexpr int N_QROWS = 2 * NPW + NUP + NEXP * NUP;
constexpr int CW_MOE = 8192;

__device__ __forceinline__ void transpose_item(const float* W, int ldw, int col0, int K, bf16_t* WT, int drow0, int kb, LAS float* scr, int lane, int gap16 = 0, unsigned* cmax = nullptr) {
    const int k0 = 64 * kb; const int cs = col0 + (lane & 31) + ((lane & 16) ? gap16 : 0);
    float v[32];
#pragma unroll
    for (int i = 0; i < 32; ++i) v[i] = W[(size_t)(k0 + 2 * i + (lane >> 5)) * ldw + cs];
#pragma unroll
    for (int i = 0; i < 32; ++i) scr[(2 * i + (lane >> 5)) * 33 + (lane & 31)] = v[i];
    asm volatile("s_waitcnt lgkmcnt(0)" ::: "memory");
    const int c = lane & 7;
#pragma unroll
    for (int j = 0; j < 4; ++j) { const int n = (lane >> 3) + 8 * j; const LAS float* s = scr + (8 * c) * 33 + n;
        u32x4 o; o.x = pk2(s[0 * 33], s[1 * 33]); o.y = pk2(s[2 * 33], s[3 * 33]); o.z = pk2(s[4 * 33], s[5 * 33]); o.w = pk2(s[6 * 33], s[7 * 33]);
        *(u32x4*)(WT + (size_t)(drow0 + n) * K + k0 + 8 * c) = o;
        if (cmax) {
            float am = fmaxf(fmaxf(fmaxf(fabsf(bflo(o.x)), fabsf(bfhi(o.x))), fmaxf(fabsf(bflo(o.y)), fabsf(bfhi(o.y)))), fmaxf(fmaxf(fabsf(bflo(o.z)), fabsf(bfhi(o.z))), fmaxf(fabsf(bflo(o.w)), fabsf(bfhi(o.w)))));
            am = fmaxf(am, swz_xor<1>(am)); am = fmaxf(am, swz_xor<2>(am)); am = fmaxf(am, swz_xor<4>(am));
            if (c == 0) atomicMax(cmax + drow0 + n, __float_as_uint(am)); } }
    asm volatile("s_waitcnt lgkmcnt(0)" ::: "memory");
}
__device__ __forceinline__ void up_item(const float* wg, const float* wu, bf16_t* WT, int it, LAS float* scr, int lane, unsigned* cmax) {
    const int nb = it >> 4, kb = it & 15, r0 = 32 * nb, pn = r0 >> 8, p = r0 & 255;
    transpose_item(p < 128 ? wg : wu, DFF, 128 * pn + (p & 127), DM, WT, r0, kb, scr, lane, 0, cmax);
}
__device__ __forceinline__ void dn_item(const float* wd, bf16_t* WT, int it, LAS float* scr, int lane) {
    const int nb = it / 44, kb = it % 44;
    transpose_item(wd, DM, 32 * nb, DFF, WT, 32 * nb, kb, scr, lane);
}
constexpr int IT_IN = 112 * 16, IT_OUT = 32 * 16, IT_UP = 176 * 16, IT_DN = 32 * 44;
constexpr int IT_TOTAL = 2 * IT_IN + 2 * IT_OUT + IT_UP + IT_DN + NEXP * (IT_UP + IT_DN);

__device__ __forceinline__ void convert_flat_item(const Args& a, unsigned char* ws, int it, LAS float* scr, int lane) {
    if (it < 2 * IT_IN) { const int l = it / IT_IN; it -= l * IT_IN; const int nb = it >> 4, kb = it & 15, r0 = 32 * nb;
        const int pn = r0 >> 8, p = r0 & 255; const bool hl = pn < 2 || (pn >= 8 && pn < 12);
        const int cbase = (pn < 8 ? 256 * pn : 256 * pn + 16);
        const int col0 = hl ? cbase + 64 * ((p >> 5) & 3) + 16 * (p >> 7) : cbase + p;
        transpose_item(a.in[8] + (size_t)l * DM * DIN, DIN, col0, DM, (bf16_t*)(ws + WS_WTIN) + (size_t)l * NPW * DM, r0, kb, scr, lane, hl ? 16 : 0, (unsigned*)(ws + WS_CTL) + CW_COLMAX + l * NPW); return; }
    it -= 2 * IT_IN;
    if (it < 2 * IT_OUT) { const int l = it / IT_OUT; it -= l * IT_OUT; const int nb = it >> 4, kb = it & 15;
        transpose_item(a.in[16] + (size_t)l * DM * DM, DM, 32 * nb, DM, (bf16_t*)(ws + WS_WTOUT) + (size_t)l * DM * DM, 32 * nb, kb, scr, lane); return; }
    it -= 2 * IT_OUT;
    if (it < IT_UP) { up_item(a.in[17], a.in[18], (bf16_t*)(ws + WS_WTUP), it, scr, lane, (unsigned*)(ws + WS_CTL) + CW_COLMAX + 2 * NPW); return; }
    it -= IT_UP;
    if (it < IT_DN) { dn_item(a.in[19], (bf16_t*)(ws + WS_WTDN), it, scr, lane); return; }
    it -= IT_DN;
    if (it < NEXP * IT_UP) { const int e = it / IT_UP; it -= e * IT_UP;
        up_item(a.in[21] + (size_t)e * DM * DFF, a.in[22] + (size_t)e * DM * DFF, (bf16_t*)(ws + WS_WTMUP) + (size_t)e * NUP * DM, it, scr, lane, (unsigned*)(ws + WS_CTL) + CW_COLMAX + 2 * NPW + NUP + e * NUP); return; }
    it -= NEXP * IT_UP;
    { const int e = it / IT_DN; it -= e * IT_DN; dn_item(a.in[23] + (size_t)e * DFF * DM, (bf16_t*)(ws + WS_WTMDN) + (size_t)e * DM * DFF, it, scr, lane); }
}
constexpr int N_EARLY = IT_IN + IT_OUT + IT_UP + IT_DN, N_DEFER = IT_TOTAL - N_EARLY, N_DEFER_L1 = IT_IN + IT_OUT;
__device__ __forceinline__ int early_to_flat(int i) { if (i < IT_IN) return i; i -= IT_IN; if (i < IT_OUT) return 2 * IT_IN + i; return 2 * IT_IN + 2 * IT_OUT + (i - IT_OUT); }
__device__ __forceinline__ int defer_to_flat(int d) { if (d < IT_IN) return IT_IN + d; d -= IT_IN; if (d < IT_OUT) return 2 * IT_IN + IT_OUT + d; return 2 * IT_IN + 2 * IT_OUT + IT_UP + IT_DN + (d - IT_OUT); }
#ifndef CVNB
#define CVNB 0
#endif
constexpr int N_MOE_ITEMS = NEXP * (IT_UP + IT_DN), CV_FIRST = NEXP * IT_UP;
constexpr int CV_HIDDEN_ = 2 * 128 * 8 * CVNB, CV_HIDDEN = CV_HIDDEN_ < NEXP * IT_DN ? CV_HIDDEN_ : NEXP * IT_DN;
__device__ __forceinline__ void convert_window(const Args& a, LAS unsigned char* lds, int lane, int wave, int G, int ph, int rank) {
    if (G != 256) return;
    unsigned char* ws = a.ws; LAS float* scr = (LAS float*)(lds + 65536 + wave * 8704);
    for (int j = 0; j < CVNB; ++j) { const int m = ((ph * 128 + rank) * NWAVES + wave) * CVNB + j; if (m < CV_HIDDEN) convert_flat_item(a, ws, defer_to_flat(N_DEFER_L1 + CV_FIRST + m), scr, lane); }
}
__device__ __forceinline__ unsigned pack_i8x4(float a, float b, float c, float d) {
    const int ia = __float2int_rn(a), ib = __float2int_rn(b), ic = __float2int_rn(c), id = __float2int_rn(d);
    return (unsigned)(ia & 0xff) | ((unsigned)(ib & 0xff) << 8) | ((unsigned)(ic & 0xff) << 16) | ((unsigned)(id & 0xff) << 24);
}
struct QStrip { const float* src; int ldw; unsigned char* dst; int qrow0; };
__device__ __forceinline__ QStrip quant_strip_decode(const Args& a, unsigned char* ws, int tid, int st) {
    const float* W; int ldw, col0, gap = 0; unsigned char* dst;
    if (st < 2 * (NPW / 32)) { const int l = st / (NPW / 32), r0 = 32 * (st - l * (NPW / 32)); const int pn = r0 >> 8, p = r0 & 255; const bool hl = pn < 2 || (pn >= 8 && pn < 12);
        const int cbase = (pn < 8 ? 256 * pn : 256 * pn + 16);
        W = a.in[8] + (size_t)l * DM * DIN; ldw = DIN; col0 = hl ? cbase + 64 * ((p >> 5) & 3) + 16 * (p >> 7) : cbase + p; gap = hl ? 16 : 0; dst = ws + WS_WTIN + (size_t)(l * NPW + r0) * 2048; }
    else { int s2 = st - 2 * (NPW / 32); const float* wg; const float* wu; unsigned char* base;
        if (s2 < NUP / 32) { wg = a.in[17]; wu = a.in[18]; base = ws + WS_WTUP; }
        else { s2 -= NUP / 32; const int e = s2 / (NUP / 32); s2 -= e * (NUP / 32); wg = a.in[21] + (size_t)e * DM * DFF; wu = a.in[22] + (size_t)e * DM * DFF; base = ws + WS_WTMUP + (size_t)e * NUP * 2048; }
        const int r0 = 32 * s2, pn = r0 >> 8, p = r0 & 255; W = p < 128 ? wg : wu; ldw = DFF; col0 = 128 * pn + (p & 127); dst = base + (size_t)r0 * 2048; }
    const int kk = tid >> 3, c4 = (tid & 7) * 4;
    QStrip q; q.src = W + col0 + c4 + (c4 >= 16 ? gap : 0) + (size_t)kk * ldw; q.ldw = ldw; q.dst = dst; q.qrow0 = 32 * st; return q;
}
__device__ __forceinline__ void quant_strip_load(const QStrip& q, f32x4 (&v)[16]) {
#pragma unroll
    for (int i = 0; i < 16; ++i) v[i] = *(const f32x4*)(q.src + (size_t)(64 * i) * q.ldw);
}
__device__ __forceinline__ void quant_strips(const Args& a, unsigned char* ws, LAS unsigned char* lds, int tid, int bid, int G) {
    LAS float* tile = (LAS float*)lds; LAS float* red = (LAS float*)(lds + 1024 * 33 * 4);
    const int nst = N_QROWS / 32; int st = bid; if (st >= nst) return;
    QStrip cur = quant_strip_decode(a, ws, tid, st); f32x4 v[16]; quant_strip_load(cur, v);
    for (;;) {
        __syncthreads();
        { const int kk = tid >> 3, c4 = (tid & 7) * 4;
#pragma unroll
          for (int i = 0; i < 16; ++i) { LAS float* tp = tile + (kk + 64 * i) * 33 + c4; tp[0] = v[i].x; tp[1] = v[i].y; tp[2] = v[i].z; tp[3] = v[i].w; } }
        __syncthreads();
        const int stn = st + G; const bool more = stn < nst; QStrip nxt = cur;
        if (more) { nxt = quant_strip_decode(a, ws, tid, stn); quant_strip_load(nxt, v); }
        const int n = tid & 31, ks = (tid >> 5) * 64;
        { float am = 0.f;
#pragma unroll 8
          for (int i = 0; i < 64; ++i) am = fmaxf(am, fabsf(tile[(ks + i) * 33 + n]));
          red[(tid >> 5) * 32 + n] = am; }
        __syncthreads();
        if (tid < 32) { float am = 0.f;
#pragma unroll
            for (int g = 0; g < 16; ++g) am = fmaxf(am, red[g * 32 + tid]);
            red[512 + tid] = am; ((unsigned*)(ws + WS_CTL) + CW_COLMAX)[cur.qrow0 + tid] = __float_as_uint(am); }
        __syncthreads();
        { const float am = red[512 + n]; const float inv = am > 0.f ? 127.0f / am : 0.f;
          unsigned char* op = cur.dst + (size_t)n * 2048 + ks;
#pragma unroll
          for (int q = 0; q < 4; ++q) { u32x4 o;
              o.x = pack_i8x4(tile[(ks + 16 * q + 0) * 33 + n] * inv, tile[(ks + 16 * q + 1) * 33 + n] * inv, tile[(ks + 16 * q + 2) * 33 + n] * inv, tile[(ks + 16 * q + 3) * 33 + n] * inv);
              o.y = pack_i8x4(tile[(ks + 16 * q + 4) * 33 + n] * inv, tile[(ks + 16 * q + 5) * 33 + n] * inv, tile[(ks + 16 * q + 6) * 33 + n] * inv, tile[(ks + 16 * q + 7) * 33 + n] * inv);
              o.z = pack_i8x4(tile[(ks + 16 * q + 8) * 33 + n] * inv, tile[(ks + 16 * q + 9) * 33 + n] * inv, tile[(ks + 16 * q + 10) * 33 + n] * inv, tile[(ks + 16 * q + 11) * 33 + n] * inv);
              o.w = pack_i8x4(tile[(ks + 16 * q + 12) * 33 + n] * inv, tile[(ks + 16 * q + 13) * 33 + n] * inv, tile[(ks + 16 * q + 14) * 33 + n] * inv, tile[(ks + 16 * q + 15) * 33 + n] * inv);
              *(u32x4*)(op + 16 * q) = o; } }
        if (!more) break;
        st = stn; cur = nxt;
    }
}
__device__ __forceinline__ void phase_prologue(const Args& a, LAS unsigned char* lds, int tid, int lane, int wave, int bid, int G) {
    unsigned char* ws = a.ws;
    quant_strips(a, ws, lds, tid, bid, G);
    __syncthreads();
    {
        LAS float* scr = (LAS float*)(lds + wave * 8704);
        const int gw = bid * NWAVES + wave, NGW = G * NWAVES;
        const int hid = (G == 256) ? CV_HIDDEN : 0, npro = N_EARLY + N_DEFER - hid;
        constexpr int NB16 = 2 * IT_OUT + IT_DN + NEXP * IT_DN;
        for (int i = gw; i < NB16; i += NGW) { int it = i;
            if (it < 2 * IT_OUT) { convert_flat_item(a, ws, 2 * IT_IN + it, scr, lane); continue; } it -= 2 * IT_OUT;
            if (it < IT_DN) { convert_flat_item(a, ws, 2 * IT_IN + 2 * IT_OUT + IT_UP + it, scr, lane); continue; } it -= IT_DN;
            convert_flat_item(a, ws, 2 * IT_IN + 2 * IT_OUT + IT_UP + IT_DN + NEXP * IT_UP + it, scr, lane); }
        (void)hid; (void)npro;
    }
    __syncthreads();
    {
        const int gt = bid * NTHR + tid;
        if (gt < 1024) { const int pos = gt >> 4, i = gt & 15;
            double inv = 1.0; for (int q = 0; q < i; ++q) inv *= 0.56234132519034908;
            const float angf = (float)pos * (float)inv; const double ang = (double)angf;
            const double kq = rint(ang * 0.63661977236758134); const double r = ang - kq * 1.5707963267948966 - kq * 6.123233995736766e-17; const double r2 = r * r;
            double sn = r * (1.0 + r2 * (-1.0 / 6 + r2 * (1.0 / 120 + r2 * (-1.0 / 5040 + r2 * (1.0 / 362880 + r2 * (-1.0 / 39916800 + r2 * (1.0 / 6227020800.0)))))));
            double cs = 1.0 + r2 * (-0.5 + r2 * (1.0 / 24 + r2 * (-1.0 / 720 + r2 * (1.0 / 40320 + r2 * (-1.0 / 3628800 + r2 * (1.0 / 479001600.0 + r2 * (-1.0 / 87178291200.0)))))));
            const int kk = ((int)kq) & 3; double c2, s2;
            if (kk == 0) { c2 = cs; s2 = sn; } else if (kk == 1) { c2 = -sn; s2 = cs; } else if (kk == 2) { c2 = -cs; s2 = -sn; } else { c2 = sn; s2 = -cs; }
            float* R = (float*)(ws + WS_ROPE); R[gt * 2] = (float)c2; R[gt * 2 + 1] = (float)s2; }
    }
    {
        LAS float* sc = (LAS float*)(lds + 73728);
        LAS float* red = (LAS float*)(lds + 73728 + 36864);
        for (int i = tid; i < 9 * 1024; i += NTHR) { const float v = i < 8192 ? a.in[1][i] : a.in[3][i - 8192]; sc[i] = v / (1.0f + __expf(-v)); }
        __syncthreads();
        for (int item = bid; item < 192; item += G) {
            const int l = item / 96, n0 = (item % 96) * 64;
            const float* wm = a.in[6] + (size_t)l * DM * 6144 + n0 + lane;
            float acc[9];
#pragma unroll
            for (int b = 0; b < 9; ++b) acc[b] = 0.f;
#pragma unroll 4
            for (int kk = 0; kk < 128; ++kk) { const int k = wave * 128 + kk; const float w = wm[(size_t)k * 6144];
#pragma unroll
                for (int b = 0; b < 9; ++b) acc[b] += sc[b * 1024 + k] * w; }
#pragma unroll
            for (int b = 0; b < 9; ++b) red[(wave * 9 + b) * 64 + lane] = acc[b];
            __syncthreads();
            for (int o = tid; o < 576; o += NTHR) { const int b = o >> 6, ln = o & 63; float s = a.in[7][(size_t)l * 6144 + n0 + ln];
#pragma unroll
                for (int w = 0; w < 8; ++w) s += red[(w * 9 + b) * 64 + ln];
                ((float*)(ws + WS_MOD))[((size_t)l * 9 + b) * 6144 + n0 + ln] = s; }
            __syncthreads();
        }
    }
}


typedef short bf16x8 __attribute__((ext_vector_type(8)));
typedef short s16x4 __attribute__((ext_vector_type(4)));
constexpr int IST = 160;
__device__ __forceinline__ f32x4 mfma16(bf16x8 a, bf16x8 b, f32x4 c) { return __builtin_amdgcn_mfma_f32_16x16x32_bf16(a, b, c, 0, 0, 0); }
__device__ __forceinline__ bf16x8 frag_row(LAS const unsigned char* img, int row0, int k0, int lane) {
    return *(const LAS bf16x8*)(img + (row0 + (lane & 15)) * IST + (k0 + 8 * (lane >> 4)) * 2);
}
template <bool PERMK>
__device__ __forceinline__ bf16x8 frag_tr(LAS const unsigned char* img, int r0, int c0, int lane) {
    const int g = lane >> 4, i = lane & 15, q = i >> 2, p = i & 3;
    const unsigned addr = (unsigned)(size_t)(img + (r0 + (PERMK ? 4 : 8) * g + q) * IST + (c0 + 4 * p) * 2);
    s16x4 lo, hi;
    if (PERMK) asm volatile("ds_read_b64_tr_b16 %0, %2\n\tds_read_b64_tr_b16 %1, %2 offset:2560\n\ts_waitcnt lgkmcnt(0)" : "=&v"(lo), "=&v"(hi) : "v"(addr) : "memory");
    else       asm volatile("ds_read_b64_tr_b16 %0, %2\n\tds_read_b64_tr_b16 %1, %2 offset:640\n\ts_waitcnt lgkmcnt(0)" : "=&v"(lo), "=&v"(hi) : "v"(addr) : "memory");
    bf16x8 r; r[0] = lo[0]; r[1] = lo[1]; r[2] = lo[2]; r[3] = lo[3]; r[4] = hi[0]; r[5] = hi[1]; r[6] = hi[2]; r[7] = hi[3];
    return r;
}
template <bool PERMK>
__device__ __forceinline__ void frag_tr_x4(LAS const unsigned char* img, int r0, int c0, int lane, bf16x8 (&out)[4]) {
    const int g = lane >> 4, i = lane & 15, q = i >> 2, p = i & 3;
    const unsigned addr = (unsigned)(size_t)(img + (r0 + (PERMK ? 4 : 8) * g + q) * IST + (c0 + 4 * p) * 2);
    s16x4 l0, h0, l1, h1, l2, h2, l3, h3;
    if (PERMK) asm volatile("ds_read_b64_tr_b16 %0, %8\n\tds_read_b64_tr_b16 %1, %8 offset:2560\n\tds_read_b64_tr_b16 %2, %8 offset:32\n\tds_read_b64_tr_b16 %3, %8 offset:2592\n\t"
                            "ds_read_b64_tr_b16 %4, %8 offset:64\n\tds_read_b64_tr_b16 %5, %8 offset:2624\n\tds_read_b64_tr_b16 %6, %8 offset:96\n\tds_read_b64_tr_b16 %7, %8 offset:2656\n\ts_waitcnt lgkmcnt(0)"
                            : "=&v"(l0), "=&v"(h0), "=&v"(l1), "=&v"(h1), "=&v"(l2), "=&v"(h2), "=&v"(l3), "=&v"(h3) : "v"(addr) : "memory");
    else       asm volatile("ds_read_b64_tr_b16 %0, %8\n\tds_read_b64_tr_b16 %1, %8 offset:640\n\tds_read_b64_tr_b16 %2, %8 offset:32\n\tds_read_b64_tr_b16 %3, %8 offset:672\n\t"
                            "ds_read_b64_tr_b16 %4, %8 offset:64\n\tds_read_b64_tr_b16 %5, %8 offset:704\n\tds_read_b64_tr_b16 %6, %8 offset:96\n\tds_read_b64_tr_b16 %7, %8 offset:736\n\ts_waitcnt lgkmcnt(0)"
                            : "=&v"(l0), "=&v"(h0), "=&v"(l1), "=&v"(h1), "=&v"(l2), "=&v"(h2), "=&v"(l3), "=&v"(h3) : "v"(addr) : "memory");
#define FT_PACK(o, lo, hi) o[0] = lo[0]; o[1] = lo[1]; o[2] = lo[2]; o[3] = lo[3]; o[4] = hi[0]; o[5] = hi[1]; o[6] = hi[2]; o[7] = hi[3];
    FT_PACK(out[0], l0, h0) FT_PACK(out[1], l1, h1) FT_PACK(out[2], l2, h2) FT_PACK(out[3], l3, h3)
#undef FT_PACK
}
__device__ __forceinline__ bf16x8 pack8(f32x4 a, f32x4 b) {
    union { u32x4 u; bf16x8 v; } x; x.u.x = pk2(a[0], a[1]); x.u.y = pk2(a[2], a[3]); x.u.z = pk2(b[0], b[1]); x.u.w = pk2(b[2], b[3]); return x.v;
}

__device__ __forceinline__ void phase_norm1(const Args& a, int l, LAS unsigned char* lds, int tid, int lane, int wave, int bid, int G) {
    unsigned char* ws = a.ws;
    constexpr int RST = 2064;
    LAS unsigned char* WgT = lds; LAS unsigned char* Himg = lds + 16 * RST; LAS float* red = (LAS float*)(lds + 32 * RST);
    { const float* w = a.in[8] + (size_t)l * DM * DIN + 2048;
      for (int i = tid; i < 16384; i += NTHR) { const int k = i >> 4, j = i & 15; *(LAS bf16_t*)(WgT + j * RST + k * 2) = (bf16_t)f2bf(w[(size_t)k * DIN + j]); } }
    __syncthreads();
    const float* gam = a.in[4] + (size_t)l * DM;
    const float* mod = (const float*)(ws + WS_MOD) + (size_t)l * 9 * 6144;
    unsigned char* H8 = ws + WS_H;
    for (int gi = bid; gi < MALL / 16; gi += G) {
#pragma unroll
        for (int rr = 0; rr < 2; ++rr) {
            const int r = 16 * gi + 2 * wave + rr; const bool lat = r < NLAT; const int bi = lat ? (r >> 11) : 8;
            const float* src = (l == 0) ? (lat ? a.in[0] + (size_t)r * DM : a.in[2] + (size_t)(r - NLAT) * DM) : (lat ? a.out + (size_t)r * DM : (const float*)(ws + WS_XC) + (size_t)(r - NLAT) * DM);
            f32x4 v[4]; float ss = 0.f;
#pragma unroll
            for (int j = 0; j < 4; ++j) { v[j] = *(const f32x4*)(src + 4 * lane + 256 * j); ss += (v[j].x * v[j].x + v[j].y * v[j].y) + (v[j].z * v[j].z + v[j].w * v[j].w); }
            const float rstd = rsqrtf(wave_sum(ss) * (1.0f / DM) + EPS);
            const float* mrow = mod + (size_t)bi * 6144;
#pragma unroll
            for (int j = 0; j < 4; ++j) { const int k = 4 * lane + 256 * j;
                const f32x4 g = *(const f32x4*)(gam + k), s = *(const f32x4*)(mrow + 1024 + k), sh = *(const f32x4*)(mrow + k);
                const f32x4 hv = v[j] * rstd * g * (1.0f + s) + sh; v[j] = hv;
                u32x2 w; w.x = pk2(hv.x, hv.y); w.y = pk2(hv.z, hv.w);
                *(LAS u32x2*)(Himg + (2 * wave + rr) * RST + k * 2) = w; }
            float am = 0.f;
#pragma unroll
            for (int j = 0; j < 4; ++j) am = fmaxf(am, fmaxf(fmaxf(fabsf(v[j].x), fabsf(v[j].y)), fmaxf(fabsf(v[j].z), fabsf(v[j].w))));
            am = wave_max(am); const float qs = am > 0.f ? 127.0f / am : 0.f;
#pragma unroll
            for (int j = 0; j < 4; ++j) *(unsigned*)(H8 + (size_t)r * DM + 4 * lane + 256 * j) = pack_i8x4(v[j].x * qs, v[j].y * qs, v[j].z * qs, v[j].w * qs);
            if (lane == 0) ((float*)(ws + WS_HS))[r] = am * (1.0f / 127.0f);
        }
        __syncthreads();
        f32x4 acc = {0.f, 0.f, 0.f, 0.f};
#pragma unroll
        for (int ks = 0; ks < 4; ++ks) { const int off = (lane & 15) * RST + (128 * wave + 32 * ks + 8 * (lane >> 4)) * 2;
            acc = mfma16(*(const LAS bf16x8*)(Himg + off), *(const LAS bf16x8*)(WgT + off), acc); }
        *(LAS f32x4*)(red + wave * 256 + lane * 4) = acc;
        __syncthreads();
        if (tid < 256) { const int ln = tid & 63, j = tid >> 6; float s = 0.f;
#pragma unroll
            for (int w = 0; w < 8; ++w) s += red[w * 256 + ln * 4 + j];
            const int row = 16 * gi + 4 * (ln >> 4) + j, gate = ln & 15;
            ((float*)(ws + WS_GATES))[(size_t)row * 16 + gate] = s + a.in[12][l * 16 + gate]; }
    }
}

template <int MODE>
__device__ __forceinline__ void phase_norm(const Args& a, int l, LAS unsigned char* lds, int tid, int lane, int wave, int bid, int G) {
    unsigned char* ws = a.ws;
    LAS float* WT = (LAS float*)lds;
    if (MODE == 0) { const float* w = a.in[8] + (size_t)l * DM * DIN + 2048; for (int i = tid; i < 16384; i += NTHR) { const int k = i >> 4, j = i & 15; WT[j * 1024 + k] = w[(size_t)k * DIN + j]; } __syncthreads(); }
    if (MODE == 2) { const float* w = a.in[20]; for (int i = tid; i < 8192; i += NTHR) { const int k = i >> 3, j = i & 7; WT[j * 1024 + k] = w[(size_t)k * 8 + j]; } __syncthreads(); }
    const float* gam = (MODE == 0 ? a.in[4] : a.in[5]) + (size_t)l * DM;
    const float* mod = (const float*)(ws + WS_MOD) + (size_t)l * 9 * 6144;
    const int shoff = MODE == 0 ? 0 : 3072, soff = MODE == 0 ? 1024 : 4096;
    const int nrows = (MODE == 2) ? NLAT : MALL;
    unsigned char* H8 = ws + WS_H;
    int nrec = 0;
    const int rstride = G * NWAVES;
    f32x4 vnext[4];
    { const int r = bid * NWAVES + wave; if (r < nrows) { const bool lat = r < NLAT;
        const float* src = (MODE == 0 && l == 0) ? (lat ? a.in[0] + (size_t)r * DM : a.in[2] + (size_t)(r - NLAT) * DM) : (lat ? a.out + (size_t)r * DM : (const float*)(ws + WS_XC) + (size_t)(r - NLAT) * DM);
#pragma unroll
        for (int j = 0; j < 4; ++j) vnext[j] = *(const f32x4*)(src + 4 * lane + 256 * j); } }
    for (int r = bid * NWAVES + wave; r < nrows; r += rstride) {
        const bool lat = r < NLAT; const int bi = lat ? (r >> 11) : 8;
        f32x4 v[4]; float ss = 0.f;
#pragma unroll
        for (int j = 0; j < 4; ++j) { v[j] = vnext[j]; ss += (v[j].x * v[j].x + v[j].y * v[j].y) + (v[j].z * v[j].z + v[j].w * v[j].w); }
        { const int rn = r + rstride; if (rn < nrows) { const bool latn = rn < NLAT;
            const float* srcn = (MODE == 0 && l == 0) ? (latn ? a.in[0] + (size_t)rn * DM : a.in[2] + (size_t)(rn - NLAT) * DM) : (latn ? a.out + (size_t)rn * DM : (const float*)(ws + WS_XC) + (size_t)(rn - NLAT) * DM);
#pragma unroll
            for (int j = 0; j < 4; ++j) vnext[j] = *(const f32x4*)(srcn + 4 * lane + 256 * j); } }
        const float rstd = rsqrtf(wave_sum(ss) * (1.0f / DM) + EPS);
        const float* mrow = mod + (size_t)bi * 6144;
#pragma unroll
        for (int j = 0; j < 4; ++j) { const int k = 4 * lane + 256 * j;
            const f32x4 g = *(const f32x4*)(gam + k), s = *(const f32x4*)(mrow + soff + k), sh = *(const f32x4*)(mrow + shoff + k);
            v[j] = v[j] * rstd * g * (1.0f + s) + sh; }
        { float am = 0.f;
#pragma unroll
          for (int j = 0; j < 4; ++j) am = fmaxf(am, fmaxf(fmaxf(fabsf(v[j].x), fabsf(v[j].y)), fmaxf(fabsf(v[j].z), fabsf(v[j].w))));
          am = wave_max(am); const float qs = am > 0.f ? 127.0f / am : 0.f;
#pragma unroll
          for (int j = 0; j < 4; ++j) *(unsigned*)(H8 + (size_t)r * DM + 4 * lane + 256 * j) = pack_i8x4(v[j].x * qs, v[j].y * qs, v[j].z * qs, v[j].w * qs);
          if (lane == 0) ((float*)(ws + WS_HS))[r] = am * (1.0f / 127.0f); }
        if (MODE == 0) {
            float p[16];
#pragma unroll
            for (int jg = 0; jg < 16; ++jg) p[jg] = 0.f;
#pragma unroll
            for (int jg = 0; jg < 16; ++jg) {
#pragma unroll
                for (int j = 0; j < 4; ++j) { const f32x4 w = *(const LAS f32x4*)(WT + jg * 1024 + 4 * lane + 256 * j); p[jg] += (v[j].x * w.x + v[j].y * w.y) + (v[j].z * w.z + v[j].w * w.w); }
                if ((jg & 3) == 3) asm volatile("" ::: "memory"); }
            const float tot = reduce16_lanes(p, lane);
            const int gid = ((lane >> 5) & 1) * 8 + ((lane >> 4) & 1) * 4 + ((lane >> 3) & 1) * 2 + ((lane >> 2) & 1);
            if ((lane & 3) == 0) ((float*)(ws + WS_GATES))[(size_t)r * 16 + gid] = tot + a.in[12][l * 16 + gid];
        }
        if (MODE == 2) {
            float p[8];
#pragma unroll
            for (int e = 0; e < 8; ++e) p[e] = 0.f;
#pragma unroll
            for (int e = 0; e < 8; ++e) {
#pragma unroll
                for (int j = 0; j < 4; ++j) { const f32x4 w = *(const LAS f32x4*)(WT + e * 1024 + 4 * lane + 256 * j); p[e] += (v[j].x * w.x + v[j].y * w.y) + (v[j].z * w.z + v[j].w * w.w); }
                if ((e & 3) == 3) asm volatile("" ::: "memory"); }
            const float tot = reduce8_lanes(p, lane);
            int i1 = 0, i2 = 0; float v1 = -3.0e38f, v2 = -3.0e38f;
#pragma unroll
            for (int e = 0; e < 8; ++e) { const float s = lane_bcast(tot, 32 * (e >> 2) + 16 * ((e >> 1) & 1) + 8 * (e & 1));
                if (s > v1) { v2 = v1; i2 = i1; v1 = s; i1 = e; } else if (s > v2) { v2 = s; i2 = e; } }
            const float w2 = 1.0f / (1.0f + __expf(v1 - v2)), w1 = 1.0f - w2;
            if (lane == 0) { LAS int* rec = (LAS int*)(lds + 32768) + nrec * 32 + wave * 4; rec[0] = i1; rec[1] = i2; rec[2] = __float_as_int(w1); rec[3] = __float_as_int(w2); }
            ++nrec;
        }
    }
    if (MODE == 2) {
        __syncthreads();
        if (tid < 8) {
            const int e = tid; const LAS int* rec = (const LAS int*)(lds + 32768); int cnt = 0;
            const int nk = (nrows - bid * NWAVES + G * NWAVES - 1) / (G * NWAVES);
            for (int k = 0; k < nk; ++k) for (int w = 0; w < NWAVES; ++w) { const int r = bid * NWAVES + w + k * G * NWAVES; if (r < nrows) { const LAS int* q = rec + k * 32 + w * 4; cnt += (q[0] == e) + (q[1] == e); } }
            int pos = (int)atomicAdd((unsigned*)(ws + WS_CTL) + CW_MOE + 64 * e, (unsigned)cnt);
            int* LIST = (int*)(ws + WS_LIST) + e * NLAT; int* TOK = (int*)(ws + WS_COMB);
            for (int k = 0; k < nk; ++k) for (int w = 0; w < NWAVES; ++w) { const int r = bid * NWAVES + w + k * G * NWAVES; if (r < nrows) { const LAS int* q = rec + k * 32 + w * 4;
                if (q[0] == e) { LIST[pos] = r; TOK[r * 8 + 0] = e; TOK[r * 8 + 2] = pos; TOK[r * 8 + 4] = q[2]; ++pos; }
                if (q[1] == e) { LIST[pos] = r; TOK[r * 8 + 1] = e; TOK[r * 8 + 3] = pos; TOK[r * 8 + 5] = q[3]; ++pos; } } }
        }
    }
}

__device__ __forceinline__ void phase_post(const Args& a, int l, int lane, int wave, int bid, int G) {
    unsigned char* ws = a.ws;
    bf16_t* P = (bf16_t*)(ws + WS_BIG); bf16_t* MQK = (bf16_t*)(ws + WS_MQK);
    const float* ROPE = (const float*)(ws + WS_ROPE);
    const float* cw = a.in[10] + (size_t)l * 3 * 512; const float* cb = a.in[11] + (size_t)l * 512;
    const float qg = a.in[13][l * 64 + lane], kg = a.in[14][l * 64 + lane];
    for (int r = bid * NWAVES + wave; r < MALL; r += G * NWAVES) {
        const bool lat = r < NLAT; bf16_t* row = P + (size_t)r * NPW;
        int t, tlen; if (lat) { t = r & (SEQ - 1); tlen = SEQ; } else { t = (r - NLAT) & (CTXL - 1); tlen = CTXL; }
        if (lat) { const int gr = t >> 6, gc = t & 63;
#pragma unroll
            for (int blk = 0; blk < 2; ++blk)
#pragma unroll
                for (int ii = 0; ii < 2; ++ii) { const int pid = lane + 64 * ii, head = pid >> 5, half = (pid >> 4) & 1, i = pid & 15, c1 = (blk ? PC_RK : PC_RQ) + head * 64 + half * 32 + i;
                    const int pos = half ? gc : gr; const float cs = ROPE[(pos * 16 + i) * 2], sn = ROPE[(pos * 16 + i) * 2 + 1];
                    const float x1 = bf2f(row[c1]), x2 = bf2f(row[c1 + 16]); const float sc = blk ? 0.125f : 1.0f;
                    row[c1] = (bf16_t)f2bf((x1 * cs - x2 * sn) * sc); row[c1 + 16] = (bf16_t)f2bf((x1 * sn + x2 * cs) * sc); }
        } else {
#pragma unroll
            for (int ii = 0; ii < 4; ++ii) { const int c = PC_RK + lane + 64 * ii; row[c] = (bf16_t)f2bf(bf2f(row[c]) * 0.125f); }
        }
#pragma unroll
        for (int ii = 0; ii < 8; ++ii) { const int c = lane + 64 * ii;
            const float x0 = bf2f(row[PC_MQ + c]);
            const float xm = t > 0 ? bf2f(row[PC_MQ + c - NPW]) : 0.f, xp = t < tlen - 1 ? bf2f(row[PC_MQ + c + NPW]) : 0.f;
            float y = cb[c] + cw[c] * xm + cw[512 + c] * x0 + cw[1024 + c] * xp;
            y = y / (1.0f + __expf(-y)); if (c >= 256) y *= 0.125f;
            MQK[(size_t)r * 512 + c] = (bf16_t)f2bf(y); }
#pragma unroll
        for (int hh = 0; hh < 16; ++hh) { const int c = PC_NQ + hh * 64 + lane; const float v = bf2f(row[c]);
            const float rs = rsqrtf(wave_sum(v * v) * (1.0f / 64.0f) + EPS);
            row[c] = (bf16_t)f2bf(v * rs * (hh < 8 ? qg : kg)); }
    }
}


__device__ __forceinline__ int hl_off(int hl, int c) { return c < 32 ? 32 * hl + c : 128 + 32 * hl + (c - 32); }
__device__ __forceinline__ u32x4 conv8_pack(const bf16_t* P, int row, int ch, bool hasm, bool hasp, const LAS float* CW) {
    const bf16_t* src = P + (size_t)row * NPW + PC_MQ + ch;
    const u32x4 x0 = *(const u32x4*)src; u32x4 xm = {0u, 0u, 0u, 0u}, xp = xm;
    if (hasm) xm = *(const u32x4*)(src - NPW);
    if (hasp) xp = *(const u32x4*)(src + NPW);
    const f32x4 w0a = *(const LAS f32x4*)(CW + ch), w0b = *(const LAS f32x4*)(CW + ch + 4), w1a = *(const LAS f32x4*)(CW + 512 + ch), w1b = *(const LAS f32x4*)(CW + 512 + ch + 4);
    const f32x4 w2a = *(const LAS f32x4*)(CW + 1024 + ch), w2b = *(const LAS f32x4*)(CW + 1024 + ch + 4), ba = *(const LAS f32x4*)(CW + 1536 + ch), bb = *(const LAS f32x4*)(CW + 1536 + ch + 4);
    float y[8];
    y[0] = ba[0] + w0a[0] * bflo(xm.x) + w1a[0] * bflo(x0.x) + w2a[0] * bflo(xp.x); y[1] = ba[1] + w0a[1] * bfhi(xm.x) + w1a[1] * bfhi(x0.x) + w2a[1] * bfhi(xp.x);
    y[2] = ba[2] + w0a[2] * bflo(xm.y) + w1a[2] * bflo(x0.y) + w2a[2] * bflo(xp.y); y[3] = ba[3] + w0a[3] * bfhi(xm.y) + w1a[3] * bfhi(x0.y) + w2a[3] * bfhi(xp.y);
    y[4] = bb[0] + w0b[0] * bflo(xm.z) + w1b[0] * bflo(x0.z) + w2b[0] * bflo(xp.z); y[5] = bb[1] + w0b[1] * bfhi(xm.z) + w1b[1] * bfhi(x0.z) + w2b[1] * bfhi(xp.z);
    y[6] = bb[2] + w0b[2] * bflo(xm.w) + w1b[2] * bflo(x0.w) + w2b[2] * bflo(xp.w); y[7] = bb[3] + w0b[3] * bfhi(xm.w) + w1b[3] * bfhi(x0.w) + w2b[3] * bfhi(xp.w);
    const float sc = ch >= 256 ? 0.125f : 1.0f;
#pragma unroll
    for (int j = 0; j < 8; ++j) y[j] = y[j] / (1.0f + __expf(-y[j])) * sc;
    u32x4 o; o.x = pk2(y[0], y[1]); o.y = pk2(y[2], y[3]); o.z = pk2(y[4], y[5]); o.w = pk2(y[6], y[7]); return o;
}
__device__ __forceinline__ void conv_weights_to_lds(const Args& a, int l, LAS float* CW, int tid) {
    for (int i = tid; i < 2048; i += NTHR) CW[i] = i < 1536 ? a.in[10][(size_t)l * 1536 + i] : a.in[11][(size_t)l * 512 + (i - 1536)];
}
__device__ __forceinline__ int chunk_row0(int b, int dir, int sc) {
    if (dir == 0) return sc < 2 ? NLAT + b * CTXL + 128 * sc : b * SEQ + 128 * (sc - 2);
    return sc < 2 ? NLAT + b * CTXL + 128 * (1 - sc) : b * SEQ + 128 * (17 - sc);
}
constexpr size_t U_BYTES = 80 * 64 * 2;

__device__ __forceinline__ void phase_chunk_sums(const Args& a, int l, LAS unsigned char* lds, int tid, int lane, int wave, int bid, int G) {
    unsigned char* ws = a.ws;
    const bf16_t* P = (const bf16_t*)(ws + WS_BIG);
    const float* GT = (const float*)(ws + WS_GATES);
    LAS unsigned char* Kimg = lds; LAS unsigned char* VFimg = lds + 20480; LAS unsigned char* VBimg = lds + 40960;
    LAS float* wkF = (LAS float*)(lds + 61440); LAS float* wkB = wkF + 128;
    LAS float* CW = (LAS float*)(lds + 62464); conv_weights_to_lds(a, l, CW, tid); __syncthreads();
    const int nitems = 2 * NB * 4 * 18;
    for (int it = bid; it < nitems; it += G) {
        const int cc = it % 18; int r_ = it / 18; const int h = r_ & 3; r_ >>= 2; const int b = r_ & 7; const int kind = r_ >> 3;
        const bool isctx = cc >= 16; const int c = isctx ? cc - 16 : cc;
        const int row0 = isctx ? NLAT + b * CTXL + 128 * c : b * SEQ + 128 * c;
        const int scf = isctx ? c : 2 + c, scb = isctx ? 1 - c : 17 - c;
        const int r = tid >> 2, c8 = (tid & 3) * 16;
        const bf16_t* vsrc = P + (size_t)(row0 + r) * NPW + (kind == 0 ? PC_RV : PC_MV) + h * 64 + c8;
        const u32x4 v0 = *(const u32x4*)vsrc, v1 = *(const u32x4*)(vsrc + 8);
        u32x4 k0, k1;
        if (kind == 0) { const bf16_t* ksrc = P + (size_t)(row0 + r) * NPW + PC_RK + hl_off(h, c8); k0 = *(const u32x4*)ksrc; k1 = *(const u32x4*)(ksrc + 8); }
        else { const int t = 128 * c + r; const bool hasm = t > 0, hasp = t < (isctx ? CTXL : SEQ) - 1;
            k0 = conv8_pack(P, row0 + r, 256 + h * 64 + c8, hasm, hasp, CW); k1 = conv8_pack(P, row0 + r, 256 + h * 64 + c8 + 8, hasm, hasp, CW);
            bf16_t* mq = (bf16_t*)(ws + WS_MQK) + (size_t)(row0 + r) * 512 + h * 64 + c8;
            *(u32x4*)(mq + 256) = k0; *(u32x4*)(mq + 256 + 8) = k1;
            *(u32x4*)mq = conv8_pack(P, row0 + r, h * 64 + c8, hasm, hasp, CW); *(u32x4*)(mq + 8) = conv8_pack(P, row0 + r, h * 64 + c8 + 8, hasm, hasp, CW); }
        __syncthreads();
        if (kind == 0) { if (tid < 256) { const int dir = tid >> 7, i = tid & 127; const float lg = logsigmoidf_(a.in[9][(l * 2 + dir) * 4 + h]); (dir ? wkB : wkF)[i] = __expf(lg * (float)(dir == 0 ? 127 - i : i)); } }
        else if (wave < 2) {
            const int dir = wave;
            const float g0i = GT[(size_t)(row0 + lane) * 16 + 4 * dir + h], g1i = GT[(size_t)(row0 + 64 + lane) * 16 + 4 * dir + h];
            const float f0 = logsigmoidf_(GT[(size_t)(row0 + lane) * 16 + 8 + 4 * dir + h]), f1 = logsigmoidf_(GT[(size_t)(row0 + 64 + lane) * 16 + 8 + 4 * dir + h]);
            float s0 = f0, s1 = f1;
#pragma unroll
            for (int o = 1; o < 64; o <<= 1) { const int sl = lane >= o ? lane - o : lane; const float u0 = lane_get(s0, sl), u1 = lane_get(s1, sl); if (lane >= o) { s0 += u0; s1 += u1; } }
            const float t0 = lane_bcast(s0, 63), t1 = lane_bcast(s1, 63), tot = t0 + t1;
            float b0, b1;
            if (dir == 0) { b0 = s0; b1 = t0 + s1; } else { b0 = tot - s0 + f0; b1 = t1 - s1 + f1; }
            const float a0 = g0i - b0, a1 = g1i - b1; const float amax = wave_max(fmaxf(a0, a1));
            float x0 = a0, x1 = a1;
            if (dir == 0) {
#pragma unroll
                for (int o = 1; o < 64; o <<= 1) { const int sl = lane >= o ? lane - o : lane; const float u0 = lane_get(x0, sl), u1 = lane_get(x1, sl); if (lane >= o) { x0 = fmaxf(x0, u0); x1 = fmaxf(x1, u1); } }
                x1 = fmaxf(x1, lane_bcast(x0, 63));
            } else {
#pragma unroll
                for (int o = 1; o < 64; o <<= 1) { const int sl = lane + o < 64 ? lane + o : lane; const float u0 = lane_get(x0, sl), u1 = lane_get(x1, sl); if (lane + o < 64) { x0 = fmaxf(x0, u0); x1 = fmaxf(x1, u1); } }
                x0 = fmaxf(x0, lane_bcast(x1, 0));
            }
            LAS float* wk = dir ? wkB : wkF;
            wk[lane] = __expf(a0 - amax); wk[lane + 64] = __expf(a1 - amax);
            float* ga = (float*)(ws + WS_GARR) + ((size_t)(((b * 4 + h) * 18 + cc) * 2 + dir)) * 384;
            ga[lane] = a0; ga[lane + 64] = a1; ga[128 + lane] = b0; ga[128 + lane + 64] = b1; ga[256 + lane] = x0; ga[256 + lane + 64] = x1;
            if (lane == 0) { float* usc = (float*)(ws + WS_USC) + ((size_t)((b * 4 + h) * 2 + dir) * 18 + (dir ? scb : scf)) * 2; usc[0] = tot; usc[1] = amax; }
        }
        __syncthreads();
        {
            *(LAS u32x4*)(Kimg + r * IST + c8 * 2) = k0; *(LAS u32x4*)(Kimg + r * IST + c8 * 2 + 16) = k1;
#pragma unroll
            for (int dir = 0; dir < 2; ++dir) {
                const float w = (dir ? wkB : wkF)[r]; LAS unsigned char* Vimg = dir ? VBimg : VFimg;
                u32x4 o0, o1;
                o0.x = pk2(bflo(v0.x) * w, bfhi(v0.x) * w); o0.y = pk2(bflo(v0.y) * w, bfhi(v0.y) * w); o0.z = pk2(bflo(v0.z) * w, bfhi(v0.z) * w); o0.w = pk2(bflo(v0.w) * w, bfhi(v0.w) * w);
                o1.x = pk2(bflo(v1.x) * w, bfhi(v1.x) * w); o1.y = pk2(bflo(v1.y) * w, bfhi(v1.y) * w); o1.z = pk2(bflo(v1.z) * w, bfhi(v1.z) * w); o1.w = pk2(bflo(v1.w) * w, bfhi(v1.w) * w);
                *(LAS u32x4*)(Vimg + r * IST + c8 * 2) = o0; *(LAS u32x4*)(Vimg + r * IST + c8 * 2 + 16) = o1;
                if ((tid & 3) == 0) { unsigned zz; asm volatile("v_mov_b32 %0, 0" : "=v"(zz)); u32x4 e0; e0.x = f2bf(w); e0.y = zz; e0.z = zz; e0.w = zz; u32x4 z; z.x = zz; z.y = zz; z.z = zz; z.w = zz;
                    *(LAS u32x4*)(Vimg + r * IST + 128) = e0; *(LAS u32x4*)(Vimg + r * IST + 144) = z; }
            }
        }
        __syncthreads();
        {
            const int dt = wave & 3, dir = wave >> 2; LAS const unsigned char* Vimg = dir ? VBimg : VFimg;
            f32x4 u[5];
#pragma unroll
            for (int et = 0; et < 5; ++et) u[et] = (f32x4){0.f, 0.f, 0.f, 0.f};
#pragma unroll
            for (int ks = 0; ks < 4; ++ks) {
                const bf16x8 af = frag_tr<false>(Kimg, 32 * ks, 16 * dt, lane);
                bf16x8 bx[4]; frag_tr_x4<false>(Vimg, 32 * ks, 0, lane, bx); const bf16x8 b4 = frag_tr<false>(Vimg, 32 * ks, 64, lane);
#pragma unroll
                for (int et = 0; et < 4; ++et) u[et] = mfma16(af, bx[et], u[et]);
                u[4] = mfma16(af, b4, u[4]);
            }
            bf16_t* U = (bf16_t*)(ws + WS_U + ((size_t)(((kind * NB + b) * 4 + h) * 2 + dir) * 18 + (dir ? scb : scf)) * U_BYTES);
            const int g = lane >> 4, e = lane & 15, d0 = 16 * dt + 4 * g;
#pragma unroll
            for (int et = 0; et < 5; ++et) if (et < 4 || kind == 1) { u32x2 w; w.x = pk2(u[et][0], u[et][1]); w.y = pk2(u[et][2], u[et][3]); *(u32x2*)(U + (size_t)(16 * et + e) * 64 + d0) = w; }
        }
    }
}

__device__ __forceinline__ void phase_chunk_states(const Args& a, int l, int tid, int bid, int G) {
    unsigned char* ws = a.ws;
    for (int it = bid; it < 2 * NB * 4 * 2; it += G) {
        const int dir = it & 1, h = (it >> 1) & 3, b = (it >> 3) & 7, kind = it >> 6;
        const size_t seq = (size_t)(((kind * NB + b) * 4 + h) * 2 + dir) * 18;
        const unsigned char* Ub = ws + WS_U + seq * U_BYTES; unsigned char* Sb = ws + WS_S + seq * U_BYTES;
        const float* usc = (const float*)(ws + WS_USC) + (size_t)((b * 4 + h) * 2 + dir) * 18 * 2;
        float* sm = (float*)(ws + WS_SM) + (size_t)((b * 4 + h) * 2 + dir) * 18;
        const float dec_ret = __expf(128.0f * logsigmoidf_(a.in[9][(l * 2 + dir) * 4 + h]));
        float blv[18], amv[18];
#pragma unroll
        for (int s = 0; s < 18; ++s) { blv[s] = kind == 0 ? 0.f : usc[2 * s]; amv[s] = kind == 0 ? 0.f : usc[2 * s + 1]; }
        const int nrow = kind == 0 ? 512 : 520;
        for (int ci = tid; ci < nrow; ci += NTHR) {
            u32x4 v[18];
#pragma unroll
            for (int s = 0; s < 18; ++s) v[s] = *(const u32x4*)(Ub + (size_t)s * U_BYTES + (size_t)ci * 16);
            float acc[8];
#pragma unroll
            for (int j = 0; j < 8; ++j) acc[j] = 0.f;
            float m = 0.f;
#pragma unroll
            for (int s = 0; s < 18; ++s) {
                u32x4 o; o.x = pk2(acc[0], acc[1]); o.y = pk2(acc[2], acc[3]); o.z = pk2(acc[4], acc[5]); o.w = pk2(acc[6], acc[7]);
                *(u32x4*)(Sb + (size_t)s * U_BYTES + (size_t)ci * 16) = o;
                float dk, ck;
                if (kind == 0) { dk = dec_ret; ck = 1.0f; }
                else { if (ci == 0) sm[s] = m; const float bl = blv[s], am = amv[s]; const float mx = fmaxf(m, am); dk = __expf(m - mx); ck = __expf(am - mx); m = bl + mx; }
                acc[0] = dk * acc[0] + ck * bflo(v[s].x); acc[1] = dk * acc[1] + ck * bfhi(v[s].x); acc[2] = dk * acc[2] + ck * bflo(v[s].y); acc[3] = dk * acc[3] + ck * bfhi(v[s].y);
                acc[4] = dk * acc[4] + ck * bflo(v[s].z); acc[5] = dk * acc[5] + ck * bfhi(v[s].z); acc[6] = dk * acc[6] + ck * bflo(v[s].w); acc[7] = dk * acc[7] + ck * bfhi(v[s].w);
            }
        }
    }
}

template <int KIND>
__device__ __forceinline__ float load_state(const unsigned char* ws, int b, int h, int dir, int sc, LAS unsigned char* Simg, int tid) {
    const unsigned char* Sp = ws + WS_S + ((size_t)((((KIND * NB + b) * 4 + h) * 2 + dir) * 18) + sc) * U_BYTES;
    *(LAS u32x4*)(Simg + (tid >> 3) * IST + (tid & 7) * 16) = *(const u32x4*)(Sp + (size_t)tid * 16);
    if (KIND == 1 && tid < 8) *(LAS u32x4*)(Simg + 64 * IST + tid * 16) = *(const u32x4*)(Sp + (size_t)(512 + tid) * 16);
    return KIND == 1 ? ((const float*)(ws + WS_SM))[(size_t)((b * 4 + h) * 2 + dir) * 18 + sc] : 0.f;
}

template <int KIND>
__device__ __forceinline__ void phase_chunk_out(const Args& a, int l, bool need_ctx, LAS unsigned char* lds, int tid, int lane, int wave, int bid, int G) {
    unsigned char* ws = a.ws;
    const bf16_t* P = (const bf16_t*)(ws + WS_BIG);
    const float* GT = (const float*)(ws + WS_GATES); bf16_t* MG = (bf16_t*)(ws + WS_H);
    LAS unsigned char* Qimg = lds; LAS unsigned char* Kimg = lds + 20480; LAS unsigned char* Vimg = lds + 40960;
    LAS unsigned char* SFimg = lds + 61440; LAS unsigned char* SBimg = lds + 74240;
    LAS float* AF = (LAS float*)(lds + 87040); LAS float* CF = AF + 128; LAS float* BF = AF + 256; LAS float* AB = AF + 384; LAS float* CB = AF + 512; LAS float* BB = AF + 640;
    const int nch = need_ctx ? 18 : 16, nitems = NB * 4 * nch;
    const int g = lane >> 4, qi = 16 * wave + (lane & 15);
    for (int it = (bid + G - (KIND == 0 ? 0 : 64) % G) % G; it < nitems; it += G) {
        const int cc = it % nch; const int bh = it / nch; const int h = bh & 3, b = bh >> 2;
        const bool isctx = cc >= 16; const int c = isctx ? cc - 16 : cc;
        const int row0 = isctx ? NLAT + b * CTXL + 128 * c : b * SEQ + 128 * c;
        const int scf = isctx ? c : 2 + c, scb = isctx ? 1 - c : 17 - c;
        __syncthreads();
        {
            const int r = tid >> 2, c8 = (tid & 3) * 16;
            const bf16_t* vsrc = P + (size_t)(row0 + r) * NPW + (KIND == 0 ? PC_RV : PC_MV) + h * 64 + c8;
            u32x4 q0, q1, k0, k1;
            if (KIND == 0) { const bf16_t* qsrc = P + (size_t)(row0 + r) * NPW + PC_RQ + hl_off(h, c8); const bf16_t* ksrc = P + (size_t)(row0 + r) * NPW + PC_RK + hl_off(h, c8);
                q0 = *(const u32x4*)qsrc; q1 = *(const u32x4*)(qsrc + 8); k0 = *(const u32x4*)ksrc; k1 = *(const u32x4*)(ksrc + 8); }
            else { const bf16_t* mq = (const bf16_t*)(ws + WS_MQK) + (size_t)(row0 + r) * 512 + h * 64 + c8;
                q0 = *(const u32x4*)mq; q1 = *(const u32x4*)(mq + 8); k0 = *(const u32x4*)(mq + 256); k1 = *(const u32x4*)(mq + 256 + 8); }
            const u32x4 v0 = *(const u32x4*)vsrc, v1 = *(const u32x4*)(vsrc + 8);
            *(LAS u32x4*)(Qimg + r * IST + c8 * 2) = q0; *(LAS u32x4*)(Qimg + r * IST + c8 * 2 + 16) = q1;
            *(LAS u32x4*)(Kimg + r * IST + c8 * 2) = k0; *(LAS u32x4*)(Kimg + r * IST + c8 * 2 + 16) = k1;
            *(LAS u32x4*)(Vimg + r * IST + c8 * 2) = v0; *(LAS u32x4*)(Vimg + r * IST + c8 * 2 + 16) = v1;
            if ((tid & 3) == 0) { unsigned zz, one; asm volatile("v_mov_b32 %0, 0\n\tv_mov_b32 %1, 0x3f80" : "=v"(zz), "=v"(one)); u32x4 e0; e0.x = one; e0.y = zz; e0.z = zz; e0.w = zz; u32x4 z; z.x = zz; z.y = zz; z.z = zz; z.w = zz;
                *(LAS u32x4*)(Vimg + r * IST + 128) = e0; *(LAS u32x4*)(Vimg + r * IST + 144) = z; }
        }
        const float mpf = load_state<KIND>(ws, b, h, 0, scf, SFimg, tid);
        const float mpb = load_state<KIND>(ws, b, h, 1, scb, SBimg, tid);
        if (KIND == 1) {
            const float* ga = (const float*)(ws + WS_GARR) + (size_t)((b * 4 + h) * 18 + cc) * 768;
            for (int i = tid; i < 768; i += NTHR) { const int dir = i / 384, which = (i - dir * 384) >> 7, j = i & 127; float v = ga[i];
                if (which == 2) v = fmaxf(v, dir ? mpb : mpf);
                AF[dir * 384 + (which == 0 ? 0 : (which == 1 ? 256 : 128)) + j] = v; }
        }
        __syncthreads();
        const bf16x8 bq0 = frag_row(Qimg, 16 * wave, 0, lane), bq1 = frag_row(Qimg, 16 * wave, 32, lane);
        f32x4 st[8];
#pragma unroll
        for (int kt = 0; kt < 8; ++kt) { f32x4 z = {0.f, 0.f, 0.f, 0.f}; z = mfma16(frag_row(Kimg, 16 * kt, 0, lane), bq0, z); st[kt] = mfma16(frag_row(Kimg, 16 * kt, 32, lane), bq1, z); }
        const int row = row0 + qi;
        if (KIND == 0) {
            const float lgf = logsigmoidf_(a.in[9][(l * 2 + 0) * 4 + h]), lgb = logsigmoidf_(a.in[9][(l * 2 + 1) * 4 + h]);
            f32x4 acc[4];
#pragma unroll
            for (int et = 0; et < 4; ++et) {
                f32x4 zf = {0.f, 0.f, 0.f, 0.f}, zb = zf;
                zf = mfma16(frag_row(SFimg, 16 * et, 0, lane), bq0, zf); zf = mfma16(frag_row(SFimg, 16 * et, 32, lane), bq1, zf);
                zb = mfma16(frag_row(SBimg, 16 * et, 0, lane), bq0, zb); zb = mfma16(frag_row(SBimg, 16 * et, 32, lane), bq1, zb);
                acc[et] = zf * __expf(lgf * (float)(qi + 1)) + zb * __expf(lgb * (float)(128 - qi));
            }
#pragma unroll
            for (int T = 0; T < 4; ++T) {
                f32x4 p0, p1;
#pragma unroll
                for (int j = 0; j < 4; ++j) {
                    const int k0 = 32 * T + 4 * g + j, k1 = k0 + 16;
                    const float w0 = (k0 <= qi ? __expf(lgf * (float)(qi - k0)) : 0.f) + (k0 >= qi ? __expf(lgb * (float)(k0 - qi)) : 0.f);
                    const float w1 = (k1 <= qi ? __expf(lgf * (float)(qi - k1)) : 0.f) + (k1 >= qi ? __expf(lgb * (float)(k1 - qi)) : 0.f);
                    p0[j] = st[2 * T][j] * w0; p1[j] = st[2 * T + 1][j] * w1;
                }
                const bf16x8 bp = pack8(p0, p1);
{ bf16x8 va[4]; frag_tr_x4<true>(Vimg, 32 * T, 0, lane, va);
#pragma unroll
                for (int et = 0; et < 4; ++et) acc[et] = mfma16(va[et], bp, acc[et]); }
            }
            float ss = 0.f;
#pragma unroll
            for (int et = 0; et < 4; ++et) ss += (acc[et][0] * acc[et][0] + acc[et][1] * acc[et][1]) + (acc[et][2] * acc[et][2] + acc[et][3] * acc[et][3]);
            ss = sum_g4(ss);
            const float rs = rsqrtf(ss * (1.0f / 64.0f) + EPS);
#pragma unroll
            for (int et = 0; et < 4; ++et) { const int e0 = h * 64 + 16 * et + 4 * g;
                const u32x2 gw = *(const u32x2*)(P + (size_t)row * NPW + PC_RG + e0);
                u32x2 o; o.x = pk2(siluf_(bflo(gw.x)) * acc[et][0] * rs, siluf_(bfhi(gw.x)) * acc[et][1] * rs); o.y = pk2(siluf_(bflo(gw.y)) * acc[et][2] * rs, siluf_(bfhi(gw.y)) * acc[et][3] * rs);
                *(u32x2*)(MG + (size_t)row * DM + e0) = o; }
        } else {
            const float cf = CF[qi], cb = CB[qi];
            const float gf = __expf(mpf - cf), gb = __expf(mpb - cb);
            f32x4 af[5], ab[5];
#pragma unroll
            for (int et = 0; et < 5; ++et) {
                f32x4 zf = {0.f, 0.f, 0.f, 0.f}, zb = zf;
                zf = mfma16(frag_row(SFimg, 16 * et, 0, lane), bq0, zf); zf = mfma16(frag_row(SFimg, 16 * et, 32, lane), bq1, zf);
                zb = mfma16(frag_row(SBimg, 16 * et, 0, lane), bq0, zb); zb = mfma16(frag_row(SBimg, 16 * et, 32, lane), bq1, zb);
                af[et] = zf * gf; ab[et] = zb * gb;
            }
#pragma unroll
            for (int T = 0; T < 4; ++T) {
                const f32x4 a0f = *(const LAS f32x4*)(AF + 32 * T + 4 * g), a1f = *(const LAS f32x4*)(AF + 32 * T + 16 + 4 * g);
                const f32x4 a0b = *(const LAS f32x4*)(AB + 32 * T + 4 * g), a1b = *(const LAS f32x4*)(AB + 32 * T + 16 + 4 * g);
                f32x4 pf0, pf1, pb0, pb1;
#pragma unroll
                for (int j = 0; j < 4; ++j) {
                    const int k0 = 32 * T + 4 * g + j, k1 = k0 + 16;
                    pf0[j] = k0 <= qi ? st[2 * T][j] * __expf(a0f[j] - cf) : 0.f; pf1[j] = k1 <= qi ? st[2 * T + 1][j] * __expf(a1f[j] - cf) : 0.f;
                    pb0[j] = k0 >= qi ? st[2 * T][j] * __expf(a0b[j] - cb) : 0.f; pb1[j] = k1 >= qi ? st[2 * T + 1][j] * __expf(a1b[j] - cb) : 0.f;
                }
                const bf16x8 bpf = pack8(pf0, pf1), bpb = pack8(pb0, pb1);
{ bf16x8 va[4]; frag_tr_x4<true>(Vimg, 32 * T, 0, lane, va); const bf16x8 v4 = frag_tr<true>(Vimg, 32 * T, 64, lane);
#pragma unroll
                for (int et = 0; et < 4; ++et) { af[et] = mfma16(va[et], bpf, af[et]); ab[et] = mfma16(va[et], bpb, ab[et]); }
                af[4] = mfma16(v4, bpf, af[4]); ab[4] = mfma16(v4, bpb, ab[4]); }
            }
            const float denf = lane_get(af[4][0], lane & 15), denb = lane_get(ab[4][0], lane & 15);
            const float nf = 1.0f / fmaxf(fabsf(denf), __expf(-(BF[qi] + cf))), nb = 1.0f / fmaxf(fabsf(denb), __expf(-(BB[qi] + cb)));
            f32x4 y[4]; float ss = 0.f;
#pragma unroll
            for (int et = 0; et < 4; ++et) { y[et] = af[et] * nf + ab[et] * nb; ss += (y[et][0] * y[et][0] + y[et][1] * y[et][1]) + (y[et][2] * y[et][2] + y[et][3] * y[et][3]); }
            ss = sum_g4(ss);
            const float rs = rsqrtf(ss * (1.0f / 64.0f) + EPS);
#pragma unroll
            for (int et = 0; et < 4; ++et) { const int e0 = h * 64 + 16 * et + 4 * g;
                const u32x2 gw = *(const u32x2*)(P + (size_t)row * NPW + PC_MO + e0);
                u32x2 o; o.x = pk2(sigmoidf_(bflo(gw.x)) * y[et][0] * rs, sigmoidf_(bfhi(gw.x)) * y[et][1] * rs); o.y = pk2(sigmoidf_(bflo(gw.y)) * y[et][2] * rs, sigmoidf_(bfhi(gw.y)) * y[et][3] * rs);
                *(u32x2*)(MG + (size_t)row * DM + 256 + e0) = o; }
        }
    }
}

struct NaItem { int b, h, r0, ur0, nlb, lat, qrow0; };
__device__ __forceinline__ NaItem na_decode(int it) {
    NaItem t;
    if (it < 512) { t.lat = 1; const int rg = it & 7; t.h = (it >> 3) & 7; t.b = it >> 6; t.r0 = 4 * rg; t.ur0 = min(max(t.r0 - 4, 0), NROWS - 8);
        const int last = min(max(t.r0 - 1, 0), NROWS - 8) + 7; t.nlb = (last - t.ur0 + 4) >> 2; t.qrow0 = t.b * SEQ + t.r0 * 64; }
    else { const int j = it - 512; t.lat = 0; t.h = j & 7; t.b = j >> 3; t.r0 = 0; t.ur0 = 0; t.nlb = 0; t.qrow0 = NLAT + t.b * CTXL; }
    return t;
}
__device__ __forceinline__ int na_krow0(const NaItem& t, int step) { return step == 0 ? NLAT + t.b * CTXL : t.b * SEQ + (t.ur0 + 4 * (step - 1)) * 64; }
struct NaKV { u32x4 k[4], v[4]; };
__device__ __forceinline__ void na_load_kv(NaKV& x, const bf16_t* P, int krow0, int h, int tid) {
    const int rr = tid >> 1, c0 = (tid & 1) * 32; const bf16_t* ks = P + (size_t)(krow0 + rr) * NPW + PC_NK + 256 * (h >> 2) + hl_off(h & 3, c0); const bf16_t* vs = P + (size_t)(krow0 + rr) * NPW + PC_NV + h * 64 + c0;
#pragma unroll
    for (int i = 0; i < 4; ++i) { x.k[i] = *(const u32x4*)(ks + 8 * i); x.v[i] = *(const u32x4*)(vs + 8 * i); }
}
struct NaQ { u32x4 q[4]; };
__device__ __forceinline__ void na_load_q(NaQ& x, const bf16_t* P, int qrow0, int h, int tid) {
    const bf16_t* qs = P + (size_t)(qrow0 + (tid >> 1)) * NPW + PC_NQ + 256 * (h >> 2) + hl_off(h & 3, (tid & 1) * 32);
#pragma unroll
    for (int i = 0; i < 4; ++i) x.q[i] = *(const u32x4*)(qs + 8 * i);
}
struct NaState { float m, l; f32x4 acc[4]; };
template <int NPAIR, unsigned VALID>
__device__ __forceinline__ void na_update(NaState& st, const f32x4 (&s)[2 * NPAIR], float mx, LAS const unsigned char* Vimg, int vrow0, int lane) {
    mx = max_g4(mx);
    const float m_new = fmaxf(st.m, mx), resc = __builtin_amdgcn_exp2f(st.m - m_new);
    st.m = m_new; st.l *= resc;
#pragma unroll
    for (int et = 0; et < 4; ++et) st.acc[et] = st.acc[et] * resc;
#pragma unroll
    for (int T = 0; T < NPAIR; ++T) {
        if (((VALID >> (2 * T)) & 3u) != 0u) {
            f32x4 p0 = {0.f, 0.f, 0.f, 0.f}, p1 = p0;
            if ((VALID >> (2 * T)) & 1u) {
#pragma unroll
                for (int j = 0; j < 4; ++j) p0[j] = __builtin_amdgcn_exp2f(s[2 * T][j] - m_new);
                st.l += (p0[0] + p0[1]) + (p0[2] + p0[3]); }
            if ((VALID >> (2 * T + 1)) & 1u) {
#pragma unroll
                for (int j = 0; j < 4; ++j) p1[j] = __builtin_amdgcn_exp2f(s[2 * T + 1][j] - m_new);
                st.l += (p1[0] + p1[1]) + (p1[2] + p1[3]); }
            asm volatile("" : "+v"(st.l));
            const bf16x8 bp = pack8(p0, p1);
            bf16x8 va[4]; frag_tr_x4<true>(Vimg, vrow0 + 32 * T, 0, lane, va);
#pragma unroll
            for (int et = 0; et < 4; ++et) st.acc[et] = mfma16(va[et], bp, st.acc[et]);
            __builtin_amdgcn_sched_barrier(0);
        }
    }
}
template <int QTA>
__device__ __forceinline__ void na_local_row(NaState& st, const bf16x8& bq0, const bf16x8& bq1, LAS const unsigned char* Kimg, LAS const unsigned char* Vimg, LAS const float* browb, int irow0, int lane) {
    constexpr int tlo = (16 * QTA - 8 < 0 ? 0 : (16 * QTA - 8 > 48 ? 48 : 16 * QTA - 8)), thi = (16 * QTA + 7 > 48 ? 48 : 16 * QTA + 7) + 15;
    constexpr unsigned VALID = ((15 >= tlo && 0 <= thi) ? 1u : 0u) | ((31 >= tlo && 16 <= thi) ? 2u : 0u) | ((47 >= tlo && 32 <= thi) ? 4u : 0u) | ((63 >= tlo && 48 <= thi) ? 8u : 0u);
    const int g = lane >> 4, ql = 16 * QTA + (lane & 15), scq = min(max(ql - 8, 0), GRIDW - 16);
    f32x4 s[4]; float mx = -1.0e30f;
#pragma unroll
    for (int ct = 0; ct < 4; ++ct) {
        if ((VALID >> ct) & 1u) {
            f32x4 z = {0.f, 0.f, 0.f, 0.f}; z = mfma16(frag_row(Kimg, irow0 + 16 * ct, 0, lane), bq0, z); z = mfma16(frag_row(Kimg, irow0 + 16 * ct, 32, lane), bq1, z);
            const LAS float* brow = browb + (16 * ct + 4 * g - ql + 63); const int t0 = 16 * ct + 4 * g - scq;
#pragma unroll
            for (int j = 0; j < 4; ++j) { const float bv = brow[j]; const float zz = z[j] * 0.18033688f + bv; z[j] = ((unsigned)(t0 + j) < 16u) ? zz : -1.0e30f; }
            s[ct] = z; mx = fmaxf(mx, fmaxf(fmaxf(z[0], z[1]), fmaxf(z[2], z[3]))); asm volatile("" ::: "memory");
        } else s[ct] = (f32x4){-1.0e30f, -1.0e30f, -1.0e30f, -1.0e30f};
    }
    na_update<2, VALID>(st, s, mx, Vimg, irow0, lane);
    __builtin_amdgcn_sched_barrier(0);
}
template <int QTA>
__device__ __forceinline__ void na_local_q(NaState& st, LAS const unsigned char* Qimg, LAS const unsigned char* Kimg, LAS const unsigned char* Vimg, LAS const float* RPB, int qimg_row, int lane, int kkb, int srw, int qrw) {
    const bf16x8 bq0 = frag_row(Qimg, qimg_row, 0, lane), bq1 = frag_row(Qimg, qimg_row, 32, lane);
#pragma unroll
    for (int kkl = 0; kkl < 4; ++kkl) { const int kk = kkb + kkl;
        if (kk >= srw && kk < srw + 8) na_local_row<QTA>(st, bq0, bq1, Kimg, Vimg, RPB + (kk - qrw + 7) * 128, 64 * kkl, lane); }
}
template <int WP>
__device__ __forceinline__ void na_local_step(NaState (&st)[2], LAS const unsigned char* Qimg, LAS const unsigned char* Kimg, LAS const unsigned char* Vimg, LAS const float* RPB, int wave, int lane, int kkb, int srw, int qrw) {
    na_local_q<2 * WP>(st[0], Qimg, Kimg, Vimg, RPB, 32 * wave, lane, kkb, srw, qrw);
    na_local_q<2 * WP + 1>(st[1], Qimg, Kimg, Vimg, RPB, 32 * wave + 16, lane, kkb, srw, qrw);
}
__device__ __forceinline__ void phase_natt_mfma(const Args& a, int l, bool need_ctx, LAS unsigned char* lds, int tid, int lane, int wave, int bid, int G) {
    unsigned char* ws = a.ws;
    const bf16_t* P = (const bf16_t*)(ws + WS_BIG); bf16_t* MG = (bf16_t*)(ws + WS_H);
    LAS unsigned char* Qimg = lds; LAS unsigned char* Kimg = lds + 40960; LAS unsigned char* Vimg = lds + 81920;
    LAS float* RPB = (LAS float*)(lds + 122880);
    const int nitems = 512 + (need_ctx ? NB * 8 : 0);
    const int g = lane >> 4;
    int it = (bid + G - 128 % G) % G; if (it >= nitems) return;
    NaItem cur = na_decode(it);
    NaKV kv; na_load_kv(kv, P, na_krow0(cur, 0), cur.h, tid);
    float rpbreg[4];
#pragma unroll
    for (int k = 0; k < 4; ++k) { const int idx = tid + 512 * k, dr = idx >> 7, dc = (idx & 127) - 48; rpbreg[k] = (idx < 1920 && dc >= 0 && dc <= 30) ? a.in[15][(size_t)(l * 8 + cur.h) * 465 + dr * 31 + dc] * 1.44269504f : 0.f; }
    for (;;) {
        const int itn = it + G; const bool has_next = itn < nitems; NaItem nxt = cur; if (has_next) nxt = na_decode(itn);
        const int nsteps = 1 + cur.nlb;
        const int qrw = cur.r0 + (wave >> 1), srw = min(max(qrw - 4, 0), NROWS - 8);
        NaState st[2];
#pragma unroll
        for (int q2 = 0; q2 < 2; ++q2) { st[q2].m = -1.0e30f; st[q2].l = 0.f;
#pragma unroll
            for (int et = 0; et < 4; ++et) st[q2].acc[et] = (f32x4){0.f, 0.f, 0.f, 0.f}; }
        for (int step = 0; step < nsteps; ++step) {
            int ts = tid; asm volatile("" : "+v"(ts));
            __syncthreads();
            { const int rr = ts >> 1, c0 = (ts & 1) * 32;
#pragma unroll
              for (int i = 0; i < 4; ++i) { *(LAS u32x4*)(Kimg + rr * IST + (c0 + 8 * i) * 2) = kv.k[i]; *(LAS u32x4*)(Vimg + rr * IST + (c0 + 8 * i) * 2) = kv.v[i]; }
              if (step == 0) { NaQ qr_; na_load_q(qr_, P, cur.qrow0, cur.h, ts);
#pragma unroll
                  for (int i = 0; i < 4; ++i) *(LAS u32x4*)(Qimg + rr * IST + (c0 + 8 * i) * 2) = qr_.q[i];
#pragma unroll
                  for (int k = 0; k < 4; ++k) if (ts + 512 * k < 1920) RPB[ts + 512 * k] = rpbreg[k]; } }
            __syncthreads();
            int tq = ts;
            if (step + 1 < nsteps) na_load_kv(kv, P, na_krow0(cur, step + 1), cur.h, tq);
            else if (has_next) { na_load_kv(kv, P, na_krow0(nxt, 0), nxt.h, tq);
#pragma unroll
                for (int k = 0; k < 4; ++k) { const int idx = tq + 512 * k, dr = idx >> 7, dc = (idx & 127) - 48; rpbreg[k] = (idx < 1920 && dc >= 0 && dc <= 30) ? a.in[15][(size_t)(l * 8 + nxt.h) * 465 + dr * 31 + dc] * 1.44269504f : 0.f; } }
            const int ln = ts & 63;
            if (step == 0) {
#pragma unroll
                for (int q2 = 0; q2 < 2; ++q2) {
                    const bf16x8 bq0 = frag_row(Qimg, 32 * wave + 16 * q2, 0, ln), bq1 = frag_row(Qimg, 32 * wave + 16 * q2, 32, ln);
#pragma unroll
                    for (int hf = 0; hf < 2; ++hf) {
                        f32x4 s[8]; float mx = -1.0e30f;
#pragma unroll
                        for (int t8 = 0; t8 < 8; ++t8) { f32x4 z = {0.f, 0.f, 0.f, 0.f}; z = mfma16(frag_row(Kimg, 128 * hf + 16 * t8, 0, ln), bq0, z); z = mfma16(frag_row(Kimg, 128 * hf + 16 * t8, 32, ln), bq1, z);
                            z = z * 0.18033688f; s[t8] = z; mx = fmaxf(mx, fmaxf(fmaxf(z[0], z[1]), fmaxf(z[2], z[3]))); if (t8 & 1) asm volatile("" ::: "memory"); }
                        na_update<4, 0xFFu>(st[q2], s, mx, Vimg, 128 * hf, ln);
                        __builtin_amdgcn_sched_barrier(0);
                    }
                }
            } else {
                const int kkb = cur.ur0 + 4 * (step - 1);
                if (wave & 1) na_local_step<1>(st, Qimg, Kimg, Vimg, RPB, wave, ln, kkb, srw, qrw);
                else          na_local_step<0>(st, Qimg, Kimg, Vimg, RPB, wave, ln, kkb, srw, qrw);
            }
        }
        int lf = lane; asm volatile("" : "+v"(lf)); const int gf = lf >> 4;
#pragma unroll
        for (int q2 = 0; q2 < 2; ++q2) {
            const float inv = 1.0f / sum_g4(st[q2].l);
            const int row = cur.qrow0 + 32 * wave + 16 * q2 + (lf & 15);
#pragma unroll
            for (int et = 0; et < 4; ++et) { u32x2 w; w.x = pk2(st[q2].acc[et][0] * inv, st[q2].acc[et][1] * inv); w.y = pk2(st[q2].acc[et][2] * inv, st[q2].acc[et][3] * inv);
                *(u32x2*)(MG + (size_t)row * DM + 512 + cur.h * 64 + 16 * et + 4 * gf) = w; }
        }
        if (!has_next) break;
        it = itn; cur = nxt;
    }
}

constexpr int MOE_TAB_OFF = 131072;
__device__ __forceinline__ void moe_tab_setup(const unsigned char* ws, LAS unsigned char* lds, int tid) {
    if (tid == 0) { LAS int* tab = (LAS int*)(lds + MOE_TAB_OFF); int p = 0;
        for (int e = 0; e < NEXP; ++e) { const int c = (int)__hip_atomic_load((const unsigned*)(ws + WS_CTL) + CW_MOE + 64 * e, __ATOMIC_RELAXED, __HIP_MEMORY_SCOPE_AGENT); tab[e] = p; tab[16 + e] = c; p += (c + 255) >> 8; }
        tab[8] = p; }
    __syncthreads();
}
namespace pg8 {
struct MoeOrder : StaticOrder {
    const PG8_LAS int* tab; const int* list; size_t bstride;
    __device__ __forceinline__ int expert(int pm) const { int e = 0;
#pragma unroll
        for (int k = 1; k < 8; ++k) e += (pm >= tab[k]) ? 1 : 0;
        return e; }
    const PG8_LAS unsigned short* rowtab;
    __device__ __forceinline__ unsigned arow(const Unit& u, int R) const {
        const int Rr = (u.hs > 0 ? HALF : 0) + (u.hs >= 0 ? (R & (HALF - 1)) : R);
        if (!list) return (unsigned)(u.pm * BM + Rr);
        return (unsigned)rowtab[u.idx * BM + Rr]; }
    __device__ __forceinline__ unsigned arow_global(const Unit& u, int Rr) const { const int e = expert(u.pm), idx = (u.pm - tab[e]) * BM + Rr; return idx < tab[16 + e] ? (unsigned)list[e * NLAT + idx] : 0u; }
    __device__ __forceinline__ const char* bbase(const Unit& u) const { return Bt + (size_t)expert(u.pm) * bstride + (size_t)u.pn * BM * K2; }
};
}
constexpr int MOE_ROWTAB_OFF = 131072 + 256 + 4096, MOE_ROWTAB_UNITS = 15;
__device__ __forceinline__ void moe_rowtab_fill(const pg8::MoeOrder& S, LAS unsigned char* lds, int tid) {
    LAS unsigned short* rt = (LAS unsigned short*)(lds + MOE_ROWTAB_OFF);
    for (int i = 0; i < MOE_ROWTAB_UNITS; ++i) { pg8::Unit u; if (!S.next(i, u)) break; if (tid < 256) rt[i * 256 + tid] = (unsigned short)S.arow_global(u, tid); }
    __syncthreads();
}
__device__ __forceinline__ void phase_moe_combine(const Args& a, LAS unsigned char* lds, int lane, int wave, int bid, int G) {
    unsigned char* ws = a.ws; const LAS int* tab = (const LAS int*)(lds + MOE_TAB_OFF);
    const int* TOK = (const int*)(ws + WS_COMB); const bf16_t* Y = (const bf16_t*)(ws + WS_WTMUP);
    const float* g2 = (const float*)(ws + WS_MOD) + (size_t)9 * 6144 + 5120;
    for (int r0 = bid * NWAVES + wave; r0 < NLAT; r0 += 2 * G * NWAVES) {
        const bf16_t* y1[2]; const bf16_t* y2[2]; float w1[2], w2[2]; bool ok[2];
#pragma unroll
        for (int u = 0; u < 2; ++u) { const int r = r0 + u * G * NWAVES; ok[u] = r < NLAT; const int rr = ok[u] ? r : r0;
            const int e1 = TOK[rr * 8], e2 = TOK[rr * 8 + 1], p1 = TOK[rr * 8 + 2], p2 = TOK[rr * 8 + 3]; w1[u] = __int_as_float(TOK[rr * 8 + 4]); w2[u] = __int_as_float(TOK[rr * 8 + 5]);
            y1[u] = Y + ((size_t)tab[e1] * 256 + p1) * DM; y2[u] = Y + ((size_t)tab[e2] * 256 + p2) * DM; }
#pragma unroll
        for (int u = 0; u < 2; ++u) if (ok[u]) { const int r = r0 + u * G * NWAVES;
            const float* gr = g2 + (size_t)(r >> 11) * 6144; float* o = a.out + (size_t)r * DM;
#pragma unroll
            for (int j = 0; j < 4; ++j) { const int k = 4 * lane + 256 * j;
                const u32x2 a1 = *(const u32x2*)(y1[u] + k), a2 = *(const u32x2*)(y2[u] + k); const f32x4 x = *(const f32x4*)(o + k), gg = *(const f32x4*)(gr + k);
                f32x4 mm; mm.x = w1[u] * bflo(a1.x) + w2[u] * bflo(a2.x); mm.y = w1[u] * bfhi(a1.x) + w2[u] * bfhi(a2.x); mm.z = w1[u] * bflo(a1.y) + w2[u] * bflo(a2.y); mm.w = w1[u] * bfhi(a1.y) + w2[u] * bfhi(a2.y);
                *(f32x4*)(o + k) = x + gg * mm; } }
    }
}
#ifndef STAGGER_US
#define STAGGER_US 0
#endif
#ifndef DUP_VIRT
#define DUP_VIRT (-1)
#endif
#define PH_REP_OPEN
#define PH_REP_CLOSE
#ifndef DUP_PH
#define DUP_PH (-1)
#endif
#ifndef PH_ONLY
#define PH_ONLY 0
#endif
#ifndef MIX_NAIVE
#define MIX_NAIVE 0
#endif
#ifndef MIX_RET
#define MIX_RET 1
#endif
#ifndef MIX_ML
#define MIX_ML 1
#endif
#ifndef MIX_NA
#define MIX_NA 1
#endif
#ifndef EN_PRO
#define EN_PRO 1
#endif
#ifndef EN_NORM
#define EN_NORM 1
#endif
#ifndef EN_GIN
#define EN_GIN 1
#endif
#ifndef EN_POST
#define EN_POST 1
#endif
#ifndef EN_FCUM
#define EN_FCUM 1
#endif
#ifndef EN_QUAD
#define EN_QUAD 1
#endif
#ifndef EN_NATT
#define EN_NATT 1
#endif
#ifndef EN_MERGE
#define EN_MERGE 1
#endif
#ifndef EN_GOUT
#define EN_GOUT 1
#endif
#ifndef EN_NORM2
#define EN_NORM2 1
#endif
#ifndef EN_GUP
#define EN_GUP 1
#endif
#ifndef EN_GDN
#define EN_GDN 1
#endif

__global__ void __launch_bounds__(NTHR, 2) fwd_kernel(Args a_) {
    extern __shared__ __attribute__((aligned(16))) unsigned char lds_raw[];
    LAS unsigned char* lds = (LAS unsigned char*)lds_raw;
    const int tid0 = threadIdx.x, G = gridDim.x, bid = blockIdx.x; const int wave0 = __builtin_amdgcn_readfirstlane(tid0 >> 6);
    unsigned char* ws0 = a_.ws;
    volatile LAS unsigned* MISC = (volatile LAS unsigned*)(lds + MISC_OFF);
    if (tid0 < 32) MISC[tid0] = 0u;
    __syncthreads();
    const int lo = a_.ph_lo, hi = a_.ph_hi;
    XcdBarrier bar; bar.bar = (unsigned*)(ws0 + WS_CTL) + CW_BAR; bar.x = 0; bar.st = MISC + 8;
    if (hi - lo > 1) bar = xcd_barrier_post((unsigned*)(ws0 + WS_CTL) + CW_BAR, MISC + 8);
    int ph = 0;
#define PH_BEGIN if (ph >= lo && ph < hi) { asm volatile("; PHMARK_BEGIN %0" :: "i"(__LINE__)); int tid; asm volatile("v_mbcnt_lo_u32_b32 %0, -1, 0\n\tv_mbcnt_hi_u32_b32 %0, -1, %0" : "=v"(tid)); tid += wave0 * 64; Args a; { const __attribute__((address_space(4))) Args* ap = (const __attribute__((address_space(4))) Args*)__builtin_amdgcn_kernarg_segment_ptr(); asm volatile("" : "+s"(ap)); a = *(const Args*)ap; } unsigned char* ws = a.ws; (void)ws; PH_REP_OPEN if (PH_ONLY == 0 || PH_ONLY == __LINE__) { const int lane = tid & 63, wave = __builtin_amdgcn_readfirstlane(tid >> 6); (void)lane; (void)wave;
#define PH_END   } PH_REP_CLOSE asm volatile("; PHMARK_END %0" :: "i"(__LINE__)); if (ph + 1 < hi) xcd_barrier(bar); else __syncthreads(); } ++ph;

    PH_BEGIN
#if EN_PRO
 phase_prologue(a, lds, tid, lane, wave, bid, G);
#endif
 PH_END

    for (int l = 0; l < 2; ++l) {
        const bool need_ctx = (l == 0);
#define MODP ((const float*)(ws + WS_MOD) + (size_t)l * 9 * 6144)
        PH_BEGIN
#if EN_NORM
 phase_norm1(a, l, lds, tid, lane, wave, bid, G);
#endif
 PH_END
        PH_BEGIN
#if EN_GIN
 { pg8::Gemm g{(const bf16_t*)(ws + WS_H), (const bf16_t*)(ws + WS_WTIN) + (size_t)l * NPW * DM, MALL, NPW, DM / 2};
                   pg8::StaticOrder S; S.init(MALL, NPW, G, bid); S.Bt = (const char*)g.Bt; S.K2 = 2 * DM;
                   { LAS float* cl = (LAS float*)(lds + PG8_EPI_CONST_OFF); const float* rp = (const float*)(ws + WS_ROPE);
                     for (int i = tid; i < 2048 + 128; i += NTHR) cl[i] = i < 2048 ? rp[i] : (i < 2048 + 64 ? a.in[13][l * 64 + i - 2048] : a.in[14][l * 64 + i - 2112]); __syncthreads(); }
                   pg8::EpiProjI8 E{(bf16_t*)(ws + WS_BIG), NPW, (const float*)(ws + WS_ROPE), a.in[13] + l * 64, a.in[14] + l * 64, NLAT / 256, (const float*)(ws + WS_HS), (const unsigned*)(ws + WS_CTL) + CW_COLMAX + l * NPW};
                   if (STAGGER_US > 0 && (bid & 1)) { const unsigned long long t0 = __builtin_amdgcn_s_memrealtime(); while (__builtin_amdgcn_s_memrealtime() - t0 < (unsigned long long)STAGGER_US * 100ull) __builtin_amdgcn_s_sleep(32); }
                   pg8::gemm_phase<pg8::EpiProjI8, pg8::StaticOrder, false>(lds, g, S, E, nullptr, tid); }
#endif
 PH_END
        PH_BEGIN
#if MIX_RET || MIX_ML
        phase_chunk_sums(a, l, lds, tid, lane, wave, bid, G);
#endif
        PH_END
        PH_BEGIN phase_chunk_states(a, l, tid, bid, G); if (bid >= 128) convert_window(a, lds, lane, wave, G, l, bid - 128); PH_END
        PH_BEGIN
#if MIX_RET
        phase_chunk_out<0>(a, l, need_ctx, lds, tid, lane, wave, bid, G);
#endif
#if MIX_ML
        phase_chunk_out<1>(a, l, need_ctx, lds, tid, lane, wave, bid, G);
#endif
#if MIX_NA
        phase_natt_mfma(a, l, need_ctx, lds, tid, lane, wave, bid, G);
#endif
        PH_END
        PH_BEGIN
#if EN_GOUT
 { const int M = need_ctx ? MALL : NLAT;
                   pg8::Gemm g{(const bf16_t*)(ws + WS_H), (const bf16_t*)(ws + WS_WTOUT) + (size_t)l * DM * DM, M, DM, DM};
                   pg8::StaticOrder S; S.init(M, DM, G, bid); S.Bt = (const char*)g.Bt; S.K2 = 2 * DM;
                   pg8::EpiResid E{l == 0 ? a.in[0] : a.out, l == 0 ? a.in[2] : (const float*)(ws + WS_XC), a.out, (float*)(ws + WS_XC), MODP + 2048, nullptr, 0, NLAT / 256};
                   pg8::gemm_phase<pg8::EpiResid, pg8::StaticOrder, false>(lds, g, S, E, nullptr, tid); }
#endif
 PH_END
        if (l == 0) { PH_BEGIN
#if EN_NORM2
 phase_norm<1>(a, l, lds, tid, lane, wave, bid, G);
#endif
 PH_END }
        else        { PH_BEGIN
#if EN_NORM2
 phase_norm<2>(a, l, lds, tid, lane, wave, bid, G);
#endif
 PH_END }
        if (l == 0) {
            PH_BEGIN { pg8::Gemm g{(const bf16_t*)(ws + WS_H), (const bf16_t*)(ws + WS_WTUP), MALL, NUP, DM / 2};
                       pg8::StaticOrder S; S.init(MALL, NUP, G, bid); S.Bt = (const char*)g.Bt; S.K2 = 2 * DM;
                       pg8::EpiSwiGLUI8 E{(bf16_t*)(ws + WS_BIG), DFF, (const float*)(ws + WS_HS), (const unsigned*)(ws + WS_CTL) + CW_COLMAX + 2 * NPW, nullptr, nullptr, 0};
                   if (STAGGER_US > 0 && (bid & 1)) { const unsigned long long t0 = __builtin_amdgcn_s_memrealtime(); while (__builtin_amdgcn_s_memrealtime() - t0 < (unsigned long long)STAGGER_US * 100ull) __builtin_amdgcn_s_sleep(32); }
                       pg8::gemm_phase<pg8::EpiSwiGLUI8, pg8::StaticOrder, false>(lds, g, S, E, nullptr, tid); } PH_END
            PH_BEGIN { pg8::Gemm g{(const bf16_t*)(ws + WS_BIG), (const bf16_t*)(ws + WS_WTDN), MALL, DM, DFF};
                       pg8::StaticOrder S; S.init(MALL, DM, G, bid); S.Bt = (const char*)g.Bt; S.K2 = 2 * DFF;
                       pg8::EpiResid E{a.out, (const float*)(ws + WS_XC), a.out, (float*)(ws + WS_XC), MODP + 5120, nullptr, 0, NLAT / 256};
                       pg8::gemm_phase<pg8::EpiResid, pg8::StaticOrder, false>(lds, g, S, E, nullptr, tid); } PH_END
        } else {
            PH_BEGIN { moe_tab_setup(ws, lds, tid); const LAS int* tab = (const LAS int*)(lds + MOE_TAB_OFF);
                       pg8::Gemm g{(const bf16_t*)(ws + WS_H), (const bf16_t*)(ws + WS_WTMUP), 256 * tab[8], NUP, DM / 2};
                       pg8::MoeOrder S; S.init(256 * tab[8], NUP, G, bid); S.Bt = (const char*)g.Bt; S.K2 = 2 * DM; S.tab = tab; S.list = (const int*)(ws + WS_LIST); S.bstride = (size_t)NUP * DM * 2; S.rowtab = (const LAS unsigned short*)(lds + MOE_ROWTAB_OFF); moe_rowtab_fill(S, lds, tid);
                       pg8::EpiSwiGLUI8 E{(bf16_t*)(ws + WS_BIG), DFF, (const float*)(ws + WS_HS), (const unsigned*)(ws + WS_CTL) + CW_COLMAX + 2 * NPW + NUP, tab, nullptr, NUP};
                   if (STAGGER_US > 0 && (bid & 1)) { const unsigned long long t0 = __builtin_amdgcn_s_memrealtime(); while (__builtin_amdgcn_s_memrealtime() - t0 < (unsigned long long)STAGGER_US * 100ull) __builtin_amdgcn_s_sleep(32); }
                       pg8::gemm_phase<pg8::EpiSwiGLUI8, pg8::MoeOrder, false>(lds, g, S, E, nullptr, tid); } PH_END
            PH_BEGIN { moe_tab_setup(ws, lds, tid); const LAS int* tab = (const LAS int*)(lds + MOE_TAB_OFF);
                       pg8::Gemm g{(const bf16_t*)(ws + WS_BIG), (const bf16_t*)(ws + WS_WTMDN), 256 * tab[8], DM, DFF};
                       pg8::MoeOrder S; S.init(256 * tab[8], DM, G, bid); S.Bt = (const char*)g.Bt; S.K2 = 2 * DFF; S.tab = tab; S.list = nullptr; S.rowtab = nullptr; S.bstride = (size_t)DM * DFF * 2;
                       pg8::EpiBf16 E{(bf16_t*)(ws + WS_WTMUP), DM};
                       pg8::gemm_phase<pg8::EpiBf16, pg8::MoeOrder, false>(lds, g, S, E, nullptr, tid); } PH_END
            PH_BEGIN { moe_tab_setup(ws, lds, tid); phase_moe_combine(a, lds, lane, wave, bid, G); } PH_END
        }
    }
#if N_LAUNCH_MODE == 1
    if (lo >= 100) {
        int tid; asm volatile("v_mbcnt_lo_u32_b32 %0, -1, 0\n\tv_mbcnt_hi_u32_b32 %0, -1, %0" : "=v"(tid)); tid += wave0 * 64; const int lane = tid & 63, wave = wave0;
        Args a = a_;
#if DUP_VIRT == 106
        if (lo == 106) { unsigned char* ws = a.ws; pg8::Gemm g{(const bf16_t*)(ws + WS_H), (const bf16_t*)(ws + WS_WTUP), MALL, NUP, DM / 2};
                   pg8::StaticOrder S; S.init(MALL, NUP, G, bid); S.Bt = (const char*)g.Bt; S.K2 = 2 * DM;
                   pg8::EpiSwiGLUI8LS E{(bf16_t*)(ws + WS_U), DFF, (const float*)(ws + WS_HS), (const unsigned*)(ws + WS_CTL) + CW_COLMAX + 2 * NPW, nullptr, nullptr, 0};
                   pg8::gemm_phase<pg8::EpiSwiGLUI8LS, pg8::StaticOrder, false>(lds, g, S, E, nullptr, tid); }
#elif DUP_VIRT == 105
        if (lo == 105) { unsigned char* ws = a.ws; pg8::Gemm g{(const bf16_t*)(ws + WS_H), (const bf16_t*)(ws + WS_WTUP), MALL, NUP, DM / 2};
                   pg8::StaticOrder S; S.init(MALL, NUP, G, bid); S.Bt = (const char*)g.Bt; S.K2 = 2 * DM;
                   pg8::EpiSwiGLUI8NS E{(bf16_t*)(ws + WS_BIG), DFF, (const float*)(ws + WS_HS), (const unsigned*)(ws + WS_CTL) + CW_COLMAX + 2 * NPW, nullptr, nullptr, 0};
                   pg8::gemm_phase<pg8::EpiSwiGLUI8NS, pg8::StaticOrder, false>(lds, g, S, E, nullptr, tid); }
#elif DUP_VIRT == 104
        if (lo == 104) { unsigned char* ws = a.ws; pg8::Gemm g{(const bf16_t*)(ws + WS_H), (const bf16_t*)(ws + WS_WTUP), MALL, NUP, DM / 2};
                   pg8::StaticOrder S; S.init(MALL, NUP, G, bid); S.Bt = (const char*)g.Bt; S.K2 = 2 * DM; pg8::EpiNullI8 E{(bf16_t*)(ws + WS_BIG), NPW};
                   pg8::gemm_phase<pg8::EpiNullI8, pg8::StaticOrder, false>(lds, g, S, E, nullptr, tid); }
#endif
    }
#endif
#undef PH_BEGIN
#undef PH_END
}
constexpr int N_PHASES = 1 + 2 * 7 + 2 + 3;
#ifndef DBG_MAXPH
#define DBG_MAXPH 1000
#endif

extern "C" void kernel_launch(void* const* d_in, const int* in_sizes, int n_in, void* d_out, int out_size, void* d_ws, size_t ws_size, hipStream_t stream) {
    static int grid = 0;
    if (grid == 0) {
        if (n_in != 24 || out_size != NLAT * DM || ws_size < WS_END) { fprintf(stderr, "kernel_launch: unexpected sizes (n_in %d, out %d, ws %zu < %zu); nothing launched\n", n_in, out_size, ws_size, (size_t)WS_END); grid = -1; return; }
        int dev = 0, cus = 0;
        if (hipGetDevice(&dev) != hipSuccess || hipDeviceGetAttribute(&cus, hipDeviceAttributeMultiprocessorCount, dev) != hipSuccess) { grid = -1; return; }
        if (hipFuncSetAttribute((const void*)fwd_kernel, hipFuncAttributeMaxDynamicSharedMemorySize, LDS_BYTES) != hipSuccess) { fprintf(stderr, "kernel_launch: hipFuncSetAttribute failed\n"); grid = -1; return; }
        int per_cu = 0;
        if (hipOccupancyMaxActiveBlocksPerMultiprocessor(&per_cu, (const void*)fwd_kernel, NTHR, LDS_BYTES) != hipSuccess || per_cu < 1) { fprintf(stderr, "kernel_launch: occupancy query says %d\n", per_cu); }
        (void)hipGetLastError();
        grid = cus;
    }
    if (grid < 0) return;
    (void)hipMemsetAsync((char*)d_ws + WS_CTL, 0, CTL_BYTES, stream);
    Args a{};
    for (int i = 0; i < 24; ++i) a.in[i] = (const float*)d_in[i];
    a.out = (float*)d_out; a.ws = (unsigned char*)d_ws;
#if N_LAUNCH_MODE == 0
    a.ph_lo = 0; a.ph_hi = N_PHASES;
    hipLaunchKernelGGL(fwd_kernel, dim3(grid), dim3(NTHR), LDS_BYTES, stream, a);
#else
    for (int p = 0; p < N_PHASES && p < DBG_MAXPH; ++p) { a.ph_lo = p; a.ph_hi = p + 1; hipLaunchKernelGGL(fwd_kernel, dim3(grid), dim3(NTHR), LDS_BYTES, stream, a);
        if (p == DUP_PH) hipLaunchKernelGGL(fwd_kernel, dim3(grid), dim3(NTHR), LDS_BYTES, stream, a);
        if (p == 8 && DUP_VIRT >= 104) { a.ph_lo = DUP_VIRT; a.ph_hi = DUP_VIRT + 1; hipLaunchKernelGGL(fwd_kernel, dim3(grid), dim3(NTHR), LDS_BYTES, stream, a); }
        if (p == 5 && DUP_VIRT >= 100 && DUP_VIRT < 104) { a.ph_lo = DUP_VIRT; a.ph_hi = DUP_VIRT + 1; hipLaunchKernelGGL(fwd_kernel, dim3(grid), dim3(NTHR), LDS_BYTES, stream, a); } }
#endif
}
```

```cpp
#include <hip/hip_runtime.h>
#include <stdio.h>
#include <stdint.h>

#ifndef N_LAUNCH_MODE
#define N_LAUNCH_MODE 0
#endif

constexpr int NB = 8, SEQ = 2048, DM = 1024, CTXL = 256, HD = 64;
constexpr int NLAT = NB * SEQ, NCTX = NB * CTXL, MALL = NLAT + NCTX;
constexpr int DIN = 3600, NPW = 3584;
constexpr int DFF = 2816, NUP = 2 * DFF, NEXP = 8;
constexpr int GRIDW = 64, NROWS = 32;
constexpr float EPS = 1e-6f;
constexpr int PC_RQ = 0, PC_RK = 256, PC_RV = 512, PC_RG = 768, PC_MQ = 1024, PC_MK = 1280, PC_MV = 1536, PC_MO = 1792, PC_NQ = 2048, PC_NK = 2560, PC_NV = 3072;

constexpr size_t al256(size_t x) { return (x + 255) & ~(size_t)255; }
constexpr size_t WS_CTL = 0, CTL_BYTES = 1u << 20;
constexpr size_t WS_MOD = WS_CTL + CTL_BYTES;
constexpr size_t WS_ROPE = WS_MOD + al256((size_t)2 * 9 * 6144 * 4);
constexpr size_t WS_WTIN = WS_ROPE + al256(64 * 16 * 2 * 4);
constexpr size_t WS_WTOUT = WS_WTIN + (size_t)2 * NPW * DM * 2;
constexpr size_t WS_WTUP = WS_WTOUT + (size_t)2 * DM * DM * 2;
constexpr size_t WS_WTDN = WS_WTUP + (size_t)NUP * DM * 2;
constexpr size_t WS_WTMUP = WS_WTDN + (size_t)DM * DFF * 2;
constexpr size_t WS_WTMDN = WS_WTMUP + (size_t)NEXP * NUP * DM * 2;
constexpr size_t WS_H = WS_WTMDN + (size_t)NEXP * DM * DFF * 2;
constexpr size_t WS_XC = WS_H + (size_t)MALL * DM * 2;
constexpr size_t WS_GATES = WS_XC + (size_t)NCTX * DM * 4;
constexpr size_t WS_COMB = WS_GATES + (size_t)MALL * 16 * 4;
constexpr size_t WS_USC = WS_COMB + (size_t)NLAT * 8 * 4;
constexpr size_t WS_SM = WS_USC + al256((size_t)NB * 4 * 2 * 18 * 2 * 4);
constexpr size_t WS_LIST = WS_SM + al256((size_t)NB * 4 * 2 * 18 * 4);
constexpr size_t WS_BIG = WS_LIST + (size_t)NEXP * NLAT * 4;
constexpr size_t WS_MQK = WS_BIG + (size_t)MALL * NPW * 2;
constexpr size_t WS_U = WS_MQK + (size_t)MALL * 512 * 2;
constexpr size_t WS_S = WS_U + (size_t)2 * NB * 4 * 2 * 18 * 80 * 64 * 2;
constexpr size_t WS_GARR = WS_S + (size_t)2 * NB * 4 * 2 * 18 * 80 * 64 * 2;
constexpr size_t WS_HS = WS_GARR + (size_t)NB * 4 * 18 * 2 * 3 * 128 * 4;
constexpr size_t WS_END0 = WS_HS + al256((size_t)MALL * 4);
constexpr size_t MOE_ROWS = 34816;
constexpr size_t WS_ACTM_END = WS_BIG + MOE_ROWS * DFF * 2;
constexpr size_t WS_SB = al256(WS_END0 > WS_ACTM_END ? WS_END0 : WS_ACTM_END);
constexpr size_t WS_END = WS_SB + (size_t)NLAT * DM * 2;

typedef unsigned short bf16_t;
typedef float f32x4 __attribute__((ext_vector_type(4)));
typedef float f32x2 __attribute__((ext_vector_type(2)));
typedef unsigned u32x4 __attribute__((ext_vector_type(4)));
typedef unsigned u32x2 __attribute__((ext_vector_type(2)));
#define LAS __attribute__((address_space(3)))
#define GAS __attribute__((address_space(1)))

__device__ __forceinline__ float bf2f(bf16_t b) { return __uint_as_float(((unsigned)b) << 16); }
__device__ __forceinline__ unsigned f2bf(float f) { unsigned u = __float_as_uint(f); return (u + 0x7fffu + ((u >> 16) & 1u)) >> 16; }
typedef __bf16 bf16x2_t __attribute__((ext_vector_type(2)));
__device__ __forceinline__ unsigned pk2(float lo, float hi) { f32x2 v = {lo, hi}; bf16x2_t b = __builtin_convertvector(v, bf16x2_t); return __builtin_bit_cast(unsigned, b); }
__device__ __forceinline__ float bflo(unsigned w) { return __uint_as_float(w << 16); }
__device__ __forceinline__ float bfhi(unsigned w) { return __uint_as_float(w & 0xffff0000u); }
constexpr float MG_F8_SCALE = 4.0f;
__device__ __forceinline__ unsigned pk4_f8(float a, float b, float c, float d) {
    int w = __builtin_amdgcn_cvt_pk_fp8_f32(__builtin_amdgcn_fmed3f(a, -448.0f, 448.0f), __builtin_amdgcn_fmed3f(b, -448.0f, 448.0f), 0, false);
    w = __builtin_amdgcn_cvt_pk_fp8_f32(__builtin_amdgcn_fmed3f(c, -448.0f, 448.0f), __builtin_amdgcn_fmed3f(d, -448.0f, 448.0f), w, true); return (unsigned)w;
}
__device__ __forceinline__ float rcpf_(float x) { return __builtin_amdgcn_rcpf(x); }
__device__ __forceinline__ float sigmoidf_(float x) { return rcpf_(1.0f + __expf(-x)); }
__device__ __forceinline__ float siluf_(float x) { return x * rcpf_(1.0f + __expf(-x)); }
__device__ __forceinline__ float logsigmoidf_(float x) { return fminf(x, 0.f) - log1pf(__expf(-fabsf(x))); }
template <int O> __device__ __forceinline__ float swz_xor(float v) { return __int_as_float(__builtin_amdgcn_ds_swizzle(__float_as_int(v), (O << 10) | 0x1f)); }
__device__ __forceinline__ float red32_sum(float v) { const auto r = __builtin_amdgcn_permlane32_swap(__float_as_uint(v), __float_as_uint(v), false, false); return __uint_as_float(r[0]) + __uint_as_float(r[1]); }
__device__ __forceinline__ float red32_max(float v) { const auto r = __builtin_amdgcn_permlane32_swap(__float_as_uint(v), __float_as_uint(v), false, false); return fmaxf(__uint_as_float(r[0]), __uint_as_float(r[1])); }
__device__ __forceinline__ float wave_sum(float v) { v += swz_xor<1>(v); v += swz_xor<2>(v); v += swz_xor<4>(v); v += swz_xor<8>(v); v += swz_xor<16>(v); return red32_sum(v); }
__device__ __forceinline__ float wave_max(float v) { v = fmaxf(v, swz_xor<1>(v)); v = fmaxf(v, swz_xor<2>(v)); v = fmaxf(v, swz_xor<4>(v)); v = fmaxf(v, swz_xor<8>(v)); v = fmaxf(v, swz_xor<16>(v)); return red32_max(v); }
__device__ __forceinline__ float sum_g4(float v) { v += swz_xor<16>(v); return red32_sum(v); }
__device__ __forceinline__ float max_g4(float v) { v = fmaxf(v, swz_xor<16>(v)); return red32_max(v); }
__device__ __forceinline__ float reduce16_lanes(const float (&p)[16], int lane) {
    float q[8], r[4], s[2];
#pragma unroll
    for (int j = 0; j < 8; ++j) { const auto x = __builtin_amdgcn_permlane32_swap(__float_as_uint(p[j]), __float_as_uint(p[j + 8]), false, false); q[j] = __uint_as_float(x[0]) + __uint_as_float(x[1]); }
    const bool b4 = (lane & 16) != 0, b3 = (lane & 8) != 0, b2 = (lane & 4) != 0;
#pragma unroll
    for (int j = 0; j < 4; ++j) { const float keep = b4 ? q[j + 4] : q[j], send = b4 ? q[j] : q[j + 4]; r[j] = keep + swz_xor<16>(send); }
#pragma unroll
    for (int j = 0; j < 2; ++j) { const float keep = b3 ? r[j + 2] : r[j], send = b3 ? r[j] : r[j + 2]; s[j] = keep + swz_xor<8>(send); }
    float v; { const float keep = b2 ? s[1] : s[0], send = b2 ? s[0] : s[1]; v = keep + swz_xor<4>(send); }
    v += swz_xor<2>(v); v += swz_xor<1>(v);
    return v;
}
__device__ __forceinline__ float reduce8_lanes(const float (&p)[8], int lane) {
    float q[4], r[2];
#pragma unroll
    for (int j = 0; j < 4; ++j) { const auto x = __builtin_amdgcn_permlane32_swap(__float_as_uint(p[j]), __float_as_uint(p[j + 4]), false, false); q[j] = __uint_as_float(x[0]) + __uint_as_float(x[1]); }
    const bool b4 = (lane & 16) != 0, b3 = (lane & 8) != 0;
#pragma unroll
    for (int j = 0; j < 2; ++j) { const float keep = b4 ? q[j + 2] : q[j], send = b4 ? q[j] : q[j + 2]; r[j] = keep + swz_xor<16>(send); }
    float v; { const float keep = b3 ? r[1] : r[0], send = b3 ? r[0] : r[1]; v = keep + swz_xor<8>(send); }
    v += swz_xor<4>(v); v += swz_xor<2>(v); v += swz_xor<1>(v);
    return v;
}
__device__ __forceinline__ float lane_get(float v, int src_lane) { return __int_as_float(__builtin_amdgcn_ds_bpermute(src_lane << 2, __float_as_int(v))); }
__device__ __forceinline__ float lane_bcast(float v, int k) { return __int_as_float(__builtin_amdgcn_readlane(__float_as_int(v), k)); }

struct Args {
    const float* in[24];
    float* out;
    unsigned char* ws;
    int ph_lo, ph_hi;
};
namespace pg8 {
#define PG8_LAS __attribute__((address_space(3)))
typedef unsigned short bf16_t;
typedef short bf16x8 __attribute__((ext_vector_type(8)));
typedef float f32x4 __attribute__((ext_vector_type(4)));
typedef unsigned u32x4 __attribute__((ext_vector_type(4)));
constexpr int BM = 256, BK = 64, HALF = 128, HTB = HALF * BK * 2  , STAGE_BYTES = 8 * HTB, NXCD = 8, WGM = 8;

__host__ __device__ __forceinline__ int lds_byte(int r, int c) { const int st = (r >> 4) * 2 + (c >> 5), rr = r & 15, cc = c & 31, ob = rr * 64 + cc * 2; return st * 1024 + (ob ^ (((ob >> 9) & 1) << 5)); }
__host__ __device__ __forceinline__ void stage_rc(int b, int& R, int& C) { const int st = b / 1024, sb = b % 1024, swz = sb ^ (((sb >> 9) & 1) << 5); R = (st >> 1) * 16 + swz / 64; C = (st & 1) * 32 + (swz % 64) / 2; }
__host__ __device__ __forceinline__ int perm32(int rho) { const int n = rho >> 4, i = rho & 15; return 8 * (i >> 2) + 4 * n + (i & 3); }

struct Unit { int pm, pn, hs, idx, bs; };
struct Gemm { const bf16_t* A; const bf16_t* Bt; int M, N, K; int lda2 = 0; };

struct StaticOrder {
    int nM, nN, nwg, G, c; bool quarter;
    __host__ __device__ void init(int M, int N, int G_, int c_) { nM = M / BM; nN = N / BM; nwg = nM * nN; G = G_; c = c_; quarter = false; }
    __host__ __device__ bool next(int i, Unit& u) const {
        const int nfr = nwg / G, left = nwg - nfr * G; int wgid; u.hs = -1; u.idx = i; u.bs = -1;
        if (i < nfr) wgid = i * G + c;
        else if (i == nfr && left > 0) {
            if (quarter && 4 * left <= G) { if (c >= 4 * left) return false; wgid = nfr * G + (c >> 2); u.hs = (c >> 1) & 1; u.bs = c & 1; }
            else if (2 * left <= G) { if (c >= 2 * left) return false; wgid = nfr * G + (c >> 1); u.hs = c & 1; } else { if (c >= left) return false; wgid = nfr * G + c; } }
        else return false; { const int q = nwg / NXCD, r = nwg % NXCD, xcd = wgid % NXCD, off = wgid / NXCD; wgid = (xcd < r ? xcd * (q + 1) : r * (q + 1) + (xcd - r) * q) + off; }
        const int nig = WGM * nN, gid = wgid / nig, fm = gid * WGM, gsz = (nM - fm) < WGM ? (nM - fm) : WGM;
        u.pm = fm + ((wgid % nig) % gsz); u.pn = (wgid % nig) / gsz; return true;
    }
    __device__ __forceinline__ void a_ready(const Unit&) const {}
    __device__ __forceinline__ void done(const Unit&) const {}
    __device__ __forceinline__ int idle_class() const { const int nfr = nwg / G, left = nwg - nfr * G; if (left == 0) return 3; if (2 * left <= G) return c < 2 * left ? 0 : 1; return c < left ? 0 : 2; }
    const char* Bt; int K2;
    __device__ __forceinline__ unsigned arow(const Unit& u, int R) const { return (unsigned)(u.pm * BM + (u.hs > 0 ? HALF : 0) + (u.hs >= 0 ? (R & (HALF - 1)) : R)); }
    __device__ __forceinline__ const char* bbase(const Unit& u) const { return Bt + (size_t)u.pn * BM * K2; }
    __device__ __forceinline__ int expert(int) const { return 0; }
};
#define PG8_EPI_CONST_OFF (131072 + 256 + 4096)
#define PG8_EPI_TAB_OFF (131072 + 256)
__device__ __forceinline__ unsigned cvt_pk_bf16(float lo, float hi) { return ::pk2(lo, hi); }
typedef float f32x2 __attribute__((ext_vector_type(2)));
typedef int i32x4 __attribute__((ext_vector_type(4)));
template <bool I8> struct AccSel { typedef f32x4 T; static __device__ __forceinline__ T zero() { return (f32x4){0.f, 0.f, 0.f, 0.f}; } };
template <> struct AccSel<true> { typedef i32x4 T; static __device__ __forceinline__ T zero() { return (i32x4){0, 0, 0, 0}; } };
template <bool I8> __device__ __forceinline__ typename AccSel<I8>::T mma_op(bf16x8 a, bf16x8 b, typename AccSel<I8>::T c);
template <> __device__ __forceinline__ f32x4 mma_op<false>(bf16x8 a, bf16x8 b, f32x4 c) { return __builtin_amdgcn_mfma_f32_16x16x32_bf16(a, b, c, 0, 0, 0); }
template <> __device__ __forceinline__ i32x4 mma_op<true>(bf16x8 a, bf16x8 b, i32x4 c) { return __builtin_amdgcn_mfma_i32_16x16x64_i8(__builtin_bit_cast(i32x4, a), __builtin_bit_cast(i32x4, b), c, 0, 0, 0); }
typedef int i32x8 __attribute__((ext_vector_type(8)));
__device__ __forceinline__ f32x4 mma_f8(bf16x8 a0, bf16x8 a1, bf16x8 b0, bf16x8 b1, f32x4 c) {
    const i32x4 x0 = __builtin_bit_cast(i32x4, a0), x1 = __builtin_bit_cast(i32x4, a1), y0 = __builtin_bit_cast(i32x4, b0), y1 = __builtin_bit_cast(i32x4, b1);
    const i32x8 a = __builtin_shufflevector(x0, x1, 0, 1, 2, 3, 4, 5, 6, 7), b = __builtin_shufflevector(y0, y1, 0, 1, 2, 3, 4, 5, 6, 7);
    return __builtin_amdgcn_mfma_scale_f32_16x16x128_f8f6f4(a, b, c, 0, 0, 0, 0, 0, 0);
}
struct EpiBf16 {
    static constexpr bool PERM = true, AFTER_DRAIN = false, I8 = false, F8 = false;
    static constexpr int NVM_FULL = -1, NVM_HALF = -1, NVM_QUARTER = -1;
    static constexpr bool TAB = false;
    bf16_t* O; int ldc;
    __device__ __forceinline__ void operator()(const f32x4 (&acc)[2][2][4][2], const Unit& u, int wr, int wc, int fr, int fq, PG8_LAS unsigned char* lds, int ui) const {
        const int row0 = u.pm * BM + (u.hs > 0 ? HALF : 0) + wr * 64 + fr, col0 = u.pn * BM + wc * 32 + 8 * fq; const int nai = u.hs >= 0 ? 1 : 2;
#pragma unroll
        for (int ai = 0; ai < 2; ++ai) if (ai < nai)
#pragma unroll
            for (int m = 0; m < 4; ++m) { bf16_t* rowp = O + (size_t)(row0 + ai * HALF + m * 16) * ldc + col0;
#pragma unroll
                for (int bj = 0; bj < 2; ++bj) if (u.bs < 0 || u.bs == bj) { const f32x4 v0 = acc[ai][bj][m][0], v1 = acc[ai][bj][m][1];
                    u32x4 w; w.x = cvt_pk_bf16(v0[0], v0[1]); w.y = cvt_pk_bf16(v0[2], v0[3]); w.z = cvt_pk_bf16(v1[0], v1[1]); w.w = cvt_pk_bf16(v1[2], v1[3]);
                    *(u32x4*)(rowp + bj * HALF) = w; } }
    }
};
struct EpiSwiGLU {
    static constexpr bool PERM = true, AFTER_DRAIN = false, I8 = false, F8 = false;
    static constexpr int NVM_FULL = -1, NVM_HALF = -1, NVM_QUARTER = -1;
    static constexpr bool TAB = false;
    bf16_t* O; int ldc;
    __device__ __forceinline__ void operator()(const f32x4 (&acc)[2][2][4][2], const Unit& u, int wr, int wc, int fr, int fq, PG8_LAS unsigned char* lds, int ui) const {
        const int row0 = u.pm * BM + (u.hs > 0 ? HALF : 0) + wr * 64 + fr, col0 = u.pn * HALF + wc * 32 + 8 * fq; const int nai = u.hs >= 0 ? 1 : 2;
#pragma unroll
        for (int ai = 0; ai < 2; ++ai) if (ai < nai)
#pragma unroll
            for (int m = 0; m < 4; ++m) { bf16_t* rowp = O + (size_t)(row0 + ai * HALF + m * 16) * ldc + col0;
                float r[8];
#pragma unroll
                for (int n = 0; n < 2; ++n)
#pragma unroll
                    for (int j = 0; j < 4; ++j) { const float g = acc[ai][0][m][n][j], uu = acc[ai][1][m][n][j]; r[n * 4 + j] = g * ::rcpf_(1.0f + __expf(-g)) * uu; }
                u32x4 w; w.x = cvt_pk_bf16(r[0], r[1]); w.y = cvt_pk_bf16(r[2], r[3]); w.z = cvt_pk_bf16(r[4], r[5]); w.w = cvt_pk_bf16(r[6], r[7]);
                *(u32x4*)rowp = w; }
    }
};
struct EpiResid {
    static constexpr bool PERM = false, AFTER_DRAIN = false, I8 = false, F8 = false;
    static constexpr int NVM_FULL = -1, NVM_HALF = -1, NVM_QUARTER = -1;
    static constexpr bool TAB = false;
    const float* base_lat; const float* base_ctx; float* out_lat; float* out_ctx; const float* gate; const float* comb; int comb_ld; int nlat_tiles;
    __device__ __forceinline__ void operator()(const f32x4 (&acc)[2][2][4][2], const Unit& u, int wr, int wc, int fr, int fq, PG8_LAS unsigned char* lds, int ui) const {
        const bool isctx = u.pm >= nlat_tiles;
        const int rloc0 = (isctx ? (u.pm - nlat_tiles) : u.pm) * BM + (u.hs > 0 ? HALF : 0) + wr * 64 + fr, col0 = u.pn * BM + wc * 32 + 4 * fq;
        const float* bp = (isctx ? base_ctx : base_lat) + (size_t)rloc0 * 1024 + col0; float* op = (isctx ? out_ctx : out_lat) + (size_t)rloc0 * 1024 + col0;
        const float* gp = gate + (size_t)(isctx ? 8 : (u.pm >> 3)) * 6144 + col0;
        f32x4 gv[2][2];
#pragma unroll
        for (int bj = 0; bj < 2; ++bj)
#pragma unroll
            for (int n = 0; n < 2; ++n) gv[bj][n] = *(const f32x4*)(gp + bj * HALF + n * 16);
        if (u.bs != 1) pass<0, 0, 1>(acc, bp, op, gv); if (u.bs != 0) pass<0, 1, 2>(acc, bp, op, gv);
        if (u.hs < 0) { pass<1, 0, 1>(acc, bp, op, gv); pass<1, 1, 2>(acc, bp, op, gv); }
    }
    template <int AI, int BJ0, int BJ1> __device__ __forceinline__ void pass(const f32x4 (&acc)[2][2][4][2], const float* bp, float* op, const f32x4 (&gv)[2][2]) const {
        f32x4 r[4][2][2];
#pragma unroll
        for (int m = 0; m < 4; ++m)
#pragma unroll
            for (int bj = BJ0; bj < BJ1; ++bj)
#pragma unroll
                for (int n = 0; n < 2; ++n) r[m][bj][n] = *(const f32x4*)(bp + (size_t)(AI * HALF + m * 16) * 1024 + bj * HALF + n * 16);
        asm volatile("" ::: "memory"); __builtin_amdgcn_sched_barrier(0);
#pragma unroll
        for (int m = 0; m < 4; ++m)
#pragma unroll
            for (int bj = BJ0; bj < BJ1; ++bj)
#pragma unroll
                for (int n = 0; n < 2; ++n) *(f32x4*)(op + (size_t)(AI * HALF + m * 16) * 1024 + bj * HALF + n * 16) = r[m][bj][n] + gv[bj][n] * acc[AI][bj][m][n];
        asm volatile("" ::: "memory"); __builtin_amdgcn_sched_barrier(0);
    }
};

struct EpiNull {
    static constexpr bool PERM = true, AFTER_DRAIN = false, I8 = false, F8 = false;
    static constexpr int NVM_FULL = -1, NVM_HALF = -1, NVM_QUARTER = -1;
    static constexpr bool TAB = false;
    bf16_t* O; int ldc;
    __device__ __forceinline__ void operator()(const f32x4 (&acc)[2][2][4][2], const Unit& u, int wr, int wc, int fr, int fq, PG8_LAS unsigned char* lds, int ui) const {
        float s = 0.f;
#pragma unroll
        for (int ai = 0; ai < 2; ++ai)
#pragma unroll
            for (int bj = 0; bj < 2; ++bj)
#pragma unroll
                for (int m = 0; m < 4; ++m)
#pragma unroll
                    for (int n = 0; n < 2; ++n) s += acc[ai][bj][m][n][0] + acc[ai][bj][m][n][1] + acc[ai][bj][m][n][2] + acc[ai][bj][m][n][3];
        if (s == 12345.678f) O[0] = (bf16_t)1;
    }
};

struct EpiProj {
    static constexpr bool PERM = true, AFTER_DRAIN = false, I8 = false, F8 = false;
    static constexpr int NVM_FULL = -1, NVM_HALF = -1, NVM_QUARTER = -1;
    static constexpr bool TAB = false;
    bf16_t* O; int ldc; const float* rope; const float* qgain; const float* kgain; int nlat_tiles;
    __device__ __forceinline__ void operator()(const f32x4 (&acc)[2][2][4][2], const Unit& u, int wr, int wc, int fr, int fq, PG8_LAS unsigned char* lds, int ui) const {
        const int row0 = u.pm * BM + (u.hs > 0 ? HALF : 0) + wr * 64 + fr, col0 = u.pn * BM + wc * 32 + 8 * fq; const int nai = u.hs >= 0 ? 1 : 2;
        const int pn = u.pn; const bool lat = u.pm < nlat_tiles;
        const bool isrope = pn < 2 && lat, isnorm = pn >= 8 && pn < 12; const float sc = (pn == 1) ? 0.125f : 1.0f;
        const float* gp = (pn < 10 ? qgain : kgain) + 32 * (fq >> 1) + 8 * (fq & 1);
#pragma unroll
        for (int ai = 0; ai < 2; ++ai) if (ai < nai)
#pragma unroll
            for (int m = 0; m < 4; ++m) { const int row = row0 + ai * HALF + m * 16; bf16_t* rowp = O + (size_t)row * ldc + col0;
                f32x4 x1[2] = {acc[ai][0][m][0], acc[ai][0][m][1]}, x2[2] = {acc[ai][1][m][0], acc[ai][1][m][1]};
                if (isrope) { const int t = row & (SEQ - 1); const int pos = (fq >> 1) ? (t & 63) : (t >> 6); const float* rp = rope + (size_t)(pos * 16 + 8 * (fq & 1)) * 2;
#pragma unroll
                    for (int n = 0; n < 2; ++n) { const f32x4 cs0 = *(const f32x4*)(rp + 8 * n), cs1 = *(const f32x4*)(rp + 8 * n + 4);
                        const f32x4 a1 = x1[n], a2 = x2[n];
                        x1[n] = (f32x4){a1[0] * cs0[0] - a2[0] * cs0[1], a1[1] * cs0[2] - a2[1] * cs0[3], a1[2] * cs1[0] - a2[2] * cs1[1], a1[3] * cs1[2] - a2[3] * cs1[3]};
                        x2[n] = (f32x4){a1[0] * cs0[1] + a2[0] * cs0[0], a1[1] * cs0[3] + a2[1] * cs0[2], a1[2] * cs1[1] + a2[2] * cs1[0], a1[3] * cs1[3] + a2[3] * cs1[2]}; } }
                if (isnorm) { float ss = 0.f;
#pragma unroll
                    for (int n = 0; n < 2; ++n) ss += (x1[n][0] * x1[n][0] + x1[n][1] * x1[n][1]) + (x1[n][2] * x1[n][2] + x1[n][3] * x1[n][3]) + (x2[n][0] * x2[n][0] + x2[n][1] * x2[n][1]) + (x2[n][2] * x2[n][2] + x2[n][3] * x2[n][3]);
                    ss = ::sum_g4(ss); const float rs = rsqrtf(ss * (1.0f / 64.0f) + 1e-6f);
#pragma unroll
                    for (int n = 0; n < 2; ++n) { x1[n] = x1[n] * rs * *(const f32x4*)(gp + 4 * n); x2[n] = x2[n] * rs * *(const f32x4*)(gp + 16 + 4 * n); } }
                u32x4 w1, w2;
                w1.x = cvt_pk_bf16(x1[0][0] * sc, x1[0][1] * sc); w1.y = cvt_pk_bf16(x1[0][2] * sc, x1[0][3] * sc); w1.z = cvt_pk_bf16(x1[1][0] * sc, x1[1][1] * sc); w1.w = cvt_pk_bf16(x1[1][2] * sc, x1[1][3] * sc);
                w2.x = cvt_pk_bf16(x2[0][0] * sc, x2[0][1] * sc); w2.y = cvt_pk_bf16(x2[0][2] * sc, x2[0][3] * sc); w2.z = cvt_pk_bf16(x2[1][0] * sc, x2[1][1] * sc); w2.w = cvt_pk_bf16(x2[1][2] * sc, x2[1][3] * sc);
                *(u32x4*)rowp = w1; *(u32x4*)(rowp + HALF) = w2;
                asm volatile("" ::: "memory"); }
    }
};

constexpr float ACT_F8_SCALE = 4.0f;
struct EpiSwiGLUI8 {
    static constexpr bool PERM = true, AFTER_DRAIN = false, I8 = true, F8 = false;
    static constexpr int NVM_FULL = 8, NVM_HALF = 4, NVM_QUARTER = 4;
    static constexpr bool TAB = true;
    template <class Sched> __device__ __forceinline__ const unsigned* pf_addr(const Sched& S, const Unit& u, int tid_) const {
        int tid = tid_; asm volatile("" : "+v"(tid));
        const int e = S.expert(u.pm);
        const unsigned* p0 = (const unsigned*)(sa + S.arow(u, (u.hs >= 0) ? (tid & (HALF - 1)) : (tid & 255))); const unsigned* p1 = colmax + (size_t)e * ncol_e + u.pn * BM + (tid & 255);
        return tid < 256 ? p0 : p1;
    }
    bf16_t* O; int ldc; const float* sa; const unsigned* colmax; const PG8_LAS int* tab; unsigned* rmax; int ncol_e;
    __device__ __forceinline__ void operator()(const i32x4 (&acc)[2][2][4][2], const Unit& u, int wr, int wc, int fr, int fq, PG8_LAS unsigned char* lds, int ui) const {
        const int rt0 = (u.hs > 0 ? HALF : 0) + wr * 64 + fr, row0 = u.pm * BM + rt0, col0 = u.pn * HALF + wc * 32 + 8 * fq; const int nai = u.hs >= 0 ? 1 : 2;
        const PG8_LAS float* tb = (const PG8_LAS float*)(lds + PG8_EPI_TAB_OFF + (ui & 1) * 2048);
        f32x2 sg2[4], sgl2[4], su2[4];
        { const f32x4 g0 = *(const PG8_LAS f32x4*)(tb + 256 + wc * 32 + 8 * fq), g1 = *(const PG8_LAS f32x4*)(tb + 256 + wc * 32 + 8 * fq + 4), u0 = *(const PG8_LAS f32x4*)(tb + 256 + HALF + wc * 32 + 8 * fq), u1 = *(const PG8_LAS f32x4*)(tb + 256 + HALF + wc * 32 + 8 * fq + 4);
          sg2[0] = (f32x2){g0[0], g0[1]} * (1.0f / 127.0f); sg2[1] = (f32x2){g0[2], g0[3]} * (1.0f / 127.0f); sg2[2] = (f32x2){g1[0], g1[1]} * (1.0f / 127.0f); sg2[3] = (f32x2){g1[2], g1[3]} * (1.0f / 127.0f);
          su2[0] = (f32x2){u0[0], u0[1]} * (ACT_F8_SCALE / 127.0f); su2[1] = (f32x2){u0[2], u0[3]} * (ACT_F8_SCALE / 127.0f); su2[2] = (f32x2){u1[0], u1[1]} * (ACT_F8_SCALE / 127.0f); su2[3] = (f32x2){u1[2], u1[3]} * (ACT_F8_SCALE / 127.0f);
#pragma unroll
          for (int q = 0; q < 4; ++q) sgl2[q] = sg2[q] * (-1.44269504f); }
        float sav[2][4];
#pragma unroll
        for (int ai = 0; ai < 2; ++ai)
#pragma unroll
            for (int m = 0; m < 4; ++m) { const int rt = rt0 + ai * HALF + m * 16; sav[ai][m] = tb[(u.hs >= 0) ? (rt & (HALF - 1)) : rt]; }
#pragma unroll
        for (int ai = 0; ai < 2; ++ai) if (ai < nai)
#pragma unroll
            for (int m = 0; m < 4; ++m) { const int rt = rt0 + ai * HALF + m * 16;
                const float s_a = sav[ai][m];
                float r[8];
#pragma unroll
                for (int q = 0; q < 4; ++q) { const int n = q >> 1, j = 2 * (q & 1);
                    const f32x2 cg = {(float)acc[ai][0][m][n][j], (float)acc[ai][0][m][n][j + 1]}, cu = {(float)acc[ai][1][m][n][j], (float)acc[ai][1][m][n][j + 1]};
                    const f32x2 g = cg * (sg2[q] * s_a), t = cg * (sgl2[q] * s_a), uu = cu * (su2[q] * s_a);
                    const f32x2 d = (f32x2){__builtin_amdgcn_exp2f(t[0]), __builtin_amdgcn_exp2f(t[1])} + 1.0f;
                    const f32x2 rr = g * (f32x2){::rcpf_(d[0]), ::rcpf_(d[1])} * uu;
                    r[2 * q] = rr[0]; r[2 * q + 1] = rr[1]; }
#pragma unroll
                for (int i = 0; i < 8; ++i) r[i] = __builtin_amdgcn_fmed3f(r[i], -448.0f, 448.0f);
                int w0 = __builtin_amdgcn_cvt_pk_fp8_f32(r[0], r[1], 0, false); w0 = __builtin_amdgcn_cvt_pk_fp8_f32(r[2], r[3], w0, true);
                int w1 = __builtin_amdgcn_cvt_pk_fp8_f32(r[4], r[5], 0, false); w1 = __builtin_amdgcn_cvt_pk_fp8_f32(r[6], r[7], w1, true);
                u32x2 w; w.x = (unsigned)w0; w.y = (unsigned)w1;
                *(u32x2*)((unsigned char*)O + (size_t)(u.pm * BM + rt) * (size_t)ldc + col0) = w; }
        (void)row0;
    }
};
struct EpiProjI8 {
    static constexpr bool PERM = true, AFTER_DRAIN = false, I8 = true, F8 = false;
    static constexpr int NVM_FULL = 16, NVM_HALF = 8, NVM_QUARTER = 8;
    static constexpr bool TAB = true;
    template <class Sched> __device__ __forceinline__ const unsigned* pf_addr(const Sched& S, const Unit& u, int tid_) const {
        int tid = tid_; asm volatile("" : "+v"(tid));
        const unsigned* p0 = (const unsigned*)(sa + S.arow(u, (u.hs >= 0) ? (tid & (HALF - 1)) : (tid & 255))); const unsigned* p1 = colmax + u.pn * BM + (tid & 255);
        return tid < 256 ? p0 : p1;
    }
    bf16_t* O; int ldc; const float* rope; const float* qgain; const float* kgain; int nlat_tiles; const float* sa; const unsigned* colmax;
    __device__ __forceinline__ void operator()(const i32x4 (&acc)[2][2][4][2], const Unit& u, int wr, int wc, int fr, int fq, PG8_LAS unsigned char* lds, int ui) const {
        const int row0 = u.pm * BM + (u.hs > 0 ? HALF : 0) + wr * 64 + fr, col0 = u.pn * BM + wc * 32 + 8 * fq; const int nai = u.hs >= 0 ? 1 : 2;
        const int pn = u.pn; const bool lat = u.pm < nlat_tiles;
        const bool isrope = pn < 2 && lat, isnorm = pn >= 8 && pn < 12; const float sc = (pn == 1) ? 0.125f : 1.0f;
        const PG8_LAS float* tb = (const PG8_LAS float*)(lds + PG8_EPI_TAB_OFF + (ui & 1) * 2048);
        const PG8_LAS float* ropeL = (const PG8_LAS float*)(lds + PG8_EPI_CONST_OFF);
        const PG8_LAS float* gp = ropeL + 2048 + (pn < 10 ? 0 : 64) + 32 * (fq >> 1) + 8 * (fq & 1);
        float c1[8], c2[8];
        { const f32x4 a0 = *(const PG8_LAS f32x4*)(tb + 256 + wc * 32 + 8 * fq), a1 = *(const PG8_LAS f32x4*)(tb + 256 + wc * 32 + 8 * fq + 4), b0 = *(const PG8_LAS f32x4*)(tb + 256 + HALF + wc * 32 + 8 * fq), b1 = *(const PG8_LAS f32x4*)(tb + 256 + HALF + wc * 32 + 8 * fq + 4);
#pragma unroll
          for (int i = 0; i < 4; ++i) { c1[i] = a0[i]; c1[4 + i] = a1[i]; c2[i] = b0[i]; c2[4 + i] = b1[i]; } }
        const int rt0 = (u.hs > 0 ? HALF : 0) + wr * 64 + fr;
        float sav[2][4];
#pragma unroll
        for (int ai = 0; ai < 2; ++ai)
#pragma unroll
            for (int m = 0; m < 4; ++m) { const int rt = rt0 + ai * HALF + m * 16; sav[ai][m] = tb[(u.hs >= 0) ? (rt & (HALF - 1)) : rt] * (1.0f / 127.0f); }
#pragma unroll
        for (int ai = 0; ai < 2; ++ai) if (ai < nai)
#pragma unroll
            for (int m = 0; m < 4; ++m) { const int row = row0 + ai * HALF + m * 16; bf16_t* rowp = O + (size_t)row * ldc + col0;
                const float s_a = sav[ai][m];
                f32x4 x1[2], x2[2];
#pragma unroll
                for (int n = 0; n < 2; ++n)
#pragma unroll
                    for (int j = 0; j < 4; ++j) { x1[n][j] = (float)acc[ai][0][m][n][j] * (s_a * c1[4 * n + j]); x2[n][j] = (float)acc[ai][1][m][n][j] * (s_a * c2[4 * n + j]); }
                if (isrope) { const int t = row & (SEQ - 1); const int pos = (fq >> 1) ? (t & 63) : (t >> 6); const PG8_LAS float* rp = ropeL + (pos * 16 + 8 * (fq & 1)) * 2;
#pragma unroll
                    for (int n = 0; n < 2; ++n) { const f32x4 cs0 = *(const PG8_LAS f32x4*)(rp + 8 * n), cs1 = *(const PG8_LAS f32x4*)(rp + 8 * n + 4);
                        const f32x4 a1 = x1[n], a2 = x2[n];
                        x1[n] = (f32x4){a1[0] * cs0[0] - a2[0] * cs0[1], a1[1] * cs0[2] - a2[1] * cs0[3], a1[2] * cs1[0] - a2[2] * cs1[1], a1[3] * cs1[2] - a2[3] * cs1[3]};
                        x2[n] = (f32x4){a1[0] * cs0[1] + a2[0] * cs0[0], a1[1] * cs0[3] + a2[1] * cs0[2], a1[2] * cs1[1] + a2[2] * cs1[0], a1[3] * cs1[3] + a2[3] * cs1[2]}; } }
                if (isnorm) { float ss = 0.f;
#pragma unroll
                    for (int n = 0; n < 2; ++n) ss += (x1[n][0] * x1[n][0] + x1[n][1] * x1[n][1]) + (x1[n][2] * x1[n][2] + x1[n][3] * x1[n][3]) + (x2[n][0] * x2[n][0] + x2[n][1] * x2[n][1]) + (x2[n][2] * x2[n][2] + x2[n][3] * x2[n][3]);
                    ss = ::sum_g4(ss); const float rs = rsqrtf(ss * (1.0f / 64.0f) + 1e-6f);
#pragma unroll
                    for (int n = 0; n < 2; ++n) { x1[n] = x1[n] * rs * *(const PG8_LAS f32x4*)(gp + 4 * n); x2[n] = x2[n] * rs * *(const PG8_LAS f32x4*)(gp + 16 + 4 * n); } }
                u32x4 w1, w2;
                w1.x = cvt_pk_bf16(x1[0][0] * sc, x1[0][1] * sc); w1.y = cvt_pk_bf16(x1[0][2] * sc, x1[0][3] * sc); w1.z = cvt_pk_bf16(x1[1][0] * sc, x1[1][1] * sc); w1.w = cvt_pk_bf16(x1[1][2] * sc, x1[1][3] * sc);
                w2.x = cvt_pk_bf16(x2[0][0] * sc, x2[0][1] * sc); w2.y = cvt_pk_bf16(x2[0][2] * sc, x2[0][3] * sc); w2.z = cvt_pk_bf16(x2[1][0] * sc, x2[1][1] * sc); w2.w = cvt_pk_bf16(x2[1][2] * sc, x2[1][3] * sc);
                *(u32x4*)rowp = w1; *(u32x4*)(rowp + HALF) = w2;
                asm volatile("" ::: "memory"); }
    }
};

struct EpiNullI8 {
    static constexpr bool PERM = true, AFTER_DRAIN = false, I8 = true, F8 = false;
    static constexpr int NVM_FULL = -1, NVM_HALF = -1, NVM_QUARTER = -1;
    static constexpr bool TAB = false;
    bf16_t* O; int ldc;
    __device__ __forceinline__ void operator()(const i32x4 (&acc)[2][2][4][2], const Unit& u, int wr, int wc, int fr, int fq, PG8_LAS unsigned char* lds, int ui) const {
        int s = 0;
#pragma unroll
        for (int ai = 0; ai < 2; ++ai)
#pragma unroll
            for (int bj = 0; bj < 2; ++bj)
#pragma unroll
                for (int m = 0; m < 4; ++m)
#pragma unroll
                    for (int n = 0; n < 2; ++n) s += acc[ai][bj][m][n][0] + acc[ai][bj][m][n][1] + acc[ai][bj][m][n][2] + acc[ai][bj][m][n][3];
        if (s == 123456789) O[0] = (bf16_t)1;
    }
};

struct EpiResidI8 {
    static constexpr bool PERM = false, AFTER_DRAIN = false, I8 = true, F8 = false;
    static constexpr int NVM_FULL = -1, NVM_HALF = -1, NVM_QUARTER = -1;
    const float* base_lat; const float* base_ctx; float* out_lat; float* out_ctx; const float* gate; int nlat_tiles; const unsigned* rmax; const unsigned* colmax;
    static constexpr bool TAB = true;
    template <class Sched> __device__ __forceinline__ const unsigned* pf_addr(const Sched& S, const Unit& u, int tid_) const {
        int tid = tid_; asm volatile("" : "+v"(tid));
        const unsigned* p0 = rmax + S.arow(u, (u.hs >= 0) ? (tid & (HALF - 1)) : (tid & 255)); const unsigned* p1 = colmax + u.pn * BM + (tid & 255);
        return tid < 256 ? p0 : p1;
    }
    __device__ __forceinline__ void operator()(const i32x4 (&acc)[2][2][4][2], const Unit& u, int wr, int wc, int fr, int fq, PG8_LAS unsigned char* lds, int ui) const {
        const PG8_LAS float* tb = (const PG8_LAS float*)(lds + PG8_EPI_TAB_OFF + (ui & 1) * 2048);
        const bool isctx = u.pm >= nlat_tiles;
        const int rt0 = (u.hs > 0 ? HALF : 0) + wr * 64 + fr;
        const int rloc0 = (isctx ? (u.pm - nlat_tiles) : u.pm) * BM + rt0, col0 = u.pn * BM + wc * 32 + 4 * fq;
        const float* bp = (isctx ? base_ctx : base_lat) + (size_t)rloc0 * 1024 + col0; float* op = (isctx ? out_ctx : out_lat) + (size_t)rloc0 * 1024 + col0;
        const float* gp = gate + (size_t)(isctx ? 8 : (u.pm >> 3)) * 6144 + col0;
        f32x4 gv[2][2];
#pragma unroll
        for (int bj = 0; bj < 2; ++bj)
#pragma unroll
            for (int n = 0; n < 2; ++n) gv[bj][n] = *(const f32x4*)(gp + bj * HALF + n * 16) * *(const PG8_LAS f32x4*)(tb + 256 + bj * HALF + wc * 32 + n * 16 + 4 * fq) * (1.0f / (127.0f * 127.0f));
        const PG8_LAS float* sap = tb + ((u.hs >= 0) ? (rt0 & (HALF - 1)) : rt0);
        if (u.bs != 1) pass<0, 0>(acc, bp, op, gv, sap); if (u.bs != 0) pass<0, 1>(acc, bp, op, gv, sap);
        if (u.hs < 0) { pass<1, 0>(acc, bp, op, gv, sap); pass<1, 1>(acc, bp, op, gv, sap); }
    }
    template <int AI, int BJ> __device__ __forceinline__ void pass(const i32x4 (&acc)[2][2][4][2], const float* bp, float* op, const f32x4 (&gv)[2][2], const PG8_LAS float* sap) const {
        f32x4 r[4][2];
#pragma unroll
        for (int m = 0; m < 4; ++m)
#pragma unroll
            for (int n = 0; n < 2; ++n) r[m][n] = *(const f32x4*)(bp + (size_t)(AI * HALF + m * 16) * 1024 + BJ * HALF + n * 16);
        asm volatile("" ::: "memory"); __builtin_amdgcn_sched_barrier(0);
#pragma unroll
        for (int m = 0; m < 4; ++m) { const float s_a = sap[AI * HALF + 16 * m];
#pragma unroll
            for (int n = 0; n < 2; ++n) { const i32x4 ia = acc[AI][BJ][m][n]; const f32x4 fa = {(float)ia[0], (float)ia[1], (float)ia[2], (float)ia[3]};
                *(f32x4*)(op + (size_t)(AI * HALF + m * 16) * 1024 + BJ * HALF + n * 16) = r[m][n] + gv[BJ][n] * fa * s_a; } }
        asm volatile("" ::: "memory"); __builtin_amdgcn_sched_barrier(0);
    }
};
struct EpiResidF8 {
    static constexpr bool PERM = true, AFTER_DRAIN = false, I8 = false, F8 = true;
    static constexpr int NVM_FULL = -1, NVM_HALF = -1, NVM_QUARTER = -1;
    static constexpr bool TAB = true;
    const void* base_lat; const void* base_ctx; bf16_t* out_lat; bf16_t* out_ctx; const float* gate; int nlat_tiles; const unsigned* colmax; float osc; int base_f32;
    template <class Sched> __device__ __forceinline__ const unsigned* pf_addr(const Sched& S, const Unit& u, int tid_) const {
        int tid = tid_; asm volatile("" : "+v"(tid)); (void)S;
        return colmax + u.pn * BM + (tid & 255);
    }
    __device__ __forceinline__ void operator()(const f32x4 (&acc)[2][2][4][2], const Unit& u, int wr, int wc, int fr, int fq, PG8_LAS unsigned char* lds, int ui) const {
        const PG8_LAS float* tb = (const PG8_LAS float*)(lds + PG8_EPI_TAB_OFF + (ui & 1) * 2048);
        const bool isctx = u.pm >= nlat_tiles;
        const int rt0 = (u.hs > 0 ? HALF : 0) + wr * 64 + fr;
        const int rloc0 = (isctx ? (u.pm - nlat_tiles) : u.pm) * BM + rt0, col0 = u.pn * BM + wc * 32 + 8 * fq;
        const size_t off0 = (size_t)rloc0 * 1024 + col0;
        const float* bpf = (const float*)(isctx ? base_ctx : base_lat) + off0; const bf16_t* bph = (const bf16_t*)(isctx ? base_ctx : base_lat) + off0; bf16_t* op = (isctx ? out_ctx : out_lat) + off0;
        const float* gp = gate + (size_t)(isctx ? 8 : (u.pm >> 3)) * 6144 + col0;
        f32x4 gv[2][2];
#pragma unroll
        for (int bj = 0; bj < 2; ++bj)
#pragma unroll
            for (int n = 0; n < 2; ++n) gv[bj][n] = *(const f32x4*)(gp + bj * HALF + 4 * n) * *(const PG8_LAS f32x4*)(tb + 256 + bj * HALF + wc * 32 + 8 * fq + 4 * n) * osc;
        if (base_f32) { if (u.bs != 1) pass<0, 0, true>(acc, bpf, bph, op, gv); if (u.bs != 0) pass<0, 1, true>(acc, bpf, bph, op, gv);
                        if (u.hs < 0) { pass<1, 0, true>(acc, bpf, bph, op, gv); pass<1, 1, true>(acc, bpf, bph, op, gv); } }
        else          { if (u.bs != 1) pass<0, 0, false>(acc, bpf, bph, op, gv); if (u.bs != 0) pass<0, 1, false>(acc, bpf, bph, op, gv);
                        if (u.hs < 0) { pass<1, 0, false>(acc, bpf, bph, op, gv); pass<1, 1, false>(acc, bpf, bph, op, gv); } }
    }
    template <int AI, int BJ, bool BF32> __device__ __forceinline__ void pass(const f32x4 (&acc)[2][2][4][2], const float* bpf, const bf16_t* bph, bf16_t* op, const f32x4 (&gv)[2][2]) const {
        f32x4 r[4][2];
        if (BF32) {
#pragma unroll
            for (int m = 0; m < 4; ++m)
#pragma unroll
                for (int n = 0; n < 2; ++n) r[m][n] = *(const f32x4*)(bpf + (size_t)(AI * HALF + m * 16) * 1024 + BJ * HALF + 4 * n);
        } else { u32x4 h[4];
#pragma unroll
            for (int m = 0; m < 4; ++m) h[m] = *(const u32x4*)(bph + (size_t)(AI * HALF + m * 16) * 1024 + BJ * HALF);
#pragma unroll
            for (int m = 0; m < 4; ++m) { r[m][0] = (f32x4){::bflo(h[m].x), ::bfhi(h[m].x), ::bflo(h[m].y), ::bfhi(h[m].y)}; r[m][1] = (f32x4){::bflo(h[m].z), ::bfhi(h[m].z), ::bflo(h[m].w), ::bfhi(h[m].w)}; } }
        asm volatile("" ::: "memory"); __builtin_amdgcn_sched_barrier(0);
#pragma unroll
        for (int m = 0; m < 4; ++m) { const f32x4 y0 = r[m][0] + gv[BJ][0] * acc[AI][BJ][m][0], y1 = r[m][1] + gv[BJ][1] * acc[AI][BJ][m][1];
            u32x4 w; w.x = cvt_pk_bf16(y0[0], y0[1]); w.y = cvt_pk_bf16(y0[2], y0[3]); w.z = cvt_pk_bf16(y1[0], y1[1]); w.w = cvt_pk_bf16(y1[2], y1[3]);
            *(u32x4*)(op + (size_t)(AI * HALF + m * 16) * 1024 + BJ * HALF) = w; }
        asm volatile("" ::: "memory"); __builtin_amdgcn_sched_barrier(0);
    }
};
struct EpiBf16I8 {
    static constexpr bool PERM = true, AFTER_DRAIN = false, I8 = true, F8 = false;
    static constexpr int NVM_FULL = 16, NVM_HALF = 8, NVM_QUARTER = 4;
    bf16_t* O; int ldc; const unsigned* rmax; const unsigned* colmax; const PG8_LAS int* tab; int ncol_e;
    static constexpr bool TAB = true;
    template <class Sched> __device__ __forceinline__ const unsigned* pf_addr(const Sched& S, const Unit& u, int tid_) const {
        int tid = tid_; asm volatile("" : "+v"(tid));
        const int e = S.expert(u.pm);
        const unsigned* p0 = rmax + S.arow(u, (u.hs >= 0) ? (tid & (HALF - 1)) : (tid & 255)); const unsigned* p1 = colmax + (size_t)e * ncol_e + u.pn * BM + (tid & 255);
        return tid < 256 ? p0 : p1;
    }
    __device__ __forceinline__ void operator()(const i32x4 (&acc)[2][2][4][2], const Unit& u, int wr, int wc, int fr, int fq, PG8_LAS unsigned char* lds, int ui) const {
        const PG8_LAS float* tb = (const PG8_LAS float*)(lds + PG8_EPI_TAB_OFF + (ui & 1) * 2048);
        const int rt0 = (u.hs > 0 ? HALF : 0) + wr * 64 + fr, col0 = u.pn * BM + wc * 32 + 8 * fq; const int nai = u.hs >= 0 ? 1 : 2;
        f32x4 sb[2][2];
#pragma unroll
        for (int bj = 0; bj < 2; ++bj)
#pragma unroll
            for (int n = 0; n < 2; ++n) sb[bj][n] = *(const PG8_LAS f32x4*)(tb + 256 + bj * HALF + wc * 32 + 8 * fq + 4 * n) * (1.0f / (127.0f * 127.0f));
#pragma unroll
        for (int ai = 0; ai < 2; ++ai) if (ai < nai)
#pragma unroll
            for (int m = 0; m < 4; ++m) { const int rt = rt0 + ai * HALF + m * 16; bf16_t* rowp = O + (size_t)(u.pm * BM + rt) * ldc + col0;
                const float s_a = tb[(u.hs >= 0) ? (rt & (HALF - 1)) : rt];
#pragma unroll
                for (int bj = 0; bj < 2; ++bj) if (u.bs < 0 || u.bs == bj) {
                    const i32x4 i0 = acc[ai][bj][m][0], i1 = acc[ai][bj][m][1];
                    const f32x4 v0 = (f32x4){(float)i0[0], (float)i0[1], (float)i0[2], (float)i0[3]} * sb[bj][0] * s_a, v1 = (f32x4){(float)i1[0], (float)i1[1], (float)i1[2], (float)i1[3]} * sb[bj][1] * s_a;
                    u32x4 w; w.x = cvt_pk_bf16(v0[0], v0[1]); w.y = cvt_pk_bf16(v0[2], v0[3]); w.z = cvt_pk_bf16(v1[0], v1[1]); w.w = cvt_pk_bf16(v1[2], v1[3]);
                    *(u32x4*)(rowp + bj * HALF) = w; } }
    }
};
struct EpiBf16F8 {
    static constexpr bool PERM = true, AFTER_DRAIN = false, I8 = false, F8 = true;
    static constexpr int NVM_FULL = 16, NVM_HALF = 8, NVM_QUARTER = 4;
    bf16_t* O; int ldc; const unsigned* rmax; const unsigned* colmax; const PG8_LAS int* tab; int ncol_e;
    static constexpr bool TAB = true;
    template <class Sched> __device__ __forceinline__ const unsigned* pf_addr(const Sched& S, const Unit& u, int tid_) const {
        int tid = tid_; asm volatile("" : "+v"(tid));
        const int e = S.expert(u.pm);
        const unsigned* p1 = colmax + (size_t)e * ncol_e + u.pn * BM + (tid & 255); const unsigned* p0 = p1;
        return tid < 256 ? p0 : p1;
    }
    __device__ __forceinline__ void operator()(const f32x4 (&acc)[2][2][4][2], const Unit& u, int wr, int wc, int fr, int fq, PG8_LAS unsigned char* lds, int ui) const {
        const PG8_LAS float* tb = (const PG8_LAS float*)(lds + PG8_EPI_TAB_OFF + (ui & 1) * 2048);
        const int rt0 = (u.hs > 0 ? HALF : 0) + wr * 64 + fr, col0 = u.pn * BM + wc * 32 + 8 * fq; const int nai = u.hs >= 0 ? 1 : 2;
        f32x4 sb[2][2];
#pragma unroll
        for (int bj = 0; bj < 2; ++bj)
#pragma unroll
            for (int n = 0; n < 2; ++n) sb[bj][n] = *(const PG8_LAS f32x4*)(tb + 256 + bj * HALF + wc * 32 + 8 * fq + 4 * n) * (1.0f / (448.0f * ACT_F8_SCALE));
#pragma unroll
        for (int ai = 0; ai < 2; ++ai) if (ai < nai)
#pragma unroll
            for (int m = 0; m < 4; ++m) { const int rt = rt0 + ai * HALF + m * 16; bf16_t* rowp = O + (size_t)(u.pm * BM + rt) * ldc + col0;
#pragma unroll
                for (int bj = 0; bj < 2; ++bj) if (u.bs < 0 || u.bs == bj) {
                    const f32x4 v0 = acc[ai][bj][m][0] * sb[bj][0], v1 = acc[ai][bj][m][1] * sb[bj][1];
                    u32x4 w; w.x = cvt_pk_bf16(v0[0], v0[1]); w.y = cvt_pk_bf16(v0[2], v0[3]); w.z = cvt_pk_bf16(v1[0], v1[1]); w.w = cvt_pk_bf16(v1[2], v1[3]);
                    *(u32x4*)(rowp + bj * HALF) = w; } }
    }
};
template <class Epi, class Sched, bool STAMP = false>
__device__ __forceinline__ void gemm_phase(PG8_LAS unsigned char* lds, const Gemm g, const Sched& S, const Epi& E, unsigned long long* stamps, int tid_in) {
    int tid_ = tid_in; asm volatile("" : "+v"(tid_)); const int tid = tid_, wid = __builtin_amdgcn_readfirstlane(tid >> 6), lane = tid & 63, wr = wid >> 2, wc = wid & 3, fr = lane & 15, fq = lane >> 4;
    const int K = g.K, nt = K / BK; const unsigned apitch = g.lda2 ? (unsigned)g.lda2 : (unsigned)(K * 2);
    int ts_lo = 0, ts_hi = 0, nts = 0; const unsigned long long rt_entry = STAMP ? (unsigned long long)wall_clock64() : 0ull;
#define PG8_STAMP() do { if (STAMP && wid == 0 && nts < 64) { const unsigned long long _c = (unsigned long long)clock64(); \
        ts_lo = (lane == nts) ? (int)(unsigned)_c : ts_lo; ts_hi = (lane == nts) ? (int)(unsigned)(_c >> 32) : ts_hi; ++nts; } } while (0)
    PG8_STAMP();
    unsigned voffB[2]; int stR[2]; unsigned stC[2];
#pragma unroll
    for (int i = 0; i < 2; ++i) { int R, C; stage_rc(tid * 16 + i * 8192, R, C); const int Rb = Epi::PERM ? ((R & ~31) + perm32(R & 31)) : R;
        stR[i] = R; stC[i] = (unsigned)C * 2u; voffB[i] = (unsigned)Rb * (unsigned)S.K2 + (unsigned)C * 2u; }
    unsigned vAc0[2], vAc1[2], vAn0[2], vAn1[2];
#define PG8_AROWS(u, d0, d1) do { _Pragma("unroll") for (int _i = 0; _i < 2; ++_i) { d0[_i] = S.arow(u, stR[_i]) * apitch + stC[_i]; d1[_i] = S.arow(u, HALF + stR[_i]) * apitch + stC[_i]; } } while (0)
    const size_t kstep = (size_t)(BK * 2);
    const size_t hstep = (size_t)HALF * S.K2;
    const size_t tstep = 2 * hstep;
    const unsigned ldsw = (unsigned)wid * 1024u;
    const int aoff = lds_byte(wr * 64 + fr, fq * 8), boff = lds_byte(wc * 32 + fr, fq * 8);
#define PG8_SA(b, h) (((b) * 2 + (h)) * HTB)
#define PG8_SB(b, h) ((4 + (b) * 2 + (h)) * HTB)
#define PG8_STAGE(bufoff, gbase, voff) do { _Pragma("unroll") for (int _i = 0; _i < 2; ++_i) \
        __builtin_amdgcn_global_load_lds((const unsigned*)((const char*)(gbase) + (voff)[_i]), (PG8_LAS unsigned*)(lds + (bufoff) + ldsw + _i * 8192), 16, 0, 0); } while (0)
#define PG8_LDA(dst, b, h) do { _Pragma("unroll") for (int m = 0; m < 4; ++m) _Pragma("unroll") for (int k = 0; k < 2; ++k) dst[m][k] = *(const PG8_LAS bf16x8*)(lds + PG8_SA(b, h) + aoff + m * 2048 + k * 1024); } while (0)
#define PG8_LDB(dst, b, h) do { _Pragma("unroll") for (int n = 0; n < 2; ++n) _Pragma("unroll") for (int k = 0; k < 2; ++k) dst[n][k] = *(const PG8_LAS bf16x8*)(lds + PG8_SB(b, h) + boff + n * 2048 + k * 1024); } while (0)
#define PG8_MMA(ai, bj, At, Bt) do { __builtin_amdgcn_s_setprio(1); _Pragma("unroll") for (int m = 0; m < 4; ++m) _Pragma("unroll") for (int n = 0; n < 2; ++n) { \
        if constexpr (Epi::F8) acc[ai][bj][m][n] = mma_f8(Bt[n][0], Bt[n][1], At[m][0], At[m][1], acc[ai][bj][m][n]); \
        else { _Pragma("unroll") for (int k = 0; k < 2; ++k) acc[ai][bj][m][n] = mma_op<Epi::I8>(Bt[n][k], At[m][k], acc[ai][bj][m][n]); } } __builtin_amdgcn_s_setprio(0); } while (0)
#define PG8_WAIT_V(n) asm volatile("s_waitcnt vmcnt(" #n ")" ::: "memory")
#define PG8_WAIT_L(n) asm volatile("s_waitcnt lgkmcnt(" #n ")" ::: "memory")
#define PG8_BAR __builtin_amdgcn_s_barrier()
#define PG8_SCHED __builtin_amdgcn_sched_barrier(0)
    Unit cur, nxt; int ui = 0;
    if (!S.next(0, cur)) return;
    typename AccSel<Epi::I8>::T acc[2][2][4][2];
#pragma unroll
    for (int a = 0; a < 2; ++a)
#pragma unroll
        for (int b = 0; b < 2; ++b)
#pragma unroll
            for (int m = 0; m < 4; ++m)
#pragma unroll
                for (int n = 0; n < 2; ++n) acc[a][b][m][n] = AccSel<Epi::I8>::zero();
    bf16x8 At[4][2], B0[2][2], B1[2][2];
    const char* const cA = (const char*)g.A; const char* cB = S.bbase(cur);
    PG8_AROWS(cur, vAc0, vAc1);
    S.a_ready(cur);
#define PG8_TABLOAD(u, par) do { if constexpr (Epi::TAB) __builtin_amdgcn_global_load_lds(E.pf_addr(S, u, tid), (PG8_LAS unsigned*)(lds + PG8_EPI_TAB_OFF + ((par) & 1) * 2048 + wid * 256), 4, 0, 0); } while (0)
    PG8_TABLOAD(cur, 0);
    PG8_STAGE(PG8_SB(0, 0), cB, voffB); PG8_STAGE(PG8_SA(0, 0), cA, vAc0); PG8_STAGE(PG8_SB(0, 1), cB + hstep, voffB); PG8_STAGE(PG8_SA(0, 1), cA, vAc1);
    if (wr == 1) PG8_BAR;
    PG8_WAIT_V(4); PG8_BAR;
    PG8_STAGE(PG8_SB(1, 0), cB + kstep, voffB); PG8_STAGE(PG8_SA(1, 0), cA + kstep, vAc0); PG8_STAGE(PG8_SB(1, 1), cB + hstep + kstep, voffB);
    PG8_WAIT_V(6); PG8_BAR;
    PG8_STAMP();
    for (;;) {
        const bool has_next = S.next(ui + 1, nxt);
        const char* nB = has_next ? S.bbase(nxt) : cB;
        if (has_next) PG8_AROWS(nxt, vAn0, vAn1); else { _Pragma("unroll") for (int _i = 0; _i < 2; ++_i) { vAn0[_i] = vAc0[_i]; vAn1[_i] = vAc1[_i]; } }
        const bool full = cur.hs < 0;
        constexpr bool EARLY = Epi::NVM_FULL > 0;
        const bool do_b0 = cur.bs != 1, do_b1 = cur.bs != 0;
        for (int t = 0; t < nt; t += 2) {
            const bool last = (t == nt - 2); const bool early = EARLY && __builtin_amdgcn_readfirstlane((t == 0 && ui > 0) ? 1 : 0) != 0;
            const char* a1 = cA + (size_t)(t + 1) * kstep;
            const char* a2 = last ? cA : cA + (size_t)(t + 2) * kstep; const char* b2 = last ? nB : cB + (size_t)(t + 2) * kstep;
            const char* a3 = a2 + kstep; const char* b3 = b2 + kstep;
            unsigned v20[2], v21[2];
#pragma unroll
            for (int _i = 0; _i < 2; ++_i) { v20[_i] = last ? vAn0[_i] : vAc0[_i]; v21[_i] = last ? vAn1[_i] : vAc1[_i]; }
            if (last && has_next) S.a_ready(nxt);
            PG8_LDB(B0, 0, 0); PG8_SCHED; PG8_LDA(At, 0, 0); if (!early) PG8_STAGE(PG8_SA(1, 1), a1, vAc1);
            PG8_WAIT_L(8); PG8_BAR; PG8_WAIT_L(0); if (do_b0) PG8_MMA(0, 0, At, B0); PG8_BAR; PG8_SCHED;
            PG8_LDB(B1, 0, 1); PG8_STAGE(PG8_SB(0, 0), b2, voffB);
            PG8_BAR; PG8_WAIT_L(0); if (do_b1) PG8_MMA(0, 1, At, B1); PG8_BAR;
            if (full) PG8_LDA(At, 0, 1); PG8_STAGE(PG8_SA(0, 0), a2, v20);
            PG8_BAR; PG8_WAIT_L(0); if (full) PG8_MMA(1, 0, At, B0); PG8_BAR; PG8_SCHED;
            PG8_STAGE(PG8_SB(0, 1), b2 + hstep, voffB);
            if (early) asm volatile("s_waitcnt vmcnt(%0)" :: "n"(6 + (Epi::TAB ? 1 : 0) + (Epi::NVM_FULL > 0 ? Epi::NVM_FULL : 0)) : "memory"); else PG8_WAIT_V(6);
            PG8_BAR; if (full) PG8_MMA(1, 1, At, B1); PG8_BAR;
            PG8_LDB(B0, 1, 0); PG8_SCHED; PG8_LDA(At, 1, 0); PG8_STAGE(PG8_SA(0, 1), a2, v21);
            PG8_WAIT_L(8); PG8_BAR; PG8_WAIT_L(0); if (do_b0) PG8_MMA(0, 0, At, B0); PG8_BAR; PG8_SCHED;
            PG8_LDB(B1, 1, 1); PG8_STAGE(PG8_SB(1, 0), b3, voffB);
            PG8_BAR; PG8_WAIT_L(0); if (do_b1) PG8_MMA(0, 1, At, B1); PG8_BAR;
            if (full) PG8_LDA(At, 1, 1); PG8_STAGE(PG8_SA(1, 0), a3, v20);
            PG8_BAR; PG8_WAIT_L(0); if (full) PG8_MMA(1, 0, At, B0); PG8_BAR; PG8_SCHED;
            PG8_STAGE(PG8_SB(1, 1), b3 + hstep, voffB);
            PG8_WAIT_V(6); PG8_BAR; if (full) PG8_MMA(1, 1, At, B1); PG8_BAR;
        }
        PG8_STAMP();
        if constexpr (EARLY) PG8_STAGE(PG8_SA(1, 1), cA + kstep, vAn1);
        { Unit pu; pu.pm = has_next ? nxt.pm : cur.pm; pu.pn = has_next ? nxt.pn : cur.pn; pu.hs = has_next ? nxt.hs : cur.hs; pu.idx = has_next ? nxt.idx : cur.idx; pu.bs = has_next ? nxt.bs : cur.bs;
          PG8_TABLOAD(pu, ui + 1); }
        if constexpr (!Epi::AFTER_DRAIN) { E(acc, cur, wr, wc, fr, fq, lds, ui); S.done(cur); }
        PG8_STAMP();
        if (!has_next) break;
#pragma unroll
        for (int a = 0; a < 2; ++a)
#pragma unroll
            for (int b = 0; b < 2; ++b)
#pragma unroll
                for (int m = 0; m < 4; ++m)
#pragma unroll
                    for (int n = 0; n < 2; ++n) acc[a][b][m][n] = AccSel<Epi::I8>::zero();
        cur = nxt; cB = nB; ++ui;
#pragma unroll
        for (int _i = 0; _i < 2; ++_i) { vAc0[_i] = vAn0[_i]; vAc1[_i] = vAn1[_i]; }
    }
    PG8_WAIT_V(0);
    if (wr == 0) PG8_BAR;
    PG8_BAR;
    if constexpr (Epi::AFTER_DRAIN) { E.fused(acc, cur, wr, wc, fr, fq, lds, wid, lane); S.done(cur); }
    PG8_STAMP();
    if (STAMP && wid == 0) { stamps[lane] = lane < nts ? (((unsigned long long)(unsigned)ts_hi << 32) | (unsigned)ts_lo) : 0ull;
        if (lane == 62) stamps[62] = rt_entry; if (lane == 63) stamps[63] = (unsigned long long)wall_clock64(); }
#undef PG8_STAMP
#undef PG8_TABLOAD
#undef PG8_SA
#undef PG8_AROWS
#undef PG8_SB
#undef PG8_STAGE
#undef PG8_LDA
#undef PG8_LDB
#undef PG8_MMA
#undef PG8_WAIT_V
#undef PG8_WAIT_L
#undef PG8_BAR
#undef PG8_SCHED
}
}
#define XB_TMO      128
#define XB_XCNT(j)  (256  + 64 * (j))
#define XB_XSUB(j)  (1280 + 64 * (j))
#define XB_XGEN(j)  (2304 + 64 * (j))
#define XB_TOP      3328
#define XB_TOPGEN   3392
#define XCD_BAR_WORDS 3456
#define XB_SPIN_CAP (1u << 24)

__device__ __forceinline__ unsigned xb_ld(unsigned* p)              { return __hip_atomic_load(p, __ATOMIC_RELAXED, __HIP_MEMORY_SCOPE_AGENT); }
__device__ __forceinline__ unsigned xb_add(unsigned* p, unsigned v) { return __hip_atomic_fetch_add(p, v, __ATOMIC_RELAXED, __HIP_MEMORY_SCOPE_AGENT); }
__device__ __forceinline__ unsigned xb_xcc_id() { return (unsigned)__builtin_amdgcn_s_getreg((3 << 11) | 20) & 0xFu; }
#define XB_SPIN(cond, bar) do { unsigned _sp = 0; while (cond) { __builtin_amdgcn_s_sleep(1); \
    if ((++_sp & 255u) == 0u) { if (xb_ld(&(bar)[XB_TMO])) break; if (_sp > XB_SPIN_CAP) { atomicAdd(&(bar)[XB_TMO], 1u); break; } } } } while (0)

struct XcdBarrier {
    unsigned* bar; unsigned x;
    volatile LAS unsigned* st;
};

__device__ __forceinline__ XcdBarrier xcd_barrier_post(unsigned* bar, volatile LAS unsigned* st) {
    XcdBarrier b; b.bar = bar; b.x = xb_xcc_id(); b.st = st;
    if (threadIdx.x == 0) (void)xb_add(&bar[XB_XCNT(b.x)], 1u);
    return b;
}
__device__ __forceinline__ void xcd_barrier_complete(unsigned* bar, unsigned x, unsigned& nloc, unsigned& nx) {
    const unsigned G = gridDim.x * gridDim.y * gridDim.z;
    unsigned sum, cnt, mine, sp = 0u;
    for (;;) {
        sum = 0u; cnt = 0u; mine = 0u;
#pragma unroll
        for (unsigned j = 0; j < 16; ++j) { const unsigned c = xb_ld(&bar[XB_XCNT(j)]); sum += c; cnt += (c > 0u) ? 1u : 0u; mine = (j == x) ? c : mine; }
        if (sum == G) break;
        __builtin_amdgcn_s_sleep(1);
        if ((++sp & 255u) == 0u) { if (xb_ld(&bar[XB_TMO])) break; if (sp > XB_SPIN_CAP) { atomicAdd(&bar[XB_TMO], 1u); break; } }
    }
    nloc = mine > 0u ? mine : 1u; nx = cnt > 0u ? cnt : 1u;
}

__device__ __forceinline__ void xcd_barrier(const XcdBarrier& b) {
    asm volatile("s_waitcnt vmcnt(0)" ::: "memory");
    __syncthreads();
    if (threadIdx.x == 0) {
        unsigned* bar = b.bar;
        __builtin_amdgcn_s_waitcnt(0);
        unsigned nloc = b.st[0], nx = b.st[1];
        if (nloc == 0u) { xcd_barrier_complete(bar, b.x, nloc, nx); b.st[0] = nloc; b.st[1] = nx; }
        const unsigned old = xb_add(&bar[XB_XSUB(b.x)], 1u);
        const unsigned gen = old / nloc;
        if (old + 1u == (gen + 1u) * nloc) {
            __builtin_amdgcn_fence(__ATOMIC_RELEASE, "agent");
            asm volatile("s_waitcnt vmcnt(0)" ::: "memory");
            const unsigned og = xb_add(&bar[XB_TOP], 1u);
            const unsigned tg = og / nx;
            if (og + 1u == (tg + 1u) * nx) xb_add(&bar[XB_TOPGEN], 1u);
            else XB_SPIN(xb_ld(&bar[XB_TOPGEN]) == tg, bar);
            __builtin_amdgcn_fence(__ATOMIC_ACQUIRE, "agent");
            xb_add(&bar[XB_XGEN(b.x)], 1u);
            asm volatile("s_waitcnt vmcnt(0)" ::: "memory");
        } else {
            XB_SPIN(xb_ld(&bar[XB_XGEN(b.x)]) == gen, bar);
            __builtin_amdgcn_fence(__ATOMIC_ACQUIRE, "agent");
            asm volatile("s_waitcnt vmcnt(0)" ::: "memory");
        }
    }
    __syncthreads();
}

constexpr int SCR_BYTES = 139264;
constexpr int MISC_OFF = 147456 - 128;
constexpr int LDS_BYTES = 147456;
constexpr int CW_BAR = 4096;
constexpr int NTHR = 512, NWAVES = 8;
constexpr int CW_COLMAX = 131072;
constexpr int N_QROWS = 2 * NPW + NUP + NEXP * NUP;
constexpr int QS_NPRO = 1024;
constexpr int CW_COLMAX_DN = CW_COLMAX + N_QROWS;
constexpr int CW_COLMAX_OUT = CW_COLMAX_DN + DM + NEXP * DM;
constexpr int CW_RMAX_D = CW_COLMAX_DN + DM + NEXP * DM, CW_RMAX_M = CW_RMAX_D + MALL; static_assert(CW_RMAX_M + 2 * NLAT + NEXP * 256 <= 262144, "CTL region");
constexpr int CW_STRIPCTR = 24576;
constexpr int CW_CHFLAG = 16384;
constexpr int CW_MOE = 8192;

template <bool F8 = false>
__device__ __forceinline__ void transpose_item(const float* W, int ldw, int col0, int K, bf16_t* WT, int drow0, int kb, LAS float* scr, int lane, int gap16 = 0, unsigned* cmax = nullptr) {
    const int k0 = 64 * kb; float smp = 0.f; if (F8) smp = fabsf(W[lane]); const int cs = col0 + (lane & 31) + ((lane & 16) ? gap16 : 0);
    float v[32];
#pragma unroll
    for (int i = 0; i < 32; ++i) v[i] = W[(size_t)(k0 + 2 * i + (lane >> 5)) * ldw + cs];
#pragma unroll
    for (int i = 0; i < 32; ++i) scr[(2 * i + (lane >> 5)) * 33 + (lane & 31)] = v[i];
    asm volatile("s_waitcnt lgkmcnt(0)" ::: "memory");
    const int c = lane & 7;
    if constexpr (F8) {
        const float m = fmaxf(wave_max(smp), 1.0e-30f), sc = __uint_as_float(__float_as_uint(16.0f * rcpf_(m)) & 0x7f800000u);
#pragma unroll
        for (int j = 0; j < 4; ++j) { const int n = (lane >> 3) + 8 * j; const LAS float* s = scr + (8 * c) * 33 + n;
            u32x2 o; o.x = pk4_f8(s[0 * 33] * sc, s[1 * 33] * sc, s[2 * 33] * sc, s[3 * 33] * sc); o.y = pk4_f8(s[4 * 33] * sc, s[5 * 33] * sc, s[6 * 33] * sc, s[7 * 33] * sc);
            *(u32x2*)((unsigned char*)WT + (size_t)(drow0 + n) * (2 * K) + k0 + 8 * c) = o;
            if (kb == 0 && c == 0) cmax[drow0 + n] = __float_as_uint(448.0f * rcpf_(sc)); }
        asm volatile("s_waitcnt lgkmcnt(0)" ::: "memory");
        return; }
#pragma unroll
    for (int j = 0; j < 4; ++j) { const int n = (lane >> 3) + 8 * j; const LAS float* s = scr + (8 * c) * 33 + n;
        u32x4 o; o.x = pk2(s[0 * 33], s[1 * 33]); o.y = pk2(s[2 * 33], s[3 * 33]); o.z = pk2(s[4 * 33], s[5 * 33]); o.w = pk2(s[6 * 33], s[7 * 33]);
        *(u32x4*)(WT + (size_t)(drow0 + n) * K + k0 + 8 * c) = o;
        if (cmax) {
            float am = fmaxf(fmaxf(fmaxf(fabsf(bflo(o.x)), fabsf(bfhi(o.x))), fmaxf(fabsf(bflo(o.y)), fabsf(bfhi(o.y)))), fmaxf(fmaxf(fabsf(bflo(o.z)), fabsf(bfhi(o.z))), fmaxf(fabsf(bflo(o.w)), fabsf(bfhi(o.w)))));
            am = fmaxf(am, swz_xor<1>(am)); am = fmaxf(am, swz_xor<2>(am)); am = fmaxf(am, swz_xor<4>(am));
            if (c == 0) atomicMax(cmax + drow0 + n, __float_as_uint(am)); } }
    asm volatile("s_waitcnt lgkmcnt(0)" ::: "memory");
}
__device__ __forceinline__ void up_item(const float* wg, const float* wu, bf16_t* WT, int it, LAS float* scr, int lane, unsigned* cmax) {
    const int nb = it >> 4, kb = it & 15, r0 = 32 * nb, pn = r0 >> 8, p = r0 & 255;
    transpose_item(p < 128 ? wg : wu, DFF, 128 * pn + (p & 127), DM, WT, r0, kb, scr, lane, 0, cmax);
}
__device__ __forceinline__ void dn_item(const float* wd, bf16_t* WT, int it, LAS float* scr, int lane, unsigned* cmax) {
    const int nb = it & 31, kb = it >> 5;
    transpose_item<true>(wd, DM, 32 * nb, DFF, WT, 32 * nb, kb, scr, lane, 0, cmax);
}
constexpr int IT_IN = 112 * 16, IT_OUT = 32 * 16, IT_UP = 176 * 16, IT_DN = 32 * 44;
constexpr int IT_TOTAL = 2 * IT_IN + 2 * IT_OUT + IT_UP + IT_DN + NEXP * (IT_UP + IT_DN);

__device__ __forceinline__ void convert_flat_item(const Args& a, unsigned char* ws, int it, LAS float* scr, int lane) {
    if (it < 2 * IT_IN) { const int l = it / IT_IN; it -= l * IT_IN; const int nb = it >> 4, kb = it & 15, r0 = 32 * nb;
        const int pn = r0 >> 8, p = r0 & 255; const bool hl = pn < 2 || (pn >= 8 && pn < 12);
        const int cbase = (pn < 8 ? 256 * pn : 256 * pn + 16);
        const int col0 = hl ? cbase + 64 * ((p >> 5) & 3) + 16 * (p >> 7) : cbase + p;
        transpose_item(a.in[8] + (size_t)l * DM * DIN, DIN, col0, DM, (bf16_t*)(ws + WS_WTIN) + (size_t)l * NPW * DM, r0, kb, scr, lane, hl ? 16 : 0, (unsigned*)(ws + WS_CTL) + CW_COLMAX + l * NPW); return; }
    it -= 2 * IT_IN;
    if (it < 2 * IT_OUT) { const int l = it / IT_OUT; it -= l * IT_OUT; const int nb = it >> 4, kb = it & 15;
        transpose_item<true>(a.in[16] + (size_t)l * DM * DM, DM, 32 * nb, DM, (bf16_t*)(ws + WS_WTOUT) + (size_t)l * DM * DM, 32 * nb, kb, scr, lane, 0, (unsigned*)(ws + WS_CTL) + CW_COLMAX_OUT + l * DM); return; }
    it -= 2 * IT_OUT;
    if (it < IT_UP) { up_item(a.in[17], a.in[18], (bf16_t*)(ws + WS_WTUP), it, scr, lane, (unsigned*)(ws + WS_CTL) + CW_COLMAX + 2 * NPW); return; }
    it -= IT_UP;
    if (it < IT_DN) { dn_item(a.in[19], (bf16_t*)(ws + WS_WTDN), it, scr, lane, (unsigned*)(ws + WS_CTL) + CW_COLMAX_DN); return; }
    it -= IT_DN;
    if (it < NEXP * IT_UP) { const int e = it / IT_UP; it -= e * IT_UP;
        up_item(a.in[21] + (size_t)e * DM * DFF, a.in[22] + (size_t)e * DM * DFF, (bf16_t*)(ws + WS_WTMUP) + (size_t)e * NUP * DM, it, scr, lane, (unsigned*)(ws + WS_CTL) + CW_COLMAX + 2 * NPW + NUP + e * NUP); return; }
    it -= NEXP * IT_UP;
    { const int e = it / IT_DN; it -= e * IT_DN; dn_item(a.in[23] + (size_t)e * DFF * DM, (bf16_t*)(ws + WS_WTMDN) + (size_t)e * DM * DFF, it, scr, lane, (unsigned*)(ws + WS_CTL) + CW_COLMAX_DN + DM + e * DM); }
}
constexpr int N_EARLY = IT_IN + IT_OUT + IT_UP + IT_DN, N_DEFER = IT_TOTAL - N_EARLY, N_DEFER_L1 = IT_IN + IT_OUT;
__device__ __forceinline__ int early_to_flat(int i) { if (i < IT_IN) return i; i -= IT_IN; if (i < IT_OUT) return 2 * IT_IN + i; return 2 * IT_IN + 2 * IT_OUT + (i - IT_OUT); }
__device__ __forceinline__ int defer_to_flat(int d) { if (d < IT_IN) return IT_IN + d; d -= IT_IN; if (d < IT_OUT) return 2 * IT_IN + IT_OUT + d; return 2 * IT_IN + 2 * IT_OUT + IT_UP + IT_DN + (d - IT_OUT); }
#ifndef CVNB
#define CVNB 0
#endif
constexpr int N_MOE_ITEMS = NEXP * (IT_UP + IT_DN), CV_FIRST = NEXP * IT_UP;
constexpr int CV_HIDDEN_ = 2 * 128 * 8 * CVNB, CV_HIDDEN = CV_HIDDEN_ < NEXP * IT_DN ? CV_HIDDEN_ : NEXP * IT_DN;
__device__ __forceinline__ void convert_window(const Args& a, LAS unsigned char* lds, int lane, int wave, int G, int ph, int rank) {
    if (G != 256) return;
    unsigned char* ws = a.ws; LAS float* scr = (LAS float*)(lds + 65536 + wave * 8704);
    for (int j = 0; j < CVNB; ++j) { const int m = ((ph * 128 + rank) * NWAVES + wave) * CVNB + j; if (m < CV_HIDDEN) convert_flat_item(a, ws, defer_to_flat(N_DEFER_L1 + CV_FIRST + m), scr, lane); }
}
__device__ __forceinline__ unsigned pack_i8x4(float a, float b, float c, float d) {
    const unsigned fa = __float_as_uint(a + 12582912.0f), fb = __float_as_uint(b + 12582912.0f), fc = __float_as_uint(c + 12582912.0f), fd = __float_as_uint(d + 12582912.0f);
    return __builtin_amdgcn_perm(fb, fa, 0x0c0c0400u) | __builtin_amdgcn_perm(fd, fc, 0x04000c0cu);
}
struct QStrip { const float* src; int ldw; unsigned char* dst; int qrow0; };
__device__ __forceinline__ QStrip quant_strip_decode(const Args& a, unsigned char* ws, int tid, int st) {
    const float* W; int ldw, col0, gap = 0; unsigned char* dst;
    if (st < 2 * (NPW / 32)) { const int l = st / (NPW / 32), r0 = 32 * (st - l * (NPW / 32)); const int pn = r0 >> 8, p = r0 & 255; const bool hl = pn < 2 || (pn >= 8 && pn < 12);
        const int cbase = (pn < 8 ? 256 * pn : 256 * pn + 16);
        W = a.in[8] + (size_t)l * DM * DIN; ldw = DIN; col0 = hl ? cbase + 64 * ((p >> 5) & 3) + 16 * (p >> 7) : cbase + p; gap = hl ? 16 : 0; dst = ws + WS_WTIN + (size_t)(l * NPW + r0) * 2048; }
    else { int s2 = st - 2 * (NPW / 32); const float* wg; const float* wu; unsigned char* base;
        if (s2 < NUP / 32) { wg = a.in[17]; wu = a.in[18]; base = ws + WS_WTUP; }
        else { s2 -= NUP / 32; const int e = s2 / (NUP / 32); s2 -= e * (NUP / 32); wg = a.in[21] + (size_t)e * DM * DFF; wu = a.in[22] + (size_t)e * DM * DFF; base = ws + WS_WTMUP + (size_t)e * NUP * 2048; }
        const int r0 = 32 * s2, pn = r0 >> 8, p = r0 & 255; W = p < 128 ? wg : wu; ldw = DFF; col0 = 128 * pn + (p & 127); dst = base + (size_t)r0 * 2048; }
    const int kk = tid >> 3, c4 = (tid & 7) * 4;
    QStrip q; q.src = W + col0 + c4 + (c4 >= 16 ? gap : 0) + (size_t)kk * ldw; q.ldw = ldw; q.dst = dst; q.qrow0 = 32 * st; return q;
}
__device__ __forceinline__ void quant_strip_load(const QStrip& q, f32x4 (&v)[16]) {
#pragma unroll
    for (int i = 0; i < 16; ++i) v[i] = *(const f32x4*)(q.src + (size_t)(64 * i) * q.ldw);
}
__device__ __forceinline__ void quant_strips(const Args& a, unsigned char* ws, LAS unsigned char* lds, int tid, int bid, int G) {
    LAS float* tile = (LAS float*)lds; LAS float* red = (LAS float*)(lds + 1024 * 33 * 4);
    const int nst = (G == 256) ? QS_NPRO : N_QROWS / 32; int st = (G == 256) ? (bid & 7) * 32 + (bid >> 3) : bid; if (st >= nst) return;
    QStrip cur = quant_strip_decode(a, ws, tid, st); f32x4 v[16]; quant_strip_load(cur, v);
    for (;;) {
        __syncthreads();
        { const int kk = tid >> 3, c4 = (tid & 7) * 4;
#pragma unroll
          for (int i = 0; i < 16; ++i) { LAS float* tp = tile + (kk + 64 * i) * 33 + c4; tp[0] = v[i].x; tp[1] = v[i].y; tp[2] = v[i].z; tp[3] = v[i].w; } }
        __syncthreads();
        const int stn = st + G; const bool more = stn < nst; QStrip nxt = cur;
        if (more) { nxt = quant_strip_decode(a, ws, tid, stn); quant_strip_load(nxt, v); }
        const int n = tid & 31, ks = (tid >> 5) * 64;
        { unsigned amu = 0u;
          const LAS unsigned* tu = (const LAS unsigned*)tile + ks * 33 + n;
#pragma unroll 16
          for (int i = 0; i < 64; ++i) { const unsigned u = tu[i * 33] & 0x7fffffffu; amu = u > amu ? u : amu; }
          red[(tid >> 5) * 32 + n] = __uint_as_float(amu); }
        __syncthreads();
        if (tid < 32) { float am = 0.f;
#pragma unroll
            for (int g = 0; g < 16; ++g) am = fmaxf(am, red[g * 32 + tid]);
            red[512 + tid] = am; ((unsigned*)(ws + WS_CTL) + CW_COLMAX)[cur.qrow0 + tid] = __float_as_uint(am); }
        __syncthreads();
        { const float am = red[512 + n]; const float inv = am > 0.f ? 127.0f / am : 0.f;
          unsigned char* op = cur.dst + (size_t)n * 2048 + ks;
#pragma unroll
          for (int q = 0; q < 4; ++q) { u32x4 o;
              o.x = pack_i8x4(tile[(ks + 16 * q + 0) * 33 + n] * inv, tile[(ks + 16 * q + 1) * 33 + n] * inv, tile[(ks + 16 * q + 2) * 33 + n] * inv, tile[(ks + 16 * q + 3) * 33 + n] * inv);
              o.y = pack_i8x4(tile[(ks + 16 * q + 4) * 33 + n] * inv, tile[(ks + 16 * q + 5) * 33 + n] * inv, tile[(ks + 16 * q + 6) * 33 + n] * inv, tile[(ks + 16 * q + 7) * 33 + n] * inv);
              o.z = pack_i8x4(tile[(ks + 16 * q + 8) * 33 + n] * inv, tile[(ks + 16 * q + 9) * 33 + n] * inv, tile[(ks + 16 * q + 10) * 33 + n] * inv, tile[(ks + 16 * q + 11) * 33 + n] * inv);
              o.w = pack_i8x4(tile[(ks + 16 * q + 12) * 33 + n] * inv, tile[(ks + 16 * q + 13) * 33 + n] * inv, tile[(ks + 16 * q + 14) * 33 + n] * inv, tile[(ks + 16 * q + 15) * 33 + n] * inv);
              *(u32x4*)(op + 16 * q) = o; } }
        if (!more) break;
        st = stn; cur = nxt;
    }
}
__device__ __forceinline__ void quant_strips_dyn(const Args& a, unsigned char* ws, LAS unsigned char* lds, int tid, int budget) {
    LAS float* tile = (LAS float*)lds; LAS float* red = (LAS float*)(lds + 1024 * 33 * 4);
    volatile LAS unsigned* MISCW = (volatile LAS unsigned*)(lds + MISC_OFF);
    constexpr int nst = N_QROWS / 32;
    for (int done = 0; done < budget; done += 2) {
        const int grab = budget - done < 2 ? budget - done : 2;
        __syncthreads();
        if (tid == 0) MISCW[13] = __hip_atomic_fetch_add((unsigned*)(ws + WS_CTL) + CW_STRIPCTR, (unsigned)grab, __ATOMIC_RELAXED, __HIP_MEMORY_SCOPE_AGENT);
        __syncthreads();
        const int s0 = QS_NPRO + (int)MISCW[13]; if (s0 >= nst) break;
        const int ns = nst - s0 < grab ? nst - s0 : grab;
        QStrip cur = quant_strip_decode(a, ws, tid, s0); f32x4 v[16]; quant_strip_load(cur, v);
        for (int k = 0; k < ns; ++k) {
            if (k) __syncthreads();
            { const int kk = tid >> 3, c4 = (tid & 7) * 4;
#pragma unroll
              for (int i = 0; i < 16; ++i) { LAS float* tp = tile + (kk + 64 * i) * 33 + c4; tp[0] = v[i].x; tp[1] = v[i].y; tp[2] = v[i].z; tp[3] = v[i].w; } }
            __syncthreads();
            QStrip nxt = cur; if (k + 1 < ns) { nxt = quant_strip_decode(a, ws, tid, s0 + k + 1); quant_strip_load(nxt, v); }
            const int n = tid & 31, ks = (tid >> 5) * 64;
            { unsigned amu = 0u; const LAS unsigned* tu = (const LAS unsigned*)tile + ks * 33 + n;
#pragma unroll 16
              for (int i = 0; i < 64; ++i) { const unsigned u = tu[i * 33] & 0x7fffffffu; amu = u > amu ? u : amu; }
              red[(tid >> 5) * 32 + n] = __uint_as_float(amu); }
            __syncthreads();
            if (tid < 32) { float am = 0.f;
#pragma unroll
                for (int g = 0; g < 16; ++g) am = fmaxf(am, red[g * 32 + tid]);
                red[512 + tid] = am; ((unsigned*)(ws + WS_CTL) + CW_COLMAX)[cur.qrow0 + tid] = __float_as_uint(am); }
            __syncthreads();
            { const float am = red[512 + n]; const float inv = am > 0.f ? 127.0f / am : 0.f;
              unsigned char* op = cur.dst + (size_t)n * 2048 + ks;
#pragma unroll
              for (int qq = 0; qq < 4; ++qq) { u32x4 o;
                  o.x = pack_i8x4(tile[(ks + 16 * qq + 0) * 33 + n] * inv, tile[(ks + 16 * qq + 1) * 33 + n] * inv, tile[(ks + 16 * qq + 2) * 33 + n] * inv, tile[(ks + 16 * qq + 3) * 33 + n] * inv);
                  o.y = pack_i8x4(tile[(ks + 16 * qq + 4) * 33 + n] * inv, tile[(ks + 16 * qq + 5) * 33 + n] * inv, tile[(ks + 16 * qq + 6) * 33 + n] * inv, tile[(ks + 16 * qq + 7) * 33 + n] * inv);
                  o.z = pack_i8x4(tile[(ks + 16 * qq + 8) * 33 + n] * inv, tile[(ks + 16 * qq + 9) * 33 + n] * inv, tile[(ks + 16 * qq + 10) * 33 + n] * inv, tile[(ks + 16 * qq + 11) * 33 + n] * inv);
                  o.w = pack_i8x4(tile[(ks + 16 * qq + 12) * 33 + n] * inv, tile[(ks + 16 * qq + 13) * 33 + n] * inv, tile[(ks + 16 * qq + 14) * 33 + n] * inv, tile[(ks + 16 * qq + 15) * 33 + n] * inv);
                  *(u32x4*)(op + 16 * qq) = o; } }
            cur = nxt;
        }
    }
    __syncthreads();
}
template <class Sched>
__device__ __forceinline__ void idle_strips(const Sched& S, const Args& a, LAS unsigned char* lds, int tid, int budget) {
    if (S.G != 256) return;
    const int nfr = S.nwg / S.G; pg8::Unit u; if (S.nwg % S.G == 0 || S.next(nfr, u)) return;
    quant_strips_dyn(a, a.ws, lds, tid, budget);
}
__device__ __forceinline__ void phase_prologue(const Args& a, LAS unsigned char* lds, int tid, int lane, int wave, int bid, int G) {
    unsigned char* ws = a.ws;
    quant_strips(a, ws, lds, tid, bid, G);
    __syncthreads();
    {
        LAS float* scr = (LAS float*)(lds + wave * 8704);
        const int gw = bid * NWAVES + wave, NGW = G * NWAVES;
        const int hid = (G == 256) ? CV_HIDDEN : 0, npro = N_EARLY + N_DEFER - hid;
        constexpr int NB16 = 2 * IT_OUT + IT_DN + NEXP * IT_DN;
        constexpr int NB16H = 16 * NWAVES * 5;
        const bool rb = false, heavy = rb && (bid & 7) == 0 && bid < 128; const int rank = bid - min((bid + 7) >> 3, 16);
        const int i0 = !rb ? gw : heavy ? NB16 - NB16H + (bid >> 3) * NWAVES + wave : rank * NWAVES + wave, istep = !rb ? NGW : heavy ? 16 * NWAVES : 240 * NWAVES, iend = (rb && !heavy) ? NB16 - NB16H : NB16;
        for (int i = i0; i < iend; i += istep) { int it = i;
            if (it < 2 * IT_OUT) { convert_flat_item(a, ws, 2 * IT_IN + it, scr, lane); continue; } it -= 2 * IT_OUT;
            if (it < IT_DN) { convert_flat_item(a, ws, 2 * IT_IN + 2 * IT_OUT + IT_UP + it, scr, lane); continue; } it -= IT_DN;
            convert_flat_item(a, ws, 2 * IT_IN + 2 * IT_OUT + IT_UP + IT_DN + NEXP * IT_UP + it, scr, lane); }
        (void)hid; (void)npro;
    }
    __syncthreads();
    {
        const int gt = (G * 4 >= 1024) ? (tid < 4 && bid < 256 ? bid * 4 + tid : 1024) : bid * NTHR + tid;
        if (gt < 1024) { const int pos = gt >> 4, i = gt & 15;
            double inv = 1.0; for (int q = 0; q < i; ++q) inv *= 0.56234132519034908;
            const float angf = (float)pos * (float)inv; const double ang = (double)angf;
            const double kq = rint(ang * 0.63661977236758134); const double r = ang - kq * 1.5707963267948966 - kq * 6.123233995736766e-17; const double r2 = r * r;
            double sn = r * (1.0 + r2 * (-1.0 / 6 + r2 * (1.0 / 120 + r2 * (-1.0 / 5040 + r2 * (1.0 / 362880 + r2 * (-1.0 / 39916800 + r2 * (1.0 / 6227020800.0)))))));
            double cs = 1.0 + r2 * (-0.5 + r2 * (1.0 / 24 + r2 * (-1.0 / 720 + r2 * (1.0 / 40320 + r2 * (-1.0 / 3628800 + r2 * (1.0 / 479001600.0 + r2 * (-1.0 / 87178291200.0)))))));
            const int kk = ((int)kq) & 3; double c2, s2;
            if (kk == 0) { c2 = cs; s2 = sn; } else if (kk == 1) { c2 = -sn; s2 = cs; } else if (kk == 2) { c2 = -cs; s2 = -sn; } else { c2 = sn; s2 = -cs; }
            float* R = (float*)(ws + WS_ROPE); R[gt * 2] = (float)c2; R[gt * 2 + 1] = (float)s2; }
    }
    {
        LAS float* sc = (LAS float*)(lds + 73728);
        LAS float* red = (LAS float*)(lds + 73728 + 36864);
        { float cv[18];
#pragma unroll
          for (int q = 0; q < 18; ++q) { const int i = tid + NTHR * q; cv[q] = *(i < 8192 ? a.in[1] + i : a.in[3] + (i - 8192)); }
#pragma unroll
          for (int q = 0; q < 18; ++q) { const float v = cv[q]; sc[tid + NTHR * q] = v / (1.0f + __expf(-v)); } }
        __syncthreads();
        int item0 = bid; if (false) { const bool heavy = (bid & 7) == 0 && bid < 128; const int rank = bid - min((bid + 7) >> 3, 16); item0 = heavy ? 192 : (rank + 48) % 240; }
        for (int item = item0; item < 192; item += G) {
            const int l = item / 96, n0 = (item % 96) * 64;
            const int kr = lane >> 4, c4 = 4 * (lane & 15);
            const float* wm = a.in[6] + (size_t)l * DM * 6144 + n0 + c4 + (size_t)(wave * 128 + kr) * 6144;
            f32x4 acc[9];
#pragma unroll
            for (int b = 0; b < 9; ++b) acc[b] = (f32x4){0.f, 0.f, 0.f, 0.f};
#pragma unroll 1
            for (int jb = 0; jb < 32; jb += 16) { f32x4 wv[16];
                const float* wp = wm + (size_t)(4 * jb) * 6144;
#pragma unroll
                for (int j = 0; j < 16; ++j) { wv[j] = *(const f32x4*)wp; wp += 4 * 6144; }
#pragma unroll
                for (int j = 0; j < 16; ++j) { const int k = wave * 128 + 4 * (jb + j) + kr;
#pragma unroll
                    for (int b = 0; b < 9; ++b) acc[b] += wv[j] * sc[b * 1024 + k]; } }
#pragma unroll
            for (int b = 0; b < 9; ++b) {
#pragma unroll
                for (int c = 0; c < 4; ++c) acc[b][c] = sum_g4(acc[b][c]);
                if (kr == 0) *(LAS f32x4*)(red + (wave * 9 + b) * 64 + c4) = acc[b]; }
            __syncthreads();
            for (int o = tid; o < 576; o += NTHR) { const int b = o >> 6, ln = o & 63; float s = a.in[7][(size_t)l * 6144 + n0 + ln];
#pragma unroll
                for (int w = 0; w < 8; ++w) s += red[(w * 9 + b) * 64 + ln];
                ((float*)(ws + WS_MOD))[((size_t)l * 9 + b) * 6144 + n0 + ln] = s; }
            __syncthreads();
        }
    }
}


__device__ __forceinline__ unsigned pack_i8x4c(float a, float b, float c, float d) {
    const int ia = max(-127, min(127, __float2int_rn(a))), ib = max(-127, min(127, __float2int_rn(b))), ic = max(-127, min(127, __float2int_rn(c))), id = max(-127, min(127, __float2int_rn(d)));
    return (unsigned)(ia & 0xff) | ((unsigned)(ib & 0xff) << 8) | ((unsigned)(ic & 0xff) << 16) | ((unsigned)(id & 0xff) << 24);
}
typedef unsigned short u16x2_t __attribute__((ext_vector_type(2)));
template <bool ROWMAX>
__device__ __forceinline__ void quant_row_2816(unsigned char* rowp, float am, int lane, unsigned* amax_out = nullptr) {
    u32x2 v[11];
#pragma unroll
    for (int i = 0; i < 11; ++i) v[i] = *(const u32x2*)(rowp + (size_t)(i * 64 + lane) * 8);
    if (ROWMAX) {
        u16x2_t mb = {0, 0};
#pragma unroll
        for (int i = 0; i < 11; ++i) { const unsigned ax = v[i].x & 0x7fff7fffu, ay = v[i].y & 0x7fff7fffu; u16x2_t px, py; __builtin_memcpy(&px, &ax, 4); __builtin_memcpy(&py, &ay, 4);
            mb = __builtin_elementwise_max(mb, __builtin_elementwise_max(px, py)); }
        const unsigned m16 = mb[0] > mb[1] ? mb[0] : mb[1];
        am = wave_max(__uint_as_float(m16 << 16)); if (lane == 0) *amax_out = __float_as_uint(am); }
    const float inv = am > 0.f ? 127.0f / am : 0.f;
    unsigned o[11];
#pragma unroll
    for (int i = 0; i < 11; ++i) { const unsigned f0 = __float_as_uint(__builtin_fmaf(bflo(v[i].x), inv, 12582912.0f)), f1 = __float_as_uint(__builtin_fmaf(bfhi(v[i].x), inv, 12582912.0f));
        const unsigned f2 = __float_as_uint(__builtin_fmaf(bflo(v[i].y), inv, 12582912.0f)), f3 = __float_as_uint(__builtin_fmaf(bfhi(v[i].y), inv, 12582912.0f));
        o[i] = __builtin_amdgcn_perm(f1, f0, 0x0c0c0400u) | __builtin_amdgcn_perm(f3, f2, 0x04000c0cu); }
    asm volatile("" : "+v"(o[0]), "+v"(o[1]), "+v"(o[2]), "+v"(o[3]), "+v"(o[4]), "+v"(o[5]), "+v"(o[6]), "+v"(o[7]), "+v"(o[8]), "+v"(o[9]), "+v"(o[10]) :: "memory");
#pragma unroll
    for (int i = 0; i < 11; ++i) *(unsigned*)(rowp + (size_t)(i * 64 + lane) * 4) = o[i];
}
__device__ __forceinline__ void f8_row_2816(unsigned char* rowp, float am, int lane) {
    u32x2 v[11];
#pragma unroll
    for (int i = 0; i < 11; ++i) v[i] = *(const u32x2*)(rowp + (size_t)(i * 64 + lane) * 8);
    const float inv = am > 0.f ? 448.0f / am : 0.f;
    unsigned o[11];
#pragma unroll
    for (int i = 0; i < 11; ++i) { int w = __builtin_amdgcn_cvt_pk_fp8_f32(__builtin_amdgcn_fmed3f(bflo(v[i].x) * inv, -448.0f, 448.0f), __builtin_amdgcn_fmed3f(bfhi(v[i].x) * inv, -448.0f, 448.0f), 0, false);
        w = __builtin_amdgcn_cvt_pk_fp8_f32(__builtin_amdgcn_fmed3f(bflo(v[i].y) * inv, -448.0f, 448.0f), __builtin_amdgcn_fmed3f(bfhi(v[i].y) * inv, -448.0f, 448.0f), w, true); o[i] = (unsigned)w; }
    asm volatile("" : "+v"(o[0]), "+v"(o[1]), "+v"(o[2]), "+v"(o[3]), "+v"(o[4]), "+v"(o[5]), "+v"(o[6]), "+v"(o[7]), "+v"(o[8]), "+v"(o[9]), "+v"(o[10]) :: "memory");
#pragma unroll
    for (int i = 0; i < 11; ++i) *(unsigned*)(rowp + (size_t)(i * 64 + lane) * 4) = o[i];
}
__device__ __forceinline__ void f8_row_1024(unsigned char* rowp, float am, int lane) {
    u32x2 v[4];
#pragma unroll
    for (int i = 0; i < 4; ++i) v[i] = *(const u32x2*)(rowp + (size_t)(i * 64 + lane) * 8);
    const float inv = am > 0.f ? 448.0f / am : 0.f;
    unsigned o[4];
#pragma unroll
    for (int i = 0; i < 4; ++i) o[i] = pk4_f8(bflo(v[i].x) * inv, bfhi(v[i].x) * inv, bflo(v[i].y) * inv, bfhi(v[i].y) * inv);
    asm volatile("" : "+v"(o[0]), "+v"(o[1]), "+v"(o[2]), "+v"(o[3]) :: "memory");
#pragma unroll
    for (int i = 0; i < 4; ++i) *(unsigned*)(rowp + (size_t)(i * 64 + lane) * 4) = o[i];
}
__device__ __forceinline__ void phase_quant_wout(unsigned char* ws, int lane, int gw, int ngw) {
    for (int w = gw; w < 2 * DM; w += ngw) f8_row_1024(ws + WS_WTOUT + (size_t)w * (DM * 2), __uint_as_float(__hip_atomic_load((const unsigned*)(ws + WS_CTL) + CW_COLMAX_OUT + w, __ATOMIC_RELAXED, __HIP_MEMORY_SCOPE_AGENT)), lane);
}
__device__ __forceinline__ void phase_quant_down(unsigned char* ws, unsigned char* act, int nrows_act, unsigned* rmax, unsigned char* wdn, int nrows_w, const unsigned* cmax, int lane, int gw, int ngw) {
    (void)act; (void)nrows_act; (void)rmax;
    for (int w = gw; w < nrows_w; w += ngw) f8_row_2816(wdn + (size_t)w * (DFF * 2), __uint_as_float(__hip_atomic_load(cmax + w, __ATOMIC_RELAXED, __HIP_MEMORY_SCOPE_AGENT)), lane);
}

typedef short bf16x8 __attribute__((ext_vector_type(8)));
typedef short s16x4 __attribute__((ext_vector_type(4)));
constexpr int IST = 160;
__device__ __forceinline__ f32x4 mfma16(bf16x8 a, bf16x8 b, f32x4 c) { return __builtin_amdgcn_mfma_f32_16x16x32_bf16(a, b, c, 0, 0, 0); }
__device__ __forceinline__ bf16x8 frag_row(LAS const unsigned char* img, int row0, int k0, int lane) {
    return *(const LAS bf16x8*)(img + (row0 + (lane & 15)) * IST + (k0 + 8 * (lane >> 4)) * 2);
}
template <bool PERMK>
__device__ __forceinline__ bf16x8 frag_tr(LAS const unsigned char* img, int r0, int c0, int lane) {
    const int g = lane >> 4, i = lane & 15, q = i >> 2, p = i & 3;
    LAS unsigned char* ap = (LAS unsigned char*)img + (r0 + (PERMK ? 4 : 8) * g + q) * IST + (c0 + 4 * p) * 2;
    const s16x4 lo = __builtin_amdgcn_ds_read_tr16_b64_v4i16((LAS s16x4*)ap), hi = __builtin_amdgcn_ds_read_tr16_b64_v4i16((LAS s16x4*)(ap + (PERMK ? 2560 : 640)));
    bf16x8 r; r[0] = lo[0]; r[1] = lo[1]; r[2] = lo[2]; r[3] = lo[3]; r[4] = hi[0]; r[5] = hi[1]; r[6] = hi[2]; r[7] = hi[3];
    return r;
}
template <bool PERMK>
__device__ __forceinline__ void frag_tr_x4(LAS const unsigned char* img, int r0, int c0, int lane, bf16x8 (&out)[4]) {
    const int g = lane >> 4, i = lane & 15, q = i >> 2, p = i & 3;
    LAS unsigned char* ap = (LAS unsigned char*)img + (r0 + (PERMK ? 4 : 8) * g + q) * IST + (c0 + 4 * p) * 2;
#pragma unroll
    for (int t = 0; t < 4; ++t) { const s16x4 lo = __builtin_amdgcn_ds_read_tr16_b64_v4i16((LAS s16x4*)(ap + 32 * t)), hi = __builtin_amdgcn_ds_read_tr16_b64_v4i16((LAS s16x4*)(ap + 32 * t + (PERMK ? 2560 : 640)));
        out[t][0] = lo[0]; out[t][1] = lo[1]; out[t][2] = lo[2]; out[t][3] = lo[3]; out[t][4] = hi[0]; out[t][5] = hi[1]; out[t][6] = hi[2]; out[t][7] = hi[3]; }
}
__device__ __forceinline__ bf16x8 pack8(f32x4 a, f32x4 b) {
    union { u32x4 u; bf16x8 v; } x; x.u.x = pk2(a[0], a[1]); x.u.y = pk2(a[2], a[3]); x.u.z = pk2(b[0], b[1]); x.u.w = pk2(b[2], b[3]); return x.v;
}

__device__ __forceinline__ void phase_norm1(const Args& a, int l, LAS unsigned char* lds, int tid, int lane, int wave, int bid, int G) {
    unsigned char* ws = a.ws;
    constexpr int RST = 2064;
    LAS unsigned char* WgT = lds; LAS unsigned char* Himg = lds + 16 * RST; LAS float* red = (LAS float*)(lds + 32 * RST);
    { const float* w = a.in[8] + (size_t)l * DM * DIN + 2048;
      f32x4 wv[8];
#pragma unroll
      for (int q = 0; q < 8; ++q) { const int idx = tid + NTHR * q; wv[q] = *(const f32x4*)(w + (size_t)(idx >> 2) * DIN + 4 * (idx & 3)); }
#pragma unroll
      for (int q = 0; q < 8; ++q) { const int idx = tid + NTHR * q, k = idx >> 2, j4 = 4 * (idx & 3);
#pragma unroll
          for (int c = 0; c < 4; ++c) *(LAS bf16_t*)(WgT + (j4 + c) * RST + k * 2) = (bf16_t)f2bf(wv[q][c]); } }
    __syncthreads();
    const float* gam = a.in[4] + (size_t)l * DM;
    const float* mod = (const float*)(ws + WS_MOD) + (size_t)l * 9 * 6144;
    unsigned char* H8 = ws + WS_H;
    const bool remap = (G == 256);
    const int nsteps = remap ? 5 : (bid < MALL / 16 ? (MALL / 16 - bid + G - 1) / G : 0);
    f32x4 gs[1][4], shv[1][4]; int cbi = -1;
    for (int kq = 0; kq < nsteps; ++kq) { const bool halfg = remap && kq == 4;
        const int gi = !remap ? bid + kq * G : (kq < 4 ? (bid >> 5) * 128 + (bid & 31) + 32 * kq : NLAT / 16 + (bid >> 1));
#pragma unroll
        for (int rr = 0; rr < 2; ++rr) { if (halfg && rr == 1) break;
            const int trow = halfg ? wave : 2 * wave + rr;
            const int r = halfg ? NLAT + 8 * bid + wave : 16 * gi + 2 * wave + rr; const bool lat = r < NLAT; const int bi = lat ? (r >> 11) : 8;
            f32x4 v[4]; float ss = 0.f;
            if (l == 0) { const float* src = lat ? a.in[0] + (size_t)r * DM : a.in[2] + (size_t)(r - NLAT) * DM;
#pragma unroll
                for (int j = 0; j < 4; ++j) v[j] = *(const f32x4*)(src + 4 * lane + 256 * j); }
            else { const bf16_t* src = lat ? (const bf16_t*)(ws + WS_SB) + (size_t)r * DM : (const bf16_t*)(ws + WS_XC) + (size_t)(r - NLAT) * DM;
#pragma unroll
                for (int j = 0; j < 4; ++j) { const u32x2 w = *(const u32x2*)(src + 4 * lane + 256 * j); v[j] = (f32x4){bflo(w.x), bfhi(w.x), bflo(w.y), bfhi(w.y)}; } }
#pragma unroll
            for (int j = 0; j < 4; ++j) ss += (v[j].x * v[j].x + v[j].y * v[j].y) + (v[j].z * v[j].z + v[j].w * v[j].w);
            const float rstd = rsqrtf(wave_sum(ss) * (1.0f / DM) + EPS);
            if (rr == 0 && bi != cbi) { cbi = bi; const float* mrow = mod + (size_t)bi * 6144;
#pragma unroll
                for (int j = 0; j < 4; ++j) { const int k = 4 * lane + 256 * j; gs[0][j] = *(const f32x4*)(gam + k) * (1.0f + *(const f32x4*)(mrow + 1024 + k)); shv[0][j] = *(const f32x4*)(mrow + k); } }
#pragma unroll
            for (int j = 0; j < 4; ++j) { const int k = 4 * lane + 256 * j;
                const f32x4 hv = v[j] * rstd * gs[0][j] + shv[0][j]; v[j] = hv;
                u32x2 w; w.x = pk2(hv.x, hv.y); w.y = pk2(hv.z, hv.w);
                *(LAS u32x2*)(Himg + trow * RST + k * 2) = w; }
            float am = 0.f;
#pragma unroll
            for (int j = 0; j < 4; ++j) am = fmaxf(am, fmaxf(fmaxf(fabsf(v[j].x), fabsf(v[j].y)), fmaxf(fabsf(v[j].z), fabsf(v[j].w))));
            am = wave_max(am); const float qs = am > 0.f ? 127.0f / am : 0.f;
#pragma unroll
            for (int j = 0; j < 4; ++j) *(unsigned*)(H8 + (size_t)r * DM + 4 * lane + 256 * j) = pack_i8x4(v[j].x * qs, v[j].y * qs, v[j].z * qs, v[j].w * qs);
            if (lane == 0) ((float*)(ws + WS_HS))[r] = am * (1.0f / 127.0f);
        }
        __syncthreads();
        f32x4 acc = {0.f, 0.f, 0.f, 0.f};
#pragma unroll
        for (int ks = 0; ks < 4; ++ks) { const int off = (lane & 15) * RST + (128 * wave + 32 * ks + 8 * (lane >> 4)) * 2;
            acc = mfma16(*(const LAS bf16x8*)(Himg + off), *(const LAS bf16x8*)(WgT + off), acc); }
        *(LAS f32x4*)(red + wave * 256 + lane * 4) = acc;
        __syncthreads();
        if (tid < 256) { const int ln = tid & 63, j = tid >> 6; float s = 0.f;
#pragma unroll
            for (int w = 0; w < 8; ++w) s += red[w * 256 + ln * 4 + j];
            const int tr = 4 * (ln >> 4) + j, row = halfg ? NLAT + 8 * bid + tr : 16 * gi + tr, gate = ln & 15;
            if (!halfg || tr < 8) ((float*)(ws + WS_GATES))[(size_t)row * 16 + gate] = s + a.in[12][l * 16 + gate]; }
    }
}

template <int MODE>
__device__ __forceinline__ void phase_norm(const Args& a, int l, LAS unsigned char* lds, int tid, int lane, int wave, int bid, int G) {
    unsigned char* ws = a.ws;
    LAS float* WT = (LAS float*)lds;
    if (MODE == 0) { const float* w = a.in[8] + (size_t)l * DM * DIN + 2048; for (int i = tid; i < 16384; i += NTHR) { const int k = i >> 4, j = i & 15; WT[j * 1024 + k] = w[(size_t)k * DIN + j]; } __syncthreads(); }
    f32x4 rw[4][4][2];
    if (MODE == 2) { const float* w = a.in[20];
#pragma unroll
        for (int j = 0; j < 4; ++j)
#pragma unroll
            for (int i = 0; i < 4; ++i) { rw[j][i][0] = *(const f32x4*)(w + (size_t)(4 * lane + 256 * j + i) * 8); rw[j][i][1] = *(const f32x4*)(w + (size_t)(4 * lane + 256 * j + i) * 8 + 4); } }
    const float* gam = (MODE == 0 ? a.in[4] : a.in[5]) + (size_t)l * DM;
    const float* mod = (const float*)(ws + WS_MOD) + (size_t)l * 9 * 6144;
    const int shoff = MODE == 0 ? 0 : 3072, soff = MODE == 0 ? 1024 : 4096;
    const int nrows = (MODE == 2) ? NLAT : MALL;
    unsigned char* H8 = ws + WS_H;
    int nrec = 0;
    const int rstride = G * NWAVES, gwv = bid * NWAVES + wave;
    const bool remap = (G == 256);
    auto rowk = [&](int gw_, int k) -> int { if (!remap) return gw_ + k * rstride; return k < 8 ? ((gw_ >> 8) << 11) + (gw_ & 255) + 256 * k : (k == 8 ? NLAT + gw_ : nrows); };
    const int nk = remap ? (MODE == 2 ? 8 : 9) : (gwv < nrows ? (nrows - gwv + rstride - 1) / rstride : 0);
    u32x2 vnext[4];
    if (nk > 0) { const int r = rowk(gwv, 0); const bool lat = r < NLAT;
        const bf16_t* src = lat ? (const bf16_t*)(ws + WS_SB) + (size_t)r * DM : (const bf16_t*)(ws + WS_XC) + (size_t)(r - NLAT) * DM;
#pragma unroll
        for (int j = 0; j < 4; ++j) vnext[j] = *(const u32x2*)(src + 4 * lane + 256 * j); }
    f32x4 gs[4], shv[4]; int cbi = -1;
    for (int kq = 0; kq < nk; ++kq) { const int r = rowk(gwv, kq);
        const bool lat = r < NLAT; const int bi = lat ? (r >> 11) : 8;
        f32x4 v[4]; float ss = 0.f;
#pragma unroll
        for (int j = 0; j < 4; ++j) { v[j] = (f32x4){bflo(vnext[j].x), bfhi(vnext[j].x), bflo(vnext[j].y), bfhi(vnext[j].y)}; ss += (v[j].x * v[j].x + v[j].y * v[j].y) + (v[j].z * v[j].z + v[j].w * v[j].w); }
        if (kq + 1 < nk) { const int rn = rowk(gwv, kq + 1); const bool latn = rn < NLAT;
            const bf16_t* srcn = latn ? (const bf16_t*)(ws + WS_SB) + (size_t)rn * DM : (const bf16_t*)(ws + WS_XC) + (size_t)(rn - NLAT) * DM;
#pragma unroll
            for (int j = 0; j < 4; ++j) vnext[j] = *(const u32x2*)(srcn + 4 * lane + 256 * j); }
        if (bi != cbi) { cbi = bi; const float* mrow = mod + (size_t)bi * 6144;
#pragma unroll
            for (int j = 0; j < 4; ++j) { const int k = 4 * lane + 256 * j; gs[j] = *(const f32x4*)(gam + k) * (1.0f + *(const f32x4*)(mrow + soff + k)); shv[j] = *(const f32x4*)(mrow + shoff + k); } }
        const float rstd = rsqrtf(wave_sum(ss) * (1.0f / DM) + EPS);
#pragma unroll
        for (int j = 0; j < 4; ++j) v[j] = v[j] * rstd * gs[j] + shv[j];
        { float am = 0.f;
#pragma unroll
          for (int j = 0; j < 4; ++j) am = fmaxf(am, fmaxf(fmaxf(fabsf(v[j].x), fabsf(v[j].y)), fmaxf(fabsf(v[j].z), fabsf(v[j].w))));
          am = wave_max(am); const float qs = am > 0.f ? 127.0f / am : 0.f;
#pragma unroll
          for (int j = 0; j < 4; ++j) *(unsigned*)(H8 + (size_t)r * DM + 4 * lane + 256 * j) = pack_i8x4(v[j].x * qs, v[j].y * qs, v[j].z * qs, v[j].w * qs);
          if (lane == 0) ((float*)(ws + WS_HS))[r] = am * (1.0f / 127.0f); }
        if (MODE == 0) {
            float p[16];
#pragma unroll
            for (int jg = 0; jg < 16; ++jg) p[jg] = 0.f;
#pragma unroll
            for (int jg = 0; jg < 16; ++jg) {
#pragma unroll
                for (int j = 0; j < 4; ++j) { const f32x4 w = *(const LAS f32x4*)(WT + jg * 1024 + 4 * lane + 256 * j); p[jg] += (v[j].x * w.x + v[j].y * w.y) + (v[j].z * w.z + v[j].w * w.w); }
                if ((jg & 3) == 3) asm volatile("" ::: "memory"); }
            const float tot = reduce16_lanes(p, lane);
            const int gid = ((lane >> 5) & 1) * 8 + ((lane >> 4) & 1) * 4 + ((lane >> 3) & 1) * 2 + ((lane >> 2) & 1);
            if ((lane & 3) == 0) ((float*)(ws + WS_GATES))[(size_t)r * 16 + gid] = tot + a.in[12][l * 16 + gid];
        }
        if (MODE == 2) {
            f32x4 pa = {0.f, 0.f, 0.f, 0.f}, pb = pa;
#pragma unroll
            for (int j = 0; j < 4; ++j)
#pragma unroll
                for (int i = 0; i < 4; ++i) { pa += rw[j][i][0] * v[j][i]; pb += rw[j][i][1] * v[j][i]; }
            float p[8] = {pa[0], pa[1], pa[2], pa[3], pb[0], pb[1], pb[2], pb[3]};
            const float tot = reduce8_lanes(p, lane);
            int i1 = 0, i2 = 0; float v1 = -3.0e38f, v2 = -3.0e38f;
#pragma unroll
            for (int e = 0; e < 8; ++e) { const float s = lane_bcast(tot, 32 * (e >> 2) + 16 * ((e >> 1) & 1) + 8 * (e & 1));
                if (s > v1) { v2 = v1; i2 = i1; v1 = s; i1 = e; } else if (s > v2) { v2 = s; i2 = e; } }
            const float w2 = 1.0f / (1.0f + __expf(v1 - v2)), w1 = 1.0f - w2;
            if (lane == 0) { LAS int* rec = (LAS int*)(lds + 32768) + nrec * 32 + wave * 4; rec[0] = i1; rec[1] = i2; rec[2] = __float_as_int(w1); rec[3] = __float_as_int(w2); }
            ++nrec;
        }
    }
    if (MODE == 2) {
        __syncthreads();
        {
            const int e = wave; const LAS int* rec = (const LAS int*)(lds + 32768);
            int* LIST = (int*)(ws + WS_LIST) + e * NLAT; int* TOK = (int*)(ws + WS_COMB);
            const int nk0 = remap ? nk : (bid * NWAVES < nrows ? (nrows - bid * NWAVES + rstride - 1) / rstride : 0);
            for (int kb = 0; kb < nk0; kb += 8) { const int k = kb + (lane >> 3), w = lane & 7, r = k < nk0 ? rowk(bid * NWAVES + w, k) : nrows; const bool ok = k < nk0 && r < nrows;
                const LAS int* q = rec + k * 32 + w * 4; const int q0 = ok ? q[0] : -1, q1 = ok ? q[1] : -1, w1b = ok ? q[2] : 0, w2b = ok ? q[3] : 0;
                const bool f0 = q0 == e, f1 = q1 == e, f = f0 || f1;
                const unsigned long long bm = __ballot(f); const int cnt = __popcll(bm);
                int pos0 = 0; if (lane == 0 && cnt > 0) pos0 = (int)atomicAdd((unsigned*)(ws + WS_CTL) + CW_MOE + 64 * e, (unsigned)cnt);
                pos0 = __builtin_amdgcn_readlane(pos0, 0);
                if (f) { const int pos = pos0 + __popcll(bm & ((1ull << lane) - 1ull)); LIST[pos] = r;
                    if (f0) { TOK[r * 8 + 0] = e; TOK[r * 8 + 2] = pos; TOK[r * 8 + 4] = w1b; } else { TOK[r * 8 + 1] = e; TOK[r * 8 + 3] = pos; TOK[r * 8 + 5] = w2b; } } }
        }
    }
}

__device__ __forceinline__ void phase_post(const Args& a, int l, int lane, int wave, int bid, int G) {
    unsigned char* ws = a.ws;
    bf16_t* P = (bf16_t*)(ws + WS_BIG); bf16_t* MQK = (bf16_t*)(ws + WS_MQK);
    const float* ROPE = (const float*)(ws + WS_ROPE);
    const float* cw = a.in[10] + (size_t)l * 3 * 512; const float* cb = a.in[11] + (size_t)l * 512;
    const float qg = a.in[13][l * 64 + lane], kg = a.in[14][l * 64 + lane];
    for (int r = bid * NWAVES + wave; r < MALL; r += G * NWAVES) {
        const bool lat = r < NLAT; bf16_t* row = P + (size_t)r * NPW;
        int t, tlen; if (lat) { t = r & (SEQ - 1); tlen = SEQ; } else { t = (r - NLAT) & (CTXL - 1); tlen = CTXL; }
        if (lat) { const int gr = t >> 6, gc = t & 63;
#pragma unroll
            for (int blk = 0; blk < 2; ++blk)
#pragma unroll
                for (int ii = 0; ii < 2; ++ii) { const int pid = lane + 64 * ii, head = pid >> 5, half = (pid >> 4) & 1, i = pid & 15, c1 = (blk ? PC_RK : PC_RQ) + head * 64 + half * 32 + i;
                    const int pos = half ? gc : gr; const float cs = ROPE[(pos * 16 + i) * 2], sn = ROPE[(pos * 16 + i) * 2 + 1];
                    const float x1 = bf2f(row[c1]), x2 = bf2f(row[c1 + 16]); const float sc = blk ? 0.125f : 1.0f;
                    row[c1] = (bf16_t)f2bf((x1 * cs - x2 * sn) * sc); row[c1 + 16] = (bf16_t)f2bf((x1 * sn + x2 * cs) * sc); }
        } else {
#pragma unroll
            for (int ii = 0; ii < 4; ++ii) { const int c = PC_RK + lane + 64 * ii; row[c] = (bf16_t)f2bf(bf2f(row[c]) * 0.125f); }
        }
#pragma unroll
        for (int ii = 0; ii < 8; ++ii) { const int c = lane + 64 * ii;
            const float x0 = bf2f(row[PC_MQ + c]);
            const float xm = t > 0 ? bf2f(row[PC_MQ + c - NPW]) : 0.f, xp = t < tlen - 1 ? bf2f(row[PC_MQ + c + NPW]) : 0.f;
            float y = cb[c] + cw[c] * xm + cw[512 + c] * x0 + cw[1024 + c] * xp;
            y = y * rcpf_(1.0f + __expf(-y)); if (c >= 256) y *= 0.125f;
            MQK[(size_t)r * 512 + c] = (bf16_t)f2bf(y); }
#pragma unroll
        for (int hh = 0; hh < 16; ++hh) { const int c = PC_NQ + hh * 64 + lane; const float v = bf2f(row[c]);
            const float rs = rsqrtf(wave_sum(v * v) * (1.0f / 64.0f) + EPS);
            row[c] = (bf16_t)f2bf(v * rs * (hh < 8 ? qg : kg)); }
    }
}


__device__ __forceinline__ int hl_off(int hl, int c) { return c < 32 ? 32 * hl + c : 128 + 32 * hl + (c - 32); }
struct Conv8Raw { u32x4 xm, x0, xp; };
__device__ __forceinline__ void conv8_load(Conv8Raw& x, const bf16_t* P, int row, int ch, bool hasm, bool hasp) {
    const bf16_t* src = P + (size_t)row * NPW + PC_MQ + ch;
    x.x0 = *(const u32x4*)src; x.xm = (u32x4){0u, 0u, 0u, 0u}; x.xp = x.xm;
    if (hasm) x.xm = *(const u32x4*)(src - NPW);
    if (hasp) x.xp = *(const u32x4*)(src + NPW);
}
__device__ __forceinline__ u32x4 conv8_eval(const Conv8Raw& x, int ch, const LAS float* CW) {
    const u32x4 xm = x.xm, x0 = x.x0, xp = x.xp;
    const f32x4 w0a = *(const LAS f32x4*)(CW + ch), w0b = *(const LAS f32x4*)(CW + ch + 4), w1a = *(const LAS f32x4*)(CW + 512 + ch), w1b = *(const LAS f32x4*)(CW + 512 + ch + 4);
    const f32x4 w2a = *(const LAS f32x4*)(CW + 1024 + ch), w2b = *(const LAS f32x4*)(CW + 1024 + ch + 4), ba = *(const LAS f32x4*)(CW + 1536 + ch), bb = *(const LAS f32x4*)(CW + 1536 + ch + 4);
    float y[8];
    y[0] = ba[0] + w0a[0] * bflo(xm.x) + w1a[0] * bflo(x0.x) + w2a[0] * bflo(xp.x); y[1] = ba[1] + w0a[1] * bfhi(xm.x) + w1a[1] * bfhi(x0.x) + w2a[1] * bfhi(xp.x);
    y[2] = ba[2] + w0a[2] * bflo(xm.y) + w1a[2] * bflo(x0.y) + w2a[2] * bflo(xp.y); y[3] = ba[3] + w0a[3] * bfhi(xm.y) + w1a[3] * bfhi(x0.y) + w2a[3] * bfhi(xp.y);
    y[4] = bb[0] + w0b[0] * bflo(xm.z) + w1b[0] * bflo(x0.z) + w2b[0] * bflo(xp.z); y[5] = bb[1] + w0b[1] * bfhi(xm.z) + w1b[1] * bfhi(x0.z) + w2b[1] * bfhi(xp.z);
    y[6] = bb[2] + w0b[2] * bflo(xm.w) + w1b[2] * bflo(x0.w) + w2b[2] * bflo(xp.w); y[7] = bb[3] + w0b[3] * bfhi(xm.w) + w1b[3] * bfhi(x0.w) + w2b[3] * bfhi(xp.w);
    const float sc = ch >= 256 ? 0.125f : 1.0f;
#pragma unroll
    for (int j = 0; j < 8; ++j) y[j] = y[j] * rcpf_(1.0f + __expf(-y[j])) * sc;
    u32x4 o; o.x = pk2(y[0], y[1]); o.y = pk2(y[2], y[3]); o.z = pk2(y[4], y[5]); o.w = pk2(y[6], y[7]); return o;
}
__device__ __forceinline__ void conv_weights_to_lds(const Args& a, int l, LAS float* CW, int tid) {
    float cv[4];
#pragma unroll
    for (int q = 0; q < 4; ++q) { const int i = tid + NTHR * q; cv[q] = *(i < 1536 ? a.in[10] + (size_t)l * 1536 + i : a.in[11] + (size_t)l * 512 + (i - 1536)); }
#pragma unroll
    for (int q = 0; q < 4; ++q) CW[tid + NTHR * q] = cv[q];
}
__device__ __forceinline__ int chunk_row0(int b, int dir, int sc) {
    if (dir == 0) return sc < 2 ? NLAT + b * CTXL + 128 * sc : b * SEQ + 128 * (sc - 2);
    return sc < 2 ? NLAT + b * CTXL + 128 * (1 - sc) : b * SEQ + 128 * (17 - sc);
}
constexpr size_t U_BYTES = 80 * 64 * 2;

__device__ __forceinline__ void phase_chunk_sums(const Args& a, int l, LAS unsigned char* lds, int tid, int lane, int wave, int bid, int G) {
    unsigned char* ws = a.ws;
    const bf16_t* P = (const bf16_t*)(ws + WS_BIG);
    const float* GT = (const float*)(ws + WS_GATES);
    LAS unsigned char* Kimg = lds; LAS unsigned char* VFimg = lds + 20480; LAS unsigned char* VBimg = lds + 40960;
    LAS float* wkF = (LAS float*)(lds + 61440); LAS float* wkB = wkF + 128;
    LAS float* CW = (LAS float*)(lds + 62464); conv_weights_to_lds(a, l, CW, tid); __syncthreads();
    const int nitems = 2 * NB * 4 * 18;
    struct M1Raw { u32x4 v0, v1; Conv8Raw x[4]; float g[4]; };
    auto m1_load = [&](M1Raw& R, int it_) {
        const int cc = it_ % 18; int r_ = it_ / 18; const int h = r_ & 3; r_ >>= 2; const int b = r_ & 7; const int kind = r_ >> 3;
        const bool isctx = cc >= 16; const int c = isctx ? cc - 16 : cc; const int row0 = isctx ? NLAT + b * CTXL + 128 * c : b * SEQ + 128 * c;
        const int r = tid >> 2, c8 = (tid & 3) * 16;
        const bf16_t* vsrc = P + (size_t)(row0 + r) * NPW + (kind == 0 ? PC_RV : PC_MV) + h * 64 + c8;
        R.v0 = *(const u32x4*)vsrc; R.v1 = *(const u32x4*)(vsrc + 8);
        if (kind == 0) { const bf16_t* ksrc = P + (size_t)(row0 + r) * NPW + PC_RK + hl_off(h, c8); R.x[0].x0 = *(const u32x4*)ksrc; R.x[1].x0 = *(const u32x4*)(ksrc + 8); }
        else { const int t = 128 * c + r; const bool hasm = t > 0, hasp = t < (isctx ? CTXL : SEQ) - 1;
            conv8_load(R.x[0], P, row0 + r, 256 + h * 64 + c8, hasm, hasp); conv8_load(R.x[1], P, row0 + r, 256 + h * 64 + c8 + 8, hasm, hasp);
            conv8_load(R.x[2], P, row0 + r, h * 64 + c8, hasm, hasp); conv8_load(R.x[3], P, row0 + r, h * 64 + c8 + 8, hasm, hasp);
            if (wave < 2) { const int dir = wave; R.g[0] = GT[(size_t)(row0 + lane) * 16 + 4 * dir + h]; R.g[1] = GT[(size_t)(row0 + 64 + lane) * 16 + 4 * dir + h];
                R.g[2] = GT[(size_t)(row0 + lane) * 16 + 8 + 4 * dir + h]; R.g[3] = GT[(size_t)(row0 + 64 + lane) * 16 + 8 + 4 * dir + h]; } }
    };
    auto item_at = [&](int j) -> int {
        if (G != 256) { const int i = bid + j * G; return i < nitems ? i : -1; }
        if (bid < 64) return j == 0 ? bid : j < 4 ? 576 + bid + 64 * (j - 1) : -1;
        if (bid < 192) { const int q = bid - 64; return j < 3 ? 64 + q + 128 * j : j < 5 ? 576 + 192 + q + 128 * (j - 3) : -1; }
        const int q = bid - 192; return j < 2 ? 448 + q + 64 * j : j < 4 ? 576 + 448 + q + 64 * (j - 2) : -1; };
    int jit = 0; int it = item_at(0); if (it < 0) return;
    M1Raw R; m1_load(R, it);
    for (;;) {
        const int cc = it % 18; int r_ = it / 18; const int h = r_ & 3; r_ >>= 2; const int b = r_ & 7; const int kind = r_ >> 3;
        const bool isctx = cc >= 16; const int c = isctx ? cc - 16 : cc;
        const int row0 = isctx ? NLAT + b * CTXL + 128 * c : b * SEQ + 128 * c;
        const int scf = isctx ? c : 2 + c, scb = isctx ? 1 - c : 17 - c;
        const int r = tid >> 2, c8 = (tid & 3) * 16;
        const u32x4 v0 = R.v0, v1 = R.v1;
        u32x4 k0, k1;
        if (kind == 0) { k0 = R.x[0].x0; k1 = R.x[1].x0; }
        else { k0 = conv8_eval(R.x[0], 256 + h * 64 + c8, CW); k1 = conv8_eval(R.x[1], 256 + h * 64 + c8 + 8, CW);
            bf16_t* mq = (bf16_t*)(ws + WS_MQK) + (size_t)(row0 + r) * 512 + h * 64 + c8;
            *(u32x4*)(mq + 256) = k0; *(u32x4*)(mq + 256 + 8) = k1;
            *(u32x4*)mq = conv8_eval(R.x[2], h * 64 + c8, CW); *(u32x4*)(mq + 8) = conv8_eval(R.x[3], h * 64 + c8 + 8, CW); }
        const float pg0 = R.g[0], pg1 = R.g[1], pg2 = R.g[2], pg3 = R.g[3];
        __syncthreads();
        if (kind == 0) { if (tid < 256) { const int dir = tid >> 7, i = tid & 127; const float lg = logsigmoidf_(a.in[9][(l * 2 + dir) * 4 + h]); (dir ? wkB : wkF)[i] = __expf(lg * (float)(dir == 0 ? 127 - i : i)); } }
        else if (wave < 2) {
            const int dir = wave;
            const float g0i = pg0, g1i = pg1;
            const float f0 = logsigmoidf_(pg2), f1 = logsigmoidf_(pg3);
            float s0 = f0, s1 = f1;
#pragma unroll
            for (int o = 1; o < 64; o <<= 1) { const int sl = lane >= o ? lane - o : lane; const float u0 = lane_get(s0, sl), u1 = lane_get(s1, sl); if (lane >= o) { s0 += u0; s1 += u1; } }
            const float t0 = lane_bcast(s0, 63), t1 = lane_bcast(s1, 63), tot = t0 + t1;
            float b0, b1;
            if (dir == 0) { b0 = s0; b1 = t0 + s1; } else { b0 = tot - s0 + f0; b1 = t1 - s1 + f1; }
            const float a0 = g0i - b0, a1 = g1i - b1; const float amax = wave_max(fmaxf(a0, a1));
            float x0 = a0, x1 = a1;
            if (dir == 0) {
#pragma unroll
                for (int o = 1; o < 64; o <<= 1) { const int sl = lane >= o ? lane - o : lane; const float u0 = lane_get(x0, sl), u1 = lane_get(x1, sl); if (lane >= o) { x0 = fmaxf(x0, u0); x1 = fmaxf(x1, u1); } }
                x1 = fmaxf(x1, lane_bcast(x0, 63));
            } else {
#pragma unroll
                for (int o = 1; o < 64; o <<= 1) { const int sl = lane + o < 64 ? lane + o : lane; const float u0 = lane_get(x0, sl), u1 = lane_get(x1, sl); if (lane + o < 64) { x0 = fmaxf(x0, u0); x1 = fmaxf(x1, u1); } }
                x0 = fmaxf(x0, lane_bcast(x1, 0));
            }
            LAS float* wk = dir ? wkB : wkF;
            wk[lane] = __expf(a0 - amax); wk[lane + 64] = __expf(a1 - amax);
            float* ga = (float*)(ws + WS_GARR) + ((size_t)(((b * 4 + h) * 18 + cc) * 2 + dir)) * 384;
            ga[lane] = a0; ga[lane + 64] = a1; ga[128 + lane] = b0; ga[128 + lane + 64] = b1; ga[256 + lane] = x0; ga[256 + lane + 64] = x1;
            if (lane == 0) { float* usc = (float*)(ws + WS_USC) + ((size_t)((b * 4 + h) * 2 + dir) * 18 + (dir ? scb : scf)) * 2; usc[0] = tot; usc[1] = amax; }
        }
        __syncthreads();
        {
            *(LAS u32x4*)(Kimg + r * IST + c8 * 2) = k0; *(LAS u32x4*)(Kimg + r * IST + c8 * 2 + 16) = k1;
#pragma unroll
            for (int dir = 0; dir < 2; ++dir) {
                const float w = (dir ? wkB : wkF)[r]; LAS unsigned char* Vimg = dir ? VBimg : VFimg;
                u32x4 o0, o1;
                o0.x = pk2(bflo(v0.x) * w, bfhi(v0.x) * w); o0.y = pk2(bflo(v0.y) * w, bfhi(v0.y) * w); o0.z = pk2(bflo(v0.z) * w, bfhi(v0.z) * w); o0.w = pk2(bflo(v0.w) * w, bfhi(v0.w) * w);
                o1.x = pk2(bflo(v1.x) * w, bfhi(v1.x) * w); o1.y = pk2(bflo(v1.y) * w, bfhi(v1.y) * w); o1.z = pk2(bflo(v1.z) * w, bfhi(v1.z) * w); o1.w = pk2(bflo(v1.w) * w, bfhi(v1.w) * w);
                *(LAS u32x4*)(Vimg + r * IST + c8 * 2) = o0; *(LAS u32x4*)(Vimg + r * IST + c8 * 2 + 16) = o1;
                if ((tid & 3) == 0) { unsigned zz; asm volatile("v_mov_b32 %0, 0" : "=v"(zz)); u32x4 e0; e0.x = f2bf(w); e0.y = zz; e0.z = zz; e0.w = zz; u32x4 z; z.x = zz; z.y = zz; z.z = zz; z.w = zz;
                    *(LAS u32x4*)(Vimg + r * IST + 128) = e0; *(LAS u32x4*)(Vimg + r * IST + 144) = z; }
            }
        }
        __syncthreads();
        const int itn = item_at(jit + 1); const bool has_next = itn >= 0; if (has_next) m1_load(R, itn);
        {
            const int dt = wave & 3, dir = wave >> 2; LAS const unsigned char* Vimg = dir ? VBimg : VFimg;
            f32x4 u[5];
#pragma unroll
            for (int et = 0; et < 5; ++et) u[et] = (f32x4){0.f, 0.f, 0.f, 0.f};
#pragma unroll
            for (int ks = 0; ks < 4; ++ks) {
                const bf16x8 af = frag_tr<false>(Kimg, 32 * ks, 16 * dt, lane);
                bf16x8 bx[4]; frag_tr_x4<false>(Vimg, 32 * ks, 0, lane, bx); const bf16x8 b4 = frag_tr<false>(Vimg, 32 * ks, 64, lane);
#pragma unroll
                for (int et = 0; et < 4; ++et) u[et] = mfma16(af, bx[et], u[et]);
                u[4] = mfma16(af, b4, u[4]);
            }
            bf16_t* U = (bf16_t*)(ws + WS_U + ((size_t)(((kind * NB + b) * 4 + h) * 2 + dir) * 18 + (dir ? scb : scf)) * U_BYTES);
            const int g = lane >> 4, e = lane & 15, d0 = 16 * dt + 4 * g;
#pragma unroll
            for (int et = 0; et < 5; ++et) if (et < 4 || kind == 1) { u32x2 w; w.x = pk2(u[et][0], u[et][1]); w.y = pk2(u[et][2], u[et][3]); *(u32x2*)(U + (size_t)(16 * et + e) * 64 + d0) = w; }
        }
        if (!has_next) break;
        it = itn; ++jit;
    }
}

__device__ __forceinline__ void phase_chunk_states(const Args& a, int l, int tid, int bid, int G) {
    unsigned char* ws = a.ws;
    for (int it = bid; it < 2 * NB * 4 * 2; it += G) {
        const int dir = it & 1, h = (it >> 1) & 3, b = (it >> 3) & 7, kind = it >> 6;
        const size_t seq = (size_t)(((kind * NB + b) * 4 + h) * 2 + dir) * 18;
        const unsigned char* Ub = ws + WS_U + seq * U_BYTES; unsigned char* Sb = ws + WS_S + seq * U_BYTES;
        const float* usc = (const float*)(ws + WS_USC) + (size_t)((b * 4 + h) * 2 + dir) * 18 * 2;
        float* sm = (float*)(ws + WS_SM) + (size_t)((b * 4 + h) * 2 + dir) * 18;
        const float dec_ret = __expf(128.0f * logsigmoidf_(a.in[9][(l * 2 + dir) * 4 + h]));
        float blv[18], amv[18];
#pragma unroll
        for (int s = 0; s < 18; ++s) { blv[s] = kind == 0 ? 0.f : usc[2 * s]; amv[s] = kind == 0 ? 0.f : usc[2 * s + 1]; }
        const int nrow = kind == 0 ? 512 : 520;
        for (int ci = tid; ci < nrow; ci += NTHR) {
            u32x4 v[18];
#pragma unroll
            for (int s = 0; s < 18; ++s) v[s] = *(const u32x4*)(Ub + (size_t)s * U_BYTES + (size_t)ci * 16);
            float acc[8];
#pragma unroll
            for (int j = 0; j < 8; ++j) acc[j] = 0.f;
            float m = 0.f;
#pragma unroll
            for (int s = 0; s < 18; ++s) {
                u32x4 o; o.x = pk2(acc[0], acc[1]); o.y = pk2(acc[2], acc[3]); o.z = pk2(acc[4], acc[5]); o.w = pk2(acc[6], acc[7]);
                *(u32x4*)(Sb + (size_t)s * U_BYTES + (size_t)ci * 16) = o;
                float dk, ck;
                if (kind == 0) { dk = dec_ret; ck = 1.0f; }
                else { if (ci == 0) sm[s] = m; const float bl = blv[s], am = amv[s]; const float mx = fmaxf(m, am); dk = __expf(m - mx); ck = __expf(am - mx); m = bl + mx; }
                acc[0] = dk * acc[0] + ck * bflo(v[s].x); acc[1] = dk * acc[1] + ck * bfhi(v[s].x); acc[2] = dk * acc[2] + ck * bflo(v[s].y); acc[3] = dk * acc[3] + ck * bfhi(v[s].y);
                acc[4] = dk * acc[4] + ck * bflo(v[s].z); acc[5] = dk * acc[5] + ck * bfhi(v[s].z); acc[6] = dk * acc[6] + ck * bflo(v[s].w); acc[7] = dk * acc[7] + ck * bfhi(v[s].w);
            }
        }
        asm volatile("s_waitcnt vmcnt(0)" ::: "memory");
        __syncthreads();
        if (tid == 0) { __builtin_amdgcn_fence(__ATOMIC_RELEASE, "agent"); asm volatile("s_waitcnt vmcnt(0)" ::: "memory");
            __hip_atomic_store((unsigned*)(ws + WS_CTL) + CW_CHFLAG + 16 * (128 * l + it), 1u, __ATOMIC_RELAXED, __HIP_MEMORY_SCOPE_AGENT); }
    }
}

template <int KIND>
__device__ __forceinline__ float load_state(const unsigned char* ws, int b, int h, int dir, int sc, LAS unsigned char* Simg, int tid) {
    const unsigned char* Sp = ws + WS_S + ((size_t)((((KIND * NB + b) * 4 + h) * 2 + dir) * 18) + sc) * U_BYTES;
    *(LAS u32x4*)(Simg + (tid >> 3) * IST + (tid & 7) * 16) = *(const u32x4*)(Sp + (size_t)tid * 16);
    if (KIND == 1 && tid < 8) *(LAS u32x4*)(Simg + 64 * IST + tid * 16) = *(const u32x4*)(Sp + (size_t)(512 + tid) * 16);
    return KIND == 1 ? ((const float*)(ws + WS_SM))[(size_t)((b * 4 + h) * 2 + dir) * 18 + sc] : 0.f;
}

template <int KIND>
__device__ __forceinline__ void phase_chunk_out(const Args& a, int l, bool need_ctx, LAS unsigned char* lds, int tid, int lane, int wave, int bid, int G) {
    unsigned char* ws = a.ws;
    const bf16_t* P = (const bf16_t*)(ws + WS_BIG);
    const float* GT = (const float*)(ws + WS_GATES); bf16_t* MG = (bf16_t*)(ws + WS_H);
    LAS unsigned char* Qimg = lds; LAS unsigned char* Kimg = lds + 20480; LAS unsigned char* Vimg = lds + 40960;
    LAS unsigned char* SFimg = lds + 61440; LAS unsigned char* SBimg = lds + 74240;
    LAS float* AF = (LAS float*)(lds + 87040); LAS float* CF = AF + 128; LAS float* BF = AF + 256; LAS float* AB = AF + 384; LAS float* CB = AF + 512; LAS float* BB = AF + 640;
    const int nch = need_ctx ? 18 : 16, nitems = NB * 4 * nch;
    const int g = lane >> 4, qi = 16 * wave + (lane & 15);
    for (int it = (bid + G - (KIND == 0 ? 0 : 64) % G) % G; it < nitems; it += G) {
        const int cc = it % nch; const int bh = it / nch; const int h = bh & 3, b = bh >> 2;
        const bool isctx = cc >= 16; const int c = isctx ? cc - 16 : cc;
        const int row0 = isctx ? NLAT + b * CTXL + 128 * c : b * SEQ + 128 * c;
        const int scf = isctx ? c : 2 + c, scb = isctx ? 1 - c : 17 - c;
        if (tid == 0) {
            unsigned* ctl = (unsigned*)(ws + WS_CTL); unsigned* fl = ctl + CW_CHFLAG + 16 * (128 * l + ((KIND * NB + b) * 4 + h) * 2);
            XB_SPIN(xb_ld(fl) == 0u || xb_ld(fl + 16) == 0u, ctl + CW_BAR);
            __builtin_amdgcn_fence(__ATOMIC_ACQUIRE, "agent"); asm volatile("s_waitcnt vmcnt(0)" ::: "memory"); }
        __syncthreads();
        float mpf = 0.f, mpb = 0.f, dpf = 0.f, dpb = 0.f;
        {
            const int r = tid >> 2, c8 = (tid & 3) * 16;
            if (KIND == 0) { dpf = a.in[9][(l * 2 + 0) * 4 + h]; dpb = a.in[9][(l * 2 + 1) * 4 + h]; }
            const bf16_t* vsrc = P + (size_t)(row0 + r) * NPW + (KIND == 0 ? PC_RV : PC_MV) + h * 64 + c8;
            u32x4 q0, q1, k0, k1;
            if (KIND == 0) { const bf16_t* qsrc = P + (size_t)(row0 + r) * NPW + PC_RQ + hl_off(h, c8); const bf16_t* ksrc = P + (size_t)(row0 + r) * NPW + PC_RK + hl_off(h, c8);
                q0 = *(const u32x4*)qsrc; q1 = *(const u32x4*)(qsrc + 8); k0 = *(const u32x4*)ksrc; k1 = *(const u32x4*)(ksrc + 8); }
            else { const bf16_t* mq = (const bf16_t*)(ws + WS_MQK) + (size_t)(row0 + r) * 512 + h * 64 + c8;
                q0 = *(const u32x4*)mq; q1 = *(const u32x4*)(mq + 8); k0 = *(const u32x4*)(mq + 256); k1 = *(const u32x4*)(mq + 256 + 8); }
            const u32x4 v0 = *(const u32x4*)vsrc, v1 = *(const u32x4*)(vsrc + 8);
            const unsigned char* SpF = ws + WS_S + ((size_t)((((KIND * NB + b) * 4 + h) * 2 + 0) * 18) + scf) * U_BYTES;
            const unsigned char* SpB = ws + WS_S + ((size_t)((((KIND * NB + b) * 4 + h) * 2 + 1) * 18) + scb) * U_BYTES;
            const u32x4 sF = *(const u32x4*)(SpF + (size_t)tid * 16), sB = *(const u32x4*)(SpB + (size_t)tid * 16);
            u32x4 sF2 = sF, sB2 = sB; float g0 = 0.f, g1 = 0.f;
            if (KIND == 1) {
                if (tid < 8) { sF2 = *(const u32x4*)(SpF + (size_t)(512 + tid) * 16); sB2 = *(const u32x4*)(SpB + (size_t)(512 + tid) * 16); }
                mpf = ((const float*)(ws + WS_SM))[(size_t)((b * 4 + h) * 2 + 0) * 18 + scf]; mpb = ((const float*)(ws + WS_SM))[(size_t)((b * 4 + h) * 2 + 1) * 18 + scb];
                const float* ga = (const float*)(ws + WS_GARR) + (size_t)((b * 4 + h) * 18 + cc) * 768;
                g0 = ga[tid]; if (tid < 256) g1 = ga[512 + tid]; }
            asm volatile("" ::: "memory");
            *(LAS u32x4*)(Qimg + r * IST + c8 * 2) = q0; *(LAS u32x4*)(Qimg + r * IST + c8 * 2 + 16) = q1;
            *(LAS u32x4*)(Kimg + r * IST + c8 * 2) = k0; *(LAS u32x4*)(Kimg + r * IST + c8 * 2 + 16) = k1;
            *(LAS u32x4*)(Vimg + r * IST + c8 * 2) = v0; *(LAS u32x4*)(Vimg + r * IST + c8 * 2 + 16) = v1;
            if ((tid & 3) == 0) { unsigned zz, one; asm volatile("v_mov_b32 %0, 0\n\tv_mov_b32 %1, 0x3f80" : "=v"(zz), "=v"(one)); u32x4 e0; e0.x = one; e0.y = zz; e0.z = zz; e0.w = zz; u32x4 z; z.x = zz; z.y = zz; z.z = zz; z.w = zz;
                *(LAS u32x4*)(Vimg + r * IST + 128) = e0; *(LAS u32x4*)(Vimg + r * IST + 144) = z; }
            *(LAS u32x4*)(SFimg + (tid >> 3) * IST + (tid & 7) * 16) = sF; *(LAS u32x4*)(SBimg + (tid >> 3) * IST + (tid & 7) * 16) = sB;
            if (KIND == 1) {
                if (tid < 8) { *(LAS u32x4*)(SFimg + 64 * IST + tid * 16) = sF2; *(LAS u32x4*)(SBimg + 64 * IST + tid * 16) = sB2; }
#pragma unroll
                for (int q = 0; q < 2; ++q) { const int i = tid + 512 * q; if (i < 768) { const int dir = i / 384, which = (i - dir * 384) >> 7, j = i & 127; float v = q ? g1 : g0;
                    if (which == 2) v = fmaxf(v, dir ? mpb : mpf);
                    AF[dir * 384 + (which == 0 ? 0 : (which == 1 ? 256 : 128)) + j] = v; } }
            }
        }
        __syncthreads();
        const bf16x8 bq0 = frag_row(Qimg, 16 * wave, 0, lane), bq1 = frag_row(Qimg, 16 * wave, 32, lane);
        f32x4 st[8];
#pragma unroll
        for (int kt = 0; kt < 8; ++kt) { f32x4 z = {0.f, 0.f, 0.f, 0.f}; z = mfma16(frag_row(Kimg, 16 * kt, 0, lane), bq0, z); st[kt] = mfma16(frag_row(Kimg, 16 * kt, 32, lane), bq1, z); }
        const int row = row0 + qi;
        u32x2 gwv[4];
#pragma unroll
        for (int et = 0; et < 4; ++et) gwv[et] = *(const u32x2*)(P + (size_t)row * NPW + (KIND == 0 ? PC_RG : PC_MO) + h * 64 + 16 * et + 4 * g);
        if (KIND == 0) {
            const float lgf = logsigmoidf_(dpf), lgb = logsigmoidf_(dpb);
            f32x4 acc[4];
#pragma unroll
            for (int et = 0; et < 4; ++et) {
                f32x4 zf = {0.f, 0.f, 0.f, 0.f}, zb = zf;
                zf = mfma16(frag_row(SFimg, 16 * et, 0, lane), bq0, zf); zf = mfma16(frag_row(SFimg, 16 * et, 32, lane), bq1, zf);
                zb = mfma16(frag_row(SBimg, 16 * et, 0, lane), bq0, zb); zb = mfma16(frag_row(SBimg, 16 * et, 32, lane), bq1, zb);
                acc[et] = zf * __expf(lgf * (float)(qi + 1)) + zb * __expf(lgb * (float)(128 - qi));
            }
#pragma unroll
            for (int T = 0; T < 4; ++T) {
                f32x4 p0, p1;
#pragma unroll
                for (int j = 0; j < 4; ++j) {
                    const int k0 = 32 * T + 4 * g + j, k1 = k0 + 16;
                    const float w0 = (k0 <= qi ? __expf(lgf * (float)(qi - k0)) : 0.f) + (k0 >= qi ? __expf(lgb * (float)(k0 - qi)) : 0.f);
                    const float w1 = (k1 <= qi ? __expf(lgf * (float)(qi - k1)) : 0.f) + (k1 >= qi ? __expf(lgb * (float)(k1 - qi)) : 0.f);
                    p0[j] = st[2 * T][j] * w0; p1[j] = st[2 * T + 1][j] * w1;
                }
                const bf16x8 bp = pack8(p0, p1);
{ bf16x8 va[4]; frag_tr_x4<true>(Vimg, 32 * T, 0, lane, va);
#pragma unroll
                for (int et = 0; et < 4; ++et) acc[et] = mfma16(va[et], bp, acc[et]); }
            }
            float ss = 0.f;
#pragma unroll
            for (int et = 0; et < 4; ++et) ss += (acc[et][0] * acc[et][0] + acc[et][1] * acc[et][1]) + (acc[et][2] * acc[et][2] + acc[et][3] * acc[et][3]);
            ss = sum_g4(ss);
            const float rs = rsqrtf(ss * (1.0f / 64.0f) + EPS);
#pragma unroll
            for (int et = 0; et < 4; ++et) { const int e0 = h * 64 + 16 * et + 4 * g;
                const u32x2 gw = gwv[et];
                const float rs8 = rs * MG_F8_SCALE;
                *(unsigned*)((unsigned char*)MG + (size_t)row * (2 * DM) + e0) = pk4_f8(siluf_(bflo(gw.x)) * acc[et][0] * rs8, siluf_(bfhi(gw.x)) * acc[et][1] * rs8, siluf_(bflo(gw.y)) * acc[et][2] * rs8, siluf_(bfhi(gw.y)) * acc[et][3] * rs8); }
        } else {
            const float cf = CF[qi], cb = CB[qi];
            const float gf = __expf(mpf - cf), gb = __expf(mpb - cb);
            f32x4 af[5], ab[5];
#pragma unroll
            for (int et = 0; et < 5; ++et) {
                f32x4 zf = {0.f, 0.f, 0.f, 0.f}, zb = zf;
                zf = mfma16(frag_row(SFimg, 16 * et, 0, lane), bq0, zf); zf = mfma16(frag_row(SFimg, 16 * et, 32, lane), bq1, zf);
                zb = mfma16(frag_row(SBimg, 16 * et, 0, lane), bq0, zb); zb = mfma16(frag_row(SBimg, 16 * et, 32, lane), bq1, zb);
                af[et] = zf * gf; ab[et] = zb * gb;
            }
#pragma unroll
            for (int T = 0; T < 4; ++T) {
                const f32x4 a0f = *(const LAS f32x4*)(AF + 32 * T + 4 * g), a1f = *(const LAS f32x4*)(AF + 32 * T + 16 + 4 * g);
                const f32x4 a0b = *(const LAS f32x4*)(AB + 32 * T + 4 * g), a1b = *(const LAS f32x4*)(AB + 32 * T + 16 + 4 * g);
                f32x4 pf0, pf1, pb0, pb1;
#pragma unroll
                for (int j = 0; j < 4; ++j) {
                    const int k0 = 32 * T + 4 * g + j, k1 = k0 + 16;
                    pf0[j] = k0 <= qi ? st[2 * T][j] * __expf(a0f[j] - cf) : 0.f; pf1[j] = k1 <= qi ? st[2 * T + 1][j] * __expf(a1f[j] - cf) : 0.f;
                    pb0[j] = k0 >= qi ? st[2 * T][j] * __expf(a0b[j] - cb) : 0.f; pb1[j] = k1 >= qi ? st[2 * T + 1][j] * __expf(a1b[j] - cb) : 0.f;
                }
                const bf16x8 bpf = pack8(pf0, pf1), bpb = pack8(pb0, pb1);
{ bf16x8 va[4]; frag_tr_x4<true>(Vimg, 32 * T, 0, lane, va); const bf16x8 v4 = frag_tr<true>(Vimg, 32 * T, 64, lane);
#pragma unroll
                for (int et = 0; et < 4; ++et) { af[et] = mfma16(va[et], bpf, af[et]); ab[et] = mfma16(va[et], bpb, ab[et]); }
                af[4] = mfma16(v4, bpf, af[4]); ab[4] = mfma16(v4, bpb, ab[4]); }
            }
            const float denf = lane_get(af[4][0], lane & 15), denb = lane_get(ab[4][0], lane & 15);
            const float nf = rcpf_(fmaxf(fabsf(denf), __expf(-(BF[qi] + cf)))), nb = rcpf_(fmaxf(fabsf(denb), __expf(-(BB[qi] + cb))));
            f32x4 y[4]; float ss = 0.f;
#pragma unroll
            for (int et = 0; et < 4; ++et) { y[et] = af[et] * nf + ab[et] * nb; ss += (y[et][0] * y[et][0] + y[et][1] * y[et][1]) + (y[et][2] * y[et][2] + y[et][3] * y[et][3]); }
            ss = sum_g4(ss);
            const float rs = rsqrtf(ss * (1.0f / 64.0f) + EPS);
#pragma unroll
            for (int et = 0; et < 4; ++et) { const int e0 = h * 64 + 16 * et + 4 * g;
                const u32x2 gw = gwv[et];
                const float rs8 = rs * MG_F8_SCALE;
                *(unsigned*)((unsigned char*)MG + (size_t)row * (2 * DM) + 256 + e0) = pk4_f8(sigmoidf_(bflo(gw.x)) * y[et][0] * rs8, sigmoidf_(bfhi(gw.x)) * y[et][1] * rs8, sigmoidf_(bflo(gw.y)) * y[et][2] * rs8, sigmoidf_(bfhi(gw.y)) * y[et][3] * rs8); }
        }
    }
}

struct NaItem { int b, h, r0, ur0, nlb, lat, qrow0; };
__device__ __forceinline__ NaItem na_decode(int it) {
    NaItem t;
    if (it < 512) { t.lat = 1; const int rg = it & 7; t.h = (it >> 3) & 7; t.b = it >> 6; t.r0 = 4 * rg; t.ur0 = min(max(t.r0 - 4, 0), NROWS - 8);
        const int last = min(max(t.r0 - 1, 0), NROWS - 8) + 7; t.nlb = (last - t.ur0 + 4) >> 2; t.qrow0 = t.b * SEQ + t.r0 * 64; }
    else { const int j = it - 512; t.lat = 0; t.h = j & 7; t.b = j >> 3; t.r0 = 0; t.ur0 = 0; t.nlb = 0; t.qrow0 = NLAT + t.b * CTXL; }
    return t;
}
__device__ __forceinline__ int na_krow0(const NaItem& t, int step) { return step == 0 ? NLAT + t.b * CTXL : t.b * SEQ + (t.ur0 + 4 * (step - 1)) * 64; }
struct NaKV { u32x4 k[4], v[4]; };
__device__ __forceinline__ void na_load_kv(NaKV& x, const bf16_t* P, int krow0, int h, int tid) {
    const int rr = tid >> 1, c0 = (tid & 1) * 32; const bf16_t* ks = P + (size_t)(krow0 + rr) * NPW + PC_NK + 256 * (h >> 2) + hl_off(h & 3, c0); const bf16_t* vs = P + (size_t)(krow0 + rr) * NPW + PC_NV + h * 64 + c0;
#pragma unroll
    for (int i = 0; i < 4; ++i) { x.k[i] = *(const u32x4*)(ks + 8 * i); x.v[i] = *(const u32x4*)(vs + 8 * i); }
}
struct NaQ { u32x4 q[4]; };
__device__ __forceinline__ void na_load_q(NaQ& x, const bf16_t* P, int qrow0, int h, int tid) {
    const bf16_t* qs = P + (size_t)(qrow0 + (tid >> 1)) * NPW + PC_NQ + 256 * (h >> 2) + hl_off(h & 3, (tid & 1) * 32);
#pragma unroll
    for (int i = 0; i < 4; ++i) x.q[i] = *(const u32x4*)(qs + 8 * i);
}
struct NaState { float m, l; f32x4 acc[4]; };
template <int NPAIR, unsigned VALID>
__device__ __forceinline__ void na_update(NaState& st, const f32x4 (&s)[2 * NPAIR], float mx, LAS const unsigned char* Vimg, int vrow0, int lane) {
    mx = max_g4(mx);
    const float m_new = fmaxf(st.m, mx), resc = __builtin_amdgcn_exp2f(st.m - m_new);
    st.m = m_new; st.l *= resc;
#pragma unroll
    for (int et = 0; et < 4; ++et) st.acc[et] = st.acc[et] * resc;
#pragma unroll
    for (int T = 0; T < NPAIR; ++T) {
        if (((VALID >> (2 * T)) & 3u) != 0u) {
            f32x4 p0 = {0.f, 0.f, 0.f, 0.f}, p1 = p0;
            if ((VALID >> (2 * T)) & 1u) {
#pragma unroll
                for (int j = 0; j < 4; ++j) p0[j] = __builtin_amdgcn_exp2f(s[2 * T][j] - m_new);
                st.l += (p0[0] + p0[1]) + (p0[2] + p0[3]); }
            if ((VALID >> (2 * T + 1)) & 1u) {
#pragma unroll
                for (int j = 0; j < 4; ++j) p1[j] = __builtin_amdgcn_exp2f(s[2 * T + 1][j] - m_new);
                st.l += (p1[0] + p1[1]) + (p1[2] + p1[3]); }
            asm volatile("" : "+v"(st.l));
            const bf16x8 bp = pack8(p0, p1);
            bf16x8 va[4]; frag_tr_x4<true>(Vimg, vrow0 + 32 * T, 0, lane, va);
#pragma unroll
            for (int et = 0; et < 4; ++et) st.acc[et] = mfma16(va[et], bp, st.acc[et]);
            __builtin_amdgcn_sched_barrier(0);
        }
    }
}
template <int NPAIR>
__device__ __forceinline__ void na_update2(NaState (&st)[2], const f32x4 (&s)[2][2 * NPAIR], float (&mx)[2], LAS const unsigned char* Vimg, int vrow0, int lane) {
    float mn[2];
#pragma unroll
    for (int q2 = 0; q2 < 2; ++q2) { const float m1 = max_g4(mx[q2]); mn[q2] = fmaxf(st[q2].m, m1); const float resc = __builtin_amdgcn_exp2f(st[q2].m - mn[q2]); st[q2].m = mn[q2]; st[q2].l *= resc;
#pragma unroll
        for (int et = 0; et < 4; ++et) st[q2].acc[et] = st[q2].acc[et] * resc; }
#pragma unroll
    for (int T = 0; T < NPAIR; ++T) {
        bf16x8 va[4]; frag_tr_x4<true>(Vimg, vrow0 + 32 * T, 0, lane, va);
#pragma unroll
        for (int q2 = 0; q2 < 2; ++q2) { f32x4 p0, p1;
#pragma unroll
            for (int j = 0; j < 4; ++j) { p0[j] = __builtin_amdgcn_exp2f(s[q2][2 * T][j] - mn[q2]); p1[j] = __builtin_amdgcn_exp2f(s[q2][2 * T + 1][j] - mn[q2]); }
            st[q2].l += ((p0[0] + p0[1]) + (p0[2] + p0[3])) + ((p1[0] + p1[1]) + (p1[2] + p1[3]));
            asm volatile("" : "+v"(st[q2].l));
            const bf16x8 bp = pack8(p0, p1);
#pragma unroll
            for (int et = 0; et < 4; ++et) st[q2].acc[et] = mfma16(va[et], bp, st[q2].acc[et]); }
        __builtin_amdgcn_sched_barrier(0);
    }
}
template <int QTA>
__device__ __forceinline__ void na_local_row(NaState& st, const bf16x8& bq0, const bf16x8& bq1, LAS const unsigned char* Kimg, LAS const unsigned char* Vimg, LAS const float* browb, int irow0, int lane) {
    constexpr int kc0 = (16 * QTA - 8 < 0 ? 0 : (16 * QTA - 8 > 32 ? 32 : 16 * QTA - 8));
    const int g = lane >> 4, ql = 16 * QTA + (lane & 15), scq = min(max(ql - 8, 0), GRIDW - 16);
    f32x4 s[2]; float mx = -1.0e30f;
#pragma unroll
    for (int ct = 0; ct < 2; ++ct) {
        f32x4 z = {0.f, 0.f, 0.f, 0.f}; z = mfma16(frag_row(Kimg, irow0 + kc0 + 16 * ct, 0, lane), bq0, z); z = mfma16(frag_row(Kimg, irow0 + kc0 + 16 * ct, 32, lane), bq1, z);
        const LAS float* brow = browb + (kc0 + 16 * ct + 4 * g - ql + 63); const int t0 = kc0 + 16 * ct + 4 * g - scq;
#pragma unroll
        for (int j = 0; j < 4; ++j) { const float bv = brow[j]; const float zz = z[j] * 0.18033688f + bv; z[j] = ((unsigned)(t0 + j) < 16u) ? zz : -1.0e30f; }
        s[ct] = z; mx = fmaxf(mx, fmaxf(fmaxf(z[0], z[1]), fmaxf(z[2], z[3]))); asm volatile("" ::: "memory");
    }
    na_update<1, 3u>(st, s, mx, Vimg, irow0 + kc0, lane);
    __builtin_amdgcn_sched_barrier(0);
}
template <int QTA>
__device__ __forceinline__ void na_local_q(NaState& st, LAS const unsigned char* Qimg, LAS const unsigned char* Kimg, LAS const unsigned char* Vimg, LAS const float* RPB, int qimg_row, int lane, int kkb, int srw, int qrw) {
    const bf16x8 bq0 = frag_row(Qimg, qimg_row, 0, lane), bq1 = frag_row(Qimg, qimg_row, 32, lane);
#pragma unroll
    for (int kkl = 0; kkl < 4; ++kkl) { const int kk = kkb + kkl;
        if (kk >= srw && kk < srw + 8) na_local_row<QTA>(st, bq0, bq1, Kimg, Vimg, RPB + (kk - qrw + 7) * 128, 64 * kkl, lane); }
}
template <int WP>
__device__ __forceinline__ void na_local_step(NaState (&st)[2], LAS const unsigned char* Qimg, LAS const unsigned char* Kimg, LAS const unsigned char* Vimg, LAS const float* RPB, int wave, int lane, int kkb, int srw, int qrw) {
    na_local_q<2 * WP>(st[0], Qimg, Kimg, Vimg, RPB, 32 * wave, lane, kkb, srw, qrw);
    na_local_q<2 * WP + 1>(st[1], Qimg, Kimg, Vimg, RPB, 32 * wave + 16, lane, kkb, srw, qrw);
}
__device__ __forceinline__ void phase_natt_mfma(const Args& a, int l, bool need_ctx, LAS unsigned char* lds, int tid, int lane, int wave, int bid, int G) {
    unsigned char* ws = a.ws;
    const bf16_t* P = (const bf16_t*)(ws + WS_BIG); bf16_t* MG = (bf16_t*)(ws + WS_H);
    LAS unsigned char* Qimg = lds; LAS unsigned char* Kimg = lds + 40960; LAS unsigned char* Vimg = lds + 81920;
    LAS float* RPB = (LAS float*)(lds + 122880);
    const int nitems = 512 + (need_ctx ? NB * 8 : 0);
    const int g = lane >> 4;
    int it = (bid + G - 128 % G) % G; if (it >= nitems) return;
    NaItem cur = na_decode(it);
    NaKV kv; na_load_kv(kv, P, na_krow0(cur, 0), cur.h, tid);
    float rpbreg[4];
#pragma unroll
    for (int k = 0; k < 4; ++k) { const int idx = tid + 512 * k, dr = idx >> 7, dc = (idx & 127) - 48; rpbreg[k] = (idx < 1920 && dc >= 0 && dc <= 30) ? a.in[15][(size_t)(l * 8 + cur.h) * 465 + dr * 31 + dc] * 1.44269504f : 0.f; }
    for (;;) {
        const int itn = it + G; const bool has_next = itn < nitems; NaItem nxt = cur; if (has_next) nxt = na_decode(itn);
        const int nsteps = 1 + cur.nlb;
        const int qrw = cur.r0 + (wave >> 1), srw = min(max(qrw - 4, 0), NROWS - 8);
        NaState st[2];
#pragma unroll
        for (int q2 = 0; q2 < 2; ++q2) { st[q2].m = -1.0e30f; st[q2].l = 0.f;
#pragma unroll
            for (int et = 0; et < 4; ++et) st[q2].acc[et] = (f32x4){0.f, 0.f, 0.f, 0.f}; }
        for (int step = 0; step < nsteps; ++step) {
            int ts = tid; asm volatile("" : "+v"(ts));
            __syncthreads();
            { const int rr = ts >> 1, c0 = (ts & 1) * 32;
#pragma unroll
              for (int i = 0; i < 4; ++i) { *(LAS u32x4*)(Kimg + rr * IST + (c0 + 8 * i) * 2) = kv.k[i]; *(LAS u32x4*)(Vimg + rr * IST + (c0 + 8 * i) * 2) = kv.v[i]; }
              if (step == 0) { NaQ qr_; na_load_q(qr_, P, cur.qrow0, cur.h, ts);
#pragma unroll
                  for (int i = 0; i < 4; ++i) *(LAS u32x4*)(Qimg + rr * IST + (c0 + 8 * i) * 2) = qr_.q[i];
#pragma unroll
                  for (int k = 0; k < 4; ++k) if (ts + 512 * k < 1920) RPB[ts + 512 * k] = rpbreg[k]; } }
            __syncthreads();
            int tq = ts;
            if (step + 1 < nsteps) na_load_kv(kv, P, na_krow0(cur, step + 1), cur.h, tq);
            else if (has_next) { na_load_kv(kv, P, na_krow0(nxt, 0), nxt.h, tq);
#pragma unroll
                for (int k = 0; k < 4; ++k) { const int idx = tq + 512 * k, dr = idx >> 7, dc = (idx & 127) - 48; rpbreg[k] = (idx < 1920 && dc >= 0 && dc <= 30) ? a.in[15][(size_t)(l * 8 + nxt.h) * 465 + dr * 31 + dc] * 1.44269504f : 0.f; } }
            const int ln = ts & 63;
            if (step == 0) {
                const bf16x8 bq[4] = {frag_row(Qimg, 32 * wave, 0, ln), frag_row(Qimg, 32 * wave, 32, ln), frag_row(Qimg, 32 * wave + 16, 0, ln), frag_row(Qimg, 32 * wave + 16, 32, ln)};
#pragma unroll
                for (int hf = 0; hf < 2; ++hf) {
                    f32x4 s[2][8]; float mx[2] = {-1.0e30f, -1.0e30f};
#pragma unroll
                    for (int t8 = 0; t8 < 8; ++t8) { const bf16x8 kf0 = frag_row(Kimg, 128 * hf + 16 * t8, 0, ln), kf1 = frag_row(Kimg, 128 * hf + 16 * t8, 32, ln);
#pragma unroll
                        for (int q2 = 0; q2 < 2; ++q2) { f32x4 z = {0.f, 0.f, 0.f, 0.f}; z = mfma16(kf0, bq[2 * q2], z); z = mfma16(kf1, bq[2 * q2 + 1], z);
                            z = z * 0.18033688f; s[q2][t8] = z; mx[q2] = fmaxf(mx[q2], fmaxf(fmaxf(z[0], z[1]), fmaxf(z[2], z[3]))); }
                        if (t8 & 1) asm volatile("" ::: "memory"); }
                    na_update2<4>(st, s, mx, Vimg, 128 * hf, ln);
                    __builtin_amdgcn_sched_barrier(0);
                }
            } else {
                const int kkb = cur.ur0 + 4 * (step - 1);
                if (wave & 1) na_local_step<1>(st, Qimg, Kimg, Vimg, RPB, wave, ln, kkb, srw, qrw);
                else          na_local_step<0>(st, Qimg, Kimg, Vimg, RPB, wave, ln, kkb, srw, qrw);
            }
        }
        int lf = lane; asm volatile("" : "+v"(lf)); const int gf = lf >> 4;
#pragma unroll
        for (int q2 = 0; q2 < 2; ++q2) {
            const float inv = 1.0f / sum_g4(st[q2].l);
            const int row = cur.qrow0 + 32 * wave + 16 * q2 + (lf & 15);
#pragma unroll
            for (int et = 0; et < 4; ++et) { const float i8 = inv * MG_F8_SCALE;
                *(unsigned*)((unsigned char*)MG + (size_t)row * (2 * DM) + 512 + cur.h * 64 + 16 * et + 4 * gf) = pk4_f8(st[q2].acc[et][0] * i8, st[q2].acc[et][1] * i8, st[q2].acc[et][2] * i8, st[q2].acc[et][3] * i8); }
        }
        if (!has_next) break;
        it = itn; cur = nxt;
    }
}

constexpr int MOE_TAB_OFF = 131072;
__device__ __forceinline__ void moe_tab_setup(const unsigned char* ws, LAS unsigned char* lds, int tid) {
    LAS int* tab = (LAS int*)(lds + MOE_TAB_OFF);
    if (tid < NEXP) tab[16 + tid] = (int)__hip_atomic_load((const unsigned*)(ws + WS_CTL) + CW_MOE + 64 * tid, __ATOMIC_RELAXED, __HIP_MEMORY_SCOPE_AGENT);
    __syncthreads();
    if (tid == 0) { int p = 0;
        for (int e = 0; e < NEXP; ++e) { tab[e] = p; p += (tab[16 + e] + 255) >> 8; }
        tab[8] = p; }
    __syncthreads();
}
namespace pg8 {
struct MoeOrder : StaticOrder {
    const PG8_LAS int* tab; const int* list; size_t bstride;
    int tp1, tp2, tp3, tp4, tp5, tp6, tp7;
    __device__ __forceinline__ void load_tab() { tp1 = __builtin_amdgcn_readfirstlane(tab[1]); tp2 = __builtin_amdgcn_readfirstlane(tab[2]); tp3 = __builtin_amdgcn_readfirstlane(tab[3]); tp4 = __builtin_amdgcn_readfirstlane(tab[4]);
        tp5 = __builtin_amdgcn_readfirstlane(tab[5]); tp6 = __builtin_amdgcn_readfirstlane(tab[6]); tp7 = __builtin_amdgcn_readfirstlane(tab[7]); }
    __device__ __forceinline__ int expert(int pm) const { return (pm >= tp1) + (pm >= tp2) + (pm >= tp3) + (pm >= tp4) + (pm >= tp5) + (pm >= tp6) + (pm >= tp7); }
    const PG8_LAS unsigned short* rowtab;
    __device__ __forceinline__ unsigned arow(const Unit& u, int R) const {
        const int Rr = (u.hs > 0 ? HALF : 0) + (u.hs >= 0 ? (R & (HALF - 1)) : R);
        if (!list) return (unsigned)(u.pm * BM + Rr);
        return (unsigned)rowtab[u.idx * BM + Rr]; }
    __device__ __forceinline__ unsigned arow_global(const Unit& u, int Rr) const { const int e = expert(u.pm), idx = (u.pm - tab[e]) * BM + Rr; return idx < tab[16 + e] ? (unsigned)list[e * NLAT + idx] : 0u; }
    __device__ __forceinline__ const char* bbase(const Unit& u) const { return Bt + (size_t)expert(u.pm) * bstride + (size_t)u.pn * BM * K2; }
};
}
constexpr int MOE_ROWTAB_OFF = 131072 + 256 + 4096, MOE_ROWTAB_UNITS = 15;
__device__ __forceinline__ void moe_rowtab_fill(const pg8::MoeOrder& S, LAS unsigned char* lds, int tid) {
    LAS unsigned short* rt = (LAS unsigned short*)(lds + MOE_ROWTAB_OFF);
    for (int i0 = 0; i0 < MOE_ROWTAB_UNITS; i0 += 8) { unsigned v[4]; bool ok[4];
#pragma unroll
        for (int j = 0; j < 4; ++j) { const int i = i0 + 2 * j + (tid >> 8); pg8::Unit u; ok[j] = i < MOE_ROWTAB_UNITS && S.next(i, u); v[j] = ok[j] ? S.arow_global(u, tid & 255) : 0u; }
#pragma unroll
        for (int j = 0; j < 4; ++j) { const int i = i0 + 2 * j + (tid >> 8); if (ok[j]) rt[i * 256 + (tid & 255)] = (unsigned short)v[j]; } }
    __syncthreads();
}
__device__ __forceinline__ void phase_moe_combine(const Args& a, LAS unsigned char* lds, int lane, int wave, int bid, int G) {
    unsigned char* ws = a.ws; const LAS int* tab = (const LAS int*)(lds + MOE_TAB_OFF);
    const int* TOK = (const int*)(ws + WS_COMB); const bf16_t* Y = (const bf16_t*)(ws + WS_WTMUP);
    const float* g2 = (const float*)(ws + WS_MOD) + (size_t)9 * 6144 + 5120;
    for (int r0 = bid * NWAVES + wave; r0 < NLAT; r0 += 2 * G * NWAVES) {
        const bf16_t* y1[2]; const bf16_t* y2[2]; float w1[2], w2[2]; bool ok[2];
#pragma unroll
        for (int u = 0; u < 2; ++u) { const int r = r0 + u * G * NWAVES; ok[u] = r < NLAT; const int rr = ok[u] ? r : r0;
            const int e1 = TOK[rr * 8], e2 = TOK[rr * 8 + 1], p1 = TOK[rr * 8 + 2], p2 = TOK[rr * 8 + 3]; w1[u] = __int_as_float(TOK[rr * 8 + 4]); w2[u] = __int_as_float(TOK[rr * 8 + 5]);
            y1[u] = Y + ((size_t)tab[e1] * 256 + p1) * DM; y2[u] = Y + ((size_t)tab[e2] * 256 + p2) * DM; }
#pragma unroll
        for (int u = 0; u < 2; ++u) if (ok[u]) { const int r = r0 + u * G * NWAVES;
            const float* gr = g2 + (size_t)(r >> 11) * 6144; float* o = a.out + (size_t)r * DM; const bf16_t* xm = (const bf16_t*)(ws + WS_SB) + (size_t)r * DM;
#pragma unroll
            for (int j = 0; j < 4; ++j) { const int k = 4 * lane + 256 * j;
                const u32x2 a1 = *(const u32x2*)(y1[u] + k), a2 = *(const u32x2*)(y2[u] + k), xw = *(const u32x2*)(xm + k); const f32x4 x = {bflo(xw.x), bfhi(xw.x), bflo(xw.y), bfhi(xw.y)}, gg = *(const f32x4*)(gr + k);
                f32x4 mm; mm.x = w1[u] * bflo(a1.x) + w2[u] * bflo(a2.x); mm.y = w1[u] * bfhi(a1.x) + w2[u] * bfhi(a2.x); mm.z = w1[u] * bflo(a1.y) + w2[u] * bflo(a2.y); mm.w = w1[u] * bfhi(a1.y) + w2[u] * bfhi(a2.y);
                *(f32x4*)(o + k) = x + gg * mm; } }
    }
}
#ifndef STAGGER_US
#define STAGGER_US 0
#endif
#ifndef DUP_VIRT
#define DUP_VIRT (-1)
#endif
#define PH_REP_OPEN
#define PH_REP_CLOSE
#ifndef DUP_MASK
#define DUP_MASK (0)
#endif
#ifndef DUP_PH
#define DUP_PH (-1)
#endif
#ifndef PH_ONLY
#define PH_ONLY 0
#endif
#ifndef MIX_NAIVE
#define MIX_NAIVE 0
#endif
#ifndef MIX_RET
#define MIX_RET 1
#endif
#ifndef MIX_ML
#define MIX_ML 1
#endif
#ifndef MIX_NA
#define MIX_NA 1
#endif
#ifndef EN_PRO
#define EN_PRO 1
#endif
#ifndef EN_NORM
#define EN_NORM 1
#endif
#ifndef EN_GIN
#define EN_GIN 1
#endif
#ifndef EN_POST
#define EN_POST 1
#endif
#ifndef EN_FCUM
#define EN_FCUM 1
#endif
#ifndef EN_QUAD
#define EN_QUAD 1
#endif
#ifndef EN_NATT
#define EN_NATT 1
#endif
#ifndef EN_MERGE
#define EN_MERGE 1
#endif
#ifndef EN_GOUT
#define EN_GOUT 1
#endif
#ifndef EN_NORM2
#define EN_NORM2 1
#endif
#ifndef EN_GUP
#define EN_GUP 1
#endif
#ifndef EN_GDN
#define EN_GDN 1
#endif

__global__ void __launch_bounds__(NTHR, 2) fwd_kernel(Args a_) {
    extern __shared__ __attribute__((aligned(16))) unsigned char lds_raw[];
    LAS unsigned char* lds = (LAS unsigned char*)lds_raw;
    const int tid0 = threadIdx.x, G = gridDim.x, bid = blockIdx.x; const int wave0 = __builtin_amdgcn_readfirstlane(tid0 >> 6);
    unsigned char* ws0 = a_.ws;
    volatile LAS unsigned* MISC = (volatile LAS unsigned*)(lds + MISC_OFF);
    if (tid0 < 32) MISC[tid0] = 0u;
    __syncthreads();
    const int lo = a_.ph_lo, hi = a_.ph_hi % 1000; const int dmask = a_.ph_hi / 1000; (void)dmask;
    XcdBarrier bar; bar.bar = (unsigned*)(ws0 + WS_CTL) + CW_BAR; bar.x = 0; bar.st = MISC + 8;
    if (hi - lo > 1) bar = xcd_barrier_post((unsigned*)(ws0 + WS_CTL) + CW_BAR, MISC + 8);
    int ph = 0;
#define PH_BEGIN if (ph >= lo && ph < hi) { asm volatile("; PHMARK_BEGIN %0" :: "i"(__LINE__)); int tid; asm volatile("v_mbcnt_lo_u32_b32 %0, -1, 0\n\tv_mbcnt_hi_u32_b32 %0, -1, %0" : "=v"(tid)); tid += wave0 * 64; Args a; { const __attribute__((address_space(4))) Args* ap = (const __attribute__((address_space(4))) Args*)__builtin_amdgcn_kernarg_segment_ptr(); asm volatile("" : "+s"(ap)); a = *(const Args*)ap; } unsigned char* ws = a.ws; (void)ws; PH_REP_OPEN if (PH_ONLY == 0 || PH_ONLY == __LINE__) { const int lane = tid & 63, wave = __builtin_amdgcn_readfirstlane(tid >> 6); (void)lane; (void)wave;
#define PH_END   } PH_REP_CLOSE asm volatile("; PHMARK_END %0" :: "i"(__LINE__)); if (ph + 1 < hi) xcd_barrier(bar); else __syncthreads(); } ++ph;

    PH_BEGIN
#if EN_PRO
 phase_prologue(a, lds, tid, lane, wave, bid, G);
#endif
 PH_END

    for (int l = 0; l < 2; ++l) {
        const bool need_ctx = (l == 0);
#define MODP ((const float*)(ws + WS_MOD) + (size_t)l * 9 * 6144)
        PH_BEGIN
#if EN_NORM
 phase_norm1(a, l, lds, tid, lane, wave, bid, G);
#endif
 PH_END
        PH_BEGIN
#if EN_GIN
 { pg8::Gemm g{(const bf16_t*)(ws + WS_H), (const bf16_t*)(ws + WS_WTIN) + (size_t)l * NPW * DM, MALL, NPW, DM / 2};
                   pg8::StaticOrder S; S.init(MALL, NPW, G, bid); S.Bt = (const char*)g.Bt; S.K2 = 2 * DM;
                   { LAS float* cl = (LAS float*)(lds + PG8_EPI_CONST_OFF); const float* rp = (const float*)(ws + WS_ROPE);
                     float cv[5];
#pragma unroll
                     for (int q = 0; q < 5; ++q) { const int i = tid + NTHR * q; const float* sp = i < 2048 ? rp + i : (i < 2048 + 64 ? a.in[13] + l * 64 + i - 2048 : a.in[14] + l * 64 + i - 2112); cv[q] = i < 2048 + 128 ? *sp : 0.f; }
#pragma unroll
                     for (int q = 0; q < 5; ++q) { const int i = tid + NTHR * q; if (i < 2048 + 128) cl[i] = cv[q]; }
                     __syncthreads(); }
                   pg8::EpiProjI8 E{(bf16_t*)(ws + WS_BIG), NPW, (const float*)(ws + WS_ROPE), a.in[13] + l * 64, a.in[14] + l * 64, NLAT / 256, (const float*)(ws + WS_HS), (const unsigned*)(ws + WS_CTL) + CW_COLMAX + l * NPW};
                   if (STAGGER_US > 0 && (bid & 1)) { const unsigned long long t0 = __builtin_amdgcn_s_memrealtime(); while (__builtin_amdgcn_s_memrealtime() - t0 < (unsigned long long)STAGGER_US * 100ull) __builtin_amdgcn_s_sleep(32); }
                   pg8::gemm_phase<pg8::EpiProjI8, pg8::StaticOrder, false>(lds, g, S, E, nullptr, tid); idle_strips(S, a, lds, tid, 2); }
#endif
 PH_END
        PH_BEGIN
#if MIX_RET || MIX_ML
        phase_chunk_sums(a, l, lds, tid, lane, wave, bid, G);
#endif
        PH_END
        PH_BEGIN phase_chunk_states(a, l, tid, bid, G);
#if MIX_NA
        if (N_LAUNCH_MODE == 0 || !(dmask & 4)) phase_natt_mfma(a, l, need_ctx, lds, tid, lane, wave, bid, G);
#endif
#if MIX_RET
        if (N_LAUNCH_MODE == 0 || !(dmask & 1)) phase_chunk_out<0>(a, l, need_ctx, lds, tid, lane, wave, bid, G);
#endif
#if MIX_ML
        if (N_LAUNCH_MODE == 0 || !(dmask & 2)) phase_chunk_out<1>(a, l, need_ctx, lds, tid, lane, wave, bid, G);
#endif
        PH_END
        PH_BEGIN
#if EN_GOUT
 { const int M = need_ctx ? MALL : NLAT;
                   pg8::Gemm g{(const bf16_t*)(ws + WS_H), (const bf16_t*)(ws + WS_WTOUT) + (size_t)l * DM * DM, M, DM, DM / 2, DM * 2};
                   pg8::StaticOrder S; S.init(M, DM, G, bid); S.quarter = true; S.Bt = (const char*)g.Bt; S.K2 = 2 * DM;
                   pg8::EpiResidF8 E{l == 0 ? (const void*)a.in[0] : (const void*)(ws + WS_SB), l == 0 ? (const void*)a.in[2] : (const void*)(ws + WS_XC), (bf16_t*)(ws + WS_SB), (bf16_t*)(ws + WS_XC), MODP + 2048, NLAT / 256, (const unsigned*)(ws + WS_CTL) + CW_COLMAX_OUT + l * DM, 1.0f / (448.0f * MG_F8_SCALE), l == 0 ? 1 : 0};
                   pg8::gemm_phase<pg8::EpiResidF8, pg8::StaticOrder, false>(lds, g, S, E, nullptr, tid); idle_strips(S, a, lds, tid, 2); }
#endif
 PH_END
        if (l == 0) { PH_BEGIN
#if EN_NORM2
 phase_norm<1>(a, l, lds, tid, lane, wave, bid, G);
#endif
 PH_END }
        else        { PH_BEGIN
#if EN_NORM2
 phase_norm<2>(a, l, lds, tid, lane, wave, bid, G);
 if (G == 256) quant_strips_dyn(a, ws, lds, tid, 1 << 30);
#endif
 PH_END }
        if (l == 0) {
            PH_BEGIN { pg8::Gemm g{(const bf16_t*)(ws + WS_H), (const bf16_t*)(ws + WS_WTUP), MALL, NUP, DM / 2};
                       pg8::StaticOrder S; S.init(MALL, NUP, G, bid); S.Bt = (const char*)g.Bt; S.K2 = 2 * DM;
                       pg8::EpiSwiGLUI8 E{(bf16_t*)(ws + WS_BIG), DFF, (const float*)(ws + WS_HS), (const unsigned*)(ws + WS_CTL) + CW_COLMAX + 2 * NPW, nullptr, (unsigned*)(ws + WS_CTL) + CW_RMAX_D, 0};
                       pg8::gemm_phase<pg8::EpiSwiGLUI8, pg8::StaticOrder, false>(lds, g, S, E, nullptr, tid); idle_strips(S, a, lds, tid, 2); } PH_END
            PH_BEGIN { pg8::Gemm g{(const bf16_t*)(ws + WS_BIG), (const bf16_t*)(ws + WS_WTDN), MALL, DM, DFF / 2, DFF};
                       pg8::StaticOrder S; S.init(MALL, DM, G, bid); S.quarter = true; S.Bt = (const char*)g.Bt; S.K2 = 2 * DFF;
                       pg8::EpiResidF8 E{(const void*)(ws + WS_SB), (const void*)(ws + WS_XC), (bf16_t*)(ws + WS_SB), (bf16_t*)(ws + WS_XC), MODP + 5120, NLAT / 256, (const unsigned*)(ws + WS_CTL) + CW_COLMAX_DN, 1.0f / (448.0f * pg8::ACT_F8_SCALE), 0};
                       pg8::gemm_phase<pg8::EpiResidF8, pg8::StaticOrder, false>(lds, g, S, E, nullptr, tid); idle_strips(S, a, lds, tid, 2); } PH_END
        } else {
            PH_BEGIN { moe_tab_setup(ws, lds, tid); const LAS int* tab = (const LAS int*)(lds + MOE_TAB_OFF);
                       pg8::Gemm g{(const bf16_t*)(ws + WS_H), (const bf16_t*)(ws + WS_WTMUP), 256 * tab[8], NUP, DM / 2};
                       pg8::MoeOrder S; S.init(256 * tab[8], NUP, G, bid); S.Bt = (const char*)g.Bt; S.K2 = 2 * DM; S.tab = tab; S.load_tab(); S.list = (const int*)(ws + WS_LIST); S.bstride = (size_t)NUP * DM * 2; S.rowtab = (const LAS unsigned short*)(lds + MOE_ROWTAB_OFF); moe_rowtab_fill(S, lds, tid);
                       pg8::EpiSwiGLUI8 E{(bf16_t*)(ws + WS_BIG), DFF, (const float*)(ws + WS_HS), (const unsigned*)(ws + WS_CTL) + CW_COLMAX + 2 * NPW + NUP, tab, (unsigned*)(ws + WS_CTL) + CW_RMAX_M, NUP};
                       pg8::gemm_phase<pg8::EpiSwiGLUI8, pg8::MoeOrder, false>(lds, g, S, E, nullptr, tid); } PH_END
            PH_BEGIN { moe_tab_setup(ws, lds, tid); const LAS int* tab = (const LAS int*)(lds + MOE_TAB_OFF);
                       pg8::Gemm g{(const bf16_t*)(ws + WS_BIG), (const bf16_t*)(ws + WS_WTMDN), 256 * tab[8], DM, DFF / 2, DFF};
                       pg8::MoeOrder S; S.init(256 * tab[8], DM, G, bid); S.quarter = true; S.Bt = (const char*)g.Bt; S.K2 = 2 * DFF; S.tab = tab; S.load_tab(); S.list = nullptr; S.rowtab = nullptr; S.bstride = (size_t)DM * DFF * 2;
                       pg8::EpiBf16F8 E{(bf16_t*)(ws + WS_WTMUP), DM, (const unsigned*)(ws + WS_CTL) + CW_RMAX_M, (const unsigned*)(ws + WS_CTL) + CW_COLMAX_DN + DM, tab, DM};
                       pg8::gemm_phase<pg8::EpiBf16F8, pg8::MoeOrder, false>(lds, g, S, E, nullptr, tid); } PH_END
            PH_BEGIN { moe_tab_setup(ws, lds, tid); phase_moe_combine(a, lds, lane, wave, bid, G); } PH_END
        }
    }
#if N_LAUNCH_MODE == 1
    if (lo >= 100) {
        int tid; asm volatile("v_mbcnt_lo_u32_b32 %0, -1, 0\n\tv_mbcnt_hi_u32_b32 %0, -1, %0" : "=v"(tid)); tid += wave0 * 64; const int lane = tid & 63, wave = wave0;
        Args a = a_;
#if DUP_VIRT == 104
        if (lo == 104) { unsigned char* ws = a.ws; pg8::Gemm g{(const bf16_t*)(ws + WS_H), (const bf16_t*)(ws + WS_WTUP), MALL, NUP, DM / 2};
                   pg8::StaticOrder S; S.init(MALL, NUP, G, bid); S.Bt = (const char*)g.Bt; S.K2 = 2 * DM; pg8::EpiNullI8 E{(bf16_t*)(ws + WS_BIG), NPW};
                   pg8::gemm_phase<pg8::EpiNullI8, pg8::StaticOrder, false>(lds, g, S, E, nullptr, tid); }
#endif
    }
#endif
#undef PH_BEGIN
#undef PH_END
}
constexpr int N_PHASES = 1 + 2 * 6 + 2 + 3;
#ifndef DBG_MAXPH
#define DBG_MAXPH 1000
#endif

extern "C" void kernel_launch(void* const* d_in, const int* in_sizes, int n_in, void* d_out, int out_size, void* d_ws, size_t ws_size, hipStream_t stream) {
    static int grid = 0;
    if (grid == 0) {
        if (n_in != 24 || out_size != NLAT * DM || ws_size < WS_END) { fprintf(stderr, "kernel_launch: unexpected sizes (n_in %d, out %d, ws %zu < %zu); nothing launched\n", n_in, out_size, ws_size, (size_t)WS_END); grid = -1; return; }
        int dev = 0, cus = 0;
        if (hipGetDevice(&dev) != hipSuccess || hipDeviceGetAttribute(&cus, hipDeviceAttributeMultiprocessorCount, dev) != hipSuccess) { grid = -1; return; }
        if (hipFuncSetAttribute((const void*)fwd_kernel, hipFuncAttributeMaxDynamicSharedMemorySize, LDS_BYTES) != hipSuccess) { fprintf(stderr, "kernel_launch: hipFuncSetAttribute failed\n"); grid = -1; return; }
        int per_cu = 0;
        if (hipOccupancyMaxActiveBlocksPerMultiprocessor(&per_cu, (const void*)fwd_kernel, NTHR, LDS_BYTES) != hipSuccess || per_cu < 1) { fprintf(stderr, "kernel_launch: occupancy query says %d\n", per_cu); }
        (void)hipGetLastError();
        grid = cus;
    }
    if (grid < 0) return;
    (void)hipMemsetAsync((char*)d_ws + WS_CTL, 0, CTL_BYTES, stream);
    Args a{};
    for (int i = 0; i < 24; ++i) a.in[i] = (const float*)d_in[i];
    a.out = (float*)d_out; a.ws = (unsigned char*)d_ws;
#if N_LAUNCH_MODE == 0
    a.ph_lo = 0; a.ph_hi = N_PHASES;
    hipLaunchKernelGGL(fwd_kernel, dim3(grid), dim3(NTHR), LDS_BYTES, stream, a);
#else
    for (int p = 0; p < N_PHASES && p < DBG_MAXPH; ++p) { a.ph_lo = p; a.ph_hi = p + 1; hipLaunchKernelGGL(fwd_kernel, dim3(grid), dim3(NTHR), LDS_BYTES, stream, a);
        if (p == DUP_PH) { a.ph_hi = p + 1 + 1000 * DUP_MASK; hipLaunchKernelGGL(fwd_kernel, dim3(grid), dim3(NTHR), LDS_BYTES, stream, a); }
        if (p == 8 && DUP_VIRT >= 104) { a.ph_lo = DUP_VIRT; a.ph_hi = DUP_VIRT + 1; hipLaunchKernelGGL(fwd_kernel, dim3(grid), dim3(NTHR), LDS_BYTES, stream, a); }
        if (p == 5 && DUP_VIRT >= 100 && DUP_VIRT < 104) { a.ph_lo = DUP_VIRT; a.ph_hi = DUP_VIRT + 1; hipLaunchKernelGGL(fwd_kernel, dim3(grid), dim3(NTHR), LDS_BYTES, stream, a); } }
#endif
}
```
